# Optimizing an MI355X kernel written in HIP

```python
import jax, jax.numpy as jnp
from jax import lax
import numpy as np

D_MODEL = 1024
BATCH = 8
SEQ = 4096
DEPTH = 1

HEAD_DIM = 64
A_HEADS = 8
A_KV_HEADS = 2
IDX_HEADS = 8
IDX_DIM = 64
TOPK_MAX = 256
B_HEADS = 8
B_KV_HEADS = 2
WINDOW = 128
Q_BLOCK = 128
D_FF = 4 * D_MODEL
ROPE_THETA = 10000.0
RMS_EPS = 1e-6
LN_EPS = 1e-6

A_Q = A_HEADS * HEAD_DIM
A_KV = A_KV_HEADS * HEAD_DIM
IDX_Q = IDX_HEADS * IDX_DIM
B_Q = B_HEADS * HEAD_DIM
B_KV = B_KV_HEADS * HEAD_DIM
SPLIT_SIZES = (A_Q, A_KV, A_KV, IDX_Q, IDX_DIM, IDX_HEADS, B_Q, B_KV, B_KV, D_MODEL, D_MODEL)
D_IN = sum(SPLIT_SIZES)

kernel_name = "hybrid_dsa_swa_sink_gated_block"


def rmsnorm(x, g):
    xf = x.astype(jnp.float32)
    y = xf * lax.rsqrt(jnp.mean(xf * xf, axis=-1, keepdims=True) + RMS_EPS)
    return (y * g.astype(jnp.float32)).astype(x.dtype)


def layernorm(x, w, b):
    xf = x.astype(jnp.float32)
    mu = jnp.mean(xf, axis=-1, keepdims=True)
    var = jnp.mean(jnp.square(xf - mu), axis=-1, keepdims=True)
    y = (xf - mu) * lax.rsqrt(var + LN_EPS)
    return (y * w.astype(jnp.float32) + b.astype(jnp.float32)).astype(x.dtype)


def rope_tables(L, dim):
    inv = 1.0 / (ROPE_THETA ** (jnp.arange(0, dim, 2, dtype=jnp.float32) / dim))
    ang = jnp.arange(L, dtype=jnp.float32)[:, None] * inv[None, :]
    return jnp.cos(ang), jnp.sin(ang)


def apply_rope(x, cos, sin):
    xf = x.astype(jnp.float32)
    x1, x2 = jnp.split(xf, 2, axis=-1)
    c = cos[None, :, None, :]
    s = sin[None, :, None, :]
    return jnp.concatenate([x1 * c - x2 * s, x2 * c + x1 * s], axis=-1).astype(x.dtype)


def dsa_branch(q, k, v, q_idx, k_idx, w_idx, topk):
    Bn, L, H, dh = q.shape
    G = k.shape[2]
    R = H // G
    nb = L // Q_BLOCK
    kpos = jnp.arange(L)
    k_idx32 = k_idx.astype(jnp.float32)
    scale = HEAD_DIM ** -0.5

    def one_block(i):
        start = i * Q_BLOCK
        qb = lax.dynamic_slice_in_dim(q, start, Q_BLOCK, axis=1)
        qib = lax.dynamic_slice_in_dim(q_idx, start, Q_BLOCK, axis=1)
        wb = lax.dynamic_slice_in_dim(w_idx, start, Q_BLOCK, axis=1)
        qpos = start + jnp.arange(Q_BLOCK)
        s = jnp.einsum('bqhd,bkd->bqhk', qib.astype(jnp.float32), k_idx32)
        score = jnp.einsum('bqhk,bqh->bqk', jax.nn.relu(s), wb.astype(jnp.float32))
        causal = kpos[None, :] <= qpos[:, None]
        score = jnp.where(causal[None], score, -jnp.inf)
        _, sel = lax.top_k(score, topk)
        ks = jax.vmap(lambda kk, ii: kk[ii])(k, sel)
        vs = jax.vmap(lambda vv, ii: vv[ii])(v, sel)
        valid = sel <= qpos[None, :, None]
        qg = qb.reshape(Bn, Q_BLOCK, G, R, dh).astype(jnp.float32)
        logits = jnp.einsum('bqgrd,bqkgd->bqgrk', qg, ks.astype(jnp.float32)) * scale
        logits = jnp.where(valid[:, :, None, None, :], logits, -jnp.inf)
        p = jax.nn.softmax(logits, axis=-1)
        o = jnp.einsum('bqgrk,bqkgd->bqgrd', p, vs.astype(jnp.float32))
        return o.reshape(Bn, Q_BLOCK, H * dh).astype(q.dtype)

    out = lax.map(one_block, jnp.arange(nb))
    return jnp.transpose(out, (1, 0, 2, 3)).reshape(Bn, L, H * dh)


def swa_branch(q, k, v, sinks):
    Bn, L, H, dh = q.shape
    G = k.shape[2]
    R = H // G
    W = WINDOW
    nb = L // W
    qb = q.reshape(Bn, nb, W, G, R, dh).astype(jnp.float32)
    pad = ((0, 0), (W, 0), (0, 0), (0, 0))
    kp = jnp.pad(k, pad).reshape(Bn, nb + 1, W, G, dh)
    vp = jnp.pad(v, pad).reshape(Bn, nb + 1, W, G, dh)
    kb = jnp.concatenate([kp[:, :-1], kp[:, 1:]], axis=2).astype(jnp.float32)
    vb = jnp.concatenate([vp[:, :-1], vp[:, 1:]], axis=2).astype(jnp.float32)
    logits = jnp.einsum('bnqgrd,bnkgd->bngrqk', qb, kb) * (HEAD_DIM ** -0.5)
    rel = jnp.arange(W)[:, None] + W - jnp.arange(2 * W)[None, :]
    kabs = jnp.arange(nb)[:, None] * W - W + jnp.arange(2 * W)[None, :]
    mask = ((rel >= 0) & (rel < W))[None, :, :] & (kabs >= 0)[:, None, :]
    logits = jnp.where(mask[None, :, None, None, :, :], logits, -jnp.inf)
    sink = jnp.broadcast_to(sinks.astype(jnp.float32).reshape(1, 1, G, R, 1, 1), logits.shape[:-1] + (1,))
    p = jax.nn.softmax(jnp.concatenate([logits, sink], axis=-1), axis=-1)[..., :-1]
    o = jnp.einsum('bngrqk,bnkgd->bnqgrd', p, vb)
    return o.reshape(Bn, L, H * dh).astype(q.dtype)


def setup_inputs(seed: int = 0) -> dict:
    key = jax.random.key(seed)
    ks = jax.random.split(key, 14)
    f32 = jnp.float32
    nrm = lambda k, shape: jax.random.normal(k, shape, dtype=f32)
    return {
        "x": nrm(ks[0], (BATCH, SEQ, D_MODEL)),
        "attn_norm_w": 1.0 + 0.02 * nrm(ks[1], (DEPTH, D_MODEL)),
        "w_in": nrm(ks[2], (DEPTH, D_MODEL, D_IN)) * D_MODEL ** -0.5,
        "idx_k_norm_w": 1.0 + 0.02 * nrm(ks[3], (DEPTH, IDX_DIM)),
        "idx_k_norm_b": 0.02 * nrm(ks[4], (DEPTH, IDX_DIM)),
        "sinks": 0.5 * nrm(ks[5], (DEPTH, B_HEADS)),
        "w_branch_a": nrm(ks[6], (DEPTH, A_Q, D_MODEL)) * A_Q ** -0.5,
        "w_branch_b": nrm(ks[7], (DEPTH, B_Q, D_MODEL)) * B_Q ** -0.5,
        "w_out": nrm(ks[8], (DEPTH, D_MODEL, D_MODEL)) * D_MODEL ** -0.5,
        "mlp_norm_w": 1.0 + 0.02 * nrm(ks[9], (DEPTH, D_MODEL)),
        "w_up": nrm(ks[10], (DEPTH, D_MODEL, D_FF)) * D_MODEL ** -0.5,
        "w_down": nrm(ks[11], (DEPTH, D_FF, D_MODEL)) * D_FF ** -0.5,
        "final_norm_w": 1.0 + 0.02 * nrm(ks[12], (D_MODEL,)),
    }


def reference(x, attn_norm_w, w_in, idx_k_norm_w, idx_k_norm_b, sinks, w_branch_a, w_branch_b,
              w_out, mlp_norm_w, w_up, w_down, final_norm_w):
    Bn, L, _ = x.shape
    topk = min(TOPK_MAX, L // 4)
    cos, sin = rope_tables(L, HEAD_DIM)
    cos_i, sin_i = rope_tables(L, IDX_DIM)
    offsets = [sum(SPLIT_SIZES[:i + 1]) for i in range(len(SPLIT_SIZES) - 1)]
    w_scale = (IDX_HEADS ** -0.5) * (IDX_DIM ** -0.5)

    for l in range(DEPTH):
        h = rmsnorm(x, attn_norm_w[l])
        proj = jnp.einsum('bld,de->ble', h, w_in[l])
        a_q, a_k, a_v, i_q, i_k, i_w, b_q, b_k, b_v, g_a, g_b = jnp.split(proj, offsets, axis=-1)

        a_q = apply_rope(a_q.reshape(Bn, L, A_HEADS, HEAD_DIM), cos, sin)
        a_k = apply_rope(a_k.reshape(Bn, L, A_KV_HEADS, HEAD_DIM), cos, sin)
        a_v = a_v.reshape(Bn, L, A_KV_HEADS, HEAD_DIM)
        i_q = apply_rope(i_q.reshape(Bn, L, IDX_HEADS, IDX_DIM), cos_i, sin_i)
        i_k = layernorm(i_k, idx_k_norm_w[l], idx_k_norm_b[l])
        i_k = apply_rope(i_k[:, :, None, :], cos_i, sin_i)[:, :, 0, :]
        i_w = i_w * w_scale
        o_a = dsa_branch(a_q, a_k, a_v, i_q, i_k, i_w, topk)

        b_q = apply_rope(b_q.reshape(Bn, L, B_HEADS, HEAD_DIM), cos, sin)
        b_k = apply_rope(b_k.reshape(Bn, L, B_KV_HEADS, HEAD_DIM), cos, sin)
        b_v = b_v.reshape(Bn, L, B_KV_HEADS, HEAD_DIM)
        o_b = swa_branch(b_q, b_k, b_v, sinks[l])

        y_a = jnp.einsum('ble,ed->bld', o_a, w_branch_a[l])
        y_b = jnp.einsum('ble,ed->bld', o_b, w_branch_b[l])
        mix = jax.nn.sigmoid(g_a) * y_a + jax.nn.sigmoid(g_b) * y_b
        x = x + jnp.einsum('bld,de->ble', mix, w_out[l])

        h2 = rmsnorm(x, mlp_norm_w[l])
        u = jax.nn.relu(jnp.einsum('bld,df->blf', h2, w_up[l]))
        x = x + jnp.einsum('blf,fd->bld', u * u, w_down[l])

    return rmsnorm(x, final_norm_w)
```

```cpp
#include <hip/hip_runtime.h>
#include <hip/hip_cooperative_groups.h>
#include <cstdio>
#include <cstdint>
namespace cg = cooperative_groups;

#ifndef MK_ONE_LAUNCH
#define MK_ONE_LAUNCH 0
#endif

constexpr int NBATCH = 8, SEQ = 4096, DM = 1024, TOK = NBATCH * SEQ, DFF = 4096, TOPK = 256, WIN = 128;
constexpr int NIN = 4352;
constexpr float RMS_EPS = 1e-6f, LN_EPS = 1e-6f;
constexpr float QSCALE = 0.125f * 1.4426950408889634f;
constexpr float LOG2E = 1.4426950408889634f;
constexpr float W_SCALE = 0.04419417382415922f;
constexpr int C_AQ = 0, C_AK = 512, C_AV = 640, C_IQ = 768, C_IK = 1280, C_IW = 1344, C_BQ = 1352, C_BK = 1864, C_BV = 1992, C_GA = 2120, C_GB = 3144, D_IN = 4168;

constexpr size_t MiB = 1u << 20;
constexpr size_t WS_RSTD1 = 0, WS_SS2 = 128 * 1024, WS_SS3 = 256 * 1024;
constexpr size_t WS_COS = 1 * MiB, WS_SIN = 1 * MiB + 512 * 1024;
constexpr size_t WS_WIN = 2 * MiB, WS_WAB = 11 * MiB, WS_WOUT = 13 * MiB, WS_WUP = 15 * MiB, WS_WDN = 23 * MiB;
constexpr size_t WS_XG = 32 * MiB;
constexpr size_t WS_AQ = 96 * MiB, WS_IQ = 128 * MiB, WS_BQ = 160 * MiB, WS_AK = 192 * MiB, WS_AV = 200 * MiB, WS_BK = 208 * MiB, WS_BV = 216 * MiB;
constexpr size_t WS_IK = 224 * MiB, WS_IW = 228 * MiB, WS_SEL = 230 * MiB, WS_GA = 248 * MiB, WS_GB = 312 * MiB, WS_MIX = 376 * MiB, WS_END = 440 * MiB;
constexpr size_t WS_HID = 96 * MiB;
static_assert(WS_WIN + (size_t)NIN * DM * 2 <= WS_WAB && WS_HID + (size_t)TOK * DFF * 2 <= WS_MIX, "ws map");

constexpr int LDS_RING = 131072, LDS_BYTES = 147456;

#define GAS __attribute__((address_space(1)))
#define LAS __attribute__((address_space(3)))
typedef unsigned short bf16;
typedef unsigned v4u __attribute__((ext_vector_type(4)));
typedef unsigned v2u __attribute__((ext_vector_type(2)));
typedef float v4f __attribute__((ext_vector_type(4)));

__device__ __forceinline__ float bf2f(unsigned short u) { return __uint_as_float((unsigned)u << 16); }
__device__ __forceinline__ float bflo(unsigned u) { return __uint_as_float(u << 16); }
__device__ __forceinline__ float bfhi(unsigned u) { return __uint_as_float(u & 0xffff0000u); }
__device__ __forceinline__ unsigned f2bf(float f) { unsigned u = __float_as_uint(f); return (u + 0x7fffu + ((u >> 16) & 1u)) >> 16; }
__device__ __forceinline__ unsigned pk2(float lo, float hi) { unsigned r; asm volatile("v_cvt_pk_bf16_f32 %0, %1, %2" : "=v"(r) : "v"(lo), "v"(hi)); return r; }
__device__ __forceinline__ float fexp2(float x) { return __builtin_amdgcn_exp2f(x); }
__device__ __forceinline__ float frsq(float x) { return __builtin_amdgcn_rsqf(x); }
__device__ __forceinline__ float frcp(float x) { return __builtin_amdgcn_rcpf(x); }
__device__ __forceinline__ float sigmoidf_(float x) { return frcp(1.0f + fexp2(-x * LOG2E)); }
__device__ __forceinline__ float wave_sum(float v) {
#pragma unroll
    for (int o = 1; o < 64; o <<= 1) v += __shfl_xor(v, o);
    return v;
}
__device__ __forceinline__ float wave_max(float v) {
#pragma unroll
    for (int o = 1; o < 64; o <<= 1) v = fmaxf(v, __shfl_xor(v, o));
    return v;
}
__device__ __forceinline__ int mbcnt64(unsigned long long m) { return __builtin_amdgcn_mbcnt_hi((unsigned)(m >> 32), __builtin_amdgcn_mbcnt_lo((unsigned)m, 0u)); }

namespace pg8 {
#define PG8_LAS __attribute__((address_space(3)))
typedef unsigned short bf16_t;
typedef short bf16x8 __attribute__((ext_vector_type(8)));
typedef float f32x4 __attribute__((ext_vector_type(4)));
typedef unsigned u32x4 __attribute__((ext_vector_type(4)));
constexpr int BM = 256, BK = 64, HALF = 128, HTB = HALF * BK * 2  , STAGE_BYTES = 8 * HTB, NXCD = 8, WGM = 8;

__host__ __device__ __forceinline__ int lds_byte(int r, int c) { const int st = (r >> 4) * 2 + (c >> 5), rr = r & 15, cc = c & 31, ob = rr * 64 + cc * 2; return st * 1024 + (ob ^ (((ob >> 9) & 1) << 5)); }
__host__ __device__ __forceinline__ void stage_rc(int b, int& R, int& C) { const int st = b / 1024, sb = b % 1024, swz = sb ^ (((sb >> 9) & 1) << 5); R = (st >> 1) * 16 + swz / 64; C = (st & 1) * 32 + (swz % 64) / 2; }
__host__ __device__ __forceinline__ int perm32(int rho) { const int n = rho >> 4, i = rho & 15; return 8 * (i >> 2) + 4 * n + (i & 3); }

struct Unit { int pm, pn; };
struct Gemm { const bf16_t* A; const bf16_t* Bt; int M, N, K; const bf16_t* A2; int asplit;
    __device__ __forceinline__ const char* abase(const Unit& u) const { return (const char*)(u.pn >= asplit ? A2 : A); } };

struct StaticOrder {
    int nM, nN, nwg, G, c;
    __host__ __device__ void init(int M, int N, int G_, int c_) { nM = M / BM; nN = N / BM; nwg = nM * nN; G = G_; c = c_; }
    __host__ __device__ bool next(int i, Unit& u) const {
        const long L = (long)i * G + c; if (L >= nwg) return false;
        int wgid = (int)L; { const int q = nwg / NXCD, r = nwg % NXCD, xcd = wgid % NXCD, off = wgid / NXCD; wgid = (xcd < r ? xcd * (q + 1) : r * (q + 1) + (xcd - r) * q) + off; }
        const int nig = WGM * nN, gid = wgid / nig, fm = gid * WGM, gsz = (nM - fm) < WGM ? (nM - fm) : WGM;
        u.pm = fm + ((wgid % nig) % gsz); u.pn = (wgid % nig) / gsz; return true;
    }
    __device__ __forceinline__ void a_ready(const Unit&) const {}
    __device__ __forceinline__ void done(const Unit&) const {}
};

__device__ __forceinline__ unsigned cvt_pk_bf16(float lo, float hi) { unsigned r; asm volatile("v_cvt_pk_bf16_f32 %0, %1, %2" : "=v"(r) : "v"(lo), "v"(hi)); return r; }
__device__ __forceinline__ u32x4 pack8(const float (&v)[8]) { u32x4 w; w.x = cvt_pk_bf16(v[0], v[1]); w.y = cvt_pk_bf16(v[2], v[3]); w.z = cvt_pk_bf16(v[4], v[5]); w.w = cvt_pk_bf16(v[6], v[7]); return w; }

struct EpiInProj {
    static constexpr bool PERM = true, AFTER_DRAIN = false;
    const float* rstd1; const float* cs; const float* sn; unsigned char* ws; const float* ikw; const float* ikb;
    __device__ __forceinline__ void operator()(const f32x4 (&acc)[2][2][4][2], const Unit& u, int wr, int wc, int fr, int fq) const {
        const int pn = u.pn;
#pragma unroll
        for (int ai = 0; ai < 2; ++ai)
#pragma unroll
            for (int m = 0; m < 4; ++m) {
                const int row = u.pm * BM + ai * HALF + wr * 64 + m * 16 + fr;
                const float rs = rstd1[row];
                float x1[8], x2[8];
#pragma unroll
                for (int j = 0; j < 4; ++j) { x1[j] = acc[ai][0][m][0][j] * rs; x1[4 + j] = acc[ai][0][m][1][j] * rs; x2[j] = acc[ai][1][m][0][j] * rs; x2[4 + j] = acc[ai][1][m][1][j] * rs; }
                if (pn >= 9) {
                    bf16_t* G = (bf16_t*)(ws + WS_GA + (size_t)((pn - 9) >> 2) * (WS_GB - WS_GA)) + (size_t)row * 1024 + 256 * ((pn - 9) & 3) + 32 * wc + 8 * fq;
                    float a[8], b[8];
#pragma unroll
                    for (int j = 0; j < 8; ++j) { a[j] = 1.0f / (1.0f + __builtin_amdgcn_exp2f(-x1[j] * 1.4426950408889634f)); b[j] = 1.0f / (1.0f + __builtin_amdgcn_exp2f(-x2[j] * 1.4426950408889634f)); }
                    *(u32x4*)G = pack8(a); *(u32x4*)(G + 128) = pack8(b);
                } else if (pn == 8) {
                    if (wc == 0) {
                        float s = 0.f;
#pragma unroll
                        for (int j = 0; j < 8; ++j) s += x1[j] + x2[j];
                        s += __shfl_xor(s, 16); s += __shfl_xor(s, 32);
                        const float mu = s * (1.0f / 64.0f); float q = 0.f;
#pragma unroll
                        for (int j = 0; j < 8; ++j) { x1[j] -= mu; x2[j] -= mu; q += x1[j] * x1[j] + x2[j] * x2[j]; }
                        q += __shfl_xor(q, 16); q += __shfl_xor(q, 32);
                        const float rstd = __builtin_amdgcn_rsqf(q * (1.0f / 64.0f) + 1e-6f);
                        const int pos = row & 4095; const float* cp = cs + pos * 32 + 8 * fq; const float* sp = sn + pos * 32 + 8 * fq;
                        float o1[8], o2[8];
#pragma unroll
                        for (int j = 0; j < 8; ++j) { const float y1 = x1[j] * rstd * ikw[8 * fq + j] + ikb[8 * fq + j], y2 = x2[j] * rstd * ikw[32 + 8 * fq + j] + ikb[32 + 8 * fq + j];
                            const float c = cp[j], sI = sp[j]; o1[j] = y1 * c - y2 * sI; o2[j] = y2 * c + y1 * sI; }
                        bf16_t* dst = (bf16_t*)(ws + WS_IK) + (size_t)row * 64 + 8 * fq;
                        *(u32x4*)dst = pack8(o1); *(u32x4*)(dst + 32) = pack8(o2);
                    } else if (wc == 1 && fq == 0) {
                        float* dst = (float*)(ws + WS_IW) + (size_t)row * 8;
                        *(f32x4*)dst = (f32x4){x1[0], x1[1], x1[2], x1[3]} * 0.04419417382415922f; *(f32x4*)(dst + 4) = (f32x4){x1[4], x1[5], x1[6], x1[7]} * 0.04419417382415922f;
                    }
                } else if (pn >= 6) {
                    bf16_t* Kd = (bf16_t*)(ws + WS_AK + (size_t)(pn - 6) * (WS_BK - WS_AK)); bf16_t* Vd = (bf16_t*)(ws + WS_AV + (size_t)(pn - 6) * (WS_BV - WS_AV));
                    if (wc < 2) {
                        const int pos = row & 4095; const float* cp = cs + pos * 32 + 8 * fq; const float* sp = sn + pos * 32 + 8 * fq;
                        float o1[8], o2[8];
#pragma unroll
                        for (int j = 0; j < 8; ++j) { const float c = cp[j], sI = sp[j]; o1[j] = x1[j] * c - x2[j] * sI; o2[j] = x2[j] * c + x1[j] * sI; }
                        bf16_t* dst = Kd + (size_t)row * 128 + wc * 64 + 8 * fq;
                        *(u32x4*)dst = pack8(o1); *(u32x4*)(dst + 32) = pack8(o2);
                    } else {
                        bf16_t* dst = Vd + (size_t)row * 128 + 32 * (wc - 2) + 8 * fq;
                        *(u32x4*)dst = pack8(x1); *(u32x4*)(dst + 64) = pack8(x2);
                    }
                } else {
                    bf16_t* Q = (bf16_t*)(ws + WS_AQ + (size_t)(pn >> 1) * (WS_IQ - WS_AQ)); const float sc = (pn >= 2 && pn < 4) ? 1.0f : 0.125f * 1.4426950408889634f;
                    const int pos = row & 4095; const float* cp = cs + pos * 32 + 8 * fq; const float* sp = sn + pos * 32 + 8 * fq;
                    float o1[8], o2[8];
#pragma unroll
                    for (int j = 0; j < 8; ++j) { const float c = cp[j], sI = sp[j]; o1[j] = (x1[j] * c - x2[j] * sI) * sc; o2[j] = (x2[j] * c + x1[j] * sI) * sc; }
                    bf16_t* dst = Q + (size_t)row * 512 + (4 * (pn & 1) + wc) * 64 + 8 * fq;
                    *(u32x4*)dst = pack8(o1); *(u32x4*)(dst + 32) = pack8(o2);
                }
            }
    }
};

struct EpiGate {
    static constexpr bool PERM = true, AFTER_DRAIN = false;
    const bf16_t *GA, *GB; float* P; bf16_t* MIX;
    __device__ __forceinline__ void operator()(const f32x4 (&acc)[2][2][4][2], const Unit& u, int wr, int wc, int fr, int fq) const {
        const bool second = u.pn >= 4; const bf16_t* G = second ? GB : GA;
#pragma unroll
        for (int ai = 0; ai < 2; ++ai)
#pragma unroll
            for (int m = 0; m < 4; ++m) {
                const int row = u.pm * BM + ai * HALF + wr * 64 + m * 16 + fr;
#pragma unroll
                for (int bj = 0; bj < 2; ++bj) {
                    const size_t off = (size_t)row * 1024 + 256 * (u.pn & 3) + 128 * bj + 32 * wc + 8 * fq;
                    const u32x4 gw = *(const u32x4*)(G + off);
                    float v[8];
#pragma unroll
                    for (int j = 0; j < 4; ++j) { v[j] = acc[ai][bj][m][0][j]; v[4 + j] = acc[ai][bj][m][1][j]; }
                    v[0] *= __uint_as_float(gw.x << 16); v[1] *= __uint_as_float(gw.x & 0xffff0000u); v[2] *= __uint_as_float(gw.y << 16); v[3] *= __uint_as_float(gw.y & 0xffff0000u);
                    v[4] *= __uint_as_float(gw.z << 16); v[5] *= __uint_as_float(gw.z & 0xffff0000u); v[6] *= __uint_as_float(gw.w << 16); v[7] *= __uint_as_float(gw.w & 0xffff0000u);
                    if (!second) { *(f32x4*)(P + off) = (f32x4){v[0], v[1], v[2], v[3]}; *(f32x4*)(P + off + 4) = (f32x4){v[4], v[5], v[6], v[7]}; }
                    else { const f32x4 p0 = *(const f32x4*)(P + off), p1 = *(const f32x4*)(P + off + 4);
#pragma unroll
                        for (int j = 0; j < 4; ++j) { v[j] += p0[j]; v[4 + j] += p1[j]; }
                        *(u32x4*)(MIX + off) = pack8(v); }
                }
            }
    }
};

template <bool WITH_XG> struct EpiResid {
    static constexpr bool PERM = false, AFTER_DRAIN = false;
    const float* base; float* out; bf16_t* XG; const float* gw; float* ss;
    __device__ __forceinline__ void operator()(const f32x4 (&acc)[2][2][4][2], const Unit& u, int wr, int wc, int fr, int fq) const {
#pragma unroll
        for (int ai = 0; ai < 2; ++ai)
#pragma unroll
            for (int m = 0; m < 4; ++m) {
                const int row = u.pm * BM + ai * HALF + wr * 64 + m * 16 + fr; float s = 0.f;
#pragma unroll
                for (int bj = 0; bj < 2; ++bj)
#pragma unroll
                    for (int n = 0; n < 2; ++n) {
                        const int col = u.pn * BM + bj * HALF + wc * 32 + n * 16 + 4 * fq; const size_t off = (size_t)row * 1024 + col;
                        const f32x4 v = *(const f32x4*)(base + off) + acc[ai][bj][m][n];
                        *(f32x4*)(out + off) = v; s += (v[0] * v[0] + v[1] * v[1]) + (v[2] * v[2] + v[3] * v[3]);
                        if (WITH_XG) { const f32x4 g = *(const f32x4*)(gw + col); unsigned long long w = (unsigned long long)cvt_pk_bf16(v[0] * g[0], v[1] * g[1]) | ((unsigned long long)cvt_pk_bf16(v[2] * g[2], v[3] * g[3]) << 32);
                            *(unsigned long long*)(XG + off) = w; }
                    }
                s += __shfl_xor(s, 16); s += __shfl_xor(s, 32);
                if (fq == 0) atomicAdd(ss + row, s);
            }
    }
};

struct EpiUp {
    static constexpr bool PERM = true, AFTER_DRAIN = false;
    const float* ss; bf16_t* HID;
    __device__ __forceinline__ void operator()(const f32x4 (&acc)[2][2][4][2], const Unit& u, int wr, int wc, int fr, int fq) const {
#pragma unroll
        for (int ai = 0; ai < 2; ++ai)
#pragma unroll
            for (int m = 0; m < 4; ++m) {
                const int row = u.pm * BM + ai * HALF + wr * 64 + m * 16 + fr;
                const float rs = __builtin_amdgcn_rsqf(ss[row] * (1.0f / 1024.0f) + 1e-6f);
#pragma unroll
                for (int bj = 0; bj < 2; ++bj) {
                    float v[8];
#pragma unroll
                    for (int j = 0; j < 4; ++j) { float a = fmaxf(acc[ai][bj][m][0][j] * rs, 0.f), b = fmaxf(acc[ai][bj][m][1][j] * rs, 0.f); v[j] = a * a; v[4 + j] = b * b; }
                    *(u32x4*)(HID + (size_t)row * 4096 + u.pn * BM + bj * HALF + wc * 32 + 8 * fq) = pack8(v);
                }
            }
    }
};

struct BranchOrder {
    int G, c;
    __device__ __forceinline__ bool next(int i, Unit& u) const {
        const int tile = (i >> 1) * G + c; if (tile >= 128 * 4) return false;
        u.pm = tile >> 2; u.pn = (tile & 3) + 4 * (i & 1); return true;
    }
    __device__ __forceinline__ void a_ready(const Unit&) const {}
    __device__ __forceinline__ void done(const Unit&) const {}
};

template <class Epi, class Sched, bool ALIGN_EPI = false, bool SP2 = false>
__device__ __forceinline__ void gemm_phase(PG8_LAS unsigned char* lds, const Gemm g, const Sched& S, const Epi& E) {
    const int tid = threadIdx.x, wid = __builtin_amdgcn_readfirstlane(tid >> 6), lane = tid & 63, wr = wid >> 2, wc = wid & 3, fr = lane & 15, fq = lane >> 4;
    const int K = g.K, nt = K / BK;
    unsigned voffA[2], voffB[2];
#pragma unroll
    for (int i = 0; i < 2; ++i) { int R, C; stage_rc(tid * 16 + i * 8192, R, C); const int Rb = Epi::PERM ? ((R & ~31) + perm32(R & 31)) : R;
        voffA[i] = (unsigned)(R * K + C) * 2u; voffB[i] = (unsigned)(Rb * K + C) * 2u; }
    const size_t kstep = (size_t)(BK * 2);
    const size_t hstep = (size_t)HALF * K * 2;
    const size_t tstep = 2 * hstep;
    const unsigned ldsw = (unsigned)wid * 1024u;
    const int aoff = lds_byte(wr * 64 + fr, fq * 8), boff = lds_byte(wc * 32 + fr, fq * 8);
#define PG8_SA(b, h) (((b) * 2 + (h)) * HTB)
#define PG8_SB(b, h) ((4 + (b) * 2 + (h)) * HTB)
#define PG8_STAGE(bufoff, gbase, voff) do { _Pragma("unroll") for (int _i = 0; _i < 2; ++_i) \
        __builtin_amdgcn_global_load_lds((const unsigned*)((const char*)(gbase) + (voff)[_i]), (PG8_LAS unsigned*)(lds + (bufoff) + ldsw + _i * 8192), 16, 0, 0); } while (0)
#define PG8_LDA(dst, b, h) do { _Pragma("unroll") for (int m = 0; m < 4; ++m) _Pragma("unroll") for (int k = 0; k < 2; ++k) dst[m][k] = *(const PG8_LAS bf16x8*)(lds + PG8_SA(b, h) + aoff + m * 2048 + k * 1024); } while (0)
#define PG8_LDB(dst, b, h) do { _Pragma("unroll") for (int n = 0; n < 2; ++n) _Pragma("unroll") for (int k = 0; k < 2; ++k) dst[n][k] = *(const PG8_LAS bf16x8*)(lds + PG8_SB(b, h) + boff + n * 2048 + k * 1024); } while (0)
#define PG8_MMA(ai, bj, At, Bt) do { __builtin_amdgcn_s_setprio(1); _Pragma("unroll") for (int m = 0; m < 4; ++m) _Pragma("unroll") for (int n = 0; n < 2; ++n) _Pragma("unroll") for (int k = 0; k < 2; ++k) \
        acc[ai][bj][m][n] = __builtin_amdgcn_mfma_f32_16x16x32_bf16(Bt[n][k], At[m][k], acc[ai][bj][m][n], 0, 0, 0); __builtin_amdgcn_s_setprio(0); } while (0)
#define PG8_WAIT_V(n) asm volatile("s_waitcnt vmcnt(" #n ")" ::: "memory")
#define PG8_WAIT_L(n) asm volatile("s_waitcnt lgkmcnt(" #n ")" ::: "memory")
#define PG8_BAR __builtin_amdgcn_s_barrier()
#define PG8_SCHED __builtin_amdgcn_sched_barrier(0)
    Unit cur, nxt; int ui = 0;
    if (!S.next(0, cur)) return;
    f32x4 acc[2][2][4][2];
#pragma unroll
    for (int a = 0; a < 2; ++a)
#pragma unroll
        for (int b = 0; b < 2; ++b)
#pragma unroll
            for (int m = 0; m < 4; ++m)
#pragma unroll
                for (int n = 0; n < 2; ++n) acc[a][b][m][n] = (f32x4){0.f, 0.f, 0.f, 0.f};
    bf16x8 At[4][2], B0[2][2], B1[2][2];
    const char* cA = g.abase(cur) + (size_t)cur.pm * tstep; const char* cB = (const char*)g.Bt + (size_t)cur.pn * tstep;
    S.a_ready(cur);
    if constexpr (SP2) {
        PG8_STAGE(PG8_SB(0, 0), cB, voffB); PG8_STAGE(PG8_SB(0, 1), cB + hstep, voffB); PG8_STAGE(PG8_SA(0, 0), cA, voffA); PG8_STAGE(PG8_SA(0, 1), cA + hstep, voffA);
        if (wr == 1) PG8_BAR;
        PG8_WAIT_V(2); PG8_BAR;
        PG8_STAGE(PG8_SB(1, 0), cB + kstep, voffB); PG8_STAGE(PG8_SA(1, 0), cA + kstep, voffA); PG8_STAGE(PG8_SB(1, 1), cB + hstep + kstep, voffB);
        PG8_WAIT_V(6); PG8_BAR;
    } else {
        PG8_STAGE(PG8_SB(0, 0), cB, voffB); PG8_STAGE(PG8_SA(0, 0), cA, voffA); PG8_STAGE(PG8_SB(0, 1), cB + hstep, voffB); PG8_STAGE(PG8_SA(0, 1), cA + hstep, voffA);
        if (wr == 1) PG8_BAR;
        PG8_WAIT_V(4); PG8_BAR;
        PG8_STAGE(PG8_SB(1, 0), cB + kstep, voffB); PG8_STAGE(PG8_SA(1, 0), cA + kstep, voffA); PG8_STAGE(PG8_SB(1, 1), cB + hstep + kstep, voffB);
        PG8_WAIT_V(6); PG8_BAR;
    }
    for (;;) {
        const bool has_next = S.next(ui + 1, nxt);
        const char* nA = has_next ? g.abase(nxt) + (size_t)nxt.pm * tstep : cA; const char* nB = has_next ? (const char*)g.Bt + (size_t)nxt.pn * tstep : cB;
        for (int t = 0; t < nt; t += 2) {
            const bool last = (t == nt - 2);
            const char* a1 = cA + (size_t)(t + 1) * kstep;
            const char* a2 = last ? nA : cA + (size_t)(t + 2) * kstep; const char* b2 = last ? nB : cB + (size_t)(t + 2) * kstep;
            const char* a3 = a2 + kstep; const char* b3 = b2 + kstep;
            if (last && has_next) S.a_ready(nxt);
            if constexpr (SP2) {
            PG8_LDB(B0, 0, 0); PG8_LDB(B1, 0, 1); PG8_SCHED; PG8_LDA(At, 0, 0); PG8_STAGE(PG8_SA(1, 1), a1 + hstep, voffA);
            PG8_WAIT_V(8); PG8_WAIT_L(0); PG8_BAR; PG8_MMA(0, 0, At, B0); PG8_MMA(0, 1, At, B1); PG8_BAR; PG8_SCHED;
            PG8_LDA(At, 0, 1); PG8_STAGE(PG8_SB(0, 0), b2, voffB); PG8_STAGE(PG8_SB(0, 1), b2 + hstep, voffB); PG8_STAGE(PG8_SA(0, 0), a2, voffA);
            PG8_WAIT_V(8); PG8_WAIT_L(0); PG8_BAR; PG8_MMA(1, 0, At, B0); PG8_MMA(1, 1, At, B1); PG8_BAR; PG8_SCHED;
            PG8_LDB(B0, 1, 0); PG8_LDB(B1, 1, 1); PG8_SCHED; PG8_LDA(At, 1, 0); PG8_STAGE(PG8_SA(0, 1), a2 + hstep, voffA);
            PG8_WAIT_V(8); PG8_WAIT_L(0); PG8_BAR; PG8_MMA(0, 0, At, B0); PG8_MMA(0, 1, At, B1); PG8_BAR; PG8_SCHED;
            PG8_LDA(At, 1, 1); PG8_STAGE(PG8_SB(1, 0), b3, voffB); PG8_STAGE(PG8_SB(1, 1), b3 + hstep, voffB); PG8_STAGE(PG8_SA(1, 0), a3, voffA);
            PG8_WAIT_V(8); PG8_WAIT_L(0); PG8_BAR; PG8_MMA(1, 0, At, B0); PG8_MMA(1, 1, At, B1); PG8_BAR; PG8_SCHED;
            } else {
            PG8_LDB(B0, 0, 0); PG8_SCHED; PG8_LDA(At, 0, 0); PG8_STAGE(PG8_SA(1, 1), a1 + hstep, voffA);
            PG8_WAIT_L(8); PG8_BAR; PG8_WAIT_L(0); PG8_MMA(0, 0, At, B0); PG8_BAR; PG8_SCHED;
            PG8_LDB(B1, 0, 1); PG8_STAGE(PG8_SB(0, 0), b2, voffB);
            PG8_BAR; PG8_WAIT_L(0); PG8_MMA(0, 1, At, B1); PG8_BAR;
            PG8_LDA(At, 0, 1); PG8_STAGE(PG8_SA(0, 0), a2, voffA);
            PG8_BAR; PG8_WAIT_L(0); PG8_MMA(1, 0, At, B0); PG8_BAR; PG8_SCHED;
            PG8_STAGE(PG8_SB(0, 1), b2 + hstep, voffB);
            PG8_WAIT_V(6); PG8_BAR; PG8_MMA(1, 1, At, B1); PG8_BAR;
            PG8_LDB(B0, 1, 0); PG8_SCHED; PG8_LDA(At, 1, 0); PG8_STAGE(PG8_SA(0, 1), a2 + hstep, voffA);
            PG8_WAIT_L(8); PG8_BAR; PG8_WAIT_L(0); PG8_MMA(0, 0, At, B0); PG8_BAR; PG8_SCHED;
            PG8_LDB(B1, 1, 1); PG8_STAGE(PG8_SB(1, 0), b3, voffB);
            PG8_BAR; PG8_WAIT_L(0); PG8_MMA(0, 1, At, B1); PG8_BAR;
            PG8_LDA(At, 1, 1); PG8_STAGE(PG8_SA(1, 0), a3, voffA);
            PG8_BAR; PG8_WAIT_L(0); PG8_MMA(1, 0, At, B0); PG8_BAR; PG8_SCHED;
            PG8_STAGE(PG8_SB(1, 1), b3 + hstep, voffB);
            PG8_WAIT_V(6); PG8_BAR; PG8_MMA(1, 1, At, B1); PG8_BAR;
            }
        }
        if constexpr (ALIGN_EPI) { if (wr == 0) PG8_BAR; }
        if constexpr (!Epi::AFTER_DRAIN) { E(acc, cur, wr, wc, fr, fq); S.done(cur); }
        if (!has_next) break;
#pragma unroll
        for (int a = 0; a < 2; ++a)
#pragma unroll
            for (int b = 0; b < 2; ++b)
#pragma unroll
                for (int m = 0; m < 4; ++m)
#pragma unroll
                    for (int n = 0; n < 2; ++n) acc[a][b][m][n] = (f32x4){0.f, 0.f, 0.f, 0.f};
        cur = nxt; cA = nA; cB = nB; ++ui;
        if constexpr (ALIGN_EPI) { if (wr == 1) PG8_BAR; }
    }
    PG8_WAIT_V(0);
    if constexpr (!ALIGN_EPI) { if (wr == 0) PG8_BAR; }
    PG8_BAR;
    if constexpr (Epi::AFTER_DRAIN) { E.fused(acc, cur, wr, wc, fr, fq, lds, wid, lane); S.done(cur); }
#undef PG8_SA
#undef PG8_SB
#undef PG8_STAGE
#undef PG8_LDA
#undef PG8_LDB
#undef PG8_MMA
#undef PG8_WAIT_V
#undef PG8_WAIT_L
#undef PG8_BAR
#undef PG8_SCHED
}
}
struct Params {
    const float *x, *attn_norm_w, *w_in, *ikw, *ikb, *sinks, *w_a, *w_b, *w_out, *mlp_norm_w, *w_up, *w_down, *final_w;
    float* out; unsigned char* ws;
    float inv_freq[32];
    int ph_lo, ph_hi;
};
constexpr int NWAVES = 8, NTHREADS = 512;

__device__ __forceinline__ int win_src_group(int grp, int& cnt) {
    const int tile = grp >> 3, g = grp & 7; cnt = 32;
    if (tile < 6) { const int base = tile < 2 ? C_AQ : (tile < 4 ? C_IQ : C_BQ); const int head = 4 * (tile & 1) + (g & 3); return base + head * 64 + 32 * (g >> 2); }
    if (tile < 8) { const int kb = tile == 6 ? C_AK : C_BK, vb = tile == 6 ? C_AV : C_BV; const int hf = g >> 2, q = g & 3;
        if (q < 2) return kb + q * 64 + 32 * hf; return vb + 64 * hf + 32 * (q - 2); }
    if (tile == 8) { if (g == 0) return C_IK; if (g == 4) return C_IK + 32; if (g == 1) { cnt = 8; return C_IW; } cnt = 0; return 0; }
    return C_GA + (grp - 72) * 32;
}
__device__ __forceinline__ void p0_transpose_item(const float* W, int ldw, int c0, int cnt, int K, bf16* WT, int n0, int k0, LAS float* scr, int lane) {
#pragma unroll 8
    for (int i = 0; i < 32; ++i) { const int kk = 2 * i + (lane >> 5), n = lane & 31; scr[kk * 33 + n] = (n < cnt) ? W[(size_t)(k0 + kk) * ldw + c0 + n] : 0.f; }
    asm volatile("s_waitcnt lgkmcnt(0)" ::: "memory");
    const int c = lane & 7;
#pragma unroll
    for (int j = 0; j < 4; ++j) { const int n = (lane >> 3) + 8 * j; const LAS float* s = scr + (8 * c) * 33 + n;
        v4u o; o.x = pk2(s[0 * 33], s[1 * 33]); o.y = pk2(s[2 * 33], s[3 * 33]); o.z = pk2(s[4 * 33], s[5 * 33]); o.w = pk2(s[6 * 33], s[7 * 33]);
        *(v4u*)(WT + (size_t)(n0 + n) * K + k0 + 8 * c) = o; }
    asm volatile("s_waitcnt lgkmcnt(0)" ::: "memory");
}
__device__ __forceinline__ void sincos_d(float angf, float& sn, float& cs) {
    const double a = (double)angf; const double kq = __builtin_rint(a * 0.63661977236758134308);
    const double y = (a - kq * 1.57079632679489655800) - kq * 6.123233995736766e-17; const double y2 = y * y;
    double s = y * (1.0 + y2 * (-1.0 / 6 + y2 * (1.0 / 120 + y2 * (-1.0 / 5040 + y2 * (1.0 / 362880 + y2 * (-1.0 / 39916800 + y2 * (1.0 / 6227020800.0)))))));
    double c = 1.0 + y2 * (-0.5 + y2 * (1.0 / 24 + y2 * (-1.0 / 720 + y2 * (1.0 / 40320 + y2 * (-1.0 / 3628800 + y2 * (1.0 / 479001600.0 + y2 * (-1.0 / 87178291200.0)))))));
    const int q = ((int)kq) & 3;
    const double ss = (q == 0) ? s : (q == 1) ? c : (q == 2) ? -s : -c; const double cc = (q == 0) ? c : (q == 1) ? -s : (q == 2) ? -c : s;
    sn = (float)ss; cs = (float)cc;
}
__device__ __forceinline__ void phase_prologue(const Params& p, LAS unsigned char* lds, int G) {
    const int lane = threadIdx.x & 63, wave = __builtin_amdgcn_readfirstlane(threadIdx.x >> 6);
    unsigned char* ws = p.ws;
    LAS float* scr = (LAS float*)(lds + wave * 16384);
    const int gw = blockIdx.x * NWAVES + wave, NGW = G * NWAVES;
    constexpr int I_IN = (DM / 64) * (NIN / 32), I_A = (512 / 64) * (DM / 32), I_O = (DM / 64) * (DM / 32), I_U = (DM / 64) * (DFF / 32), I_D = (DFF / 64) * (DM / 32);
    constexpr int NITEMS = I_IN + 2 * I_A + I_O + I_U + I_D;
    for (int it = gw; it < NITEMS; it += NGW) {
        int r = it;
        if (r < I_IN) { const int grp = r % (NIN / 32), kb = r / (NIN / 32); int cnt; const int c0 = win_src_group(grp, cnt);
            p0_transpose_item(p.w_in, D_IN, c0, cnt, DM, (bf16*)(ws + WS_WIN), grp * 32, kb * 64, scr, lane); continue; } r -= I_IN;
        if (r < I_A) { const int nb = r % 32, kb = r / 32; p0_transpose_item(p.w_a, DM, nb * 32, 32, 512, (bf16*)(ws + WS_WAB), nb * 32, kb * 64, scr, lane); continue; } r -= I_A;
        if (r < I_A) { const int nb = r % 32, kb = r / 32; p0_transpose_item(p.w_b, DM, nb * 32, 32, 512, (bf16*)(ws + WS_WAB), 1024 + nb * 32, kb * 64, scr, lane); continue; } r -= I_A;
        if (r < I_O) { const int nb = r % 32, kb = r / 32; p0_transpose_item(p.w_out, DM, nb * 32, 32, DM, (bf16*)(ws + WS_WOUT), nb * 32, kb * 64, scr, lane); continue; } r -= I_O;
        if (r < I_U) { const int nb = r % 128, kb = r / 128; p0_transpose_item(p.w_up, DFF, nb * 32, 32, DM, (bf16*)(ws + WS_WUP), nb * 32, kb * 64, scr, lane); continue; } r -= I_U;
        { const int nb = r % 32, kb = r / 32; p0_transpose_item(p.w_down, DM, nb * 32, 32, DFF, (bf16*)(ws + WS_WDN), nb * 32, kb * 64, scr, lane); }
    }
    float* COS = (float*)(ws + WS_COS); float* SIN = (float*)(ws + WS_SIN);
    for (int i = gw * 64 + lane; i < SEQ * 32; i += NGW * 64) { const int pos = i >> 5, d = i & 31; const float ang = (float)pos * p.inv_freq[d]; float s, c; sincos_d(ang, s, c); COS[i] = c; SIN[i] = s; }
    float* RSTD1 = (float*)(ws + WS_RSTD1); float* SS2 = (float*)(ws + WS_SS2); float* SS3 = (float*)(ws + WS_SS3); bf16* XG = (bf16*)(ws + WS_XG);
    v4f g[4];
#pragma unroll
    for (int j = 0; j < 4; ++j) g[j] = *((const v4f*)p.attn_norm_w + lane + 64 * j);
    for (int m = gw; m < TOK; m += NGW) {
        const v4f* xr = (const v4f*)(p.x + (size_t)m * DM) + lane; v4f v[4]; float s = 0.f;
#pragma unroll
        for (int j = 0; j < 4; ++j) { v[j] = xr[64 * j]; s += (v[j].x * v[j].x + v[j].y * v[j].y) + (v[j].z * v[j].z + v[j].w * v[j].w); }
        s = wave_sum(s);
        unsigned long long* o8 = (unsigned long long*)(XG + (size_t)m * DM) + lane;
#pragma unroll
        for (int j = 0; j < 4; ++j) o8[64 * j] = (unsigned long long)pk2(v[j].x * g[j].x, v[j].y * g[j].y) | ((unsigned long long)pk2(v[j].z * g[j].z, v[j].w * g[j].w) << 32);
        if (lane == 0) { RSTD1[m] = frsq(s * (1.0f / DM) + RMS_EPS); SS2[m] = 0.f; SS3[m] = 0.f; }
    }
}

__device__ __forceinline__ unsigned f2key(float f) { const unsigned u = __float_as_uint(f); return (u & 0x80000000u) ? ~u : (u | 0x80000000u); }
__device__ __forceinline__ void phase_topk_simple(const Params& p, LAS unsigned char* lds, int G) {
    const int lane = threadIdx.x & 63, wave = __builtin_amdgcn_readfirstlane(threadIdx.x >> 6);
    unsigned char* ws = p.ws;
    const bf16* IQ = (const bf16*)(ws + WS_IQ); const bf16* IK = (const bf16*)(ws + WS_IK); const float* IW = (const float*)(ws + WS_IW);
    unsigned short* SEL = (unsigned short*)(ws + WS_SEL);
    LAS unsigned* keys = (LAS unsigned*)(lds + wave * 16384);
    LAS float* qf = (LAS float*)(lds + LDS_RING + wave * 2048);
    const int gw = blockIdx.x * NWAVES + wave, NGW = G * NWAVES;
    for (int row = gw; row < TOK; row += NGW) {
        const int b = row >> 12, t = row & 4095, n = t + 1;
        unsigned short* selrow = SEL + (size_t)row * TOPK;
        if (n <= TOPK) { for (int i = lane; i < n; i += 64) selrow[i] = (unsigned short)i; continue; }
        { const v4u q8 = *((const v4u*)(IQ + (size_t)row * 512) + lane);
            LAS float* d = qf + 8 * lane;
            d[0] = bflo(q8.x); d[1] = bfhi(q8.x); d[2] = bflo(q8.y); d[3] = bfhi(q8.y); d[4] = bflo(q8.z); d[5] = bfhi(q8.z); d[6] = bflo(q8.w); d[7] = bfhi(q8.w); }
        float w[8];
#pragma unroll
        for (int h = 0; h < 8; ++h) w[h] = IW[(size_t)row * 8 + h];
        asm volatile("s_waitcnt lgkmcnt(0)" ::: "memory");
        for (int s0 = 0; s0 < n; s0 += 64) {
            const int s = s0 + lane; const int sc = s < n ? s : t;
            const v4u* kp = (const v4u*)(IK + ((size_t)b * SEQ + sc) * 64);
            float dot[8];
#pragma unroll
            for (int h = 0; h < 8; ++h) dot[h] = 0.f;
#pragma unroll
            for (int c = 0; c < 8; ++c) {
                const v4u k8 = kp[c]; float kf[8] = {bflo(k8.x), bfhi(k8.x), bflo(k8.y), bfhi(k8.y), bflo(k8.z), bfhi(k8.z), bflo(k8.w), bfhi(k8.w)};
#pragma unroll
                for (int h = 0; h < 8; ++h) { const v4f qa = *(const LAS v4f*)(qf + h * 64 + c * 8), qb = *(const LAS v4f*)(qf + h * 64 + c * 8 + 4);
                    dot[h] += (kf[0] * qa.x + kf[1] * qa.y) + (kf[2] * qa.z + kf[3] * qa.w) + (kf[4] * qb.x + kf[5] * qb.y) + (kf[6] * qb.z + kf[7] * qb.w); }
            }
            float sc_ = 0.f;
#pragma unroll
            for (int h = 0; h < 8; ++h) sc_ += w[h] * fmaxf(dot[h], 0.f);
            keys[s] = (s < n) ? f2key(sc_) : 0u;
        }
        asm volatile("s_waitcnt lgkmcnt(0)" ::: "memory");
        const int nch = (n + 63) >> 6;
        unsigned thr = 0u;
        for (int bit = 31; bit >= 0; --bit) {
            const unsigned cand = thr | (1u << bit); int cnt = 0;
            for (int c = 0; c < nch; ++c) cnt += __popcll(__ballot(keys[c * 64 + lane] >= cand));
            if (cnt >= TOPK) thr = cand;
        }
        int cgt = 0;
        for (int c = 0; c < nch; ++c) cgt += __popcll(__ballot(keys[c * 64 + lane] > thr));
        const int need = TOPK - cgt; int pos = 0, ties = 0;
        for (int c = 0; c < nch; ++c) {
            const unsigned k = keys[c * 64 + lane]; const bool gt = k > thr, eq = k == thr;
            const unsigned long long meq = __ballot(eq);
            const bool sel = gt || (eq && (ties + mbcnt64(meq) < need));
            const unsigned long long msel = __ballot(sel);
            if (sel) selrow[pos + mbcnt64(msel)] = (unsigned short)(c * 64 + lane);
            pos += __popcll(msel); ties += __popcll(meq);
        }
    }
}

template <bool SINK, class KeyFn>
__device__ __forceinline__ void attend_wave(const bf16* Q, const bf16* K, const bf16* V, bf16* O, int row, int g, int nslots, const KeyFn& keyfn, const float* sinkv,
                                            LAS float* qf  , LAS float* pf  , LAS int* kidx  , int lane) {
    const int b = row >> 12;
    { const v2u q4 = *((const v2u*)(Q + (size_t)row * 512 + g * 256) + lane);
        LAS float* d = qf + 4 * lane; d[0] = bflo(q4.x); d[1] = bfhi(q4.x); d[2] = bflo(q4.y); d[3] = bfhi(q4.y); }
    asm volatile("s_waitcnt lgkmcnt(0)" ::: "memory");
#pragma unroll 1
    for (int j = 0; j < 4; ++j) {
        const int slot = 64 * j + lane; int key = slot < nslots ? keyfn(slot) : -1; kidx[slot] = key;
        const bool valid = key >= 0; const int kc = valid ? key : 0;
        const v4u* kp = (const v4u*)(K + ((size_t)b * SEQ + kc) * 128 + g * 64);
        float dot[4] = {0.f, 0.f, 0.f, 0.f};
        if (64 * j < nslots) {
#pragma unroll
            for (int c = 0; c < 8; ++c) {
                const v4u k8 = kp[c]; float kf[8] = {bflo(k8.x), bfhi(k8.x), bflo(k8.y), bfhi(k8.y), bflo(k8.z), bfhi(k8.z), bflo(k8.w), bfhi(k8.w)};
#pragma unroll
                for (int h = 0; h < 4; ++h) { const v4f qa = *(const LAS v4f*)(qf + h * 64 + c * 8), qb = *(const LAS v4f*)(qf + h * 64 + c * 8 + 4);
                    dot[h] += (kf[0] * qa.x + kf[1] * qa.y) + (kf[2] * qa.z + kf[3] * qa.w) + (kf[4] * qb.x + kf[5] * qb.y) + (kf[6] * qb.z + kf[7] * qb.w); }
            }
        }
        *(LAS v4f*)(pf + slot * 4) = valid ? (v4f){dot[0], dot[1], dot[2], dot[3]} : (v4f){-INFINITY, -INFINITY, -INFINITY, -INFINITY};
    }
    asm volatile("s_waitcnt lgkmcnt(0)" ::: "memory");
    float lg[4][4];
#pragma unroll
    for (int j = 0; j < 4; ++j) { const v4f t4 = *(const LAS v4f*)(pf + (64 * j + lane) * 4); lg[j][0] = t4.x; lg[j][1] = t4.y; lg[j][2] = t4.z; lg[j][3] = t4.w; }
    float inv[4];
#pragma unroll
    for (int h = 0; h < 4; ++h) {
        float mx = fmaxf(fmaxf(lg[0][h], lg[1][h]), fmaxf(lg[2][h], lg[3][h])); mx = wave_max(mx);
        float sk = 0.f; if (SINK) { sk = sinkv[g * 4 + h] * LOG2E; mx = fmaxf(mx, sk); }
        float s = 0.f;
#pragma unroll
        for (int j = 0; j < 4; ++j) { const float e = fexp2(lg[j][h] - mx); lg[j][h] = e; s += e; }
        s = wave_sum(s); if (SINK) s += fexp2(sk - mx);
        inv[h] = 1.0f / s;
    }
#pragma unroll
    for (int j = 0; j < 4; ++j) *(LAS v4f*)(pf + (64 * j + lane) * 4) = (v4f){lg[j][0], lg[j][1], lg[j][2], lg[j][3]};
    asm volatile("s_waitcnt lgkmcnt(0)" ::: "memory");
    float o[4] = {0.f, 0.f, 0.f, 0.f};
    const bf16* Vb = V + (size_t)b * SEQ * 128 + g * 64 + lane;
#pragma unroll 1
    for (int s0 = 0; s0 < nslots; s0 += 8) {
        float vv[8]; v4f pp[8];
#pragma unroll
        for (int i = 0; i < 8; ++i) { const int slot = s0 + i; const int key = slot < nslots ? kidx[slot] : -1; pp[i] = *(const LAS v4f*)(pf + (slot & 255) * 4);
            vv[i] = key >= 0 ? bf2f(Vb[(size_t)key * 128]) : 0.f; if (key < 0) pp[i] = (v4f){0.f, 0.f, 0.f, 0.f}; }
#pragma unroll
        for (int i = 0; i < 8; ++i) { o[0] += pp[i].x * vv[i]; o[1] += pp[i].y * vv[i]; o[2] += pp[i].z * vv[i]; o[3] += pp[i].w * vv[i]; }
    }
    bf16* op = O + (size_t)row * 512 + g * 256 + lane;
#pragma unroll
    for (int h = 0; h < 4; ++h) op[h * 64] = (bf16)f2bf(o[h] * inv[h]);
}
struct SelKey { const unsigned short* selrow; __device__ __forceinline__ int operator()(int slot) const { return (int)selrow[slot]; } };
struct WinKey { int t; __device__ __forceinline__ int operator()(int slot) const { return t - (WIN - 1) + slot; } };

__device__ __forceinline__ void phase_attn_simple(const Params& p, LAS unsigned char* lds, int G) {
    const int lane = threadIdx.x & 63, wave = __builtin_amdgcn_readfirstlane(threadIdx.x >> 6);
    unsigned char* ws = p.ws;
    LAS float* qf = (LAS float*)(lds + wave * 16384); LAS float* pf = qf + 256; LAS int* kidx = (LAS int*)(pf + 1024);
    const int gw = blockIdx.x * NWAVES + wave, NGW = G * NWAVES;
    const unsigned short* SEL = (const unsigned short*)(ws + WS_SEL);
    for (int item = gw; item < TOK * 2; item += NGW) {
        const int row = item >> 1, g = item & 1, t = row & 4095;
        { SelKey kf{SEL + (size_t)row * TOPK}; const int ns = (t + 1 < TOPK) ? t + 1 : TOPK;
            attend_wave<false>((const bf16*)(ws + WS_AQ), (const bf16*)(ws + WS_AK), (const bf16*)(ws + WS_AV), (bf16*)(ws + WS_AQ), row, g, ns, kf, nullptr, qf, pf, kidx, lane); }
        { WinKey kf{t};
            attend_wave<true>((const bf16*)(ws + WS_BQ), (const bf16*)(ws + WS_BK), (const bf16*)(ws + WS_BV), (bf16*)(ws + WS_BQ), row, g, WIN, kf, p.sinks, qf, pf, kidx, lane); }
    }
}

__device__ __forceinline__ void phase_final(const Params& p, int G) {
    const int lane = threadIdx.x & 63, wave = __builtin_amdgcn_readfirstlane(threadIdx.x >> 6);
    const float* SS3 = (const float*)(p.ws + WS_SS3);
    const int gw = blockIdx.x * NWAVES + wave, NGW = G * NWAVES;
    v4f g[4];
#pragma unroll
    for (int j = 0; j < 4; ++j) g[j] = *((const v4f*)p.final_w + lane + 64 * j);
    for (int m = gw; m < TOK; m += NGW) {
        const float rs = frsq(SS3[m] * (1.0f / DM) + RMS_EPS);
        v4f* xr = (v4f*)(p.out + (size_t)m * DM) + lane;
#pragma unroll
        for (int j = 0; j < 4; ++j) { v4f v = xr[64 * j]; xr[64 * j] = v * g[j] * rs; }
    }
}

constexpr int NPHASE = 9;
__global__ void __launch_bounds__(NTHREADS, 2) mk_fwd(Params p) {
    extern __shared__ __attribute__((aligned(16))) unsigned char lds_raw[];
    LAS unsigned char* lds = (LAS unsigned char*)lds_raw;
    const int G = gridDim.x;
    unsigned char* ws = p.ws;
#if MK_ONE_LAUNCH
    cg::grid_group grid = cg::this_grid();
#define SEAM(k) do { if (lo <= (k) && (k) + 1 < hi) grid.sync(); } while (0)
#else
#define SEAM(k) do { } while (0)
#endif
    const int lo = p.ph_lo, hi = p.ph_hi;
#ifndef PHMASK
#define PHMASK 0x1ffu
#endif
#define IN(k) (((PHMASK >> (k)) & 1u) && lo <= (k) && (k) < hi)
    if (IN(0)) { phase_prologue(p, lds, G); SEAM(0); }
    if (IN(1)) {
        pg8::Gemm g{(const bf16*)(ws + WS_XG), (const bf16*)(ws + WS_WIN), TOK, NIN, DM, nullptr, 1 << 30};
        pg8::StaticOrder S; S.init(TOK, NIN, G, (int)blockIdx.x);
        pg8::EpiInProj E{(const float*)(ws + WS_RSTD1), (const float*)(ws + WS_COS), (const float*)(ws + WS_SIN), ws, p.ikw, p.ikb};
        pg8::gemm_phase<pg8::EpiInProj, pg8::StaticOrder, true, true>(lds, g, S, E);
        SEAM(1);
    }
    if (IN(2)) { phase_topk_simple(p, lds, G); SEAM(2); }
    if (IN(3)) { phase_attn_simple(p, lds, G); SEAM(3); }
    if (IN(4)) {
        pg8::Gemm g{(const bf16*)(ws + WS_AQ), (const bf16*)(ws + WS_WAB), TOK, 2048, 512, (const bf16*)(ws + WS_BQ), 4};
        pg8::BranchOrder S{G, (int)blockIdx.x};
        pg8::EpiGate E{(const bf16*)(ws + WS_GA), (const bf16*)(ws + WS_GB), p.out, (bf16*)(ws + WS_MIX)};
        pg8::gemm_phase<pg8::EpiGate, pg8::BranchOrder, true, true>(lds, g, S, E);
        SEAM(4);
    }
    if (IN(5)) {
        pg8::Gemm g{(const bf16*)(ws + WS_MIX), (const bf16*)(ws + WS_WOUT), TOK, DM, DM, nullptr, 1 << 30};
        pg8::StaticOrder S; S.init(TOK, DM, G, (int)blockIdx.x);
        pg8::EpiResid<true> E{p.x, p.out, (bf16*)(ws + WS_XG), p.mlp_norm_w, (float*)(ws + WS_SS2)};
        pg8::gemm_phase<pg8::EpiResid<true>, pg8::StaticOrder, true, true>(lds, g, S, E);
        SEAM(5);
    }
    if (IN(6)) {
        pg8::Gemm g{(const bf16*)(ws + WS_XG), (const bf16*)(ws + WS_WUP), TOK, DFF, DM, nullptr, 1 << 30};
        pg8::StaticOrder S; S.init(TOK, DFF, G, (int)blockIdx.x);
        pg8::EpiUp E{(const float*)(ws + WS_SS2), (bf16*)(ws + WS_HID)};
        pg8::gemm_phase<pg8::EpiUp, pg8::StaticOrder, true, true>(lds, g, S, E);
        SEAM(6);
    }
    if (IN(7)) {
        pg8::Gemm g{(const bf16*)(ws + WS_HID), (const bf16*)(ws + WS_WDN), TOK, DM, DFF, nullptr, 1 << 30};
        pg8::StaticOrder S; S.init(TOK, DM, G, (int)blockIdx.x);
        pg8::EpiResid<false> E{p.out, p.out, nullptr, nullptr, (float*)(ws + WS_SS3)};
        pg8::gemm_phase<pg8::EpiResid<false>, pg8::StaticOrder, true, true>(lds, g, S, E);
        SEAM(7);
    }
    if (IN(8)) { phase_final(p, G); }
#undef IN
#undef SEAM
}

extern "C" void kernel_launch(void* const* d_in, const int* in_sizes, int n_in, void* d_out, int out_size, void* d_ws, size_t ws_size, hipStream_t stream) {
    static int grid = 0;
    if (grid == 0) {
        if (n_in != 13 || in_sizes[0] != TOK * DM || out_size != TOK * DM || ws_size < WS_END) {
            fprintf(stderr, "kernel_launch: unexpected shapes (n_in %d, in0 %d, out %d, ws %zu); nothing launched\n", n_in, n_in > 0 ? in_sizes[0] : -1, out_size, ws_size); grid = -1; return; }
        int dev = 0, cus = 0, per_cu = 0;
        (void)hipGetDevice(&dev); (void)hipDeviceGetAttribute(&cus, hipDeviceAttributeMultiprocessorCount, dev);
        if (hipFuncSetAttribute((const void*)mk_fwd, hipFuncAttributeMaxDynamicSharedMemorySize, LDS_BYTES) != hipSuccess) { fprintf(stderr, "kernel_launch: hipFuncSetAttribute failed\n"); grid = -1; return; }
        if (hipOccupancyMaxActiveBlocksPerMultiprocessor(&per_cu, (const void*)mk_fwd, NTHREADS, LDS_BYTES) != hipSuccess || per_cu < 1) { fprintf(stderr, "kernel_launch: occupancy query says %d blocks per CU\n", per_cu); per_cu = 1; }
        (void)hipGetLastError();
        if (per_cu > 1) per_cu = 1;
        grid = cus * per_cu;
    }
    if (grid < 0) return;
    Params p{};
    p.x = (const float*)d_in[0]; p.attn_norm_w = (const float*)d_in[1]; p.w_in = (const float*)d_in[2]; p.ikw = (const float*)d_in[3]; p.ikb = (const float*)d_in[4];
    p.sinks = (const float*)d_in[5]; p.w_a = (const float*)d_in[6]; p.w_b = (const float*)d_in[7]; p.w_out = (const float*)d_in[8]; p.mlp_norm_w = (const float*)d_in[9];
    p.w_up = (const float*)d_in[10]; p.w_down = (const float*)d_in[11]; p.final_w = (const float*)d_in[12];
    p.out = (float*)d_out; p.ws = (unsigned char*)d_ws;
    for (int i = 0; i < 32; ++i) p.inv_freq[i] = 1.0f / powf(10000.0f, (float)(2 * i) / 64.0f);
#if MK_ONE_LAUNCH
    p.ph_lo = 0; p.ph_hi = NPHASE;
    void* args[] = {&p};
    hipError_t e = hipLaunchCooperativeKernel((const void*)mk_fwd, dim3(grid), dim3(NTHREADS), args, LDS_BYTES, stream);
    if (e != hipSuccess) fprintf(stderr, "kernel_launch: cooperative launch failed: %s (grid %d)\n", hipGetErrorString(e), grid);
#else
    for (int ph = 0; ph < NPHASE; ++ph) {
        p.ph_lo = ph; p.ph_hi = ph + 1;
        hipLaunchKernelGGL(mk_fwd, dim3(grid), dim3(NTHREADS), LDS_BYTES, stream, p);
    }
#endif
}
```

```cpp
#include <hip/hip_runtime.h>
#include <hip/hip_cooperative_groups.h>
#include <cstdio>
#include <cstdint>
namespace cg = cooperative_groups;

#ifndef MK_ONE_LAUNCH
#define MK_ONE_LAUNCH 1
#endif

constexpr int NBATCH = 8, SEQ = 4096, DM = 1024, TOK = NBATCH * SEQ, DFF = 4096, TOPK = 256, WIN = 128;
constexpr int NIN = 4352;
constexpr float RMS_EPS = 1e-6f, LN_EPS = 1e-6f;
constexpr float QSCALE = 0.125f * 1.4426950408889634f;
constexpr float LOG2E = 1.4426950408889634f;
constexpr float W_SCALE = 0.04419417382415922f;
constexpr int C_AQ = 0, C_AK = 512, C_AV = 640, C_IQ = 768, C_IK = 1280, C_IW = 1344, C_BQ = 1352, C_BK = 1864, C_BV = 1992, C_GA = 2120, C_GB = 3144, D_IN = 4168;

constexpr size_t MiB = 1u << 20;
constexpr size_t WS_RSTD1 = 0, WS_SS2 = 128 * 1024, WS_SS3 = 256 * 1024;
constexpr size_t WS_COS = 1 * MiB, WS_SIN = 1 * MiB + 512 * 1024;
constexpr size_t WS_WIN = 2 * MiB, WS_WAB = 11 * MiB, WS_WOUT = 13 * MiB, WS_WUP = 15 * MiB, WS_WDN = 23 * MiB;
constexpr size_t WS_XG = 32 * MiB;
constexpr size_t WS_AQ = 96 * MiB, WS_IQ = 128 * MiB, WS_BQ = 160 * MiB, WS_AK = 192 * MiB, WS_AV = 200 * MiB, WS_BK = 208 * MiB, WS_BV = 216 * MiB;
constexpr size_t WS_IK = 224 * MiB, WS_IW = 228 * MiB, WS_SEL = 230 * MiB, WS_GA = 248 * MiB, WS_GB = 312 * MiB, WS_MIX = 376 * MiB, WS_END = 440 * MiB;
constexpr size_t WS_HID = 96 * MiB;
static_assert(WS_WIN + (size_t)NIN * DM * 2 <= WS_WAB && WS_HID + (size_t)TOK * DFF * 2 <= WS_MIX, "ws map");

constexpr int LDS_RING = 131072, LDS_BYTES = 147456;

#define GAS __attribute__((address_space(1)))
#define LAS __attribute__((address_space(3)))
typedef unsigned short bf16;
typedef unsigned v4u __attribute__((ext_vector_type(4)));
typedef unsigned v2u __attribute__((ext_vector_type(2)));
typedef float v4f __attribute__((ext_vector_type(4)));

__device__ __forceinline__ float bf2f(unsigned short u) { return __uint_as_float((unsigned)u << 16); }
__device__ __forceinline__ float bflo(unsigned u) { return __uint_as_float(u << 16); }
__device__ __forceinline__ float bfhi(unsigned u) { return __uint_as_float(u & 0xffff0000u); }
__device__ __forceinline__ unsigned f2bf(float f) { unsigned u = __float_as_uint(f); return (u + 0x7fffu + ((u >> 16) & 1u)) >> 16; }
__device__ __forceinline__ unsigned pk2(float lo, float hi) { unsigned r; asm volatile("v_cvt_pk_bf16_f32 %0, %1, %2" : "=v"(r) : "v"(lo), "v"(hi)); return r; }
__device__ __forceinline__ float fexp2(float x) { return __builtin_amdgcn_exp2f(x); }
__device__ __forceinline__ float frsq(float x) { return __builtin_amdgcn_rsqf(x); }
__device__ __forceinline__ float frcp(float x) { return __builtin_amdgcn_rcpf(x); }
__device__ __forceinline__ float sigmoidf_(float x) { return frcp(1.0f + fexp2(-x * LOG2E)); }
__device__ __forceinline__ float wave_sum(float v) {
#pragma unroll
    for (int o = 1; o < 64; o <<= 1) v += __shfl_xor(v, o);
    return v;
}
__device__ __forceinline__ float wave_max(float v) {
#pragma unroll
    for (int o = 1; o < 64; o <<= 1) v = fmaxf(v, __shfl_xor(v, o));
    return v;
}
__device__ __forceinline__ int mbcnt64(unsigned long long m) { return __builtin_amdgcn_mbcnt_hi((unsigned)(m >> 32), __builtin_amdgcn_mbcnt_lo((unsigned)m, 0u)); }

namespace pg8 {
#define PG8_LAS __attribute__((address_space(3)))
typedef unsigned short bf16_t;
typedef short bf16x8 __attribute__((ext_vector_type(8)));
typedef float f32x4 __attribute__((ext_vector_type(4)));
typedef unsigned u32x4 __attribute__((ext_vector_type(4)));
constexpr int BM = 256, BK = 64, HALF = 128, HTB = HALF * BK * 2  , STAGE_BYTES = 8 * HTB, NXCD = 8, WGM = 8;

__host__ __device__ __forceinline__ int lds_byte(int r, int c) { const int st = (r >> 4) * 2 + (c >> 5), rr = r & 15, cc = c & 31, ob = rr * 64 + cc * 2; return st * 1024 + (ob ^ (((ob >> 9) & 1) << 5)); }
__host__ __device__ __forceinline__ void stage_rc(int b, int& R, int& C) { const int st = b / 1024, sb = b % 1024, swz = sb ^ (((sb >> 9) & 1) << 5); R = (st >> 1) * 16 + swz / 64; C = (st & 1) * 32 + (swz % 64) / 2; }
__host__ __device__ __forceinline__ int perm32(int rho) { const int n = rho >> 4, i = rho & 15; return 8 * (i >> 2) + 4 * n + (i & 3); }

struct Unit { int pm, pn; };
struct Gemm { const bf16_t* A; const bf16_t* Bt; int M, N, K; const bf16_t* A2; int asplit;
    __device__ __forceinline__ const char* abase(const Unit& u) const { return (const char*)(u.pn >= asplit ? A2 : A); } };

struct StaticOrder {
    int nM, nN, nwg, G, c;
    __host__ __device__ void init(int M, int N, int G_, int c_) { nM = M / BM; nN = N / BM; nwg = nM * nN; G = G_; c = c_; }
    __host__ __device__ bool next(int i, Unit& u) const {
        const long L = (long)i * G + c; if (L >= nwg) return false;
        int wgid = (int)L; { const int q = nwg / NXCD, r = nwg % NXCD, xcd = wgid % NXCD, off = wgid / NXCD; wgid = (xcd < r ? xcd * (q + 1) : r * (q + 1) + (xcd - r) * q) + off; }
        const int nig = WGM * nN, gid = wgid / nig, fm = gid * WGM, gsz = (nM - fm) < WGM ? (nM - fm) : WGM;
        u.pm = fm + ((wgid % nig) % gsz); u.pn = (wgid % nig) / gsz; return true;
    }
    __device__ __forceinline__ void a_ready(const Unit&) const {}
    __device__ __forceinline__ void done(const Unit&) const {}
};

__device__ __forceinline__ unsigned cvt_pk_bf16(float lo, float hi) { unsigned r; asm volatile("v_cvt_pk_bf16_f32 %0, %1, %2" : "=v"(r) : "v"(lo), "v"(hi)); return r; }
__device__ __forceinline__ u32x4 pack8(const float (&v)[8]) { u32x4 w; w.x = cvt_pk_bf16(v[0], v[1]); w.y = cvt_pk_bf16(v[2], v[3]); w.z = cvt_pk_bf16(v[4], v[5]); w.w = cvt_pk_bf16(v[6], v[7]); return w; }

struct EpiInProj {
    static constexpr bool PERM = true, AFTER_DRAIN = false;
    const float* rstd1; const float* cs; const float* sn; unsigned char* ws; const float* ikw; const float* ikb;
    __device__ __forceinline__ void operator()(const f32x4 (&acc)[2][2][4][2], const Unit& u, int wr, int wc, int fr_, int fq_) const {
        const int pn = u.pn; int fr = fr_, fq = fq_;
        asm volatile("" : "+v"(fr), "+v"(fq));
#pragma unroll
        for (int ai = 0; ai < 2; ++ai)
#pragma unroll
            for (int m = 0; m < 4; ++m) {
                const int row = u.pm * BM + ai * HALF + wr * 64 + m * 16 + fr;
                const float rs = rstd1[row];
                float x1[8], x2[8];
#pragma unroll
                for (int j = 0; j < 4; ++j) { x1[j] = acc[ai][0][m][0][j] * rs; x1[4 + j] = acc[ai][0][m][1][j] * rs; x2[j] = acc[ai][1][m][0][j] * rs; x2[4 + j] = acc[ai][1][m][1][j] * rs; }
                if (pn >= 9) {
                    bf16_t* G = (bf16_t*)(ws + WS_GA + (size_t)((pn - 9) >> 2) * (WS_GB - WS_GA)) + (size_t)row * 1024 + 256 * ((pn - 9) & 3) + 32 * wc + 8 * fq;
                    float a[8], b[8];
#pragma unroll
                    for (int j = 0; j < 8; ++j) { a[j] = 1.0f / (1.0f + __builtin_amdgcn_exp2f(-x1[j] * 1.4426950408889634f)); b[j] = 1.0f / (1.0f + __builtin_amdgcn_exp2f(-x2[j] * 1.4426950408889634f)); }
                    *(u32x4*)G = pack8(a); *(u32x4*)(G + 128) = pack8(b);
                } else if (pn == 8) {
                    if (wc == 0) {
                        float s = 0.f;
#pragma unroll
                        for (int j = 0; j < 8; ++j) s += x1[j] + x2[j];
                        s += __shfl_xor(s, 16); s += __shfl_xor(s, 32);
                        const float mu = s * (1.0f / 64.0f); float q = 0.f;
#pragma unroll
                        for (int j = 0; j < 8; ++j) { x1[j] -= mu; x2[j] -= mu; q += x1[j] * x1[j] + x2[j] * x2[j]; }
                        q += __shfl_xor(q, 16); q += __shfl_xor(q, 32);
                        const float rstd = __builtin_amdgcn_rsqf(q * (1.0f / 64.0f) + 1e-6f);
                        const int pos = row & 4095; const float* cp = cs + pos * 32 + 8 * fq; const float* sp = sn + pos * 32 + 8 * fq;
                        float o1[8], o2[8];
#pragma unroll
                        for (int j = 0; j < 8; ++j) { const float y1 = x1[j] * rstd * ikw[8 * fq + j] + ikb[8 * fq + j], y2 = x2[j] * rstd * ikw[32 + 8 * fq + j] + ikb[32 + 8 * fq + j];
                            const float c = cp[j], sI = sp[j]; o1[j] = y1 * c - y2 * sI; o2[j] = y2 * c + y1 * sI; }
                        bf16_t* dst = (bf16_t*)(ws + WS_IK) + (size_t)row * 64 + 8 * fq;
                        *(u32x4*)dst = pack8(o1); *(u32x4*)(dst + 32) = pack8(o2);
                    } else if (wc == 1 && fq == 0) {
                        float* dst = (float*)(ws + WS_IW) + (size_t)row * 8;
                        *(f32x4*)dst = (f32x4){x1[0], x1[1], x1[2], x1[3]} * 0.04419417382415922f; *(f32x4*)(dst + 4) = (f32x4){x1[4], x1[5], x1[6], x1[7]} * 0.04419417382415922f;
                    }
                } else if (pn >= 6) {
                    bf16_t* Kd = (bf16_t*)(ws + WS_AK + (size_t)(pn - 6) * (WS_BK - WS_AK)); bf16_t* Vd = (bf16_t*)(ws + WS_AV + (size_t)(pn - 6) * (WS_BV - WS_AV));
                    if (wc < 2) {
                        const int pos = row & 4095; const float* cp = cs + pos * 32 + 8 * fq; const float* sp = sn + pos * 32 + 8 * fq;
                        float o1[8], o2[8];
#pragma unroll
                        for (int j = 0; j < 8; ++j) { const float c = cp[j], sI = sp[j]; o1[j] = x1[j] * c - x2[j] * sI; o2[j] = x2[j] * c + x1[j] * sI; }
                        bf16_t* dst = Kd + (size_t)row * 128 + wc * 64 + 8 * fq;
                        *(u32x4*)dst = pack8(o1); *(u32x4*)(dst + 32) = pack8(o2);
                    } else {
                        bf16_t* dst = Vd + (size_t)row * 128 + 32 * (wc - 2) + 8 * fq;
                        *(u32x4*)dst = pack8(x1); *(u32x4*)(dst + 64) = pack8(x2);
                    }
                } else {
                    bf16_t* Q = (bf16_t*)(ws + WS_AQ + (size_t)(pn >> 1) * (WS_IQ - WS_AQ)); const float sc = (pn >= 2 && pn < 4) ? 1.0f : 0.125f * 1.4426950408889634f;
                    const int pos = row & 4095; const float* cp = cs + pos * 32 + 8 * fq; const float* sp = sn + pos * 32 + 8 * fq;
                    float o1[8], o2[8];
#pragma unroll
                    for (int j = 0; j < 8; ++j) { const float c = cp[j], sI = sp[j]; o1[j] = (x1[j] * c - x2[j] * sI) * sc; o2[j] = (x2[j] * c + x1[j] * sI) * sc; }
                    bf16_t* dst = Q + (size_t)row * 512 + (4 * (pn & 1) + wc) * 64 + 8 * fq;
                    *(u32x4*)dst = pack8(o1); *(u32x4*)(dst + 32) = pack8(o2);
                }
                asm volatile("" ::: "memory");
            }
    }
};

struct EpiGate {
    static constexpr bool PERM = true, AFTER_DRAIN = false;
    const bf16_t *GA, *GB; float* P; bf16_t* MIX;
    __device__ __forceinline__ void operator()(const f32x4 (&acc)[2][2][4][2], const Unit& u, int wr, int wc, int fr, int fq) const {
        const bool second = u.pn >= 4; const bf16_t* G = second ? GB : GA;
#pragma unroll
        for (int ai = 0; ai < 2; ++ai)
#pragma unroll
            for (int m = 0; m < 4; ++m) {
                const int row = u.pm * BM + ai * HALF + wr * 64 + m * 16 + fr;
#pragma unroll
                for (int bj = 0; bj < 2; ++bj) {
                    const size_t off = (size_t)row * 1024 + 256 * (u.pn & 3) + 128 * bj + 32 * wc + 8 * fq;
                    const u32x4 gw = *(const u32x4*)(G + off);
                    float v[8];
#pragma unroll
                    for (int j = 0; j < 4; ++j) { v[j] = acc[ai][bj][m][0][j]; v[4 + j] = acc[ai][bj][m][1][j]; }
                    v[0] *= __uint_as_float(gw.x << 16); v[1] *= __uint_as_float(gw.x & 0xffff0000u); v[2] *= __uint_as_float(gw.y << 16); v[3] *= __uint_as_float(gw.y & 0xffff0000u);
                    v[4] *= __uint_as_float(gw.z << 16); v[5] *= __uint_as_float(gw.z & 0xffff0000u); v[6] *= __uint_as_float(gw.w << 16); v[7] *= __uint_as_float(gw.w & 0xffff0000u);
                    if (!second) { *(f32x4*)(P + off) = (f32x4){v[0], v[1], v[2], v[3]}; *(f32x4*)(P + off + 4) = (f32x4){v[4], v[5], v[6], v[7]}; }
                    else { const f32x4 p0 = *(const f32x4*)(P + off), p1 = *(const f32x4*)(P + off + 4);
#pragma unroll
                        for (int j = 0; j < 4; ++j) { v[j] += p0[j]; v[4 + j] += p1[j]; }
                        *(u32x4*)(MIX + off) = pack8(v); }
                }
            }
    }
};

template <bool WITH_XG> struct EpiResid {
    static constexpr bool PERM = false, AFTER_DRAIN = false;
    const float* base; float* out; bf16_t* XG; const float* gw; float* ss;
    __device__ __forceinline__ void operator()(const f32x4 (&acc)[2][2][4][2], const Unit& u, int wr, int wc, int fr, int fq) const {
#pragma unroll
        for (int ai = 0; ai < 2; ++ai)
#pragma unroll
            for (int m = 0; m < 4; ++m) {
                const int row = u.pm * BM + ai * HALF + wr * 64 + m * 16 + fr; float s = 0.f;
#pragma unroll
                for (int bj = 0; bj < 2; ++bj)
#pragma unroll
                    for (int n = 0; n < 2; ++n) {
                        const int col = u.pn * BM + bj * HALF + wc * 32 + n * 16 + 4 * fq; const size_t off = (size_t)row * 1024 + col;
                        const f32x4 v = *(const f32x4*)(base + off) + acc[ai][bj][m][n];
                        *(f32x4*)(out + off) = v; s += (v[0] * v[0] + v[1] * v[1]) + (v[2] * v[2] + v[3] * v[3]);
                        if (WITH_XG) { const f32x4 g = *(const f32x4*)(gw + col); unsigned long long w = (unsigned long long)cvt_pk_bf16(v[0] * g[0], v[1] * g[1]) | ((unsigned long long)cvt_pk_bf16(v[2] * g[2], v[3] * g[3]) << 32);
                            *(unsigned long long*)(XG + off) = w; }
                    }
                s += __shfl_xor(s, 16); s += __shfl_xor(s, 32);
                if (fq == 0) atomicAdd(ss + row, s);
            }
    }
};

struct EpiUp {
    static constexpr bool PERM = true, AFTER_DRAIN = false;
    const float* ss; bf16_t* HID;
    __device__ __forceinline__ void operator()(const f32x4 (&acc)[2][2][4][2], const Unit& u, int wr, int wc, int fr, int fq) const {
#pragma unroll
        for (int ai = 0; ai < 2; ++ai)
#pragma unroll
            for (int m = 0; m < 4; ++m) {
                const int row = u.pm * BM + ai * HALF + wr * 64 + m * 16 + fr;
                const float rs = __builtin_amdgcn_rsqf(ss[row] * (1.0f / 1024.0f) + 1e-6f);
#pragma unroll
                for (int bj = 0; bj < 2; ++bj) {
                    float v[8];
#pragma unroll
                    for (int j = 0; j < 4; ++j) { float a = fmaxf(acc[ai][bj][m][0][j] * rs, 0.f), b = fmaxf(acc[ai][bj][m][1][j] * rs, 0.f); v[j] = a * a; v[4 + j] = b * b; }
                    *(u32x4*)(HID + (size_t)row * 4096 + u.pn * BM + bj * HALF + wc * 32 + 8 * fq) = pack8(v);
                }
            }
    }
};

struct BranchOrder {
    int G, c;
    __device__ __forceinline__ bool next(int i, Unit& u) const {
        const int tile = (i >> 1) * G + c; if (tile >= 128 * 4) return false;
        u.pm = tile >> 2; u.pn = (tile & 3) + 4 * (i & 1); return true;
    }
    __device__ __forceinline__ void a_ready(const Unit&) const {}
    __device__ __forceinline__ void done(const Unit&) const {}
};

template <class Epi, class Sched, bool ALIGN_EPI = false, bool SP2 = false>
__device__ __forceinline__ void gemm_phase(PG8_LAS unsigned char* lds, const Gemm g, const Sched& S, const Epi& E) {
    const int tid = threadIdx.x, wid = __builtin_amdgcn_readfirstlane(tid >> 6), lane = tid & 63, wr = wid >> 2, wc = wid & 3, fr = lane & 15, fq = lane >> 4;
    const int K = g.K, nt = K / BK;
    unsigned voffA[2], voffB[2];
#pragma unroll
    for (int i = 0; i < 2; ++i) { int R, C; stage_rc(tid * 16 + i * 8192, R, C); const int Rb = Epi::PERM ? ((R & ~31) + perm32(R & 31)) : R;
        voffA[i] = (unsigned)(R * K + C) * 2u; voffB[i] = (unsigned)(Rb * K + C) * 2u; }
    const size_t kstep = (size_t)(BK * 2);
    const size_t hstep = (size_t)HALF * K * 2;
    const size_t tstep = 2 * hstep;
    const unsigned ldsw = (unsigned)wid * 1024u;
    const int aoff = lds_byte(wr * 64 + fr, fq * 8), boff = lds_byte(wc * 32 + fr, fq * 8);
#define PG8_SA(b, h) (((b) * 2 + (h)) * HTB)
#define PG8_SB(b, h) ((4 + (b) * 2 + (h)) * HTB)
#define PG8_STAGE(bufoff, gbase, voff) do { _Pragma("unroll") for (int _i = 0; _i < 2; ++_i) \
        __builtin_amdgcn_global_load_lds((const unsigned*)((const char*)(gbase) + (voff)[_i]), (PG8_LAS unsigned*)(lds + (bufoff) + ldsw + _i * 8192), 16, 0, 0); } while (0)
#define PG8_LDA(dst, b, h) do { _Pragma("unroll") for (int m = 0; m < 4; ++m) _Pragma("unroll") for (int k = 0; k < 2; ++k) dst[m][k] = *(const PG8_LAS bf16x8*)(lds + PG8_SA(b, h) + aoff + m * 2048 + k * 1024); } while (0)
#define PG8_LDB(dst, b, h) do { _Pragma("unroll") for (int n = 0; n < 2; ++n) _Pragma("unroll") for (int k = 0; k < 2; ++k) dst[n][k] = *(const PG8_LAS bf16x8*)(lds + PG8_SB(b, h) + boff + n * 2048 + k * 1024); } while (0)
#define PG8_MMA(ai, bj, At, Bt) do { __builtin_amdgcn_s_setprio(1); _Pragma("unroll") for (int m = 0; m < 4; ++m) _Pragma("unroll") for (int n = 0; n < 2; ++n) _Pragma("unroll") for (int k = 0; k < 2; ++k) \
        acc[ai][bj][m][n] = __builtin_amdgcn_mfma_f32_16x16x32_bf16(Bt[n][k], At[m][k], acc[ai][bj][m][n], 0, 0, 0); __builtin_amdgcn_s_setprio(0); } while (0)
#define PG8_WAIT_V(n) asm volatile("s_waitcnt vmcnt(" #n ")" ::: "memory")
#define PG8_WAIT_L(n) asm volatile("s_waitcnt lgkmcnt(" #n ")" ::: "memory")
#define PG8_BAR __builtin_amdgcn_s_barrier()
#define PG8_SCHED __builtin_amdgcn_sched_barrier(0)
    Unit cur, nxt; int ui = 0;
    if (!S.next(0, cur)) return;
    f32x4 acc[2][2][4][2];
#pragma unroll
    for (int a = 0; a < 2; ++a)
#pragma unroll
        for (int b = 0; b < 2; ++b)
#pragma unroll
            for (int m = 0; m < 4; ++m)
#pragma unroll
                for (int n = 0; n < 2; ++n) acc[a][b][m][n] = (f32x4){0.f, 0.f, 0.f, 0.f};
    bf16x8 At[4][2], B0[2][2], B1[2][2];
    const char* cA = g.abase(cur) + (size_t)cur.pm * tstep; const char* cB = (const char*)g.Bt + (size_t)cur.pn * tstep;
    S.a_ready(cur);
    if constexpr (SP2) {
        PG8_STAGE(PG8_SB(0, 0), cB, voffB); PG8_STAGE(PG8_SB(0, 1), cB + hstep, voffB); PG8_STAGE(PG8_SA(0, 0), cA, voffA); PG8_STAGE(PG8_SA(0, 1), cA + hstep, voffA);
        if (wr == 1) PG8_BAR;
        PG8_WAIT_V(2); PG8_BAR;
        PG8_STAGE(PG8_SB(1, 0), cB + kstep, voffB); PG8_STAGE(PG8_SA(1, 0), cA + kstep, voffA); PG8_STAGE(PG8_SB(1, 1), cB + hstep + kstep, voffB);
        PG8_WAIT_V(6); PG8_BAR;
    } else {
        PG8_STAGE(PG8_SB(0, 0), cB, voffB); PG8_STAGE(PG8_SA(0, 0), cA, voffA); PG8_STAGE(PG8_SB(0, 1), cB + hstep, voffB); PG8_STAGE(PG8_SA(0, 1), cA + hstep, voffA);
        if (wr == 1) PG8_BAR;
        PG8_WAIT_V(4); PG8_BAR;
        PG8_STAGE(PG8_SB(1, 0), cB + kstep, voffB); PG8_STAGE(PG8_SA(1, 0), cA + kstep, voffA); PG8_STAGE(PG8_SB(1, 1), cB + hstep + kstep, voffB);
        PG8_WAIT_V(6); PG8_BAR;
    }
    for (;;) {
        const bool has_next = S.next(ui + 1, nxt);
        const char* nA = has_next ? g.abase(nxt) + (size_t)nxt.pm * tstep : cA; const char* nB = has_next ? (const char*)g.Bt + (size_t)nxt.pn * tstep : cB;
        for (int t = 0; t < nt; t += 2) {
            const bool last = (t == nt - 2);
            const char* a1 = cA + (size_t)(t + 1) * kstep;
            const char* a2 = last ? nA : cA + (size_t)(t + 2) * kstep; const char* b2 = last ? nB : cB + (size_t)(t + 2) * kstep;
            const char* a3 = a2 + kstep; const char* b3 = b2 + kstep;
            if (last && has_next) S.a_ready(nxt);
            if constexpr (SP2) {
            PG8_LDB(B0, 0, 0); PG8_LDB(B1, 0, 1); PG8_SCHED; PG8_LDA(At, 0, 0); PG8_STAGE(PG8_SA(1, 1), a1 + hstep, voffA);
            PG8_WAIT_V(8); PG8_WAIT_L(0); PG8_BAR; PG8_MMA(0, 0, At, B0); PG8_MMA(0, 1, At, B1); PG8_BAR; PG8_SCHED;
            PG8_LDA(At, 0, 1); PG8_STAGE(PG8_SB(0, 0), b2, voffB); PG8_STAGE(PG8_SB(0, 1), b2 + hstep, voffB); PG8_STAGE(PG8_SA(0, 0), a2, voffA);
            PG8_WAIT_V(8); PG8_WAIT_L(0); PG8_BAR; PG8_MMA(1, 0, At, B0); PG8_MMA(1, 1, At, B1); PG8_BAR; PG8_SCHED;
            PG8_LDB(B0, 1, 0); PG8_LDB(B1, 1, 1); PG8_SCHED; PG8_LDA(At, 1, 0); PG8_STAGE(PG8_SA(0, 1), a2 + hstep, voffA);
            PG8_WAIT_V(8); PG8_WAIT_L(0); PG8_BAR; PG8_MMA(0, 0, At, B0); PG8_MMA(0, 1, At, B1); PG8_BAR; PG8_SCHED;
            PG8_LDA(At, 1, 1); PG8_STAGE(PG8_SB(1, 0), b3, voffB); PG8_STAGE(PG8_SB(1, 1), b3 + hstep, voffB); PG8_STAGE(PG8_SA(1, 0), a3, voffA);
            PG8_WAIT_V(8); PG8_WAIT_L(0); PG8_BAR; PG8_MMA(1, 0, At, B0); PG8_MMA(1, 1, At, B1); PG8_BAR; PG8_SCHED;
            } else {
            PG8_LDB(B0, 0, 0); PG8_SCHED; PG8_LDA(At, 0, 0); PG8_STAGE(PG8_SA(1, 1), a1 + hstep, voffA);
            PG8_WAIT_L(8); PG8_BAR; PG8_WAIT_L(0); PG8_MMA(0, 0, At, B0); PG8_BAR; PG8_SCHED;
            PG8_LDB(B1, 0, 1); PG8_STAGE(PG8_SB(0, 0), b2, voffB);
            PG8_BAR; PG8_WAIT_L(0); PG8_MMA(0, 1, At, B1); PG8_BAR;
            PG8_LDA(At, 0, 1); PG8_STAGE(PG8_SA(0, 0), a2, voffA);
            PG8_BAR; PG8_WAIT_L(0); PG8_MMA(1, 0, At, B0); PG8_BAR; PG8_SCHED;
            PG8_STAGE(PG8_SB(0, 1), b2 + hstep, voffB);
            PG8_WAIT_V(6); PG8_BAR; PG8_MMA(1, 1, At, B1); PG8_BAR;
            PG8_LDB(B0, 1, 0); PG8_SCHED; PG8_LDA(At, 1, 0); PG8_STAGE(PG8_SA(0, 1), a2 + hstep, voffA);
            PG8_WAIT_L(8); PG8_BAR; PG8_WAIT_L(0); PG8_MMA(0, 0, At, B0); PG8_BAR; PG8_SCHED;
            PG8_LDB(B1, 1, 1); PG8_STAGE(PG8_SB(1, 0), b3, voffB);
            PG8_BAR; PG8_WAIT_L(0); PG8_MMA(0, 1, At, B1); PG8_BAR;
            PG8_LDA(At, 1, 1); PG8_STAGE(PG8_SA(1, 0), a3, voffA);
            PG8_BAR; PG8_WAIT_L(0); PG8_MMA(1, 0, At, B0); PG8_BAR; PG8_SCHED;
            PG8_STAGE(PG8_SB(1, 1), b3 + hstep, voffB);
            PG8_WAIT_V(6); PG8_BAR; PG8_MMA(1, 1, At, B1); PG8_BAR;
            }
        }
        if constexpr (ALIGN_EPI) { if (wr == 0) PG8_BAR; }
        if constexpr (!Epi::AFTER_DRAIN) { E(acc, cur, wr, wc, fr, fq); S.done(cur); }
        if (!has_next) break;
#pragma unroll
        for (int a = 0; a < 2; ++a)
#pragma unroll
            for (int b = 0; b < 2; ++b)
#pragma unroll
                for (int m = 0; m < 4; ++m)
#pragma unroll
                    for (int n = 0; n < 2; ++n) acc[a][b][m][n] = (f32x4){0.f, 0.f, 0.f, 0.f};
        cur = nxt; cA = nA; cB = nB; ++ui;
        if constexpr (ALIGN_EPI) { if (wr == 1) PG8_BAR; }
    }
    PG8_WAIT_V(0);
    if constexpr (!ALIGN_EPI) { if (wr == 0) PG8_BAR; }
    PG8_BAR;
    if constexpr (Epi::AFTER_DRAIN) { E.fused(acc, cur, wr, wc, fr, fq, lds, wid, lane); S.done(cur); }
#undef PG8_SA
#undef PG8_SB
#undef PG8_STAGE
#undef PG8_LDA
#undef PG8_LDB
#undef PG8_MMA
#undef PG8_WAIT_V
#undef PG8_WAIT_L
#undef PG8_BAR
#undef PG8_SCHED
}
}
struct Params {
    const float *x, *attn_norm_w, *w_in, *ikw, *ikb, *sinks, *w_a, *w_b, *w_out, *mlp_norm_w, *w_up, *w_down, *final_w;
    float* out; unsigned char* ws;
    float inv_freq[32];
    int ph_lo, ph_hi;
};
constexpr int NWAVES = 8, NTHREADS = 512;

__device__ __forceinline__ int win_src_group(int grp, int& cnt) {
    const int tile = grp >> 3, g = grp & 7; cnt = 32;
    if (tile < 6) { const int base = tile < 2 ? C_AQ : (tile < 4 ? C_IQ : C_BQ); const int head = 4 * (tile & 1) + (g & 3); return base + head * 64 + 32 * (g >> 2); }
    if (tile < 8) { const int kb = tile == 6 ? C_AK : C_BK, vb = tile == 6 ? C_AV : C_BV; const int hf = g >> 2, q = g & 3;
        if (q < 2) return kb + q * 64 + 32 * hf; return vb + 64 * hf + 32 * (q - 2); }
    if (tile == 8) { if (g == 0) return C_IK; if (g == 4) return C_IK + 32; if (g == 1) { cnt = 8; return C_IW; } cnt = 0; return 0; }
    return C_GA + (grp - 72) * 32;
}
__device__ __forceinline__ void p0_transpose_item(const float* W, int ldw, int c0, int cnt, int K, bf16* WT, int n0, int k0, LAS float* scr, int lane) {
#pragma unroll 8
    for (int i = 0; i < 32; ++i) { const int kk = 2 * i + (lane >> 5), n = lane & 31; scr[kk * 33 + n] = (n < cnt) ? W[(size_t)(k0 + kk) * ldw + c0 + n] : 0.f; }
    asm volatile("s_waitcnt lgkmcnt(0)" ::: "memory");
    const int c = lane & 7;
#pragma unroll
    for (int j = 0; j < 4; ++j) { const int n = (lane >> 3) + 8 * j; const LAS float* s = scr + (8 * c) * 33 + n;
        v4u o; o.x = pk2(s[0 * 33], s[1 * 33]); o.y = pk2(s[2 * 33], s[3 * 33]); o.z = pk2(s[4 * 33], s[5 * 33]); o.w = pk2(s[6 * 33], s[7 * 33]);
        *(v4u*)(WT + (size_t)(n0 + n) * K + k0 + 8 * c) = o; }
    asm volatile("s_waitcnt lgkmcnt(0)" ::: "memory");
}
__device__ __forceinline__ void sincos_d(float angf, float& sn, float& cs) {
    const double a = (double)angf; const double kq = __builtin_rint(a * 0.63661977236758134308);
    const double y = (a - kq * 1.57079632679489655800) - kq * 6.123233995736766e-17; const double y2 = y * y;
    double s = y * (1.0 + y2 * (-1.0 / 6 + y2 * (1.0 / 120 + y2 * (-1.0 / 5040 + y2 * (1.0 / 362880 + y2 * (-1.0 / 39916800 + y2 * (1.0 / 6227020800.0)))))));
    double c = 1.0 + y2 * (-0.5 + y2 * (1.0 / 24 + y2 * (-1.0 / 720 + y2 * (1.0 / 40320 + y2 * (-1.0 / 3628800 + y2 * (1.0 / 479001600.0 + y2 * (-1.0 / 87178291200.0)))))));
    const int q = ((int)kq) & 3;
    const double ss = (q == 0) ? s : (q == 1) ? c : (q == 2) ? -s : -c; const double cc = (q == 0) ? c : (q == 1) ? -s : (q == 2) ? -c : s;
    sn = (float)ss; cs = (float)cc;
}
__device__ __forceinline__ void phase_prologue(const Params& p, LAS unsigned char* lds, int G) {
    const int lane = threadIdx.x & 63, wave = __builtin_amdgcn_readfirstlane(threadIdx.x >> 6);
    unsigned char* ws = p.ws;
    LAS float* scr = (LAS float*)(lds + wave * 16384);
    const int gw = blockIdx.x * NWAVES + wave, NGW = G * NWAVES;
    constexpr int I_IN = (DM / 64) * (NIN / 32), I_A = (512 / 64) * (DM / 32), I_O = (DM / 64) * (DM / 32), I_U = (DM / 64) * (DFF / 32), I_D = (DFF / 64) * (DM / 32);
    constexpr int NITEMS = I_IN + 2 * I_A + I_O + I_U + I_D;
    for (int it = gw; it < NITEMS; it += NGW) {
        int r = it;
        if (r < I_IN) { const int grp = r % (NIN / 32), kb = r / (NIN / 32); int cnt; const int c0 = win_src_group(grp, cnt);
            p0_transpose_item(p.w_in, D_IN, c0, cnt, DM, (bf16*)(ws + WS_WIN), grp * 32, kb * 64, scr, lane); continue; } r -= I_IN;
        if (r < I_A) { const int nb = r % 32, kb = r / 32; p0_transpose_item(p.w_a, DM, nb * 32, 32, 512, (bf16*)(ws + WS_WAB), nb * 32, kb * 64, scr, lane); continue; } r -= I_A;
        if (r < I_A) { const int nb = r % 32, kb = r / 32; p0_transpose_item(p.w_b, DM, nb * 32, 32, 512, (bf16*)(ws + WS_WAB), 1024 + nb * 32, kb * 64, scr, lane); continue; } r -= I_A;
        if (r < I_O) { const int nb = r % 32, kb = r / 32; p0_transpose_item(p.w_out, DM, nb * 32, 32, DM, (bf16*)(ws + WS_WOUT), nb * 32, kb * 64, scr, lane); continue; } r -= I_O;
        if (r < I_U) { const int nb = r % 128, kb = r / 128; p0_transpose_item(p.w_up, DFF, nb * 32, 32, DM, (bf16*)(ws + WS_WUP), nb * 32, kb * 64, scr, lane); continue; } r -= I_U;
        { const int nb = r % 32, kb = r / 32; p0_transpose_item(p.w_down, DM, nb * 32, 32, DFF, (bf16*)(ws + WS_WDN), nb * 32, kb * 64, scr, lane); }
    }
    float* COS = (float*)(ws + WS_COS); float* SIN = (float*)(ws + WS_SIN);
    for (int i = gw * 64 + lane; i < SEQ * 32; i += NGW * 64) { const int pos = i >> 5, d = i & 31; const float ang = (float)pos * p.inv_freq[d]; float s, c; sincos_d(ang, s, c); COS[i] = c; SIN[i] = s; }
    float* RSTD1 = (float*)(ws + WS_RSTD1); float* SS2 = (float*)(ws + WS_SS2); float* SS3 = (float*)(ws + WS_SS3); bf16* XG = (bf16*)(ws + WS_XG);
    v4f g[4];
#pragma unroll
    for (int j = 0; j < 4; ++j) g[j] = *((const v4f*)p.attn_norm_w + lane + 64 * j);
    for (int m = gw; m < TOK; m += NGW) {
        const v4f* xr = (const v4f*)(p.x + (size_t)m * DM) + lane; v4f v[4]; float s = 0.f;
#pragma unroll
        for (int j = 0; j < 4; ++j) { v[j] = xr[64 * j]; s += (v[j].x * v[j].x + v[j].y * v[j].y) + (v[j].z * v[j].z + v[j].w * v[j].w); }
        s = wave_sum(s);
        unsigned long long* o8 = (unsigned long long*)(XG + (size_t)m * DM) + lane;
#pragma unroll
        for (int j = 0; j < 4; ++j) o8[64 * j] = (unsigned long long)pk2(v[j].x * g[j].x, v[j].y * g[j].y) | ((unsigned long long)pk2(v[j].z * g[j].z, v[j].w * g[j].w) << 32);
        if (lane == 0) { RSTD1[m] = frsq(s * (1.0f / DM) + RMS_EPS); SS2[m] = 0.f; SS3[m] = 0.f; }
    }
}

__device__ __forceinline__ unsigned f2key(float f) { const unsigned u = __float_as_uint(f); return (u & 0x80000000u) ? ~u : (u | 0x80000000u); }
__device__ __forceinline__ void phase_topk_simple(const Params& p, LAS unsigned char* lds, int G) {
    const int lane = threadIdx.x & 63, wave = __builtin_amdgcn_readfirstlane(threadIdx.x >> 6);
    unsigned char* ws = p.ws;
    const bf16* IQ = (const bf16*)(ws + WS_IQ); const bf16* IK = (const bf16*)(ws + WS_IK); const float* IW = (const float*)(ws + WS_IW);
    unsigned short* SEL = (unsigned short*)(ws + WS_SEL);
    LAS unsigned* keys = (LAS unsigned*)(lds + wave * 16384);
    LAS float* qf = (LAS float*)(lds + LDS_RING + wave * 2048);
    const int gw = blockIdx.x * NWAVES + wave, NGW = G * NWAVES;
    for (int row = gw; row < TOK; row += NGW) {
        const int b = row >> 12, t = row & 4095, n = t + 1;
        unsigned short* selrow = SEL + (size_t)row * TOPK;
        if (n <= TOPK) { for (int i = lane; i < n; i += 64) selrow[i] = (unsigned short)i; continue; }
        { const v4u q8 = *((const v4u*)(IQ + (size_t)row * 512) + lane);
            LAS float* d = qf + 8 * lane;
            d[0] = bflo(q8.x); d[1] = bfhi(q8.x); d[2] = bflo(q8.y); d[3] = bfhi(q8.y); d[4] = bflo(q8.z); d[5] = bfhi(q8.z); d[6] = bflo(q8.w); d[7] = bfhi(q8.w); }
        float w[8];
#pragma unroll
        for (int h = 0; h < 8; ++h) w[h] = IW[(size_t)row * 8 + h];
        asm volatile("s_waitcnt lgkmcnt(0)" ::: "memory");
        for (int s0 = 0; s0 < n; s0 += 64) {
            const int s = s0 + lane; const int sc = s < n ? s : t;
            const v4u* kp = (const v4u*)(IK + ((size_t)b * SEQ + sc) * 64);
            float dot[8];
#pragma unroll
            for (int h = 0; h < 8; ++h) dot[h] = 0.f;
#pragma unroll
            for (int c = 0; c < 8; ++c) {
                const v4u k8 = kp[c]; float kf[8] = {bflo(k8.x), bfhi(k8.x), bflo(k8.y), bfhi(k8.y), bflo(k8.z), bfhi(k8.z), bflo(k8.w), bfhi(k8.w)};
#pragma unroll
                for (int h = 0; h < 8; ++h) { const v4f qa = *(const LAS v4f*)(qf + h * 64 + c * 8), qb = *(const LAS v4f*)(qf + h * 64 + c * 8 + 4);
                    dot[h] += (kf[0] * qa.x + kf[1] * qa.y) + (kf[2] * qa.z + kf[3] * qa.w) + (kf[4] * qb.x + kf[5] * qb.y) + (kf[6] * qb.z + kf[7] * qb.w); }
            }
            float sc_ = 0.f;
#pragma unroll
            for (int h = 0; h < 8; ++h) sc_ += w[h] * fmaxf(dot[h], 0.f);
            keys[s] = (s < n) ? f2key(sc_) : 0u;
        }
        asm volatile("s_waitcnt lgkmcnt(0)" ::: "memory");
        const int nch = (n + 63) >> 6;
        unsigned thr = 0u;
        for (int bit = 31; bit >= 0; --bit) {
            const unsigned cand = thr | (1u << bit); int cnt = 0;
            for (int c = 0; c < nch; ++c) cnt += __popcll(__ballot(keys[c * 64 + lane] >= cand));
            if (cnt >= TOPK) thr = cand;
        }
        int cgt = 0;
        for (int c = 0; c < nch; ++c) cgt += __popcll(__ballot(keys[c * 64 + lane] > thr));
        const int need = TOPK - cgt; int pos = 0, ties = 0;
        for (int c = 0; c < nch; ++c) {
            const unsigned k = keys[c * 64 + lane]; const bool gt = k > thr, eq = k == thr;
            const unsigned long long meq = __ballot(eq);
            const bool sel = gt || (eq && (ties + mbcnt64(meq) < need));
            const unsigned long long msel = __ballot(sel);
            if (sel) selrow[pos + mbcnt64(msel)] = (unsigned short)(c * 64 + lane);
            pos += __popcll(msel); ties += __popcll(meq);
        }
    }
}

template <bool SINK, class KeyFn>
__device__ __forceinline__ void attend_wave(const bf16* Q, const bf16* K, const bf16* V, bf16* O, int row, int g, int nslots, const KeyFn& keyfn, const float* sinkv,
                                            LAS float* qf  , LAS float* pf  , LAS int* kidx  , int lane) {
    const int b = row >> 12;
    { const v2u q4 = *((const v2u*)(Q + (size_t)row * 512 + g * 256) + lane);
        LAS float* d = qf + 4 * lane; d[0] = bflo(q4.x); d[1] = bfhi(q4.x); d[2] = bflo(q4.y); d[3] = bfhi(q4.y); }
    asm volatile("s_waitcnt lgkmcnt(0)" ::: "memory");
#pragma unroll 1
    for (int j = 0; j < 4; ++j) {
        const int slot = 64 * j + lane; int key = slot < nslots ? keyfn(slot) : -1; kidx[slot] = key;
        const bool valid = key >= 0; const int kc = valid ? key : 0;
        const v4u* kp = (const v4u*)(K + ((size_t)b * SEQ + kc) * 128 + g * 64);
        float dot[4] = {0.f, 0.f, 0.f, 0.f};
        if (64 * j < nslots) {
#pragma unroll
            for (int c = 0; c < 8; ++c) {
                const v4u k8 = kp[c]; float kf[8] = {bflo(k8.x), bfhi(k8.x), bflo(k8.y), bfhi(k8.y), bflo(k8.z), bfhi(k8.z), bflo(k8.w), bfhi(k8.w)};
#pragma unroll
                for (int h = 0; h < 4; ++h) { const v4f qa = *(const LAS v4f*)(qf + h * 64 + c * 8), qb = *(const LAS v4f*)(qf + h * 64 + c * 8 + 4);
                    dot[h] += (kf[0] * qa.x + kf[1] * qa.y) + (kf[2] * qa.z + kf[3] * qa.w) + (kf[4] * qb.x + kf[5] * qb.y) + (kf[6] * qb.z + kf[7] * qb.w); }
            }
        }
        *(LAS v4f*)(pf + slot * 4) = valid ? (v4f){dot[0], dot[1], dot[2], dot[3]} : (v4f){-INFINITY, -INFINITY, -INFINITY, -INFINITY};
    }
    asm volatile("s_waitcnt lgkmcnt(0)" ::: "memory");
    float lg[4][4];
#pragma unroll
    for (int j = 0; j < 4; ++j) { const v4f t4 = *(const LAS v4f*)(pf + (64 * j + lane) * 4); lg[j][0] = t4.x; lg[j][1] = t4.y; lg[j][2] = t4.z; lg[j][3] = t4.w; }
    float inv[4];
#pragma unroll
    for (int h = 0; h < 4; ++h) {
        float mx = fmaxf(fmaxf(lg[0][h], lg[1][h]), fmaxf(lg[2][h], lg[3][h])); mx = wave_max(mx);
        float sk = 0.f; if (SINK) { sk = sinkv[g * 4 + h] * LOG2E; mx = fmaxf(mx, sk); }
        float s = 0.f;
#pragma unroll
        for (int j = 0; j < 4; ++j) { const float e = fexp2(lg[j][h] - mx); lg[j][h] = e; s += e; }
        s = wave_sum(s); if (SINK) s += fexp2(sk - mx);
        inv[h] = 1.0f / s;
    }
#pragma unroll
    for (int j = 0; j < 4; ++j) *(LAS v4f*)(pf + (64 * j + lane) * 4) = (v4f){lg[j][0], lg[j][1], lg[j][2], lg[j][3]};
    asm volatile("s_waitcnt lgkmcnt(0)" ::: "memory");
    float o[4] = {0.f, 0.f, 0.f, 0.f};
    const bf16* Vb = V + (size_t)b * SEQ * 128 + g * 64 + lane;
#pragma unroll 1
    for (int s0 = 0; s0 < nslots; s0 += 8) {
        float vv[8]; v4f pp[8];
#pragma unroll
        for (int i = 0; i < 8; ++i) { const int slot = s0 + i; const int key = slot < nslots ? kidx[slot] : -1; pp[i] = *(const LAS v4f*)(pf + (slot & 255) * 4);
            vv[i] = key >= 0 ? bf2f(Vb[(size_t)key * 128]) : 0.f; if (key < 0) pp[i] = (v4f){0.f, 0.f, 0.f, 0.f}; }
#pragma unroll
        for (int i = 0; i < 8; ++i) { o[0] += pp[i].x * vv[i]; o[1] += pp[i].y * vv[i]; o[2] += pp[i].z * vv[i]; o[3] += pp[i].w * vv[i]; }
    }
    bf16* op = O + (size_t)row * 512 + g * 256 + lane;
#pragma unroll
    for (int h = 0; h < 4; ++h) op[h * 64] = (bf16)f2bf(o[h] * inv[h]);
}
struct SelKey { const unsigned short* selrow; __device__ __forceinline__ int operator()(int slot) const { return (int)selrow[slot]; } };
struct WinKey { int t; __device__ __forceinline__ int operator()(int slot) const { return t - (WIN - 1) + slot; } };

__device__ __forceinline__ void phase_attn_simple(const Params& p, LAS unsigned char* lds, int G) {
    const int lane = threadIdx.x & 63, wave = __builtin_amdgcn_readfirstlane(threadIdx.x >> 6);
    unsigned char* ws = p.ws;
    LAS float* qf = (LAS float*)(lds + wave * 16384); LAS float* pf = qf + 256; LAS int* kidx = (LAS int*)(pf + 1024);
    const int gw = blockIdx.x * NWAVES + wave, NGW = G * NWAVES;
    const unsigned short* SEL = (const unsigned short*)(ws + WS_SEL);
    for (int item = gw; item < TOK * 2; item += NGW) {
        const int row = item >> 1, g = item & 1, t = row & 4095;
        { SelKey kf{SEL + (size_t)row * TOPK}; const int ns = (t + 1 < TOPK) ? t + 1 : TOPK;
            attend_wave<false>((const bf16*)(ws + WS_AQ), (const bf16*)(ws + WS_AK), (const bf16*)(ws + WS_AV), (bf16*)(ws + WS_AQ), row, g, ns, kf, nullptr, qf, pf, kidx, lane); }
        { WinKey kf{t};
            attend_wave<true>((const bf16*)(ws + WS_BQ), (const bf16*)(ws + WS_BK), (const bf16*)(ws + WS_BV), (bf16*)(ws + WS_BQ), row, g, WIN, kf, p.sinks, qf, pf, kidx, lane); }
    }
}

__device__ __forceinline__ void phase_final(const Params& p, int G) {
    const int lane = threadIdx.x & 63, wave = __builtin_amdgcn_readfirstlane(threadIdx.x >> 6);
    const float* SS3 = (const float*)(p.ws + WS_SS3);
    const int gw = blockIdx.x * NWAVES + wave, NGW = G * NWAVES;
    v4f g[4];
#pragma unroll
    for (int j = 0; j < 4; ++j) g[j] = *((const v4f*)p.final_w + lane + 64 * j);
    for (int m = gw; m < TOK; m += NGW) {
        const float rs = frsq(SS3[m] * (1.0f / DM) + RMS_EPS);
        v4f* xr = (v4f*)(p.out + (size_t)m * DM) + lane;
#pragma unroll
        for (int j = 0; j < 4; ++j) { v4f v = xr[64 * j]; xr[64 * j] = v * g[j] * rs; }
    }
}

constexpr int NPHASE = 9;
__global__ void __launch_bounds__(NTHREADS, 2) mk_fwd(Params p) {
    extern __shared__ __attribute__((aligned(16))) unsigned char lds_raw[];
    LAS unsigned char* lds = (LAS unsigned char*)lds_raw;
    const int G = gridDim.x;
    unsigned char* ws = p.ws;
#if MK_ONE_LAUNCH
#define SEAM(k) do { if (lo <= (k) && (k) + 1 < hi) cg::this_grid().sync(); } while (0)
#else
#define SEAM(k) do { } while (0)
#endif
    const int lo = p.ph_lo, hi = p.ph_hi;
#ifndef PHMASK
#define PHMASK 0x1ffu
#endif
#define IN(k) (((PHMASK >> (k)) & 1u) && lo <= (k) && (k) < hi)
    if (IN(0)) { phase_prologue(p, lds, G); SEAM(0); }
    if (IN(1)) {
        pg8::Gemm g{(const bf16*)(ws + WS_XG), (const bf16*)(ws + WS_WIN), TOK, NIN, DM, nullptr, 1 << 30};
        pg8::StaticOrder S; S.init(TOK, NIN, G, (int)blockIdx.x);
        pg8::EpiInProj E{(const float*)(ws + WS_RSTD1), (const float*)(ws + WS_COS), (const float*)(ws + WS_SIN), ws, p.ikw, p.ikb};
        pg8::gemm_phase<pg8::EpiInProj, pg8::StaticOrder, true, true>(lds, g, S, E);
        SEAM(1);
    }
    if (IN(2)) { phase_topk_simple(p, lds, G); SEAM(2); }
    if (IN(3)) { phase_attn_simple(p, lds, G); SEAM(3); }
    if (IN(4)) {
        pg8::Gemm g{(const bf16*)(ws + WS_AQ), (const bf16*)(ws + WS_WAB), TOK, 2048, 512, (const bf16*)(ws + WS_BQ), 4};
        pg8::BranchOrder S{G, (int)blockIdx.x};
        pg8::EpiGate E{(const bf16*)(ws + WS_GA), (const bf16*)(ws + WS_GB), p.out, (bf16*)(ws + WS_MIX)};
        pg8::gemm_phase<pg8::EpiGate, pg8::BranchOrder, true, true>(lds, g, S, E);
        SEAM(4);
    }
    if (IN(5)) {
        pg8::Gemm g{(const bf16*)(ws + WS_MIX), (const bf16*)(ws + WS_WOUT), TOK, DM, DM, nullptr, 1 << 30};
        pg8::StaticOrder S; S.init(TOK, DM, G, (int)blockIdx.x);
        pg8::EpiResid<true> E{p.x, p.out, (bf16*)(ws + WS_XG), p.mlp_norm_w, (float*)(ws + WS_SS2)};
        pg8::gemm_phase<pg8::EpiResid<true>, pg8::StaticOrder, true, true>(lds, g, S, E);
        SEAM(5);
    }
    if (IN(6)) {
        pg8::Gemm g{(const bf16*)(ws + WS_XG), (const bf16*)(ws + WS_WUP), TOK, DFF, DM, nullptr, 1 << 30};
        pg8::StaticOrder S; S.init(TOK, DFF, G, (int)blockIdx.x);
        pg8::EpiUp E{(const float*)(ws + WS_SS2), (bf16*)(ws + WS_HID)};
        pg8::gemm_phase<pg8::EpiUp, pg8::StaticOrder, true, true>(lds, g, S, E);
        SEAM(6);
    }
    if (IN(7)) {
        pg8::Gemm g{(const bf16*)(ws + WS_HID), (const bf16*)(ws + WS_WDN), TOK, DM, DFF, nullptr, 1 << 30};
        pg8::StaticOrder S; S.init(TOK, DM, G, (int)blockIdx.x);
        pg8::EpiResid<false> E{p.out, p.out, nullptr, nullptr, (float*)(ws + WS_SS3)};
        pg8::gemm_phase<pg8::EpiResid<false>, pg8::StaticOrder, true, true>(lds, g, S, E);
        SEAM(7);
    }
    if (IN(8)) { phase_final(p, G); }
#undef IN
#undef SEAM
}

extern "C" void kernel_launch(void* const* d_in, const int* in_sizes, int n_in, void* d_out, int out_size, void* d_ws, size_t ws_size, hipStream_t stream) {
    static int grid = 0;
    if (grid == 0) {
        if (n_in != 13 || in_sizes[0] != TOK * DM || out_size != TOK * DM || ws_size < WS_END) {
            fprintf(stderr, "kernel_launch: unexpected shapes (n_in %d, in0 %d, out %d, ws %zu); nothing launched\n", n_in, n_in > 0 ? in_sizes[0] : -1, out_size, ws_size); grid = -1; return; }
        int dev = 0, cus = 0, per_cu = 0;
        (void)hipGetDevice(&dev); (void)hipDeviceGetAttribute(&cus, hipDeviceAttributeMultiprocessorCount, dev);
        if (hipFuncSetAttribute((const void*)mk_fwd, hipFuncAttributeMaxDynamicSharedMemorySize, LDS_BYTES) != hipSuccess) { fprintf(stderr, "kernel_launch: hipFuncSetAttribute failed\n"); grid = -1; return; }
        if (hipOccupancyMaxActiveBlocksPerMultiprocessor(&per_cu, (const void*)mk_fwd, NTHREADS, LDS_BYTES) != hipSuccess || per_cu < 1) { fprintf(stderr, "kernel_launch: occupancy query says %d blocks per CU\n", per_cu); per_cu = 1; }
        (void)hipGetLastError();
        if (per_cu > 1) per_cu = 1;
        grid = cus * per_cu;
    }
    if (grid < 0) return;
    Params p{};
    p.x = (const float*)d_in[0]; p.attn_norm_w = (const float*)d_in[1]; p.w_in = (const float*)d_in[2]; p.ikw = (const float*)d_in[3]; p.ikb = (const float*)d_in[4];
    p.sinks = (const float*)d_in[5]; p.w_a = (const float*)d_in[6]; p.w_b = (const float*)d_in[7]; p.w_out = (const float*)d_in[8]; p.mlp_norm_w = (const float*)d_in[9];
    p.w_up = (const float*)d_in[10]; p.w_down = (const float*)d_in[11]; p.final_w = (const float*)d_in[12];
    p.out = (float*)d_out; p.ws = (unsigned char*)d_ws;
    for (int i = 0; i < 32; ++i) p.inv_freq[i] = 1.0f / powf(10000.0f, (float)(2 * i) / 64.0f);
#if MK_ONE_LAUNCH
    p.ph_lo = 0; p.ph_hi = NPHASE;
    void* args[] = {&p};
    hipError_t e = hipLaunchCooperativeKernel((const void*)mk_fwd, dim3(grid), dim3(NTHREADS), args, LDS_BYTES, stream);
    if (e != hipSuccess) fprintf(stderr, "kernel_launch: cooperative launch failed: %s (grid %d)\n", hipGetErrorString(e), grid);
#else
    for (int ph = 0; ph < NPHASE; ++ph) {
        p.ph_lo = ph; p.ph_hi = ph + 1;
        hipLaunchKernelGGL(mk_fwd, dim3(grid), dim3(NTHREADS), LDS_BYTES, stream, p);
    }
#endif
}
```

```cpp
#include <hip/hip_runtime.h>
#include <hip/hip_cooperative_groups.h>
#include <cstdio>
#include <cstdint>
namespace cg = cooperative_groups;

#ifndef MK_ONE_LAUNCH
#define MK_ONE_LAUNCH 1
#endif
#ifndef MK_SIMPLE_TOPK
#define MK_SIMPLE_TOPK 0
#endif
#ifndef MK_SIMPLE_DSA
#define MK_SIMPLE_DSA 0
#endif

constexpr int NBATCH = 8, SEQ = 4096, DM = 1024, TOK = NBATCH * SEQ, DFF = 4096, TOPK = 256, WIN = 128;
constexpr int NIN = 4352;
constexpr float RMS_EPS = 1e-6f, LN_EPS = 1e-6f;
constexpr float QSCALE = 0.125f * 1.4426950408889634f;
constexpr float LOG2E = 1.4426950408889634f;
constexpr float W_SCALE = 0.04419417382415922f;
constexpr int C_AQ = 0, C_AK = 512, C_AV = 640, C_IQ = 768, C_IK = 1280, C_IW = 1344, C_BQ = 1352, C_BK = 1864, C_BV = 1992, C_GA = 2120, C_GB = 3144, D_IN = 4168;

constexpr size_t MiB = 1u << 20;
constexpr size_t WS_RSTD1 = 0, WS_SS2 = 128 * 1024, WS_SS3 = 256 * 1024;
constexpr size_t WS_COS = 1 * MiB, WS_SIN = 1 * MiB + 512 * 1024;
constexpr size_t WS_WIN = 2 * MiB, WS_WAB = 11 * MiB, WS_WOUT = 13 * MiB, WS_WUP = 15 * MiB, WS_WDN = 23 * MiB;
constexpr size_t WS_XG = 32 * MiB;
constexpr size_t WS_AQ = 96 * MiB, WS_IQ = 128 * MiB, WS_BQ = 160 * MiB, WS_AK = 192 * MiB, WS_AV = 200 * MiB, WS_BK = 208 * MiB, WS_BV = 216 * MiB;
constexpr size_t WS_IK = 224 * MiB, WS_IW = 228 * MiB, WS_SEL = 230 * MiB, WS_GA = 248 * MiB, WS_GB = 312 * MiB, WS_MIX = 376 * MiB, WS_END = 440 * MiB;
constexpr size_t WS_HID = 96 * MiB;
static_assert(WS_WIN + (size_t)NIN * DM * 2 <= WS_WAB && WS_HID + (size_t)TOK * DFF * 2 <= WS_MIX, "ws map");

constexpr int LDS_RING = 131072, LDS_BYTES = 147456;

#define GAS __attribute__((address_space(1)))
#define LAS __attribute__((address_space(3)))
typedef unsigned short bf16;
typedef unsigned v4u __attribute__((ext_vector_type(4)));
typedef unsigned v2u __attribute__((ext_vector_type(2)));
typedef float v4f __attribute__((ext_vector_type(4)));

__device__ __forceinline__ float bf2f(unsigned short u) { return __uint_as_float((unsigned)u << 16); }
__device__ __forceinline__ float bflo(unsigned u) { return __uint_as_float(u << 16); }
__device__ __forceinline__ float bfhi(unsigned u) { return __uint_as_float(u & 0xffff0000u); }
__device__ __forceinline__ unsigned f2bf(float f) { unsigned u = __float_as_uint(f); return (u + 0x7fffu + ((u >> 16) & 1u)) >> 16; }
__device__ __forceinline__ unsigned pk2(float lo, float hi) { unsigned r; asm volatile("v_cvt_pk_bf16_f32 %0, %1, %2" : "=v"(r) : "v"(lo), "v"(hi)); return r; }
__device__ __forceinline__ float fexp2(float x) { return __builtin_amdgcn_exp2f(x); }
__device__ __forceinline__ float frsq(float x) { return __builtin_amdgcn_rsqf(x); }
__device__ __forceinline__ float frcp(float x) { return __builtin_amdgcn_rcpf(x); }
__device__ __forceinline__ float sigmoidf_(float x) { return frcp(1.0f + fexp2(-x * LOG2E)); }
__device__ __forceinline__ float wave_sum(float v) {
#pragma unroll
    for (int o = 1; o < 64; o <<= 1) v += __shfl_xor(v, o);
    return v;
}
__device__ __forceinline__ float wave_max(float v) {
#pragma unroll
    for (int o = 1; o < 64; o <<= 1) v = fmaxf(v, __shfl_xor(v, o));
    return v;
}
__device__ __forceinline__ int mbcnt64(unsigned long long m) { return __builtin_amdgcn_mbcnt_hi((unsigned)(m >> 32), __builtin_amdgcn_mbcnt_lo((unsigned)m, 0u)); }

namespace pg8 {
#define PG8_LAS __attribute__((address_space(3)))
typedef unsigned short bf16_t;
typedef short bf16x8 __attribute__((ext_vector_type(8)));
typedef float f32x4 __attribute__((ext_vector_type(4)));
typedef unsigned u32x4 __attribute__((ext_vector_type(4)));
constexpr int BM = 256, BK = 64, HALF = 128, HTB = HALF * BK * 2  , STAGE_BYTES = 8 * HTB, NXCD = 8, WGM = 8;

__host__ __device__ __forceinline__ int lds_byte(int r, int c) { const int st = (r >> 4) * 2 + (c >> 5), rr = r & 15, cc = c & 31, ob = rr * 64 + cc * 2; return st * 1024 + (ob ^ (((ob >> 9) & 1) << 5)); }
__host__ __device__ __forceinline__ void stage_rc(int b, int& R, int& C) { const int st = b / 1024, sb = b % 1024, swz = sb ^ (((sb >> 9) & 1) << 5); R = (st >> 1) * 16 + swz / 64; C = (st & 1) * 32 + (swz % 64) / 2; }
__host__ __device__ __forceinline__ int perm32(int rho) { const int n = rho >> 4, i = rho & 15; return 8 * (i >> 2) + 4 * n + (i & 3); }

struct Unit { int pm, pn; };
struct Gemm { const bf16_t* A; const bf16_t* Bt; int M, N, K; const bf16_t* A2; int asplit;
    __device__ __forceinline__ const char* abase(const Unit& u) const { return (const char*)(u.pn >= asplit ? A2 : A); } };

struct StaticOrder {
    int nM, nN, nwg, G, c;
    __host__ __device__ void init(int M, int N, int G_, int c_) { nM = M / BM; nN = N / BM; nwg = nM * nN; G = G_; c = c_; }
    __host__ __device__ bool next(int i, Unit& u) const {
        const long L = (long)i * G + c; if (L >= nwg) return false;
        int wgid = (int)L; { const int q = nwg / NXCD, r = nwg % NXCD, xcd = wgid % NXCD, off = wgid / NXCD; wgid = (xcd < r ? xcd * (q + 1) : r * (q + 1) + (xcd - r) * q) + off; }
        const int nig = WGM * nN, gid = wgid / nig, fm = gid * WGM, gsz = (nM - fm) < WGM ? (nM - fm) : WGM;
        u.pm = fm + ((wgid % nig) % gsz); u.pn = (wgid % nig) / gsz; return true;
    }
    __device__ __forceinline__ void a_ready(const Unit&) const {}
    __device__ __forceinline__ void done(const Unit&) const {}
};

__device__ __forceinline__ unsigned cvt_pk_bf16(float lo, float hi) { unsigned r; asm volatile("v_cvt_pk_bf16_f32 %0, %1, %2" : "=v"(r) : "v"(lo), "v"(hi)); return r; }
__device__ __forceinline__ u32x4 pack8(const float (&v)[8]) { u32x4 w; w.x = cvt_pk_bf16(v[0], v[1]); w.y = cvt_pk_bf16(v[2], v[3]); w.z = cvt_pk_bf16(v[4], v[5]); w.w = cvt_pk_bf16(v[6], v[7]); return w; }

struct EpiInProj {
    static constexpr bool PERM = true, AFTER_DRAIN = false;
    const float* rstd1; const float* cs; const float* sn; unsigned char* ws; const float* ikw; const float* ikb;
    __device__ __forceinline__ void operator()(const f32x4 (&acc)[2][2][4][2], const Unit& u, int wr, int wc, int fr_, int fq_) const {
        const int pn = u.pn; int fr = fr_, fq = fq_;
        asm volatile("" : "+v"(fr), "+v"(fq));
#pragma unroll
        for (int ai = 0; ai < 2; ++ai)
#pragma unroll
            for (int m = 0; m < 4; ++m) {
                const int row = u.pm * BM + ai * HALF + wr * 64 + m * 16 + fr;
                const float rs = rstd1[row];
                float x1[8], x2[8];
#pragma unroll
                for (int j = 0; j < 4; ++j) { x1[j] = acc[ai][0][m][0][j] * rs; x1[4 + j] = acc[ai][0][m][1][j] * rs; x2[j] = acc[ai][1][m][0][j] * rs; x2[4 + j] = acc[ai][1][m][1][j] * rs; }
                if (pn >= 9) {
                    bf16_t* G = (bf16_t*)(ws + WS_GA + (size_t)((pn - 9) >> 2) * (WS_GB - WS_GA)) + (size_t)row * 1024 + 256 * ((pn - 9) & 3) + 32 * wc + 8 * fq;
                    float a[8], b[8];
#pragma unroll
                    for (int j = 0; j < 8; ++j) { a[j] = 1.0f / (1.0f + __builtin_amdgcn_exp2f(-x1[j] * 1.4426950408889634f)); b[j] = 1.0f / (1.0f + __builtin_amdgcn_exp2f(-x2[j] * 1.4426950408889634f)); }
                    *(u32x4*)G = pack8(a); *(u32x4*)(G + 128) = pack8(b);
                } else if (pn == 8) {
                    if (wc == 0) {
                        float s = 0.f;
#pragma unroll
                        for (int j = 0; j < 8; ++j) s += x1[j] + x2[j];
                        s += __shfl_xor(s, 16); s += __shfl_xor(s, 32);
                        const float mu = s * (1.0f / 64.0f); float q = 0.f;
#pragma unroll
                        for (int j = 0; j < 8; ++j) { x1[j] -= mu; x2[j] -= mu; q += x1[j] * x1[j] + x2[j] * x2[j]; }
                        q += __shfl_xor(q, 16); q += __shfl_xor(q, 32);
                        const float rstd = __builtin_amdgcn_rsqf(q * (1.0f / 64.0f) + 1e-6f);
                        const int pos = row & 4095; const float* cp = cs + pos * 32 + 8 * fq; const float* sp = sn + pos * 32 + 8 * fq;
                        float o1[8], o2[8];
#pragma unroll
                        for (int j = 0; j < 8; ++j) { const float y1 = x1[j] * rstd * ikw[8 * fq + j] + ikb[8 * fq + j], y2 = x2[j] * rstd * ikw[32 + 8 * fq + j] + ikb[32 + 8 * fq + j];
                            const float c = cp[j], sI = sp[j]; o1[j] = y1 * c - y2 * sI; o2[j] = y2 * c + y1 * sI; }
                        bf16_t* dst = (bf16_t*)(ws + WS_IK) + (size_t)row * 64 + 8 * fq;
                        *(u32x4*)dst = pack8(o1); *(u32x4*)(dst + 32) = pack8(o2);
                    } else if (wc == 1 && fq == 0) {
                        float* dst = (float*)(ws + WS_IW) + (size_t)row * 8;
                        *(f32x4*)dst = (f32x4){x1[0], x1[1], x1[2], x1[3]} * 0.04419417382415922f; *(f32x4*)(dst + 4) = (f32x4){x1[4], x1[5], x1[6], x1[7]} * 0.04419417382415922f;
                    }
                } else if (pn >= 6) {
                    bf16_t* Kd = (bf16_t*)(ws + WS_AK + (size_t)(pn - 6) * (WS_BK - WS_AK)); bf16_t* Vd = (bf16_t*)(ws + WS_AV + (size_t)(pn - 6) * (WS_BV - WS_AV));
                    if (wc < 2) {
                        const int pos = row & 4095; const float* cp = cs + pos * 32 + 8 * fq; const float* sp = sn + pos * 32 + 8 * fq;
                        float o1[8], o2[8];
#pragma unroll
                        for (int j = 0; j < 8; ++j) { const float c = cp[j], sI = sp[j]; o1[j] = x1[j] * c - x2[j] * sI; o2[j] = x2[j] * c + x1[j] * sI; }
                        bf16_t* dst = Kd + (size_t)row * 128 + wc * 64 + 8 * fq;
                        *(u32x4*)dst = pack8(o1); *(u32x4*)(dst + 32) = pack8(o2);
                    } else {
                        bf16_t* dst = Vd + (size_t)row * 128 + 32 * (wc - 2) + 8 * fq;
                        *(u32x4*)dst = pack8(x1); *(u32x4*)(dst + 64) = pack8(x2);
                    }
                } else {
                    bf16_t* Q = (bf16_t*)(ws + WS_AQ + (size_t)(pn >> 1) * (WS_IQ - WS_AQ)); const float sc = (pn >= 2 && pn < 4) ? 1.0f : 0.125f * 1.4426950408889634f;
                    const int pos = row & 4095; const float* cp = cs + pos * 32 + 8 * fq; const float* sp = sn + pos * 32 + 8 * fq;
                    float o1[8], o2[8];
#pragma unroll
                    for (int j = 0; j < 8; ++j) { const float c = cp[j], sI = sp[j]; o1[j] = (x1[j] * c - x2[j] * sI) * sc; o2[j] = (x2[j] * c + x1[j] * sI) * sc; }
                    bf16_t* dst = Q + (size_t)row * 512 + (4 * (pn & 1) + wc) * 64 + 8 * fq;
                    *(u32x4*)dst = pack8(o1); *(u32x4*)(dst + 32) = pack8(o2);
                }
                asm volatile("" ::: "memory");
            }
    }
};

struct EpiGate {
    static constexpr bool PERM = true, AFTER_DRAIN = false;
    const bf16_t *GA, *GB; float* P; bf16_t* MIX;
    __device__ __forceinline__ void operator()(const f32x4 (&acc)[2][2][4][2], const Unit& u, int wr, int wc, int fr, int fq) const {
        const bool second = u.pn >= 4; const bf16_t* G = second ? GB : GA;
#pragma unroll
        for (int ai = 0; ai < 2; ++ai)
#pragma unroll
            for (int m = 0; m < 4; ++m) {
                const int row = u.pm * BM + ai * HALF + wr * 64 + m * 16 + fr;
#pragma unroll
                for (int bj = 0; bj < 2; ++bj) {
                    const size_t off = (size_t)row * 1024 + 256 * (u.pn & 3) + 128 * bj + 32 * wc + 8 * fq;
                    const u32x4 gw = *(const u32x4*)(G + off);
                    float v[8];
#pragma unroll
                    for (int j = 0; j < 4; ++j) { v[j] = acc[ai][bj][m][0][j]; v[4 + j] = acc[ai][bj][m][1][j]; }
                    v[0] *= __uint_as_float(gw.x << 16); v[1] *= __uint_as_float(gw.x & 0xffff0000u); v[2] *= __uint_as_float(gw.y << 16); v[3] *= __uint_as_float(gw.y & 0xffff0000u);
                    v[4] *= __uint_as_float(gw.z << 16); v[5] *= __uint_as_float(gw.z & 0xffff0000u); v[6] *= __uint_as_float(gw.w << 16); v[7] *= __uint_as_float(gw.w & 0xffff0000u);
                    if (!second) { *(f32x4*)(P + off) = (f32x4){v[0], v[1], v[2], v[3]}; *(f32x4*)(P + off + 4) = (f32x4){v[4], v[5], v[6], v[7]}; }
                    else { const f32x4 p0 = *(const f32x4*)(P + off), p1 = *(const f32x4*)(P + off + 4);
#pragma unroll
                        for (int j = 0; j < 4; ++j) { v[j] += p0[j]; v[4 + j] += p1[j]; }
                        *(u32x4*)(MIX + off) = pack8(v); }
                }
            }
    }
};

template <bool WITH_XG> struct EpiResid {
    static constexpr bool PERM = false, AFTER_DRAIN = false;
    const float* base; float* out; bf16_t* XG; const float* gw; float* ss;
    __device__ __forceinline__ void operator()(const f32x4 (&acc)[2][2][4][2], const Unit& u, int wr, int wc, int fr, int fq) const {
#pragma unroll
        for (int ai = 0; ai < 2; ++ai)
#pragma unroll
            for (int m = 0; m < 4; ++m) {
                const int row = u.pm * BM + ai * HALF + wr * 64 + m * 16 + fr; float s = 0.f;
#pragma unroll
                for (int bj = 0; bj < 2; ++bj)
#pragma unroll
                    for (int n = 0; n < 2; ++n) {
                        const int col = u.pn * BM + bj * HALF + wc * 32 + n * 16 + 4 * fq; const size_t off = (size_t)row * 1024 + col;
                        const f32x4 v = *(const f32x4*)(base + off) + acc[ai][bj][m][n];
                        *(f32x4*)(out + off) = v; s += (v[0] * v[0] + v[1] * v[1]) + (v[2] * v[2] + v[3] * v[3]);
                        if (WITH_XG) { const f32x4 g = *(const f32x4*)(gw + col); unsigned long long w = (unsigned long long)cvt_pk_bf16(v[0] * g[0], v[1] * g[1]) | ((unsigned long long)cvt_pk_bf16(v[2] * g[2], v[3] * g[3]) << 32);
                            *(unsigned long long*)(XG + off) = w; }
                    }
                s += __shfl_xor(s, 16); s += __shfl_xor(s, 32);
                if (fq == 0) atomicAdd(ss + row, s);
            }
    }
};

struct EpiUp {
    static constexpr bool PERM = true, AFTER_DRAIN = false;
    const float* ss; bf16_t* HID;
    __device__ __forceinline__ void operator()(const f32x4 (&acc)[2][2][4][2], const Unit& u, int wr, int wc, int fr, int fq) const {
#pragma unroll
        for (int ai = 0; ai < 2; ++ai)
#pragma unroll
            for (int m = 0; m < 4; ++m) {
                const int row = u.pm * BM + ai * HALF + wr * 64 + m * 16 + fr;
                const float rs = __builtin_amdgcn_rsqf(ss[row] * (1.0f / 1024.0f) + 1e-6f);
#pragma unroll
                for (int bj = 0; bj < 2; ++bj) {
                    float v[8];
#pragma unroll
                    for (int j = 0; j < 4; ++j) { float a = fmaxf(acc[ai][bj][m][0][j] * rs, 0.f), b = fmaxf(acc[ai][bj][m][1][j] * rs, 0.f); v[j] = a * a; v[4 + j] = b * b; }
                    *(u32x4*)(HID + (size_t)row * 4096 + u.pn * BM + bj * HALF + wc * 32 + 8 * fq) = pack8(v);
                }
            }
    }
};

struct BranchOrder {
    int G, c;
    __device__ __forceinline__ bool next(int i, Unit& u) const {
        const int tile = (i >> 1) * G + c; if (tile >= 128 * 4) return false;
        u.pm = tile >> 2; u.pn = (tile & 3) + 4 * (i & 1); return true;
    }
    __device__ __forceinline__ void a_ready(const Unit&) const {}
    __device__ __forceinline__ void done(const Unit&) const {}
};

template <class Epi, class Sched, bool ALIGN_EPI = false, bool SP2 = false>
__device__ __forceinline__ void gemm_phase(PG8_LAS unsigned char* lds, const Gemm g, const Sched& S, const Epi& E) {
    const int tid = threadIdx.x, wid = __builtin_amdgcn_readfirstlane(tid >> 6), lane = tid & 63, wr = wid >> 2, wc = wid & 3, fr = lane & 15, fq = lane >> 4;
    const int K = g.K, nt = K / BK;
    unsigned voffA[2], voffB[2];
#pragma unroll
    for (int i = 0; i < 2; ++i) { int R, C; stage_rc(tid * 16 + i * 8192, R, C); const int Rb = Epi::PERM ? ((R & ~31) + perm32(R & 31)) : R;
        voffA[i] = (unsigned)(R * K + C) * 2u; voffB[i] = (unsigned)(Rb * K + C) * 2u; }
    const size_t kstep = (size_t)(BK * 2);
    const size_t hstep = (size_t)HALF * K * 2;
    const size_t tstep = 2 * hstep;
    const unsigned ldsw = (unsigned)wid * 1024u;
    const int aoff = lds_byte(wr * 64 + fr, fq * 8), boff = lds_byte(wc * 32 + fr, fq * 8);
#define PG8_SA(b, h) (((b) * 2 + (h)) * HTB)
#define PG8_SB(b, h) ((4 + (b) * 2 + (h)) * HTB)
#define PG8_STAGE(bufoff, gbase, voff) do { _Pragma("unroll") for (int _i = 0; _i < 2; ++_i) \
        __builtin_amdgcn_global_load_lds((const unsigned*)((const char*)(gbase) + (voff)[_i]), (PG8_LAS unsigned*)(lds + (bufoff) + ldsw + _i * 8192), 16, 0, 0); } while (0)
#define PG8_LDA(dst, b, h) do { _Pragma("unroll") for (int m = 0; m < 4; ++m) _Pragma("unroll") for (int k = 0; k < 2; ++k) dst[m][k] = *(const PG8_LAS bf16x8*)(lds + PG8_SA(b, h) + aoff + m * 2048 + k * 1024); } while (0)
#define PG8_LDB(dst, b, h) do { _Pragma("unroll") for (int n = 0; n < 2; ++n) _Pragma("unroll") for (int k = 0; k < 2; ++k) dst[n][k] = *(const PG8_LAS bf16x8*)(lds + PG8_SB(b, h) + boff + n * 2048 + k * 1024); } while (0)
#define PG8_MMA(ai, bj, At, Bt) do { __builtin_amdgcn_s_setprio(1); _Pragma("unroll") for (int m = 0; m < 4; ++m) _Pragma("unroll") for (int n = 0; n < 2; ++n) _Pragma("unroll") for (int k = 0; k < 2; ++k) \
        acc[ai][bj][m][n] = __builtin_amdgcn_mfma_f32_16x16x32_bf16(Bt[n][k], At[m][k], acc[ai][bj][m][n], 0, 0, 0); __builtin_amdgcn_s_setprio(0); } while (0)
#define PG8_WAIT_V(n) asm volatile("s_waitcnt vmcnt(" #n ")" ::: "memory")
#define PG8_WAIT_L(n) asm volatile("s_waitcnt lgkmcnt(" #n ")" ::: "memory")
#define PG8_BAR __builtin_amdgcn_s_barrier()
#define PG8_SCHED __builtin_amdgcn_sched_barrier(0)
    Unit cur, nxt; int ui = 0;
    if (!S.next(0, cur)) return;
    f32x4 acc[2][2][4][2];
#pragma unroll
    for (int a = 0; a < 2; ++a)
#pragma unroll
        for (int b = 0; b < 2; ++b)
#pragma unroll
            for (int m = 0; m < 4; ++m)
#pragma unroll
                for (int n = 0; n < 2; ++n) acc[a][b][m][n] = (f32x4){0.f, 0.f, 0.f, 0.f};
    bf16x8 At[4][2], B0[2][2], B1[2][2];
    const char* cA = g.abase(cur) + (size_t)cur.pm * tstep; const char* cB = (const char*)g.Bt + (size_t)cur.pn * tstep;
    S.a_ready(cur);
    if constexpr (SP2) {
        PG8_STAGE(PG8_SB(0, 0), cB, voffB); PG8_STAGE(PG8_SB(0, 1), cB + hstep, voffB); PG8_STAGE(PG8_SA(0, 0), cA, voffA); PG8_STAGE(PG8_SA(0, 1), cA + hstep, voffA);
        if (wr == 1) PG8_BAR;
        PG8_WAIT_V(2); PG8_BAR;
        PG8_STAGE(PG8_SB(1, 0), cB + kstep, voffB); PG8_STAGE(PG8_SA(1, 0), cA + kstep, voffA); PG8_STAGE(PG8_SB(1, 1), cB + hstep + kstep, voffB);
        PG8_WAIT_V(6); PG8_BAR;
    } else {
        PG8_STAGE(PG8_SB(0, 0), cB, voffB); PG8_STAGE(PG8_SA(0, 0), cA, voffA); PG8_STAGE(PG8_SB(0, 1), cB + hstep, voffB); PG8_STAGE(PG8_SA(0, 1), cA + hstep, voffA);
        if (wr == 1) PG8_BAR;
        PG8_WAIT_V(4); PG8_BAR;
        PG8_STAGE(PG8_SB(1, 0), cB + kstep, voffB); PG8_STAGE(PG8_SA(1, 0), cA + kstep, voffA); PG8_STAGE(PG8_SB(1, 1), cB + hstep + kstep, voffB);
        PG8_WAIT_V(6); PG8_BAR;
    }
    for (;;) {
        const bool has_next = S.next(ui + 1, nxt);
        const char* nA = has_next ? g.abase(nxt) + (size_t)nxt.pm * tstep : cA; const char* nB = has_next ? (const char*)g.Bt + (size_t)nxt.pn * tstep : cB;
        for (int t = 0; t < nt; t += 2) {
            const bool last = (t == nt - 2);
            const char* a1 = cA + (size_t)(t + 1) * kstep;
            const char* a2 = last ? nA : cA + (size_t)(t + 2) * kstep; const char* b2 = last ? nB : cB + (size_t)(t + 2) * kstep;
            const char* a3 = a2 + kstep; const char* b3 = b2 + kstep;
            if (last && has_next) S.a_ready(nxt);
            if constexpr (SP2) {
            PG8_LDB(B0, 0, 0); PG8_LDB(B1, 0, 1); PG8_SCHED; PG8_LDA(At, 0, 0); PG8_STAGE(PG8_SA(1, 1), a1 + hstep, voffA);
            PG8_WAIT_V(8); PG8_WAIT_L(0); PG8_BAR; PG8_MMA(0, 0, At, B0); PG8_MMA(0, 1, At, B1); PG8_BAR; PG8_SCHED;
            PG8_LDA(At, 0, 1); PG8_STAGE(PG8_SB(0, 0), b2, voffB); PG8_STAGE(PG8_SB(0, 1), b2 + hstep, voffB); PG8_STAGE(PG8_SA(0, 0), a2, voffA);
            PG8_WAIT_V(8); PG8_WAIT_L(0); PG8_BAR; PG8_MMA(1, 0, At, B0); PG8_MMA(1, 1, At, B1); PG8_BAR; PG8_SCHED;
            PG8_LDB(B0, 1, 0); PG8_LDB(B1, 1, 1); PG8_SCHED; PG8_LDA(At, 1, 0); PG8_STAGE(PG8_SA(0, 1), a2 + hstep, voffA);
            PG8_WAIT_V(8); PG8_WAIT_L(0); PG8_BAR; PG8_MMA(0, 0, At, B0); PG8_MMA(0, 1, At, B1); PG8_BAR; PG8_SCHED;
            PG8_LDA(At, 1, 1); PG8_STAGE(PG8_SB(1, 0), b3, voffB); PG8_STAGE(PG8_SB(1, 1), b3 + hstep, voffB); PG8_STAGE(PG8_SA(1, 0), a3, voffA);
            PG8_WAIT_V(8); PG8_WAIT_L(0); PG8_BAR; PG8_MMA(1, 0, At, B0); PG8_MMA(1, 1, At, B1); PG8_BAR; PG8_SCHED;
            } else {
            PG8_LDB(B0, 0, 0); PG8_SCHED; PG8_LDA(At, 0, 0); PG8_STAGE(PG8_SA(1, 1), a1 + hstep, voffA);
            PG8_WAIT_L(8); PG8_BAR; PG8_WAIT_L(0); PG8_MMA(0, 0, At, B0); PG8_BAR; PG8_SCHED;
            PG8_LDB(B1, 0, 1); PG8_STAGE(PG8_SB(0, 0), b2, voffB);
            PG8_BAR; PG8_WAIT_L(0); PG8_MMA(0, 1, At, B1); PG8_BAR;
            PG8_LDA(At, 0, 1); PG8_STAGE(PG8_SA(0, 0), a2, voffA);
            PG8_BAR; PG8_WAIT_L(0); PG8_MMA(1, 0, At, B0); PG8_BAR; PG8_SCHED;
            PG8_STAGE(PG8_SB(0, 1), b2 + hstep, voffB);
            PG8_WAIT_V(6); PG8_BAR; PG8_MMA(1, 1, At, B1); PG8_BAR;
            PG8_LDB(B0, 1, 0); PG8_SCHED; PG8_LDA(At, 1, 0); PG8_STAGE(PG8_SA(0, 1), a2 + hstep, voffA);
            PG8_WAIT_L(8); PG8_BAR; PG8_WAIT_L(0); PG8_MMA(0, 0, At, B0); PG8_BAR; PG8_SCHED;
            PG8_LDB(B1, 1, 1); PG8_STAGE(PG8_SB(1, 0), b3, voffB);
            PG8_BAR; PG8_WAIT_L(0); PG8_MMA(0, 1, At, B1); PG8_BAR;
            PG8_LDA(At, 1, 1); PG8_STAGE(PG8_SA(1, 0), a3, voffA);
            PG8_BAR; PG8_WAIT_L(0); PG8_MMA(1, 0, At, B0); PG8_BAR; PG8_SCHED;
            PG8_STAGE(PG8_SB(1, 1), b3 + hstep, voffB);
            PG8_WAIT_V(6); PG8_BAR; PG8_MMA(1, 1, At, B1); PG8_BAR;
            }
        }
        if constexpr (ALIGN_EPI) { if (wr == 0) PG8_BAR; }
        if constexpr (!Epi::AFTER_DRAIN) { E(acc, cur, wr, wc, fr, fq); S.done(cur); }
        if (!has_next) break;
#pragma unroll
        for (int a = 0; a < 2; ++a)
#pragma unroll
            for (int b = 0; b < 2; ++b)
#pragma unroll
                for (int m = 0; m < 4; ++m)
#pragma unroll
                    for (int n = 0; n < 2; ++n) acc[a][b][m][n] = (f32x4){0.f, 0.f, 0.f, 0.f};
        cur = nxt; cA = nA; cB = nB; ++ui;
        if constexpr (ALIGN_EPI) { if (wr == 1) PG8_BAR; }
    }
    PG8_WAIT_V(0);
    if constexpr (!ALIGN_EPI) { if (wr == 0) PG8_BAR; }
    PG8_BAR;
    if constexpr (Epi::AFTER_DRAIN) { E.fused(acc, cur, wr, wc, fr, fq, lds, wid, lane); S.done(cur); }
#undef PG8_SA
#undef PG8_SB
#undef PG8_STAGE
#undef PG8_LDA
#undef PG8_LDB
#undef PG8_MMA
#undef PG8_WAIT_V
#undef PG8_WAIT_L
#undef PG8_BAR
#undef PG8_SCHED
}
}
struct Params {
    const float *x, *attn_norm_w, *w_in, *ikw, *ikb, *sinks, *w_a, *w_b, *w_out, *mlp_norm_w, *w_up, *w_down, *final_w;
    float* out; unsigned char* ws;
    float inv_freq[32];
    int ph_lo, ph_hi;
};
constexpr int NWAVES = 8, NTHREADS = 512;

__device__ __forceinline__ int win_src_group(int grp, int& cnt) {
    const int tile = grp >> 3, g = grp & 7; cnt = 32;
    if (tile < 6) { const int base = tile < 2 ? C_AQ : (tile < 4 ? C_IQ : C_BQ); const int head = 4 * (tile & 1) + (g & 3); return base + head * 64 + 32 * (g >> 2); }
    if (tile < 8) { const int kb = tile == 6 ? C_AK : C_BK, vb = tile == 6 ? C_AV : C_BV; const int hf = g >> 2, q = g & 3;
        if (q < 2) return kb + q * 64 + 32 * hf; return vb + 64 * hf + 32 * (q - 2); }
    if (tile == 8) { if (g == 0) return C_IK; if (g == 4) return C_IK + 32; if (g == 1) { cnt = 8; return C_IW; } cnt = 0; return 0; }
    return C_GA + (grp - 72) * 32;
}
__device__ __forceinline__ void p0_transpose_item(const float* W, int ldw, int c0, int cnt, int K, bf16* WT, int n0, int k0, LAS float* scr, int lane) {
#pragma unroll 8
    for (int i = 0; i < 32; ++i) { const int kk = 2 * i + (lane >> 5), n = lane & 31; scr[kk * 33 + n] = (n < cnt) ? W[(size_t)(k0 + kk) * ldw + c0 + n] : 0.f; }
    asm volatile("s_waitcnt lgkmcnt(0)" ::: "memory");
    const int c = lane & 7;
#pragma unroll
    for (int j = 0; j < 4; ++j) { const int n = (lane >> 3) + 8 * j; const LAS float* s = scr + (8 * c) * 33 + n;
        v4u o; o.x = pk2(s[0 * 33], s[1 * 33]); o.y = pk2(s[2 * 33], s[3 * 33]); o.z = pk2(s[4 * 33], s[5 * 33]); o.w = pk2(s[6 * 33], s[7 * 33]);
        *(v4u*)(WT + (size_t)(n0 + n) * K + k0 + 8 * c) = o; }
    asm volatile("s_waitcnt lgkmcnt(0)" ::: "memory");
}
__device__ __forceinline__ void sincos_d(float angf, float& sn, float& cs) {
    const double a = (double)angf; const double kq = __builtin_rint(a * 0.63661977236758134308);
    const double y = (a - kq * 1.57079632679489655800) - kq * 6.123233995736766e-17; const double y2 = y * y;
    double s = y * (1.0 + y2 * (-1.0 / 6 + y2 * (1.0 / 120 + y2 * (-1.0 / 5040 + y2 * (1.0 / 362880 + y2 * (-1.0 / 39916800 + y2 * (1.0 / 6227020800.0)))))));
    double c = 1.0 + y2 * (-0.5 + y2 * (1.0 / 24 + y2 * (-1.0 / 720 + y2 * (1.0 / 40320 + y2 * (-1.0 / 3628800 + y2 * (1.0 / 479001600.0 + y2 * (-1.0 / 87178291200.0)))))));
    const int q = ((int)kq) & 3;
    const double ss = (q == 0) ? s : (q == 1) ? c : (q == 2) ? -s : -c; const double cc = (q == 0) ? c : (q == 1) ? -s : (q == 2) ? -c : s;
    sn = (float)ss; cs = (float)cc;
}
__device__ __forceinline__ void phase_prologue(const Params& p, LAS unsigned char* lds, int G) {
    const int lane = threadIdx.x & 63, wave = __builtin_amdgcn_readfirstlane(threadIdx.x >> 6);
    unsigned char* ws = p.ws;
    LAS float* scr = (LAS float*)(lds + wave * 16384);
    const int gw = blockIdx.x * NWAVES + wave, NGW = G * NWAVES;
    constexpr int I_IN = (DM / 64) * (NIN / 32), I_A = (512 / 64) * (DM / 32), I_O = (DM / 64) * (DM / 32), I_U = (DM / 64) * (DFF / 32), I_D = (DFF / 64) * (DM / 32);
    constexpr int NITEMS = I_IN + 2 * I_A + I_O + I_U + I_D;
    for (int it = gw; it < NITEMS; it += NGW) {
        int r = it;
        if (r < I_IN) { const int grp = r % (NIN / 32), kb = r / (NIN / 32); int cnt; const int c0 = win_src_group(grp, cnt);
            p0_transpose_item(p.w_in, D_IN, c0, cnt, DM, (bf16*)(ws + WS_WIN), grp * 32, kb * 64, scr, lane); continue; } r -= I_IN;
        if (r < I_A) { const int nb = r % 32, kb = r / 32; p0_transpose_item(p.w_a, DM, nb * 32, 32, 512, (bf16*)(ws + WS_WAB), nb * 32, kb * 64, scr, lane); continue; } r -= I_A;
        if (r < I_A) { const int nb = r % 32, kb = r / 32; p0_transpose_item(p.w_b, DM, nb * 32, 32, 512, (bf16*)(ws + WS_WAB), 1024 + nb * 32, kb * 64, scr, lane); continue; } r -= I_A;
        if (r < I_O) { const int nb = r % 32, kb = r / 32; p0_transpose_item(p.w_out, DM, nb * 32, 32, DM, (bf16*)(ws + WS_WOUT), nb * 32, kb * 64, scr, lane); continue; } r -= I_O;
        if (r < I_U) { const int nb = r % 128, kb = r / 128; p0_transpose_item(p.w_up, DFF, nb * 32, 32, DM, (bf16*)(ws + WS_WUP), nb * 32, kb * 64, scr, lane); continue; } r -= I_U;
        { const int nb = r % 32, kb = r / 32; p0_transpose_item(p.w_down, DM, nb * 32, 32, DFF, (bf16*)(ws + WS_WDN), nb * 32, kb * 64, scr, lane); }
    }
    float* COS = (float*)(ws + WS_COS); float* SIN = (float*)(ws + WS_SIN);
    for (int i = gw * 64 + lane; i < SEQ * 32; i += NGW * 64) { const int pos = i >> 5, d = i & 31; const float ang = (float)pos * p.inv_freq[d]; float s, c; sincos_d(ang, s, c); COS[i] = c; SIN[i] = s; }
    float* RSTD1 = (float*)(ws + WS_RSTD1); float* SS2 = (float*)(ws + WS_SS2); float* SS3 = (float*)(ws + WS_SS3); bf16* XG = (bf16*)(ws + WS_XG);
    v4f g[4];
#pragma unroll
    for (int j = 0; j < 4; ++j) g[j] = *((const v4f*)p.attn_norm_w + lane + 64 * j);
    for (int m = gw; m < TOK; m += NGW) {
        const v4f* xr = (const v4f*)(p.x + (size_t)m * DM) + lane; v4f v[4]; float s = 0.f;
#pragma unroll
        for (int j = 0; j < 4; ++j) { v[j] = xr[64 * j]; s += (v[j].x * v[j].x + v[j].y * v[j].y) + (v[j].z * v[j].z + v[j].w * v[j].w); }
        s = wave_sum(s);
        unsigned long long* o8 = (unsigned long long*)(XG + (size_t)m * DM) + lane;
#pragma unroll
        for (int j = 0; j < 4; ++j) o8[64 * j] = (unsigned long long)pk2(v[j].x * g[j].x, v[j].y * g[j].y) | ((unsigned long long)pk2(v[j].z * g[j].z, v[j].w * g[j].w) << 32);
        if (lane == 0) { RSTD1[m] = frsq(s * (1.0f / DM) + RMS_EPS); SS2[m] = 0.f; SS3[m] = 0.f; }
    }
}

__device__ __forceinline__ unsigned f2key(float f) { const unsigned u = __float_as_uint(f); return (u & 0x80000000u) ? ~u : (u | 0x80000000u); }
__device__ __forceinline__ void phase_topk_simple(const Params& p, LAS unsigned char* lds, int G) {
    const int lane = threadIdx.x & 63, wave = __builtin_amdgcn_readfirstlane(threadIdx.x >> 6);
    unsigned char* ws = p.ws;
    const bf16* IQ = (const bf16*)(ws + WS_IQ); const bf16* IK = (const bf16*)(ws + WS_IK); const float* IW = (const float*)(ws + WS_IW);
    unsigned short* SEL = (unsigned short*)(ws + WS_SEL);
    LAS unsigned* keys = (LAS unsigned*)(lds + wave * 16384);
    LAS float* qf = (LAS float*)(lds + LDS_RING + wave * 2048);
    const int gw = blockIdx.x * NWAVES + wave, NGW = G * NWAVES;
    for (int row = gw; row < TOK; row += NGW) {
        const int b = row >> 12, t = row & 4095, n = t + 1;
        unsigned short* selrow = SEL + (size_t)row * TOPK;
        if (n <= TOPK) { for (int i = lane; i < n; i += 64) selrow[i] = (unsigned short)i; continue; }
        { const v4u q8 = *((const v4u*)(IQ + (size_t)row * 512) + lane);
            LAS float* d = qf + 8 * lane;
            d[0] = bflo(q8.x); d[1] = bfhi(q8.x); d[2] = bflo(q8.y); d[3] = bfhi(q8.y); d[4] = bflo(q8.z); d[5] = bfhi(q8.z); d[6] = bflo(q8.w); d[7] = bfhi(q8.w); }
        float w[8];
#pragma unroll
        for (int h = 0; h < 8; ++h) w[h] = IW[(size_t)row * 8 + h];
        asm volatile("s_waitcnt lgkmcnt(0)" ::: "memory");
        for (int s0 = 0; s0 < n; s0 += 64) {
            const int s = s0 + lane; const int sc = s < n ? s : t;
            const v4u* kp = (const v4u*)(IK + ((size_t)b * SEQ + sc) * 64);
            float dot[8];
#pragma unroll
            for (int h = 0; h < 8; ++h) dot[h] = 0.f;
#pragma unroll
            for (int c = 0; c < 8; ++c) {
                const v4u k8 = kp[c]; float kf[8] = {bflo(k8.x), bfhi(k8.x), bflo(k8.y), bfhi(k8.y), bflo(k8.z), bfhi(k8.z), bflo(k8.w), bfhi(k8.w)};
#pragma unroll
                for (int h = 0; h < 8; ++h) { const v4f qa = *(const LAS v4f*)(qf + h * 64 + c * 8), qb = *(const LAS v4f*)(qf + h * 64 + c * 8 + 4);
                    dot[h] += (kf[0] * qa.x + kf[1] * qa.y) + (kf[2] * qa.z + kf[3] * qa.w) + (kf[4] * qb.x + kf[5] * qb.y) + (kf[6] * qb.z + kf[7] * qb.w); }
            }
            float sc_ = 0.f;
#pragma unroll
            for (int h = 0; h < 8; ++h) sc_ += w[h] * fmaxf(dot[h], 0.f);
            keys[s] = (s < n) ? f2key(sc_) : 0u;
        }
        asm volatile("s_waitcnt lgkmcnt(0)" ::: "memory");
        const int nch = (n + 63) >> 6;
        unsigned thr = 0u;
        for (int bit = 31; bit >= 0; --bit) {
            const unsigned cand = thr | (1u << bit); int cnt = 0;
            for (int c = 0; c < nch; ++c) cnt += __popcll(__ballot(keys[c * 64 + lane] >= cand));
            if (cnt >= TOPK) thr = cand;
        }
        int cgt = 0;
        for (int c = 0; c < nch; ++c) cgt += __popcll(__ballot(keys[c * 64 + lane] > thr));
        const int need = TOPK - cgt; int pos = 0, ties = 0;
        for (int c = 0; c < nch; ++c) {
            const unsigned k = keys[c * 64 + lane]; const bool gt = k > thr, eq = k == thr;
            const unsigned long long meq = __ballot(eq);
            const bool sel = gt || (eq && (ties + mbcnt64(meq) < need));
            const unsigned long long msel = __ballot(sel);
            if (sel) selrow[pos + mbcnt64(msel)] = (unsigned short)(c * 64 + lane);
            pos += __popcll(msel); ties += __popcll(meq);
        }
    }
}

template <bool SINK, class KeyFn>
__device__ __forceinline__ void attend_wave(const bf16* Q, const bf16* K, const bf16* V, bf16* O, int row, int g, int nslots, const KeyFn& keyfn, const float* sinkv,
                                            LAS float* qf  , LAS float* pf  , LAS int* kidx  , int lane) {
    const int b = row >> 12;
    { const v2u q4 = *((const v2u*)(Q + (size_t)row * 512 + g * 256) + lane);
        LAS float* d = qf + 4 * lane; d[0] = bflo(q4.x); d[1] = bfhi(q4.x); d[2] = bflo(q4.y); d[3] = bfhi(q4.y); }
    asm volatile("s_waitcnt lgkmcnt(0)" ::: "memory");
#pragma unroll 1
    for (int j = 0; j < 4; ++j) {
        const int slot = 64 * j + lane; int key = slot < nslots ? keyfn(slot) : -1; kidx[slot] = key;
        const bool valid = key >= 0; const int kc = valid ? key : 0;
        const v4u* kp = (const v4u*)(K + ((size_t)b * SEQ + kc) * 128 + g * 64);
        float dot[4] = {0.f, 0.f, 0.f, 0.f};
        if (64 * j < nslots) {
#pragma unroll 2
            for (int c = 0; c < 8; ++c) {
                const v4u k8 = kp[c]; float kf[8] = {bflo(k8.x), bfhi(k8.x), bflo(k8.y), bfhi(k8.y), bflo(k8.z), bfhi(k8.z), bflo(k8.w), bfhi(k8.w)};
#pragma unroll
                for (int h = 0; h < 4; ++h) { const v4f qa = *(const LAS v4f*)(qf + h * 64 + c * 8), qb = *(const LAS v4f*)(qf + h * 64 + c * 8 + 4);
                    dot[h] += (kf[0] * qa.x + kf[1] * qa.y) + (kf[2] * qa.z + kf[3] * qa.w) + (kf[4] * qb.x + kf[5] * qb.y) + (kf[6] * qb.z + kf[7] * qb.w); }
            }
        }
        *(LAS v4f*)(pf + slot * 4) = valid ? (v4f){dot[0], dot[1], dot[2], dot[3]} : (v4f){-INFINITY, -INFINITY, -INFINITY, -INFINITY};
    }
    asm volatile("s_waitcnt lgkmcnt(0)" ::: "memory");
    float lg[4][4];
#pragma unroll
    for (int j = 0; j < 4; ++j) { const v4f t4 = *(const LAS v4f*)(pf + (64 * j + lane) * 4); lg[j][0] = t4.x; lg[j][1] = t4.y; lg[j][2] = t4.z; lg[j][3] = t4.w; }
    float inv[4];
#pragma unroll
    for (int h = 0; h < 4; ++h) {
        float mx = fmaxf(fmaxf(lg[0][h], lg[1][h]), fmaxf(lg[2][h], lg[3][h])); mx = wave_max(mx);
        float sk = 0.f; if (SINK) { sk = sinkv[g * 4 + h] * LOG2E; mx = fmaxf(mx, sk); }
        float s = 0.f;
#pragma unroll
        for (int j = 0; j < 4; ++j) { const float e = fexp2(lg[j][h] - mx); lg[j][h] = e; s += e; }
        s = wave_sum(s); if (SINK) s += fexp2(sk - mx);
        inv[h] = 1.0f / s;
    }
#pragma unroll
    for (int j = 0; j < 4; ++j) *(LAS v4f*)(pf + (64 * j + lane) * 4) = (v4f){lg[j][0], lg[j][1], lg[j][2], lg[j][3]};
    asm volatile("s_waitcnt lgkmcnt(0)" ::: "memory");
    float o[4] = {0.f, 0.f, 0.f, 0.f};
    const bf16* Vb = V + (size_t)b * SEQ * 128 + g * 64 + lane;
#pragma unroll 1
    for (int s0 = 0; s0 < nslots; s0 += 8) {
        float vv[8]; v4f pp[8];
#pragma unroll
        for (int i = 0; i < 8; ++i) { const int slot = s0 + i; const int key = slot < nslots ? kidx[slot] : -1; pp[i] = *(const LAS v4f*)(pf + (slot & 255) * 4);
            vv[i] = key >= 0 ? bf2f(Vb[(size_t)key * 128]) : 0.f; if (key < 0) pp[i] = (v4f){0.f, 0.f, 0.f, 0.f}; }
#pragma unroll
        for (int i = 0; i < 8; ++i) { o[0] += pp[i].x * vv[i]; o[1] += pp[i].y * vv[i]; o[2] += pp[i].z * vv[i]; o[3] += pp[i].w * vv[i]; }
    }
    bf16* op = O + (size_t)row * 512 + g * 256 + lane;
#pragma unroll
    for (int h = 0; h < 4; ++h) op[h * 64] = (bf16)f2bf(o[h] * inv[h]);
}
struct SelKey { const unsigned short* selrow; __device__ __forceinline__ int operator()(int slot) const { return (int)selrow[slot]; } };
struct WinKey { int t; __device__ __forceinline__ int operator()(int slot) const { return t - (WIN - 1) + slot; } };

template <bool DO_DSA, bool DO_SWA>
__device__ __forceinline__ void phase_attn_simple(const Params& p, LAS unsigned char* lds, int G) {
    const int lane = threadIdx.x & 63, wave = __builtin_amdgcn_readfirstlane(threadIdx.x >> 6);
    unsigned char* ws = p.ws;
    LAS float* qf = (LAS float*)(lds + wave * 16384); LAS float* pf = qf + 256; LAS int* kidx = (LAS int*)(pf + 1024);
    const int gw = blockIdx.x * NWAVES + wave, NGW = G * NWAVES;
    const unsigned short* SEL = (const unsigned short*)(ws + WS_SEL);
    for (int item = gw; item < TOK * 2; item += NGW) {
        const int row = item >> 1, g = item & 1, t = row & 4095;
        if (DO_DSA) { SelKey kf{SEL + (size_t)row * TOPK}; const int ns = (t + 1 < TOPK) ? t + 1 : TOPK;
            attend_wave<false>((const bf16*)(ws + WS_AQ), (const bf16*)(ws + WS_AK), (const bf16*)(ws + WS_AV), (bf16*)(ws + WS_AQ), row, g, ns, kf, nullptr, qf, pf, kidx, lane); }
        if (DO_SWA) { WinKey kf{t};
            attend_wave<true>((const bf16*)(ws + WS_BQ), (const bf16*)(ws + WS_BK), (const bf16*)(ws + WS_BV), (bf16*)(ws + WS_BQ), row, g, WIN, kf, p.sinks, qf, pf, kidx, lane); }
    }
}

__device__ __forceinline__ void phase_final(const Params& p, int G) {
    const int lane = threadIdx.x & 63, wave = __builtin_amdgcn_readfirstlane(threadIdx.x >> 6);
    const float* SS3 = (const float*)(p.ws + WS_SS3);
    const int gw = blockIdx.x * NWAVES + wave, NGW = G * NWAVES;
    v4f g[4];
#pragma unroll
    for (int j = 0; j < 4; ++j) g[j] = *((const v4f*)p.final_w + lane + 64 * j);
    for (int m = gw; m < TOK; m += NGW) {
        const float rs = frsq(SS3[m] * (1.0f / DM) + RMS_EPS);
        v4f* xr = (v4f*)(p.out + (size_t)m * DM) + lane;
#pragma unroll
        for (int j = 0; j < 4; ++j) { v4f v = xr[64 * j]; xr[64 * j] = v * g[j] * rs; }
    }
}

typedef short bf16x8_t __attribute__((ext_vector_type(8)));
typedef float f32x16_t __attribute__((ext_vector_type(16)));
typedef float f32x4_t __attribute__((ext_vector_type(4)));
__device__ __forceinline__ unsigned f16key(float f) { const _Float16 hf = (_Float16)f; const unsigned b = (unsigned)__builtin_bit_cast(unsigned short, hf); return (b & 0x8000u) ? (~b & 0xffffu) : (b | 0x8000u); }
__device__ __forceinline__ int tk_pos(int e) { return 512 * (e >> 9) + 8 * (e & 63) + ((e >> 6) & 7); }

__device__ __forceinline__ void phase_topk_fast(const Params& p, LAS unsigned char* lds, int G) {
    const int tid = threadIdx.x, lane = tid & 63, wave = __builtin_amdgcn_readfirstlane(tid >> 6);
    const int r = lane & 31, h = lane >> 5, mt = wave & 3, par = wave >> 2;
    unsigned char* ws = p.ws;
    const bf16* IQ = (const bf16*)(ws + WS_IQ); const bf16* IK = (const bf16*)(ws + WS_IK); const float* IW = (const float*)(ws + WS_IW);
    unsigned short* SEL = (unsigned short*)(ws + WS_SEL);
    LAS unsigned short* kb = (LAS unsigned short*)lds;
    const int qrow = 4 * mt + 2 * ((r >> 2) & 1) + (r >> 4), qhead = 4 * ((r >> 3) & 1) + (r & 3);
    for (int k = 0;; ++k) {
        int b, tile;
        if (G == 256) { if (k >= 8) break; const int c = blockIdx.x, i = c >> 3, grp = k >> 1; b = c & 7; tile = (k & 1) ? (64 * grp + 63 - i) : (64 * grp + i); }
        else { const int u = blockIdx.x + k * G; if (u >= TOK / 16) break; b = u >> 8; tile = u & 255; }
        const int t0 = tile * 16, R0 = b * SEQ + t0;
        if (t0 + 16 <= TOPK) {
            for (int i = tid; i < 16 * TOPK; i += NTHREADS) { const int ql = i >> 8, s = i & 255; if (s <= t0 + ql) SEL[(size_t)(R0 + ql) * TOPK + s] = (unsigned short)s; }
            continue;
        }
        bf16x8_t aq[4];
#pragma unroll
        for (int s = 0; s < 4; ++s) aq[s] = *(const bf16x8_t*)(IQ + (size_t)(R0 + qrow) * 512 + qhead * 64 + 16 * s + 8 * h);
        float wq[2][8];
#pragma unroll
        for (int qq = 0; qq < 2; ++qq) { const f32x4_t w0 = *(const f32x4_t*)(IW + (size_t)(R0 + 4 * mt + 2 * h + qq) * 8), w1 = *(const f32x4_t*)(IW + (size_t)(R0 + 4 * mt + 2 * h + qq) * 8 + 4);
            wq[qq][0] = w0[0]; wq[qq][1] = w0[1]; wq[qq][2] = w0[2]; wq[qq][3] = w0[3]; wq[qq][4] = w1[0]; wq[qq][5] = w1[1]; wq[qq][6] = w1[2]; wq[qq][7] = w1[3]; }
        const int ntile = (t0 + 16 + 31) >> 5, nch = (t0 + 16 + 511) >> 9;
        const char* kbase = (const char*)IK + (size_t)b * SEQ * 128;
        const unsigned voff = (unsigned)(r * 128 + h * 16);
        const int tq0 = t0 + 4 * mt + 2 * h;
        LAS unsigned short* row0 = kb + (4 * mt + 2 * h) * 4096;
#define TK_LOAD(dst, kt_) do { const char* tp_ = kbase + (size_t)(kt_) * 4096; _Pragma("unroll") for (int s_ = 0; s_ < 4; ++s_) dst[s_] = *(const bf16x8_t*)(tp_ + voff + 32 * s_); } while (0)
#define TK_PROC(src, kt_) do { f32x16_t acc_ = {0.f, 0.f, 0.f, 0.f, 0.f, 0.f, 0.f, 0.f, 0.f, 0.f, 0.f, 0.f, 0.f, 0.f, 0.f, 0.f}; \
            _Pragma("unroll") for (int s_ = 0; s_ < 4; ++s_) acc_ = __builtin_amdgcn_mfma_f32_32x32x16_bf16(aq[s_], src[s_], acc_, 0, 0, 0); \
            float sc0_ = 0.f, sc1_ = 0.f; \
            _Pragma("unroll") for (int hd_ = 0; hd_ < 8; ++hd_) { sc0_ += wq[0][hd_] * fmaxf(acc_[hd_], 0.f); sc1_ += wq[1][hd_] * fmaxf(acc_[8 + hd_], 0.f); } \
            const int e_ = 32 * (kt_) + r; const int pe_ = tk_pos(e_); \
            row0[pe_] = (unsigned short)((e_ <= tq0) ? f16key(sc0_) : 0u); row0[4096 + pe_] = (unsigned short)((e_ <= tq0 + 1) ? f16key(sc1_) : 0u); } while (0)
        {
            bf16x8_t B[4][4];
            const int nmy = (ntile - par + 1) >> 1;
#pragma unroll
            for (int u = 0; u < 4; ++u) if (u < nmy) TK_LOAD(B[u], par + 2 * u);
#pragma unroll 1
            for (int i = 0; i < nmy; i += 4) {
#pragma unroll
                for (int u = 0; u < 4; ++u) if (i + u < nmy) { TK_PROC(B[u], par + 2 * (i + u)); if (i + u + 4 < nmy) TK_LOAD(B[u], par + 2 * (i + u + 4)); }
            }
        }
#undef TK_LOAD
#undef TK_PROC
        { const int e0 = 32 * ntile, cnt = 512 * nch - e0;
            for (int i = tid; i < 16 * cnt; i += NTHREADS) { const int ql = i / cnt, e = e0 + (i - ql * cnt); kb[ql * 4096 + tk_pos(e)] = 0; } }
        __syncthreads();
#pragma unroll 1
        for (int qi = 0; qi < 2; ++qi) {
            const int ql = 2 * wave + qi;
            const LAS unsigned short* rb = kb + ql * 4096 + 8 * lane;
            unsigned thr = 0u;
#pragma unroll 1
            for (int bit = 15; bit >= 0; --bit) {
                const unsigned cand = thr | (1u << bit); int cnt = 0;
#pragma unroll 1
                for (int j = 0; j < nch; ++j) {
                    const v4u w = *(const LAS v4u*)(rb + 512 * j);
                    cnt += __popcll(__ballot((w.x & 0xffffu) >= cand)) + __popcll(__ballot((w.x >> 16) >= cand)) + __popcll(__ballot((w.y & 0xffffu) >= cand)) + __popcll(__ballot((w.y >> 16) >= cand))
                         + __popcll(__ballot((w.z & 0xffffu) >= cand)) + __popcll(__ballot((w.z >> 16) >= cand)) + __popcll(__ballot((w.w & 0xffffu) >= cand)) + __popcll(__ballot((w.w >> 16) >= cand));
                }
                if (cnt >= TOPK) thr = cand;
            }
            int cgt = 0;
#pragma unroll 1
            for (int j = 0; j < nch; ++j) {
                const v4u w = *(const LAS v4u*)(rb + 512 * j);
                cgt += __popcll(__ballot((w.x & 0xffffu) > thr)) + __popcll(__ballot((w.x >> 16) > thr)) + __popcll(__ballot((w.y & 0xffffu) > thr)) + __popcll(__ballot((w.y >> 16) > thr))
                     + __popcll(__ballot((w.z & 0xffffu) > thr)) + __popcll(__ballot((w.z >> 16) > thr)) + __popcll(__ballot((w.w & 0xffffu) > thr)) + __popcll(__ballot((w.w >> 16) > thr));
            }
            const int need = TOPK - cgt; int pos = 0, ties = 0;
            unsigned short* selrow = SEL + (size_t)(R0 + ql) * TOPK;
#pragma unroll 1
            for (int j = 0; j < nch; ++j) {
                const v4u w = *(const LAS v4u*)(rb + 512 * j);
                const unsigned kk[8] = {w.x & 0xffffu, w.x >> 16, w.y & 0xffffu, w.y >> 16, w.z & 0xffffu, w.z >> 16, w.w & 0xffffu, w.w >> 16};
#pragma unroll
                for (int s = 0; s < 8; ++s) {
                    const bool gt = kk[s] > thr, eq = kk[s] == thr;
                    const unsigned long long meq = __ballot(eq);
                    const bool sel = gt || (eq && (ties + mbcnt64(meq) < need));
                    const unsigned long long msel = __ballot(sel);
                    if (sel) selrow[pos + mbcnt64(msel)] = (unsigned short)(512 * j + 64 * s + lane);
                    pos += __popcll(msel); ties += __popcll(meq);
                }
            }
        }
        __syncthreads();
    }
}

typedef short s16x4_t __attribute__((ext_vector_type(4)));
__device__ __forceinline__ s16x4_t tr_read(unsigned addr) { s16x4_t r_; asm volatile("ds_read_b64_tr_b16 %0, %1" : "=v"(r_) : "v"(addr) : "memory"); return r_; }

__device__ __forceinline__ void phase_dsa_fast(const Params& p, LAS unsigned char* lds, int G) {
    const int tid = threadIdx.x, lane = tid & 63, wave = __builtin_amdgcn_readfirstlane(tid >> 6);
    const int c16 = lane & 15, kq = lane >> 4;
    unsigned char* ws = p.ws;
    const bf16* AQ = (const bf16*)(ws + WS_AQ); const bf16* AK = (const bf16*)(ws + WS_AK); const bf16* AV = (const bf16*)(ws + WS_AV); bf16* OA = (bf16*)(ws + WS_AQ);
    const unsigned short* SEL = (const unsigned short*)(ws + WS_SEL);
    LAS unsigned char* wl = lds + wave * 13312;
    LAS unsigned short* sidx = (LAS unsigned short*)wl; LAS unsigned short* Pl = (LAS unsigned short*)(wl + 512); LAS unsigned char* Vl = wl + 2560;
    const unsigned vl_addr = (unsigned)(size_t)Vl;
    const bool arow = (c16 & 3) == 0; const int ahead = c16 >> 2;
    const int nper = (G >= 8 && (G & 7) == 0) ? (G >> 3) * NWAVES : 0;
    for (int it = 0;; ++it) {
        int row;
        if (nper) { const int wi = (blockIdx.x >> 3) * NWAVES + wave, t = wi + it * nper; if (t >= SEQ) break; row = (blockIdx.x & 7) * SEQ + t; }
        else { row = blockIdx.x * NWAVES + wave + it * G * NWAVES; if (row >= TOK) break; }
        const int b = row >> 12, t = row & 4095; const int cnt = (t + 1 < TOPK) ? t + 1 : TOPK;
        { const v2u sv = *((const v2u*)(SEL + (size_t)row * TOPK) + lane);
            const int s0 = 4 * lane; v2u o;
            o.x = ((s0 < cnt) ? (sv.x & 0xffffu) : 0u) | (((s0 + 1 < cnt) ? (sv.x >> 16) : 0u) << 16); o.y = ((s0 + 2 < cnt) ? (sv.y & 0xffffu) : 0u) | (((s0 + 3 < cnt) ? (sv.y >> 16) : 0u) << 16);
            *(LAS v2u*)(sidx + 4 * lane) = o; }
        asm volatile("s_waitcnt lgkmcnt(0)" ::: "memory");
        const bf16* Kb = AK + (size_t)b * SEQ * 128; const bf16* Vb = AV + (size_t)b * SEQ * 128;
#pragma unroll 1
        for (int g = 0; g < 2; ++g) {
            bf16x8_t aq[2];
#pragma unroll
            for (int c = 0; c < 2; ++c) { aq[c] = (bf16x8_t){0, 0, 0, 0, 0, 0, 0, 0}; if (arow) aq[c] = *(const bf16x8_t*)(AQ + (size_t)row * 512 + (4 * g + ahead) * 64 + 32 * c + 8 * kq); }
            float sc[16];
            const bf16* Kg = Kb + g * 64 + 8 * kq;
#pragma unroll
            for (int q4 = 0; q4 < 4; ++q4) {
                bf16x8_t kf[4][2];
#pragma unroll
                for (int u = 0; u < 4; ++u) { const int key = sidx[16 * (4 * q4 + u) + c16]; const bf16* kp = Kg + (size_t)key * 128; kf[u][0] = *(const bf16x8_t*)kp; kf[u][1] = *(const bf16x8_t*)(kp + 32); }
#pragma unroll
                for (int u = 0; u < 4; ++u) { f32x4_t a = {0.f, 0.f, 0.f, 0.f};
                    a = __builtin_amdgcn_mfma_f32_16x16x32_bf16(aq[0], kf[u][0], a, 0, 0, 0); a = __builtin_amdgcn_mfma_f32_16x16x32_bf16(aq[1], kf[u][1], a, 0, 0, 0);
                    sc[4 * q4 + u] = (16 * (4 * q4 + u) + c16 < cnt) ? a[0] : -INFINITY; }
            }
            float mx = sc[0];
#pragma unroll
            for (int i = 1; i < 16; ++i) mx = fmaxf(mx, sc[i]);
            mx = fmaxf(mx, __shfl_xor(mx, 1)); mx = fmaxf(mx, __shfl_xor(mx, 2)); mx = fmaxf(mx, __shfl_xor(mx, 4)); mx = fmaxf(mx, __shfl_xor(mx, 8));
            float sum = 0.f;
#pragma unroll
            for (int i = 0; i < 16; ++i) { sc[i] = fexp2(sc[i] - mx); sum += sc[i]; }
            sum += __shfl_xor(sum, 1); sum += __shfl_xor(sum, 2); sum += __shfl_xor(sum, 4); sum += __shfl_xor(sum, 8);
            const float inv = 1.0f / sum;
#pragma unroll
            for (int i = 0; i < 16; ++i) Pl[kq * 256 + 16 * i + c16] = (unsigned short)f2bf(sc[i]);
            asm volatile("s_waitcnt lgkmcnt(0)" ::: "memory");
            f32x4_t o[4];
#pragma unroll
            for (int dt = 0; dt < 4; ++dt) o[dt] = (f32x4_t){0.f, 0.f, 0.f, 0.f};
            const bf16* Vg = Vb + g * 64 + 8 * (lane & 7);
#pragma unroll 1
            for (int ch = 0; ch < 4; ++ch) {
                v4u vr[8];
#pragma unroll
                for (int i = 0; i < 8; ++i) { const int key = sidx[64 * ch + 8 * i + (lane >> 3)]; vr[i] = *(const v4u*)(Vg + (size_t)key * 128); }
#pragma unroll
                for (int i = 0; i < 8; ++i) *(LAS v4u*)(Vl + (8 * i + (lane >> 3)) * 160 + 16 * (lane & 7)) = vr[i];
                asm volatile("s_waitcnt lgkmcnt(0)" ::: "memory");
#pragma unroll
                for (int hf = 0; hf < 2; ++hf) {
                    bf16x8_t pa = (bf16x8_t){0, 0, 0, 0, 0, 0, 0, 0};
                    if (arow) { const s16x4_t lo = *(const LAS s16x4_t*)(Pl + ahead * 256 + 64 * ch + 32 * hf + 4 * kq), hi = *(const LAS s16x4_t*)(Pl + ahead * 256 + 64 * ch + 32 * hf + 16 + 4 * kq);
                        pa = (bf16x8_t){lo[0], lo[1], lo[2], lo[3], hi[0], hi[1], hi[2], hi[3]}; }
                    const unsigned va = vl_addr + (unsigned)((32 * hf + 4 * kq + (c16 >> 2)) * 160 + 8 * (c16 & 3));
                    s16x4_t vlo[4], vhi[4];
#pragma unroll
                    for (int dt = 0; dt < 4; ++dt) { vlo[dt] = tr_read(va + 32 * dt); vhi[dt] = tr_read(va + 16 * 160 + 32 * dt); }
                    asm volatile("s_waitcnt lgkmcnt(0)" : "+v"(vlo[0]), "+v"(vlo[1]), "+v"(vlo[2]), "+v"(vlo[3]), "+v"(vhi[0]), "+v"(vhi[1]), "+v"(vhi[2]), "+v"(vhi[3]) :: "memory");
                    __builtin_amdgcn_sched_barrier(0);
#pragma unroll
                    for (int dt = 0; dt < 4; ++dt) { const bf16x8_t vb = (bf16x8_t){vlo[dt][0], vlo[dt][1], vlo[dt][2], vlo[dt][3], vhi[dt][0], vhi[dt][1], vhi[dt][2], vhi[dt][3]};
                        o[dt] = __builtin_amdgcn_mfma_f32_16x16x32_bf16(pa, vb, o[dt], 0, 0, 0); }
                }
                asm volatile("s_waitcnt lgkmcnt(0)" ::: "memory");
            }
            bf16* op = OA + (size_t)row * 512 + (4 * g + kq) * 64 + c16;
#pragma unroll
            for (int dt = 0; dt < 4; ++dt) op[16 * dt] = (bf16)f2bf(o[dt][0] * inv);
        }
    }
}

constexpr int NPHASE = 9;
__global__ void __launch_bounds__(NTHREADS, 2) mk_fwd(Params p) {
    extern __shared__ __attribute__((aligned(16))) unsigned char lds_raw[];
    LAS unsigned char* lds = (LAS unsigned char*)lds_raw;
    const int G = gridDim.x;
    unsigned char* ws = p.ws;
#if MK_ONE_LAUNCH
#define SEAM(k) do { if (lo <= (k) && (k) + 1 < hi) cg::this_grid().sync(); } while (0)
#else
#define SEAM(k) do { } while (0)
#endif
    const int lo = p.ph_lo, hi = p.ph_hi;
#ifndef PHMASK
#define PHMASK 0x1ffu
#endif
#define IN(k) (((PHMASK >> (k)) & 1u) && lo <= (k) && (k) < hi)
    if (IN(0)) { phase_prologue(p, lds, G); SEAM(0); }
    if (IN(1)) {
        pg8::Gemm g{(const bf16*)(ws + WS_XG), (const bf16*)(ws + WS_WIN), TOK, NIN, DM, nullptr, 1 << 30};
        pg8::StaticOrder S; S.init(TOK, NIN, G, (int)blockIdx.x);
        pg8::EpiInProj E{(const float*)(ws + WS_RSTD1), (const float*)(ws + WS_COS), (const float*)(ws + WS_SIN), ws, p.ikw, p.ikb};
        pg8::gemm_phase<pg8::EpiInProj, pg8::StaticOrder, true, true>(lds, g, S, E);
        SEAM(1);
    }
#if MK_SIMPLE_TOPK
    if (IN(2)) { phase_topk_simple(p, lds, G); SEAM(2); }
#else
    if (IN(2)) { phase_topk_fast(p, lds, G); SEAM(2); }
#endif
#if MK_SIMPLE_DSA
    if (IN(3)) { phase_attn_simple<true, true>(p, lds, G); SEAM(3); }
#else
    if (IN(3)) { phase_dsa_fast(p, lds, G); __syncthreads(); phase_attn_simple<false, true>(p, lds, G); SEAM(3); }
#endif
    if (IN(4)) {
        pg8::Gemm g{(const bf16*)(ws + WS_AQ), (const bf16*)(ws + WS_WAB), TOK, 2048, 512, (const bf16*)(ws + WS_BQ), 4};
        pg8::BranchOrder S{G, (int)blockIdx.x};
        pg8::EpiGate E{(const bf16*)(ws + WS_GA), (const bf16*)(ws + WS_GB), p.out, (bf16*)(ws + WS_MIX)};
        pg8::gemm_phase<pg8::EpiGate, pg8::BranchOrder, true, true>(lds, g, S, E);
        SEAM(4);
    }
    if (IN(5)) {
        pg8::Gemm g{(const bf16*)(ws + WS_MIX), (const bf16*)(ws + WS_WOUT), TOK, DM, DM, nullptr, 1 << 30};
        pg8::StaticOrder S; S.init(TOK, DM, G, (int)blockIdx.x);
        pg8::EpiResid<true> E{p.x, p.out, (bf16*)(ws + WS_XG), p.mlp_norm_w, (float*)(ws + WS_SS2)};
        pg8::gemm_phase<pg8::EpiResid<true>, pg8::StaticOrder, true, true>(lds, g, S, E);
        SEAM(5);
    }
    if (IN(6)) {
        pg8::Gemm g{(const bf16*)(ws + WS_XG), (const bf16*)(ws + WS_WUP), TOK, DFF, DM, nullptr, 1 << 30};
        pg8::StaticOrder S; S.init(TOK, DFF, G, (int)blockIdx.x);
        pg8::EpiUp E{(const float*)(ws + WS_SS2), (bf16*)(ws + WS_HID)};
        pg8::gemm_phase<pg8::EpiUp, pg8::StaticOrder, true, true>(lds, g, S, E);
        SEAM(6);
    }
    if (IN(7)) {
        pg8::Gemm g{(const bf16*)(ws + WS_HID), (const bf16*)(ws + WS_WDN), TOK, DM, DFF, nullptr, 1 << 30};
        pg8::StaticOrder S; S.init(TOK, DM, G, (int)blockIdx.x);
        pg8::EpiResid<false> E{p.out, p.out, nullptr, nullptr, (float*)(ws + WS_SS3)};
        pg8::gemm_phase<pg8::EpiResid<false>, pg8::StaticOrder, true, true>(lds, g, S, E);
        SEAM(7);
    }
    if (IN(8)) { phase_final(p, G); }
#undef IN
#undef SEAM
}

extern "C" void kernel_launch(void* const* d_in, const int* in_sizes, int n_in, void* d_out, int out_size, void* d_ws, size_t ws_size, hipStream_t stream) {
    static int grid = 0;
    if (grid == 0) {
        if (n_in != 13 || in_sizes[0] != TOK * DM || out_size != TOK * DM || ws_size < WS_END) {
            fprintf(stderr, "kernel_launch: unexpected shapes (n_in %d, in0 %d, out %d, ws %zu); nothing launched\n", n_in, n_in > 0 ? in_sizes[0] : -1, out_size, ws_size); grid = -1; return; }
        int dev = 0, cus = 0, per_cu = 0;
        (void)hipGetDevice(&dev); (void)hipDeviceGetAttribute(&cus, hipDeviceAttributeMultiprocessorCount, dev);
        if (hipFuncSetAttribute((const void*)mk_fwd, hipFuncAttributeMaxDynamicSharedMemorySize, LDS_BYTES) != hipSuccess) { fprintf(stderr, "kernel_launch: hipFuncSetAttribute failed\n"); grid = -1; return; }
        if (hipOccupancyMaxActiveBlocksPerMultiprocessor(&per_cu, (const void*)mk_fwd, NTHREADS, LDS_BYTES) != hipSuccess || per_cu < 1) { fprintf(stderr, "kernel_launch: occupancy query says %d blocks per CU\n", per_cu); per_cu = 1; }
        (void)hipGetLastError();
        if (per_cu > 1) per_cu = 1;
        grid = cus * per_cu;
    }
    if (grid < 0) return;
    Params p{};
    p.x = (const float*)d_in[0]; p.attn_norm_w = (const float*)d_in[1]; p.w_in = (const float*)d_in[2]; p.ikw = (const float*)d_in[3]; p.ikb = (const float*)d_in[4];
    p.sinks = (const float*)d_in[5]; p.w_a = (const float*)d_in[6]; p.w_b = (const float*)d_in[7]; p.w_out = (const float*)d_in[8]; p.mlp_norm_w = (const float*)d_in[9];
    p.w_up = (const float*)d_in[10]; p.w_down = (const float*)d_in[11]; p.final_w = (const float*)d_in[12];
    p.out = (float*)d_out; p.ws = (unsigned char*)d_ws;
    for (int i = 0; i < 32; ++i) p.inv_freq[i] = 1.0f / powf(10000.0f, (float)(2 * i) / 64.0f);
#if MK_ONE_LAUNCH
    p.ph_lo = 0; p.ph_hi = NPHASE;
    void* args[] = {&p};
    hipError_t e = hipLaunchCooperativeKernel((const void*)mk_fwd, dim3(grid), dim3(NTHREADS), args, LDS_BYTES, stream);
    if (e != hipSuccess) fprintf(stderr, "kernel_launch: cooperative launch failed: %s (grid %d)\n", hipGetErrorString(e), grid);
#else
    for (int ph = 0; ph < NPHASE; ++ph) {
        p.ph_lo = ph; p.ph_hi = ph + 1;
        hipLaunchKernelGGL(mk_fwd, dim3(grid), dim3(NTHREADS), LDS_BYTES, stream, p);
    }
#endif
}
```

```cpp
#include <hip/hip_runtime.h>
#include <hip/hip_cooperative_groups.h>
#include <cstdio>
#include <cstdint>
namespace cg = cooperative_groups;

#ifndef MK_ONE_LAUNCH
#define MK_ONE_LAUNCH 1
#endif
#ifndef MK_SIMPLE_TOPK
#define MK_SIMPLE_TOPK 0
#endif
#ifndef MK_SIMPLE_SWA
#define MK_SIMPLE_SWA 0
#endif
#ifndef MK_SIMPLE_DSA
#define MK_SIMPLE_DSA 0
#endif

constexpr int NBATCH = 8, SEQ = 4096, DM = 1024, TOK = NBATCH * SEQ, DFF = 4096, TOPK = 256, WIN = 128;
constexpr int NIN = 4352;
constexpr float RMS_EPS = 1e-6f, LN_EPS = 1e-6f;
constexpr float QSCALE = 0.125f * 1.4426950408889634f;
constexpr float LOG2E = 1.4426950408889634f;
constexpr float W_SCALE = 0.04419417382415922f;
constexpr int C_AQ = 0, C_AK = 512, C_AV = 640, C_IQ = 768, C_IK = 1280, C_IW = 1344, C_BQ = 1352, C_BK = 1864, C_BV = 1992, C_GA = 2120, C_GB = 3144, D_IN = 4168;

constexpr size_t MiB = 1u << 20;
constexpr size_t WS_RSTD1 = 0, WS_SS2 = 128 * 1024, WS_SS3 = 256 * 1024;
constexpr size_t WS_COS = 1 * MiB, WS_SIN = 1 * MiB + 512 * 1024;
constexpr size_t WS_WIN = 2 * MiB, WS_WAB = 11 * MiB, WS_WOUT = 13 * MiB, WS_WUP = 15 * MiB, WS_WDN = 23 * MiB;
constexpr size_t WS_XG = 32 * MiB;
constexpr size_t WS_AQ = 96 * MiB, WS_IQ = 128 * MiB, WS_BQ = 160 * MiB, WS_AK = 192 * MiB, WS_AV = 200 * MiB, WS_BK = 208 * MiB, WS_BV = 216 * MiB;
constexpr size_t WS_IK = 224 * MiB, WS_IW = 228 * MiB, WS_SEL = 230 * MiB, WS_GA = 248 * MiB, WS_GB = 312 * MiB, WS_MIX = 376 * MiB, WS_END = 440 * MiB;
constexpr size_t WS_HID = 96 * MiB;
static_assert(WS_WIN + (size_t)NIN * DM * 2 <= WS_WAB && WS_HID + (size_t)TOK * DFF * 2 <= WS_MIX, "ws map");

constexpr int LDS_RING = 131072, LDS_BYTES = 147456;

#define GAS __attribute__((address_space(1)))
#define LAS __attribute__((address_space(3)))
typedef unsigned short bf16;
typedef unsigned v4u __attribute__((ext_vector_type(4)));
typedef unsigned v2u __attribute__((ext_vector_type(2)));
typedef float v4f __attribute__((ext_vector_type(4)));

__device__ __forceinline__ float bf2f(unsigned short u) { return __uint_as_float((unsigned)u << 16); }
__device__ __forceinline__ float bflo(unsigned u) { return __uint_as_float(u << 16); }
__device__ __forceinline__ float bfhi(unsigned u) { return __uint_as_float(u & 0xffff0000u); }
__device__ __forceinline__ unsigned f2bf(float f) { unsigned u = __float_as_uint(f); return (u + 0x7fffu + ((u >> 16) & 1u)) >> 16; }
__device__ __forceinline__ unsigned pk2(float lo, float hi) { unsigned r; asm volatile("v_cvt_pk_bf16_f32 %0, %1, %2" : "=v"(r) : "v"(lo), "v"(hi)); return r; }
__device__ __forceinline__ float fexp2(float x) { return __builtin_amdgcn_exp2f(x); }
__device__ __forceinline__ float frsq(float x) { return __builtin_amdgcn_rsqf(x); }
__device__ __forceinline__ float frcp(float x) { return __builtin_amdgcn_rcpf(x); }
__device__ __forceinline__ float sigmoidf_(float x) { return frcp(1.0f + fexp2(-x * LOG2E)); }
__device__ __forceinline__ float wave_sum(float v) {
#pragma unroll
    for (int o = 1; o < 64; o <<= 1) v += __shfl_xor(v, o);
    return v;
}
__device__ __forceinline__ float wave_max(float v) {
#pragma unroll
    for (int o = 1; o < 64; o <<= 1) v = fmaxf(v, __shfl_xor(v, o));
    return v;
}
__device__ __forceinline__ int mbcnt64(unsigned long long m) { return __builtin_amdgcn_mbcnt_hi((unsigned)(m >> 32), __builtin_amdgcn_mbcnt_lo((unsigned)m, 0u)); }

namespace pg8 {
#define PG8_LAS __attribute__((address_space(3)))
typedef unsigned short bf16_t;
typedef short bf16x8 __attribute__((ext_vector_type(8)));
typedef float f32x4 __attribute__((ext_vector_type(4)));
typedef unsigned u32x4 __attribute__((ext_vector_type(4)));
constexpr int BM = 256, BK = 64, HALF = 128, HTB = HALF * BK * 2  , STAGE_BYTES = 8 * HTB, NXCD = 8, WGM = 8;

__host__ __device__ __forceinline__ int lds_byte(int r, int c) { const int st = (r >> 4) * 2 + (c >> 5), rr = r & 15, cc = c & 31, ob = rr * 64 + cc * 2; return st * 1024 + (ob ^ (((ob >> 9) & 1) << 5)); }
__host__ __device__ __forceinline__ void stage_rc(int b, int& R, int& C) { const int st = b / 1024, sb = b % 1024, swz = sb ^ (((sb >> 9) & 1) << 5); R = (st >> 1) * 16 + swz / 64; C = (st & 1) * 32 + (swz % 64) / 2; }
__host__ __device__ __forceinline__ int perm32(int rho) { const int n = rho >> 4, i = rho & 15; return 8 * (i >> 2) + 4 * n + (i & 3); }

struct Unit { int pm, pn; };
struct Gemm { const bf16_t* A; const bf16_t* Bt; int M, N, K; const bf16_t* A2; int asplit;
    __device__ __forceinline__ const char* abase(const Unit& u) const { return (const char*)(u.pn >= asplit ? A2 : A); } };

struct StaticOrder {
    int nM, nN, nwg, G, c;
    __host__ __device__ void init(int M, int N, int G_, int c_) { nM = M / BM; nN = N / BM; nwg = nM * nN; G = G_; c = c_; }
    __host__ __device__ bool next(int i, Unit& u) const {
        const long L = (long)i * G + c; if (L >= nwg) return false;
        int wgid = (int)L; { const int q = nwg / NXCD, r = nwg % NXCD, xcd = wgid % NXCD, off = wgid / NXCD; wgid = (xcd < r ? xcd * (q + 1) : r * (q + 1) + (xcd - r) * q) + off; }
        const int nig = WGM * nN, gid = wgid / nig, fm = gid * WGM, gsz = (nM - fm) < WGM ? (nM - fm) : WGM;
        u.pm = fm + ((wgid % nig) % gsz); u.pn = (wgid % nig) / gsz; return true;
    }
    __device__ __forceinline__ void a_ready(const Unit&) const {}
    __device__ __forceinline__ void done(const Unit&) const {}
};

__device__ __forceinline__ unsigned cvt_pk_bf16(float lo, float hi) { unsigned r; asm volatile("v_cvt_pk_bf16_f32 %0, %1, %2" : "=v"(r) : "v"(lo), "v"(hi)); return r; }
__device__ __forceinline__ u32x4 pack8(const float (&v)[8]) { u32x4 w; w.x = cvt_pk_bf16(v[0], v[1]); w.y = cvt_pk_bf16(v[2], v[3]); w.z = cvt_pk_bf16(v[4], v[5]); w.w = cvt_pk_bf16(v[6], v[7]); return w; }

struct EpiInProj {
    static constexpr bool PERM = true, AFTER_DRAIN = false;
    const float* rstd1; const float* cs; const float* sn; unsigned char* ws; const float* ikw; const float* ikb;
    __device__ __forceinline__ void operator()(const f32x4 (&acc)[2][2][4][2], const Unit& u, int wr, int wc, int fr_, int fq_) const {
        const int pn = u.pn; int fr = fr_, fq = fq_;
        asm volatile("" : "+v"(fr), "+v"(fq));
#pragma unroll
        for (int ai = 0; ai < 2; ++ai)
#pragma unroll
            for (int m = 0; m < 4; ++m) {
                const int row = u.pm * BM + ai * HALF + wr * 64 + m * 16 + fr;
                const float rs = rstd1[row];
                float x1[8], x2[8];
#pragma unroll
                for (int j = 0; j < 4; ++j) { x1[j] = acc[ai][0][m][0][j] * rs; x1[4 + j] = acc[ai][0][m][1][j] * rs; x2[j] = acc[ai][1][m][0][j] * rs; x2[4 + j] = acc[ai][1][m][1][j] * rs; }
                if (pn >= 9) {
                    bf16_t* G = (bf16_t*)(ws + WS_GA + (size_t)((pn - 9) >> 2) * (WS_GB - WS_GA)) + (size_t)row * 1024 + 256 * ((pn - 9) & 3) + 32 * wc + 8 * fq;
                    float a[8], b[8];
#pragma unroll
                    for (int j = 0; j < 8; ++j) { a[j] = 1.0f / (1.0f + __builtin_amdgcn_exp2f(-x1[j] * 1.4426950408889634f)); b[j] = 1.0f / (1.0f + __builtin_amdgcn_exp2f(-x2[j] * 1.4426950408889634f)); }
                    *(u32x4*)G = pack8(a); *(u32x4*)(G + 128) = pack8(b);
                } else if (pn == 8) {
                    if (wc == 0) {
                        float s = 0.f;
#pragma unroll
                        for (int j = 0; j < 8; ++j) s += x1[j] + x2[j];
                        s += __shfl_xor(s, 16); s += __shfl_xor(s, 32);
                        const float mu = s * (1.0f / 64.0f); float q = 0.f;
#pragma unroll
                        for (int j = 0; j < 8; ++j) { x1[j] -= mu; x2[j] -= mu; q += x1[j] * x1[j] + x2[j] * x2[j]; }
                        q += __shfl_xor(q, 16); q += __shfl_xor(q, 32);
                        const float rstd = __builtin_amdgcn_rsqf(q * (1.0f / 64.0f) + 1e-6f);
                        const int pos = row & 4095; const float* cp = cs + pos * 32 + 8 * fq; const float* sp = sn + pos * 32 + 8 * fq;
                        float o1[8], o2[8];
#pragma unroll
                        for (int j = 0; j < 8; ++j) { const float y1 = x1[j] * rstd * ikw[8 * fq + j] + ikb[8 * fq + j], y2 = x2[j] * rstd * ikw[32 + 8 * fq + j] + ikb[32 + 8 * fq + j];
                            const float c = cp[j], sI = sp[j]; o1[j] = y1 * c - y2 * sI; o2[j] = y2 * c + y1 * sI; }
                        bf16_t* dst = (bf16_t*)(ws + WS_IK) + (size_t)row * 64 + 8 * fq;
                        *(u32x4*)dst = pack8(o1); *(u32x4*)(dst + 32) = pack8(o2);
                    } else if (wc == 1 && fq == 0) {
                        float* dst = (float*)(ws + WS_IW) + (size_t)row * 8;
                        *(f32x4*)dst = (f32x4){x1[0], x1[1], x1[2], x1[3]} * 0.04419417382415922f; *(f32x4*)(dst + 4) = (f32x4){x1[4], x1[5], x1[6], x1[7]} * 0.04419417382415922f;
                    }
                } else if (pn >= 6) {
                    bf16_t* Kd = (bf16_t*)(ws + WS_AK + (size_t)(pn - 6) * (WS_BK - WS_AK)); bf16_t* Vd = (bf16_t*)(ws + WS_AV + (size_t)(pn - 6) * (WS_BV - WS_AV));
                    if (wc < 2) {
                        const int pos = row & 4095; const float* cp = cs + pos * 32 + 8 * fq; const float* sp = sn + pos * 32 + 8 * fq;
                        float o1[8], o2[8];
#pragma unroll
                        for (int j = 0; j < 8; ++j) { const float c = cp[j], sI = sp[j]; o1[j] = x1[j] * c - x2[j] * sI; o2[j] = x2[j] * c + x1[j] * sI; }
                        bf16_t* dst = Kd + (size_t)row * 128 + wc * 64 + 8 * fq;
                        *(u32x4*)dst = pack8(o1); *(u32x4*)(dst + 32) = pack8(o2);
                    } else {
                        bf16_t* dst = Vd + (size_t)row * 128 + 32 * (wc - 2) + 8 * fq;
                        *(u32x4*)dst = pack8(x1); *(u32x4*)(dst + 64) = pack8(x2);
                    }
                } else {
                    bf16_t* Q = (bf16_t*)(ws + WS_AQ + (size_t)(pn >> 1) * (WS_IQ - WS_AQ)); const float sc = (pn >= 2 && pn < 4) ? 1.0f : 0.125f * 1.4426950408889634f;
                    const int pos = row & 4095; const float* cp = cs + pos * 32 + 8 * fq; const float* sp = sn + pos * 32 + 8 * fq;
                    float o1[8], o2[8];
#pragma unroll
                    for (int j = 0; j < 8; ++j) { const float c = cp[j], sI = sp[j]; o1[j] = (x1[j] * c - x2[j] * sI) * sc; o2[j] = (x2[j] * c + x1[j] * sI) * sc; }
                    bf16_t* dst = Q + (size_t)row * 512 + (4 * (pn & 1) + wc) * 64 + 8 * fq;
                    *(u32x4*)dst = pack8(o1); *(u32x4*)(dst + 32) = pack8(o2);
                }
                asm volatile("" ::: "memory");
            }
    }
};

struct EpiGate {
    static constexpr bool PERM = true, AFTER_DRAIN = false;
    const bf16_t *GA, *GB; float* P; bf16_t* MIX;
    __device__ __forceinline__ void operator()(const f32x4 (&acc)[2][2][4][2], const Unit& u, int wr, int wc, int fr, int fq) const {
        const bool second = u.pn >= 4; const bf16_t* G = second ? GB : GA;
#pragma unroll
        for (int ai = 0; ai < 2; ++ai)
#pragma unroll
            for (int m = 0; m < 4; ++m) {
                const int row = u.pm * BM + ai * HALF + wr * 64 + m * 16 + fr;
#pragma unroll
                for (int bj = 0; bj < 2; ++bj) {
                    const size_t off = (size_t)row * 1024 + 256 * (u.pn & 3) + 128 * bj + 32 * wc + 8 * fq;
                    const u32x4 gw = *(const u32x4*)(G + off);
                    float v[8];
#pragma unroll
                    for (int j = 0; j < 4; ++j) { v[j] = acc[ai][bj][m][0][j]; v[4 + j] = acc[ai][bj][m][1][j]; }
                    v[0] *= __uint_as_float(gw.x << 16); v[1] *= __uint_as_float(gw.x & 0xffff0000u); v[2] *= __uint_as_float(gw.y << 16); v[3] *= __uint_as_float(gw.y & 0xffff0000u);
                    v[4] *= __uint_as_float(gw.z << 16); v[5] *= __uint_as_float(gw.z & 0xffff0000u); v[6] *= __uint_as_float(gw.w << 16); v[7] *= __uint_as_float(gw.w & 0xffff0000u);
                    if (!second) { *(f32x4*)(P + off) = (f32x4){v[0], v[1], v[2], v[3]}; *(f32x4*)(P + off + 4) = (f32x4){v[4], v[5], v[6], v[7]}; }
                    else { const f32x4 p0 = *(const f32x4*)(P + off), p1 = *(const f32x4*)(P + off + 4);
#pragma unroll
                        for (int j = 0; j < 4; ++j) { v[j] += p0[j]; v[4 + j] += p1[j]; }
                        *(u32x4*)(MIX + off) = pack8(v); }
                }
            }
    }
};

template <bool WITH_XG> struct EpiResid {
    static constexpr bool PERM = false, AFTER_DRAIN = false;
    const float* base; float* out; bf16_t* XG; const float* gw; float* ss;
    __device__ __forceinline__ void operator()(const f32x4 (&acc)[2][2][4][2], const Unit& u, int wr, int wc, int fr, int fq) const {
#pragma unroll
        for (int ai = 0; ai < 2; ++ai)
#pragma unroll
            for (int m = 0; m < 4; ++m) {
                const int row = u.pm * BM + ai * HALF + wr * 64 + m * 16 + fr; float s = 0.f;
#pragma unroll
                for (int bj = 0; bj < 2; ++bj)
#pragma unroll
                    for (int n = 0; n < 2; ++n) {
                        const int col = u.pn * BM + bj * HALF + wc * 32 + n * 16 + 4 * fq; const size_t off = (size_t)row * 1024 + col;
                        const f32x4 v = *(const f32x4*)(base + off) + acc[ai][bj][m][n];
                        *(f32x4*)(out + off) = v; s += (v[0] * v[0] + v[1] * v[1]) + (v[2] * v[2] + v[3] * v[3]);
                        if (WITH_XG) { const f32x4 g = *(const f32x4*)(gw + col); unsigned long long w = (unsigned long long)cvt_pk_bf16(v[0] * g[0], v[1] * g[1]) | ((unsigned long long)cvt_pk_bf16(v[2] * g[2], v[3] * g[3]) << 32);
                            *(unsigned long long*)(XG + off) = w; }
                    }
                s += __shfl_xor(s, 16); s += __shfl_xor(s, 32);
                if (fq == 0) atomicAdd(ss + row, s);
            }
    }
};

struct EpiUp {
    static constexpr bool PERM = true, AFTER_DRAIN = false;
    const float* ss; bf16_t* HID;
    __device__ __forceinline__ void operator()(const f32x4 (&acc)[2][2][4][2], const Unit& u, int wr, int wc, int fr, int fq) const {
#pragma unroll
        for (int ai = 0; ai < 2; ++ai)
#pragma unroll
            for (int m = 0; m < 4; ++m) {
                const int row = u.pm * BM + ai * HALF + wr * 64 + m * 16 + fr;
                const float rs = __builtin_amdgcn_rsqf(ss[row] * (1.0f / 1024.0f) + 1e-6f);
#pragma unroll
                for (int bj = 0; bj < 2; ++bj) {
                    float v[8];
#pragma unroll
                    for (int j = 0; j < 4; ++j) { float a = fmaxf(acc[ai][bj][m][0][j] * rs, 0.f), b = fmaxf(acc[ai][bj][m][1][j] * rs, 0.f); v[j] = a * a; v[4 + j] = b * b; }
                    *(u32x4*)(HID + (size_t)row * 4096 + u.pn * BM + bj * HALF + wc * 32 + 8 * fq) = pack8(v);
                }
            }
    }
};

struct BranchOrder {
    int G, c;
    __device__ __forceinline__ bool next(int i, Unit& u) const {
        const int tile = (i >> 1) * G + c; if (tile >= 128 * 4) return false;
        u.pm = tile >> 2; u.pn = (tile & 3) + 4 * (i & 1); return true;
    }
    __device__ __forceinline__ void a_ready(const Unit&) const {}
    __device__ __forceinline__ void done(const Unit&) const {}
};

template <class Epi, class Sched, bool ALIGN_EPI = false, bool SP2 = false>
__device__ __forceinline__ void gemm_phase(PG8_LAS unsigned char* lds, const Gemm g, const Sched& S, const Epi& E) {
    const int tid = threadIdx.x, wid = __builtin_amdgcn_readfirstlane(tid >> 6), lane = tid & 63, wr = wid >> 2, wc = wid & 3, fr = lane & 15, fq = lane >> 4;
    const int K = g.K, nt = K / BK;
    unsigned voffA[2], voffB[2];
#pragma unroll
    for (int i = 0; i < 2; ++i) { int R, C; stage_rc(tid * 16 + i * 8192, R, C); const int Rb = Epi::PERM ? ((R & ~31) + perm32(R & 31)) : R;
        voffA[i] = (unsigned)(R * K + C) * 2u; voffB[i] = (unsigned)(Rb * K + C) * 2u; }
    const size_t kstep = (size_t)(BK * 2);
    const size_t hstep = (size_t)HALF * K * 2;
    const size_t tstep = 2 * hstep;
    const unsigned ldsw = (unsigned)wid * 1024u;
    const int aoff = lds_byte(wr * 64 + fr, fq * 8), boff = lds_byte(wc * 32 + fr, fq * 8);
#define PG8_SA(b, h) (((b) * 2 + (h)) * HTB)
#define PG8_SB(b, h) ((4 + (b) * 2 + (h)) * HTB)
#define PG8_STAGE(bufoff, gbase, voff) do { _Pragma("unroll") for (int _i = 0; _i < 2; ++_i) \
        __builtin_amdgcn_global_load_lds((const unsigned*)((const char*)(gbase) + (voff)[_i]), (PG8_LAS unsigned*)(lds + (bufoff) + ldsw + _i * 8192), 16, 0, 0); } while (0)
#define PG8_LDA(dst, b, h) do { _Pragma("unroll") for (int m = 0; m < 4; ++m) _Pragma("unroll") for (int k = 0; k < 2; ++k) dst[m][k] = *(const PG8_LAS bf16x8*)(lds + PG8_SA(b, h) + aoff + m * 2048 + k * 1024); } while (0)
#define PG8_LDB(dst, b, h) do { _Pragma("unroll") for (int n = 0; n < 2; ++n) _Pragma("unroll") for (int k = 0; k < 2; ++k) dst[n][k] = *(const PG8_LAS bf16x8*)(lds + PG8_SB(b, h) + boff + n * 2048 + k * 1024); } while (0)
#define PG8_MMA(ai, bj, At, Bt) do { __builtin_amdgcn_s_setprio(1); _Pragma("unroll") for (int m = 0; m < 4; ++m) _Pragma("unroll") for (int n = 0; n < 2; ++n) _Pragma("unroll") for (int k = 0; k < 2; ++k) \
        acc[ai][bj][m][n] = __builtin_amdgcn_mfma_f32_16x16x32_bf16(Bt[n][k], At[m][k], acc[ai][bj][m][n], 0, 0, 0); __builtin_amdgcn_s_setprio(0); } while (0)
#define PG8_WAIT_V(n) asm volatile("s_waitcnt vmcnt(" #n ")" ::: "memory")
#define PG8_WAIT_L(n) asm volatile("s_waitcnt lgkmcnt(" #n ")" ::: "memory")
#define PG8_BAR __builtin_amdgcn_s_barrier()
#define PG8_SCHED __builtin_amdgcn_sched_barrier(0)
    Unit cur, nxt; int ui = 0;
    if (!S.next(0, cur)) return;
    f32x4 acc[2][2][4][2];
#pragma unroll
    for (int a = 0; a < 2; ++a)
#pragma unroll
        for (int b = 0; b < 2; ++b)
#pragma unroll
            for (int m = 0; m < 4; ++m)
#pragma unroll
                for (int n = 0; n < 2; ++n) acc[a][b][m][n] = (f32x4){0.f, 0.f, 0.f, 0.f};
    bf16x8 At[4][2], B0[2][2], B1[2][2];
    const char* cA = g.abase(cur) + (size_t)cur.pm * tstep; const char* cB = (const char*)g.Bt + (size_t)cur.pn * tstep;
    S.a_ready(cur);
    if constexpr (SP2) {
        PG8_STAGE(PG8_SB(0, 0), cB, voffB); PG8_STAGE(PG8_SB(0, 1), cB + hstep, voffB); PG8_STAGE(PG8_SA(0, 0), cA, voffA); PG8_STAGE(PG8_SA(0, 1), cA + hstep, voffA);
        if (wr == 1) PG8_BAR;
        PG8_WAIT_V(2); PG8_BAR;
        PG8_STAGE(PG8_SB(1, 0), cB + kstep, voffB); PG8_STAGE(PG8_SA(1, 0), cA + kstep, voffA); PG8_STAGE(PG8_SB(1, 1), cB + hstep + kstep, voffB);
        PG8_WAIT_V(6); PG8_BAR;
    } else {
        PG8_STAGE(PG8_SB(0, 0), cB, voffB); PG8_STAGE(PG8_SA(0, 0), cA, voffA); PG8_STAGE(PG8_SB(0, 1), cB + hstep, voffB); PG8_STAGE(PG8_SA(0, 1), cA + hstep, voffA);
        if (wr == 1) PG8_BAR;
        PG8_WAIT_V(4); PG8_BAR;
        PG8_STAGE(PG8_SB(1, 0), cB + kstep, voffB); PG8_STAGE(PG8_SA(1, 0), cA + kstep, voffA); PG8_STAGE(PG8_SB(1, 1), cB + hstep + kstep, voffB);
        PG8_WAIT_V(6); PG8_BAR;
    }
    for (;;) {
        const bool has_next = S.next(ui + 1, nxt);
        const char* nA = has_next ? g.abase(nxt) + (size_t)nxt.pm * tstep : cA; const char* nB = has_next ? (const char*)g.Bt + (size_t)nxt.pn * tstep : cB;
        for (int t = 0; t < nt; t += 2) {
            const bool last = (t == nt - 2);
            const char* a1 = cA + (size_t)(t + 1) * kstep;
            const char* a2 = last ? nA : cA + (size_t)(t + 2) * kstep; const char* b2 = last ? nB : cB + (size_t)(t + 2) * kstep;
            const char* a3 = a2 + kstep; const char* b3 = b2 + kstep;
            if (last && has_next) S.a_ready(nxt);
            if constexpr (SP2) {
            PG8_LDB(B0, 0, 0); PG8_LDB(B1, 0, 1); PG8_SCHED; PG8_LDA(At, 0, 0); PG8_STAGE(PG8_SA(1, 1), a1 + hstep, voffA);
            PG8_WAIT_V(8); PG8_WAIT_L(0); PG8_BAR; PG8_MMA(0, 0, At, B0); PG8_MMA(0, 1, At, B1); PG8_BAR; PG8_SCHED;
            PG8_LDA(At, 0, 1); PG8_STAGE(PG8_SB(0, 0), b2, voffB); PG8_STAGE(PG8_SB(0, 1), b2 + hstep, voffB); PG8_STAGE(PG8_SA(0, 0), a2, voffA);
            PG8_WAIT_V(8); PG8_WAIT_L(0); PG8_BAR; PG8_MMA(1, 0, At, B0); PG8_MMA(1, 1, At, B1); PG8_BAR; PG8_SCHED;
            PG8_LDB(B0, 1, 0); PG8_LDB(B1, 1, 1); PG8_SCHED; PG8_LDA(At, 1, 0); PG8_STAGE(PG8_SA(0, 1), a2 + hstep, voffA);
            PG8_WAIT_V(8); PG8_WAIT_L(0); PG8_BAR; PG8_MMA(0, 0, At, B0); PG8_MMA(0, 1, At, B1); PG8_BAR; PG8_SCHED;
            PG8_LDA(At, 1, 1); PG8_STAGE(PG8_SB(1, 0), b3, voffB); PG8_STAGE(PG8_SB(1, 1), b3 + hstep, voffB); PG8_STAGE(PG8_SA(1, 0), a3, voffA);
            PG8_WAIT_V(8); PG8_WAIT_L(0); PG8_BAR; PG8_MMA(1, 0, At, B0); PG8_MMA(1, 1, At, B1); PG8_BAR; PG8_SCHED;
            } else {
            PG8_LDB(B0, 0, 0); PG8_SCHED; PG8_LDA(At, 0, 0); PG8_STAGE(PG8_SA(1, 1), a1 + hstep, voffA);
            PG8_WAIT_L(8); PG8_BAR; PG8_WAIT_L(0); PG8_MMA(0, 0, At, B0); PG8_BAR; PG8_SCHED;
            PG8_LDB(B1, 0, 1); PG8_STAGE(PG8_SB(0, 0), b2, voffB);
            PG8_BAR; PG8_WAIT_L(0); PG8_MMA(0, 1, At, B1); PG8_BAR;
            PG8_LDA(At, 0, 1); PG8_STAGE(PG8_SA(0, 0), a2, voffA);
            PG8_BAR; PG8_WAIT_L(0); PG8_MMA(1, 0, At, B0); PG8_BAR; PG8_SCHED;
            PG8_STAGE(PG8_SB(0, 1), b2 + hstep, voffB);
            PG8_WAIT_V(6); PG8_BAR; PG8_MMA(1, 1, At, B1); PG8_BAR;
            PG8_LDB(B0, 1, 0); PG8_SCHED; PG8_LDA(At, 1, 0); PG8_STAGE(PG8_SA(0, 1), a2 + hstep, voffA);
            PG8_WAIT_L(8); PG8_BAR; PG8_WAIT_L(0); PG8_MMA(0, 0, At, B0); PG8_BAR; PG8_SCHED;
            PG8_LDB(B1, 1, 1); PG8_STAGE(PG8_SB(1, 0), b3, voffB);
            PG8_BAR; PG8_WAIT_L(0); PG8_MMA(0, 1, At, B1); PG8_BAR;
            PG8_LDA(At, 1, 1); PG8_STAGE(PG8_SA(1, 0), a3, voffA);
            PG8_BAR; PG8_WAIT_L(0); PG8_MMA(1, 0, At, B0); PG8_BAR; PG8_SCHED;
            PG8_STAGE(PG8_SB(1, 1), b3 + hstep, voffB);
            PG8_WAIT_V(6); PG8_BAR; PG8_MMA(1, 1, At, B1); PG8_BAR;
            }
        }
        if constexpr (ALIGN_EPI) { if (wr == 0) PG8_BAR; }
        if constexpr (!Epi::AFTER_DRAIN) { E(acc, cur, wr, wc, fr, fq); S.done(cur); }
        if (!has_next) break;
#pragma unroll
        for (int a = 0; a < 2; ++a)
#pragma unroll
            for (int b = 0; b < 2; ++b)
#pragma unroll
                for (int m = 0; m < 4; ++m)
#pragma unroll
                    for (int n = 0; n < 2; ++n) acc[a][b][m][n] = (f32x4){0.f, 0.f, 0.f, 0.f};
        cur = nxt; cA = nA; cB = nB; ++ui;
        if constexpr (ALIGN_EPI) { if (wr == 1) PG8_BAR; }
    }
    PG8_WAIT_V(0);
    if constexpr (!ALIGN_EPI) { if (wr == 0) PG8_BAR; }
    PG8_BAR;
    if constexpr (Epi::AFTER_DRAIN) { E.fused(acc, cur, wr, wc, fr, fq, lds, wid, lane); S.done(cur); }
#undef PG8_SA
#undef PG8_SB
#undef PG8_STAGE
#undef PG8_LDA
#undef PG8_LDB
#undef PG8_MMA
#undef PG8_WAIT_V
#undef PG8_WAIT_L
#undef PG8_BAR
#undef PG8_SCHED
}
}
struct Params {
    const float *x, *attn_norm_w, *w_in, *ikw, *ikb, *sinks, *w_a, *w_b, *w_out, *mlp_norm_w, *w_up, *w_down, *final_w;
    float* out; unsigned char* ws;
    float inv_freq[32];
    int ph_lo, ph_hi;
};
constexpr int NWAVES = 8, NTHREADS = 512;

__device__ __forceinline__ int win_src_group(int grp, int& cnt) {
    const int tile = grp >> 3, g = grp & 7; cnt = 32;
    if (tile < 6) { const int base = tile < 2 ? C_AQ : (tile < 4 ? C_IQ : C_BQ); const int head = 4 * (tile & 1) + (g & 3); return base + head * 64 + 32 * (g >> 2); }
    if (tile < 8) { const int kb = tile == 6 ? C_AK : C_BK, vb = tile == 6 ? C_AV : C_BV; const int hf = g >> 2, q = g & 3;
        if (q < 2) return kb + q * 64 + 32 * hf; return vb + 64 * hf + 32 * (q - 2); }
    if (tile == 8) { if (g == 0) return C_IK; if (g == 4) return C_IK + 32; if (g == 1) { cnt = 8; return C_IW; } cnt = 0; return 0; }
    return C_GA + (grp - 72) * 32;
}
__device__ __forceinline__ void p0_transpose_item(const float* W, int ldw, int c0, int cnt, int K, bf16* WT, int n0, int k0, LAS float* scr, int lane) {
#pragma unroll 8
    for (int i = 0; i < 32; ++i) { const int kk = 2 * i + (lane >> 5), n = lane & 31; scr[kk * 33 + n] = (n < cnt) ? W[(size_t)(k0 + kk) * ldw + c0 + n] : 0.f; }
    asm volatile("s_waitcnt lgkmcnt(0)" ::: "memory");
    const int c = lane & 7;
#pragma unroll
    for (int j = 0; j < 4; ++j) { const int n = (lane >> 3) + 8 * j; const LAS float* s = scr + (8 * c) * 33 + n;
        v4u o; o.x = pk2(s[0 * 33], s[1 * 33]); o.y = pk2(s[2 * 33], s[3 * 33]); o.z = pk2(s[4 * 33], s[5 * 33]); o.w = pk2(s[6 * 33], s[7 * 33]);
        *(v4u*)(WT + (size_t)(n0 + n) * K + k0 + 8 * c) = o; }
    asm volatile("s_waitcnt lgkmcnt(0)" ::: "memory");
}
__device__ __forceinline__ void sincos_d(float angf, float& sn, float& cs) {
    const double a = (double)angf; const double kq = __builtin_rint(a * 0.63661977236758134308);
    const double y = (a - kq * 1.57079632679489655800) - kq * 6.123233995736766e-17; const double y2 = y * y;
    double s = y * (1.0 + y2 * (-1.0 / 6 + y2 * (1.0 / 120 + y2 * (-1.0 / 5040 + y2 * (1.0 / 362880 + y2 * (-1.0 / 39916800 + y2 * (1.0 / 6227020800.0)))))));
    double c = 1.0 + y2 * (-0.5 + y2 * (1.0 / 24 + y2 * (-1.0 / 720 + y2 * (1.0 / 40320 + y2 * (-1.0 / 3628800 + y2 * (1.0 / 479001600.0 + y2 * (-1.0 / 87178291200.0)))))));
    const int q = ((int)kq) & 3;
    const double ss = (q == 0) ? s : (q == 1) ? c : (q == 2) ? -s : -c; const double cc = (q == 0) ? c : (q == 1) ? -s : (q == 2) ? -c : s;
    sn = (float)ss; cs = (float)cc;
}
__device__ __forceinline__ void phase_prologue(const Params& p, LAS unsigned char* lds, int G) {
    const int lane = threadIdx.x & 63, wave = __builtin_amdgcn_readfirstlane(threadIdx.x >> 6);
    unsigned char* ws = p.ws;
    LAS float* scr = (LAS float*)(lds + wave * 16384);
    const int gw = blockIdx.x * NWAVES + wave, NGW = G * NWAVES;
    constexpr int I_IN = (DM / 64) * (NIN / 32), I_A = (512 / 64) * (DM / 32), I_O = (DM / 64) * (DM / 32), I_U = (DM / 64) * (DFF / 32), I_D = (DFF / 64) * (DM / 32);
    constexpr int NITEMS = I_IN + 2 * I_A + I_O + I_U + I_D;
    for (int it = gw; it < NITEMS; it += NGW) {
        int r = it;
        if (r < I_IN) { const int grp = r % (NIN / 32), kb = r / (NIN / 32); int cnt; const int c0 = win_src_group(grp, cnt);
            p0_transpose_item(p.w_in, D_IN, c0, cnt, DM, (bf16*)(ws + WS_WIN), grp * 32, kb * 64, scr, lane); continue; } r -= I_IN;
        if (r < I_A) { const int nb = r % 32, kb = r / 32; p0_transpose_item(p.w_a, DM, nb * 32, 32, 512, (bf16*)(ws + WS_WAB), nb * 32, kb * 64, scr, lane); continue; } r -= I_A;
        if (r < I_A) { const int nb = r % 32, kb = r / 32; p0_transpose_item(p.w_b, DM, nb * 32, 32, 512, (bf16*)(ws + WS_WAB), 1024 + nb * 32, kb * 64, scr, lane); continue; } r -= I_A;
        if (r < I_O) { const int nb = r % 32, kb = r / 32; p0_transpose_item(p.w_out, DM, nb * 32, 32, DM, (bf16*)(ws + WS_WOUT), nb * 32, kb * 64, scr, lane); continue; } r -= I_O;
        if (r < I_U) { const int nb = r % 128, kb = r / 128; p0_transpose_item(p.w_up, DFF, nb * 32, 32, DM, (bf16*)(ws + WS_WUP), nb * 32, kb * 64, scr, lane); continue; } r -= I_U;
        { const int nb = r % 32, kb = r / 32; p0_transpose_item(p.w_down, DM, nb * 32, 32, DFF, (bf16*)(ws + WS_WDN), nb * 32, kb * 64, scr, lane); }
    }
    float* COS = (float*)(ws + WS_COS); float* SIN = (float*)(ws + WS_SIN);
    for (int i = gw * 64 + lane; i < SEQ * 32; i += NGW * 64) { const int pos = i >> 5, d = i & 31; const float ang = (float)pos * p.inv_freq[d]; float s, c; sincos_d(ang, s, c); COS[i] = c; SIN[i] = s; }
    float* RSTD1 = (float*)(ws + WS_RSTD1); float* SS2 = (float*)(ws + WS_SS2); float* SS3 = (float*)(ws + WS_SS3); bf16* XG = (bf16*)(ws + WS_XG);
    v4f g[4];
#pragma unroll
    for (int j = 0; j < 4; ++j) g[j] = *((const v4f*)p.attn_norm_w + lane + 64 * j);
    for (int m = gw; m < TOK; m += NGW) {
        const v4f* xr = (const v4f*)(p.x + (size_t)m * DM) + lane; v4f v[4]; float s = 0.f;
#pragma unroll
        for (int j = 0; j < 4; ++j) { v[j] = xr[64 * j]; s += (v[j].x * v[j].x + v[j].y * v[j].y) + (v[j].z * v[j].z + v[j].w * v[j].w); }
        s = wave_sum(s);
        unsigned long long* o8 = (unsigned long long*)(XG + (size_t)m * DM) + lane;
#pragma unroll
        for (int j = 0; j < 4; ++j) o8[64 * j] = (unsigned long long)pk2(v[j].x * g[j].x, v[j].y * g[j].y) | ((unsigned long long)pk2(v[j].z * g[j].z, v[j].w * g[j].w) << 32);
        if (lane == 0) { RSTD1[m] = frsq(s * (1.0f / DM) + RMS_EPS); SS2[m] = 0.f; SS3[m] = 0.f; }
    }
}

__device__ __forceinline__ unsigned f2key(float f) { const unsigned u = __float_as_uint(f); return (u & 0x80000000u) ? ~u : (u | 0x80000000u); }
__device__ __forceinline__ void phase_topk_simple(const Params& p, LAS unsigned char* lds, int G) {
    const int lane = threadIdx.x & 63, wave = __builtin_amdgcn_readfirstlane(threadIdx.x >> 6);
    unsigned char* ws = p.ws;
    const bf16* IQ = (const bf16*)(ws + WS_IQ); const bf16* IK = (const bf16*)(ws + WS_IK); const float* IW = (const float*)(ws + WS_IW);
    unsigned short* SEL = (unsigned short*)(ws + WS_SEL);
    LAS unsigned* keys = (LAS unsigned*)(lds + wave * 16384);
    LAS float* qf = (LAS float*)(lds + LDS_RING + wave * 2048);
    const int gw = blockIdx.x * NWAVES + wave, NGW = G * NWAVES;
    for (int row = gw; row < TOK; row += NGW) {
        const int b = row >> 12, t = row & 4095, n = t + 1;
        unsigned short* selrow = SEL + (size_t)row * TOPK;
        if (n <= TOPK) { for (int i = lane; i < n; i += 64) selrow[i] = (unsigned short)i; continue; }
        { const v4u q8 = *((const v4u*)(IQ + (size_t)row * 512) + lane);
            LAS float* d = qf + 8 * lane;
            d[0] = bflo(q8.x); d[1] = bfhi(q8.x); d[2] = bflo(q8.y); d[3] = bfhi(q8.y); d[4] = bflo(q8.z); d[5] = bfhi(q8.z); d[6] = bflo(q8.w); d[7] = bfhi(q8.w); }
        float w[8];
#pragma unroll
        for (int h = 0; h < 8; ++h) w[h] = IW[(size_t)row * 8 + h];
        asm volatile("s_waitcnt lgkmcnt(0)" ::: "memory");
        for (int s0 = 0; s0 < n; s0 += 64) {
            const int s = s0 + lane; const int sc = s < n ? s : t;
            const v4u* kp = (const v4u*)(IK + ((size_t)b * SEQ + sc) * 64);
            float dot[8];
#pragma unroll
            for (int h = 0; h < 8; ++h) dot[h] = 0.f;
#pragma unroll
            for (int c = 0; c < 8; ++c) {
                const v4u k8 = kp[c]; float kf[8] = {bflo(k8.x), bfhi(k8.x), bflo(k8.y), bfhi(k8.y), bflo(k8.z), bfhi(k8.z), bflo(k8.w), bfhi(k8.w)};
#pragma unroll
                for (int h = 0; h < 8; ++h) { const v4f qa = *(const LAS v4f*)(qf + h * 64 + c * 8), qb = *(const LAS v4f*)(qf + h * 64 + c * 8 + 4);
                    dot[h] += (kf[0] * qa.x + kf[1] * qa.y) + (kf[2] * qa.z + kf[3] * qa.w) + (kf[4] * qb.x + kf[5] * qb.y) + (kf[6] * qb.z + kf[7] * qb.w); }
            }
            float sc_ = 0.f;
#pragma unroll
            for (int h = 0; h < 8; ++h) sc_ += w[h] * fmaxf(dot[h], 0.f);
            keys[s] = (s < n) ? f2key(sc_) : 0u;
        }
        asm volatile("s_waitcnt lgkmcnt(0)" ::: "memory");
        const int nch = (n + 63) >> 6;
        unsigned thr = 0u;
        for (int bit = 31; bit >= 0; --bit) {
            const unsigned cand = thr | (1u << bit); int cnt = 0;
            for (int c = 0; c < nch; ++c) cnt += __popcll(__ballot(keys[c * 64 + lane] >= cand));
            if (cnt >= TOPK) thr = cand;
        }
        int cgt = 0;
        for (int c = 0; c < nch; ++c) cgt += __popcll(__ballot(keys[c * 64 + lane] > thr));
        const int need = TOPK - cgt; int pos = 0, ties = 0;
        for (int c = 0; c < nch; ++c) {
            const unsigned k = keys[c * 64 + lane]; const bool gt = k > thr, eq = k == thr;
            const unsigned long long meq = __ballot(eq);
            const bool sel = gt || (eq && (ties + mbcnt64(meq) < need));
            const unsigned long long msel = __ballot(sel);
            if (sel) selrow[pos + mbcnt64(msel)] = (unsigned short)(c * 64 + lane);
            pos += __popcll(msel); ties += __popcll(meq);
        }
    }
}

template <bool SINK, class KeyFn>
__device__ __forceinline__ void attend_wave(const bf16* Q, const bf16* K, const bf16* V, bf16* O, int row, int g, int nslots, const KeyFn& keyfn, const float* sinkv,
                                            LAS float* qf  , LAS float* pf  , LAS int* kidx  , int lane) {
    const int b = row >> 12;
    { const v2u q4 = *((const v2u*)(Q + (size_t)row * 512 + g * 256) + lane);
        LAS float* d = qf + 4 * lane; d[0] = bflo(q4.x); d[1] = bfhi(q4.x); d[2] = bflo(q4.y); d[3] = bfhi(q4.y); }
    asm volatile("s_waitcnt lgkmcnt(0)" ::: "memory");
#pragma unroll 1
    for (int j = 0; j < 4; ++j) {
        const int slot = 64 * j + lane; int key = slot < nslots ? keyfn(slot) : -1; kidx[slot] = key;
        const bool valid = key >= 0; const int kc = valid ? key : 0;
        const v4u* kp = (const v4u*)(K + ((size_t)b * SEQ + kc) * 128 + g * 64);
        float dot[4] = {0.f, 0.f, 0.f, 0.f};
        if (64 * j < nslots) {
#pragma unroll 2
            for (int c = 0; c < 8; ++c) {
                const v4u k8 = kp[c]; float kf[8] = {bflo(k8.x), bfhi(k8.x), bflo(k8.y), bfhi(k8.y), bflo(k8.z), bfhi(k8.z), bflo(k8.w), bfhi(k8.w)};
#pragma unroll
                for (int h = 0; h < 4; ++h) { const v4f qa = *(const LAS v4f*)(qf + h * 64 + c * 8), qb = *(const LAS v4f*)(qf + h * 64 + c * 8 + 4);
                    dot[h] += (kf[0] * qa.x + kf[1] * qa.y) + (kf[2] * qa.z + kf[3] * qa.w) + (kf[4] * qb.x + kf[5] * qb.y) + (kf[6] * qb.z + kf[7] * qb.w); }
            }
        }
        *(LAS v4f*)(pf + slot * 4) = valid ? (v4f){dot[0], dot[1], dot[2], dot[3]} : (v4f){-INFINITY, -INFINITY, -INFINITY, -INFINITY};
    }
    asm volatile("s_waitcnt lgkmcnt(0)" ::: "memory");
    float lg[4][4];
#pragma unroll
    for (int j = 0; j < 4; ++j) { const v4f t4 = *(const LAS v4f*)(pf + (64 * j + lane) * 4); lg[j][0] = t4.x; lg[j][1] = t4.y; lg[j][2] = t4.z; lg[j][3] = t4.w; }
    float inv[4];
#pragma unroll
    for (int h = 0; h < 4; ++h) {
        float mx = fmaxf(fmaxf(lg[0][h], lg[1][h]), fmaxf(lg[2][h], lg[3][h])); mx = wave_max(mx);
        float sk = 0.f; if (SINK) { sk = sinkv[g * 4 + h] * LOG2E; mx = fmaxf(mx, sk); }
        float s = 0.f;
#pragma unroll
        for (int j = 0; j < 4; ++j) { const float e = fexp2(lg[j][h] - mx); lg[j][h] = e; s += e; }
        s = wave_sum(s); if (SINK) s += fexp2(sk - mx);
        inv[h] = 1.0f / s;
    }
#pragma unroll
    for (int j = 0; j < 4; ++j) *(LAS v4f*)(pf + (64 * j + lane) * 4) = (v4f){lg[j][0], lg[j][1], lg[j][2], lg[j][3]};
    asm volatile("s_waitcnt lgkmcnt(0)" ::: "memory");
    float o[4] = {0.f, 0.f, 0.f, 0.f};
    const bf16* Vb = V + (size_t)b * SEQ * 128 + g * 64 + lane;
#pragma unroll 1
    for (int s0 = 0; s0 < nslots; s0 += 8) {
        float vv[8]; v4f pp[8];
#pragma unroll
        for (int i = 0; i < 8; ++i) { const int slot = s0 + i; const int key = slot < nslots ? kidx[slot] : -1; pp[i] = *(const LAS v4f*)(pf + (slot & 255) * 4);
            vv[i] = key >= 0 ? bf2f(Vb[(size_t)key * 128]) : 0.f; if (key < 0) pp[i] = (v4f){0.f, 0.f, 0.f, 0.f}; }
#pragma unroll
        for (int i = 0; i < 8; ++i) { o[0] += pp[i].x * vv[i]; o[1] += pp[i].y * vv[i]; o[2] += pp[i].z * vv[i]; o[3] += pp[i].w * vv[i]; }
    }
    bf16* op = O + (size_t)row * 512 + g * 256 + lane;
#pragma unroll
    for (int h = 0; h < 4; ++h) op[h * 64] = (bf16)f2bf(o[h] * inv[h]);
}
struct SelKey { const unsigned short* selrow; __device__ __forceinline__ int operator()(int slot) const { return (int)selrow[slot]; } };
struct WinKey { int t; __device__ __forceinline__ int operator()(int slot) const { return t - (WIN - 1) + slot; } };

template <bool DO_DSA, bool DO_SWA>
__device__ __forceinline__ void phase_attn_simple(const Params& p, LAS unsigned char* lds, int G) {
    const int lane = threadIdx.x & 63, wave = __builtin_amdgcn_readfirstlane(threadIdx.x >> 6);
    unsigned char* ws = p.ws;
    LAS float* qf = (LAS float*)(lds + wave * 16384); LAS float* pf = qf + 256; LAS int* kidx = (LAS int*)(pf + 1024);
    const int gw = blockIdx.x * NWAVES + wave, NGW = G * NWAVES;
    const unsigned short* SEL = (const unsigned short*)(ws + WS_SEL);
    for (int item = gw; item < TOK * 2; item += NGW) {
        const int row = item >> 1, g = item & 1, t = row & 4095;
        if (DO_DSA) { SelKey kf{SEL + (size_t)row * TOPK}; const int ns = (t + 1 < TOPK) ? t + 1 : TOPK;
            attend_wave<false>((const bf16*)(ws + WS_AQ), (const bf16*)(ws + WS_AK), (const bf16*)(ws + WS_AV), (bf16*)(ws + WS_AQ), row, g, ns, kf, nullptr, qf, pf, kidx, lane); }
        if (DO_SWA) { WinKey kf{t};
            attend_wave<true>((const bf16*)(ws + WS_BQ), (const bf16*)(ws + WS_BK), (const bf16*)(ws + WS_BV), (bf16*)(ws + WS_BQ), row, g, WIN, kf, p.sinks, qf, pf, kidx, lane); }
    }
}

__device__ __forceinline__ void phase_final(const Params& p, int G) {
    const int lane = threadIdx.x & 63, wave = __builtin_amdgcn_readfirstlane(threadIdx.x >> 6);
    const float* SS3 = (const float*)(p.ws + WS_SS3);
    const int gw = blockIdx.x * NWAVES + wave, NGW = G * NWAVES;
    v4f g[4];
#pragma unroll
    for (int j = 0; j < 4; ++j) g[j] = *((const v4f*)p.final_w + lane + 64 * j);
    for (int m = gw; m < TOK; m += NGW) {
        const float rs = frsq(SS3[m] * (1.0f / DM) + RMS_EPS);
        v4f* xr = (v4f*)(p.out + (size_t)m * DM) + lane;
#pragma unroll
        for (int j = 0; j < 4; ++j) { v4f v = xr[64 * j]; xr[64 * j] = v * g[j] * rs; }
    }
}

typedef short bf16x8_t __attribute__((ext_vector_type(8)));
typedef float f32x16_t __attribute__((ext_vector_type(16)));
typedef float f32x4_t __attribute__((ext_vector_type(4)));
__device__ __forceinline__ unsigned f16key(float f) { const _Float16 hf = (_Float16)f; const unsigned b = (unsigned)__builtin_bit_cast(unsigned short, hf); return (b & 0x8000u) ? (~b & 0xffffu) : (b | 0x8000u); }
__device__ __forceinline__ int tk_pos(int e) { return 512 * (e >> 9) + 8 * (e & 63) + ((e >> 6) & 7); }

__device__ __forceinline__ void phase_topk_fast(const Params& p, LAS unsigned char* lds, int G) {
    const int tid = threadIdx.x, lane = tid & 63, wave = __builtin_amdgcn_readfirstlane(tid >> 6);
    const int r = lane & 31, h = lane >> 5, mt = wave & 3, par = wave >> 2;
    unsigned char* ws = p.ws;
    const bf16* IQ = (const bf16*)(ws + WS_IQ); const bf16* IK = (const bf16*)(ws + WS_IK); const float* IW = (const float*)(ws + WS_IW);
    unsigned short* SEL = (unsigned short*)(ws + WS_SEL);
    LAS unsigned short* kb = (LAS unsigned short*)lds;
    const int qrow = 4 * mt + 2 * ((r >> 2) & 1) + (r >> 4), qhead = 4 * ((r >> 3) & 1) + (r & 3);
    for (int k = 0;; ++k) {
        int b, tile;
        if (G == 256) { if (k >= 8) break; const int c = blockIdx.x, i = c >> 3, grp = k >> 1; b = c & 7; tile = (k & 1) ? (64 * grp + 63 - i) : (64 * grp + i); }
        else { const int u = blockIdx.x + k * G; if (u >= TOK / 16) break; b = u >> 8; tile = u & 255; }
        const int t0 = tile * 16, R0 = b * SEQ + t0;
        if (t0 + 16 <= TOPK) {
            for (int i = tid; i < 16 * TOPK; i += NTHREADS) { const int ql = i >> 8, s = i & 255; if (s <= t0 + ql) SEL[(size_t)(R0 + ql) * TOPK + s] = (unsigned short)s; }
            continue;
        }
        bf16x8_t aq[4];
#pragma unroll
        for (int s = 0; s < 4; ++s) aq[s] = *(const bf16x8_t*)(IQ + (size_t)(R0 + qrow) * 512 + qhead * 64 + 16 * s + 8 * h);
        float wq[2][8];
#pragma unroll
        for (int qq = 0; qq < 2; ++qq) { const f32x4_t w0 = *(const f32x4_t*)(IW + (size_t)(R0 + 4 * mt + 2 * h + qq) * 8), w1 = *(const f32x4_t*)(IW + (size_t)(R0 + 4 * mt + 2 * h + qq) * 8 + 4);
            wq[qq][0] = w0[0]; wq[qq][1] = w0[1]; wq[qq][2] = w0[2]; wq[qq][3] = w0[3]; wq[qq][4] = w1[0]; wq[qq][5] = w1[1]; wq[qq][6] = w1[2]; wq[qq][7] = w1[3]; }
        const int ntile = (t0 + 16 + 31) >> 5, nch = (t0 + 16 + 511) >> 9;
        const char* kbase = (const char*)IK + (size_t)b * SEQ * 128;
        const unsigned voff = (unsigned)(r * 128 + h * 16);
        const int tq0 = t0 + 4 * mt + 2 * h;
        LAS unsigned short* row0 = kb + (4 * mt + 2 * h) * 4096;
#define TK_LOAD(dst, kt_) do { const char* tp_ = kbase + (size_t)(kt_) * 4096; _Pragma("unroll") for (int s_ = 0; s_ < 4; ++s_) dst[s_] = *(const bf16x8_t*)(tp_ + voff + 32 * s_); } while (0)
#define TK_PROC(src, kt_) do { f32x16_t acc_ = {0.f, 0.f, 0.f, 0.f, 0.f, 0.f, 0.f, 0.f, 0.f, 0.f, 0.f, 0.f, 0.f, 0.f, 0.f, 0.f}; \
            _Pragma("unroll") for (int s_ = 0; s_ < 4; ++s_) acc_ = __builtin_amdgcn_mfma_f32_32x32x16_bf16(aq[s_], src[s_], acc_, 0, 0, 0); \
            float sc0_ = 0.f, sc1_ = 0.f; \
            _Pragma("unroll") for (int hd_ = 0; hd_ < 8; ++hd_) { sc0_ += wq[0][hd_] * fmaxf(acc_[hd_], 0.f); sc1_ += wq[1][hd_] * fmaxf(acc_[8 + hd_], 0.f); } \
            const int e_ = 32 * (kt_) + r; const int pe_ = tk_pos(e_); \
            row0[pe_] = (unsigned short)((e_ <= tq0) ? f16key(sc0_) : 0u); row0[4096 + pe_] = (unsigned short)((e_ <= tq0 + 1) ? f16key(sc1_) : 0u); } while (0)
        {
            bf16x8_t B[4][4];
            const int nmy = (ntile - par + 1) >> 1;
#pragma unroll
            for (int u = 0; u < 4; ++u) if (u < nmy) TK_LOAD(B[u], par + 2 * u);
#pragma unroll 1
            for (int i = 0; i < nmy; i += 4) {
#pragma unroll
                for (int u = 0; u < 4; ++u) if (i + u < nmy) { TK_PROC(B[u], par + 2 * (i + u)); if (i + u + 4 < nmy) TK_LOAD(B[u], par + 2 * (i + u + 4)); }
            }
        }
#undef TK_LOAD
#undef TK_PROC
        { const int e0 = 32 * ntile, cnt = 512 * nch - e0;
            for (int i = tid; i < 16 * cnt; i += NTHREADS) { const int ql = i / cnt, e = e0 + (i - ql * cnt); kb[ql * 4096 + tk_pos(e)] = 0; } }
        __syncthreads();
#pragma unroll 1
        for (int qi = 0; qi < 2; ++qi) {
            const int ql = 2 * wave + qi;
            const LAS unsigned short* rb = kb + ql * 4096 + 8 * lane;
            unsigned thr = 0u;
#pragma unroll 1
            for (int bit = 15; bit >= 0; --bit) {
                const unsigned cand = thr | (1u << bit); int cnt = 0;
#pragma unroll 1
                for (int j = 0; j < nch; ++j) {
                    const v4u w = *(const LAS v4u*)(rb + 512 * j);
                    cnt += __popcll(__ballot((w.x & 0xffffu) >= cand)) + __popcll(__ballot((w.x >> 16) >= cand)) + __popcll(__ballot((w.y & 0xffffu) >= cand)) + __popcll(__ballot((w.y >> 16) >= cand))
                         + __popcll(__ballot((w.z & 0xffffu) >= cand)) + __popcll(__ballot((w.z >> 16) >= cand)) + __popcll(__ballot((w.w & 0xffffu) >= cand)) + __popcll(__ballot((w.w >> 16) >= cand));
                }
                if (cnt >= TOPK) thr = cand;
            }
            int cgt = 0;
#pragma unroll 1
            for (int j = 0; j < nch; ++j) {
                const v4u w = *(const LAS v4u*)(rb + 512 * j);
                cgt += __popcll(__ballot((w.x & 0xffffu) > thr)) + __popcll(__ballot((w.x >> 16) > thr)) + __popcll(__ballot((w.y & 0xffffu) > thr)) + __popcll(__ballot((w.y >> 16) > thr))
                     + __popcll(__ballot((w.z & 0xffffu) > thr)) + __popcll(__ballot((w.z >> 16) > thr)) + __popcll(__ballot((w.w & 0xffffu) > thr)) + __popcll(__ballot((w.w >> 16) > thr));
            }
            const int need = TOPK - cgt; int pos = 0, ties = 0;
            unsigned short* selrow = SEL + (size_t)(R0 + ql) * TOPK;
#pragma unroll 1
            for (int j = 0; j < nch; ++j) {
                const v4u w = *(const LAS v4u*)(rb + 512 * j);
                const unsigned kk[8] = {w.x & 0xffffu, w.x >> 16, w.y & 0xffffu, w.y >> 16, w.z & 0xffffu, w.z >> 16, w.w & 0xffffu, w.w >> 16};
#pragma unroll
                for (int s = 0; s < 8; ++s) {
                    const bool gt = kk[s] > thr, eq = kk[s] == thr;
                    const unsigned long long meq = __ballot(eq);
                    const bool sel = gt || (eq && (ties + mbcnt64(meq) < need));
                    const unsigned long long msel = __ballot(sel);
                    if (sel) selrow[pos + mbcnt64(msel)] = (unsigned short)(512 * j + 64 * s + lane);
                    pos += __popcll(msel); ties += __popcll(meq);
                }
            }
        }
        __syncthreads();
    }
}

typedef short s16x4_t __attribute__((ext_vector_type(4)));
__device__ __forceinline__ s16x4_t tr_read(unsigned addr) { s16x4_t r_; asm volatile("ds_read_b64_tr_b16 %0, %1" : "=v"(r_) : "v"(addr) : "memory"); return r_; }

__device__ __forceinline__ void phase_dsa_fast(const Params& p, LAS unsigned char* lds, int G) {
    const int tid = threadIdx.x, lane = tid & 63, wave = __builtin_amdgcn_readfirstlane(tid >> 6);
    const int c16 = lane & 15, kq = lane >> 4;
    unsigned char* ws = p.ws;
    const bf16* AQ = (const bf16*)(ws + WS_AQ); const bf16* AK = (const bf16*)(ws + WS_AK); const bf16* AV = (const bf16*)(ws + WS_AV); bf16* OA = (bf16*)(ws + WS_AQ);
    const unsigned short* SEL = (const unsigned short*)(ws + WS_SEL);
    LAS unsigned char* wl = lds + wave * 13312;
    LAS unsigned short* sidx = (LAS unsigned short*)wl; LAS unsigned short* Pl = (LAS unsigned short*)(wl + 512); LAS unsigned char* Vl = wl + 2560;
    const unsigned vl_addr = (unsigned)(size_t)Vl;
    const bool arow = (c16 & 3) == 0; const int ahead = c16 >> 2;
    const int nper = (G >= 8 && (G & 7) == 0) ? (G >> 3) * NWAVES : 0;
    for (int it = 0;; ++it) {
        int row;
        if (nper) { const int wi = (blockIdx.x >> 3) * NWAVES + wave, t = wi + it * nper; if (t >= SEQ) break; row = (blockIdx.x & 7) * SEQ + t; }
        else { row = blockIdx.x * NWAVES + wave + it * G * NWAVES; if (row >= TOK) break; }
        const int b = row >> 12, t = row & 4095; const int cnt = (t + 1 < TOPK) ? t + 1 : TOPK;
        { const v2u sv = *((const v2u*)(SEL + (size_t)row * TOPK) + lane);
            const int s0 = 4 * lane; v2u o;
            o.x = ((s0 < cnt) ? (sv.x & 0xffffu) : 0u) | (((s0 + 1 < cnt) ? (sv.x >> 16) : 0u) << 16); o.y = ((s0 + 2 < cnt) ? (sv.y & 0xffffu) : 0u) | (((s0 + 3 < cnt) ? (sv.y >> 16) : 0u) << 16);
            *(LAS v2u*)(sidx + 4 * lane) = o; }
        asm volatile("s_waitcnt lgkmcnt(0)" ::: "memory");
        const bf16* Kb = AK + (size_t)b * SEQ * 128; const bf16* Vb = AV + (size_t)b * SEQ * 128;
#pragma unroll 1
        for (int g = 0; g < 2; ++g) {
            bf16x8_t aq[2];
#pragma unroll
            for (int c = 0; c < 2; ++c) { aq[c] = (bf16x8_t){0, 0, 0, 0, 0, 0, 0, 0}; if (arow) aq[c] = *(const bf16x8_t*)(AQ + (size_t)row * 512 + (4 * g + ahead) * 64 + 32 * c + 8 * kq); }
            float sc[16];
            const bf16* Kg = Kb + g * 64 + 8 * kq;
#pragma unroll
            for (int q4 = 0; q4 < 4; ++q4) {
                bf16x8_t kf[4][2];
#pragma unroll
                for (int u = 0; u < 4; ++u) { const int key = sidx[16 * (4 * q4 + u) + c16]; const bf16* kp = Kg + (size_t)key * 128; kf[u][0] = *(const bf16x8_t*)kp; kf[u][1] = *(const bf16x8_t*)(kp + 32); }
#pragma unroll
                for (int u = 0; u < 4; ++u) { f32x4_t a = {0.f, 0.f, 0.f, 0.f};
                    a = __builtin_amdgcn_mfma_f32_16x16x32_bf16(aq[0], kf[u][0], a, 0, 0, 0); a = __builtin_amdgcn_mfma_f32_16x16x32_bf16(aq[1], kf[u][1], a, 0, 0, 0);
                    sc[4 * q4 + u] = (16 * (4 * q4 + u) + c16 < cnt) ? a[0] : -INFINITY; }
            }
            float mx = sc[0];
#pragma unroll
            for (int i = 1; i < 16; ++i) mx = fmaxf(mx, sc[i]);
            mx = fmaxf(mx, __shfl_xor(mx, 1)); mx = fmaxf(mx, __shfl_xor(mx, 2)); mx = fmaxf(mx, __shfl_xor(mx, 4)); mx = fmaxf(mx, __shfl_xor(mx, 8));
            float sum = 0.f;
#pragma unroll
            for (int i = 0; i < 16; ++i) { sc[i] = fexp2(sc[i] - mx); sum += sc[i]; }
            sum += __shfl_xor(sum, 1); sum += __shfl_xor(sum, 2); sum += __shfl_xor(sum, 4); sum += __shfl_xor(sum, 8);
            const float inv = 1.0f / sum;
#pragma unroll
            for (int i = 0; i < 16; ++i) Pl[kq * 256 + 16 * i + c16] = (unsigned short)f2bf(sc[i]);
            asm volatile("s_waitcnt lgkmcnt(0)" ::: "memory");
            f32x4_t o[4];
#pragma unroll
            for (int dt = 0; dt < 4; ++dt) o[dt] = (f32x4_t){0.f, 0.f, 0.f, 0.f};
            const bf16* Vg = Vb + g * 64 + 8 * (lane & 7);
#pragma unroll 1
            for (int ch = 0; ch < 4; ++ch) {
                v4u vr[8];
#pragma unroll
                for (int i = 0; i < 8; ++i) { const int key = sidx[64 * ch + 8 * i + (lane >> 3)]; vr[i] = *(const v4u*)(Vg + (size_t)key * 128); }
#pragma unroll
                for (int i = 0; i < 8; ++i) *(LAS v4u*)(Vl + (8 * i + (lane >> 3)) * 160 + 16 * (lane & 7)) = vr[i];
                asm volatile("s_waitcnt lgkmcnt(0)" ::: "memory");
#pragma unroll
                for (int hf = 0; hf < 2; ++hf) {
                    bf16x8_t pa = (bf16x8_t){0, 0, 0, 0, 0, 0, 0, 0};
                    if (arow) { const s16x4_t lo = *(const LAS s16x4_t*)(Pl + ahead * 256 + 64 * ch + 32 * hf + 4 * kq), hi = *(const LAS s16x4_t*)(Pl + ahead * 256 + 64 * ch + 32 * hf + 16 + 4 * kq);
                        pa = (bf16x8_t){lo[0], lo[1], lo[2], lo[3], hi[0], hi[1], hi[2], hi[3]}; }
                    const unsigned va = vl_addr + (unsigned)((32 * hf + 4 * kq + (c16 >> 2)) * 160 + 8 * (c16 & 3));
                    s16x4_t vlo[4], vhi[4];
#pragma unroll
                    for (int dt = 0; dt < 4; ++dt) { vlo[dt] = tr_read(va + 32 * dt); vhi[dt] = tr_read(va + 16 * 160 + 32 * dt); }
                    asm volatile("s_waitcnt lgkmcnt(0)" : "+v"(vlo[0]), "+v"(vlo[1]), "+v"(vlo[2]), "+v"(vlo[3]), "+v"(vhi[0]), "+v"(vhi[1]), "+v"(vhi[2]), "+v"(vhi[3]) :: "memory");
                    __builtin_amdgcn_sched_barrier(0);
#pragma unroll
                    for (int dt = 0; dt < 4; ++dt) { const bf16x8_t vb = (bf16x8_t){vlo[dt][0], vlo[dt][1], vlo[dt][2], vlo[dt][3], vhi[dt][0], vhi[dt][1], vhi[dt][2], vhi[dt][3]};
                        o[dt] = __builtin_amdgcn_mfma_f32_16x16x32_bf16(pa, vb, o[dt], 0, 0, 0); }
                }
                asm volatile("s_waitcnt lgkmcnt(0)" ::: "memory");
            }
            bf16* op = OA + (size_t)row * 512 + (4 * g + kq) * 64 + c16;
#pragma unroll
            for (int dt = 0; dt < 4; ++dt) op[16 * dt] = (bf16)f2bf(o[dt][0] * inv);
        }
    }
}

typedef float f32x2_t __attribute__((ext_vector_type(2))); typedef __bf16 bf16x2v_t __attribute__((ext_vector_type(2)));
__device__ __forceinline__ unsigned cvtpk_s(float lo, float hi) { f32x2_t v = {lo, hi}; bf16x2v_t b = __builtin_convertvector(v, bf16x2v_t); return __builtin_bit_cast(unsigned, b); }
__device__ __forceinline__ int crow16(int reg, int h) { return (reg & 3) + 8 * (reg >> 2) + 4 * h; }

__device__ __forceinline__ void phase_swa_fast(const Params& p, int G) {
    const int tid = threadIdx.x, lane = tid & 63, wave = __builtin_amdgcn_readfirstlane(tid >> 6);
    const int r = lane & 31, h = lane >> 5, hh = wave >> 1, qh = wave & 1;
    unsigned char* ws = p.ws;
    const bf16* BQ = (const bf16*)(ws + WS_BQ); const bf16* BK = (const bf16*)(ws + WS_BK); const bf16* BV = (const bf16*)(ws + WS_BV); bf16* OB = (bf16*)(ws + WS_BQ);
    for (int k = 0;; ++k) {
        int b, idx;
        if (G >= 8 && (G & 7) == 0) { idx = (blockIdx.x >> 3) + (G >> 3) * k; if (idx >= 64) break; b = blockIdx.x & 7; }
        else { const int u = blockIdx.x + k * G; if (u >= 512) break; b = u >> 6; idx = u & 63; }
        const int qb = idx >> 1, g = idx & 1, head = 4 * g + hh;
        const float sink = p.sinks[head] * LOG2E;
        const bf16* Kb = BK + (size_t)b * SEQ * 128 + g * 64 + 8 * h; const bf16* Vb = BV + (size_t)b * SEQ * 128 + g * 64 + r;
#pragma unroll 1
        for (int qt = 0; qt < 2; ++qt) {
            const int q0 = 128 * qb + 64 * qh + 32 * qt;
            const size_t qrow = (size_t)b * SEQ + q0 + r;
            bf16x8_t qf[4];
#pragma unroll
            for (int s = 0; s < 4; ++s) qf[s] = *(const bf16x8_t*)(BQ + qrow * 512 + head * 64 + 16 * s + 8 * h);
            f32x16_t S[5];
#pragma unroll
            for (int kt = 0; kt < 5; ++kt) {
                const int kb0 = q0 - 128 + 32 * kt; const int krow_ = kb0 + r; const int kc = krow_ < 0 ? 0 : krow_;
                bf16x8_t kf[4];
#pragma unroll
                for (int s = 0; s < 4; ++s) kf[s] = *(const bf16x8_t*)(Kb + (size_t)kc * 128 + 16 * s);
                f32x16_t a = {0.f, 0.f, 0.f, 0.f, 0.f, 0.f, 0.f, 0.f, 0.f, 0.f, 0.f, 0.f, 0.f, 0.f, 0.f, 0.f};
#pragma unroll
                for (int s = 0; s < 4; ++s) a = __builtin_amdgcn_mfma_f32_32x32x16_bf16(kf[s], qf[s], a, 0, 0, 0);
#pragma unroll
                for (int i = 0; i < 16; ++i) { const int key = kb0 + crow16(i, h); const int rel = q0 + r - key; S[kt][i] = (key >= 0 && rel >= 0 && rel < WIN) ? a[i] : -INFINITY; }
            }
            float mx = sink;
#pragma unroll
            for (int kt = 0; kt < 5; ++kt)
#pragma unroll
                for (int i = 0; i < 16; ++i) mx = fmaxf(mx, S[kt][i]);
            mx = fmaxf(mx, __shfl_xor(mx, 32));
            float l = 0.f;
#pragma unroll
            for (int kt = 0; kt < 5; ++kt)
#pragma unroll
                for (int i = 0; i < 16; ++i) { S[kt][i] = fexp2(S[kt][i] - mx); l += S[kt][i]; }
            l += __shfl_xor(l, 32); l += fexp2(sink - mx);
            const float linv = 1.0f / l;
            f32x16_t O0 = {0.f, 0.f, 0.f, 0.f, 0.f, 0.f, 0.f, 0.f, 0.f, 0.f, 0.f, 0.f, 0.f, 0.f, 0.f, 0.f}, O1 = O0;
#pragma unroll
            for (int kt = 0; kt < 5; ++kt) {
                const int kb0 = q0 - 128 + 32 * kt;
#pragma unroll
                for (int s = 0; s < 2; ++s) {
                    v4u pw; pw.x = cvtpk_s(S[kt][8 * s + 0], S[kt][8 * s + 1]); pw.y = cvtpk_s(S[kt][8 * s + 2], S[kt][8 * s + 3]); pw.z = cvtpk_s(S[kt][8 * s + 4], S[kt][8 * s + 5]); pw.w = cvtpk_s(S[kt][8 * s + 6], S[kt][8 * s + 7]);
                    const bf16x8_t pa = __builtin_bit_cast(bf16x8_t, pw);
                    unsigned short v0[8], v1[8];
#pragma unroll
                    for (int j = 0; j < 8; ++j) { int key = kb0 + 16 * s + 8 * (j >> 2) + 4 * h + (j & 3); key = key < 0 ? 0 : key; v0[j] = Vb[(size_t)key * 128]; v1[j] = Vb[(size_t)key * 128 + 32]; }
                    const bf16x8_t vb0 = (bf16x8_t){(short)v0[0], (short)v0[1], (short)v0[2], (short)v0[3], (short)v0[4], (short)v0[5], (short)v0[6], (short)v0[7]};
                    const bf16x8_t vb1 = (bf16x8_t){(short)v1[0], (short)v1[1], (short)v1[2], (short)v1[3], (short)v1[4], (short)v1[5], (short)v1[6], (short)v1[7]};
                    O0 = __builtin_amdgcn_mfma_f32_32x32x16_bf16(pa, vb0, O0, 0, 0, 0); O1 = __builtin_amdgcn_mfma_f32_32x32x16_bf16(pa, vb1, O1, 0, 0, 0);
                }
            }
            bf16* op = OB + ((size_t)b * SEQ + q0) * 512 + head * 64 + r;
#pragma unroll
            for (int i = 0; i < 16; ++i) { const int qq = crow16(i, h); const float li = __shfl(linv, qq); op[(size_t)qq * 512] = (bf16)f2bf(O0[i] * li); op[(size_t)qq * 512 + 32] = (bf16)f2bf(O1[i] * li); }
        }
    }
}

constexpr int NPHASE = 9;
__global__ void __launch_bounds__(NTHREADS, 2) mk_fwd(Params p) {
    extern __shared__ __attribute__((aligned(16))) unsigned char lds_raw[];
    LAS unsigned char* lds = (LAS unsigned char*)lds_raw;
    const int G = gridDim.x;
    unsigned char* ws = p.ws;
#if MK_ONE_LAUNCH
#define SEAM(k) do { if (lo <= (k) && (k) + 1 < hi) cg::this_grid().sync(); } while (0)
#else
#define SEAM(k) do { } while (0)
#endif
    const int lo = p.ph_lo, hi = p.ph_hi;
#ifndef PHMASK
#define PHMASK 0x1ffu
#endif
#define IN(k) (((PHMASK >> (k)) & 1u) && lo <= (k) && (k) < hi)
    if (IN(0)) { phase_prologue(p, lds, G); SEAM(0); }
    if (IN(1)) {
        pg8::Gemm g{(const bf16*)(ws + WS_XG), (const bf16*)(ws + WS_WIN), TOK, NIN, DM, nullptr, 1 << 30};
        pg8::StaticOrder S; S.init(TOK, NIN, G, (int)blockIdx.x);
        pg8::EpiInProj E{(const float*)(ws + WS_RSTD1), (const float*)(ws + WS_COS), (const float*)(ws + WS_SIN), ws, p.ikw, p.ikb};
        pg8::gemm_phase<pg8::EpiInProj, pg8::StaticOrder, true, true>(lds, g, S, E);
        SEAM(1);
    }
#if MK_SIMPLE_TOPK
    if (IN(2)) { phase_topk_simple(p, lds, G); SEAM(2); }
#else
    if (IN(2)) { phase_topk_fast(p, lds, G); SEAM(2); }
#endif
#if MK_SIMPLE_DSA
    if (IN(3)) { phase_attn_simple<true, true>(p, lds, G); SEAM(3); }
#else
#if MK_SIMPLE_SWA
    if (IN(3)) { phase_dsa_fast(p, lds, G); __syncthreads(); phase_attn_simple<false, true>(p, lds, G); SEAM(3); }
#else
    if (IN(3)) { phase_swa_fast(p, G); phase_dsa_fast(p, lds, G); SEAM(3); }
#endif
#endif
    if (IN(4)) {
        pg8::Gemm g{(const bf16*)(ws + WS_AQ), (const bf16*)(ws + WS_WAB), TOK, 2048, 512, (const bf16*)(ws + WS_BQ), 4};
        pg8::BranchOrder S{G, (int)blockIdx.x};
        pg8::EpiGate E{(const bf16*)(ws + WS_GA), (const bf16*)(ws + WS_GB), p.out, (bf16*)(ws + WS_MIX)};
        pg8::gemm_phase<pg8::EpiGate, pg8::BranchOrder, true, true>(lds, g, S, E);
        SEAM(4);
    }
    if (IN(5)) {
        pg8::Gemm g{(const bf16*)(ws + WS_MIX), (const bf16*)(ws + WS_WOUT), TOK, DM, DM, nullptr, 1 << 30};
        pg8::StaticOrder S; S.init(TOK, DM, G, (int)blockIdx.x);
        pg8::EpiResid<true> E{p.x, p.out, (bf16*)(ws + WS_XG), p.mlp_norm_w, (float*)(ws + WS_SS2)};
        pg8::gemm_phase<pg8::EpiResid<true>, pg8::StaticOrder, true, true>(lds, g, S, E);
        SEAM(5);
    }
    if (IN(6)) {
        pg8::Gemm g{(const bf16*)(ws + WS_XG), (const bf16*)(ws + WS_WUP), TOK, DFF, DM, nullptr, 1 << 30};
        pg8::StaticOrder S; S.init(TOK, DFF, G, (int)blockIdx.x);
        pg8::EpiUp E{(const float*)(ws + WS_SS2), (bf16*)(ws + WS_HID)};
        pg8::gemm_phase<pg8::EpiUp, pg8::StaticOrder, true, true>(lds, g, S, E);
        SEAM(6);
    }
    if (IN(7)) {
        pg8::Gemm g{(const bf16*)(ws + WS_HID), (const bf16*)(ws + WS_WDN), TOK, DM, DFF, nullptr, 1 << 30};
        pg8::StaticOrder S; S.init(TOK, DM, G, (int)blockIdx.x);
        pg8::EpiResid<false> E{p.out, p.out, nullptr, nullptr, (float*)(ws + WS_SS3)};
        pg8::gemm_phase<pg8::EpiResid<false>, pg8::StaticOrder, true, true>(lds, g, S, E);
        SEAM(7);
    }
    if (IN(8)) { phase_final(p, G); }
#undef IN
#undef SEAM
}

extern "C" void kernel_launch(void* const* d_in, const int* in_sizes, int n_in, void* d_out, int out_size, void* d_ws, size_t ws_size, hipStream_t stream) {
    static int grid = 0;
    if (grid == 0) {
        if (n_in != 13 || in_sizes[0] != TOK * DM || out_size != TOK * DM || ws_size < WS_END) {
            fprintf(stderr, "kernel_launch: unexpected shapes (n_in %d, in0 %d, out %d, ws %zu); nothing launched\n", n_in, n_in > 0 ? in_sizes[0] : -1, out_size, ws_size); grid = -1; return; }
        int dev = 0, cus = 0, per_cu = 0;
        (void)hipGetDevice(&dev); (void)hipDeviceGetAttribute(&cus, hipDeviceAttributeMultiprocessorCount, dev);
        if (hipFuncSetAttribute((const void*)mk_fwd, hipFuncAttributeMaxDynamicSharedMemorySize, LDS_BYTES) != hipSuccess) { fprintf(stderr, "kernel_launch: hipFuncSetAttribute failed\n"); grid = -1; return; }
        if (hipOccupancyMaxActiveBlocksPerMultiprocessor(&per_cu, (const void*)mk_fwd, NTHREADS, LDS_BYTES) != hipSuccess || per_cu < 1) { fprintf(stderr, "kernel_launch: occupancy query says %d blocks per CU\n", per_cu); per_cu = 1; }
        (void)hipGetLastError();
        if (per_cu > 1) per_cu = 1;
        grid = cus * per_cu;
    }
    if (grid < 0) return;
    Params p{};
    p.x = (const float*)d_in[0]; p.attn_norm_w = (const float*)d_in[1]; p.w_in = (const float*)d_in[2]; p.ikw = (const float*)d_in[3]; p.ikb = (const float*)d_in[4];
    p.sinks = (const float*)d_in[5]; p.w_a = (const float*)d_in[6]; p.w_b = (const float*)d_in[7]; p.w_out = (const float*)d_in[8]; p.mlp_norm_w = (const float*)d_in[9];
    p.w_up = (const float*)d_in[10]; p.w_down = (const float*)d_in[11]; p.final_w = (const float*)d_in[12];
    p.out = (float*)d_out; p.ws = (unsigned char*)d_ws;
    for (int i = 0; i < 32; ++i) p.inv_freq[i] = 1.0f / powf(10000.0f, (float)(2 * i) / 64.0f);
#if MK_ONE_LAUNCH
    p.ph_lo = 0; p.ph_hi = NPHASE;
    void* args[] = {&p};
    hipError_t e = hipLaunchCooperativeKernel((const void*)mk_fwd, dim3(grid), dim3(NTHREADS), args, LDS_BYTES, stream);
    if (e != hipSuccess) fprintf(stderr, "kernel_launch: cooperative launch failed: %s (grid %d)\n", hipGetErrorString(e), grid);
#else
    for (int ph = 0; ph < NPHASE; ++ph) {
        p.ph_lo = ph; p.ph_hi = ph + 1;
        hipLaunchKernelGGL(mk_fwd, dim3(grid), dim3(NTHREADS), LDS_BYTES, stream, p);
    }
#endif
}
```

```cpp
#include <hip/hip_runtime.h>
#include <hip/hip_cooperative_groups.h>
#include <cstdio>
#include <cstdint>
namespace cg = cooperative_groups;

#ifndef MK_ONE_LAUNCH
#define MK_ONE_LAUNCH 1
#endif
#ifndef MK_SIMPLE_TOPK
#define MK_SIMPLE_TOPK 0
#endif
#ifndef MK_SIMPLE_SWA
#define MK_SIMPLE_SWA 0
#endif
#ifndef MK_SIMPLE_DSA
#define MK_SIMPLE_DSA 0
#endif

constexpr int NBATCH = 8, SEQ = 4096, DM = 1024, TOK = NBATCH * SEQ, DFF = 4096, TOPK = 256, WIN = 128;
constexpr int NIN = 4352;
constexpr float RMS_EPS = 1e-6f, LN_EPS = 1e-6f;
constexpr float QSCALE = 0.125f * 1.4426950408889634f;
constexpr float LOG2E = 1.4426950408889634f;
constexpr float W_SCALE = 0.04419417382415922f;
constexpr int C_AQ = 0, C_AK = 512, C_AV = 640, C_IQ = 768, C_IK = 1280, C_IW = 1344, C_BQ = 1352, C_BK = 1864, C_BV = 1992, C_GA = 2120, C_GB = 3144, D_IN = 4168;

constexpr size_t MiB = 1u << 20;
constexpr size_t WS_RSTD1 = 0, WS_SS2 = 128 * 1024, WS_SS3 = 256 * 1024;
constexpr size_t WS_COS = 1 * MiB, WS_SIN = 1 * MiB + 512 * 1024;
constexpr size_t WS_WIN = 2 * MiB, WS_WAB = 11 * MiB, WS_WOUT = 13 * MiB, WS_WUP = 15 * MiB, WS_WDN = 23 * MiB;
constexpr size_t WS_XG = 32 * MiB;
constexpr size_t WS_AQ = 96 * MiB, WS_IQ = 128 * MiB, WS_BQ = 160 * MiB, WS_AK = 192 * MiB, WS_AV = 200 * MiB, WS_BK = 208 * MiB, WS_BV = 216 * MiB;
constexpr size_t WS_IK = 224 * MiB, WS_IW = 228 * MiB, WS_SEL = 230 * MiB, WS_GA = 248 * MiB, WS_GB = 312 * MiB, WS_MIX = 376 * MiB, WS_END = 440 * MiB;
#ifndef MK_SEPARATE_O
#define MK_SEPARATE_O 0
#endif
#ifndef REP_MASK
#define REP_MASK 0u
#endif
constexpr size_t WS_OA = MK_SEPARATE_O ? 440 * MiB : WS_AQ, WS_OB = MK_SEPARATE_O ? 472 * MiB : WS_BQ, WS_NEED = MK_SEPARATE_O ? 504 * MiB : WS_END;
constexpr size_t WS_HID = 96 * MiB;
static_assert(WS_WIN + (size_t)NIN * DM * 2 <= WS_WAB && WS_HID + (size_t)TOK * DFF * 2 <= WS_MIX, "ws map");

constexpr int LDS_RING = 131072, LDS_BYTES = 163840;

#define GAS __attribute__((address_space(1)))
#define LAS __attribute__((address_space(3)))
typedef unsigned short bf16;
typedef unsigned v4u __attribute__((ext_vector_type(4)));
typedef unsigned v2u __attribute__((ext_vector_type(2)));
typedef float v4f __attribute__((ext_vector_type(4)));

__device__ __forceinline__ float bf2f(unsigned short u) { return __uint_as_float((unsigned)u << 16); }
__device__ __forceinline__ float bflo(unsigned u) { return __uint_as_float(u << 16); }
__device__ __forceinline__ float bfhi(unsigned u) { return __uint_as_float(u & 0xffff0000u); }
__device__ __forceinline__ unsigned f2bf(float f) { unsigned u = __float_as_uint(f); return (u + 0x7fffu + ((u >> 16) & 1u)) >> 16; }
__device__ __forceinline__ unsigned pk2(float lo, float hi) { unsigned r; asm volatile("v_cvt_pk_bf16_f32 %0, %1, %2" : "=v"(r) : "v"(lo), "v"(hi)); return r; }
__device__ __forceinline__ float fexp2(float x) { return __builtin_amdgcn_exp2f(x); }
__device__ __forceinline__ float frsq(float x) { return __builtin_amdgcn_rsqf(x); }
__device__ __forceinline__ float frcp(float x) { return __builtin_amdgcn_rcpf(x); }
__device__ __forceinline__ float sigmoidf_(float x) { return frcp(1.0f + fexp2(-x * LOG2E)); }
__device__ __forceinline__ float wave_sum(float v) {
#pragma unroll
    for (int o = 1; o < 64; o <<= 1) v += __shfl_xor(v, o);
    return v;
}
__device__ __forceinline__ float wave_max(float v) {
#pragma unroll
    for (int o = 1; o < 64; o <<= 1) v = fmaxf(v, __shfl_xor(v, o));
    return v;
}
__device__ __forceinline__ int mbcnt64(unsigned long long m) { return __builtin_amdgcn_mbcnt_hi((unsigned)(m >> 32), __builtin_amdgcn_mbcnt_lo((unsigned)m, 0u)); }

namespace pg8 {
#define PG8_LAS __attribute__((address_space(3)))
typedef unsigned short bf16_t;
typedef short bf16x8 __attribute__((ext_vector_type(8)));
typedef float f32x4 __attribute__((ext_vector_type(4)));
typedef unsigned u32x4 __attribute__((ext_vector_type(4)));
constexpr int BM = 256, BK = 64, HALF = 128, HTB = HALF * BK * 2  , STAGE_BYTES = 8 * HTB, NXCD = 8, WGM = 8;

__host__ __device__ __forceinline__ int lds_byte(int r, int c) { const int st = (r >> 4) * 2 + (c >> 5), rr = r & 15, cc = c & 31, ob = rr * 64 + cc * 2; return st * 1024 + (ob ^ (((ob >> 9) & 1) << 5)); }
__host__ __device__ __forceinline__ void stage_rc(int b, int& R, int& C) { const int st = b / 1024, sb = b % 1024, swz = sb ^ (((sb >> 9) & 1) << 5); R = (st >> 1) * 16 + swz / 64; C = (st & 1) * 32 + (swz % 64) / 2; }
__host__ __device__ __forceinline__ int perm32(int rho) { const int n = rho >> 4, i = rho & 15; return 8 * (i >> 2) + 4 * n + (i & 3); }

struct Unit { int pm, pn; };
struct Gemm { const bf16_t* A; const bf16_t* Bt; int M, N, K; const bf16_t* A2; int asplit;
    __device__ __forceinline__ const char* abase(const Unit& u) const { return (const char*)(u.pn >= asplit ? A2 : A); } };

struct StaticOrder {
    int nM, nN, nwg, G, c;
    __host__ __device__ void init(int M, int N, int G_, int c_) { nM = M / BM; nN = N / BM; nwg = nM * nN; G = G_; c = c_; }
    __host__ __device__ bool next(int i, Unit& u) const {
        const long L = (long)i * G + c; if (L >= nwg) return false;
        int wgid = (int)L; { const int q = nwg / NXCD, r = nwg % NXCD, xcd = wgid % NXCD, off = wgid / NXCD; wgid = (xcd < r ? xcd * (q + 1) : r * (q + 1) + (xcd - r) * q) + off; }
        const int nig = WGM * nN, gid = wgid / nig, fm = gid * WGM, gsz = (nM - fm) < WGM ? (nM - fm) : WGM;
        u.pm = fm + ((wgid % nig) % gsz); u.pn = (wgid % nig) / gsz; return true;
    }
    __device__ __forceinline__ void a_ready(const Unit&) const {}
    __device__ __forceinline__ void done(const Unit&) const {}
};

__device__ __forceinline__ unsigned cvt_pk_bf16(float lo, float hi) { unsigned r; asm volatile("v_cvt_pk_bf16_f32 %0, %1, %2" : "=v"(r) : "v"(lo), "v"(hi)); return r; }
__device__ __forceinline__ u32x4 pack8(const float (&v)[8]) { u32x4 w; w.x = cvt_pk_bf16(v[0], v[1]); w.y = cvt_pk_bf16(v[2], v[3]); w.z = cvt_pk_bf16(v[4], v[5]); w.w = cvt_pk_bf16(v[6], v[7]); return w; }

struct EpiInProj {
    static constexpr bool PERM = true, AFTER_DRAIN = false;
    const float* rstd1; const float* cs; const float* sn; unsigned char* ws; const float* ikw; const float* ikb;
    __device__ __forceinline__ void operator()(const f32x4 (&acc)[2][2][4][2], const Unit& u, int wr, int wc, int fr_, int fq_) const {
        const int pn = u.pn; int fr = fr_, fq = fq_;
        asm volatile("" : "+v"(fr), "+v"(fq));
#pragma unroll
        for (int ai = 0; ai < 2; ++ai)
#pragma unroll
            for (int m = 0; m < 4; ++m) {
                const int row = u.pm * BM + ai * HALF + wr * 64 + m * 16 + fr;
                const float rs = rstd1[row];
                float x1[8], x2[8];
#pragma unroll
                for (int j = 0; j < 4; ++j) { x1[j] = acc[ai][0][m][0][j] * rs; x1[4 + j] = acc[ai][0][m][1][j] * rs; x2[j] = acc[ai][1][m][0][j] * rs; x2[4 + j] = acc[ai][1][m][1][j] * rs; }
                if (pn >= 9) {
                    bf16_t* G = (bf16_t*)(ws + WS_GA + (size_t)((pn - 9) >> 2) * (WS_GB - WS_GA)) + (size_t)row * 1024 + 256 * ((pn - 9) & 3) + 32 * wc + 8 * fq;
                    float a[8], b[8];
#pragma unroll
                    for (int j = 0; j < 8; ++j) { a[j] = 1.0f / (1.0f + __builtin_amdgcn_exp2f(-x1[j] * 1.4426950408889634f)); b[j] = 1.0f / (1.0f + __builtin_amdgcn_exp2f(-x2[j] * 1.4426950408889634f)); }
                    *(u32x4*)G = pack8(a); *(u32x4*)(G + 128) = pack8(b);
                } else if (pn == 8) {
                    if (wc == 0) {
                        float s = 0.f;
#pragma unroll
                        for (int j = 0; j < 8; ++j) s += x1[j] + x2[j];
                        s += __shfl_xor(s, 16); s += __shfl_xor(s, 32);
                        const float mu = s * (1.0f / 64.0f); float q = 0.f;
#pragma unroll
                        for (int j = 0; j < 8; ++j) { x1[j] -= mu; x2[j] -= mu; q += x1[j] * x1[j] + x2[j] * x2[j]; }
                        q += __shfl_xor(q, 16); q += __shfl_xor(q, 32);
                        const float rstd = __builtin_amdgcn_rsqf(q * (1.0f / 64.0f) + 1e-6f);
                        const int pos = row & 4095; const float* cp = cs + pos * 32 + 8 * fq; const float* sp = sn + pos * 32 + 8 * fq;
                        float o1[8], o2[8];
#pragma unroll
                        for (int j = 0; j < 8; ++j) { const float y1 = x1[j] * rstd * ikw[8 * fq + j] + ikb[8 * fq + j], y2 = x2[j] * rstd * ikw[32 + 8 * fq + j] + ikb[32 + 8 * fq + j];
                            const float c = cp[j], sI = sp[j]; o1[j] = y1 * c - y2 * sI; o2[j] = y2 * c + y1 * sI; }
                        bf16_t* dst = (bf16_t*)(ws + WS_IK) + (size_t)row * 64 + 8 * fq;
                        *(u32x4*)dst = pack8(o1); *(u32x4*)(dst + 32) = pack8(o2);
                    } else if (wc == 1 && fq == 0) {
                        float* dst = (float*)(ws + WS_IW) + (size_t)row * 8;
                        *(f32x4*)dst = (f32x4){x1[0], x1[1], x1[2], x1[3]} * 0.04419417382415922f; *(f32x4*)(dst + 4) = (f32x4){x1[4], x1[5], x1[6], x1[7]} * 0.04419417382415922f;
                    }
                } else if (pn >= 6) {
                    bf16_t* Kd = (bf16_t*)(ws + WS_AK + (size_t)(pn - 6) * (WS_BK - WS_AK)); bf16_t* Vd = (bf16_t*)(ws + WS_AV + (size_t)(pn - 6) * (WS_BV - WS_AV));
                    if (wc < 2) {
                        const int pos = row & 4095; const float* cp = cs + pos * 32 + 8 * fq; const float* sp = sn + pos * 32 + 8 * fq;
                        float o1[8], o2[8];
#pragma unroll
                        for (int j = 0; j < 8; ++j) { const float c = cp[j], sI = sp[j]; o1[j] = x1[j] * c - x2[j] * sI; o2[j] = x2[j] * c + x1[j] * sI; }
                        bf16_t* dst = Kd + (size_t)row * 128 + wc * 64 + 8 * fq;
                        *(u32x4*)dst = pack8(o1); *(u32x4*)(dst + 32) = pack8(o2);
                    } else {
                        bf16_t* dst = Vd + (size_t)row * 128 + 32 * (wc - 2) + 8 * fq;
                        *(u32x4*)dst = pack8(x1); *(u32x4*)(dst + 64) = pack8(x2);
                    }
                } else {
                    bf16_t* Q = (bf16_t*)(ws + WS_AQ + (size_t)(pn >> 1) * (WS_IQ - WS_AQ)); const float sc = (pn >= 2 && pn < 4) ? 1.0f : 0.125f * 1.4426950408889634f;
                    const int pos = row & 4095; const float* cp = cs + pos * 32 + 8 * fq; const float* sp = sn + pos * 32 + 8 * fq;
                    float o1[8], o2[8];
#pragma unroll
                    for (int j = 0; j < 8; ++j) { const float c = cp[j], sI = sp[j]; o1[j] = (x1[j] * c - x2[j] * sI) * sc; o2[j] = (x2[j] * c + x1[j] * sI) * sc; }
                    bf16_t* dst = Q + (size_t)row * 512 + (4 * (pn & 1) + wc) * 64 + 8 * fq;
                    *(u32x4*)dst = pack8(o1); *(u32x4*)(dst + 32) = pack8(o2);
                }
                asm volatile("" ::: "memory");
            }
    }
};

struct EpiGate {
    static constexpr bool PERM = true, AFTER_DRAIN = false;
    const bf16_t *GA, *GB; float* P; bf16_t* MIX;
    __device__ __forceinline__ void operator()(const f32x4 (&acc)[2][2][4][2], const Unit& u, int wr, int wc, int fr, int fq) const {
        const bool second = u.pn >= 4; const bf16_t* G = second ? GB : GA;
#pragma unroll
        for (int ai = 0; ai < 2; ++ai)
#pragma unroll
            for (int m = 0; m < 4; ++m) {
                const int row = u.pm * BM + ai * HALF + wr * 64 + m * 16 + fr;
#pragma unroll
                for (int bj = 0; bj < 2; ++bj) {
                    const size_t off = (size_t)row * 1024 + 256 * (u.pn & 3) + 128 * bj + 32 * wc + 8 * fq;
                    const u32x4 gw = *(const u32x4*)(G + off);
                    float v[8];
#pragma unroll
                    for (int j = 0; j < 4; ++j) { v[j] = acc[ai][bj][m][0][j]; v[4 + j] = acc[ai][bj][m][1][j]; }
                    v[0] *= __uint_as_float(gw.x << 16); v[1] *= __uint_as_float(gw.x & 0xffff0000u); v[2] *= __uint_as_float(gw.y << 16); v[3] *= __uint_as_float(gw.y & 0xffff0000u);
                    v[4] *= __uint_as_float(gw.z << 16); v[5] *= __uint_as_float(gw.z & 0xffff0000u); v[6] *= __uint_as_float(gw.w << 16); v[7] *= __uint_as_float(gw.w & 0xffff0000u);
                    if (!second) { *(f32x4*)(P + off) = (f32x4){v[0], v[1], v[2], v[3]}; *(f32x4*)(P + off + 4) = (f32x4){v[4], v[5], v[6], v[7]}; }
                    else { const f32x4 p0 = *(const f32x4*)(P + off), p1 = *(const f32x4*)(P + off + 4);
#pragma unroll
                        for (int j = 0; j < 4; ++j) { v[j] += p0[j]; v[4 + j] += p1[j]; }
                        *(u32x4*)(MIX + off) = pack8(v); }
                }
            }
    }
};

template <bool WITH_XG> struct EpiResid {
    static constexpr bool PERM = false, AFTER_DRAIN = false;
    const float* base; float* out; bf16_t* XG; const float* gw; float* ss;
    __device__ __forceinline__ void operator()(const f32x4 (&acc)[2][2][4][2], const Unit& u, int wr, int wc, int fr, int fq) const {
#pragma unroll
        for (int ai = 0; ai < 2; ++ai)
#pragma unroll
            for (int m = 0; m < 4; ++m) {
                const int row = u.pm * BM + ai * HALF + wr * 64 + m * 16 + fr; float s = 0.f;
#pragma unroll
                for (int bj = 0; bj < 2; ++bj)
#pragma unroll
                    for (int n = 0; n < 2; ++n) {
                        const int col = u.pn * BM + bj * HALF + wc * 32 + n * 16 + 4 * fq; const size_t off = (size_t)row * 1024 + col;
                        const f32x4 v = *(const f32x4*)(base + off) + acc[ai][bj][m][n];
                        *(f32x4*)(out + off) = v; s += (v[0] * v[0] + v[1] * v[1]) + (v[2] * v[2] + v[3] * v[3]);
                        if (WITH_XG) { const f32x4 g = *(const f32x4*)(gw + col); unsigned long long w = (unsigned long long)cvt_pk_bf16(v[0] * g[0], v[1] * g[1]) | ((unsigned long long)cvt_pk_bf16(v[2] * g[2], v[3] * g[3]) << 32);
                            *(unsigned long long*)(XG + off) = w; }
                    }
                s += __shfl_xor(s, 16); s += __shfl_xor(s, 32);
                if (fq == 0) atomicAdd(ss + row, s);
            }
    }
};

struct EpiUp {
    static constexpr bool PERM = true, AFTER_DRAIN = false;
    const float* ss; bf16_t* HID;
    __device__ __forceinline__ void operator()(const f32x4 (&acc)[2][2][4][2], const Unit& u, int wr, int wc, int fr, int fq) const {
#pragma unroll
        for (int ai = 0; ai < 2; ++ai)
#pragma unroll
            for (int m = 0; m < 4; ++m) {
                const int row = u.pm * BM + ai * HALF + wr * 64 + m * 16 + fr;
                const float rs = __builtin_amdgcn_rsqf(ss[row] * (1.0f / 1024.0f) + 1e-6f);
#pragma unroll
                for (int bj = 0; bj < 2; ++bj) {
                    float v[8];
#pragma unroll
                    for (int j = 0; j < 4; ++j) { float a = fmaxf(acc[ai][bj][m][0][j] * rs, 0.f), b = fmaxf(acc[ai][bj][m][1][j] * rs, 0.f); v[j] = a * a; v[4 + j] = b * b; }
                    *(u32x4*)(HID + (size_t)row * 4096 + u.pn * BM + bj * HALF + wc * 32 + 8 * fq) = pack8(v);
                }
            }
    }
};

struct BranchOrder {
    int G, c;
    __device__ __forceinline__ bool next(int i, Unit& u) const {
        const int tile = (i >> 1) * G + c; if (tile >= 128 * 4) return false;
        u.pm = tile >> 2; u.pn = (tile & 3) + 4 * (i & 1); return true;
    }
    __device__ __forceinline__ void a_ready(const Unit&) const {}
    __device__ __forceinline__ void done(const Unit&) const {}
};

template <class Epi, class Sched, bool ALIGN_EPI = false, bool SP2 = false>
__device__ __forceinline__ void gemm_phase(PG8_LAS unsigned char* lds, const Gemm g, const Sched& S, const Epi& E) {
    const int tid = threadIdx.x, wid = __builtin_amdgcn_readfirstlane(tid >> 6), lane = tid & 63, wr = wid >> 2, wc = wid & 3, fr = lane & 15, fq = lane >> 4;
    const int K = g.K, nt = K / BK;
    unsigned voffA[2], voffB[2];
#pragma unroll
    for (int i = 0; i < 2; ++i) { int R, C; stage_rc(tid * 16 + i * 8192, R, C); const int Rb = Epi::PERM ? ((R & ~31) + perm32(R & 31)) : R;
        voffA[i] = (unsigned)(R * K + C) * 2u; voffB[i] = (unsigned)(Rb * K + C) * 2u; }
    const size_t kstep = (size_t)(BK * 2);
    const size_t hstep = (size_t)HALF * K * 2;
    const size_t tstep = 2 * hstep;
    const unsigned ldsw = (unsigned)wid * 1024u;
    const int aoff = lds_byte(wr * 64 + fr, fq * 8), boff = lds_byte(wc * 32 + fr, fq * 8);
#define PG8_SA(b, h) (((b) * 2 + (h)) * HTB)
#define PG8_SB(b, h) ((4 + (b) * 2 + (h)) * HTB)
#define PG8_STAGE(bufoff, gbase, voff) do { _Pragma("unroll") for (int _i = 0; _i < 2; ++_i) \
        __builtin_amdgcn_global_load_lds((const unsigned*)((const char*)(gbase) + (voff)[_i]), (PG8_LAS unsigned*)(lds + (bufoff) + ldsw + _i * 8192), 16, 0, 0); } while (0)
#define PG8_LDA(dst, b, h) do { _Pragma("unroll") for (int m = 0; m < 4; ++m) _Pragma("unroll") for (int k = 0; k < 2; ++k) dst[m][k] = *(const PG8_LAS bf16x8*)(lds + PG8_SA(b, h) + aoff + m * 2048 + k * 1024); } while (0)
#define PG8_LDB(dst, b, h) do { _Pragma("unroll") for (int n = 0; n < 2; ++n) _Pragma("unroll") for (int k = 0; k < 2; ++k) dst[n][k] = *(const PG8_LAS bf16x8*)(lds + PG8_SB(b, h) + boff + n * 2048 + k * 1024); } while (0)
#define PG8_MMA(ai, bj, At, Bt) do { __builtin_amdgcn_s_setprio(1); _Pragma("unroll") for (int m = 0; m < 4; ++m) _Pragma("unroll") for (int n = 0; n < 2; ++n) _Pragma("unroll") for (int k = 0; k < 2; ++k) \
        acc[ai][bj][m][n] = __builtin_amdgcn_mfma_f32_16x16x32_bf16(Bt[n][k], At[m][k], acc[ai][bj][m][n], 0, 0, 0); __builtin_amdgcn_s_setprio(0); } while (0)
#define PG8_WAIT_V(n) asm volatile("s_waitcnt vmcnt(" #n ")" ::: "memory")
#define PG8_WAIT_L(n) asm volatile("s_waitcnt lgkmcnt(" #n ")" ::: "memory")
#define PG8_BAR __builtin_amdgcn_s_barrier()
#define PG8_SCHED __builtin_amdgcn_sched_barrier(0)
    Unit cur, nxt; int ui = 0;
    if (!S.next(0, cur)) return;
    f32x4 acc[2][2][4][2];
#pragma unroll
    for (int a = 0; a < 2; ++a)
#pragma unroll
        for (int b = 0; b < 2; ++b)
#pragma unroll
            for (int m = 0; m < 4; ++m)
#pragma unroll
                for (int n = 0; n < 2; ++n) acc[a][b][m][n] = (f32x4){0.f, 0.f, 0.f, 0.f};
    bf16x8 At[4][2], B0[2][2], B1[2][2];
    const char* cA = g.abase(cur) + (size_t)cur.pm * tstep; const char* cB = (const char*)g.Bt + (size_t)cur.pn * tstep;
    S.a_ready(cur);
    if constexpr (SP2) {
        PG8_STAGE(PG8_SB(0, 0), cB, voffB); PG8_STAGE(PG8_SB(0, 1), cB + hstep, voffB); PG8_STAGE(PG8_SA(0, 0), cA, voffA); PG8_STAGE(PG8_SA(0, 1), cA + hstep, voffA);
        if (wr == 1) PG8_BAR;
        PG8_WAIT_V(2); PG8_BAR;
        PG8_STAGE(PG8_SB(1, 0), cB + kstep, voffB); PG8_STAGE(PG8_SA(1, 0), cA + kstep, voffA); PG8_STAGE(PG8_SB(1, 1), cB + hstep + kstep, voffB);
        PG8_WAIT_V(6); PG8_BAR;
    } else {
        PG8_STAGE(PG8_SB(0, 0), cB, voffB); PG8_STAGE(PG8_SA(0, 0), cA, voffA); PG8_STAGE(PG8_SB(0, 1), cB + hstep, voffB); PG8_STAGE(PG8_SA(0, 1), cA + hstep, voffA);
        if (wr == 1) PG8_BAR;
        PG8_WAIT_V(4); PG8_BAR;
        PG8_STAGE(PG8_SB(1, 0), cB + kstep, voffB); PG8_STAGE(PG8_SA(1, 0), cA + kstep, voffA); PG8_STAGE(PG8_SB(1, 1), cB + hstep + kstep, voffB);
        PG8_WAIT_V(6); PG8_BAR;
    }
    for (;;) {
        const bool has_next = S.next(ui + 1, nxt);
        const char* nA = has_next ? g.abase(nxt) + (size_t)nxt.pm * tstep : cA; const char* nB = has_next ? (const char*)g.Bt + (size_t)nxt.pn * tstep : cB;
        for (int t = 0; t < nt; t += 2) {
            const bool last = (t == nt - 2);
            const char* a1 = cA + (size_t)(t + 1) * kstep;
            const char* a2 = last ? nA : cA + (size_t)(t + 2) * kstep; const char* b2 = last ? nB : cB + (size_t)(t + 2) * kstep;
            const char* a3 = a2 + kstep; const char* b3 = b2 + kstep;
            if (last && has_next) S.a_ready(nxt);
            if constexpr (SP2) {
            PG8_LDB(B0, 0, 0); PG8_LDB(B1, 0, 1); PG8_SCHED; PG8_LDA(At, 0, 0); PG8_STAGE(PG8_SA(1, 1), a1 + hstep, voffA);
            PG8_WAIT_V(8); PG8_WAIT_L(0); PG8_BAR; PG8_MMA(0, 0, At, B0); PG8_MMA(0, 1, At, B1); PG8_BAR; PG8_SCHED;
            PG8_LDA(At, 0, 1); PG8_STAGE(PG8_SB(0, 0), b2, voffB); PG8_STAGE(PG8_SB(0, 1), b2 + hstep, voffB); PG8_STAGE(PG8_SA(0, 0), a2, voffA);
            PG8_WAIT_V(8); PG8_WAIT_L(0); PG8_BAR; PG8_MMA(1, 0, At, B0); PG8_MMA(1, 1, At, B1); PG8_BAR; PG8_SCHED;
            PG8_LDB(B0, 1, 0); PG8_LDB(B1, 1, 1); PG8_SCHED; PG8_LDA(At, 1, 0); PG8_STAGE(PG8_SA(0, 1), a2 + hstep, voffA);
            PG8_WAIT_V(8); PG8_WAIT_L(0); PG8_BAR; PG8_MMA(0, 0, At, B0); PG8_MMA(0, 1, At, B1); PG8_BAR; PG8_SCHED;
            PG8_LDA(At, 1, 1); PG8_STAGE(PG8_SB(1, 0), b3, voffB); PG8_STAGE(PG8_SB(1, 1), b3 + hstep, voffB); PG8_STAGE(PG8_SA(1, 0), a3, voffA);
            PG8_WAIT_V(8); PG8_WAIT_L(0); PG8_BAR; PG8_MMA(1, 0, At, B0); PG8_MMA(1, 1, At, B1); PG8_BAR; PG8_SCHED;
            } else {
            PG8_LDB(B0, 0, 0); PG8_SCHED; PG8_LDA(At, 0, 0); PG8_STAGE(PG8_SA(1, 1), a1 + hstep, voffA);
            PG8_WAIT_L(8); PG8_BAR; PG8_WAIT_L(0); PG8_MMA(0, 0, At, B0); PG8_BAR; PG8_SCHED;
            PG8_LDB(B1, 0, 1); PG8_STAGE(PG8_SB(0, 0), b2, voffB);
            PG8_BAR; PG8_WAIT_L(0); PG8_MMA(0, 1, At, B1); PG8_BAR;
            PG8_LDA(At, 0, 1); PG8_STAGE(PG8_SA(0, 0), a2, voffA);
            PG8_BAR; PG8_WAIT_L(0); PG8_MMA(1, 0, At, B0); PG8_BAR; PG8_SCHED;
            PG8_STAGE(PG8_SB(0, 1), b2 + hstep, voffB);
            PG8_WAIT_V(6); PG8_BAR; PG8_MMA(1, 1, At, B1); PG8_BAR;
            PG8_LDB(B0, 1, 0); PG8_SCHED; PG8_LDA(At, 1, 0); PG8_STAGE(PG8_SA(0, 1), a2 + hstep, voffA);
            PG8_WAIT_L(8); PG8_BAR; PG8_WAIT_L(0); PG8_MMA(0, 0, At, B0); PG8_BAR; PG8_SCHED;
            PG8_LDB(B1, 1, 1); PG8_STAGE(PG8_SB(1, 0), b3, voffB);
            PG8_BAR; PG8_WAIT_L(0); PG8_MMA(0, 1, At, B1); PG8_BAR;
            PG8_LDA(At, 1, 1); PG8_STAGE(PG8_SA(1, 0), a3, voffA);
            PG8_BAR; PG8_WAIT_L(0); PG8_MMA(1, 0, At, B0); PG8_BAR; PG8_SCHED;
            PG8_STAGE(PG8_SB(1, 1), b3 + hstep, voffB);
            PG8_WAIT_V(6); PG8_BAR; PG8_MMA(1, 1, At, B1); PG8_BAR;
            }
        }
        if constexpr (ALIGN_EPI) { if (wr == 0) PG8_BAR; }
        if constexpr (!Epi::AFTER_DRAIN) { E(acc, cur, wr, wc, fr, fq); S.done(cur); }
        if (!has_next) break;
#pragma unroll
        for (int a = 0; a < 2; ++a)
#pragma unroll
            for (int b = 0; b < 2; ++b)
#pragma unroll
                for (int m = 0; m < 4; ++m)
#pragma unroll
                    for (int n = 0; n < 2; ++n) acc[a][b][m][n] = (f32x4){0.f, 0.f, 0.f, 0.f};
        cur = nxt; cA = nA; cB = nB; ++ui;
        if constexpr (ALIGN_EPI) { if (wr == 1) PG8_BAR; }
    }
    PG8_WAIT_V(0);
    if constexpr (!ALIGN_EPI) { if (wr == 0) PG8_BAR; }
    PG8_BAR;
    if constexpr (Epi::AFTER_DRAIN) { E.fused(acc, cur, wr, wc, fr, fq, lds, wid, lane); S.done(cur); }
#undef PG8_SA
#undef PG8_SB
#undef PG8_STAGE
#undef PG8_LDA
#undef PG8_LDB
#undef PG8_MMA
#undef PG8_WAIT_V
#undef PG8_WAIT_L
#undef PG8_BAR
#undef PG8_SCHED
}
}
struct Params {
    const float *x, *attn_norm_w, *w_in, *ikw, *ikb, *sinks, *w_a, *w_b, *w_out, *mlp_norm_w, *w_up, *w_down, *final_w;
    float* out; unsigned char* ws;
    float inv_freq[32];
    int ph_lo, ph_hi;
};
constexpr int NWAVES = 8, NTHREADS = 512;

__device__ __forceinline__ int win_src_group(int grp, int& cnt) {
    const int tile = grp >> 3, g = grp & 7; cnt = 32;
    if (tile < 6) { const int base = tile < 2 ? C_AQ : (tile < 4 ? C_IQ : C_BQ); const int head = 4 * (tile & 1) + (g & 3); return base + head * 64 + 32 * (g >> 2); }
    if (tile < 8) { const int kb = tile == 6 ? C_AK : C_BK, vb = tile == 6 ? C_AV : C_BV; const int hf = g >> 2, q = g & 3;
        if (q < 2) return kb + q * 64 + 32 * hf; return vb + 64 * hf + 32 * (q - 2); }
    if (tile == 8) { if (g == 0) return C_IK; if (g == 4) return C_IK + 32; if (g == 1) { cnt = 8; return C_IW; } cnt = 0; return 0; }
    return C_GA + (grp - 72) * 32;
}
__device__ __forceinline__ void p0_transpose_item(const float* W, int ldw, int c0, int cnt, int K, bf16* WT, int n0, int k0, LAS float* scr, int lane) {
#pragma unroll 8
    for (int i = 0; i < 32; ++i) { const int kk = 2 * i + (lane >> 5), n = lane & 31; scr[kk * 33 + n] = (n < cnt) ? W[(size_t)(k0 + kk) * ldw + c0 + n] : 0.f; }
    asm volatile("s_waitcnt lgkmcnt(0)" ::: "memory");
    const int c = lane & 7;
#pragma unroll
    for (int j = 0; j < 4; ++j) { const int n = (lane >> 3) + 8 * j; const LAS float* s = scr + (8 * c) * 33 + n;
        v4u o; o.x = pk2(s[0 * 33], s[1 * 33]); o.y = pk2(s[2 * 33], s[3 * 33]); o.z = pk2(s[4 * 33], s[5 * 33]); o.w = pk2(s[6 * 33], s[7 * 33]);
        *(v4u*)(WT + (size_t)(n0 + n) * K + k0 + 8 * c) = o; }
    asm volatile("s_waitcnt lgkmcnt(0)" ::: "memory");
}
__device__ __forceinline__ void sincos_d(float angf, float& sn, float& cs) {
    const double a = (double)angf; const double kq = __builtin_rint(a * 0.63661977236758134308);
    const double y = (a - kq * 1.57079632679489655800) - kq * 6.123233995736766e-17; const double y2 = y * y;
    double s = y * (1.0 + y2 * (-1.0 / 6 + y2 * (1.0 / 120 + y2 * (-1.0 / 5040 + y2 * (1.0 / 362880 + y2 * (-1.0 / 39916800 + y2 * (1.0 / 6227020800.0)))))));
    double c = 1.0 + y2 * (-0.5 + y2 * (1.0 / 24 + y2 * (-1.0 / 720 + y2 * (1.0 / 40320 + y2 * (-1.0 / 3628800 + y2 * (1.0 / 479001600.0 + y2 * (-1.0 / 87178291200.0)))))));
    const int q = ((int)kq) & 3;
    const double ss = (q == 0) ? s : (q == 1) ? c : (q == 2) ? -s : -c; const double cc = (q == 0) ? c : (q == 1) ? -s : (q == 2) ? -c : s;
    sn = (float)ss; cs = (float)cc;
}
__device__ __forceinline__ void phase_prologue(const Params& p, LAS unsigned char* lds, int G) {
    const int lane = threadIdx.x & 63, wave = __builtin_amdgcn_readfirstlane(threadIdx.x >> 6);
    unsigned char* ws = p.ws;
    LAS float* scr = (LAS float*)(lds + wave * 16384);
    const int gw = blockIdx.x * NWAVES + wave, NGW = G * NWAVES;
    constexpr int I_IN = (DM / 64) * (NIN / 32), I_A = (512 / 64) * (DM / 32), I_O = (DM / 64) * (DM / 32), I_U = (DM / 64) * (DFF / 32), I_D = (DFF / 64) * (DM / 32);
    constexpr int NITEMS = I_IN + 2 * I_A + I_O + I_U + I_D;
    for (int it = gw; it < NITEMS; it += NGW) {
        int r = it;
        if (r < I_IN) { const int grp = r % (NIN / 32), kb = r / (NIN / 32); int cnt; const int c0 = win_src_group(grp, cnt);
            p0_transpose_item(p.w_in, D_IN, c0, cnt, DM, (bf16*)(ws + WS_WIN), grp * 32, kb * 64, scr, lane); continue; } r -= I_IN;
        if (r < I_A) { const int nb = r % 32, kb = r / 32; p0_transpose_item(p.w_a, DM, nb * 32, 32, 512, (bf16*)(ws + WS_WAB), nb * 32, kb * 64, scr, lane); continue; } r -= I_A;
        if (r < I_A) { const int nb = r % 32, kb = r / 32; p0_transpose_item(p.w_b, DM, nb * 32, 32, 512, (bf16*)(ws + WS_WAB), 1024 + nb * 32, kb * 64, scr, lane); continue; } r -= I_A;
        if (r < I_O) { const int nb = r % 32, kb = r / 32; p0_transpose_item(p.w_out, DM, nb * 32, 32, DM, (bf16*)(ws + WS_WOUT), nb * 32, kb * 64, scr, lane); continue; } r -= I_O;
        if (r < I_U) { const int nb = r % 128, kb = r / 128; p0_transpose_item(p.w_up, DFF, nb * 32, 32, DM, (bf16*)(ws + WS_WUP), nb * 32, kb * 64, scr, lane); continue; } r -= I_U;
        { const int nb = r % 32, kb = r / 32; p0_transpose_item(p.w_down, DM, nb * 32, 32, DFF, (bf16*)(ws + WS_WDN), nb * 32, kb * 64, scr, lane); }
    }
    float* COS = (float*)(ws + WS_COS); float* SIN = (float*)(ws + WS_SIN);
    for (int i = gw * 64 + lane; i < SEQ * 32; i += NGW * 64) { const int pos = i >> 5, d = i & 31; const float ang = (float)pos * p.inv_freq[d]; float s, c; sincos_d(ang, s, c); COS[i] = c; SIN[i] = s; }
    float* RSTD1 = (float*)(ws + WS_RSTD1); float* SS2 = (float*)(ws + WS_SS2); float* SS3 = (float*)(ws + WS_SS3); bf16* XG = (bf16*)(ws + WS_XG);
    v4f g[4];
#pragma unroll
    for (int j = 0; j < 4; ++j) g[j] = *((const v4f*)p.attn_norm_w + lane + 64 * j);
    for (int m = gw; m < TOK; m += NGW) {
        const v4f* xr = (const v4f*)(p.x + (size_t)m * DM) + lane; v4f v[4]; float s = 0.f;
#pragma unroll
        for (int j = 0; j < 4; ++j) { v[j] = xr[64 * j]; s += (v[j].x * v[j].x + v[j].y * v[j].y) + (v[j].z * v[j].z + v[j].w * v[j].w); }
        s = wave_sum(s);
        unsigned long long* o8 = (unsigned long long*)(XG + (size_t)m * DM) + lane;
#pragma unroll
        for (int j = 0; j < 4; ++j) o8[64 * j] = (unsigned long long)pk2(v[j].x * g[j].x, v[j].y * g[j].y) | ((unsigned long long)pk2(v[j].z * g[j].z, v[j].w * g[j].w) << 32);
        if (lane == 0) { RSTD1[m] = frsq(s * (1.0f / DM) + RMS_EPS); SS2[m] = 0.f; SS3[m] = 0.f; }
    }
}

__device__ __forceinline__ unsigned f2key(float f) { const unsigned u = __float_as_uint(f); return (u & 0x80000000u) ? ~u : (u | 0x80000000u); }
__device__ __forceinline__ void phase_topk_simple(const Params& p, LAS unsigned char* lds, int G) {
    const int lane = threadIdx.x & 63, wave = __builtin_amdgcn_readfirstlane(threadIdx.x >> 6);
    unsigned char* ws = p.ws;
    const bf16* IQ = (const bf16*)(ws + WS_IQ); const bf16* IK = (const bf16*)(ws + WS_IK); const float* IW = (const float*)(ws + WS_IW);
    unsigned short* SEL = (unsigned short*)(ws + WS_SEL);
    LAS unsigned* keys = (LAS unsigned*)(lds + wave * 16384);
    LAS float* qf = (LAS float*)(lds + LDS_RING + wave * 2048);
    const int gw = blockIdx.x * NWAVES + wave, NGW = G * NWAVES;
    for (int row = gw; row < TOK; row += NGW) {
        const int b = row >> 12, t = row & 4095, n = t + 1;
        unsigned short* selrow = SEL + (size_t)row * TOPK;
        if (n <= TOPK) { for (int i = lane; i < n; i += 64) selrow[i] = (unsigned short)i; continue; }
        { const v4u q8 = *((const v4u*)(IQ + (size_t)row * 512) + lane);
            LAS float* d = qf + 8 * lane;
            d[0] = bflo(q8.x); d[1] = bfhi(q8.x); d[2] = bflo(q8.y); d[3] = bfhi(q8.y); d[4] = bflo(q8.z); d[5] = bfhi(q8.z); d[6] = bflo(q8.w); d[7] = bfhi(q8.w); }
        float w[8];
#pragma unroll
        for (int h = 0; h < 8; ++h) w[h] = IW[(size_t)row * 8 + h];
        asm volatile("s_waitcnt lgkmcnt(0)" ::: "memory");
        for (int s0 = 0; s0 < n; s0 += 64) {
            const int s = s0 + lane; const int sc = s < n ? s : t;
            const v4u* kp = (const v4u*)(IK + ((size_t)b * SEQ + sc) * 64);
            float dot[8];
#pragma unroll
            for (int h = 0; h < 8; ++h) dot[h] = 0.f;
#pragma unroll
            for (int c = 0; c < 8; ++c) {
                const v4u k8 = kp[c]; float kf[8] = {bflo(k8.x), bfhi(k8.x), bflo(k8.y), bfhi(k8.y), bflo(k8.z), bfhi(k8.z), bflo(k8.w), bfhi(k8.w)};
#pragma unroll
                for (int h = 0; h < 8; ++h) { const v4f qa = *(const LAS v4f*)(qf + h * 64 + c * 8), qb = *(const LAS v4f*)(qf + h * 64 + c * 8 + 4);
                    dot[h] += (kf[0] * qa.x + kf[1] * qa.y) + (kf[2] * qa.z + kf[3] * qa.w) + (kf[4] * qb.x + kf[5] * qb.y) + (kf[6] * qb.z + kf[7] * qb.w); }
            }
            float sc_ = 0.f;
#pragma unroll
            for (int h = 0; h < 8; ++h) sc_ += w[h] * fmaxf(dot[h], 0.f);
            keys[s] = (s < n) ? f2key(sc_) : 0u;
        }
        asm volatile("s_waitcnt lgkmcnt(0)" ::: "memory");
        const int nch = (n + 63) >> 6;
        unsigned thr = 0u;
        for (int bit = 31; bit >= 0; --bit) {
            const unsigned cand = thr | (1u << bit); int cnt = 0;
            for (int c = 0; c < nch; ++c) cnt += __popcll(__ballot(keys[c * 64 + lane] >= cand));
            if (cnt >= TOPK) thr = cand;
        }
        int cgt = 0;
        for (int c = 0; c < nch; ++c) cgt += __popcll(__ballot(keys[c * 64 + lane] > thr));
        const int need = TOPK - cgt; int pos = 0, ties = 0;
        for (int c = 0; c < nch; ++c) {
            const unsigned k = keys[c * 64 + lane]; const bool gt = k > thr, eq = k == thr;
            const unsigned long long meq = __ballot(eq);
            const bool sel = gt || (eq && (ties + mbcnt64(meq) < need));
            const unsigned long long msel = __ballot(sel);
            if (sel) selrow[pos + mbcnt64(msel)] = (unsigned short)(c * 64 + lane);
            pos += __popcll(msel); ties += __popcll(meq);
        }
    }
}

template <bool SINK, class KeyFn>
__device__ __forceinline__ void attend_wave(const bf16* Q, const bf16* K, const bf16* V, bf16* O, int row, int g, int nslots, const KeyFn& keyfn, const float* sinkv,
                                            LAS float* qf  , LAS float* pf  , LAS int* kidx  , int lane) {
    const int b = row >> 12;
    { const v2u q4 = *((const v2u*)(Q + (size_t)row * 512 + g * 256) + lane);
        LAS float* d = qf + 4 * lane; d[0] = bflo(q4.x); d[1] = bfhi(q4.x); d[2] = bflo(q4.y); d[3] = bfhi(q4.y); }
    asm volatile("s_waitcnt lgkmcnt(0)" ::: "memory");
#pragma unroll 1
    for (int j = 0; j < 4; ++j) {
        const int slot = 64 * j + lane; int key = slot < nslots ? keyfn(slot) : -1; kidx[slot] = key;
        const bool valid = key >= 0; const int kc = valid ? key : 0;
        const v4u* kp = (const v4u*)(K + ((size_t)b * SEQ + kc) * 128 + g * 64);
        float dot[4] = {0.f, 0.f, 0.f, 0.f};
        if (64 * j < nslots) {
#pragma unroll 2
            for (int c = 0; c < 8; ++c) {
                const v4u k8 = kp[c]; float kf[8] = {bflo(k8.x), bfhi(k8.x), bflo(k8.y), bfhi(k8.y), bflo(k8.z), bfhi(k8.z), bflo(k8.w), bfhi(k8.w)};
#pragma unroll
                for (int h = 0; h < 4; ++h) { const v4f qa = *(const LAS v4f*)(qf + h * 64 + c * 8), qb = *(const LAS v4f*)(qf + h * 64 + c * 8 + 4);
                    dot[h] += (kf[0] * qa.x + kf[1] * qa.y) + (kf[2] * qa.z + kf[3] * qa.w) + (kf[4] * qb.x + kf[5] * qb.y) + (kf[6] * qb.z + kf[7] * qb.w); }
            }
        }
        *(LAS v4f*)(pf + slot * 4) = valid ? (v4f){dot[0], dot[1], dot[2], dot[3]} : (v4f){-INFINITY, -INFINITY, -INFINITY, -INFINITY};
    }
    asm volatile("s_waitcnt lgkmcnt(0)" ::: "memory");
    float lg[4][4];
#pragma unroll
    for (int j = 0; j < 4; ++j) { const v4f t4 = *(const LAS v4f*)(pf + (64 * j + lane) * 4); lg[j][0] = t4.x; lg[j][1] = t4.y; lg[j][2] = t4.z; lg[j][3] = t4.w; }
    float inv[4];
#pragma unroll
    for (int h = 0; h < 4; ++h) {
        float mx = fmaxf(fmaxf(lg[0][h], lg[1][h]), fmaxf(lg[2][h], lg[3][h])); mx = wave_max(mx);
        float sk = 0.f; if (SINK) { sk = sinkv[g * 4 + h] * LOG2E; mx = fmaxf(mx, sk); }
        float s = 0.f;
#pragma unroll
        for (int j = 0; j < 4; ++j) { const float e = fexp2(lg[j][h] - mx); lg[j][h] = e; s += e; }
        s = wave_sum(s); if (SINK) s += fexp2(sk - mx);
        inv[h] = 1.0f / s;
    }
#pragma unroll
    for (int j = 0; j < 4; ++j) *(LAS v4f*)(pf + (64 * j + lane) * 4) = (v4f){lg[j][0], lg[j][1], lg[j][2], lg[j][3]};
    asm volatile("s_waitcnt lgkmcnt(0)" ::: "memory");
    float o[4] = {0.f, 0.f, 0.f, 0.f};
    const bf16* Vb = V + (size_t)b * SEQ * 128 + g * 64 + lane;
#pragma unroll 1
    for (int s0 = 0; s0 < nslots; s0 += 8) {
        float vv[8]; v4f pp[8];
#pragma unroll
        for (int i = 0; i < 8; ++i) { const int slot = s0 + i; const int key = slot < nslots ? kidx[slot] : -1; pp[i] = *(const LAS v4f*)(pf + (slot & 255) * 4);
            vv[i] = key >= 0 ? bf2f(Vb[(size_t)key * 128]) : 0.f; if (key < 0) pp[i] = (v4f){0.f, 0.f, 0.f, 0.f}; }
#pragma unroll
        for (int i = 0; i < 8; ++i) { o[0] += pp[i].x * vv[i]; o[1] += pp[i].y * vv[i]; o[2] += pp[i].z * vv[i]; o[3] += pp[i].w * vv[i]; }
    }
    bf16* op = O + (size_t)row * 512 + g * 256 + lane;
#pragma unroll
    for (int h = 0; h < 4; ++h) op[h * 64] = (bf16)f2bf(o[h] * inv[h]);
}
struct SelKey { const unsigned short* selrow; __device__ __forceinline__ int operator()(int slot) const { return (int)selrow[slot]; } };
struct WinKey { int t; __device__ __forceinline__ int operator()(int slot) const { return t - (WIN - 1) + slot; } };

template <bool DO_DSA, bool DO_SWA>
__device__ __forceinline__ void phase_attn_simple(const Params& p, LAS unsigned char* lds, int G) {
    const int lane = threadIdx.x & 63, wave = __builtin_amdgcn_readfirstlane(threadIdx.x >> 6);
    unsigned char* ws = p.ws;
    LAS float* qf = (LAS float*)(lds + wave * 16384); LAS float* pf = qf + 256; LAS int* kidx = (LAS int*)(pf + 1024);
    const int gw = blockIdx.x * NWAVES + wave, NGW = G * NWAVES;
    const unsigned short* SEL = (const unsigned short*)(ws + WS_SEL);
    for (int item = gw; item < TOK * 2; item += NGW) {
        const int row = item >> 1, g = item & 1, t = row & 4095;
        if (DO_DSA) { SelKey kf{SEL + (size_t)row * TOPK}; const int ns = (t + 1 < TOPK) ? t + 1 : TOPK;
            attend_wave<false>((const bf16*)(ws + WS_AQ), (const bf16*)(ws + WS_AK), (const bf16*)(ws + WS_AV), (bf16*)(ws + WS_OA), row, g, ns, kf, nullptr, qf, pf, kidx, lane); }
        if (DO_SWA) { WinKey kf{t};
            attend_wave<true>((const bf16*)(ws + WS_BQ), (const bf16*)(ws + WS_BK), (const bf16*)(ws + WS_BV), (bf16*)(ws + WS_OB), row, g, WIN, kf, p.sinks, qf, pf, kidx, lane); }
    }
}

__device__ __forceinline__ void phase_final(const Params& p, int G) {
    const int lane = threadIdx.x & 63, wave = __builtin_amdgcn_readfirstlane(threadIdx.x >> 6);
    const float* SS3 = (const float*)(p.ws + WS_SS3);
    const int gw = blockIdx.x * NWAVES + wave, NGW = G * NWAVES;
    v4f g[4];
#pragma unroll
    for (int j = 0; j < 4; ++j) g[j] = *((const v4f*)p.final_w + lane + 64 * j);
    for (int m = gw; m < TOK; m += NGW) {
        const float rs = frsq(SS3[m] * (1.0f / DM) + RMS_EPS);
        v4f* xr = (v4f*)(p.out + (size_t)m * DM) + lane;
#pragma unroll
        for (int j = 0; j < 4; ++j) { v4f v = xr[64 * j]; xr[64 * j] = v * g[j] * rs; }
    }
}

typedef short bf16x8_t __attribute__((ext_vector_type(8)));
typedef float f32x16_t __attribute__((ext_vector_type(16)));
typedef float f32x4_t __attribute__((ext_vector_type(4)));
typedef float f32x2_t __attribute__((ext_vector_type(2)));
__device__ __forceinline__ unsigned f16key(float f) { const int q = (int)__builtin_rintf(f * 4096.0f) + 32768; return (unsigned)(q < 256 ? 256 : (q > 65535 ? 65535 : q)); }
__device__ __forceinline__ float relu1(float x) { return __builtin_amdgcn_fmed3f(x, 0.f, 3.0e38f); }
constexpr int TK_H1 = LDS_RING, TK_WAVE = LDS_RING + 8192, TK_WAVE_BYTES = 3072, TK_CAND = 512;
static_assert(TK_WAVE + 8 * TK_WAVE_BYTES <= LDS_BYTES, "top-k LDS map");

__device__ __forceinline__ void phase_topk_fast(const Params& p, LAS unsigned char* lds, int G) {
    const int tid = threadIdx.x, lane = tid & 63, wave = __builtin_amdgcn_readfirstlane(tid >> 6);
    const int r = lane & 31, h = lane >> 5, mt = wave & 3, par = wave >> 2;
    unsigned char* ws = p.ws;
    const bf16* IQ = (const bf16*)(ws + WS_IQ); const bf16* IK = (const bf16*)(ws + WS_IK); const float* IW = (const float*)(ws + WS_IW);
    unsigned short* SEL = (unsigned short*)(ws + WS_SEL);
    LAS unsigned short* kb = (LAS unsigned short*)lds;
    LAS unsigned* H1 = (LAS unsigned*)(lds + TK_H1);
    LAS unsigned* cl = (LAS unsigned*)(lds + TK_WAVE + wave * TK_WAVE_BYTES); LAS unsigned short* ol = (LAS unsigned short*)(lds + TK_WAVE + wave * TK_WAVE_BYTES + 4 * TK_CAND);
    const int qrow = 4 * mt + 2 * ((r >> 2) & 1) + (r >> 4), qhead = 4 * ((r >> 3) & 1) + (r & 3);
    { LAS v4u* hz = (LAS v4u*)H1; hz[tid] = (v4u){0u, 0u, 0u, 0u}; }
    for (int k = 0;; ++k) {
        int b, tile;
        if (G == 256) { if (k >= 8) break; const int c = blockIdx.x, i = c >> 3, grp = k >> 1; b = c & 7; tile = (k & 1) ? (64 * grp + 63 - i) : (64 * grp + i); }
        else { const int u = blockIdx.x + k * G; if (u >= TOK / 16) break; b = u >> 8; tile = u & 255; }
        const int t0 = tile * 16, R0 = b * SEQ + t0;
        if (t0 + 16 <= TOPK) {
            for (int i = tid; i < 16 * TOPK; i += NTHREADS) { const int ql = i >> 8, s = i & 255; if (s <= t0 + ql) SEL[(size_t)(R0 + ql) * TOPK + s] = (unsigned short)s; }
            continue;
        }
        bf16x8_t aq[4];
#pragma unroll
        for (int s = 0; s < 4; ++s) aq[s] = *(const bf16x8_t*)(IQ + (size_t)(R0 + qrow) * 512 + qhead * 64 + 16 * s + 8 * h);
        f32x2_t wq[2][4];
#pragma unroll
        for (int qq = 0; qq < 2; ++qq) { const f32x4_t w0 = *(const f32x4_t*)(IW + (size_t)(R0 + 4 * mt + 2 * h + qq) * 8), w1 = *(const f32x4_t*)(IW + (size_t)(R0 + 4 * mt + 2 * h + qq) * 8 + 4);
            wq[qq][0] = (f32x2_t){w0[0], w0[1]}; wq[qq][1] = (f32x2_t){w0[2], w0[3]}; wq[qq][2] = (f32x2_t){w1[0], w1[1]}; wq[qq][3] = (f32x2_t){w1[2], w1[3]}; }
        const int ntile = (t0 + 16 + 31) >> 5, ntp = (ntile + 7) & ~7, nch = (t0 + 16 + 511) >> 9;
        const char* kbase = (const char*)IK + (size_t)b * SEQ * 128;
        const unsigned voff = (unsigned)(r * 128 + h * 16);
        const int tq0 = t0 + 4 * mt + 2 * h;
        const int ql0 = 4 * mt + 2 * h;
        LAS unsigned short* row0 = kb + ql0 * 4096; LAS unsigned* h0 = H1 + ql0 * 128;
        __syncthreads();
#define TK_LOAD(dst, kt_) do { const int ktc_ = (kt_) < 127 ? (kt_) : 127; const char* tp_ = kbase + (size_t)ktc_ * 4096; _Pragma("unroll") for (int s_ = 0; s_ < 4; ++s_) dst[s_] = *(const bf16x8_t*)(tp_ + voff + 32 * s_); } while (0)
#define TK_MMA(acc_, src) do { acc_ = (f32x16_t){0.f, 0.f, 0.f, 0.f, 0.f, 0.f, 0.f, 0.f, 0.f, 0.f, 0.f, 0.f, 0.f, 0.f, 0.f, 0.f}; \
            _Pragma("unroll") for (int s_ = 0; s_ < 4; ++s_) acc_ = __builtin_amdgcn_mfma_f32_32x32x16_bf16(aq[s_], src[s_], acc_, 0, 0, 0); } while (0)
#define TK_POST(acc_, kt_) do { f32x2_t s0_ = {0.f, 0.f}, s1_ = {0.f, 0.f}; \
            _Pragma("unroll") for (int hd_ = 0; hd_ < 4; ++hd_) { s0_ += (f32x2_t){relu1(acc_[2 * hd_]), relu1(acc_[2 * hd_ + 1])} * wq[0][hd_]; s1_ += (f32x2_t){relu1(acc_[8 + 2 * hd_]), relu1(acc_[9 + 2 * hd_])} * wq[1][hd_]; } \
            const int e_ = 32 * (kt_) + r; const unsigned k0_ = (e_ <= tq0) ? f16key(s0_.x + s0_.y) : 0u, k1_ = (e_ <= tq0 + 1) ? f16key(s1_.x + s1_.y) : 0u; \
            row0[e_] = (unsigned short)k0_; row0[4096 + e_] = (unsigned short)k1_; \
            if (k0_) __hip_atomic_fetch_add(h0 + (k0_ >> 9), 1u << ((k0_ >> 4) & 16u), __ATOMIC_RELAXED, __HIP_MEMORY_SCOPE_WORKGROUP); \
            if (k1_) __hip_atomic_fetch_add(h0 + 128 + (k1_ >> 9), 1u << ((k1_ >> 4) & 16u), __ATOMIC_RELAXED, __HIP_MEMORY_SCOPE_WORKGROUP); } while (0)
#ifndef TK_REP_SCORE
#define TK_REP_SCORE 1
#endif
#ifndef TK_REP_SEL
#define TK_REP_SEL 1
#endif
#pragma unroll 1
        for (int rp_ = 0; rp_ < TK_REP_SCORE; ++rp_) {
            bf16x8_t B[4][4]; f32x16_t accA, accB;
            const int nmy = ntp >> 1;
#pragma unroll
            for (int u = 0; u < 4; ++u) TK_LOAD(B[u], par + 2 * u);
            TK_MMA(accA, B[0]);
#pragma unroll 1
            for (int i = 0; i < nmy; i += 4) {
                const int kt = par + 2 * i;
                TK_MMA(accB, B[1]); TK_POST(accA, kt);     TK_LOAD(B[0], kt + 8);
                TK_MMA(accA, B[2]); TK_POST(accB, kt + 2); TK_LOAD(B[1], kt + 10);
                TK_MMA(accB, B[3]); TK_POST(accA, kt + 4); TK_LOAD(B[2], kt + 12);
                TK_MMA(accA, B[0]); TK_POST(accB, kt + 6); TK_LOAD(B[3], kt + 14);
            }
        }
#undef TK_LOAD
#undef TK_MMA
#undef TK_POST
        if (32 * ntp < 512 * nch) {
#pragma unroll
            for (int qi = 0; qi < 2; ++qi) { LAS v2u* z = (LAS v2u*)(kb + (2 * wave + qi) * 4096 + 32 * ntp) + lane; *z = (v2u){0u, 0u}; }
        }
        __syncthreads();
#pragma unroll 1
        for (int qi = 0; qi < 2 * TK_REP_SEL; ++qi) {
            const int ql = 2 * wave + (qi & 1);
            const LAS unsigned short* rb = kb + ql * 4096 + lane;
            const v2u hw = *(const LAS v2u*)(H1 + ql * 128 + 2 * lane); const v4u hv = {hw.x & 0xffffu, hw.x >> 16, hw.y & 0xffffu, hw.y >> 16};
            if ((qi >> 1) + 1 == TK_REP_SEL) *(LAS v2u*)(H1 + ql * 128 + 2 * lane) = (v2u){0u, 0u};
            const int hs = (int)(hv.x + hv.y + hv.z + hv.w); int S = hs;
#pragma unroll
            for (int off = 1; off < 64; off <<= 1) { const int v = __shfl_down(S, off); if (lane + off < 64) S += v; }
            int ab = S - hs; const bool cross = ab < TOPK && S >= TOPK;
            int Bl = 4 * lane + 3;
            if (ab + (int)hv.w < TOPK) { ab += (int)hv.w; Bl = 4 * lane + 2; if (ab + (int)hv.z < TOPK) { ab += (int)hv.z; Bl = 4 * lane + 1; if (ab + (int)hv.y < TOPK) { ab += (int)hv.y; Bl = 4 * lane; } } }
            const unsigned long long mc = __ballot(cross);
            const int src = mc ? (__ffsll((long long)mc) - 1) : 0;
            const unsigned Bb = (unsigned)__shfl(Bl, src);
            int pos = 0, m = 0;
#pragma unroll 1
            for (int j = 0; j < nch; ++j) {
                unsigned kk[8];
#pragma unroll
                for (int s = 0; s < 8; ++s) kk[s] = rb[512 * j + 64 * s];
#pragma unroll
                for (int s = 0; s < 8; ++s) {
                    const unsigned hb = kk[s] >> 8; const bool gt = hb > Bb, eq = hb == Bb;
                    const unsigned long long mg = __ballot(gt), me = __ballot(eq);
                    const unsigned e = (unsigned)(512 * j + 64 * s + lane);
                    if (gt) ol[pos + mbcnt64(mg)] = (unsigned short)e;
                    if (eq) { const int ci = m + mbcnt64(me); if (ci < TK_CAND) cl[ci] = ((kk[s] & 0xffu) << 16) | e; }
                    pos += __popcll(mg); m += __popcll(me);
                }
            }
            asm volatile("s_waitcnt lgkmcnt(0)" ::: "memory");
            if (mc != 0ull && m <= TK_CAND && pos < TOPK && pos + m >= TOPK) {
                const int need2 = TOPK - pos;
                unsigned ent[8]; bool val[8];
#pragma unroll
                for (int q = 0; q < 8; ++q) { val[q] = 64 * q + lane < m; ent[q] = val[q] ? cl[64 * q + lane] : 0u; }
                unsigned thr2 = 0u;
#pragma unroll 1
                for (int bit = 7; bit >= 0; --bit) {
                    const unsigned cand = thr2 | (1u << bit); int cnt = 0;
#pragma unroll
                    for (int q = 0; q < 8; ++q) cnt += __popcll(__ballot(val[q] && (ent[q] >> 16) >= cand));
                    if (cnt >= need2) thr2 = cand;
                }
                int cgt2 = 0;
#pragma unroll
                for (int q = 0; q < 8; ++q) cgt2 += __popcll(__ballot(val[q] && (ent[q] >> 16) > thr2));
                const int need3 = need2 - cgt2; int ties = 0;
#pragma unroll
                for (int q = 0; q < 8; ++q) {
                    const unsigned lb = ent[q] >> 16; const bool gt = val[q] && lb > thr2, eq = val[q] && lb == thr2;
                    const unsigned long long meq = __ballot(eq);
                    const bool sel = gt || (eq && (ties + mbcnt64(meq) < need3));
                    const unsigned long long msel = __ballot(sel);
                    if (sel) ol[pos + mbcnt64(msel)] = (unsigned short)(ent[q] & 0xffffu);
                    pos += __popcll(msel); ties += __popcll(meq);
                }
            } else {
                unsigned thr = 0u;
#pragma unroll 1
                for (int bit = 15; bit >= 0; --bit) {
                    const unsigned cand = thr | (1u << bit); int cnt = 0;
#pragma unroll 1
                    for (int i = 0; i < 8 * nch; ++i) cnt += __popcll(__ballot((unsigned)rb[64 * i] >= cand));
                    if (cnt >= TOPK) thr = cand;
                }
                int cgt = 0;
#pragma unroll 1
                for (int i = 0; i < 8 * nch; ++i) cgt += __popcll(__ballot((unsigned)rb[64 * i] > thr));
                const int need = TOPK - cgt; int ties = 0; pos = 0;
#pragma unroll 1
                for (int i = 0; i < 8 * nch; ++i) {
                    const unsigned kx = rb[64 * i]; const bool gt = kx > thr, eq = kx == thr;
                    const unsigned long long meq = __ballot(eq);
                    const bool sel = gt || (eq && (ties + mbcnt64(meq) < need));
                    const unsigned long long msel = __ballot(sel);
                    if (sel) ol[pos + mbcnt64(msel)] = (unsigned short)(64 * i + lane);
                    pos += __popcll(msel); ties += __popcll(meq);
                }
            }
            asm volatile("s_waitcnt lgkmcnt(0)" ::: "memory");
            *((v2u*)(SEL + (size_t)(R0 + ql) * TOPK) + lane) = *(const LAS v2u*)(ol + 4 * lane);
            asm volatile("s_waitcnt lgkmcnt(0)" ::: "memory");
        }
    }
    __syncthreads();
}

typedef short s16x4_t __attribute__((ext_vector_type(4)));
__device__ __forceinline__ s16x4_t tr_read(unsigned addr) { s16x4_t r_; asm volatile("ds_read_b64_tr_b16 %0, %1" : "=v"(r_) : "v"(addr) : "memory"); return r_; }

__device__ __forceinline__ void phase_dsa_fast(const Params& p, LAS unsigned char* lds, int G) {
    const int tid = threadIdx.x, lane = tid & 63, wave = __builtin_amdgcn_readfirstlane(tid >> 6);
    const int c16 = lane & 15, kq = lane >> 4;
    unsigned char* ws = p.ws;
    const bf16* AQ = (const bf16*)(ws + WS_AQ); const bf16* AK = (const bf16*)(ws + WS_AK); const bf16* AV = (const bf16*)(ws + WS_AV); bf16* OA = (bf16*)(ws + WS_OA);
    const unsigned short* SEL = (const unsigned short*)(ws + WS_SEL);
    LAS unsigned char* wl = lds + wave * 13312;
    LAS unsigned short* sidx = (LAS unsigned short*)wl; LAS unsigned short* Pl = (LAS unsigned short*)(wl + 512); LAS unsigned char* Vl = wl + 2560;
    const unsigned vl_addr = (unsigned)(size_t)Vl;
    const bool arow = (c16 & 3) == 0; const int ahead = c16 >> 2;
    const int nper = (G >= 8 && (G & 7) == 0) ? (G >> 3) * NWAVES : 0;
    for (int it = 0;; ++it) {
        int row;
        if (nper) { const int wi = (blockIdx.x >> 3) * NWAVES + wave, t = wi + it * nper; if (t >= SEQ) break; row = (blockIdx.x & 7) * SEQ + t; }
        else { row = blockIdx.x * NWAVES + wave + it * G * NWAVES; if (row >= TOK) break; }
        const int b = row >> 12, t = row & 4095; const int cnt = (t + 1 < TOPK) ? t + 1 : TOPK;
        { const v2u sv = *((const v2u*)(SEL + (size_t)row * TOPK) + lane);
            const int s0 = 4 * lane; v2u o;
            o.x = ((s0 < cnt) ? (sv.x & 0xffffu) : 0u) | (((s0 + 1 < cnt) ? (sv.x >> 16) : 0u) << 16); o.y = ((s0 + 2 < cnt) ? (sv.y & 0xffffu) : 0u) | (((s0 + 3 < cnt) ? (sv.y >> 16) : 0u) << 16);
            *(LAS v2u*)(sidx + 4 * lane) = o; }
        asm volatile("s_waitcnt lgkmcnt(0)" ::: "memory");
        const bf16* Kb = AK + (size_t)b * SEQ * 128; const bf16* Vb = AV + (size_t)b * SEQ * 128;
#pragma unroll 1
        for (int g = 0; g < 2; ++g) {
            bf16x8_t aq[2];
#pragma unroll
            for (int c = 0; c < 2; ++c) { aq[c] = (bf16x8_t){0, 0, 0, 0, 0, 0, 0, 0}; if (arow) aq[c] = *(const bf16x8_t*)(AQ + (size_t)row * 512 + (4 * g + ahead) * 64 + 32 * c + 8 * kq); }
            float sc[16];
            const bf16* Kg = Kb + g * 64 + 8 * kq;
#pragma unroll
            for (int q4 = 0; q4 < 4; ++q4) {
                bf16x8_t kf[4][2];
#pragma unroll
                for (int u = 0; u < 4; ++u) { const int key = sidx[16 * (4 * q4 + u) + c16]; const bf16* kp = Kg + (size_t)key * 128; kf[u][0] = *(const bf16x8_t*)kp; kf[u][1] = *(const bf16x8_t*)(kp + 32); }
#pragma unroll
                for (int u = 0; u < 4; ++u) { f32x4_t a = {0.f, 0.f, 0.f, 0.f};
                    a = __builtin_amdgcn_mfma_f32_16x16x32_bf16(aq[0], kf[u][0], a, 0, 0, 0); a = __builtin_amdgcn_mfma_f32_16x16x32_bf16(aq[1], kf[u][1], a, 0, 0, 0);
                    sc[4 * q4 + u] = (16 * (4 * q4 + u) + c16 < cnt) ? a[0] : -INFINITY; }
            }
            float mx = sc[0];
#pragma unroll
            for (int i = 1; i < 16; ++i) mx = fmaxf(mx, sc[i]);
            mx = fmaxf(mx, __shfl_xor(mx, 1)); mx = fmaxf(mx, __shfl_xor(mx, 2)); mx = fmaxf(mx, __shfl_xor(mx, 4)); mx = fmaxf(mx, __shfl_xor(mx, 8));
            float sum = 0.f;
#pragma unroll
            for (int i = 0; i < 16; ++i) { sc[i] = fexp2(sc[i] - mx); sum += sc[i]; }
            sum += __shfl_xor(sum, 1); sum += __shfl_xor(sum, 2); sum += __shfl_xor(sum, 4); sum += __shfl_xor(sum, 8);
            const float inv = 1.0f / sum;
#pragma unroll
            for (int i = 0; i < 16; ++i) Pl[kq * 256 + 16 * i + c16] = (unsigned short)f2bf(sc[i]);
            asm volatile("s_waitcnt lgkmcnt(0)" ::: "memory");
            f32x4_t o[4];
#pragma unroll
            for (int dt = 0; dt < 4; ++dt) o[dt] = (f32x4_t){0.f, 0.f, 0.f, 0.f};
            const bf16* Vg = Vb + g * 64 + 8 * (lane & 7);
#pragma unroll 1
            for (int ch = 0; ch < 4; ++ch) {
                v4u vr[8];
#pragma unroll
                for (int i = 0; i < 8; ++i) { const int key = sidx[64 * ch + 8 * i + (lane >> 3)]; vr[i] = *(const v4u*)(Vg + (size_t)key * 128); }
#pragma unroll
                for (int i = 0; i < 8; ++i) *(LAS v4u*)(Vl + (8 * i + (lane >> 3)) * 160 + 16 * (lane & 7)) = vr[i];
                asm volatile("s_waitcnt lgkmcnt(0)" ::: "memory");
#pragma unroll
                for (int hf = 0; hf < 2; ++hf) {
                    bf16x8_t pa = (bf16x8_t){0, 0, 0, 0, 0, 0, 0, 0};
                    if (arow) { const s16x4_t lo = *(const LAS s16x4_t*)(Pl + ahead * 256 + 64 * ch + 32 * hf + 4 * kq), hi = *(const LAS s16x4_t*)(Pl + ahead * 256 + 64 * ch + 32 * hf + 16 + 4 * kq);
                        pa = (bf16x8_t){lo[0], lo[1], lo[2], lo[3], hi[0], hi[1], hi[2], hi[3]}; }
                    const unsigned va = vl_addr + (unsigned)((32 * hf + 4 * kq + (c16 >> 2)) * 160 + 8 * (c16 & 3));
                    s16x4_t vlo[4], vhi[4];
#pragma unroll
                    for (int dt = 0; dt < 4; ++dt) { vlo[dt] = tr_read(va + 32 * dt); vhi[dt] = tr_read(va + 16 * 160 + 32 * dt); }
                    asm volatile("s_waitcnt lgkmcnt(0)" : "+v"(vlo[0]), "+v"(vlo[1]), "+v"(vlo[2]), "+v"(vlo[3]), "+v"(vhi[0]), "+v"(vhi[1]), "+v"(vhi[2]), "+v"(vhi[3]) :: "memory");
                    __builtin_amdgcn_sched_barrier(0);
#pragma unroll
                    for (int dt = 0; dt < 4; ++dt) { const bf16x8_t vb = (bf16x8_t){vlo[dt][0], vlo[dt][1], vlo[dt][2], vlo[dt][3], vhi[dt][0], vhi[dt][1], vhi[dt][2], vhi[dt][3]};
                        o[dt] = __builtin_amdgcn_mfma_f32_16x16x32_bf16(pa, vb, o[dt], 0, 0, 0); }
                }
                asm volatile("s_waitcnt lgkmcnt(0)" ::: "memory");
            }
            bf16* op = OA + (size_t)row * 512 + (4 * g + kq) * 64 + c16;
#pragma unroll
            for (int dt = 0; dt < 4; ++dt) op[16 * dt] = (bf16)f2bf(o[dt][0] * inv);
        }
    }
}

typedef float f32x2_t __attribute__((ext_vector_type(2))); typedef __bf16 bf16x2v_t __attribute__((ext_vector_type(2)));
__device__ __forceinline__ unsigned cvtpk_s(float lo, float hi) { f32x2_t v = {lo, hi}; bf16x2v_t b = __builtin_convertvector(v, bf16x2v_t); return __builtin_bit_cast(unsigned, b); }
__device__ __forceinline__ int crow16(int reg, int h) { return (reg & 3) + 8 * (reg >> 2) + 4 * h; }

__device__ __forceinline__ void phase_swa_fast(const Params& p, int G) {
    const int tid = threadIdx.x, lane = tid & 63, wave = __builtin_amdgcn_readfirstlane(tid >> 6);
    const int r = lane & 31, h = lane >> 5, hh = wave >> 1, qh = wave & 1;
    unsigned char* ws = p.ws;
    const bf16* BQ = (const bf16*)(ws + WS_BQ); const bf16* BK = (const bf16*)(ws + WS_BK); const bf16* BV = (const bf16*)(ws + WS_BV); bf16* OB = (bf16*)(ws + WS_OB);
    for (int k = 0;; ++k) {
        int b, idx;
        if (G >= 8 && (G & 7) == 0) { idx = (blockIdx.x >> 3) + (G >> 3) * k; if (idx >= 64) break; b = blockIdx.x & 7; }
        else { const int u = blockIdx.x + k * G; if (u >= 512) break; b = u >> 6; idx = u & 63; }
        const int qb = idx >> 1, g = idx & 1, head = 4 * g + hh;
        const float sink = p.sinks[head] * LOG2E;
        const bf16* Kb = BK + (size_t)b * SEQ * 128 + g * 64 + 8 * h; const bf16* Vb = BV + (size_t)b * SEQ * 128 + g * 64 + r;
#pragma unroll 1
        for (int qt = 0; qt < 2; ++qt) {
            const int q0 = 128 * qb + 64 * qh + 32 * qt;
            const size_t qrow = (size_t)b * SEQ + q0 + r;
            bf16x8_t qf[4];
#pragma unroll
            for (int s = 0; s < 4; ++s) qf[s] = *(const bf16x8_t*)(BQ + qrow * 512 + head * 64 + 16 * s + 8 * h);
            f32x16_t S[5];
#pragma unroll
            for (int kt = 0; kt < 5; ++kt) {
                const int kb0 = q0 - 128 + 32 * kt; const int krow_ = kb0 + r; const int kc = krow_ < 0 ? 0 : krow_;
                bf16x8_t kf[4];
#pragma unroll
                for (int s = 0; s < 4; ++s) kf[s] = *(const bf16x8_t*)(Kb + (size_t)kc * 128 + 16 * s);
                f32x16_t a = {0.f, 0.f, 0.f, 0.f, 0.f, 0.f, 0.f, 0.f, 0.f, 0.f, 0.f, 0.f, 0.f, 0.f, 0.f, 0.f};
#pragma unroll
                for (int s = 0; s < 4; ++s) a = __builtin_amdgcn_mfma_f32_32x32x16_bf16(kf[s], qf[s], a, 0, 0, 0);
#pragma unroll
                for (int i = 0; i < 16; ++i) { const int key = kb0 + crow16(i, h); const int rel = q0 + r - key; S[kt][i] = (key >= 0 && rel >= 0 && rel < WIN) ? a[i] : -INFINITY; }
            }
            float mx = sink;
#pragma unroll
            for (int kt = 0; kt < 5; ++kt)
#pragma unroll
                for (int i = 0; i < 16; ++i) mx = fmaxf(mx, S[kt][i]);
            mx = fmaxf(mx, __shfl_xor(mx, 32));
            float l = 0.f;
#pragma unroll
            for (int kt = 0; kt < 5; ++kt)
#pragma unroll
                for (int i = 0; i < 16; ++i) { S[kt][i] = fexp2(S[kt][i] - mx); l += S[kt][i]; }
            l += __shfl_xor(l, 32); l += fexp2(sink - mx);
            const float linv = 1.0f / l;
            f32x16_t O0 = {0.f, 0.f, 0.f, 0.f, 0.f, 0.f, 0.f, 0.f, 0.f, 0.f, 0.f, 0.f, 0.f, 0.f, 0.f, 0.f}, O1 = O0;
#pragma unroll
            for (int kt = 0; kt < 5; ++kt) {
                const int kb0 = q0 - 128 + 32 * kt;
#pragma unroll
                for (int s = 0; s < 2; ++s) {
                    v4u pw; pw.x = cvtpk_s(S[kt][8 * s + 0], S[kt][8 * s + 1]); pw.y = cvtpk_s(S[kt][8 * s + 2], S[kt][8 * s + 3]); pw.z = cvtpk_s(S[kt][8 * s + 4], S[kt][8 * s + 5]); pw.w = cvtpk_s(S[kt][8 * s + 6], S[kt][8 * s + 7]);
                    const bf16x8_t pa = __builtin_bit_cast(bf16x8_t, pw);
                    unsigned short v0[8], v1[8];
#pragma unroll
                    for (int j = 0; j < 8; ++j) { int key = kb0 + 16 * s + 8 * (j >> 2) + 4 * h + (j & 3); key = key < 0 ? 0 : key; v0[j] = Vb[(size_t)key * 128]; v1[j] = Vb[(size_t)key * 128 + 32]; }
                    const bf16x8_t vb0 = (bf16x8_t){(short)v0[0], (short)v0[1], (short)v0[2], (short)v0[3], (short)v0[4], (short)v0[5], (short)v0[6], (short)v0[7]};
                    const bf16x8_t vb1 = (bf16x8_t){(short)v1[0], (short)v1[1], (short)v1[2], (short)v1[3], (short)v1[4], (short)v1[5], (short)v1[6], (short)v1[7]};
                    O0 = __builtin_amdgcn_mfma_f32_32x32x16_bf16(pa, vb0, O0, 0, 0, 0); O1 = __builtin_amdgcn_mfma_f32_32x32x16_bf16(pa, vb1, O1, 0, 0, 0);
                }
            }
            bf16* op = OB + ((size_t)b * SEQ + q0) * 512 + head * 64 + r;
#pragma unroll
            for (int i = 0; i < 16; ++i) { const int qq = crow16(i, h); const float li = __shfl(linv, qq); op[(size_t)qq * 512] = (bf16)f2bf(O0[i] * li); op[(size_t)qq * 512 + 32] = (bf16)f2bf(O1[i] * li); }
        }
    }
}

constexpr int NPHASE = 9;
__global__ void __launch_bounds__(NTHREADS, 2) mk_fwd(Params p) {
    extern __shared__ __attribute__((aligned(16))) unsigned char lds_raw[];
    LAS unsigned char* lds = (LAS unsigned char*)lds_raw;
    const int G = gridDim.x;
    unsigned char* ws = p.ws;
#if MK_ONE_LAUNCH
#define SEAM(k) do { if (rep_ + 1 < REPS(k)) __syncthreads(); else if (lo <= (k) && (k) + 1 < hi) cg::this_grid().sync(); } while (0)
#else
#define SEAM(k) do { if (rep_ + 1 < REPS(k)) __syncthreads(); } while (0)
#endif
    const int lo = p.ph_lo, hi = p.ph_hi;
#ifndef PHMASK
#define PHMASK 0x1ffu
#endif
#define IN(k) (((PHMASK >> (k)) & 1u) && lo <= (k) && (k) < hi)
#define REPS(k) (((REP_MASK >> (k)) & 1u) ? 2 : 1)
#define PHASE(k) if (IN(k)) for (int rep_ = 0; rep_ < REPS(k); ++rep_)
    PHASE(0) { phase_prologue(p, lds, G); SEAM(0); }
    PHASE(1) {
        pg8::Gemm g{(const bf16*)(ws + WS_XG), (const bf16*)(ws + WS_WIN), TOK, NIN, DM, nullptr, 1 << 30};
        pg8::StaticOrder S; S.init(TOK, NIN, G, (int)blockIdx.x);
        pg8::EpiInProj E{(const float*)(ws + WS_RSTD1), (const float*)(ws + WS_COS), (const float*)(ws + WS_SIN), ws, p.ikw, p.ikb};
        pg8::gemm_phase<pg8::EpiInProj, pg8::StaticOrder, true, true>(lds, g, S, E);
        SEAM(1);
    }
#if MK_SIMPLE_TOPK
    PHASE(2) { phase_topk_simple(p, lds, G); SEAM(2); }
#else
    PHASE(2) { phase_topk_fast(p, lds, G); SEAM(2); }
#endif
#if MK_SIMPLE_DSA
    PHASE(3) { phase_attn_simple<true, true>(p, lds, G); SEAM(3); }
#else
#if MK_SIMPLE_SWA
    PHASE(3) { phase_dsa_fast(p, lds, G); __syncthreads(); phase_attn_simple<false, true>(p, lds, G); SEAM(3); }
#else
    PHASE(3) { phase_swa_fast(p, G); phase_dsa_fast(p, lds, G); SEAM(3); }
#endif
#endif
    PHASE(4) {
        pg8::Gemm g{(const bf16*)(ws + WS_OA), (const bf16*)(ws + WS_WAB), TOK, 2048, 512, (const bf16*)(ws + WS_OB), 4};
        pg8::BranchOrder S{G, (int)blockIdx.x};
        pg8::EpiGate E{(const bf16*)(ws + WS_GA), (const bf16*)(ws + WS_GB), p.out, (bf16*)(ws + WS_MIX)};
        pg8::gemm_phase<pg8::EpiGate, pg8::BranchOrder, true, true>(lds, g, S, E);
        SEAM(4);
    }
    PHASE(5) {
        pg8::Gemm g{(const bf16*)(ws + WS_MIX), (const bf16*)(ws + WS_WOUT), TOK, DM, DM, nullptr, 1 << 30};
        pg8::StaticOrder S; S.init(TOK, DM, G, (int)blockIdx.x);
        pg8::EpiResid<true> E{p.x, p.out, (bf16*)(ws + WS_XG), p.mlp_norm_w, (float*)(ws + WS_SS2)};
        pg8::gemm_phase<pg8::EpiResid<true>, pg8::StaticOrder, true, true>(lds, g, S, E);
        SEAM(5);
    }
    PHASE(6) {
        pg8::Gemm g{(const bf16*)(ws + WS_XG), (const bf16*)(ws + WS_WUP), TOK, DFF, DM, nullptr, 1 << 30};
        pg8::StaticOrder S; S.init(TOK, DFF, G, (int)blockIdx.x);
        pg8::EpiUp E{(const float*)(ws + WS_SS2), (bf16*)(ws + WS_HID)};
        pg8::gemm_phase<pg8::EpiUp, pg8::StaticOrder, true, true>(lds, g, S, E);
        SEAM(6);
    }
    PHASE(7) {
        pg8::Gemm g{(const bf16*)(ws + WS_HID), (const bf16*)(ws + WS_WDN), TOK, DM, DFF, nullptr, 1 << 30};
        pg8::StaticOrder S; S.init(TOK, DM, G, (int)blockIdx.x);
        pg8::EpiResid<false> E{p.out, p.out, nullptr, nullptr, (float*)(ws + WS_SS3)};
        pg8::gemm_phase<pg8::EpiResid<false>, pg8::StaticOrder, true, true>(lds, g, S, E);
        SEAM(7);
    }
    PHASE(8) { phase_final(p, G); }
#undef PHASE
#undef REPS
#undef IN
#undef SEAM
}

extern "C" void kernel_launch(void* const* d_in, const int* in_sizes, int n_in, void* d_out, int out_size, void* d_ws, size_t ws_size, hipStream_t stream) {
    static int grid = 0;
    if (grid == 0) {
        if (n_in != 13 || in_sizes[0] != TOK * DM || out_size != TOK * DM || ws_size < WS_NEED) {
            fprintf(stderr, "kernel_launch: unexpected shapes (n_in %d, in0 %d, out %d, ws %zu); nothing launched\n", n_in, n_in > 0 ? in_sizes[0] : -1, out_size, ws_size); grid = -1; return; }
        int dev = 0, cus = 0, per_cu = 0;
        (void)hipGetDevice(&dev); (void)hipDeviceGetAttribute(&cus, hipDeviceAttributeMultiprocessorCount, dev);
        if (hipFuncSetAttribute((const void*)mk_fwd, hipFuncAttributeMaxDynamicSharedMemorySize, LDS_BYTES) != hipSuccess) { fprintf(stderr, "kernel_launch: hipFuncSetAttribute failed\n"); grid = -1; return; }
        if (hipOccupancyMaxActiveBlocksPerMultiprocessor(&per_cu, (const void*)mk_fwd, NTHREADS, LDS_BYTES) != hipSuccess || per_cu < 1) { fprintf(stderr, "kernel_launch: occupancy query says %d blocks per CU\n", per_cu); per_cu = 1; }
        (void)hipGetLastError();
        if (per_cu > 1) per_cu = 1;
        grid = cus * per_cu;
    }
    if (grid < 0) return;
    Params p{};
    p.x = (const float*)d_in[0]; p.attn_norm_w = (const float*)d_in[1]; p.w_in = (const float*)d_in[2]; p.ikw = (const float*)d_in[3]; p.ikb = (const float*)d_in[4];
    p.sinks = (const float*)d_in[5]; p.w_a = (const float*)d_in[6]; p.w_b = (const float*)d_in[7]; p.w_out = (const float*)d_in[8]; p.mlp_norm_w = (const float*)d_in[9];
    p.w_up = (const float*)d_in[10]; p.w_down = (const float*)d_in[11]; p.final_w = (const float*)d_in[12];
    p.out = (float*)d_out; p.ws = (unsigned char*)d_ws;
    for (int i = 0; i < 32; ++i) p.inv_freq[i] = 1.0f / powf(10000.0f, (float)(2 * i) / 64.0f);
#if MK_ONE_LAUNCH
    p.ph_lo = 0; p.ph_hi = NPHASE;
    void* args[] = {&p};
    hipError_t e = hipLaunchCooperativeKernel((const void*)mk_fwd, dim3(grid), dim3(NTHREADS), args, LDS_BYTES, stream);
    if (e != hipSuccess) fprintf(stderr, "kernel_launch: cooperative launch failed: %s (grid %d)\n", hipGetErrorString(e), grid);
#else
    for (int ph = 0; ph < NPHASE; ++ph) {
        p.ph_lo = ph; p.ph_hi = ph + 1;
        hipLaunchKernelGGL(mk_fwd, dim3(grid), dim3(NTHREADS), LDS_BYTES, stream, p);
    }
#endif
}
```

```cpp
#include <hip/hip_runtime.h>
#include <hip/hip_cooperative_groups.h>
#include <cstdio>
#include <cstdint>
namespace cg = cooperative_groups;

#ifndef MK_ONE_LAUNCH
#define MK_ONE_LAUNCH 1
#endif
#ifndef MK_SIMPLE_TOPK
#define MK_SIMPLE_TOPK 0
#endif
#ifndef MK_SIMPLE_SWA
#define MK_SIMPLE_SWA 0
#endif
#ifndef MK_SIMPLE_DSA
#define MK_SIMPLE_DSA 0
#endif

constexpr int NBATCH = 8, SEQ = 4096, DM = 1024, TOK = NBATCH * SEQ, DFF = 4096, TOPK = 256, WIN = 128;
constexpr int NIN = 4352;
constexpr float RMS_EPS = 1e-6f, LN_EPS = 1e-6f;
constexpr float QSCALE = 0.125f * 1.4426950408889634f;
constexpr float LOG2E = 1.4426950408889634f;
constexpr float W_SCALE = 0.04419417382415922f;
constexpr int C_AQ = 0, C_AK = 512, C_AV = 640, C_IQ = 768, C_IK = 1280, C_IW = 1344, C_BQ = 1352, C_BK = 1864, C_BV = 1992, C_GA = 2120, C_GB = 3144, D_IN = 4168;

constexpr size_t MiB = 1u << 20;
constexpr size_t WS_RSTD1 = 0, WS_SS2 = 128 * 1024, WS_SS3 = 256 * 1024;
constexpr size_t WS_COS = 1 * MiB, WS_SIN = 1 * MiB + 512 * 1024;
constexpr size_t WS_WIN = 2 * MiB, WS_WAB = 11 * MiB, WS_WOUT = 13 * MiB, WS_WUP = 15 * MiB, WS_WDN = 23 * MiB;
constexpr size_t WS_XG = 32 * MiB;
constexpr size_t WS_AQ = 96 * MiB, WS_IQ = 128 * MiB, WS_BQ = 160 * MiB, WS_AK = 192 * MiB, WS_AV = 200 * MiB, WS_BK = 208 * MiB, WS_BV = 216 * MiB;
constexpr size_t WS_IK = 224 * MiB, WS_IW = 228 * MiB, WS_SEL = 230 * MiB, WS_GA = 248 * MiB, WS_GB = 312 * MiB, WS_MIX = 376 * MiB, WS_END = 440 * MiB;
#ifndef MK_SEPARATE_O
#define MK_SEPARATE_O 0
#endif
#ifndef REP_MASK
#define REP_MASK 0u
#endif
constexpr size_t WS_OA = MK_SEPARATE_O ? 440 * MiB : WS_AQ, WS_OB = MK_SEPARATE_O ? 472 * MiB : WS_BQ, WS_NEED = MK_SEPARATE_O ? 504 * MiB : WS_END;
constexpr size_t WS_HID = 96 * MiB;
static_assert(WS_WIN + (size_t)NIN * DM * 2 <= WS_WAB && WS_HID + (size_t)TOK * DFF * 2 <= WS_MIX, "ws map");

constexpr int LDS_RING = 131072, LDS_BYTES = 163840;

#define GAS __attribute__((address_space(1)))
#define LAS __attribute__((address_space(3)))
typedef unsigned short bf16;
typedef unsigned v4u __attribute__((ext_vector_type(4)));
typedef unsigned v2u __attribute__((ext_vector_type(2)));
typedef float v4f __attribute__((ext_vector_type(4)));

__device__ __forceinline__ float bf2f(unsigned short u) { return __uint_as_float((unsigned)u << 16); }
__device__ __forceinline__ float bflo(unsigned u) { return __uint_as_float(u << 16); }
__device__ __forceinline__ float bfhi(unsigned u) { return __uint_as_float(u & 0xffff0000u); }
__device__ __forceinline__ unsigned f2bf(float f) { unsigned u = __float_as_uint(f); return (u + 0x7fffu + ((u >> 16) & 1u)) >> 16; }
__device__ __forceinline__ unsigned pk2(float lo, float hi) { unsigned r; asm volatile("v_cvt_pk_bf16_f32 %0, %1, %2" : "=v"(r) : "v"(lo), "v"(hi)); return r; }
__device__ __forceinline__ float fexp2(float x) { return __builtin_amdgcn_exp2f(x); }
__device__ __forceinline__ float frsq(float x) { return __builtin_amdgcn_rsqf(x); }
__device__ __forceinline__ float frcp(float x) { return __builtin_amdgcn_rcpf(x); }
__device__ __forceinline__ float sigmoidf_(float x) { return frcp(1.0f + fexp2(-x * LOG2E)); }
__device__ __forceinline__ float wave_sum(float v) {
#pragma unroll
    for (int o = 1; o < 64; o <<= 1) v += __shfl_xor(v, o);
    return v;
}
__device__ __forceinline__ float wave_max(float v) {
#pragma unroll
    for (int o = 1; o < 64; o <<= 1) v = fmaxf(v, __shfl_xor(v, o));
    return v;
}
__device__ __forceinline__ int mbcnt64(unsigned long long m) { return __builtin_amdgcn_mbcnt_hi((unsigned)(m >> 32), __builtin_amdgcn_mbcnt_lo((unsigned)m, 0u)); }

namespace pg8 {
#define PG8_LAS __attribute__((address_space(3)))
typedef unsigned short bf16_t;
typedef short bf16x8 __attribute__((ext_vector_type(8)));
typedef float f32x4 __attribute__((ext_vector_type(4)));
typedef unsigned u32x4 __attribute__((ext_vector_type(4)));
constexpr int BM = 256, BK = 64, HALF = 128, HTB = HALF * BK * 2  , STAGE_BYTES = 8 * HTB, NXCD = 8, WGM = 8;

__host__ __device__ __forceinline__ int lds_byte(int r, int c) { const int st = (r >> 4) * 2 + (c >> 5), rr = r & 15, cc = c & 31, ob = rr * 64 + cc * 2; return st * 1024 + (ob ^ (((ob >> 9) & 1) << 5)); }
__host__ __device__ __forceinline__ void stage_rc(int b, int& R, int& C) { const int st = b / 1024, sb = b % 1024, swz = sb ^ (((sb >> 9) & 1) << 5); R = (st >> 1) * 16 + swz / 64; C = (st & 1) * 32 + (swz % 64) / 2; }
__host__ __device__ __forceinline__ int perm32(int rho) { const int n = rho >> 4, i = rho & 15; return 8 * (i >> 2) + 4 * n + (i & 3); }

struct Unit { int pm, pn; };
struct Gemm { const bf16_t* A; const bf16_t* Bt; int M, N, K; const bf16_t* A2; int asplit;
    __device__ __forceinline__ const char* abase(const Unit& u) const { return (const char*)(u.pn >= asplit ? A2 : A); } };

struct StaticOrder {
    int nM, nN, nwg, G, c;
    __host__ __device__ void init(int M, int N, int G_, int c_) { nM = M / BM; nN = N / BM; nwg = nM * nN; G = G_; c = c_; }
    __host__ __device__ bool next(int i, Unit& u) const {
        const long L = (long)i * G + c; if (L >= nwg) return false;
        int wgid = (int)L; { const int q = nwg / NXCD, r = nwg % NXCD, xcd = wgid % NXCD, off = wgid / NXCD; wgid = (xcd < r ? xcd * (q + 1) : r * (q + 1) + (xcd - r) * q) + off; }
        const int nig = WGM * nN, gid = wgid / nig, fm = gid * WGM, gsz = (nM - fm) < WGM ? (nM - fm) : WGM;
        u.pm = fm + ((wgid % nig) % gsz); u.pn = (wgid % nig) / gsz; return true;
    }
    __device__ __forceinline__ void a_ready(const Unit&) const {}
    __device__ __forceinline__ void done(const Unit&) const {}
};

__device__ __forceinline__ unsigned cvt_pk_bf16(float lo, float hi) { unsigned r; asm volatile("v_cvt_pk_bf16_f32 %0, %1, %2" : "=v"(r) : "v"(lo), "v"(hi)); return r; }
__device__ __forceinline__ u32x4 pack8(const float (&v)[8]) { u32x4 w; w.x = cvt_pk_bf16(v[0], v[1]); w.y = cvt_pk_bf16(v[2], v[3]); w.z = cvt_pk_bf16(v[4], v[5]); w.w = cvt_pk_bf16(v[6], v[7]); return w; }

struct EpiInProj {
    static constexpr bool PERM = true, AFTER_DRAIN = false;
    const float* rstd1; const float* cs; const float* sn; unsigned char* ws; const float* ikw; const float* ikb;
    __device__ __forceinline__ void operator()(const f32x4 (&acc)[2][2][4][2], const Unit& u, int wr, int wc, int fr_, int fq_) const {
        const int pn = u.pn; int fr = fr_, fq = fq_;
        asm volatile("" : "+v"(fr), "+v"(fq));
#pragma unroll
        for (int ai = 0; ai < 2; ++ai)
#pragma unroll
            for (int m = 0; m < 4; ++m) {
                const int row = u.pm * BM + ai * HALF + wr * 64 + m * 16 + fr;
                const float rs = rstd1[row];
                float x1[8], x2[8];
#pragma unroll
                for (int j = 0; j < 4; ++j) { x1[j] = acc[ai][0][m][0][j] * rs; x1[4 + j] = acc[ai][0][m][1][j] * rs; x2[j] = acc[ai][1][m][0][j] * rs; x2[4 + j] = acc[ai][1][m][1][j] * rs; }
                if (pn >= 9) {
                    bf16_t* G = (bf16_t*)(ws + WS_GA + (size_t)((pn - 9) >> 2) * (WS_GB - WS_GA)) + (size_t)row * 1024 + 256 * ((pn - 9) & 3) + 32 * wc + 8 * fq;
                    float a[8], b[8];
#pragma unroll
                    for (int j = 0; j < 8; ++j) { a[j] = 1.0f / (1.0f + __builtin_amdgcn_exp2f(-x1[j] * 1.4426950408889634f)); b[j] = 1.0f / (1.0f + __builtin_amdgcn_exp2f(-x2[j] * 1.4426950408889634f)); }
                    *(u32x4*)G = pack8(a); *(u32x4*)(G + 128) = pack8(b);
                } else if (pn == 8) {
                    if (wc == 0) {
                        float s = 0.f;
#pragma unroll
                        for (int j = 0; j < 8; ++j) s += x1[j] + x2[j];
                        s += __shfl_xor(s, 16); s += __shfl_xor(s, 32);
                        const float mu = s * (1.0f / 64.0f); float q = 0.f;
#pragma unroll
                        for (int j = 0; j < 8; ++j) { x1[j] -= mu; x2[j] -= mu; q += x1[j] * x1[j] + x2[j] * x2[j]; }
                        q += __shfl_xor(q, 16); q += __shfl_xor(q, 32);
                        const float rstd = __builtin_amdgcn_rsqf(q * (1.0f / 64.0f) + 1e-6f);
                        const int pos = row & 4095; const float* cp = cs + pos * 32 + 8 * fq; const float* sp = sn + pos * 32 + 8 * fq;
                        float o1[8], o2[8];
#pragma unroll
                        for (int j = 0; j < 8; ++j) { const float y1 = x1[j] * rstd * ikw[8 * fq + j] + ikb[8 * fq + j], y2 = x2[j] * rstd * ikw[32 + 8 * fq + j] + ikb[32 + 8 * fq + j];
                            const float c = cp[j], sI = sp[j]; o1[j] = y1 * c - y2 * sI; o2[j] = y2 * c + y1 * sI; }
                        unsigned char* tb = ws + WS_IK + (size_t)(row >> 5) * 4096 + (size_t)(row & 31) * 16;
                        *(u32x4*)(tb + (fq >> 1) * 1024 + (fq & 1) * 512) = pack8(o1); *(u32x4*)(tb + (2 + (fq >> 1)) * 1024 + (fq & 1) * 512) = pack8(o2);
                    } else if (wc == 1 && fq == 0) {
                        float* dst = (float*)(ws + WS_IW) + (size_t)row * 8;
                        *(f32x4*)dst = (f32x4){x1[0], x1[1], x1[2], x1[3]} * 0.04419417382415922f; *(f32x4*)(dst + 4) = (f32x4){x1[4], x1[5], x1[6], x1[7]} * 0.04419417382415922f;
                    }
                } else if (pn >= 6) {
                    bf16_t* Kd = (bf16_t*)(ws + WS_AK + (size_t)(pn - 6) * (WS_BK - WS_AK)); bf16_t* Vd = (bf16_t*)(ws + WS_AV + (size_t)(pn - 6) * (WS_BV - WS_AV));
                    if (wc < 2) {
                        const int pos = row & 4095; const float* cp = cs + pos * 32 + 8 * fq; const float* sp = sn + pos * 32 + 8 * fq;
                        float o1[8], o2[8];
#pragma unroll
                        for (int j = 0; j < 8; ++j) { const float c = cp[j], sI = sp[j]; o1[j] = x1[j] * c - x2[j] * sI; o2[j] = x2[j] * c + x1[j] * sI; }
                        bf16_t* dst = Kd + (size_t)row * 128 + wc * 64 + 8 * fq;
                        *(u32x4*)dst = pack8(o1); *(u32x4*)(dst + 32) = pack8(o2);
                    } else {
                        bf16_t* dst = Vd + (size_t)row * 128 + 32 * (wc - 2) + 8 * fq;
                        *(u32x4*)dst = pack8(x1); *(u32x4*)(dst + 64) = pack8(x2);
                    }
                } else {
                    bf16_t* Q = (bf16_t*)(ws + WS_AQ + (size_t)(pn >> 1) * (WS_IQ - WS_AQ)); const float sc = (pn >= 2 && pn < 4) ? 1.0f : 0.125f * 1.4426950408889634f;
                    const int pos = row & 4095; const float* cp = cs + pos * 32 + 8 * fq; const float* sp = sn + pos * 32 + 8 * fq;
                    float o1[8], o2[8];
#pragma unroll
                    for (int j = 0; j < 8; ++j) { const float c = cp[j], sI = sp[j]; o1[j] = (x1[j] * c - x2[j] * sI) * sc; o2[j] = (x2[j] * c + x1[j] * sI) * sc; }
                    bf16_t* dst = Q + (size_t)row * 512 + (4 * (pn & 1) + wc) * 64 + 8 * fq;
                    *(u32x4*)dst = pack8(o1); *(u32x4*)(dst + 32) = pack8(o2);
                }
                asm volatile("" ::: "memory");
            }
    }
};

struct EpiGate {
    static constexpr bool PERM = true, AFTER_DRAIN = false;
    const bf16_t *GA, *GB; float* P; bf16_t* MIX;
    __device__ __forceinline__ void operator()(const f32x4 (&acc)[2][2][4][2], const Unit& u, int wr, int wc, int fr, int fq) const {
        const bool second = u.pn >= 4; const bf16_t* G = second ? GB : GA;
#pragma unroll
        for (int ai = 0; ai < 2; ++ai)
#pragma unroll
            for (int m = 0; m < 4; ++m) {
                const int row = u.pm * BM + ai * HALF + wr * 64 + m * 16 + fr;
#pragma unroll
                for (int bj = 0; bj < 2; ++bj) {
                    const size_t off = (size_t)row * 1024 + 256 * (u.pn & 3) + 128 * bj + 32 * wc + 8 * fq;
                    const u32x4 gw = *(const u32x4*)(G + off);
                    float v[8];
#pragma unroll
                    for (int j = 0; j < 4; ++j) { v[j] = acc[ai][bj][m][0][j]; v[4 + j] = acc[ai][bj][m][1][j]; }
                    v[0] *= __uint_as_float(gw.x << 16); v[1] *= __uint_as_float(gw.x & 0xffff0000u); v[2] *= __uint_as_float(gw.y << 16); v[3] *= __uint_as_float(gw.y & 0xffff0000u);
                    v[4] *= __uint_as_float(gw.z << 16); v[5] *= __uint_as_float(gw.z & 0xffff0000u); v[6] *= __uint_as_float(gw.w << 16); v[7] *= __uint_as_float(gw.w & 0xffff0000u);
                    if (!second) { *(f32x4*)(P + off) = (f32x4){v[0], v[1], v[2], v[3]}; *(f32x4*)(P + off + 4) = (f32x4){v[4], v[5], v[6], v[7]}; }
                    else { const f32x4 p0 = *(const f32x4*)(P + off), p1 = *(const f32x4*)(P + off + 4);
#pragma unroll
                        for (int j = 0; j < 4; ++j) { v[j] += p0[j]; v[4 + j] += p1[j]; }
                        *(u32x4*)(MIX + off) = pack8(v); }
                }
            }
    }
};

template <bool WITH_XG> struct EpiResid {
    static constexpr bool PERM = false, AFTER_DRAIN = false;
    const float* base; float* out; bf16_t* XG; const float* gw; float* ss;
    __device__ __forceinline__ void operator()(const f32x4 (&acc)[2][2][4][2], const Unit& u, int wr, int wc, int fr, int fq) const {
#pragma unroll
        for (int ai = 0; ai < 2; ++ai)
#pragma unroll
            for (int m = 0; m < 4; ++m) {
                const int row = u.pm * BM + ai * HALF + wr * 64 + m * 16 + fr; float s = 0.f;
#pragma unroll
                for (int bj = 0; bj < 2; ++bj)
#pragma unroll
                    for (int n = 0; n < 2; ++n) {
                        const int col = u.pn * BM + bj * HALF + wc * 32 + n * 16 + 4 * fq; const size_t off = (size_t)row * 1024 + col;
                        const f32x4 v = *(const f32x4*)(base + off) + acc[ai][bj][m][n];
                        *(f32x4*)(out + off) = v; s += (v[0] * v[0] + v[1] * v[1]) + (v[2] * v[2] + v[3] * v[3]);
                        if (WITH_XG) { const f32x4 g = *(const f32x4*)(gw + col); unsigned long long w = (unsigned long long)cvt_pk_bf16(v[0] * g[0], v[1] * g[1]) | ((unsigned long long)cvt_pk_bf16(v[2] * g[2], v[3] * g[3]) << 32);
                            *(unsigned long long*)(XG + off) = w; }
                    }
                s += __shfl_xor(s, 16); s += __shfl_xor(s, 32);
                if (fq == 0) atomicAdd(ss + row, s);
            }
    }
};

struct EpiUp {
    static constexpr bool PERM = true, AFTER_DRAIN = false;
    const float* ss; bf16_t* HID;
    __device__ __forceinline__ void operator()(const f32x4 (&acc)[2][2][4][2], const Unit& u, int wr, int wc, int fr, int fq) const {
#pragma unroll
        for (int ai = 0; ai < 2; ++ai)
#pragma unroll
            for (int m = 0; m < 4; ++m) {
                const int row = u.pm * BM + ai * HALF + wr * 64 + m * 16 + fr;
                const float rs = __builtin_amdgcn_rsqf(ss[row] * (1.0f / 1024.0f) + 1e-6f);
#pragma unroll
                for (int bj = 0; bj < 2; ++bj) {
                    float v[8];
#pragma unroll
                    for (int j = 0; j < 4; ++j) { float a = fmaxf(acc[ai][bj][m][0][j] * rs, 0.f), b = fmaxf(acc[ai][bj][m][1][j] * rs, 0.f); v[j] = a * a; v[4 + j] = b * b; }
                    *(u32x4*)(HID + (size_t)row * 4096 + u.pn * BM + bj * HALF + wc * 32 + 8 * fq) = pack8(v);
                }
            }
    }
};

struct BranchOrder {
    int G, c;
    __device__ __forceinline__ bool next(int i, Unit& u) const {
        const int tile = (i >> 1) * G + c; if (tile >= 128 * 4) return false;
        u.pm = tile >> 2; u.pn = (tile & 3) + 4 * (i & 1); return true;
    }
    __device__ __forceinline__ void a_ready(const Unit&) const {}
    __device__ __forceinline__ void done(const Unit&) const {}
};

template <class Epi, class Sched, bool ALIGN_EPI = false, bool SP2 = false>
__device__ __forceinline__ void gemm_phase(PG8_LAS unsigned char* lds, const Gemm g, const Sched& S, const Epi& E) {
    const int tid = threadIdx.x, wid = __builtin_amdgcn_readfirstlane(tid >> 6), lane = tid & 63, wr = wid >> 2, wc = wid & 3, fr = lane & 15, fq = lane >> 4;
    const int K = g.K, nt = K / BK;
    unsigned voffA[2], voffB[2];
#pragma unroll
    for (int i = 0; i < 2; ++i) { int R, C; stage_rc(tid * 16 + i * 8192, R, C); const int Rb = Epi::PERM ? ((R & ~31) + perm32(R & 31)) : R;
        voffA[i] = (unsigned)(R * K + C) * 2u; voffB[i] = (unsigned)(Rb * K + C) * 2u; }
    const size_t kstep = (size_t)(BK * 2);
    const size_t hstep = (size_t)HALF * K * 2;
    const size_t tstep = 2 * hstep;
    const unsigned ldsw = (unsigned)wid * 1024u;
    const int aoff = lds_byte(wr * 64 + fr, fq * 8), boff = lds_byte(wc * 32 + fr, fq * 8);
#define PG8_SA(b, h) (((b) * 2 + (h)) * HTB)
#define PG8_SB(b, h) ((4 + (b) * 2 + (h)) * HTB)
#define PG8_STAGE(bufoff, gbase, voff) do { _Pragma("unroll") for (int _i = 0; _i < 2; ++_i) \
        __builtin_amdgcn_global_load_lds((const unsigned*)((const char*)(gbase) + (voff)[_i]), (PG8_LAS unsigned*)(lds + (bufoff) + ldsw + _i * 8192), 16, 0, 0); } while (0)
#define PG8_LDA(dst, b, h) do { _Pragma("unroll") for (int m = 0; m < 4; ++m) _Pragma("unroll") for (int k = 0; k < 2; ++k) dst[m][k] = *(const PG8_LAS bf16x8*)(lds + PG8_SA(b, h) + aoff + m * 2048 + k * 1024); } while (0)
#define PG8_LDB(dst, b, h) do { _Pragma("unroll") for (int n = 0; n < 2; ++n) _Pragma("unroll") for (int k = 0; k < 2; ++k) dst[n][k] = *(const PG8_LAS bf16x8*)(lds + PG8_SB(b, h) + boff + n * 2048 + k * 1024); } while (0)
#define PG8_MMA(ai, bj, At, Bt) do { __builtin_amdgcn_s_setprio(1); _Pragma("unroll") for (int m = 0; m < 4; ++m) _Pragma("unroll") for (int n = 0; n < 2; ++n) _Pragma("unroll") for (int k = 0; k < 2; ++k) \
        acc[ai][bj][m][n] = __builtin_amdgcn_mfma_f32_16x16x32_bf16(Bt[n][k], At[m][k], acc[ai][bj][m][n], 0, 0, 0); __builtin_amdgcn_s_setprio(0); } while (0)
#define PG8_WAIT_V(n) asm volatile("s_waitcnt vmcnt(" #n ")" ::: "memory")
#define PG8_WAIT_L(n) asm volatile("s_waitcnt lgkmcnt(" #n ")" ::: "memory")
#define PG8_BAR __builtin_amdgcn_s_barrier()
#define PG8_SCHED __builtin_amdgcn_sched_barrier(0)
    Unit cur, nxt; int ui = 0;
    if (!S.next(0, cur)) return;
    f32x4 acc[2][2][4][2];
#pragma unroll
    for (int a = 0; a < 2; ++a)
#pragma unroll
        for (int b = 0; b < 2; ++b)
#pragma unroll
            for (int m = 0; m < 4; ++m)
#pragma unroll
                for (int n = 0; n < 2; ++n) acc[a][b][m][n] = (f32x4){0.f, 0.f, 0.f, 0.f};
    bf16x8 At[4][2], B0[2][2], B1[2][2];
    const char* cA = g.abase(cur) + (size_t)cur.pm * tstep; const char* cB = (const char*)g.Bt + (size_t)cur.pn * tstep;
    S.a_ready(cur);
    if constexpr (SP2) {
        PG8_STAGE(PG8_SB(0, 0), cB, voffB); PG8_STAGE(PG8_SB(0, 1), cB + hstep, voffB); PG8_STAGE(PG8_SA(0, 0), cA, voffA); PG8_STAGE(PG8_SA(0, 1), cA + hstep, voffA);
        if (wr == 1) PG8_BAR;
        PG8_WAIT_V(2); PG8_BAR;
        PG8_STAGE(PG8_SB(1, 0), cB + kstep, voffB); PG8_STAGE(PG8_SA(1, 0), cA + kstep, voffA); PG8_STAGE(PG8_SB(1, 1), cB + hstep + kstep, voffB);
        PG8_WAIT_V(6); PG8_BAR;
    } else {
        PG8_STAGE(PG8_SB(0, 0), cB, voffB); PG8_STAGE(PG8_SA(0, 0), cA, voffA); PG8_STAGE(PG8_SB(0, 1), cB + hstep, voffB); PG8_STAGE(PG8_SA(0, 1), cA + hstep, voffA);
        if (wr == 1) PG8_BAR;
        PG8_WAIT_V(4); PG8_BAR;
        PG8_STAGE(PG8_SB(1, 0), cB + kstep, voffB); PG8_STAGE(PG8_SA(1, 0), cA + kstep, voffA); PG8_STAGE(PG8_SB(1, 1), cB + hstep + kstep, voffB);
        PG8_WAIT_V(6); PG8_BAR;
    }
    for (;;) {
        const bool has_next = S.next(ui + 1, nxt);
        const char* nA = has_next ? g.abase(nxt) + (size_t)nxt.pm * tstep : cA; const char* nB = has_next ? (const char*)g.Bt + (size_t)nxt.pn * tstep : cB;
        for (int t = 0; t < nt; t += 2) {
            const bool last = (t == nt - 2);
            const char* a1 = cA + (size_t)(t + 1) * kstep;
            const char* a2 = last ? nA : cA + (size_t)(t + 2) * kstep; const char* b2 = last ? nB : cB + (size_t)(t + 2) * kstep;
            const char* a3 = a2 + kstep; const char* b3 = b2 + kstep;
            if (last && has_next) S.a_ready(nxt);
            if constexpr (SP2) {
            PG8_LDB(B0, 0, 0); PG8_LDB(B1, 0, 1); PG8_SCHED; PG8_LDA(At, 0, 0); PG8_STAGE(PG8_SA(1, 1), a1 + hstep, voffA);
            PG8_WAIT_V(8); PG8_WAIT_L(0); PG8_BAR; PG8_MMA(0, 0, At, B0); PG8_MMA(0, 1, At, B1); PG8_BAR; PG8_SCHED;
            PG8_LDA(At, 0, 1); PG8_STAGE(PG8_SB(0, 0), b2, voffB); PG8_STAGE(PG8_SB(0, 1), b2 + hstep, voffB); PG8_STAGE(PG8_SA(0, 0), a2, voffA);
            PG8_WAIT_V(8); PG8_WAIT_L(0); PG8_BAR; PG8_MMA(1, 0, At, B0); PG8_MMA(1, 1, At, B1); PG8_BAR; PG8_SCHED;
            PG8_LDB(B0, 1, 0); PG8_LDB(B1, 1, 1); PG8_SCHED; PG8_LDA(At, 1, 0); PG8_STAGE(PG8_SA(0, 1), a2 + hstep, voffA);
            PG8_WAIT_V(8); PG8_WAIT_L(0); PG8_BAR; PG8_MMA(0, 0, At, B0); PG8_MMA(0, 1, At, B1); PG8_BAR; PG8_SCHED;
            PG8_LDA(At, 1, 1); PG8_STAGE(PG8_SB(1, 0), b3, voffB); PG8_STAGE(PG8_SB(1, 1), b3 + hstep, voffB); PG8_STAGE(PG8_SA(1, 0), a3, voffA);
            PG8_WAIT_V(8); PG8_WAIT_L(0); PG8_BAR; PG8_MMA(1, 0, At, B0); PG8_MMA(1, 1, At, B1); PG8_BAR; PG8_SCHED;
            } else {
            PG8_LDB(B0, 0, 0); PG8_SCHED; PG8_LDA(At, 0, 0); PG8_STAGE(PG8_SA(1, 1), a1 + hstep, voffA);
            PG8_WAIT_L(8); PG8_BAR; PG8_WAIT_L(0); PG8_MMA(0, 0, At, B0); PG8_BAR; PG8_SCHED;
            PG8_LDB(B1, 0, 1); PG8_STAGE(PG8_SB(0, 0), b2, voffB);
            PG8_BAR; PG8_WAIT_L(0); PG8_MMA(0, 1, At, B1); PG8_BAR;
            PG8_LDA(At, 0, 1); PG8_STAGE(PG8_SA(0, 0), a2, voffA);
            PG8_BAR; PG8_WAIT_L(0); PG8_MMA(1, 0, At, B0); PG8_BAR; PG8_SCHED;
            PG8_STAGE(PG8_SB(0, 1), b2 + hstep, voffB);
            PG8_WAIT_V(6); PG8_BAR; PG8_MMA(1, 1, At, B1); PG8_BAR;
            PG8_LDB(B0, 1, 0); PG8_SCHED; PG8_LDA(At, 1, 0); PG8_STAGE(PG8_SA(0, 1), a2 + hstep, voffA);
            PG8_WAIT_L(8); PG8_BAR; PG8_WAIT_L(0); PG8_MMA(0, 0, At, B0); PG8_BAR; PG8_SCHED;
            PG8_LDB(B1, 1, 1); PG8_STAGE(PG8_SB(1, 0), b3, voffB);
            PG8_BAR; PG8_WAIT_L(0); PG8_MMA(0, 1, At, B1); PG8_BAR;
            PG8_LDA(At, 1, 1); PG8_STAGE(PG8_SA(1, 0), a3, voffA);
            PG8_BAR; PG8_WAIT_L(0); PG8_MMA(1, 0, At, B0); PG8_BAR; PG8_SCHED;
            PG8_STAGE(PG8_SB(1, 1), b3 + hstep, voffB);
            PG8_WAIT_V(6); PG8_BAR; PG8_MMA(1, 1, At, B1); PG8_BAR;
            }
        }
        if constexpr (ALIGN_EPI) { if (wr == 0) PG8_BAR; }
        if constexpr (!Epi::AFTER_DRAIN) { E(acc, cur, wr, wc, fr, fq); S.done(cur); }
        if (!has_next) break;
#pragma unroll
        for (int a = 0; a < 2; ++a)
#pragma unroll
            for (int b = 0; b < 2; ++b)
#pragma unroll
                for (int m = 0; m < 4; ++m)
#pragma unroll
                    for (int n = 0; n < 2; ++n) acc[a][b][m][n] = (f32x4){0.f, 0.f, 0.f, 0.f};
        cur = nxt; cA = nA; cB = nB; ++ui;
        if constexpr (ALIGN_EPI) { if (wr == 1) PG8_BAR; }
    }
    PG8_WAIT_V(0);
    if constexpr (!ALIGN_EPI) { if (wr == 0) PG8_BAR; }
    PG8_BAR;
    if constexpr (Epi::AFTER_DRAIN) { E.fused(acc, cur, wr, wc, fr, fq, lds, wid, lane); S.done(cur); }
#undef PG8_SA
#undef PG8_SB
#undef PG8_STAGE
#undef PG8_LDA
#undef PG8_LDB
#undef PG8_MMA
#undef PG8_WAIT_V
#undef PG8_WAIT_L
#undef PG8_BAR
#undef PG8_SCHED
}
}
struct Params {
    const float *x, *attn_norm_w, *w_in, *ikw, *ikb, *sinks, *w_a, *w_b, *w_out, *mlp_norm_w, *w_up, *w_down, *final_w;
    float* out; unsigned char* ws;
    float inv_freq[32];
    int ph_lo, ph_hi;
};
constexpr int NWAVES = 8, NTHREADS = 512;

__device__ __forceinline__ int win_src_group(int grp, int& cnt) {
    const int tile = grp >> 3, g = grp & 7; cnt = 32;
    if (tile < 6) { const int base = tile < 2 ? C_AQ : (tile < 4 ? C_IQ : C_BQ); const int head = 4 * (tile & 1) + (g & 3); return base + head * 64 + 32 * (g >> 2); }
    if (tile < 8) { const int kb = tile == 6 ? C_AK : C_BK, vb = tile == 6 ? C_AV : C_BV; const int hf = g >> 2, q = g & 3;
        if (q < 2) return kb + q * 64 + 32 * hf; return vb + 64 * hf + 32 * (q - 2); }
    if (tile == 8) { if (g == 0) return C_IK; if (g == 4) return C_IK + 32; if (g == 1) { cnt = 8; return C_IW; } cnt = 0; return 0; }
    return C_GA + (grp - 72) * 32;
}
__device__ __forceinline__ void p0_transpose_item(const float* W, int ldw, int c0, int cnt, int K, bf16* WT, int n0, int k0, LAS float* scr, int lane) {
#pragma unroll 8
    for (int i = 0; i < 32; ++i) { const int kk = 2 * i + (lane >> 5), n = lane & 31; scr[kk * 33 + n] = (n < cnt) ? W[(size_t)(k0 + kk) * ldw + c0 + n] : 0.f; }
    asm volatile("s_waitcnt lgkmcnt(0)" ::: "memory");
    const int c = lane & 7;
#pragma unroll
    for (int j = 0; j < 4; ++j) { const int n = (lane >> 3) + 8 * j; const LAS float* s = scr + (8 * c) * 33 + n;
        v4u o; o.x = pk2(s[0 * 33], s[1 * 33]); o.y = pk2(s[2 * 33], s[3 * 33]); o.z = pk2(s[4 * 33], s[5 * 33]); o.w = pk2(s[6 * 33], s[7 * 33]);
        *(v4u*)(WT + (size_t)(n0 + n) * K + k0 + 8 * c) = o; }
    asm volatile("s_waitcnt lgkmcnt(0)" ::: "memory");
}
__device__ __forceinline__ void sincos_d(float angf, float& sn, float& cs) {
    const double a = (double)angf; const double kq = __builtin_rint(a * 0.63661977236758134308);
    const double y = (a - kq * 1.57079632679489655800) - kq * 6.123233995736766e-17; const double y2 = y * y;
    double s = y * (1.0 + y2 * (-1.0 / 6 + y2 * (1.0 / 120 + y2 * (-1.0 / 5040 + y2 * (1.0 / 362880 + y2 * (-1.0 / 39916800 + y2 * (1.0 / 6227020800.0)))))));
    double c = 1.0 + y2 * (-0.5 + y2 * (1.0 / 24 + y2 * (-1.0 / 720 + y2 * (1.0 / 40320 + y2 * (-1.0 / 3628800 + y2 * (1.0 / 479001600.0 + y2 * (-1.0 / 87178291200.0)))))));
    const int q = ((int)kq) & 3;
    const double ss = (q == 0) ? s : (q == 1) ? c : (q == 2) ? -s : -c; const double cc = (q == 0) ? c : (q == 1) ? -s : (q == 2) ? -c : s;
    sn = (float)ss; cs = (float)cc;
}
__device__ __forceinline__ void phase_prologue(const Params& p, LAS unsigned char* lds, int G) {
    const int lane = threadIdx.x & 63, wave = __builtin_amdgcn_readfirstlane(threadIdx.x >> 6);
    unsigned char* ws = p.ws;
    LAS float* scr = (LAS float*)(lds + wave * 16384);
    const int gw = blockIdx.x * NWAVES + wave, NGW = G * NWAVES;
    constexpr int I_IN = (DM / 64) * (NIN / 32), I_A = (512 / 64) * (DM / 32), I_O = (DM / 64) * (DM / 32), I_U = (DM / 64) * (DFF / 32), I_D = (DFF / 64) * (DM / 32);
    constexpr int NITEMS = I_IN + 2 * I_A + I_O + I_U + I_D;
    for (int it = gw; it < NITEMS; it += NGW) {
        int r = it;
        if (r < I_IN) { const int grp = r % (NIN / 32), kb = r / (NIN / 32); int cnt; const int c0 = win_src_group(grp, cnt);
            p0_transpose_item(p.w_in, D_IN, c0, cnt, DM, (bf16*)(ws + WS_WIN), grp * 32, kb * 64, scr, lane); continue; } r -= I_IN;
        if (r < I_A) { const int nb = r % 32, kb = r / 32; p0_transpose_item(p.w_a, DM, nb * 32, 32, 512, (bf16*)(ws + WS_WAB), nb * 32, kb * 64, scr, lane); continue; } r -= I_A;
        if (r < I_A) { const int nb = r % 32, kb = r / 32; p0_transpose_item(p.w_b, DM, nb * 32, 32, 512, (bf16*)(ws + WS_WAB), 1024 + nb * 32, kb * 64, scr, lane); continue; } r -= I_A;
        if (r < I_O) { const int nb = r % 32, kb = r / 32; p0_transpose_item(p.w_out, DM, nb * 32, 32, DM, (bf16*)(ws + WS_WOUT), nb * 32, kb * 64, scr, lane); continue; } r -= I_O;
        if (r < I_U) { const int nb = r % 128, kb = r / 128; p0_transpose_item(p.w_up, DFF, nb * 32, 32, DM, (bf16*)(ws + WS_WUP), nb * 32, kb * 64, scr, lane); continue; } r -= I_U;
        { const int nb = r % 32, kb = r / 32; p0_transpose_item(p.w_down, DM, nb * 32, 32, DFF, (bf16*)(ws + WS_WDN), nb * 32, kb * 64, scr, lane); }
    }
    float* COS = (float*)(ws + WS_COS); float* SIN = (float*)(ws + WS_SIN);
    for (int i = gw * 64 + lane; i < SEQ * 32; i += NGW * 64) { const int pos = i >> 5, d = i & 31; const float ang = (float)pos * p.inv_freq[d]; float s, c; sincos_d(ang, s, c); COS[i] = c; SIN[i] = s; }
    float* RSTD1 = (float*)(ws + WS_RSTD1); float* SS2 = (float*)(ws + WS_SS2); float* SS3 = (float*)(ws + WS_SS3); bf16* XG = (bf16*)(ws + WS_XG);
    v4f g[4];
#pragma unroll
    for (int j = 0; j < 4; ++j) g[j] = *((const v4f*)p.attn_norm_w + lane + 64 * j);
    for (int m = gw; m < TOK; m += NGW) {
        const v4f* xr = (const v4f*)(p.x + (size_t)m * DM) + lane; v4f v[4]; float s = 0.f;
#pragma unroll
        for (int j = 0; j < 4; ++j) { v[j] = xr[64 * j]; s += (v[j].x * v[j].x + v[j].y * v[j].y) + (v[j].z * v[j].z + v[j].w * v[j].w); }
        s = wave_sum(s);
        unsigned long long* o8 = (unsigned long long*)(XG + (size_t)m * DM) + lane;
#pragma unroll
        for (int j = 0; j < 4; ++j) o8[64 * j] = (unsigned long long)pk2(v[j].x * g[j].x, v[j].y * g[j].y) | ((unsigned long long)pk2(v[j].z * g[j].z, v[j].w * g[j].w) << 32);
        if (lane == 0) { RSTD1[m] = frsq(s * (1.0f / DM) + RMS_EPS); SS2[m] = 0.f; SS3[m] = 0.f; }
    }
}

__device__ __forceinline__ unsigned f2key(float f) { const unsigned u = __float_as_uint(f); return (u & 0x80000000u) ? ~u : (u | 0x80000000u); }
__device__ __forceinline__ void phase_topk_simple(const Params& p, LAS unsigned char* lds, int G) {
    const int lane = threadIdx.x & 63, wave = __builtin_amdgcn_readfirstlane(threadIdx.x >> 6);
    unsigned char* ws = p.ws;
    const bf16* IQ = (const bf16*)(ws + WS_IQ); const bf16* IK = (const bf16*)(ws + WS_IK); const float* IW = (const float*)(ws + WS_IW);
    unsigned short* SEL = (unsigned short*)(ws + WS_SEL);
    LAS unsigned* keys = (LAS unsigned*)(lds + wave * 16384);
    LAS float* qf = (LAS float*)(lds + LDS_RING + wave * 2048);
    const int gw = blockIdx.x * NWAVES + wave, NGW = G * NWAVES;
    for (int row = gw; row < TOK; row += NGW) {
        const int b = row >> 12, t = row & 4095, n = t + 1;
        unsigned short* selrow = SEL + (size_t)row * TOPK;
        if (n <= TOPK) { for (int i = lane; i < n; i += 64) selrow[i] = (unsigned short)i; continue; }
        { const v4u q8 = *((const v4u*)(IQ + (size_t)row * 512) + lane);
            LAS float* d = qf + 8 * lane;
            d[0] = bflo(q8.x); d[1] = bfhi(q8.x); d[2] = bflo(q8.y); d[3] = bfhi(q8.y); d[4] = bflo(q8.z); d[5] = bfhi(q8.z); d[6] = bflo(q8.w); d[7] = bfhi(q8.w); }
        float w[8];
#pragma unroll
        for (int h = 0; h < 8; ++h) w[h] = IW[(size_t)row * 8 + h];
        asm volatile("s_waitcnt lgkmcnt(0)" ::: "memory");
        for (int s0 = 0; s0 < n; s0 += 64) {
            const int s = s0 + lane; const int sc = s < n ? s : t;
            const v4u* kp = (const v4u*)(IK + ((size_t)b * SEQ + sc) * 64);
            float dot[8];
#pragma unroll
            for (int h = 0; h < 8; ++h) dot[h] = 0.f;
#pragma unroll
            for (int c = 0; c < 8; ++c) {
                const v4u k8 = kp[c]; float kf[8] = {bflo(k8.x), bfhi(k8.x), bflo(k8.y), bfhi(k8.y), bflo(k8.z), bfhi(k8.z), bflo(k8.w), bfhi(k8.w)};
#pragma unroll
                for (int h = 0; h < 8; ++h) { const v4f qa = *(const LAS v4f*)(qf + h * 64 + c * 8), qb = *(const LAS v4f*)(qf + h * 64 + c * 8 + 4);
                    dot[h] += (kf[0] * qa.x + kf[1] * qa.y) + (kf[2] * qa.z + kf[3] * qa.w) + (kf[4] * qb.x + kf[5] * qb.y) + (kf[6] * qb.z + kf[7] * qb.w); }
            }
            float sc_ = 0.f;
#pragma unroll
            for (int h = 0; h < 8; ++h) sc_ += w[h] * fmaxf(dot[h], 0.f);
            keys[s] = (s < n) ? f2key(sc_) : 0u;
        }
        asm volatile("s_waitcnt lgkmcnt(0)" ::: "memory");
        const int nch = (n + 63) >> 6;
        unsigned thr = 0u;
        for (int bit = 31; bit >= 0; --bit) {
            const unsigned cand = thr | (1u << bit); int cnt = 0;
            for (int c = 0; c < nch; ++c) cnt += __popcll(__ballot(keys[c * 64 + lane] >= cand));
            if (cnt >= TOPK) thr = cand;
        }
        int cgt = 0;
        for (int c = 0; c < nch; ++c) cgt += __popcll(__ballot(keys[c * 64 + lane] > thr));
        const int need = TOPK - cgt; int pos = 0, ties = 0;
        for (int c = 0; c < nch; ++c) {
            const unsigned k = keys[c * 64 + lane]; const bool gt = k > thr, eq = k == thr;
            const unsigned long long meq = __ballot(eq);
            const bool sel = gt || (eq && (ties + mbcnt64(meq) < need));
            const unsigned long long msel = __ballot(sel);
            if (sel) selrow[pos + mbcnt64(msel)] = (unsigned short)(c * 64 + lane);
            pos += __popcll(msel); ties += __popcll(meq);
        }
    }
}

template <bool SINK, class KeyFn>
__device__ __forceinline__ void attend_wave(const bf16* Q, const bf16* K, const bf16* V, bf16* O, int row, int g, int nslots, const KeyFn& keyfn, const float* sinkv,
                                            LAS float* qf  , LAS float* pf  , LAS int* kidx  , int lane) {
    const int b = row >> 12;
    { const v2u q4 = *((const v2u*)(Q + (size_t)row * 512 + g * 256) + lane);
        LAS float* d = qf + 4 * lane; d[0] = bflo(q4.x); d[1] = bfhi(q4.x); d[2] = bflo(q4.y); d[3] = bfhi(q4.y); }
    asm volatile("s_waitcnt lgkmcnt(0)" ::: "memory");
#pragma unroll 1
    for (int j = 0; j < 4; ++j) {
        const int slot = 64 * j + lane; int key = slot < nslots ? keyfn(slot) : -1; kidx[slot] = key;
        const bool valid = key >= 0; const int kc = valid ? key : 0;
        const v4u* kp = (const v4u*)(K + ((size_t)b * SEQ + kc) * 128 + g * 64);
        float dot[4] = {0.f, 0.f, 0.f, 0.f};
        if (64 * j < nslots) {
#pragma unroll 2
            for (int c = 0; c < 8; ++c) {
                const v4u k8 = kp[c]; float kf[8] = {bflo(k8.x), bfhi(k8.x), bflo(k8.y), bfhi(k8.y), bflo(k8.z), bfhi(k8.z), bflo(k8.w), bfhi(k8.w)};
#pragma unroll
                for (int h = 0; h < 4; ++h) { const v4f qa = *(const LAS v4f*)(qf + h * 64 + c * 8), qb = *(const LAS v4f*)(qf + h * 64 + c * 8 + 4);
                    dot[h] += (kf[0] * qa.x + kf[1] * qa.y) + (kf[2] * qa.z + kf[3] * qa.w) + (kf[4] * qb.x + kf[5] * qb.y) + (kf[6] * qb.z + kf[7] * qb.w); }
            }
        }
        *(LAS v4f*)(pf + slot * 4) = valid ? (v4f){dot[0], dot[1], dot[2], dot[3]} : (v4f){-INFINITY, -INFINITY, -INFINITY, -INFINITY};
    }
    asm volatile("s_waitcnt lgkmcnt(0)" ::: "memory");
    float lg[4][4];
#pragma unroll
    for (int j = 0; j < 4; ++j) { const v4f t4 = *(const LAS v4f*)(pf + (64 * j + lane) * 4); lg[j][0] = t4.x; lg[j][1] = t4.y; lg[j][2] = t4.z; lg[j][3] = t4.w; }
    float inv[4];
#pragma unroll
    for (int h = 0; h < 4; ++h) {
        float mx = fmaxf(fmaxf(lg[0][h], lg[1][h]), fmaxf(lg[2][h], lg[3][h])); mx = wave_max(mx);
        float sk = 0.f; if (SINK) { sk = sinkv[g * 4 + h] * LOG2E; mx = fmaxf(mx, sk); }
        float s = 0.f;
#pragma unroll
        for (int j = 0; j < 4; ++j) { const float e = fexp2(lg[j][h] - mx); lg[j][h] = e; s += e; }
        s = wave_sum(s); if (SINK) s += fexp2(sk - mx);
        inv[h] = 1.0f / s;
    }
#pragma unroll
    for (int j = 0; j < 4; ++j) *(LAS v4f*)(pf + (64 * j + lane) * 4) = (v4f){lg[j][0], lg[j][1], lg[j][2], lg[j][3]};
    asm volatile("s_waitcnt lgkmcnt(0)" ::: "memory");
    float o[4] = {0.f, 0.f, 0.f, 0.f};
    const bf16* Vb = V + (size_t)b * SEQ * 128 + g * 64 + lane;
#pragma unroll 1
    for (int s0 = 0; s0 < nslots; s0 += 8) {
        float vv[8]; v4f pp[8];
#pragma unroll
        for (int i = 0; i < 8; ++i) { const int slot = s0 + i; const int key = slot < nslots ? kidx[slot] : -1; pp[i] = *(const LAS v4f*)(pf + (slot & 255) * 4);
            vv[i] = key >= 0 ? bf2f(Vb[(size_t)key * 128]) : 0.f; if (key < 0) pp[i] = (v4f){0.f, 0.f, 0.f, 0.f}; }
#pragma unroll
        for (int i = 0; i < 8; ++i) { o[0] += pp[i].x * vv[i]; o[1] += pp[i].y * vv[i]; o[2] += pp[i].z * vv[i]; o[3] += pp[i].w * vv[i]; }
    }
    bf16* op = O + (size_t)row * 512 + g * 256 + lane;
#pragma unroll
    for (int h = 0; h < 4; ++h) op[h * 64] = (bf16)f2bf(o[h] * inv[h]);
}
struct SelKey { const unsigned short* selrow; __device__ __forceinline__ int operator()(int slot) const { return (int)selrow[slot]; } };
struct WinKey { int t; __device__ __forceinline__ int operator()(int slot) const { return t - (WIN - 1) + slot; } };

template <bool DO_DSA, bool DO_SWA>
__device__ __forceinline__ void phase_attn_simple(const Params& p, LAS unsigned char* lds, int G) {
    const int lane = threadIdx.x & 63, wave = __builtin_amdgcn_readfirstlane(threadIdx.x >> 6);
    unsigned char* ws = p.ws;
    LAS float* qf = (LAS float*)(lds + wave * 16384); LAS float* pf = qf + 256; LAS int* kidx = (LAS int*)(pf + 1024);
    const int gw = blockIdx.x * NWAVES + wave, NGW = G * NWAVES;
    const unsigned short* SEL = (const unsigned short*)(ws + WS_SEL);
    for (int item = gw; item < TOK * 2; item += NGW) {
        const int row = item >> 1, g = item & 1, t = row & 4095;
        if (DO_DSA) { SelKey kf{SEL + (size_t)row * TOPK}; const int ns = (t + 1 < TOPK) ? t + 1 : TOPK;
            attend_wave<false>((const bf16*)(ws + WS_AQ), (const bf16*)(ws + WS_AK), (const bf16*)(ws + WS_AV), (bf16*)(ws + WS_OA), row, g, ns, kf, nullptr, qf, pf, kidx, lane); }
        if (DO_SWA) { WinKey kf{t};
            attend_wave<true>((const bf16*)(ws + WS_BQ), (const bf16*)(ws + WS_BK), (const bf16*)(ws + WS_BV), (bf16*)(ws + WS_OB), row, g, WIN, kf, p.sinks, qf, pf, kidx, lane); }
    }
}

__device__ __forceinline__ void phase_final(const Params& p, int G) {
    const int lane = threadIdx.x & 63, wave = __builtin_amdgcn_readfirstlane(threadIdx.x >> 6);
    const float* SS3 = (const float*)(p.ws + WS_SS3);
    const int gw = blockIdx.x * NWAVES + wave, NGW = G * NWAVES;
    v4f g[4];
#pragma unroll
    for (int j = 0; j < 4; ++j) g[j] = *((const v4f*)p.final_w + lane + 64 * j);
    for (int m = gw; m < TOK; m += NGW) {
        const float rs = frsq(SS3[m] * (1.0f / DM) + RMS_EPS);
        v4f* xr = (v4f*)(p.out + (size_t)m * DM) + lane;
#pragma unroll
        for (int j = 0; j < 4; ++j) { v4f v = xr[64 * j]; xr[64 * j] = v * g[j] * rs; }
    }
}

typedef short bf16x8_t __attribute__((ext_vector_type(8)));
typedef float f32x16_t __attribute__((ext_vector_type(16)));
typedef float f32x4_t __attribute__((ext_vector_type(4)));
typedef float f32x2_t __attribute__((ext_vector_type(2)));
__device__ __forceinline__ unsigned f16key(float f) { const int q = (int)__builtin_rintf(f * 4096.0f) + 32768; return (unsigned)(q < 256 ? 256 : (q > 65535 ? 65535 : q)); }
__device__ __forceinline__ float relu1(float x) { return __builtin_amdgcn_fmed3f(x, 0.f, 3.0e38f); }
constexpr int TK_H1 = LDS_RING, TK_WAVE = LDS_RING + 8192, TK_WAVE_BYTES = 3072, TK_CAND = 512;
static_assert(TK_WAVE + 8 * TK_WAVE_BYTES <= LDS_BYTES, "top-k LDS map");

__device__ __forceinline__ void phase_topk_fast(const Params& p, LAS unsigned char* lds, int G) {
    const int tid = threadIdx.x, lane = tid & 63, wave = __builtin_amdgcn_readfirstlane(tid >> 6);
    const int r = lane & 31, h = lane >> 5, mt = wave & 3, par = wave >> 2;
    unsigned char* ws = p.ws;
    const bf16* IQ = (const bf16*)(ws + WS_IQ); const bf16* IK = (const bf16*)(ws + WS_IK); const float* IW = (const float*)(ws + WS_IW);
    unsigned short* SEL = (unsigned short*)(ws + WS_SEL);
    LAS unsigned short* kb = (LAS unsigned short*)lds;
    LAS unsigned* H1 = (LAS unsigned*)(lds + TK_H1);
    LAS unsigned* cl = (LAS unsigned*)(lds + TK_WAVE + wave * TK_WAVE_BYTES); LAS unsigned short* ol = (LAS unsigned short*)(lds + TK_WAVE + wave * TK_WAVE_BYTES + 4 * TK_CAND);
    const int qrow = 4 * mt + 2 * ((r >> 2) & 1) + (r >> 4), qhead = 4 * ((r >> 3) & 1) + (r & 3);
    { LAS v4u* hz = (LAS v4u*)H1; hz[tid] = (v4u){0u, 0u, 0u, 0u}; }
    for (int k = 0;; ++k) {
        int b, tile;
        if (G == 256) { if (k >= 8) break; const int c = blockIdx.x, i = c >> 3, grp = k >> 1; b = c & 7; tile = (k & 1) ? (64 * grp + 63 - i) : (64 * grp + i); }
        else { const int u = blockIdx.x + k * G; if (u >= TOK / 16) break; b = u >> 8; tile = u & 255; }
        const int t0 = tile * 16, R0 = b * SEQ + t0;
        if (t0 + 16 <= TOPK) {
            for (int i = tid; i < 16 * TOPK; i += NTHREADS) { const int ql = i >> 8, s = i & 255; if (s <= t0 + ql) SEL[(size_t)(R0 + ql) * TOPK + s] = (unsigned short)s; }
            continue;
        }
        bf16x8_t aq[4];
#pragma unroll
        for (int s = 0; s < 4; ++s) aq[s] = *(const bf16x8_t*)(IQ + (size_t)(R0 + qrow) * 512 + qhead * 64 + 16 * s + 8 * h);
        f32x2_t wq[2][4];
#pragma unroll
        for (int qq = 0; qq < 2; ++qq) { const f32x4_t w0 = *(const f32x4_t*)(IW + (size_t)(R0 + 4 * mt + 2 * h + qq) * 8), w1 = *(const f32x4_t*)(IW + (size_t)(R0 + 4 * mt + 2 * h + qq) * 8 + 4);
            wq[qq][0] = (f32x2_t){w0[0], w0[1]}; wq[qq][1] = (f32x2_t){w0[2], w0[3]}; wq[qq][2] = (f32x2_t){w1[0], w1[1]}; wq[qq][3] = (f32x2_t){w1[2], w1[3]}; }
        const int ntile = (t0 + 16 + 31) >> 5, ntp = (ntile + 7) & ~7, nch = (t0 + 16 + 511) >> 9;
        const char* kbase = (const char*)IK + (size_t)b * SEQ * 128;
        const unsigned voff = (unsigned)(lane * 16);
        const int tq0 = t0 + 4 * mt + 2 * h;
        const int ql0 = 4 * mt + 2 * h;
        LAS unsigned short* row0 = kb + ql0 * 4096; LAS unsigned* h0 = H1 + ql0 * 128;
        __syncthreads();
#define TK_LOAD(dst, kt_) do { const int ktc_ = (kt_) < 127 ? (kt_) : 127; const char* tp_ = kbase + (size_t)ktc_ * 4096; _Pragma("unroll") for (int s_ = 0; s_ < 4; ++s_) dst[s_] = *(const bf16x8_t*)(tp_ + voff + 1024 * s_); } while (0)
#define TK_MMA(acc_, src) do { acc_ = (f32x16_t){0.f, 0.f, 0.f, 0.f, 0.f, 0.f, 0.f, 0.f, 0.f, 0.f, 0.f, 0.f, 0.f, 0.f, 0.f, 0.f}; \
            _Pragma("unroll") for (int s_ = 0; s_ < 4; ++s_) acc_ = __builtin_amdgcn_mfma_f32_32x32x16_bf16(aq[s_], src[s_], acc_, 0, 0, 0); } while (0)
#define TK_POST(acc_, kt_) do { f32x2_t s0_ = {0.f, 0.f}, s1_ = {0.f, 0.f}; \
            _Pragma("unroll") for (int hd_ = 0; hd_ < 4; ++hd_) { s0_ += (f32x2_t){relu1(acc_[2 * hd_]), relu1(acc_[2 * hd_ + 1])} * wq[0][hd_]; s1_ += (f32x2_t){relu1(acc_[8 + 2 * hd_]), relu1(acc_[9 + 2 * hd_])} * wq[1][hd_]; } \
            const int e_ = 32 * (kt_) + r; const unsigned k0_ = (e_ <= tq0) ? f16key(s0_.x + s0_.y) : 0u, k1_ = (e_ <= tq0 + 1) ? f16key(s1_.x + s1_.y) : 0u; \
            row0[e_] = (unsigned short)k0_; row0[4096 + e_] = (unsigned short)k1_; \
            if (k0_) __hip_atomic_fetch_add(h0 + (k0_ >> 9), 1u << ((k0_ >> 4) & 16u), __ATOMIC_RELAXED, __HIP_MEMORY_SCOPE_WORKGROUP); \
            if (k1_) __hip_atomic_fetch_add(h0 + 128 + (k1_ >> 9), 1u << ((k1_ >> 4) & 16u), __ATOMIC_RELAXED, __HIP_MEMORY_SCOPE_WORKGROUP); } while (0)
#ifndef TK_REP_SCORE
#define TK_REP_SCORE 1
#endif
#ifndef TK_REP_SEL
#define TK_REP_SEL 1
#endif
#pragma unroll 1
        for (int rp_ = 0; rp_ < TK_REP_SCORE; ++rp_) {
            bf16x8_t B[4][4]; f32x16_t accA, accB;
            const int nmy = ntp >> 1;
#pragma unroll
            for (int u = 0; u < 4; ++u) TK_LOAD(B[u], par + 2 * u);
            TK_MMA(accA, B[0]);
#pragma unroll 1
            for (int i = 0; i < nmy; i += 4) {
                const int kt = par + 2 * i;
                TK_MMA(accB, B[1]); TK_POST(accA, kt);     TK_LOAD(B[0], kt + 8);
                TK_MMA(accA, B[2]); TK_POST(accB, kt + 2); TK_LOAD(B[1], kt + 10);
                TK_MMA(accB, B[3]); TK_POST(accA, kt + 4); TK_LOAD(B[2], kt + 12);
                TK_MMA(accA, B[0]); TK_POST(accB, kt + 6); TK_LOAD(B[3], kt + 14);
            }
        }
#undef TK_LOAD
#undef TK_MMA
#undef TK_POST
        if (32 * ntp < 512 * nch) {
#pragma unroll
            for (int qi = 0; qi < 2; ++qi) { LAS v2u* z = (LAS v2u*)(kb + (2 * wave + qi) * 4096 + 32 * ntp) + lane; *z = (v2u){0u, 0u}; }
        }
        __syncthreads();
#pragma unroll 1
        for (int qi = 0; qi < 2 * TK_REP_SEL; ++qi) {
            const int ql = 2 * wave + (qi & 1);
            const LAS unsigned short* rb = kb + ql * 4096 + lane;
            const v2u hw = *(const LAS v2u*)(H1 + ql * 128 + 2 * lane); const v4u hv = {hw.x & 0xffffu, hw.x >> 16, hw.y & 0xffffu, hw.y >> 16};
            if ((qi >> 1) + 1 == TK_REP_SEL) *(LAS v2u*)(H1 + ql * 128 + 2 * lane) = (v2u){0u, 0u};
            const int hs = (int)(hv.x + hv.y + hv.z + hv.w); int S = hs;
#pragma unroll
            for (int off = 1; off < 64; off <<= 1) { const int v = __shfl_down(S, off); if (lane + off < 64) S += v; }
            int ab = S - hs; const bool cross = ab < TOPK && S >= TOPK;
            int Bl = 4 * lane + 3;
            if (ab + (int)hv.w < TOPK) { ab += (int)hv.w; Bl = 4 * lane + 2; if (ab + (int)hv.z < TOPK) { ab += (int)hv.z; Bl = 4 * lane + 1; if (ab + (int)hv.y < TOPK) { ab += (int)hv.y; Bl = 4 * lane; } } }
            const unsigned long long mc = __ballot(cross);
            const int src = mc ? (__ffsll((long long)mc) - 1) : 0;
            const unsigned Bb = (unsigned)__shfl(Bl, src);
            int pos = 0, m = 0;
#pragma unroll 1
            for (int j = 0; j < nch; ++j) {
                unsigned kk[8];
#pragma unroll
                for (int s = 0; s < 8; ++s) kk[s] = rb[512 * j + 64 * s];
#pragma unroll
                for (int s = 0; s < 8; ++s) {
                    const unsigned hb = kk[s] >> 8; const bool gt = hb > Bb, eq = hb == Bb;
                    const unsigned long long mg = __ballot(gt), me = __ballot(eq);
                    const unsigned e = (unsigned)(512 * j + 64 * s + lane);
                    if (gt) ol[pos + mbcnt64(mg)] = (unsigned short)e;
                    if (eq) { const int ci = m + mbcnt64(me); if (ci < TK_CAND) cl[ci] = ((kk[s] & 0xffu) << 16) | e; }
                    pos += __popcll(mg); m += __popcll(me);
                }
            }
            asm volatile("s_waitcnt lgkmcnt(0)" ::: "memory");
            if (mc != 0ull && m <= TK_CAND && pos < TOPK && pos + m >= TOPK) {
                const int need2 = TOPK - pos;
                unsigned ent[8]; bool val[8];
#pragma unroll
                for (int q = 0; q < 8; ++q) { val[q] = 64 * q + lane < m; ent[q] = val[q] ? cl[64 * q + lane] : 0u; }
                unsigned thr2 = 0u;
#pragma unroll 1
                for (int bit = 7; bit >= 0; --bit) {
                    const unsigned cand = thr2 | (1u << bit); int cnt = 0;
#pragma unroll
                    for (int q = 0; q < 8; ++q) cnt += __popcll(__ballot(val[q] && (ent[q] >> 16) >= cand));
                    if (cnt >= need2) thr2 = cand;
                }
                int cgt2 = 0;
#pragma unroll
                for (int q = 0; q < 8; ++q) cgt2 += __popcll(__ballot(val[q] && (ent[q] >> 16) > thr2));
                const int need3 = need2 - cgt2; int ties = 0;
#pragma unroll
                for (int q = 0; q < 8; ++q) {
                    const unsigned lb = ent[q] >> 16; const bool gt = val[q] && lb > thr2, eq = val[q] && lb == thr2;
                    const unsigned long long meq = __ballot(eq);
                    const bool sel = gt || (eq && (ties + mbcnt64(meq) < need3));
                    const unsigned long long msel = __ballot(sel);
                    if (sel) ol[pos + mbcnt64(msel)] = (unsigned short)(ent[q] & 0xffffu);
                    pos += __popcll(msel); ties += __popcll(meq);
                }
            } else {
                unsigned thr = 0u;
#pragma unroll 1
                for (int bit = 15; bit >= 0; --bit) {
                    const unsigned cand = thr | (1u << bit); int cnt = 0;
#pragma unroll 1
                    for (int i = 0; i < 8 * nch; ++i) cnt += __popcll(__ballot((unsigned)rb[64 * i] >= cand));
                    if (cnt >= TOPK) thr = cand;
                }
                int cgt = 0;
#pragma unroll 1
                for (int i = 0; i < 8 * nch; ++i) cgt += __popcll(__ballot((unsigned)rb[64 * i] > thr));
                const int need = TOPK - cgt; int ties = 0; pos = 0;
#pragma unroll 1
                for (int i = 0; i < 8 * nch; ++i) {
                    const unsigned kx = rb[64 * i]; const bool gt = kx > thr, eq = kx == thr;
                    const unsigned long long meq = __ballot(eq);
                    const bool sel = gt || (eq && (ties + mbcnt64(meq) < need));
                    const unsigned long long msel = __ballot(sel);
                    if (sel) ol[pos + mbcnt64(msel)] = (unsigned short)(64 * i + lane);
                    pos += __popcll(msel); ties += __popcll(meq);
                }
            }
            asm volatile("s_waitcnt lgkmcnt(0)" ::: "memory");
            *((v2u*)(SEL + (size_t)(R0 + ql) * TOPK) + lane) = *(const LAS v2u*)(ol + 4 * lane);
            asm volatile("s_waitcnt lgkmcnt(0)" ::: "memory");
        }
    }
    __syncthreads();
}

typedef short s16x4_t __attribute__((ext_vector_type(4)));
__device__ __forceinline__ s16x4_t tr_read(unsigned addr) { s16x4_t r_; asm volatile("ds_read_b64_tr_b16 %0, %1" : "=v"(r_) : "v"(addr) : "memory"); return r_; }

__device__ __forceinline__ void phase_dsa_fast(const Params& p, LAS unsigned char* lds, int G) {
    const int tid = threadIdx.x, lane = tid & 63, wave = __builtin_amdgcn_readfirstlane(tid >> 6);
    const int c16 = lane & 15, kq = lane >> 4;
    unsigned char* ws = p.ws;
    const bf16* AQ = (const bf16*)(ws + WS_AQ); const bf16* AK = (const bf16*)(ws + WS_AK); const bf16* AV = (const bf16*)(ws + WS_AV); bf16* OA = (bf16*)(ws + WS_OA);
    const unsigned short* SEL = (const unsigned short*)(ws + WS_SEL);
    LAS unsigned char* wl = lds + wave * 13312;
    LAS unsigned short* sidx = (LAS unsigned short*)wl; LAS unsigned short* Pl = (LAS unsigned short*)(wl + 512); LAS unsigned char* Vl = wl + 2560;
    const unsigned vl_addr = (unsigned)(size_t)Vl;
    const bool arow = (c16 & 3) == 0; const int ahead = c16 >> 2;
    const int nper = (G >= 8 && (G & 7) == 0) ? (G >> 3) * NWAVES : 0;
    for (int it = 0;; ++it) {
        int row;
        if (nper) { const int wi = (blockIdx.x >> 3) * NWAVES + wave, t = wi + it * nper; if (t >= SEQ) break; row = (blockIdx.x & 7) * SEQ + t; }
        else { row = blockIdx.x * NWAVES + wave + it * G * NWAVES; if (row >= TOK) break; }
        const int b = row >> 12, t = row & 4095; const int cnt = (t + 1 < TOPK) ? t + 1 : TOPK;
        { const v2u sv = *((const v2u*)(SEL + (size_t)row * TOPK) + lane);
            const int s0 = 4 * lane; v2u o;
            o.x = ((s0 < cnt) ? (sv.x & 0xffffu) : 0u) | (((s0 + 1 < cnt) ? (sv.x >> 16) : 0u) << 16); o.y = ((s0 + 2 < cnt) ? (sv.y & 0xffffu) : 0u) | (((s0 + 3 < cnt) ? (sv.y >> 16) : 0u) << 16);
            *(LAS v2u*)(sidx + 4 * lane) = o; }
        asm volatile("s_waitcnt lgkmcnt(0)" ::: "memory");
        const bf16* Kb = AK + (size_t)b * SEQ * 128; const bf16* Vb = AV + (size_t)b * SEQ * 128;
#pragma unroll 1
        for (int g = 0; g < 2; ++g) {
            bf16x8_t aq[2];
#pragma unroll
            for (int c = 0; c < 2; ++c) { aq[c] = (bf16x8_t){0, 0, 0, 0, 0, 0, 0, 0}; if (arow) aq[c] = *(const bf16x8_t*)(AQ + (size_t)row * 512 + (4 * g + ahead) * 64 + 32 * c + 8 * kq); }
            float sc[16];
            const bf16* Kg = Kb + g * 64 + 8 * kq;
#pragma unroll
            for (int q4 = 0; q4 < 4; ++q4) {
                bf16x8_t kf[4][2];
#pragma unroll
                for (int u = 0; u < 4; ++u) { const int key = sidx[16 * (4 * q4 + u) + c16]; const bf16* kp = Kg + (size_t)key * 128; kf[u][0] = *(const bf16x8_t*)kp; kf[u][1] = *(const bf16x8_t*)(kp + 32); }
#pragma unroll
                for (int u = 0; u < 4; ++u) { f32x4_t a = {0.f, 0.f, 0.f, 0.f};
                    a = __builtin_amdgcn_mfma_f32_16x16x32_bf16(aq[0], kf[u][0], a, 0, 0, 0); a = __builtin_amdgcn_mfma_f32_16x16x32_bf16(aq[1], kf[u][1], a, 0, 0, 0);
                    sc[4 * q4 + u] = (16 * (4 * q4 + u) + c16 < cnt) ? a[0] : -INFINITY; }
            }
            float mx = sc[0];
#pragma unroll
            for (int i = 1; i < 16; ++i) mx = fmaxf(mx, sc[i]);
            mx = fmaxf(mx, __shfl_xor(mx, 1)); mx = fmaxf(mx, __shfl_xor(mx, 2)); mx = fmaxf(mx, __shfl_xor(mx, 4)); mx = fmaxf(mx, __shfl_xor(mx, 8));
            float sum = 0.f;
#pragma unroll
            for (int i = 0; i < 16; ++i) { sc[i] = fexp2(sc[i] - mx); sum += sc[i]; }
            sum += __shfl_xor(sum, 1); sum += __shfl_xor(sum, 2); sum += __shfl_xor(sum, 4); sum += __shfl_xor(sum, 8);
            const float inv = 1.0f / sum;
#pragma unroll
            for (int i = 0; i < 16; ++i) Pl[kq * 256 + 16 * i + c16] = (unsigned short)f2bf(sc[i]);
            asm volatile("s_waitcnt lgkmcnt(0)" ::: "memory");
            f32x4_t o[4];
#pragma unroll
            for (int dt = 0; dt < 4; ++dt) o[dt] = (f32x4_t){0.f, 0.f, 0.f, 0.f};
            const bf16* Vg = Vb + g * 64 + 8 * (lane & 7);
#pragma unroll 1
            for (int ch = 0; ch < 4; ++ch) {
                v4u vr[8];
#pragma unroll
                for (int i = 0; i < 8; ++i) { const int key = sidx[64 * ch + 8 * i + (lane >> 3)]; vr[i] = *(const v4u*)(Vg + (size_t)key * 128); }
#pragma unroll
                for (int i = 0; i < 8; ++i) *(LAS v4u*)(Vl + (8 * i + (lane >> 3)) * 160 + 16 * (lane & 7)) = vr[i];
                asm volatile("s_waitcnt lgkmcnt(0)" ::: "memory");
#pragma unroll
                for (int hf = 0; hf < 2; ++hf) {
                    bf16x8_t pa = (bf16x8_t){0, 0, 0, 0, 0, 0, 0, 0};
                    if (arow) { const s16x4_t lo = *(const LAS s16x4_t*)(Pl + ahead * 256 + 64 * ch + 32 * hf + 4 * kq), hi = *(const LAS s16x4_t*)(Pl + ahead * 256 + 64 * ch + 32 * hf + 16 + 4 * kq);
                        pa = (bf16x8_t){lo[0], lo[1], lo[2], lo[3], hi[0], hi[1], hi[2], hi[3]}; }
                    const unsigned va = vl_addr + (unsigned)((32 * hf + 4 * kq + (c16 >> 2)) * 160 + 8 * (c16 & 3));
                    s16x4_t vlo[4], vhi[4];
#pragma unroll
                    for (int dt = 0; dt < 4; ++dt) { vlo[dt] = tr_read(va + 32 * dt); vhi[dt] = tr_read(va + 16 * 160 + 32 * dt); }
                    asm volatile("s_waitcnt lgkmcnt(0)" : "+v"(vlo[0]), "+v"(vlo[1]), "+v"(vlo[2]), "+v"(vlo[3]), "+v"(vhi[0]), "+v"(vhi[1]), "+v"(vhi[2]), "+v"(vhi[3]) :: "memory");
                    __builtin_amdgcn_sched_barrier(0);
#pragma unroll
                    for (int dt = 0; dt < 4; ++dt) { const bf16x8_t vb = (bf16x8_t){vlo[dt][0], vlo[dt][1], vlo[dt][2], vlo[dt][3], vhi[dt][0], vhi[dt][1], vhi[dt][2], vhi[dt][3]};
                        o[dt] = __builtin_amdgcn_mfma_f32_16x16x32_bf16(pa, vb, o[dt], 0, 0, 0); }
                }
                asm volatile("s_waitcnt lgkmcnt(0)" ::: "memory");
            }
            bf16* op = OA + (size_t)row * 512 + (4 * g + kq) * 64 + c16;
#pragma unroll
            for (int dt = 0; dt < 4; ++dt) op[16 * dt] = (bf16)f2bf(o[dt][0] * inv);
        }
    }
}

typedef float f32x2_t __attribute__((ext_vector_type(2))); typedef __bf16 bf16x2v_t __attribute__((ext_vector_type(2)));
__device__ __forceinline__ unsigned cvtpk_s(float lo, float hi) { f32x2_t v = {lo, hi}; bf16x2v_t b = __builtin_convertvector(v, bf16x2v_t); return __builtin_bit_cast(unsigned, b); }
__device__ __forceinline__ int crow16(int reg, int h) { return (reg & 3) + 8 * (reg >> 2) + 4 * h; }

__device__ __forceinline__ void phase_swa_fast(const Params& p, int G) {
    const int tid = threadIdx.x, lane = tid & 63, wave = __builtin_amdgcn_readfirstlane(tid >> 6);
    const int r = lane & 31, h = lane >> 5, hh = wave >> 1, qh = wave & 1;
    unsigned char* ws = p.ws;
    const bf16* BQ = (const bf16*)(ws + WS_BQ); const bf16* BK = (const bf16*)(ws + WS_BK); const bf16* BV = (const bf16*)(ws + WS_BV); bf16* OB = (bf16*)(ws + WS_OB);
    for (int k = 0;; ++k) {
        int b, idx;
        if (G >= 8 && (G & 7) == 0) { idx = (blockIdx.x >> 3) + (G >> 3) * k; if (idx >= 64) break; b = blockIdx.x & 7; }
        else { const int u = blockIdx.x + k * G; if (u >= 512) break; b = u >> 6; idx = u & 63; }
        const int qb = idx >> 1, g = idx & 1, head = 4 * g + hh;
        const float sink = p.sinks[head] * LOG2E;
        const bf16* Kb = BK + (size_t)b * SEQ * 128 + g * 64 + 8 * h; const bf16* Vb = BV + (size_t)b * SEQ * 128 + g * 64 + r;
#pragma unroll 1
        for (int qt = 0; qt < 2; ++qt) {
            const int q0 = 128 * qb + 64 * qh + 32 * qt;
            const size_t qrow = (size_t)b * SEQ + q0 + r;
            bf16x8_t qf[4];
#pragma unroll
            for (int s = 0; s < 4; ++s) qf[s] = *(const bf16x8_t*)(BQ + qrow * 512 + head * 64 + 16 * s + 8 * h);
            f32x16_t S[5];
#pragma unroll
            for (int kt = 0; kt < 5; ++kt) {
                const int kb0 = q0 - 128 + 32 * kt; const int krow_ = kb0 + r; const int kc = krow_ < 0 ? 0 : krow_;
                bf16x8_t kf[4];
#pragma unroll
                for (int s = 0; s < 4; ++s) kf[s] = *(const bf16x8_t*)(Kb + (size_t)kc * 128 + 16 * s);
                f32x16_t a = {0.f, 0.f, 0.f, 0.f, 0.f, 0.f, 0.f, 0.f, 0.f, 0.f, 0.f, 0.f, 0.f, 0.f, 0.f, 0.f};
#pragma unroll
                for (int s = 0; s < 4; ++s) a = __builtin_amdgcn_mfma_f32_32x32x16_bf16(kf[s], qf[s], a, 0, 0, 0);
#pragma unroll
                for (int i = 0; i < 16; ++i) { const int key = kb0 + crow16(i, h); const int rel = q0 + r - key; S[kt][i] = (key >= 0 && rel >= 0 && rel < WIN) ? a[i] : -INFINITY; }
            }
            float mx = sink;
#pragma unroll
            for (int kt = 0; kt < 5; ++kt)
#pragma unroll
                for (int i = 0; i < 16; ++i) mx = fmaxf(mx, S[kt][i]);
            mx = fmaxf(mx, __shfl_xor(mx, 32));
            float l = 0.f;
#pragma unroll
            for (int kt = 0; kt < 5; ++kt)
#pragma unroll
                for (int i = 0; i < 16; ++i) { S[kt][i] = fexp2(S[kt][i] - mx); l += S[kt][i]; }
            l += __shfl_xor(l, 32); l += fexp2(sink - mx);
            const float linv = 1.0f / l;
            f32x16_t O0 = {0.f, 0.f, 0.f, 0.f, 0.f, 0.f, 0.f, 0.f, 0.f, 0.f, 0.f, 0.f, 0.f, 0.f, 0.f, 0.f}, O1 = O0;
#pragma unroll
            for (int kt = 0; kt < 5; ++kt) {
                const int kb0 = q0 - 128 + 32 * kt;
#pragma unroll
                for (int s = 0; s < 2; ++s) {
                    v4u pw; pw.x = cvtpk_s(S[kt][8 * s + 0], S[kt][8 * s + 1]); pw.y = cvtpk_s(S[kt][8 * s + 2], S[kt][8 * s + 3]); pw.z = cvtpk_s(S[kt][8 * s + 4], S[kt][8 * s + 5]); pw.w = cvtpk_s(S[kt][8 * s + 6], S[kt][8 * s + 7]);
                    const bf16x8_t pa = __builtin_bit_cast(bf16x8_t, pw);
                    unsigned short v0[8], v1[8];
#pragma unroll
                    for (int j = 0; j < 8; ++j) { int key = kb0 + 16 * s + 8 * (j >> 2) + 4 * h + (j & 3); key = key < 0 ? 0 : key; v0[j] = Vb[(size_t)key * 128]; v1[j] = Vb[(size_t)key * 128 + 32]; }
                    const bf16x8_t vb0 = (bf16x8_t){(short)v0[0], (short)v0[1], (short)v0[2], (short)v0[3], (short)v0[4], (short)v0[5], (short)v0[6], (short)v0[7]};
                    const bf16x8_t vb1 = (bf16x8_t){(short)v1[0], (short)v1[1], (short)v1[2], (short)v1[3], (short)v1[4], (short)v1[5], (short)v1[6], (short)v1[7]};
                    O0 = __builtin_amdgcn_mfma_f32_32x32x16_bf16(pa, vb0, O0, 0, 0, 0); O1 = __builtin_amdgcn_mfma_f32_32x32x16_bf16(pa, vb1, O1, 0, 0, 0);
                }
            }
            bf16* op = OB + ((size_t)b * SEQ + q0) * 512 + head * 64 + r;
#pragma unroll
            for (int i = 0; i < 16; ++i) { const int qq = crow16(i, h); const float li = __shfl(linv, qq); op[(size_t)qq * 512] = (bf16)f2bf(O0[i] * li); op[(size_t)qq * 512 + 32] = (bf16)f2bf(O1[i] * li); }
        }
    }
}

constexpr int NPHASE = 9;
__global__ void __launch_bounds__(NTHREADS, 2) mk_fwd(Params p) {
    extern __shared__ __attribute__((aligned(16))) unsigned char lds_raw[];
    LAS unsigned char* lds = (LAS unsigned char*)lds_raw;
    const int G = gridDim.x;
    unsigned char* ws = p.ws;
#if MK_ONE_LAUNCH
#define SEAM(k) do { if (rep_ + 1 < REPS(k)) __syncthreads(); else if (lo <= (k) && (k) + 1 < hi) cg::this_grid().sync(); } while (0)
#else
#define SEAM(k) do { if (rep_ + 1 < REPS(k)) __syncthreads(); } while (0)
#endif
    const int lo = p.ph_lo, hi = p.ph_hi;
#ifndef PHMASK
#define PHMASK 0x1ffu
#endif
#define IN(k) (((PHMASK >> (k)) & 1u) && lo <= (k) && (k) < hi)
#define REPS(k) (((REP_MASK >> (k)) & 1u) ? 2 : 1)
#define PHASE(k) if (IN(k)) for (int rep_ = 0; rep_ < REPS(k); ++rep_)
    PHASE(0) { phase_prologue(p, lds, G); SEAM(0); }
    PHASE(1) {
        pg8::Gemm g{(const bf16*)(ws + WS_XG), (const bf16*)(ws + WS_WIN), TOK, NIN, DM, nullptr, 1 << 30};
        pg8::StaticOrder S; S.init(TOK, NIN, G, (int)blockIdx.x);
        pg8::EpiInProj E{(const float*)(ws + WS_RSTD1), (const float*)(ws + WS_COS), (const float*)(ws + WS_SIN), ws, p.ikw, p.ikb};
        pg8::gemm_phase<pg8::EpiInProj, pg8::StaticOrder, true, true>(lds, g, S, E);
        SEAM(1);
    }
#if MK_SIMPLE_TOPK
    PHASE(2) { phase_topk_simple(p, lds, G); SEAM(2); }
#else
    PHASE(2) { phase_topk_fast(p, lds, G); SEAM(2); }
#endif
#if MK_SIMPLE_DSA
    PHASE(3) { phase_attn_simple<true, true>(p, lds, G); SEAM(3); }
#else
#if MK_SIMPLE_SWA
    PHASE(3) { phase_dsa_fast(p, lds, G); __syncthreads(); phase_attn_simple<false, true>(p, lds, G); SEAM(3); }
#else
    PHASE(3) { phase_swa_fast(p, G); phase_dsa_fast(p, lds, G); SEAM(3); }
#endif
#endif
    PHASE(4) {
        pg8::Gemm g{(const bf16*)(ws + WS_OA), (const bf16*)(ws + WS_WAB), TOK, 2048, 512, (const bf16*)(ws + WS_OB), 4};
        pg8::BranchOrder S{G, (int)blockIdx.x};
        pg8::EpiGate E{(const bf16*)(ws + WS_GA), (const bf16*)(ws + WS_GB), p.out, (bf16*)(ws + WS_MIX)};
        pg8::gemm_phase<pg8::EpiGate, pg8::BranchOrder, true, true>(lds, g, S, E);
        SEAM(4);
    }
    PHASE(5) {
        pg8::Gemm g{(const bf16*)(ws + WS_MIX), (const bf16*)(ws + WS_WOUT), TOK, DM, DM, nullptr, 1 << 30};
        pg8::StaticOrder S; S.init(TOK, DM, G, (int)blockIdx.x);
        pg8::EpiResid<true> E{p.x, p.out, (bf16*)(ws + WS_XG), p.mlp_norm_w, (float*)(ws + WS_SS2)};
        pg8::gemm_phase<pg8::EpiResid<true>, pg8::StaticOrder, true, true>(lds, g, S, E);
        SEAM(5);
    }
    PHASE(6) {
        pg8::Gemm g{(const bf16*)(ws + WS_XG), (const bf16*)(ws + WS_WUP), TOK, DFF, DM, nullptr, 1 << 30};
        pg8::StaticOrder S; S.init(TOK, DFF, G, (int)blockIdx.x);
        pg8::EpiUp E{(const float*)(ws + WS_SS2), (bf16*)(ws + WS_HID)};
        pg8::gemm_phase<pg8::EpiUp, pg8::StaticOrder, true, true>(lds, g, S, E);
        SEAM(6);
    }
    PHASE(7) {
        pg8::Gemm g{(const bf16*)(ws + WS_HID), (const bf16*)(ws + WS_WDN), TOK, DM, DFF, nullptr, 1 << 30};
        pg8::StaticOrder S; S.init(TOK, DM, G, (int)blockIdx.x);
        pg8::EpiResid<false> E{p.out, p.out, nullptr, nullptr, (float*)(ws + WS_SS3)};
        pg8::gemm_phase<pg8::EpiResid<false>, pg8::StaticOrder, true, true>(lds, g, S, E);
        SEAM(7);
    }
    PHASE(8) { phase_final(p, G); }
#undef PHASE
#undef REPS
#undef IN
#undef SEAM
}

extern "C" void kernel_launch(void* const* d_in, const int* in_sizes, int n_in, void* d_out, int out_size, void* d_ws, size_t ws_size, hipStream_t stream) {
    static int grid = 0;
    if (grid == 0) {
        if (n_in != 13 || in_sizes[0] != TOK * DM || out_size != TOK * DM || ws_size < WS_NEED) {
            fprintf(stderr, "kernel_launch: unexpected shapes (n_in %d, in0 %d, out %d, ws %zu); nothing launched\n", n_in, n_in > 0 ? in_sizes[0] : -1, out_size, ws_size); grid = -1; return; }
        int dev = 0, cus = 0, per_cu = 0;
        (void)hipGetDevice(&dev); (void)hipDeviceGetAttribute(&cus, hipDeviceAttributeMultiprocessorCount, dev);
        if (hipFuncSetAttribute((const void*)mk_fwd, hipFuncAttributeMaxDynamicSharedMemorySize, LDS_BYTES) != hipSuccess) { fprintf(stderr, "kernel_launch: hipFuncSetAttribute failed\n"); grid = -1; return; }
        if (hipOccupancyMaxActiveBlocksPerMultiprocessor(&per_cu, (const void*)mk_fwd, NTHREADS, LDS_BYTES) != hipSuccess || per_cu < 1) { fprintf(stderr, "kernel_launch: occupancy query says %d blocks per CU\n", per_cu); per_cu = 1; }
        (void)hipGetLastError();
        if (per_cu > 1) per_cu = 1;
        grid = cus * per_cu;
    }
    if (grid < 0) return;
    Params p{};
    p.x = (const float*)d_in[0]; p.attn_norm_w = (const float*)d_in[1]; p.w_in = (const float*)d_in[2]; p.ikw = (const float*)d_in[3]; p.ikb = (const float*)d_in[4];
    p.sinks = (const float*)d_in[5]; p.w_a = (const float*)d_in[6]; p.w_b = (const float*)d_in[7]; p.w_out = (const float*)d_in[8]; p.mlp_norm_w = (const float*)d_in[9];
    p.w_up = (const float*)d_in[10]; p.w_down = (const float*)d_in[11]; p.final_w = (const float*)d_in[12];
    p.out = (float*)d_out; p.ws = (unsigned char*)d_ws;
    for (int i = 0; i < 32; ++i) p.inv_freq[i] = 1.0f / powf(10000.0f, (float)(2 * i) / 64.0f);
#if MK_ONE_LAUNCH
    p.ph_lo = 0; p.ph_hi = NPHASE;
    void* args[] = {&p};
    hipError_t e = hipLaunchCooperativeKernel((const void*)mk_fwd, dim3(grid), dim3(NTHREADS), args, LDS_BYTES, stream);
    if (e != hipSuccess) fprintf(stderr, "kernel_launch: cooperative launch failed: %s (grid %d)\n", hipGetErrorString(e), grid);
#else
    for (int ph = 0; ph < NPHASE; ++ph) {
        p.ph_lo = ph; p.ph_hi = ph + 1;
        hipLaunchKernelGGL(mk_fwd, dim3(grid), dim3(NTHREADS), LDS_BYTES, stream, p);
    }
#endif
}
```

```cpp
#include <hip/hip_runtime.h>
#include <hip/hip_cooperative_groups.h>
#include <cstdio>
#include <cstdint>
namespace cg = cooperative_groups;

#ifndef MK_ONE_LAUNCH
#define MK_ONE_LAUNCH 1
#endif
#ifndef MK_SIMPLE_TOPK
#define MK_SIMPLE_TOPK 0
#endif
#ifndef MK_SIMPLE_SWA
#define MK_SIMPLE_SWA 0
#endif
#ifndef MK_SIMPLE_DSA
#define MK_SIMPLE_DSA 0
#endif

constexpr int NBATCH = 8, SEQ = 4096, DM = 1024, TOK = NBATCH * SEQ, DFF = 4096, TOPK = 256, WIN = 128;
constexpr int NIN = 4352;
constexpr float RMS_EPS = 1e-6f, LN_EPS = 1e-6f;
constexpr float QSCALE = 0.125f * 1.4426950408889634f;
constexpr float LOG2E = 1.4426950408889634f;
constexpr float W_SCALE = 0.04419417382415922f;
constexpr int C_AQ = 0, C_AK = 512, C_AV = 640, C_IQ = 768, C_IK = 1280, C_IW = 1344, C_BQ = 1352, C_BK = 1864, C_BV = 1992, C_GA = 2120, C_GB = 3144, D_IN = 4168;

constexpr size_t MiB = 1u << 20;
constexpr size_t WS_RSTD1 = 0, WS_SS2 = 128 * 1024, WS_SS3 = 256 * 1024;
constexpr size_t WS_BAR = 512 * 1024;
constexpr int XB_LDS_OFF = 163832;
constexpr size_t WS_COS = 1 * MiB, WS_SIN = 1 * MiB + 512 * 1024;
constexpr size_t WS_WIN = 2 * MiB, WS_WAB = 11 * MiB, WS_WOUT = 13 * MiB, WS_WUP = 15 * MiB, WS_WDN = 23 * MiB;
constexpr size_t WS_XG = 32 * MiB;
constexpr size_t WS_AQ = 96 * MiB, WS_IQ = 128 * MiB, WS_BQ = 160 * MiB, WS_AK = 192 * MiB, WS_AV = 200 * MiB, WS_BK = 208 * MiB, WS_BV = 216 * MiB;
constexpr size_t WS_IK = 224 * MiB, WS_IW = 228 * MiB, WS_SEL = 230 * MiB, WS_GA = 248 * MiB, WS_GB = 312 * MiB, WS_MIX = 376 * MiB, WS_END = 440 * MiB;
#ifndef MK_SEPARATE_O
#define MK_SEPARATE_O 0
#endif
#ifndef REP_MASK
#define REP_MASK 0u
#endif
constexpr size_t WS_OA = MK_SEPARATE_O ? 440 * MiB : WS_AQ, WS_OB = MK_SEPARATE_O ? 472 * MiB : WS_BQ, WS_NEED = MK_SEPARATE_O ? 504 * MiB : WS_END;
constexpr size_t WS_HID = 96 * MiB;
static_assert(WS_WIN + (size_t)NIN * DM * 2 <= WS_WAB && WS_HID + (size_t)TOK * DFF * 2 <= WS_MIX, "ws map");

constexpr int LDS_RING = 131072, LDS_BYTES = 163840;

#define GAS __attribute__((address_space(1)))
#define LAS __attribute__((address_space(3)))
typedef unsigned short bf16;
typedef unsigned v4u __attribute__((ext_vector_type(4)));
typedef unsigned v2u __attribute__((ext_vector_type(2)));
typedef float v4f __attribute__((ext_vector_type(4)));

__device__ __forceinline__ float bf2f(unsigned short u) { return __uint_as_float((unsigned)u << 16); }
__device__ __forceinline__ float bflo(unsigned u) { return __uint_as_float(u << 16); }
__device__ __forceinline__ float bfhi(unsigned u) { return __uint_as_float(u & 0xffff0000u); }
__device__ __forceinline__ unsigned f2bf(float f) { unsigned u = __float_as_uint(f); return (u + 0x7fffu + ((u >> 16) & 1u)) >> 16; }
__device__ __forceinline__ unsigned pk2(float lo, float hi) { unsigned r; asm volatile("v_cvt_pk_bf16_f32 %0, %1, %2" : "=v"(r) : "v"(lo), "v"(hi)); return r; }
__device__ __forceinline__ float fexp2(float x) { return __builtin_amdgcn_exp2f(x); }
__device__ __forceinline__ float frsq(float x) { return __builtin_amdgcn_rsqf(x); }
__device__ __forceinline__ float frcp(float x) { return __builtin_amdgcn_rcpf(x); }
__device__ __forceinline__ float sigmoidf_(float x) { return frcp(1.0f + fexp2(-x * LOG2E)); }
__device__ __forceinline__ float wave_sum(float v) {
#pragma unroll
    for (int o = 1; o < 64; o <<= 1) v += __shfl_xor(v, o);
    return v;
}
__device__ __forceinline__ float wave_max(float v) {
#pragma unroll
    for (int o = 1; o < 64; o <<= 1) v = fmaxf(v, __shfl_xor(v, o));
    return v;
}
__device__ __forceinline__ int lane_id() { unsigned m = ~0u; asm volatile("" : "+s"(m)); return __builtin_amdgcn_mbcnt_hi(m, __builtin_amdgcn_mbcnt_lo(m, 0u)); }
__device__ __forceinline__ int tid_op(int wv) { return wv * 64 + lane_id(); }
__device__ __forceinline__ int mbcnt64(unsigned long long m) { return __builtin_amdgcn_mbcnt_hi((unsigned)(m >> 32), __builtin_amdgcn_mbcnt_lo((unsigned)m, 0u)); }

namespace pg8 {
#define PG8_LAS __attribute__((address_space(3)))
typedef unsigned short bf16_t;
typedef short bf16x8 __attribute__((ext_vector_type(8)));
typedef float f32x4 __attribute__((ext_vector_type(4)));
typedef unsigned u32x4 __attribute__((ext_vector_type(4)));
constexpr int BM = 256, BK = 64, HALF = 128, HTB = HALF * BK * 2  , STAGE_BYTES = 8 * HTB, NXCD = 8, WGM = 8;

__host__ __device__ __forceinline__ int lds_byte(int r, int c) { const int st = (r >> 4) * 2 + (c >> 5), rr = r & 15, cc = c & 31, ob = rr * 64 + cc * 2; return st * 1024 + (ob ^ (((ob >> 9) & 1) << 5)); }
__host__ __device__ __forceinline__ void stage_rc(int b, int& R, int& C) { const int st = b / 1024, sb = b % 1024, swz = sb ^ (((sb >> 9) & 1) << 5); R = (st >> 1) * 16 + swz / 64; C = (st & 1) * 32 + (swz % 64) / 2; }
__host__ __device__ __forceinline__ int perm32(int rho) { const int n = rho >> 4, i = rho & 15; return 8 * (i >> 2) + 4 * n + (i & 3); }

struct Unit { int pm, pn; };
struct Gemm { const bf16_t* A; const bf16_t* Bt; int M, N, K; const bf16_t* A2; int asplit;
    __device__ __forceinline__ const char* abase(const Unit& u) const { return (const char*)(u.pn >= asplit ? A2 : A); } };

struct StaticOrder {
    int nM, nN, nwg, G, c;
    __host__ __device__ void init(int M, int N, int G_, int c_) { nM = M / BM; nN = N / BM; nwg = nM * nN; G = G_; c = c_; }
    __host__ __device__ bool next(int i, Unit& u) const {
        const long L = (long)i * G + c; if (L >= nwg) return false;
        int wgid = (int)L; { const int q = nwg / NXCD, r = nwg % NXCD, xcd = wgid % NXCD, off = wgid / NXCD; wgid = (xcd < r ? xcd * (q + 1) : r * (q + 1) + (xcd - r) * q) + off; }
        const int nig = WGM * nN, gid = wgid / nig, fm = gid * WGM, gsz = (nM - fm) < WGM ? (nM - fm) : WGM;
        u.pm = fm + ((wgid % nig) % gsz); u.pn = (wgid % nig) / gsz; return true;
    }
    __device__ __forceinline__ void a_ready(const Unit&) const {}
    __device__ __forceinline__ void done(const Unit&) const {}
};

__device__ __forceinline__ unsigned cvt_pk_bf16(float lo, float hi) { unsigned r; asm volatile("v_cvt_pk_bf16_f32 %0, %1, %2" : "=v"(r) : "v"(lo), "v"(hi)); return r; }
__device__ __forceinline__ u32x4 pack8(const float (&v)[8]) { u32x4 w; w.x = cvt_pk_bf16(v[0], v[1]); w.y = cvt_pk_bf16(v[2], v[3]); w.z = cvt_pk_bf16(v[4], v[5]); w.w = cvt_pk_bf16(v[6], v[7]); return w; }

struct EpiInProj {
    static constexpr bool PERM = true, AFTER_DRAIN = false;
    const float* rstd1; const float* cs; const float* sn; unsigned char* ws; const float* ikw; const float* ikb;
    __device__ __forceinline__ void operator()(const f32x4 (&acc)[2][2][4][2], const Unit& u, int wr, int wc, int fr_, int fq_) const {
        const int pn = u.pn; int fr = fr_, fq = fq_;
        asm volatile("" : "+v"(fr), "+v"(fq));
#pragma unroll
        for (int ai = 0; ai < 2; ++ai)
#pragma unroll
            for (int m = 0; m < 4; ++m) {
                const int row = u.pm * BM + ai * HALF + wr * 64 + m * 16 + fr;
                const float rs = rstd1[row];
                float x1[8], x2[8];
#pragma unroll
                for (int j = 0; j < 4; ++j) { x1[j] = acc[ai][0][m][0][j] * rs; x1[4 + j] = acc[ai][0][m][1][j] * rs; x2[j] = acc[ai][1][m][0][j] * rs; x2[4 + j] = acc[ai][1][m][1][j] * rs; }
                if (pn >= 9) {
                    bf16_t* G = (bf16_t*)(ws + WS_GA + (size_t)((pn - 9) >> 2) * (WS_GB - WS_GA)) + (size_t)row * 1024 + 256 * ((pn - 9) & 3) + 32 * wc + 8 * fq;
                    float a[8], b[8];
#pragma unroll
                    for (int j = 0; j < 8; ++j) { a[j] = 1.0f / (1.0f + __builtin_amdgcn_exp2f(-x1[j] * 1.4426950408889634f)); b[j] = 1.0f / (1.0f + __builtin_amdgcn_exp2f(-x2[j] * 1.4426950408889634f)); }
                    *(u32x4*)G = pack8(a); *(u32x4*)(G + 128) = pack8(b);
                } else if (pn == 8) {
                    if (wc == 0) {
                        float s = 0.f;
#pragma unroll
                        for (int j = 0; j < 8; ++j) s += x1[j] + x2[j];
                        s += __shfl_xor(s, 16); s += __shfl_xor(s, 32);
                        const float mu = s * (1.0f / 64.0f); float q = 0.f;
#pragma unroll
                        for (int j = 0; j < 8; ++j) { x1[j] -= mu; x2[j] -= mu; q += x1[j] * x1[j] + x2[j] * x2[j]; }
                        q += __shfl_xor(q, 16); q += __shfl_xor(q, 32);
                        const float rstd = __builtin_amdgcn_rsqf(q * (1.0f / 64.0f) + 1e-6f);
                        const int pos = row & 4095; const float* cp = cs + pos * 32 + 8 * fq; const float* sp = sn + pos * 32 + 8 * fq;
                        float o1[8], o2[8];
#pragma unroll
                        for (int j = 0; j < 8; ++j) { const float y1 = x1[j] * rstd * ikw[8 * fq + j] + ikb[8 * fq + j], y2 = x2[j] * rstd * ikw[32 + 8 * fq + j] + ikb[32 + 8 * fq + j];
                            const float c = cp[j], sI = sp[j]; o1[j] = y1 * c - y2 * sI; o2[j] = y2 * c + y1 * sI; }
                        unsigned char* tb = ws + WS_IK + (size_t)(row >> 5) * 4096 + (size_t)(row & 31) * 16;
                        *(u32x4*)(tb + (fq >> 1) * 1024 + (fq & 1) * 512) = pack8(o1); *(u32x4*)(tb + (2 + (fq >> 1)) * 1024 + (fq & 1) * 512) = pack8(o2);
                    } else if (wc == 1 && fq == 0) {
                        float* dst = (float*)(ws + WS_IW) + (size_t)row * 8;
                        *(f32x4*)dst = (f32x4){x1[0], x1[1], x1[2], x1[3]} * 0.04419417382415922f; *(f32x4*)(dst + 4) = (f32x4){x1[4], x1[5], x1[6], x1[7]} * 0.04419417382415922f;
                    }
                } else if (pn >= 6) {
                    bf16_t* Kd = (bf16_t*)(ws + WS_AK + (size_t)(pn - 6) * (WS_BK - WS_AK)); bf16_t* Vd = (bf16_t*)(ws + WS_AV + (size_t)(pn - 6) * (WS_BV - WS_AV));
                    if (wc < 2) {
                        const int pos = row & 4095; const float* cp = cs + pos * 32 + 8 * fq; const float* sp = sn + pos * 32 + 8 * fq;
                        float o1[8], o2[8];
#pragma unroll
                        for (int j = 0; j < 8; ++j) { const float c = cp[j], sI = sp[j]; o1[j] = x1[j] * c - x2[j] * sI; o2[j] = x2[j] * c + x1[j] * sI; }
                        bf16_t* dst = Kd + (size_t)row * 128 + wc * 64 + 8 * fq;
                        *(u32x4*)dst = pack8(o1); *(u32x4*)(dst + 32) = pack8(o2);
                    } else {
                        bf16_t* dst = Vd + (size_t)row * 128 + 32 * (wc - 2) + 8 * fq;
                        *(u32x4*)dst = pack8(x1); *(u32x4*)(dst + 64) = pack8(x2);
                    }
                } else {
                    bf16_t* Q = (bf16_t*)(ws + WS_AQ + (size_t)(pn >> 1) * (WS_IQ - WS_AQ)); const float sc = (pn >= 2 && pn < 4) ? 1.0f : 0.125f * 1.4426950408889634f;
                    const int pos = row & 4095; const float* cp = cs + pos * 32 + 8 * fq; const float* sp = sn + pos * 32 + 8 * fq;
                    float o1[8], o2[8];
#pragma unroll
                    for (int j = 0; j < 8; ++j) { const float c = cp[j], sI = sp[j]; o1[j] = (x1[j] * c - x2[j] * sI) * sc; o2[j] = (x2[j] * c + x1[j] * sI) * sc; }
                    bf16_t* dst = Q + (size_t)row * 512 + (4 * (pn & 1) + wc) * 64 + 8 * fq;
                    *(u32x4*)dst = pack8(o1); *(u32x4*)(dst + 32) = pack8(o2);
                }
                asm volatile("" ::: "memory");
            }
    }
};

struct EpiGate {
    static constexpr bool PERM = true, AFTER_DRAIN = false;
    const bf16_t *GA, *GB; float* P; bf16_t* MIX;
    __device__ __forceinline__ void operator()(const f32x4 (&acc)[2][2][4][2], const Unit& u, int wr, int wc, int fr, int fq) const {
        const bool second = u.pn >= 4; const bf16_t* G = second ? GB : GA;
#pragma unroll
        for (int ai = 0; ai < 2; ++ai)
#pragma unroll
            for (int m = 0; m < 4; ++m) {
                const int row = u.pm * BM + ai * HALF + wr * 64 + m * 16 + fr;
#pragma unroll
                for (int bj = 0; bj < 2; ++bj) {
                    const size_t off = (size_t)row * 1024 + 256 * (u.pn & 3) + 128 * bj + 32 * wc + 8 * fq;
                    const u32x4 gw = *(const u32x4*)(G + off);
                    float v[8];
#pragma unroll
                    for (int j = 0; j < 4; ++j) { v[j] = acc[ai][bj][m][0][j]; v[4 + j] = acc[ai][bj][m][1][j]; }
                    v[0] *= __uint_as_float(gw.x << 16); v[1] *= __uint_as_float(gw.x & 0xffff0000u); v[2] *= __uint_as_float(gw.y << 16); v[3] *= __uint_as_float(gw.y & 0xffff0000u);
                    v[4] *= __uint_as_float(gw.z << 16); v[5] *= __uint_as_float(gw.z & 0xffff0000u); v[6] *= __uint_as_float(gw.w << 16); v[7] *= __uint_as_float(gw.w & 0xffff0000u);
                    if (!second) { *(f32x4*)(P + off) = (f32x4){v[0], v[1], v[2], v[3]}; *(f32x4*)(P + off + 4) = (f32x4){v[4], v[5], v[6], v[7]}; }
                    else { const f32x4 p0 = *(const f32x4*)(P + off), p1 = *(const f32x4*)(P + off + 4);
#pragma unroll
                        for (int j = 0; j < 4; ++j) { v[j] += p0[j]; v[4 + j] += p1[j]; }
                        *(u32x4*)(MIX + off) = pack8(v); }
                }
            }
    }
};

template <bool WITH_XG> struct EpiResid {
    static constexpr bool PERM = false, AFTER_DRAIN = false;
    const float* base; float* out; bf16_t* XG; const float* gw; float* ss;
    __device__ __forceinline__ void operator()(const f32x4 (&acc)[2][2][4][2], const Unit& u, int wr, int wc, int fr, int fq) const {
#pragma unroll
        for (int ai = 0; ai < 2; ++ai)
#pragma unroll
            for (int m = 0; m < 4; ++m) {
                const int row = u.pm * BM + ai * HALF + wr * 64 + m * 16 + fr; float s = 0.f;
#pragma unroll
                for (int bj = 0; bj < 2; ++bj)
#pragma unroll
                    for (int n = 0; n < 2; ++n) {
                        const int col = u.pn * BM + bj * HALF + wc * 32 + n * 16 + 4 * fq; const size_t off = (size_t)row * 1024 + col;
                        const f32x4 v = *(const f32x4*)(base + off) + acc[ai][bj][m][n];
                        *(f32x4*)(out + off) = v; s += (v[0] * v[0] + v[1] * v[1]) + (v[2] * v[2] + v[3] * v[3]);
                        if (WITH_XG) { const f32x4 g = *(const f32x4*)(gw + col); unsigned long long w = (unsigned long long)cvt_pk_bf16(v[0] * g[0], v[1] * g[1]) | ((unsigned long long)cvt_pk_bf16(v[2] * g[2], v[3] * g[3]) << 32);
                            *(unsigned long long*)(XG + off) = w; }
                    }
                s += __shfl_xor(s, 16); s += __shfl_xor(s, 32);
                if (fq == 0) atomicAdd(ss + row, s);
            }
    }
};

struct EpiUp {
    static constexpr bool PERM = true, AFTER_DRAIN = false;
    const float* ss; bf16_t* HID;
    __device__ __forceinline__ void operator()(const f32x4 (&acc)[2][2][4][2], const Unit& u, int wr, int wc, int fr, int fq) const {
#pragma unroll
        for (int ai = 0; ai < 2; ++ai)
#pragma unroll
            for (int m = 0; m < 4; ++m) {
                const int row = u.pm * BM + ai * HALF + wr * 64 + m * 16 + fr;
                const float rs = __builtin_amdgcn_rsqf(ss[row] * (1.0f / 1024.0f) + 1e-6f);
#pragma unroll
                for (int bj = 0; bj < 2; ++bj) {
                    float v[8];
#pragma unroll
                    for (int j = 0; j < 4; ++j) { float a = fmaxf(acc[ai][bj][m][0][j] * rs, 0.f), b = fmaxf(acc[ai][bj][m][1][j] * rs, 0.f); v[j] = a * a; v[4 + j] = b * b; }
                    *(u32x4*)(HID + (size_t)row * 4096 + u.pn * BM + bj * HALF + wc * 32 + 8 * fq) = pack8(v);
                }
            }
    }
};

struct BranchOrder {
    int G, c;
    __device__ __forceinline__ bool next(int i, Unit& u) const {
        const int tile = (i >> 1) * G + c; if (tile >= 128 * 4) return false;
        u.pm = tile >> 2; u.pn = (tile & 3) + 4 * (i & 1); return true;
    }
    __device__ __forceinline__ void a_ready(const Unit&) const {}
    __device__ __forceinline__ void done(const Unit&) const {}
};

template <class Epi, class Sched, bool ALIGN_EPI = false, bool SP2 = false>
__device__ __forceinline__ void gemm_phase(PG8_LAS unsigned char* lds, const Gemm g, const Sched& S, const Epi& E, int wv) {
    const int tid = tid_op(wv), wid = wv, lane = tid & 63, wr = wid >> 2, wc = wid & 3, fr = lane & 15, fq = lane >> 4;
    const int K = g.K, nt = K / BK;
    unsigned voffA[2], voffB[2];
#pragma unroll
    for (int i = 0; i < 2; ++i) { int R, C; stage_rc(tid * 16 + i * 8192, R, C); const int Rb = Epi::PERM ? ((R & ~31) + perm32(R & 31)) : R;
        voffA[i] = (unsigned)(R * K + C) * 2u; voffB[i] = (unsigned)(Rb * K + C) * 2u; }
    const size_t kstep = (size_t)(BK * 2);
    const size_t hstep = (size_t)HALF * K * 2;
    const size_t tstep = 2 * hstep;
    const unsigned ldsw = (unsigned)wid * 1024u;
    const int aoff = lds_byte(wr * 64 + fr, fq * 8), boff = lds_byte(wc * 32 + fr, fq * 8);
#define PG8_SA(b, h) (((b) * 2 + (h)) * HTB)
#define PG8_SB(b, h) ((4 + (b) * 2 + (h)) * HTB)
#define PG8_STAGE(bufoff, gbase, voff) do { _Pragma("unroll") for (int _i = 0; _i < 2; ++_i) \
        __builtin_amdgcn_global_load_lds((const unsigned*)((const char*)(gbase) + (voff)[_i]), (PG8_LAS unsigned*)(lds + (bufoff) + ldsw + _i * 8192), 16, 0, 0); } while (0)
#define PG8_LDA(dst, b, h) do { _Pragma("unroll") for (int m = 0; m < 4; ++m) _Pragma("unroll") for (int k = 0; k < 2; ++k) dst[m][k] = *(const PG8_LAS bf16x8*)(lds + PG8_SA(b, h) + aoff + m * 2048 + k * 1024); } while (0)
#define PG8_LDB(dst, b, h) do { _Pragma("unroll") for (int n = 0; n < 2; ++n) _Pragma("unroll") for (int k = 0; k < 2; ++k) dst[n][k] = *(const PG8_LAS bf16x8*)(lds + PG8_SB(b, h) + boff + n * 2048 + k * 1024); } while (0)
#define PG8_MMA(ai, bj, At, Bt) do { __builtin_amdgcn_s_setprio(1); _Pragma("unroll") for (int m = 0; m < 4; ++m) _Pragma("unroll") for (int n = 0; n < 2; ++n) _Pragma("unroll") for (int k = 0; k < 2; ++k) \
        acc[ai][bj][m][n] = __builtin_amdgcn_mfma_f32_16x16x32_bf16(Bt[n][k], At[m][k], acc[ai][bj][m][n], 0, 0, 0); __builtin_amdgcn_s_setprio(0); } while (0)
#define PG8_WAIT_V(n) asm volatile("s_waitcnt vmcnt(" #n ")" ::: "memory")
#define PG8_WAIT_L(n) asm volatile("s_waitcnt lgkmcnt(" #n ")" ::: "memory")
#define PG8_BAR __builtin_amdgcn_s_barrier()
#define PG8_SCHED __builtin_amdgcn_sched_barrier(0)
    Unit cur, nxt; int ui = 0;
    if (!S.next(0, cur)) return;
    f32x4 acc[2][2][4][2];
#pragma unroll
    for (int a = 0; a < 2; ++a)
#pragma unroll
        for (int b = 0; b < 2; ++b)
#pragma unroll
            for (int m = 0; m < 4; ++m)
#pragma unroll
                for (int n = 0; n < 2; ++n) acc[a][b][m][n] = (f32x4){0.f, 0.f, 0.f, 0.f};
    bf16x8 At[4][2], B0[2][2], B1[2][2];
    const char* cA = g.abase(cur) + (size_t)cur.pm * tstep; const char* cB = (const char*)g.Bt + (size_t)cur.pn * tstep;
    S.a_ready(cur);
    if constexpr (SP2) {
        PG8_STAGE(PG8_SB(0, 0), cB, voffB); PG8_STAGE(PG8_SB(0, 1), cB + hstep, voffB); PG8_STAGE(PG8_SA(0, 0), cA, voffA); PG8_STAGE(PG8_SA(0, 1), cA + hstep, voffA);
        if (wr == 1) PG8_BAR;
        PG8_WAIT_V(2); PG8_BAR;
        PG8_STAGE(PG8_SB(1, 0), cB + kstep, voffB); PG8_STAGE(PG8_SA(1, 0), cA + kstep, voffA); PG8_STAGE(PG8_SB(1, 1), cB + hstep + kstep, voffB);
        PG8_WAIT_V(6); PG8_BAR;
    } else {
        PG8_STAGE(PG8_SB(0, 0), cB, voffB); PG8_STAGE(PG8_SA(0, 0), cA, voffA); PG8_STAGE(PG8_SB(0, 1), cB + hstep, voffB); PG8_STAGE(PG8_SA(0, 1), cA + hstep, voffA);
        if (wr == 1) PG8_BAR;
        PG8_WAIT_V(4); PG8_BAR;
        PG8_STAGE(PG8_SB(1, 0), cB + kstep, voffB); PG8_STAGE(PG8_SA(1, 0), cA + kstep, voffA); PG8_STAGE(PG8_SB(1, 1), cB + hstep + kstep, voffB);
        PG8_WAIT_V(6); PG8_BAR;
    }
    for (;;) {
        const bool has_next = S.next(ui + 1, nxt);
        const char* nA = has_next ? g.abase(nxt) + (size_t)nxt.pm * tstep : cA; const char* nB = has_next ? (const char*)g.Bt + (size_t)nxt.pn * tstep : cB;
        for (int t = 0; t < nt; t += 2) {
            const bool last = (t == nt - 2);
            const char* a1 = cA + (size_t)(t + 1) * kstep;
            const char* a2 = last ? nA : cA + (size_t)(t + 2) * kstep; const char* b2 = last ? nB : cB + (size_t)(t + 2) * kstep;
            const char* a3 = a2 + kstep; const char* b3 = b2 + kstep;
            if (last && has_next) S.a_ready(nxt);
            if constexpr (SP2) {
            PG8_LDB(B0, 0, 0); PG8_LDB(B1, 0, 1); PG8_SCHED; PG8_LDA(At, 0, 0); PG8_STAGE(PG8_SA(1, 1), a1 + hstep, voffA);
            PG8_WAIT_V(8); PG8_WAIT_L(0); PG8_BAR; PG8_MMA(0, 0, At, B0); PG8_MMA(0, 1, At, B1); PG8_BAR; PG8_SCHED;
            PG8_LDA(At, 0, 1); PG8_STAGE(PG8_SB(0, 0), b2, voffB); PG8_STAGE(PG8_SB(0, 1), b2 + hstep, voffB); PG8_STAGE(PG8_SA(0, 0), a2, voffA);
            PG8_WAIT_V(8); PG8_WAIT_L(0); PG8_BAR; PG8_MMA(1, 0, At, B0); PG8_MMA(1, 1, At, B1); PG8_BAR; PG8_SCHED;
            PG8_LDB(B0, 1, 0); PG8_LDB(B1, 1, 1); PG8_SCHED; PG8_LDA(At, 1, 0); PG8_STAGE(PG8_SA(0, 1), a2 + hstep, voffA);
            PG8_WAIT_V(8); PG8_WAIT_L(0); PG8_BAR; PG8_MMA(0, 0, At, B0); PG8_MMA(0, 1, At, B1); PG8_BAR; PG8_SCHED;
            PG8_LDA(At, 1, 1); PG8_STAGE(PG8_SB(1, 0), b3, voffB); PG8_STAGE(PG8_SB(1, 1), b3 + hstep, voffB); PG8_STAGE(PG8_SA(1, 0), a3, voffA);
            PG8_WAIT_V(8); PG8_WAIT_L(0); PG8_BAR; PG8_MMA(1, 0, At, B0); PG8_MMA(1, 1, At, B1); PG8_BAR; PG8_SCHED;
            } else {
            PG8_LDB(B0, 0, 0); PG8_SCHED; PG8_LDA(At, 0, 0); PG8_STAGE(PG8_SA(1, 1), a1 + hstep, voffA);
            PG8_WAIT_L(8); PG8_BAR; PG8_WAIT_L(0); PG8_MMA(0, 0, At, B0); PG8_BAR; PG8_SCHED;
            PG8_LDB(B1, 0, 1); PG8_STAGE(PG8_SB(0, 0), b2, voffB);
            PG8_BAR; PG8_WAIT_L(0); PG8_MMA(0, 1, At, B1); PG8_BAR;
            PG8_LDA(At, 0, 1); PG8_STAGE(PG8_SA(0, 0), a2, voffA);
            PG8_BAR; PG8_WAIT_L(0); PG8_MMA(1, 0, At, B0); PG8_BAR; PG8_SCHED;
            PG8_STAGE(PG8_SB(0, 1), b2 + hstep, voffB);
            PG8_WAIT_V(6); PG8_BAR; PG8_MMA(1, 1, At, B1); PG8_BAR;
            PG8_LDB(B0, 1, 0); PG8_SCHED; PG8_LDA(At, 1, 0); PG8_STAGE(PG8_SA(0, 1), a2 + hstep, voffA);
            PG8_WAIT_L(8); PG8_BAR; PG8_WAIT_L(0); PG8_MMA(0, 0, At, B0); PG8_BAR; PG8_SCHED;
            PG8_LDB(B1, 1, 1); PG8_STAGE(PG8_SB(1, 0), b3, voffB);
            PG8_BAR; PG8_WAIT_L(0); PG8_MMA(0, 1, At, B1); PG8_BAR;
            PG8_LDA(At, 1, 1); PG8_STAGE(PG8_SA(1, 0), a3, voffA);
            PG8_BAR; PG8_WAIT_L(0); PG8_MMA(1, 0, At, B0); PG8_BAR; PG8_SCHED;
            PG8_STAGE(PG8_SB(1, 1), b3 + hstep, voffB);
            PG8_WAIT_V(6); PG8_BAR; PG8_MMA(1, 1, At, B1); PG8_BAR;
            }
        }
        if constexpr (ALIGN_EPI) { if (wr == 0) PG8_BAR; }
        if constexpr (!Epi::AFTER_DRAIN) { E(acc, cur, wr, wc, fr, fq); S.done(cur); }
        if (!has_next) break;
#pragma unroll
        for (int a = 0; a < 2; ++a)
#pragma unroll
            for (int b = 0; b < 2; ++b)
#pragma unroll
                for (int m = 0; m < 4; ++m)
#pragma unroll
                    for (int n = 0; n < 2; ++n) acc[a][b][m][n] = (f32x4){0.f, 0.f, 0.f, 0.f};
        cur = nxt; cA = nA; cB = nB; ++ui;
        if constexpr (ALIGN_EPI) { if (wr == 1) PG8_BAR; }
    }
    PG8_WAIT_V(0);
    if constexpr (!ALIGN_EPI) { if (wr == 0) PG8_BAR; }
    PG8_BAR;
    if constexpr (Epi::AFTER_DRAIN) { E.fused(acc, cur, wr, wc, fr, fq, lds, wid, lane); S.done(cur); }
#undef PG8_SA
#undef PG8_SB
#undef PG8_STAGE
#undef PG8_LDA
#undef PG8_LDB
#undef PG8_MMA
#undef PG8_WAIT_V
#undef PG8_WAIT_L
#undef PG8_BAR
#undef PG8_SCHED
}
}
struct Params {
    const float *x, *attn_norm_w, *w_in, *ikw, *ikb, *sinks, *w_a, *w_b, *w_out, *mlp_norm_w, *w_up, *w_down, *final_w;
    float* out; unsigned char* ws;
    float inv_freq[32];
    int ph_lo, ph_hi;
};
constexpr int NWAVES = 8, NTHREADS = 512;

__device__ __forceinline__ int win_src_group(int grp, int& cnt) {
    const int tile = grp >> 3, g = grp & 7; cnt = 32;
    if (tile < 6) { const int base = tile < 2 ? C_AQ : (tile < 4 ? C_IQ : C_BQ); const int head = 4 * (tile & 1) + (g & 3); return base + head * 64 + 32 * (g >> 2); }
    if (tile < 8) { const int kb = tile == 6 ? C_AK : C_BK, vb = tile == 6 ? C_AV : C_BV; const int hf = g >> 2, q = g & 3;
        if (q < 2) return kb + q * 64 + 32 * hf; return vb + 64 * hf + 32 * (q - 2); }
    if (tile == 8) { if (g == 0) return C_IK; if (g == 4) return C_IK + 32; if (g == 1) { cnt = 8; return C_IW; } cnt = 0; return 0; }
    return C_GA + (grp - 72) * 32;
}
__device__ __forceinline__ void p0_transpose_item(const float* W, int ldw, int c0, int cnt, int K, bf16* WT, int n0, int k0, LAS float* scr, int lane) {
#pragma unroll 8
    for (int i = 0; i < 32; ++i) { const int kk = 2 * i + (lane >> 5), n = lane & 31; scr[kk * 33 + n] = (n < cnt) ? W[(size_t)(k0 + kk) * ldw + c0 + n] : 0.f; }
    asm volatile("s_waitcnt lgkmcnt(0)" ::: "memory");
    const int c = lane & 7;
#pragma unroll
    for (int j = 0; j < 4; ++j) { const int n = (lane >> 3) + 8 * j; const LAS float* s = scr + (8 * c) * 33 + n;
        v4u o; o.x = pk2(s[0 * 33], s[1 * 33]); o.y = pk2(s[2 * 33], s[3 * 33]); o.z = pk2(s[4 * 33], s[5 * 33]); o.w = pk2(s[6 * 33], s[7 * 33]);
        *(v4u*)(WT + (size_t)(n0 + n) * K + k0 + 8 * c) = o; }
    asm volatile("s_waitcnt lgkmcnt(0)" ::: "memory");
}
__device__ __forceinline__ void sincos_d(float angf, float& sn, float& cs) {
    const double a = (double)angf; const double kq = __builtin_rint(a * 0.63661977236758134308);
    const double y = (a - kq * 1.57079632679489655800) - kq * 6.123233995736766e-17; const double y2 = y * y;
    double s = y * (1.0 + y2 * (-1.0 / 6 + y2 * (1.0 / 120 + y2 * (-1.0 / 5040 + y2 * (1.0 / 362880 + y2 * (-1.0 / 39916800 + y2 * (1.0 / 6227020800.0)))))));
    double c = 1.0 + y2 * (-0.5 + y2 * (1.0 / 24 + y2 * (-1.0 / 720 + y2 * (1.0 / 40320 + y2 * (-1.0 / 3628800 + y2 * (1.0 / 479001600.0 + y2 * (-1.0 / 87178291200.0)))))));
    const int q = ((int)kq) & 3;
    const double ss = (q == 0) ? s : (q == 1) ? c : (q == 2) ? -s : -c; const double cc = (q == 0) ? c : (q == 1) ? -s : (q == 2) ? -c : s;
    sn = (float)ss; cs = (float)cc;
}
__device__ __forceinline__ void phase_prologue(const Params& p, LAS unsigned char* lds, int G, int wv) {
    const int wave = wv, lane = lane_id();
    unsigned char* ws = p.ws;
    LAS float* scr = (LAS float*)(lds + wave * 16384);
    const int gw = blockIdx.x * NWAVES + wave, NGW = G * NWAVES;
    constexpr int I_IN = (DM / 64) * (NIN / 32), I_A = (512 / 64) * (DM / 32), I_O = (DM / 64) * (DM / 32), I_U = (DM / 64) * (DFF / 32), I_D = (DFF / 64) * (DM / 32);
    constexpr int NITEMS = I_IN + 2 * I_A + I_O + I_U + I_D;
    for (int it = gw; it < NITEMS; it += NGW) {
        int r = it;
        if (r < I_IN) { const int grp = r % (NIN / 32), kb = r / (NIN / 32); int cnt; const int c0 = win_src_group(grp, cnt);
            p0_transpose_item(p.w_in, D_IN, c0, cnt, DM, (bf16*)(ws + WS_WIN), grp * 32, kb * 64, scr, lane); continue; } r -= I_IN;
        if (r < I_A) { const int nb = r % 32, kb = r / 32; p0_transpose_item(p.w_a, DM, nb * 32, 32, 512, (bf16*)(ws + WS_WAB), nb * 32, kb * 64, scr, lane); continue; } r -= I_A;
        if (r < I_A) { const int nb = r % 32, kb = r / 32; p0_transpose_item(p.w_b, DM, nb * 32, 32, 512, (bf16*)(ws + WS_WAB), 1024 + nb * 32, kb * 64, scr, lane); continue; } r -= I_A;
        if (r < I_O) { const int nb = r % 32, kb = r / 32; p0_transpose_item(p.w_out, DM, nb * 32, 32, DM, (bf16*)(ws + WS_WOUT), nb * 32, kb * 64, scr, lane); continue; } r -= I_O;
        if (r < I_U) { const int nb = r % 128, kb = r / 128; p0_transpose_item(p.w_up, DFF, nb * 32, 32, DM, (bf16*)(ws + WS_WUP), nb * 32, kb * 64, scr, lane); continue; } r -= I_U;
        { const int nb = r % 32, kb = r / 32; p0_transpose_item(p.w_down, DM, nb * 32, 32, DFF, (bf16*)(ws + WS_WDN), nb * 32, kb * 64, scr, lane); }
    }
    float* COS = (float*)(ws + WS_COS); float* SIN = (float*)(ws + WS_SIN);
    for (int i = gw * 64 + lane; i < SEQ * 32; i += NGW * 64) { const int pos = i >> 5, d = i & 31; const float ang = (float)pos * p.inv_freq[d]; float s, c; sincos_d(ang, s, c); COS[i] = c; SIN[i] = s; }
    float* RSTD1 = (float*)(ws + WS_RSTD1); float* SS2 = (float*)(ws + WS_SS2); float* SS3 = (float*)(ws + WS_SS3); bf16* XG = (bf16*)(ws + WS_XG);
    v4f g[4];
#pragma unroll
    for (int j = 0; j < 4; ++j) g[j] = *((const v4f*)p.attn_norm_w + lane + 64 * j);
    for (int m = gw; m < TOK; m += NGW) {
        const v4f* xr = (const v4f*)(p.x + (size_t)m * DM) + lane; v4f v[4]; float s = 0.f;
#pragma unroll
        for (int j = 0; j < 4; ++j) { v[j] = xr[64 * j]; s += (v[j].x * v[j].x + v[j].y * v[j].y) + (v[j].z * v[j].z + v[j].w * v[j].w); }
        s = wave_sum(s);
        unsigned long long* o8 = (unsigned long long*)(XG + (size_t)m * DM) + lane;
#pragma unroll
        for (int j = 0; j < 4; ++j) o8[64 * j] = (unsigned long long)pk2(v[j].x * g[j].x, v[j].y * g[j].y) | ((unsigned long long)pk2(v[j].z * g[j].z, v[j].w * g[j].w) << 32);
        if (lane == 0) { RSTD1[m] = frsq(s * (1.0f / DM) + RMS_EPS); SS2[m] = 0.f; SS3[m] = 0.f; }
    }
}

__device__ __forceinline__ unsigned f2key(float f) { const unsigned u = __float_as_uint(f); return (u & 0x80000000u) ? ~u : (u | 0x80000000u); }
__device__ __forceinline__ void phase_topk_simple(const Params& p, LAS unsigned char* lds, int G, int wv) {
    const int wave = wv, lane = lane_id();
    unsigned char* ws = p.ws;
    const bf16* IQ = (const bf16*)(ws + WS_IQ); const bf16* IK = (const bf16*)(ws + WS_IK); const float* IW = (const float*)(ws + WS_IW);
    unsigned short* SEL = (unsigned short*)(ws + WS_SEL);
    LAS unsigned* keys = (LAS unsigned*)(lds + wave * 16384);
    LAS float* qf = (LAS float*)(lds + LDS_RING + wave * 2048);
    const int gw = blockIdx.x * NWAVES + wave, NGW = G * NWAVES;
    for (int row = gw; row < TOK; row += NGW) {
        const int b = row >> 12, t = row & 4095, n = t + 1;
        unsigned short* selrow = SEL + (size_t)row * TOPK;
        if (n <= TOPK) { for (int i = lane; i < n; i += 64) selrow[i] = (unsigned short)i; continue; }
        { const v4u q8 = *((const v4u*)(IQ + (size_t)row * 512) + lane);
            LAS float* d = qf + 8 * lane;
            d[0] = bflo(q8.x); d[1] = bfhi(q8.x); d[2] = bflo(q8.y); d[3] = bfhi(q8.y); d[4] = bflo(q8.z); d[5] = bfhi(q8.z); d[6] = bflo(q8.w); d[7] = bfhi(q8.w); }
        float w[8];
#pragma unroll
        for (int h = 0; h < 8; ++h) w[h] = IW[(size_t)row * 8 + h];
        asm volatile("s_waitcnt lgkmcnt(0)" ::: "memory");
        for (int s0 = 0; s0 < n; s0 += 64) {
            const int s = s0 + lane; const int sc = s < n ? s : t;
            const v4u* kp = (const v4u*)(IK + ((size_t)b * SEQ + sc) * 64);
            float dot[8];
#pragma unroll
            for (int h = 0; h < 8; ++h) dot[h] = 0.f;
#pragma unroll
            for (int c = 0; c < 8; ++c) {
                const v4u k8 = kp[c]; float kf[8] = {bflo(k8.x), bfhi(k8.x), bflo(k8.y), bfhi(k8.y), bflo(k8.z), bfhi(k8.z), bflo(k8.w), bfhi(k8.w)};
#pragma unroll
                for (int h = 0; h < 8; ++h) { const v4f qa = *(const LAS v4f*)(qf + h * 64 + c * 8), qb = *(const LAS v4f*)(qf + h * 64 + c * 8 + 4);
                    dot[h] += (kf[0] * qa.x + kf[1] * qa.y) + (kf[2] * qa.z + kf[3] * qa.w) + (kf[4] * qb.x + kf[5] * qb.y) + (kf[6] * qb.z + kf[7] * qb.w); }
            }
            float sc_ = 0.f;
#pragma unroll
            for (int h = 0; h < 8; ++h) sc_ += w[h] * fmaxf(dot[h], 0.f);
            keys[s] = (s < n) ? f2key(sc_) : 0u;
        }
        asm volatile("s_waitcnt lgkmcnt(0)" ::: "memory");
        const int nch = (n + 63) >> 6;
        unsigned thr = 0u;
        for (int bit = 31; bit >= 0; --bit) {
            const unsigned cand = thr | (1u << bit); int cnt = 0;
            for (int c = 0; c < nch; ++c) cnt += __popcll(__ballot(keys[c * 64 + lane] >= cand));
            if (cnt >= TOPK) thr = cand;
        }
        int cgt = 0;
        for (int c = 0; c < nch; ++c) cgt += __popcll(__ballot(keys[c * 64 + lane] > thr));
        const int need = TOPK - cgt; int pos = 0, ties = 0;
        for (int c = 0; c < nch; ++c) {
            const unsigned k = keys[c * 64 + lane]; const bool gt = k > thr, eq = k == thr;
            const unsigned long long meq = __ballot(eq);
            const bool sel = gt || (eq && (ties + mbcnt64(meq) < need));
            const unsigned long long msel = __ballot(sel);
            if (sel) selrow[pos + mbcnt64(msel)] = (unsigned short)(c * 64 + lane);
            pos += __popcll(msel); ties += __popcll(meq);
        }
    }
}

template <bool SINK, class KeyFn>
__device__ __forceinline__ void attend_wave(const bf16* Q, const bf16* K, const bf16* V, bf16* O, int row, int g, int nslots, const KeyFn& keyfn, const float* sinkv,
                                            LAS float* qf  , LAS float* pf  , LAS int* kidx  , int lane) {
    const int b = row >> 12;
    { const v2u q4 = *((const v2u*)(Q + (size_t)row * 512 + g * 256) + lane);
        LAS float* d = qf + 4 * lane; d[0] = bflo(q4.x); d[1] = bfhi(q4.x); d[2] = bflo(q4.y); d[3] = bfhi(q4.y); }
    asm volatile("s_waitcnt lgkmcnt(0)" ::: "memory");
#pragma unroll 1
    for (int j = 0; j < 4; ++j) {
        const int slot = 64 * j + lane; int key = slot < nslots ? keyfn(slot) : -1; kidx[slot] = key;
        const bool valid = key >= 0; const int kc = valid ? key : 0;
        const v4u* kp = (const v4u*)(K + ((size_t)b * SEQ + kc) * 128 + g * 64);
        float dot[4] = {0.f, 0.f, 0.f, 0.f};
        if (64 * j < nslots) {
#pragma unroll 2
            for (int c = 0; c < 8; ++c) {
                const v4u k8 = kp[c]; float kf[8] = {bflo(k8.x), bfhi(k8.x), bflo(k8.y), bfhi(k8.y), bflo(k8.z), bfhi(k8.z), bflo(k8.w), bfhi(k8.w)};
#pragma unroll
                for (int h = 0; h < 4; ++h) { const v4f qa = *(const LAS v4f*)(qf + h * 64 + c * 8), qb = *(const LAS v4f*)(qf + h * 64 + c * 8 + 4);
                    dot[h] += (kf[0] * qa.x + kf[1] * qa.y) + (kf[2] * qa.z + kf[3] * qa.w) + (kf[4] * qb.x + kf[5] * qb.y) + (kf[6] * qb.z + kf[7] * qb.w); }
            }
        }
        *(LAS v4f*)(pf + slot * 4) = valid ? (v4f){dot[0], dot[1], dot[2], dot[3]} : (v4f){-INFINITY, -INFINITY, -INFINITY, -INFINITY};
    }
    asm volatile("s_waitcnt lgkmcnt(0)" ::: "memory");
    float lg[4][4];
#pragma unroll
    for (int j = 0; j < 4; ++j) { const v4f t4 = *(const LAS v4f*)(pf + (64 * j + lane) * 4); lg[j][0] = t4.x; lg[j][1] = t4.y; lg[j][2] = t4.z; lg[j][3] = t4.w; }
    float inv[4];
#pragma unroll
    for (int h = 0; h < 4; ++h) {
        float mx = fmaxf(fmaxf(lg[0][h], lg[1][h]), fmaxf(lg[2][h], lg[3][h])); mx = wave_max(mx);
        float sk = 0.f; if (SINK) { sk = sinkv[g * 4 + h] * LOG2E; mx = fmaxf(mx, sk); }
        float s = 0.f;
#pragma unroll
        for (int j = 0; j < 4; ++j) { const float e = fexp2(lg[j][h] - mx); lg[j][h] = e; s += e; }
        s = wave_sum(s); if (SINK) s += fexp2(sk - mx);
        inv[h] = 1.0f / s;
    }
#pragma unroll
    for (int j = 0; j < 4; ++j) *(LAS v4f*)(pf + (64 * j + lane) * 4) = (v4f){lg[j][0], lg[j][1], lg[j][2], lg[j][3]};
    asm volatile("s_waitcnt lgkmcnt(0)" ::: "memory");
    float o[4] = {0.f, 0.f, 0.f, 0.f};
    const bf16* Vb = V + (size_t)b * SEQ * 128 + g * 64 + lane;
#pragma unroll 1
    for (int s0 = 0; s0 < nslots; s0 += 8) {
        float vv[8]; v4f pp[8];
#pragma unroll
        for (int i = 0; i < 8; ++i) { const int slot = s0 + i; const int key = slot < nslots ? kidx[slot] : -1; pp[i] = *(const LAS v4f*)(pf + (slot & 255) * 4);
            vv[i] = key >= 0 ? bf2f(Vb[(size_t)key * 128]) : 0.f; if (key < 0) pp[i] = (v4f){0.f, 0.f, 0.f, 0.f}; }
#pragma unroll
        for (int i = 0; i < 8; ++i) { o[0] += pp[i].x * vv[i]; o[1] += pp[i].y * vv[i]; o[2] += pp[i].z * vv[i]; o[3] += pp[i].w * vv[i]; }
    }
    bf16* op = O + (size_t)row * 512 + g * 256 + lane;
#pragma unroll
    for (int h = 0; h < 4; ++h) op[h * 64] = (bf16)f2bf(o[h] * inv[h]);
}
struct SelKey { const unsigned short* selrow; __device__ __forceinline__ int operator()(int slot) const { return (int)selrow[slot]; } };
struct WinKey { int t; __device__ __forceinline__ int operator()(int slot) const { return t - (WIN - 1) + slot; } };

template <bool DO_DSA, bool DO_SWA>
__device__ __forceinline__ void phase_attn_simple(const Params& p, LAS unsigned char* lds, int G, int wv) {
    const int wave = wv, lane = lane_id();
    unsigned char* ws = p.ws;
    LAS float* qf = (LAS float*)(lds + wave * 16384); LAS float* pf = qf + 256; LAS int* kidx = (LAS int*)(pf + 1024);
    const int gw = blockIdx.x * NWAVES + wave, NGW = G * NWAVES;
    const unsigned short* SEL = (const unsigned short*)(ws + WS_SEL);
    for (int item = gw; item < TOK * 2; item += NGW) {
        const int row = item >> 1, g = item & 1, t = row & 4095;
        if (DO_DSA) { SelKey kf{SEL + (size_t)row * TOPK}; const int ns = (t + 1 < TOPK) ? t + 1 : TOPK;
            attend_wave<false>((const bf16*)(ws + WS_AQ), (const bf16*)(ws + WS_AK), (const bf16*)(ws + WS_AV), (bf16*)(ws + WS_OA), row, g, ns, kf, nullptr, qf, pf, kidx, lane); }
        if (DO_SWA) { WinKey kf{t};
            attend_wave<true>((const bf16*)(ws + WS_BQ), (const bf16*)(ws + WS_BK), (const bf16*)(ws + WS_BV), (bf16*)(ws + WS_OB), row, g, WIN, kf, p.sinks, qf, pf, kidx, lane); }
    }
}

__device__ __forceinline__ void phase_final(const Params& p, int G, int wv) {
    const int wave = wv, lane = lane_id();
    const float* SS3 = (const float*)(p.ws + WS_SS3);
    const int gw = blockIdx.x * NWAVES + wave, NGW = G * NWAVES;
    v4f g[4];
#pragma unroll
    for (int j = 0; j < 4; ++j) g[j] = *((const v4f*)p.final_w + lane + 64 * j);
    for (int m = gw; m < TOK; m += NGW) {
        float rs = frsq(SS3[m] * (1.0f / DM) + RMS_EPS);
#ifdef PROBE_TS
        { const unsigned long long* TS = (const unsigned long long*)(p.ws + WS_RSTD1 + 384 * 1024); rs *= 1.0f + (float)(TS[PROBE_TS + 1] - TS[PROBE_TS]) * 1.0e-5f; }
#endif
        v4f* xr = (v4f*)(p.out + (size_t)m * DM) + lane;
#pragma unroll
        for (int j = 0; j < 4; ++j) { v4f v = xr[64 * j]; xr[64 * j] = v * g[j] * rs; }
    }
}

typedef short bf16x8_t __attribute__((ext_vector_type(8)));
typedef float f32x16_t __attribute__((ext_vector_type(16)));
typedef float f32x4_t __attribute__((ext_vector_type(4)));
typedef float f32x2_t __attribute__((ext_vector_type(2)));
__device__ __forceinline__ unsigned f16key(float f) { const int q = (int)__builtin_rintf(f * 4096.0f) + 32768; return (unsigned)(q < 256 ? 256 : (q > 65535 ? 65535 : q)); }
__device__ __forceinline__ float relu1(float x) { return __builtin_amdgcn_fmed3f(x, 0.f, 3.0e38f); }
constexpr int TK_H1 = LDS_RING, TK_WAVE = LDS_RING + 8192, TK_WAVE_BYTES = 3072, TK_CAND = 512;
static_assert(TK_WAVE + 8 * TK_WAVE_BYTES <= LDS_BYTES, "top-k LDS map");

__device__ __forceinline__ void phase_topk_fast(const Params& p, LAS unsigned char* lds, int G, int wv) {
    const int wave = wv, lane = lane_id(), tid = wave * 64 + lane;
    const int r = lane & 31, h = lane >> 5, mt = wave & 3, par = wave >> 2;
    unsigned char* ws = p.ws;
    const bf16* IQ = (const bf16*)(ws + WS_IQ); const bf16* IK = (const bf16*)(ws + WS_IK); const float* IW = (const float*)(ws + WS_IW);
    unsigned short* SEL = (unsigned short*)(ws + WS_SEL);
    LAS unsigned short* kb = (LAS unsigned short*)lds;
    LAS unsigned* H1 = (LAS unsigned*)(lds + TK_H1);
    LAS unsigned* cl = (LAS unsigned*)(lds + TK_WAVE + wave * TK_WAVE_BYTES); LAS unsigned short* ol = (LAS unsigned short*)(lds + TK_WAVE + wave * TK_WAVE_BYTES + 4 * TK_CAND);
    const int qrow = 4 * mt + 2 * ((r >> 2) & 1) + (r >> 4), qhead = 4 * ((r >> 3) & 1) + (r & 3);
    { LAS v4u* hz = (LAS v4u*)H1; hz[tid] = (v4u){0u, 0u, 0u, 0u}; }
    for (int k = 0;; ++k) {
        int b, tile;
        if (G == 256) { if (k >= 8) break; const int c = blockIdx.x, i = c >> 3, grp = k >> 1; b = c & 7; tile = (k & 1) ? (64 * grp + 63 - i) : (64 * grp + i); }
        else { const int u = blockIdx.x + k * G; if (u >= TOK / 16) break; b = u >> 8; tile = u & 255; }
        const int t0 = tile * 16, R0 = b * SEQ + t0;
        if (t0 + 16 <= TOPK) {
            for (int i = tid; i < 16 * TOPK; i += NTHREADS) { const int ql = i >> 8, s = i & 255; if (s <= t0 + ql) SEL[(size_t)(R0 + ql) * TOPK + s] = (unsigned short)s; }
            continue;
        }
        bf16x8_t aq[4];
#pragma unroll
        for (int s = 0; s < 4; ++s) aq[s] = *(const bf16x8_t*)(IQ + (size_t)(R0 + qrow) * 512 + qhead * 64 + 16 * s + 8 * h);
        f32x2_t wq[2][4];
#pragma unroll
        for (int qq = 0; qq < 2; ++qq) { const f32x4_t w0 = *(const f32x4_t*)(IW + (size_t)(R0 + 4 * mt + 2 * h + qq) * 8), w1 = *(const f32x4_t*)(IW + (size_t)(R0 + 4 * mt + 2 * h + qq) * 8 + 4);
            wq[qq][0] = (f32x2_t){w0[0], w0[1]}; wq[qq][1] = (f32x2_t){w0[2], w0[3]}; wq[qq][2] = (f32x2_t){w1[0], w1[1]}; wq[qq][3] = (f32x2_t){w1[2], w1[3]}; }
        const int ntile = (t0 + 16 + 31) >> 5, ntp = (ntile + 7) & ~7, nch = (t0 + 16 + 511) >> 9;
        const char* kbase = (const char*)IK + (size_t)b * SEQ * 128;
        const unsigned voff = (unsigned)(lane * 16);
        const int tq0 = t0 + 4 * mt + 2 * h;
        const int ql0 = 4 * mt + 2 * h;
        LAS unsigned short* row0 = kb + ql0 * 4096; LAS unsigned* h0 = H1 + ql0 * 128;
        __syncthreads();
#define TK_LOAD(dst, kt_) do { const int ktc_ = (kt_) < 127 ? (kt_) : 127; const char* tp_ = kbase + (size_t)ktc_ * 4096; _Pragma("unroll") for (int s_ = 0; s_ < 4; ++s_) dst[s_] = *(const bf16x8_t*)(tp_ + voff + 1024 * s_); } while (0)
#define TK_MMA(acc_, src) do { acc_ = (f32x16_t){0.f, 0.f, 0.f, 0.f, 0.f, 0.f, 0.f, 0.f, 0.f, 0.f, 0.f, 0.f, 0.f, 0.f, 0.f, 0.f}; \
            _Pragma("unroll") for (int s_ = 0; s_ < 4; ++s_) acc_ = __builtin_amdgcn_mfma_f32_32x32x16_bf16(aq[s_], src[s_], acc_, 0, 0, 0); } while (0)
#define TK_POST(acc_, kt_) do { f32x2_t s0_ = {0.f, 0.f}, s1_ = {0.f, 0.f}; \
            _Pragma("unroll") for (int hd_ = 0; hd_ < 4; ++hd_) { s0_ += (f32x2_t){relu1(acc_[2 * hd_]), relu1(acc_[2 * hd_ + 1])} * wq[0][hd_]; s1_ += (f32x2_t){relu1(acc_[8 + 2 * hd_]), relu1(acc_[9 + 2 * hd_])} * wq[1][hd_]; } \
            const int e_ = 32 * (kt_) + r; const unsigned k0_ = (e_ <= tq0) ? f16key(s0_.x + s0_.y) : 0u, k1_ = (e_ <= tq0 + 1) ? f16key(s1_.x + s1_.y) : 0u; \
            row0[e_] = (unsigned short)k0_; row0[4096 + e_] = (unsigned short)k1_; \
            if (k0_) __hip_atomic_fetch_add(h0 + (k0_ >> 9), 1u << ((k0_ >> 4) & 16u), __ATOMIC_RELAXED, __HIP_MEMORY_SCOPE_WORKGROUP); \
            if (k1_) __hip_atomic_fetch_add(h0 + 128 + (k1_ >> 9), 1u << ((k1_ >> 4) & 16u), __ATOMIC_RELAXED, __HIP_MEMORY_SCOPE_WORKGROUP); } while (0)
#ifndef TK_REP_SCORE
#define TK_REP_SCORE 1
#endif
#ifndef TK_REP_SEL
#define TK_REP_SEL 1
#endif
#pragma unroll 1
        for (int rp_ = 0; rp_ < TK_REP_SCORE; ++rp_) {
            bf16x8_t B[4][4]; f32x16_t accA, accB;
            const int nmy = ntp >> 1;
#pragma unroll
            for (int u = 0; u < 4; ++u) TK_LOAD(B[u], par + 2 * u);
            TK_MMA(accA, B[0]);
#pragma unroll 1
            for (int i = 0; i < nmy; i += 4) {
                const int kt = par + 2 * i;
                TK_MMA(accB, B[1]); TK_POST(accA, kt);     TK_LOAD(B[0], kt + 8);
                TK_MMA(accA, B[2]); TK_POST(accB, kt + 2); TK_LOAD(B[1], kt + 10);
                TK_MMA(accB, B[3]); TK_POST(accA, kt + 4); TK_LOAD(B[2], kt + 12);
                TK_MMA(accA, B[0]); TK_POST(accB, kt + 6); TK_LOAD(B[3], kt + 14);
            }
        }
#undef TK_LOAD
#undef TK_MMA
#undef TK_POST
        if (32 * ntp < 512 * nch) {
#pragma unroll
            for (int qi = 0; qi < 2; ++qi) { LAS v2u* z = (LAS v2u*)(kb + (2 * wave + qi) * 4096 + 32 * ntp) + lane; *z = (v2u){0u, 0u}; }
        }
        __syncthreads();
#pragma unroll 1
        for (int qi = 0; qi < 2 * TK_REP_SEL; ++qi) {
            const int ql = 2 * wave + (qi & 1);
            const LAS unsigned short* rb = kb + ql * 4096 + lane;
            const v2u hw = *(const LAS v2u*)(H1 + ql * 128 + 2 * lane); const v4u hv = {hw.x & 0xffffu, hw.x >> 16, hw.y & 0xffffu, hw.y >> 16};
            if ((qi >> 1) + 1 == TK_REP_SEL) *(LAS v2u*)(H1 + ql * 128 + 2 * lane) = (v2u){0u, 0u};
            const int hs = (int)(hv.x + hv.y + hv.z + hv.w); int S = hs;
#pragma unroll
            for (int off = 1; off < 64; off <<= 1) { const int v = __shfl_down(S, off); if (lane + off < 64) S += v; }
            int ab = S - hs; const bool cross = ab < TOPK && S >= TOPK;
            int Bl = 4 * lane + 3;
            if (ab + (int)hv.w < TOPK) { ab += (int)hv.w; Bl = 4 * lane + 2; if (ab + (int)hv.z < TOPK) { ab += (int)hv.z; Bl = 4 * lane + 1; if (ab + (int)hv.y < TOPK) { ab += (int)hv.y; Bl = 4 * lane; } } }
            const unsigned long long mc = __ballot(cross);
            const int src = mc ? (__ffsll((long long)mc) - 1) : 0;
            const unsigned Bb = (unsigned)__shfl(Bl, src);
            int pos = 0, m = 0;
#pragma unroll 1
            for (int j = 0; j < nch; ++j) {
                unsigned kk[8];
#pragma unroll
                for (int s = 0; s < 8; ++s) kk[s] = rb[512 * j + 64 * s];
#pragma unroll
                for (int s = 0; s < 8; ++s) {
                    const unsigned hb = kk[s] >> 8; const bool gt = hb > Bb, eq = hb == Bb;
                    const unsigned long long mg = __ballot(gt), me = __ballot(eq);
                    const unsigned e = (unsigned)(512 * j + 64 * s + lane);
                    if (gt) ol[pos + mbcnt64(mg)] = (unsigned short)e;
                    if (eq) { const int ci = m + mbcnt64(me); if (ci < TK_CAND) cl[ci] = ((kk[s] & 0xffu) << 16) | e; }
                    pos += __popcll(mg); m += __popcll(me);
                }
            }
            asm volatile("s_waitcnt lgkmcnt(0)" ::: "memory");
            if (mc != 0ull && m <= TK_CAND && pos < TOPK && pos + m >= TOPK) {
                const int need2 = TOPK - pos;
                unsigned ent[8]; bool val[8];
#pragma unroll
                for (int q = 0; q < 8; ++q) { val[q] = 64 * q + lane < m; ent[q] = val[q] ? cl[64 * q + lane] : 0u; }
                unsigned thr2 = 0u;
#pragma unroll 1
                for (int bit = 7; bit >= 0; --bit) {
                    const unsigned cand = thr2 | (1u << bit); int cnt = 0;
#pragma unroll
                    for (int q = 0; q < 8; ++q) cnt += __popcll(__ballot(val[q] && (ent[q] >> 16) >= cand));
                    if (cnt >= need2) thr2 = cand;
                }
                int cgt2 = 0;
#pragma unroll
                for (int q = 0; q < 8; ++q) cgt2 += __popcll(__ballot(val[q] && (ent[q] >> 16) > thr2));
                const int need3 = need2 - cgt2; int ties = 0;
#pragma unroll
                for (int q = 0; q < 8; ++q) {
                    const unsigned lb = ent[q] >> 16; const bool gt = val[q] && lb > thr2, eq = val[q] && lb == thr2;
                    const unsigned long long meq = __ballot(eq);
                    const bool sel = gt || (eq && (ties + mbcnt64(meq) < need3));
                    const unsigned long long msel = __ballot(sel);
                    if (sel) ol[pos + mbcnt64(msel)] = (unsigned short)(ent[q] & 0xffffu);
                    pos += __popcll(msel); ties += __popcll(meq);
                }
            } else {
                unsigned thr = 0u;
#pragma unroll 1
                for (int bit = 15; bit >= 0; --bit) {
                    const unsigned cand = thr | (1u << bit); int cnt = 0;
#pragma unroll 1
                    for (int i = 0; i < 8 * nch; ++i) cnt += __popcll(__ballot((unsigned)rb[64 * i] >= cand));
                    if (cnt >= TOPK) thr = cand;
                }
                int cgt = 0;
#pragma unroll 1
                for (int i = 0; i < 8 * nch; ++i) cgt += __popcll(__ballot((unsigned)rb[64 * i] > thr));
                const int need = TOPK - cgt; int ties = 0; pos = 0;
#pragma unroll 1
                for (int i = 0; i < 8 * nch; ++i) {
                    const unsigned kx = rb[64 * i]; const bool gt = kx > thr, eq = kx == thr;
                    const unsigned long long meq = __ballot(eq);
                    const bool sel = gt || (eq && (ties + mbcnt64(meq) < need));
                    const unsigned long long msel = __ballot(sel);
                    if (sel) ol[pos + mbcnt64(msel)] = (unsigned short)(64 * i + lane);
                    pos += __popcll(msel); ties += __popcll(meq);
                }
            }
            asm volatile("s_waitcnt lgkmcnt(0)" ::: "memory");
            *((v2u*)(SEL + (size_t)(R0 + ql) * TOPK) + lane) = *(const LAS v2u*)(ol + 4 * lane);
            asm volatile("s_waitcnt lgkmcnt(0)" ::: "memory");
        }
    }
    __syncthreads();
}

typedef short s16x4_t __attribute__((ext_vector_type(4)));
__device__ __forceinline__ s16x4_t tr_read(unsigned addr) { s16x4_t r_; asm volatile("ds_read_b64_tr_b16 %0, %1" : "=v"(r_) : "v"(addr) : "memory"); return r_; }

__device__ __forceinline__ void phase_dsa_fast(const Params& p, LAS unsigned char* lds, int G, int wv) {
    const int wave = wv, lane = lane_id(), tid = wave * 64 + lane;
    const int c16 = lane & 15, kq = lane >> 4;
    unsigned char* ws = p.ws;
    const bf16* AQ = (const bf16*)(ws + WS_AQ); const bf16* AK = (const bf16*)(ws + WS_AK); const bf16* AV = (const bf16*)(ws + WS_AV); bf16* OA = (bf16*)(ws + WS_OA);
    const unsigned short* SEL = (const unsigned short*)(ws + WS_SEL);
    LAS unsigned char* wl = lds + wave * 13312;
    LAS unsigned short* sidx = (LAS unsigned short*)wl; LAS unsigned short* Pl = (LAS unsigned short*)(wl + 512); LAS unsigned char* Vl = wl + 2560;
    const unsigned vl_addr = (unsigned)(size_t)Vl;
    const bool arow = (c16 & 3) == 0; const int ahead = c16 >> 2;
    const int nper = (G >= 8 && (G & 7) == 0) ? (G >> 3) * NWAVES : 0;
    for (int it = 0;; ++it) {
        int row;
        if (nper) { const int wi = (blockIdx.x >> 3) * NWAVES + wave, t = wi + it * nper; if (t >= SEQ) break; row = (blockIdx.x & 7) * SEQ + t; }
        else { row = blockIdx.x * NWAVES + wave + it * G * NWAVES; if (row >= TOK) break; }
        const int b = row >> 12, t = row & 4095; const int cnt = (t + 1 < TOPK) ? t + 1 : TOPK;
        { const v2u sv = *((const v2u*)(SEL + (size_t)row * TOPK) + lane);
            const int s0 = 4 * lane; v2u o;
            o.x = ((s0 < cnt) ? (sv.x & 0xffffu) : 0u) | (((s0 + 1 < cnt) ? (sv.x >> 16) : 0u) << 16); o.y = ((s0 + 2 < cnt) ? (sv.y & 0xffffu) : 0u) | (((s0 + 3 < cnt) ? (sv.y >> 16) : 0u) << 16);
            *(LAS v2u*)(sidx + 4 * lane) = o; }
        asm volatile("s_waitcnt lgkmcnt(0)" ::: "memory");
        const bf16* Kb = AK + (size_t)b * SEQ * 128; const bf16* Vb = AV + (size_t)b * SEQ * 128;
#pragma unroll 1
        for (int g = 0; g < 2; ++g) {
            bf16x8_t aq[2];
#pragma unroll
            for (int c = 0; c < 2; ++c) { aq[c] = (bf16x8_t){0, 0, 0, 0, 0, 0, 0, 0}; if (arow) aq[c] = *(const bf16x8_t*)(AQ + (size_t)row * 512 + (4 * g + ahead) * 64 + 32 * c + 8 * kq); }
            float sc[16];
            const bf16* Kg = Kb + g * 64 + 8 * kq;
#pragma unroll
            for (int q4 = 0; q4 < 4; ++q4) {
                bf16x8_t kf[4][2];
#pragma unroll
                for (int u = 0; u < 4; ++u) { const int key = sidx[16 * (4 * q4 + u) + c16]; const bf16* kp = Kg + (size_t)key * 128; kf[u][0] = *(const bf16x8_t*)kp; kf[u][1] = *(const bf16x8_t*)(kp + 32); }
#pragma unroll
                for (int u = 0; u < 4; ++u) { f32x4_t a = {0.f, 0.f, 0.f, 0.f};
                    a = __builtin_amdgcn_mfma_f32_16x16x32_bf16(aq[0], kf[u][0], a, 0, 0, 0); a = __builtin_amdgcn_mfma_f32_16x16x32_bf16(aq[1], kf[u][1], a, 0, 0, 0);
                    sc[4 * q4 + u] = (16 * (4 * q4 + u) + c16 < cnt) ? a[0] : -INFINITY; }
            }
            float mx = sc[0];
#pragma unroll
            for (int i = 1; i < 16; ++i) mx = fmaxf(mx, sc[i]);
            mx = fmaxf(mx, __shfl_xor(mx, 1)); mx = fmaxf(mx, __shfl_xor(mx, 2)); mx = fmaxf(mx, __shfl_xor(mx, 4)); mx = fmaxf(mx, __shfl_xor(mx, 8));
            float sum = 0.f;
#pragma unroll
            for (int i = 0; i < 16; ++i) { sc[i] = fexp2(sc[i] - mx); sum += sc[i]; }
            sum += __shfl_xor(sum, 1); sum += __shfl_xor(sum, 2); sum += __shfl_xor(sum, 4); sum += __shfl_xor(sum, 8);
            const float inv = 1.0f / sum;
#pragma unroll
            for (int i = 0; i < 16; ++i) Pl[kq * 256 + 16 * i + c16] = (unsigned short)f2bf(sc[i]);
            asm volatile("s_waitcnt lgkmcnt(0)" ::: "memory");
            f32x4_t o[4];
#pragma unroll
            for (int dt = 0; dt < 4; ++dt) o[dt] = (f32x4_t){0.f, 0.f, 0.f, 0.f};
            const bf16* Vg = Vb + g * 64 + 8 * (lane & 7);
#pragma unroll 1
            for (int ch = 0; ch < 4; ++ch) {
                v4u vr[8];
#pragma unroll
                for (int i = 0; i < 8; ++i) { const int key = sidx[64 * ch + 8 * i + (lane >> 3)]; vr[i] = *(const v4u*)(Vg + (size_t)key * 128); }
#pragma unroll
                for (int i = 0; i < 8; ++i) *(LAS v4u*)(Vl + (8 * i + (lane >> 3)) * 160 + 16 * (lane & 7)) = vr[i];
                asm volatile("s_waitcnt lgkmcnt(0)" ::: "memory");
#pragma unroll
                for (int hf = 0; hf < 2; ++hf) {
                    bf16x8_t pa = (bf16x8_t){0, 0, 0, 0, 0, 0, 0, 0};
                    if (arow) { const s16x4_t lo = *(const LAS s16x4_t*)(Pl + ahead * 256 + 64 * ch + 32 * hf + 4 * kq), hi = *(const LAS s16x4_t*)(Pl + ahead * 256 + 64 * ch + 32 * hf + 16 + 4 * kq);
                        pa = (bf16x8_t){lo[0], lo[1], lo[2], lo[3], hi[0], hi[1], hi[2], hi[3]}; }
                    const unsigned va = vl_addr + (unsigned)((32 * hf + 4 * kq + (c16 >> 2)) * 160 + 8 * (c16 & 3));
                    s16x4_t vlo[4], vhi[4];
#pragma unroll
                    for (int dt = 0; dt < 4; ++dt) { vlo[dt] = tr_read(va + 32 * dt); vhi[dt] = tr_read(va + 16 * 160 + 32 * dt); }
                    asm volatile("s_waitcnt lgkmcnt(0)" : "+v"(vlo[0]), "+v"(vlo[1]), "+v"(vlo[2]), "+v"(vlo[3]), "+v"(vhi[0]), "+v"(vhi[1]), "+v"(vhi[2]), "+v"(vhi[3]) :: "memory");
                    __builtin_amdgcn_sched_barrier(0);
#pragma unroll
                    for (int dt = 0; dt < 4; ++dt) { const bf16x8_t vb = (bf16x8_t){vlo[dt][0], vlo[dt][1], vlo[dt][2], vlo[dt][3], vhi[dt][0], vhi[dt][1], vhi[dt][2], vhi[dt][3]};
                        o[dt] = __builtin_amdgcn_mfma_f32_16x16x32_bf16(pa, vb, o[dt], 0, 0, 0); }
                }
                asm volatile("s_waitcnt lgkmcnt(0)" ::: "memory");
            }
            bf16* op = OA + (size_t)row * 512 + (4 * g + kq) * 64 + c16;
#pragma unroll
            for (int dt = 0; dt < 4; ++dt) op[16 * dt] = (bf16)f2bf(o[dt][0] * inv);
        }
    }
}

typedef float f32x2_t __attribute__((ext_vector_type(2))); typedef __bf16 bf16x2v_t __attribute__((ext_vector_type(2)));
__device__ __forceinline__ unsigned cvtpk_s(float lo, float hi) { f32x2_t v = {lo, hi}; bf16x2v_t b = __builtin_convertvector(v, bf16x2v_t); return __builtin_bit_cast(unsigned, b); }
__device__ __forceinline__ int crow16(int reg, int h) { return (reg & 3) + 8 * (reg >> 2) + 4 * h; }

__device__ __forceinline__ void phase_swa_fast(const Params& p, int G, int wv) {
    const int wave = wv, lane = lane_id(), tid = wave * 64 + lane;
    const int r = lane & 31, h = lane >> 5, hh = wave >> 1, qh = wave & 1;
    unsigned char* ws = p.ws;
    const bf16* BQ = (const bf16*)(ws + WS_BQ); const bf16* BK = (const bf16*)(ws + WS_BK); const bf16* BV = (const bf16*)(ws + WS_BV); bf16* OB = (bf16*)(ws + WS_OB);
    for (int k = 0;; ++k) {
        int b, idx;
        if (G >= 8 && (G & 7) == 0) { idx = (blockIdx.x >> 3) + (G >> 3) * k; if (idx >= 64) break; b = blockIdx.x & 7; }
        else { const int u = blockIdx.x + k * G; if (u >= 512) break; b = u >> 6; idx = u & 63; }
        const int qb = idx >> 1, g = idx & 1, head = 4 * g + hh;
        const float sink = p.sinks[head] * LOG2E;
        const bf16* Kb = BK + (size_t)b * SEQ * 128 + g * 64 + 8 * h; const bf16* Vb = BV + (size_t)b * SEQ * 128 + g * 64 + r;
#pragma unroll 1
        for (int qt = 0; qt < 2; ++qt) {
            const int q0 = 128 * qb + 64 * qh + 32 * qt;
            const size_t qrow = (size_t)b * SEQ + q0 + r;
            bf16x8_t qf[4];
#pragma unroll
            for (int s = 0; s < 4; ++s) qf[s] = *(const bf16x8_t*)(BQ + qrow * 512 + head * 64 + 16 * s + 8 * h);
            f32x16_t S[5];
#pragma unroll
            for (int kt = 0; kt < 5; ++kt) {
                const int kb0 = q0 - 128 + 32 * kt; const int krow_ = kb0 + r; const int kc = krow_ < 0 ? 0 : krow_;
                bf16x8_t kf[4];
#pragma unroll
                for (int s = 0; s < 4; ++s) kf[s] = *(const bf16x8_t*)(Kb + (size_t)kc * 128 + 16 * s);
                f32x16_t a = {0.f, 0.f, 0.f, 0.f, 0.f, 0.f, 0.f, 0.f, 0.f, 0.f, 0.f, 0.f, 0.f, 0.f, 0.f, 0.f};
#pragma unroll
                for (int s = 0; s < 4; ++s) a = __builtin_amdgcn_mfma_f32_32x32x16_bf16(kf[s], qf[s], a, 0, 0, 0);
#pragma unroll
                for (int i = 0; i < 16; ++i) { const int key = kb0 + crow16(i, h); const int rel = q0 + r - key; S[kt][i] = (key >= 0 && rel >= 0 && rel < WIN) ? a[i] : -INFINITY; }
            }
            float mx = sink;
#pragma unroll
            for (int kt = 0; kt < 5; ++kt)
#pragma unroll
                for (int i = 0; i < 16; ++i) mx = fmaxf(mx, S[kt][i]);
            mx = fmaxf(mx, __shfl_xor(mx, 32));
            float l = 0.f;
#pragma unroll
            for (int kt = 0; kt < 5; ++kt)
#pragma unroll
                for (int i = 0; i < 16; ++i) { S[kt][i] = fexp2(S[kt][i] - mx); l += S[kt][i]; }
            l += __shfl_xor(l, 32); l += fexp2(sink - mx);
            const float linv = 1.0f / l;
            f32x16_t O0 = {0.f, 0.f, 0.f, 0.f, 0.f, 0.f, 0.f, 0.f, 0.f, 0.f, 0.f, 0.f, 0.f, 0.f, 0.f, 0.f}, O1 = O0;
#pragma unroll
            for (int kt = 0; kt < 5; ++kt) {
                const int kb0 = q0 - 128 + 32 * kt;
#pragma unroll
                for (int s = 0; s < 2; ++s) {
                    v4u pw; pw.x = cvtpk_s(S[kt][8 * s + 0], S[kt][8 * s + 1]); pw.y = cvtpk_s(S[kt][8 * s + 2], S[kt][8 * s + 3]); pw.z = cvtpk_s(S[kt][8 * s + 4], S[kt][8 * s + 5]); pw.w = cvtpk_s(S[kt][8 * s + 6], S[kt][8 * s + 7]);
                    const bf16x8_t pa = __builtin_bit_cast(bf16x8_t, pw);
                    unsigned short v0[8], v1[8];
#pragma unroll
                    for (int j = 0; j < 8; ++j) { int key = kb0 + 16 * s + 8 * (j >> 2) + 4 * h + (j & 3); key = key < 0 ? 0 : key; v0[j] = Vb[(size_t)key * 128]; v1[j] = Vb[(size_t)key * 128 + 32]; }
                    const bf16x8_t vb0 = (bf16x8_t){(short)v0[0], (short)v0[1], (short)v0[2], (short)v0[3], (short)v0[4], (short)v0[5], (short)v0[6], (short)v0[7]};
                    const bf16x8_t vb1 = (bf16x8_t){(short)v1[0], (short)v1[1], (short)v1[2], (short)v1[3], (short)v1[4], (short)v1[5], (short)v1[6], (short)v1[7]};
                    O0 = __builtin_amdgcn_mfma_f32_32x32x16_bf16(pa, vb0, O0, 0, 0, 0); O1 = __builtin_amdgcn_mfma_f32_32x32x16_bf16(pa, vb1, O1, 0, 0, 0);
                }
            }
            bf16* op = OB + ((size_t)b * SEQ + q0) * 512 + head * 64 + r;
#pragma unroll
            for (int i = 0; i < 16; ++i) { const int qq = crow16(i, h); const float li = __shfl(linv, qq); op[(size_t)qq * 512] = (bf16)f2bf(O0[i] * li); op[(size_t)qq * 512 + 32] = (bf16)f2bf(O1[i] * li); }
        }
    }
}

#define XB_TMO      128
#define XB_XCNT(j)  (256  + 64 * (j))
#define XB_XSUB(j)  (1280 + 64 * (j))
#define XB_XGEN(j)  (2304 + 64 * (j))
#define XB_TOP      3328
#define XB_TOPGEN   3392
#define XCD_BAR_WORDS 3456
#define XB_SPIN_CAP (1u << 18)

__device__ __forceinline__ unsigned xb_ld(unsigned* p)              { return __hip_atomic_load(p, __ATOMIC_RELAXED, __HIP_MEMORY_SCOPE_AGENT); }
__device__ __forceinline__ unsigned xb_add(unsigned* p, unsigned v) { return __hip_atomic_fetch_add(p, v, __ATOMIC_RELAXED, __HIP_MEMORY_SCOPE_AGENT); }
__device__ __forceinline__ unsigned xb_xcc_id() { return (unsigned)__builtin_amdgcn_s_getreg((3 << 11) | 20) & 0xFu; }
#define XB_SPIN(cond, bar) do { unsigned _sp = 0; while (cond) { __builtin_amdgcn_s_sleep(1); \
    if ((++_sp & 255u) == 0u) { if (xb_ld(&(bar)[XB_TMO])) break; if (_sp > XB_SPIN_CAP) { atomicAdd(&(bar)[XB_TMO], 1u); break; } } } } while (0)

struct XcdBarrier {
    unsigned* bar; unsigned x;
    volatile LAS unsigned* st;
};

__device__ __forceinline__ XcdBarrier xcd_barrier_post(unsigned* bar, volatile LAS unsigned* st) {
    XcdBarrier b; b.bar = bar; b.x = xb_xcc_id(); b.st = st;
    if (threadIdx.x == 0) (void)xb_add(&bar[XB_XCNT(b.x)], 1u);
    return b;
}
__device__ __forceinline__ void xcd_barrier_complete(unsigned* bar, unsigned x, unsigned& nloc, unsigned& nx) {
    const unsigned G = gridDim.x * gridDim.y * gridDim.z;
    unsigned sum, cnt, mine, sp = 0u;
    for (;;) {
        sum = 0u; cnt = 0u; mine = 0u;
#pragma unroll
        for (unsigned j = 0; j < 16; ++j) { const unsigned c = xb_ld(&bar[XB_XCNT(j)]); sum += c; cnt += (c > 0u) ? 1u : 0u; mine = (j == x) ? c : mine; }
        if (sum == G) break;
        __builtin_amdgcn_s_sleep(1);
        if ((++sp & 255u) == 0u) { if (xb_ld(&bar[XB_TMO])) break; if (sp > XB_SPIN_CAP) { atomicAdd(&bar[XB_TMO], 1u); break; } }
    }
    nloc = mine > 0u ? mine : 1u; nx = cnt > 0u ? cnt : 1u;
}

__device__ __forceinline__ void xcd_barrier(const XcdBarrier& b, int wv) {
    asm volatile("s_waitcnt vmcnt(0)" ::: "memory");
    __syncthreads();
    if (wv == 0 && lane_id() == 0) {
        unsigned* bar = b.bar;
        __builtin_amdgcn_s_waitcnt(0);
        unsigned nloc = b.st[0], nx = b.st[1];
        if (nloc == 0u) { xcd_barrier_complete(bar, b.x, nloc, nx); b.st[0] = nloc; b.st[1] = nx; }
        const unsigned old = xb_add(&bar[XB_XSUB(b.x)], 1u);
        const unsigned gen = old / nloc;
        if (old + 1u == (gen + 1u) * nloc) {
            __builtin_amdgcn_fence(__ATOMIC_RELEASE, "agent");
            asm volatile("s_waitcnt vmcnt(0)" ::: "memory");
            const unsigned og = xb_add(&bar[XB_TOP], 1u);
            const unsigned tg = og / nx;
            if (og + 1u == (tg + 1u) * nx) xb_add(&bar[XB_TOPGEN], 1u);
            else XB_SPIN(xb_ld(&bar[XB_TOPGEN]) == tg, bar);
            __builtin_amdgcn_fence(__ATOMIC_ACQUIRE, "agent");
            xb_add(&bar[XB_XGEN(b.x)], 1u);
            asm volatile("s_waitcnt vmcnt(0)" ::: "memory");
        } else {
            XB_SPIN(xb_ld(&bar[XB_XGEN(b.x)]) == gen, bar);
            __builtin_amdgcn_fence(__ATOMIC_ACQUIRE, "agent");
            asm volatile("s_waitcnt vmcnt(0)" ::: "memory");
        }
    }
    __syncthreads();
}

constexpr int NPHASE = 9;
__global__ void __launch_bounds__(NTHREADS, 2) mk_fwd(Params p) {
    extern __shared__ __attribute__((aligned(16))) unsigned char lds_raw[];
    LAS unsigned char* lds = (LAS unsigned char*)lds_raw;
    const int G = gridDim.x, wv = __builtin_amdgcn_readfirstlane(threadIdx.x >> 6);
    unsigned char* ws = p.ws;
#if MK_ONE_LAUNCH
#define SEAM(k) do { if (rep_ + 1 < REPS(k)) __syncthreads(); else if (lo <= (k) && (k) + 1 < hi) { if ((k) == 0) cg::this_grid().sync(); else xcd_barrier(xbar, wv); } } while (0)
#else
#define SEAM(k) do { if (rep_ + 1 < REPS(k)) __syncthreads(); } while (0)
#endif
    const int lo = p.ph_lo, hi = p.ph_hi;
#if MK_ONE_LAUNCH
    if (threadIdx.x == 0) { ((volatile LAS unsigned*)(lds + XB_LDS_OFF))[0] = 0u; ((volatile LAS unsigned*)(lds + XB_LDS_OFF))[1] = 0u; }
    const XcdBarrier xbar = xcd_barrier_post((unsigned*)(ws + WS_BAR), (volatile LAS unsigned*)(lds + XB_LDS_OFF));
#endif
#ifdef PROBE_TS
    unsigned long long* TS = (unsigned long long*)(ws + WS_RSTD1 + 384 * 1024);
#define STAMP(k) do { if (blockIdx.x == 0) TS[k] = __builtin_amdgcn_s_memrealtime(); } while (0)
#else
#define STAMP(k) do { } while (0)
#endif
    STAMP(0);
#ifndef PHMASK
#define PHMASK 0x1ffu
#endif
#define IN(k) (((PHMASK >> (k)) & 1u) && lo <= (k) && (k) < hi)
#define REPS(k) (((REP_MASK >> (k)) & 1u) ? 2 : 1)
#define PHASE(k) if (IN(k)) for (int rep_ = 0; rep_ < REPS(k); ++rep_)
    PHASE(0) { phase_prologue(p, lds, G, wv); SEAM(0); STAMP(0 + 1); }
    PHASE(1) {
        pg8::Gemm g{(const bf16*)(ws + WS_XG), (const bf16*)(ws + WS_WIN), TOK, NIN, DM, nullptr, 1 << 30};
        pg8::StaticOrder S; S.init(TOK, NIN, G, (int)blockIdx.x);
        pg8::EpiInProj E{(const float*)(ws + WS_RSTD1), (const float*)(ws + WS_COS), (const float*)(ws + WS_SIN), ws, p.ikw, p.ikb};
        pg8::gemm_phase<pg8::EpiInProj, pg8::StaticOrder, true, true>(lds, g, S, E, wv);
        SEAM(1); STAMP(1 + 1);
    }
#if MK_SIMPLE_TOPK
    PHASE(2) { phase_topk_simple(p, lds, G, wv); SEAM(2); STAMP(2 + 1); }
#else
    PHASE(2) { phase_topk_fast(p, lds, G, wv); SEAM(2); STAMP(2 + 1); }
#endif
#if MK_SIMPLE_DSA
    PHASE(3) { phase_attn_simple<true, true>(p, lds, G, wv); SEAM(3); STAMP(3 + 1); }
#else
#if MK_SIMPLE_SWA
    PHASE(3) { phase_dsa_fast(p, lds, G, wv); __syncthreads(); phase_attn_simple<false, true>(p, lds, G, wv); SEAM(3); STAMP(3 + 1); }
#else
    PHASE(3) { phase_swa_fast(p, G, wv); phase_dsa_fast(p, lds, G, wv); SEAM(3); STAMP(3 + 1); }
#endif
#endif
    PHASE(4) {
        pg8::Gemm g{(const bf16*)(ws + WS_OA), (const bf16*)(ws + WS_WAB), TOK, 2048, 512, (const bf16*)(ws + WS_OB), 4};
        pg8::BranchOrder S{G, (int)blockIdx.x};
        pg8::EpiGate E{(const bf16*)(ws + WS_GA), (const bf16*)(ws + WS_GB), p.out, (bf16*)(ws + WS_MIX)};
        pg8::gemm_phase<pg8::EpiGate, pg8::BranchOrder, true, true>(lds, g, S, E, wv);
        SEAM(4); STAMP(4 + 1);
    }
    PHASE(5) {
        pg8::Gemm g{(const bf16*)(ws + WS_MIX), (const bf16*)(ws + WS_WOUT), TOK, DM, DM, nullptr, 1 << 30};
        pg8::StaticOrder S; S.init(TOK, DM, G, (int)blockIdx.x);
        pg8::EpiResid<true> E{p.x, p.out, (bf16*)(ws + WS_XG), p.mlp_norm_w, (float*)(ws + WS_SS2)};
        pg8::gemm_phase<pg8::EpiResid<true>, pg8::StaticOrder, true, true>(lds, g, S, E, wv);
        SEAM(5); STAMP(5 + 1);
    }
    PHASE(6) {
        pg8::Gemm g{(const bf16*)(ws + WS_XG), (const bf16*)(ws + WS_WUP), TOK, DFF, DM, nullptr, 1 << 30};
        pg8::StaticOrder S; S.init(TOK, DFF, G, (int)blockIdx.x);
        pg8::EpiUp E{(const float*)(ws + WS_SS2), (bf16*)(ws + WS_HID)};
        pg8::gemm_phase<pg8::EpiUp, pg8::StaticOrder, true, true>(lds, g, S, E, wv);
        SEAM(6); STAMP(6 + 1);
    }
    PHASE(7) {
        pg8::Gemm g{(const bf16*)(ws + WS_HID), (const bf16*)(ws + WS_WDN), TOK, DM, DFF, nullptr, 1 << 30};
        pg8::StaticOrder S; S.init(TOK, DM, G, (int)blockIdx.x);
        pg8::EpiResid<false> E{p.out, p.out, nullptr, nullptr, (float*)(ws + WS_SS3)};
        pg8::gemm_phase<pg8::EpiResid<false>, pg8::StaticOrder, true, true>(lds, g, S, E, wv);
        SEAM(7); STAMP(7 + 1);
    }
#ifdef EXTRA_SYNCS
#if MK_ONE_LAUNCH
    for (int es_ = 0; es_ < EXTRA_SYNCS; ++es_) xcd_barrier(xbar, wv);
#endif
#endif
    PHASE(8) { phase_final(p, G, wv); }
#undef PHASE
#undef REPS
#undef IN
#undef SEAM
}

extern "C" void kernel_launch(void* const* d_in, const int* in_sizes, int n_in, void* d_out, int out_size, void* d_ws, size_t ws_size, hipStream_t stream) {
    static int grid = 0;
    if (grid == 0) {
        if (n_in != 13 || in_sizes[0] != TOK * DM || out_size != TOK * DM || ws_size < WS_NEED) {
            fprintf(stderr, "kernel_launch: unexpected shapes (n_in %d, in0 %d, out %d, ws %zu); nothing launched\n", n_in, n_in > 0 ? in_sizes[0] : -1, out_size, ws_size); grid = -1; return; }
        int dev = 0, cus = 0, per_cu = 0;
        (void)hipGetDevice(&dev); (void)hipDeviceGetAttribute(&cus, hipDeviceAttributeMultiprocessorCount, dev);
        if (hipFuncSetAttribute((const void*)mk_fwd, hipFuncAttributeMaxDynamicSharedMemorySize, LDS_BYTES) != hipSuccess) { fprintf(stderr, "kernel_launch: hipFuncSetAttribute failed\n"); grid = -1; return; }
        if (hipOccupancyMaxActiveBlocksPerMultiprocessor(&per_cu, (const void*)mk_fwd, NTHREADS, LDS_BYTES) != hipSuccess || per_cu < 1) { fprintf(stderr, "kernel_launch: occupancy query says %d blocks per CU\n", per_cu); per_cu = 1; }
        (void)hipGetLastError();
        if (per_cu > 1) per_cu = 1;
        grid = cus * per_cu;
    }
    if (grid < 0) return;
    Params p{};
    p.x = (const float*)d_in[0]; p.attn_norm_w = (const float*)d_in[1]; p.w_in = (const float*)d_in[2]; p.ikw = (const float*)d_in[3]; p.ikb = (const float*)d_in[4];
    p.sinks = (const float*)d_in[5]; p.w_a = (const float*)d_in[6]; p.w_b = (const float*)d_in[7]; p.w_out = (const float*)d_in[8]; p.mlp_norm_w = (const float*)d_in[9];
    p.w_up = (const float*)d_in[10]; p.w_down = (const float*)d_in[11]; p.final_w = (const float*)d_in[12];
    p.out = (float*)d_out; p.ws = (unsigned char*)d_ws;
    for (int i = 0; i < 32; ++i) p.inv_freq[i] = 1.0f / powf(10000.0f, (float)(2 * i) / 64.0f);
#if MK_ONE_LAUNCH
    if (hipMemsetAsync((char*)d_ws + WS_BAR, 0, 16384, stream) != hipSuccess) { fprintf(stderr, "kernel_launch: hipMemsetAsync of the barrier words failed\n"); return; }
    p.ph_lo = 0; p.ph_hi = NPHASE;
    void* args[] = {&p};
    hipError_t e = hipLaunchCooperativeKernel((const void*)mk_fwd, dim3(grid), dim3(NTHREADS), args, LDS_BYTES, stream);
    if (e != hipSuccess) fprintf(stderr, "kernel_launch: cooperative launch failed: %s (grid %d)\n", hipGetErrorString(e), grid);
#else
    for (int ph = 0; ph < NPHASE; ++ph) {
        p.ph_lo = ph; p.ph_hi = ph + 1;
        hipLaunchKernelGGL(mk_fwd, dim3(grid), dim3(NTHREADS), LDS_BYTES, stream, p);
    }
#endif
}
```

```cpp
#include <hip/hip_runtime.h>
#include <hip/hip_cooperative_groups.h>
#include <cstdio>
#include <cstdint>
namespace cg = cooperative_groups;

#ifndef MK_ONE_LAUNCH
#define MK_ONE_LAUNCH 1
#endif
#ifndef MK_SIMPLE_TOPK
#define MK_SIMPLE_TOPK 0
#endif
#ifndef MK_SIMPLE_SWA
#define MK_SIMPLE_SWA 0
#endif
#ifndef MK_SIMPLE_DSA
#define MK_SIMPLE_DSA 0
#endif

constexpr int NBATCH = 8, SEQ = 4096, DM = 1024, TOK = NBATCH * SEQ, DFF = 4096, TOPK = 256, WIN = 128;
constexpr int NIN = 4352;
constexpr float RMS_EPS = 1e-6f, LN_EPS = 1e-6f;
constexpr float QSCALE = 0.125f * 1.4426950408889634f;
constexpr float LOG2E = 1.4426950408889634f;
constexpr float W_SCALE = 0.04419417382415922f;
constexpr int C_AQ = 0, C_AK = 512, C_AV = 640, C_IQ = 768, C_IK = 1280, C_IW = 1344, C_BQ = 1352, C_BK = 1864, C_BV = 1992, C_GA = 2120, C_GB = 3144, D_IN = 4168;

constexpr size_t MiB = 1u << 20;
constexpr size_t WS_RSTD1 = 0, WS_SS2 = 128 * 1024, WS_SS3 = 256 * 1024;
constexpr size_t WS_BAR = 512 * 1024;
constexpr int XB_LDS_OFF = 163832;
constexpr size_t WS_COS = 1 * MiB, WS_SIN = 1 * MiB + 512 * 1024;
constexpr size_t WS_WIN = 2 * MiB, WS_WAB = 11 * MiB, WS_WOUT = 13 * MiB, WS_WUP = 15 * MiB, WS_WDN = 23 * MiB;
constexpr size_t WS_XG = 32 * MiB;
constexpr size_t WS_AQ = 96 * MiB, WS_IQ = 128 * MiB, WS_BQ = 160 * MiB, WS_AK = 192 * MiB, WS_AV = 200 * MiB, WS_BK = 208 * MiB, WS_BV = 216 * MiB;
constexpr size_t WS_IK = 224 * MiB, WS_IW = 228 * MiB, WS_SEL = 230 * MiB, WS_GA = 248 * MiB, WS_GB = 312 * MiB, WS_MIX = 376 * MiB, WS_END = 440 * MiB;
#ifndef MK_SEPARATE_O
#define MK_SEPARATE_O 0
#endif
#ifndef REP_MASK
#define REP_MASK 0u
#endif
constexpr size_t WS_OA = MK_SEPARATE_O ? 440 * MiB : WS_AQ, WS_OB = MK_SEPARATE_O ? 472 * MiB : WS_BQ, WS_NEED = MK_SEPARATE_O ? 504 * MiB : WS_END;
constexpr size_t WS_HID = 96 * MiB;
static_assert(WS_WIN + (size_t)NIN * DM * 2 <= WS_WAB && WS_HID + (size_t)TOK * DFF * 2 <= WS_MIX, "ws map");

constexpr int LDS_RING = 131072, LDS_BYTES = 163840;

#define GAS __attribute__((address_space(1)))
#define LAS __attribute__((address_space(3)))
typedef unsigned short bf16;
typedef unsigned v4u __attribute__((ext_vector_type(4)));
typedef unsigned v2u __attribute__((ext_vector_type(2)));
typedef float v4f __attribute__((ext_vector_type(4)));

__device__ __forceinline__ float bf2f(unsigned short u) { return __uint_as_float((unsigned)u << 16); }
__device__ __forceinline__ float bflo(unsigned u) { return __uint_as_float(u << 16); }
__device__ __forceinline__ float bfhi(unsigned u) { return __uint_as_float(u & 0xffff0000u); }
__device__ __forceinline__ unsigned f2bf(float f) { unsigned u = __float_as_uint(f); return (u + 0x7fffu + ((u >> 16) & 1u)) >> 16; }
__device__ __forceinline__ unsigned pk2(float lo, float hi) { unsigned r; asm volatile("v_cvt_pk_bf16_f32 %0, %1, %2" : "=v"(r) : "v"(lo), "v"(hi)); return r; }
__device__ __forceinline__ float fexp2(float x) { return __builtin_amdgcn_exp2f(x); }
__device__ __forceinline__ float frsq(float x) { return __builtin_amdgcn_rsqf(x); }
__device__ __forceinline__ float frcp(float x) { return __builtin_amdgcn_rcpf(x); }
__device__ __forceinline__ float sigmoidf_(float x) { return frcp(1.0f + fexp2(-x * LOG2E)); }
__device__ __forceinline__ float wave_sum(float v) {
#pragma unroll
    for (int o = 1; o < 64; o <<= 1) v += __shfl_xor(v, o);
    return v;
}
__device__ __forceinline__ float wave_max(float v) {
#pragma unroll
    for (int o = 1; o < 64; o <<= 1) v = fmaxf(v, __shfl_xor(v, o));
    return v;
}
__device__ __forceinline__ int lane_id() { unsigned m = ~0u; asm volatile("" : "+s"(m)); return __builtin_amdgcn_mbcnt_hi(m, __builtin_amdgcn_mbcnt_lo(m, 0u)); }
__device__ __forceinline__ int tid_op(int wv) { return wv * 64 + lane_id(); }
__device__ __forceinline__ int mbcnt64(unsigned long long m) { return __builtin_amdgcn_mbcnt_hi((unsigned)(m >> 32), __builtin_amdgcn_mbcnt_lo((unsigned)m, 0u)); }

namespace pg8 {
#define PG8_LAS __attribute__((address_space(3)))
typedef unsigned short bf16_t;
typedef short bf16x8 __attribute__((ext_vector_type(8)));
typedef float f32x4 __attribute__((ext_vector_type(4)));
typedef unsigned u32x4 __attribute__((ext_vector_type(4)));
constexpr int BM = 256, BK = 64, HALF = 128, HTB = HALF * BK * 2  , STAGE_BYTES = 8 * HTB, NXCD = 8, WGM = 8;

__host__ __device__ __forceinline__ int lds_byte(int r, int c) { const int st = (r >> 4) * 2 + (c >> 5), rr = r & 15, cc = c & 31, ob = rr * 64 + cc * 2; return st * 1024 + (ob ^ (((ob >> 9) & 1) << 5)); }
__host__ __device__ __forceinline__ void stage_rc(int b, int& R, int& C) { const int st = b / 1024, sb = b % 1024, swz = sb ^ (((sb >> 9) & 1) << 5); R = (st >> 1) * 16 + swz / 64; C = (st & 1) * 32 + (swz % 64) / 2; }
__host__ __device__ __forceinline__ int perm32(int rho) { const int n = rho >> 4, i = rho & 15; return 8 * (i >> 2) + 4 * n + (i & 3); }

struct Unit { int pm, pn; };
struct Gemm { const bf16_t* A; const bf16_t* Bt; int M, N, K; const bf16_t* A2; int asplit;
    __device__ __forceinline__ const char* abase(const Unit& u) const { return (const char*)(u.pn >= asplit ? A2 : A); } };

struct StaticOrder {
    int nM, nN, nwg, G, c;
    __host__ __device__ void init(int M, int N, int G_, int c_) { nM = M / BM; nN = N / BM; nwg = nM * nN; G = G_; c = c_; }
    __host__ __device__ bool next(int i, Unit& u) const {
        const long L = (long)i * G + c; if (L >= nwg) return false;
        int wgid = (int)L; { const int q = nwg / NXCD, r = nwg % NXCD, xcd = wgid % NXCD, off = wgid / NXCD; wgid = (xcd < r ? xcd * (q + 1) : r * (q + 1) + (xcd - r) * q) + off; }
        const int nig = WGM * nN, gid = wgid / nig, fm = gid * WGM, gsz = (nM - fm) < WGM ? (nM - fm) : WGM;
        u.pm = fm + ((wgid % nig) % gsz); u.pn = (wgid % nig) / gsz; return true;
    }
    __device__ __forceinline__ void a_ready(const Unit&) const {}
    __device__ __forceinline__ void done(const Unit&) const {}
};

__device__ __forceinline__ unsigned cvt_pk_bf16(float lo, float hi) { unsigned r; asm volatile("v_cvt_pk_bf16_f32 %0, %1, %2" : "=v"(r) : "v"(lo), "v"(hi)); return r; }
__device__ __forceinline__ u32x4 pack8(const float (&v)[8]) { u32x4 w; w.x = cvt_pk_bf16(v[0], v[1]); w.y = cvt_pk_bf16(v[2], v[3]); w.z = cvt_pk_bf16(v[4], v[5]); w.w = cvt_pk_bf16(v[6], v[7]); return w; }

struct EpiInProj {
    static constexpr bool PERM = true, AFTER_DRAIN = false;
    const float* rstd1; const float* cs; const float* sn; unsigned char* ws; const float* ikw; const float* ikb;
    __device__ __forceinline__ void operator()(const f32x4 (&acc)[2][2][4][2], const Unit& u, int wr, int wc, int fr_, int fq_) const {
        const int pn = u.pn; int fr = fr_, fq = fq_;
        asm volatile("" : "+v"(fr), "+v"(fq));
#pragma unroll
        for (int ai = 0; ai < 2; ++ai)
#pragma unroll
            for (int m = 0; m < 4; ++m) {
                const int row = u.pm * BM + ai * HALF + wr * 64 + m * 16 + fr;
                const float rs = rstd1[row];
                float x1[8], x2[8];
#pragma unroll
                for (int j = 0; j < 4; ++j) { x1[j] = acc[ai][0][m][0][j] * rs; x1[4 + j] = acc[ai][0][m][1][j] * rs; x2[j] = acc[ai][1][m][0][j] * rs; x2[4 + j] = acc[ai][1][m][1][j] * rs; }
                if (pn >= 9) {
                    bf16_t* G = (bf16_t*)(ws + WS_GA + (size_t)((pn - 9) >> 2) * (WS_GB - WS_GA)) + (size_t)row * 1024 + 256 * ((pn - 9) & 3) + 32 * wc + 8 * fq;
                    float a[8], b[8];
#pragma unroll
                    for (int j = 0; j < 8; ++j) { a[j] = 1.0f / (1.0f + __builtin_amdgcn_exp2f(-x1[j] * 1.4426950408889634f)); b[j] = 1.0f / (1.0f + __builtin_amdgcn_exp2f(-x2[j] * 1.4426950408889634f)); }
                    *(u32x4*)G = pack8(a); *(u32x4*)(G + 128) = pack8(b);
                } else if (pn == 8) {
                    if (wc == 0) {
                        float s = 0.f;
#pragma unroll
                        for (int j = 0; j < 8; ++j) s += x1[j] + x2[j];
                        s += __shfl_xor(s, 16); s += __shfl_xor(s, 32);
                        const float mu = s * (1.0f / 64.0f); float q = 0.f;
#pragma unroll
                        for (int j = 0; j < 8; ++j) { x1[j] -= mu; x2[j] -= mu; q += x1[j] * x1[j] + x2[j] * x2[j]; }
                        q += __shfl_xor(q, 16); q += __shfl_xor(q, 32);
                        const float rstd = __builtin_amdgcn_rsqf(q * (1.0f / 64.0f) + 1e-6f);
                        const int pos = row & 4095; const float* cp = cs + pos * 32 + 8 * fq; const float* sp = sn + pos * 32 + 8 * fq;
                        float o1[8], o2[8];
#pragma unroll
                        for (int j = 0; j < 8; ++j) { const float y1 = x1[j] * rstd * ikw[8 * fq + j] + ikb[8 * fq + j], y2 = x2[j] * rstd * ikw[32 + 8 * fq + j] + ikb[32 + 8 * fq + j];
                            const float c = cp[j], sI = sp[j]; o1[j] = y1 * c - y2 * sI; o2[j] = y2 * c + y1 * sI; }
                        unsigned char* tb = ws + WS_IK + (size_t)(row >> 5) * 4096 + (size_t)(row & 31) * 16;
                        *(u32x4*)(tb + (fq >> 1) * 1024 + (fq & 1) * 512) = pack8(o1); *(u32x4*)(tb + (2 + (fq >> 1)) * 1024 + (fq & 1) * 512) = pack8(o2);
                    } else if (wc == 1 && fq == 0) {
                        float* dst = (float*)(ws + WS_IW) + (size_t)row * 8;
                        *(f32x4*)dst = (f32x4){x1[0], x1[1], x1[2], x1[3]} * 0.04419417382415922f; *(f32x4*)(dst + 4) = (f32x4){x1[4], x1[5], x1[6], x1[7]} * 0.04419417382415922f;
                    }
                } else if (pn >= 6) {
                    bf16_t* Kd = (bf16_t*)(ws + WS_AK + (size_t)(pn - 6) * (WS_BK - WS_AK)); bf16_t* Vd = (bf16_t*)(ws + WS_AV + (size_t)(pn - 6) * (WS_BV - WS_AV));
                    if (wc < 2) {
                        const int pos = row & 4095; const float* cp = cs + pos * 32 + 8 * fq; const float* sp = sn + pos * 32 + 8 * fq;
                        float o1[8], o2[8];
#pragma unroll
                        for (int j = 0; j < 8; ++j) { const float c = cp[j], sI = sp[j]; o1[j] = x1[j] * c - x2[j] * sI; o2[j] = x2[j] * c + x1[j] * sI; }
                        bf16_t* dst = Kd + (size_t)row * 128 + wc * 64 + 8 * fq;
                        *(u32x4*)dst = pack8(o1); *(u32x4*)(dst + 32) = pack8(o2);
                    } else {
                        bf16_t* dst = Vd + (size_t)row * 128 + 32 * (wc - 2) + 8 * fq;
                        *(u32x4*)dst = pack8(x1); *(u32x4*)(dst + 64) = pack8(x2);
                    }
                } else {
                    bf16_t* Q = (bf16_t*)(ws + WS_AQ + (size_t)(pn >> 1) * (WS_IQ - WS_AQ)); const float sc = (pn >= 2 && pn < 4) ? 1.0f : 0.125f * 1.4426950408889634f;
                    const int pos = row & 4095; const float* cp = cs + pos * 32 + 8 * fq; const float* sp = sn + pos * 32 + 8 * fq;
                    float o1[8], o2[8];
#pragma unroll
                    for (int j = 0; j < 8; ++j) { const float c = cp[j], sI = sp[j]; o1[j] = (x1[j] * c - x2[j] * sI) * sc; o2[j] = (x2[j] * c + x1[j] * sI) * sc; }
                    bf16_t* dst = Q + (size_t)row * 512 + (4 * (pn & 1) + wc) * 64 + 8 * fq;
                    *(u32x4*)dst = pack8(o1); *(u32x4*)(dst + 32) = pack8(o2);
                }
                asm volatile("" ::: "memory");
            }
    }
};

struct EpiGate {
    static constexpr bool PERM = true, AFTER_DRAIN = false;
    const bf16_t *GA, *GB; float* P; bf16_t* MIX;
    __device__ __forceinline__ void operator()(const f32x4 (&acc)[2][2][4][2], const Unit& u, int wr, int wc, int fr, int fq) const {
        const bool second = u.pn >= 4; const bf16_t* G = second ? GB : GA;
#pragma unroll
        for (int ai = 0; ai < 2; ++ai)
#pragma unroll
            for (int m = 0; m < 4; ++m) {
                const int row = u.pm * BM + ai * HALF + wr * 64 + m * 16 + fr;
#pragma unroll
                for (int bj = 0; bj < 2; ++bj) {
                    const size_t off = (size_t)row * 1024 + 256 * (u.pn & 3) + 128 * bj + 32 * wc + 8 * fq;
                    const u32x4 gw = *(const u32x4*)(G + off);
                    float v[8];
#pragma unroll
                    for (int j = 0; j < 4; ++j) { v[j] = acc[ai][bj][m][0][j]; v[4 + j] = acc[ai][bj][m][1][j]; }
                    v[0] *= __uint_as_float(gw.x << 16); v[1] *= __uint_as_float(gw.x & 0xffff0000u); v[2] *= __uint_as_float(gw.y << 16); v[3] *= __uint_as_float(gw.y & 0xffff0000u);
                    v[4] *= __uint_as_float(gw.z << 16); v[5] *= __uint_as_float(gw.z & 0xffff0000u); v[6] *= __uint_as_float(gw.w << 16); v[7] *= __uint_as_float(gw.w & 0xffff0000u);
                    if (!second) { *(f32x4*)(P + off) = (f32x4){v[0], v[1], v[2], v[3]}; *(f32x4*)(P + off + 4) = (f32x4){v[4], v[5], v[6], v[7]}; }
                    else { const f32x4 p0 = *(const f32x4*)(P + off), p1 = *(const f32x4*)(P + off + 4);
#pragma unroll
                        for (int j = 0; j < 4; ++j) { v[j] += p0[j]; v[4 + j] += p1[j]; }
                        *(u32x4*)(MIX + off) = pack8(v); }
                }
            }
    }
};

template <bool WITH_XG> struct EpiResid {
    static constexpr bool PERM = false, AFTER_DRAIN = false;
    const float* base; float* out; bf16_t* XG; const float* gw; float* ss;
    __device__ __forceinline__ void operator()(const f32x4 (&acc)[2][2][4][2], const Unit& u, int wr, int wc, int fr, int fq) const {
#pragma unroll
        for (int ai = 0; ai < 2; ++ai)
#pragma unroll
            for (int m = 0; m < 4; ++m) {
                const int row = u.pm * BM + ai * HALF + wr * 64 + m * 16 + fr; float s = 0.f;
#pragma unroll
                for (int bj = 0; bj < 2; ++bj)
#pragma unroll
                    for (int n = 0; n < 2; ++n) {
                        const int col = u.pn * BM + bj * HALF + wc * 32 + n * 16 + 4 * fq; const size_t off = (size_t)row * 1024 + col;
                        const f32x4 v = *(const f32x4*)(base + off) + acc[ai][bj][m][n];
                        *(f32x4*)(out + off) = v; s += (v[0] * v[0] + v[1] * v[1]) + (v[2] * v[2] + v[3] * v[3]);
                        if (WITH_XG) { const f32x4 g = *(const f32x4*)(gw + col); unsigned long long w = (unsigned long long)cvt_pk_bf16(v[0] * g[0], v[1] * g[1]) | ((unsigned long long)cvt_pk_bf16(v[2] * g[2], v[3] * g[3]) << 32);
                            *(unsigned long long*)(XG + off) = w; }
                    }
                s += __shfl_xor(s, 16); s += __shfl_xor(s, 32);
                if (fq == 0) atomicAdd(ss + row, s);
            }
    }
};

struct EpiUp {
    static constexpr bool PERM = true, AFTER_DRAIN = false;
    const float* ss; bf16_t* HID;
    __device__ __forceinline__ void operator()(const f32x4 (&acc)[2][2][4][2], const Unit& u, int wr, int wc, int fr, int fq) const {
#pragma unroll
        for (int ai = 0; ai < 2; ++ai)
#pragma unroll
            for (int m = 0; m < 4; ++m) {
                const int row = u.pm * BM + ai * HALF + wr * 64 + m * 16 + fr;
                const float rs = __builtin_amdgcn_rsqf(ss[row] * (1.0f / 1024.0f) + 1e-6f);
#pragma unroll
                for (int bj = 0; bj < 2; ++bj) {
                    float v[8];
#pragma unroll
                    for (int j = 0; j < 4; ++j) { float a = fmaxf(acc[ai][bj][m][0][j] * rs, 0.f), b = fmaxf(acc[ai][bj][m][1][j] * rs, 0.f); v[j] = a * a; v[4 + j] = b * b; }
                    *(u32x4*)(HID + (size_t)row * 4096 + u.pn * BM + bj * HALF + wc * 32 + 8 * fq) = pack8(v);
                }
            }
    }
};

struct BranchOrder {
    int G, c;
    __device__ __forceinline__ bool next(int i, Unit& u) const {
        const int tile = (i >> 1) * G + c; if (tile >= 128 * 4) return false;
        u.pm = tile >> 2; u.pn = (tile & 3) + 4 * (i & 1); return true;
    }
    __device__ __forceinline__ void a_ready(const Unit&) const {}
    __device__ __forceinline__ void done(const Unit&) const {}
};

template <class Epi, class Sched, bool ALIGN_EPI = false, bool SP2 = false>
__device__ __forceinline__ void gemm_phase(PG8_LAS unsigned char* lds, const Gemm g, const Sched& S, const Epi& E, int wv) {
    const int tid = tid_op(wv), wid = wv, lane = tid & 63, wr = wid >> 2, wc = wid & 3, fr = lane & 15, fq = lane >> 4;
    const int K = g.K, nt = K / BK;
    unsigned voffA[2], voffB[2];
#pragma unroll
    for (int i = 0; i < 2; ++i) { int R, C; stage_rc(tid * 16 + i * 8192, R, C); const int Rb = Epi::PERM ? ((R & ~31) + perm32(R & 31)) : R;
        voffA[i] = (unsigned)(R * K + C) * 2u; voffB[i] = (unsigned)(Rb * K + C) * 2u; }
    const size_t kstep = (size_t)(BK * 2);
    const size_t hstep = (size_t)HALF * K * 2;
    const size_t tstep = 2 * hstep;
    const unsigned ldsw = (unsigned)wid * 1024u;
    const int aoff = lds_byte(wr * 64 + fr, fq * 8), boff = lds_byte(wc * 32 + fr, fq * 8);
#define PG8_SA(b, h) (((b) * 2 + (h)) * HTB)
#define PG8_SB(b, h) ((4 + (b) * 2 + (h)) * HTB)
#define PG8_STAGE(bufoff, gbase, voff) do { _Pragma("unroll") for (int _i = 0; _i < 2; ++_i) \
        __builtin_amdgcn_global_load_lds((const unsigned*)((const char*)(gbase) + (voff)[_i]), (PG8_LAS unsigned*)(lds + (bufoff) + ldsw + _i * 8192), 16, 0, 0); } while (0)
#define PG8_LDA(dst, b, h) do { _Pragma("unroll") for (int m = 0; m < 4; ++m) _Pragma("unroll") for (int k = 0; k < 2; ++k) dst[m][k] = *(const PG8_LAS bf16x8*)(lds + PG8_SA(b, h) + aoff + m * 2048 + k * 1024); } while (0)
#define PG8_LDB(dst, b, h) do { _Pragma("unroll") for (int n = 0; n < 2; ++n) _Pragma("unroll") for (int k = 0; k < 2; ++k) dst[n][k] = *(const PG8_LAS bf16x8*)(lds + PG8_SB(b, h) + boff + n * 2048 + k * 1024); } while (0)
#define PG8_MMA(ai, bj, At, Bt) do { __builtin_amdgcn_s_setprio(1); _Pragma("unroll") for (int m = 0; m < 4; ++m) _Pragma("unroll") for (int n = 0; n < 2; ++n) _Pragma("unroll") for (int k = 0; k < 2; ++k) \
        acc[ai][bj][m][n] = __builtin_amdgcn_mfma_f32_16x16x32_bf16(Bt[n][k], At[m][k], acc[ai][bj][m][n], 0, 0, 0); __builtin_amdgcn_s_setprio(0); } while (0)
#define PG8_WAIT_V(n) asm volatile("s_waitcnt vmcnt(" #n ")" ::: "memory")
#define PG8_WAIT_L(n) asm volatile("s_waitcnt lgkmcnt(" #n ")" ::: "memory")
#define PG8_BAR __builtin_amdgcn_s_barrier()
#define PG8_SCHED __builtin_amdgcn_sched_barrier(0)
    Unit cur, nxt; int ui = 0;
    if (!S.next(0, cur)) return;
    f32x4 acc[2][2][4][2];
#pragma unroll
    for (int a = 0; a < 2; ++a)
#pragma unroll
        for (int b = 0; b < 2; ++b)
#pragma unroll
            for (int m = 0; m < 4; ++m)
#pragma unroll
                for (int n = 0; n < 2; ++n) acc[a][b][m][n] = (f32x4){0.f, 0.f, 0.f, 0.f};
    bf16x8 At[4][2], B0[2][2], B1[2][2];
    const char* cA = g.abase(cur) + (size_t)cur.pm * tstep; const char* cB = (const char*)g.Bt + (size_t)cur.pn * tstep;
    S.a_ready(cur);
    if constexpr (SP2) {
        PG8_STAGE(PG8_SB(0, 0), cB, voffB); PG8_STAGE(PG8_SB(0, 1), cB + hstep, voffB); PG8_STAGE(PG8_SA(0, 0), cA, voffA); PG8_STAGE(PG8_SA(0, 1), cA + hstep, voffA);
        if (wr == 1) PG8_BAR;
        PG8_WAIT_V(2); PG8_BAR;
        PG8_STAGE(PG8_SB(1, 0), cB + kstep, voffB); PG8_STAGE(PG8_SA(1, 0), cA + kstep, voffA); PG8_STAGE(PG8_SB(1, 1), cB + hstep + kstep, voffB);
        PG8_WAIT_V(6); PG8_BAR;
    } else {
        PG8_STAGE(PG8_SB(0, 0), cB, voffB); PG8_STAGE(PG8_SA(0, 0), cA, voffA); PG8_STAGE(PG8_SB(0, 1), cB + hstep, voffB); PG8_STAGE(PG8_SA(0, 1), cA + hstep, voffA);
        if (wr == 1) PG8_BAR;
        PG8_WAIT_V(4); PG8_BAR;
        PG8_STAGE(PG8_SB(1, 0), cB + kstep, voffB); PG8_STAGE(PG8_SA(1, 0), cA + kstep, voffA); PG8_STAGE(PG8_SB(1, 1), cB + hstep + kstep, voffB);
        PG8_WAIT_V(6); PG8_BAR;
    }
    for (;;) {
        const bool has_next = S.next(ui + 1, nxt);
        const char* nA = has_next ? g.abase(nxt) + (size_t)nxt.pm * tstep : cA; const char* nB = has_next ? (const char*)g.Bt + (size_t)nxt.pn * tstep : cB;
        for (int t = 0; t < nt; t += 2) {
            const bool last = (t == nt - 2);
            const char* a1 = cA + (size_t)(t + 1) * kstep;
            const char* a2 = last ? nA : cA + (size_t)(t + 2) * kstep; const char* b2 = last ? nB : cB + (size_t)(t + 2) * kstep;
            const char* a3 = a2 + kstep; const char* b3 = b2 + kstep;
            if (last && has_next) S.a_ready(nxt);
            if constexpr (SP2) {
            PG8_LDB(B0, 0, 0); PG8_LDB(B1, 0, 1); PG8_SCHED; PG8_LDA(At, 0, 0); PG8_STAGE(PG8_SA(1, 1), a1 + hstep, voffA);
            PG8_WAIT_V(8); PG8_WAIT_L(0); PG8_BAR; PG8_MMA(0, 0, At, B0); PG8_MMA(0, 1, At, B1); PG8_BAR; PG8_SCHED;
            PG8_LDA(At, 0, 1); PG8_STAGE(PG8_SB(0, 0), b2, voffB); PG8_STAGE(PG8_SB(0, 1), b2 + hstep, voffB); PG8_STAGE(PG8_SA(0, 0), a2, voffA);
            PG8_WAIT_V(8); PG8_WAIT_L(0); PG8_BAR; PG8_MMA(1, 0, At, B0); PG8_MMA(1, 1, At, B1); PG8_BAR; PG8_SCHED;
            PG8_LDB(B0, 1, 0); PG8_LDB(B1, 1, 1); PG8_SCHED; PG8_LDA(At, 1, 0); PG8_STAGE(PG8_SA(0, 1), a2 + hstep, voffA);
            PG8_WAIT_V(8); PG8_WAIT_L(0); PG8_BAR; PG8_MMA(0, 0, At, B0); PG8_MMA(0, 1, At, B1); PG8_BAR; PG8_SCHED;
            PG8_LDA(At, 1, 1); PG8_STAGE(PG8_SB(1, 0), b3, voffB); PG8_STAGE(PG8_SB(1, 1), b3 + hstep, voffB); PG8_STAGE(PG8_SA(1, 0), a3, voffA);
            PG8_WAIT_V(8); PG8_WAIT_L(0); PG8_BAR; PG8_MMA(1, 0, At, B0); PG8_MMA(1, 1, At, B1); PG8_BAR; PG8_SCHED;
            } else {
            PG8_LDB(B0, 0, 0); PG8_SCHED; PG8_LDA(At, 0, 0); PG8_STAGE(PG8_SA(1, 1), a1 + hstep, voffA);
            PG8_WAIT_L(8); PG8_BAR; PG8_WAIT_L(0); PG8_MMA(0, 0, At, B0); PG8_BAR; PG8_SCHED;
            PG8_LDB(B1, 0, 1); PG8_STAGE(PG8_SB(0, 0), b2, voffB);
            PG8_BAR; PG8_WAIT_L(0); PG8_MMA(0, 1, At, B1); PG8_BAR;
            PG8_LDA(At, 0, 1); PG8_STAGE(PG8_SA(0, 0), a2, voffA);
            PG8_BAR; PG8_WAIT_L(0); PG8_MMA(1, 0, At, B0); PG8_BAR; PG8_SCHED;
            PG8_STAGE(PG8_SB(0, 1), b2 + hstep, voffB);
            PG8_WAIT_V(6); PG8_BAR; PG8_MMA(1, 1, At, B1); PG8_BAR;
            PG8_LDB(B0, 1, 0); PG8_SCHED; PG8_LDA(At, 1, 0); PG8_STAGE(PG8_SA(0, 1), a2 + hstep, voffA);
            PG8_WAIT_L(8); PG8_BAR; PG8_WAIT_L(0); PG8_MMA(0, 0, At, B0); PG8_BAR; PG8_SCHED;
            PG8_LDB(B1, 1, 1); PG8_STAGE(PG8_SB(1, 0), b3, voffB);
            PG8_BAR; PG8_WAIT_L(0); PG8_MMA(0, 1, At, B1); PG8_BAR;
            PG8_LDA(At, 1, 1); PG8_STAGE(PG8_SA(1, 0), a3, voffA);
            PG8_BAR; PG8_WAIT_L(0); PG8_MMA(1, 0, At, B0); PG8_BAR; PG8_SCHED;
            PG8_STAGE(PG8_SB(1, 1), b3 + hstep, voffB);
            PG8_WAIT_V(6); PG8_BAR; PG8_MMA(1, 1, At, B1); PG8_BAR;
            }
        }
        if constexpr (ALIGN_EPI) { if (wr == 0) PG8_BAR; }
        if constexpr (!Epi::AFTER_DRAIN) { E(acc, cur, wr, wc, fr, fq); S.done(cur); }
        if (!has_next) break;
#pragma unroll
        for (int a = 0; a < 2; ++a)
#pragma unroll
            for (int b = 0; b < 2; ++b)
#pragma unroll
                for (int m = 0; m < 4; ++m)
#pragma unroll
                    for (int n = 0; n < 2; ++n) acc[a][b][m][n] = (f32x4){0.f, 0.f, 0.f, 0.f};
        cur = nxt; cA = nA; cB = nB; ++ui;
        if constexpr (ALIGN_EPI) { if (wr == 1) PG8_BAR; }
    }
    PG8_WAIT_V(0);
    if constexpr (!ALIGN_EPI) { if (wr == 0) PG8_BAR; }
    PG8_BAR;
    if constexpr (Epi::AFTER_DRAIN) { E.fused(acc, cur, wr, wc, fr, fq, lds, wid, lane); S.done(cur); }
#undef PG8_SA
#undef PG8_SB
#undef PG8_STAGE
#undef PG8_LDA
#undef PG8_LDB
#undef PG8_MMA
#undef PG8_WAIT_V
#undef PG8_WAIT_L
#undef PG8_BAR
#undef PG8_SCHED
}
}
struct Params {
    const float *x, *attn_norm_w, *w_in, *ikw, *ikb, *sinks, *w_a, *w_b, *w_out, *mlp_norm_w, *w_up, *w_down, *final_w;
    float* out; unsigned char* ws;
    float inv_freq[32];
    int ph_lo, ph_hi;
};
constexpr int NWAVES = 8, NTHREADS = 512;

__device__ __forceinline__ int win_src_group(int grp, int& cnt) {
    const int tile = grp >> 3, g = grp & 7; cnt = 32;
    if (tile < 6) { const int base = tile < 2 ? C_AQ : (tile < 4 ? C_IQ : C_BQ); const int head = 4 * (tile & 1) + (g & 3); return base + head * 64 + 32 * (g >> 2); }
    if (tile < 8) { const int kb = tile == 6 ? C_AK : C_BK, vb = tile == 6 ? C_AV : C_BV; const int hf = g >> 2, q = g & 3;
        if (q < 2) return kb + q * 64 + 32 * hf; return vb + 64 * hf + 32 * (q - 2); }
    if (tile == 8) { if (g == 0) return C_IK; if (g == 4) return C_IK + 32; if (g == 1) { cnt = 8; return C_IW; } cnt = 0; return 0; }
    return C_GA + (grp - 72) * 32;
}
__device__ __forceinline__ void p0_transpose_item(const float* W, int ldw, int c0, int cnt, int K, bf16* WT, int n0, int k0, LAS float* scr, int lane) {
#pragma unroll 8
    for (int i = 0; i < 32; ++i) { const int kk = 2 * i + (lane >> 5), n = lane & 31; scr[kk * 33 + n] = (n < cnt) ? W[(size_t)(k0 + kk) * ldw + c0 + n] : 0.f; }
    asm volatile("s_waitcnt lgkmcnt(0)" ::: "memory");
    const int c = lane & 7;
#pragma unroll
    for (int j = 0; j < 4; ++j) { const int n = (lane >> 3) + 8 * j; const LAS float* s = scr + (8 * c) * 33 + n;
        v4u o; o.x = pk2(s[0 * 33], s[1 * 33]); o.y = pk2(s[2 * 33], s[3 * 33]); o.z = pk2(s[4 * 33], s[5 * 33]); o.w = pk2(s[6 * 33], s[7 * 33]);
        *(v4u*)(WT + (size_t)(n0 + n) * K + k0 + 8 * c) = o; }
    asm volatile("s_waitcnt lgkmcnt(0)" ::: "memory");
}
__device__ __forceinline__ void sincos_d(float angf, float& sn, float& cs) {
    const double a = (double)angf; const double kq = __builtin_rint(a * 0.63661977236758134308);
    const double y = (a - kq * 1.57079632679489655800) - kq * 6.123233995736766e-17; const double y2 = y * y;
    double s = y * (1.0 + y2 * (-1.0 / 6 + y2 * (1.0 / 120 + y2 * (-1.0 / 5040 + y2 * (1.0 / 362880 + y2 * (-1.0 / 39916800 + y2 * (1.0 / 6227020800.0)))))));
    double c = 1.0 + y2 * (-0.5 + y2 * (1.0 / 24 + y2 * (-1.0 / 720 + y2 * (1.0 / 40320 + y2 * (-1.0 / 3628800 + y2 * (1.0 / 479001600.0 + y2 * (-1.0 / 87178291200.0)))))));
    const int q = ((int)kq) & 3;
    const double ss = (q == 0) ? s : (q == 1) ? c : (q == 2) ? -s : -c; const double cc = (q == 0) ? c : (q == 1) ? -s : (q == 2) ? -c : s;
    sn = (float)ss; cs = (float)cc;
}
__device__ __forceinline__ void phase_prologue(const Params& p, LAS unsigned char* lds, int G, int wv) {
    const int wave = wv, lane = lane_id();
    unsigned char* ws = p.ws;
    LAS float* scr = (LAS float*)(lds + wave * 16384);
    const int gw = blockIdx.x * NWAVES + wave, NGW = G * NWAVES;
    constexpr int I_IN = (DM / 64) * (NIN / 32), I_A = (512 / 64) * (DM / 32), I_O = (DM / 64) * (DM / 32), I_U = (DM / 64) * (DFF / 32), I_D = (DFF / 64) * (DM / 32);
    constexpr int NITEMS = I_IN + 2 * I_A + I_O + I_U + I_D;
    for (int it = gw; it < NITEMS; it += NGW) {
        int r = it;
        if (r < I_IN) { const int grp = r % (NIN / 32), kb = r / (NIN / 32); int cnt; const int c0 = win_src_group(grp, cnt);
            p0_transpose_item(p.w_in, D_IN, c0, cnt, DM, (bf16*)(ws + WS_WIN), grp * 32, kb * 64, scr, lane); continue; } r -= I_IN;
        if (r < I_A) { const int nb = r % 32, kb = r / 32; p0_transpose_item(p.w_a, DM, nb * 32, 32, 512, (bf16*)(ws + WS_WAB), nb * 32, kb * 64, scr, lane); continue; } r -= I_A;
        if (r < I_A) { const int nb = r % 32, kb = r / 32; p0_transpose_item(p.w_b, DM, nb * 32, 32, 512, (bf16*)(ws + WS_WAB), 1024 + nb * 32, kb * 64, scr, lane); continue; } r -= I_A;
        if (r < I_O) { const int nb = r % 32, kb = r / 32; p0_transpose_item(p.w_out, DM, nb * 32, 32, DM, (bf16*)(ws + WS_WOUT), nb * 32, kb * 64, scr, lane); continue; } r -= I_O;
        if (r < I_U) { const int nb = r % 128, kb = r / 128; p0_transpose_item(p.w_up, DFF, nb * 32, 32, DM, (bf16*)(ws + WS_WUP), nb * 32, kb * 64, scr, lane); continue; } r -= I_U;
        { const int nb = r % 32, kb = r / 32; p0_transpose_item(p.w_down, DM, nb * 32, 32, DFF, (bf16*)(ws + WS_WDN), nb * 32, kb * 64, scr, lane); }
    }
    float* COS = (float*)(ws + WS_COS); float* SIN = (float*)(ws + WS_SIN);
    for (int i = gw * 64 + lane; i < SEQ * 32; i += NGW * 64) { const int pos = i >> 5, d = i & 31; const float ang = (float)pos * p.inv_freq[d]; float s, c; sincos_d(ang, s, c); COS[i] = c; SIN[i] = s; }
    float* RSTD1 = (float*)(ws + WS_RSTD1); float* SS2 = (float*)(ws + WS_SS2); float* SS3 = (float*)(ws + WS_SS3); bf16* XG = (bf16*)(ws + WS_XG);
    v4f g[4];
#pragma unroll
    for (int j = 0; j < 4; ++j) g[j] = *((const v4f*)p.attn_norm_w + lane + 64 * j);
    for (int m = gw; m < TOK; m += NGW) {
        const v4f* xr = (const v4f*)(p.x + (size_t)m * DM) + lane; v4f v[4]; float s = 0.f;
#pragma unroll
        for (int j = 0; j < 4; ++j) { v[j] = xr[64 * j]; s += (v[j].x * v[j].x + v[j].y * v[j].y) + (v[j].z * v[j].z + v[j].w * v[j].w); }
        s = wave_sum(s);
        unsigned long long* o8 = (unsigned long long*)(XG + (size_t)m * DM) + lane;
#pragma unroll
        for (int j = 0; j < 4; ++j) o8[64 * j] = (unsigned long long)pk2(v[j].x * g[j].x, v[j].y * g[j].y) | ((unsigned long long)pk2(v[j].z * g[j].z, v[j].w * g[j].w) << 32);
        if (lane == 0) { RSTD1[m] = frsq(s * (1.0f / DM) + RMS_EPS); SS2[m] = 0.f; SS3[m] = 0.f; }
    }
}

__device__ __forceinline__ unsigned f2key(float f) { const unsigned u = __float_as_uint(f); return (u & 0x80000000u) ? ~u : (u | 0x80000000u); }
__device__ __forceinline__ void phase_topk_simple(const Params& p, LAS unsigned char* lds, int G, int wv) {
    const int wave = wv, lane = lane_id();
    unsigned char* ws = p.ws;
    const bf16* IQ = (const bf16*)(ws + WS_IQ); const bf16* IK = (const bf16*)(ws + WS_IK); const float* IW = (const float*)(ws + WS_IW);
    unsigned short* SEL = (unsigned short*)(ws + WS_SEL);
    LAS unsigned* keys = (LAS unsigned*)(lds + wave * 16384);
    LAS float* qf = (LAS float*)(lds + LDS_RING + wave * 2048);
    const int gw = blockIdx.x * NWAVES + wave, NGW = G * NWAVES;
    for (int row = gw; row < TOK; row += NGW) {
        const int b = row >> 12, t = row & 4095, n = t + 1;
        unsigned short* selrow = SEL + (size_t)row * TOPK;
        if (n <= TOPK) { for (int i = lane; i < n; i += 64) selrow[i] = (unsigned short)i; continue; }
        { const v4u q8 = *((const v4u*)(IQ + (size_t)row * 512) + lane);
            LAS float* d = qf + 8 * lane;
            d[0] = bflo(q8.x); d[1] = bfhi(q8.x); d[2] = bflo(q8.y); d[3] = bfhi(q8.y); d[4] = bflo(q8.z); d[5] = bfhi(q8.z); d[6] = bflo(q8.w); d[7] = bfhi(q8.w); }
        float w[8];
#pragma unroll
        for (int h = 0; h < 8; ++h) w[h] = IW[(size_t)row * 8 + h];
        asm volatile("s_waitcnt lgkmcnt(0)" ::: "memory");
        for (int s0 = 0; s0 < n; s0 += 64) {
            const int s = s0 + lane; const int sc = s < n ? s : t;
            const v4u* kp = (const v4u*)(IK + ((size_t)b * SEQ + sc) * 64);
            float dot[8];
#pragma unroll
            for (int h = 0; h < 8; ++h) dot[h] = 0.f;
#pragma unroll
            for (int c = 0; c < 8; ++c) {
                const v4u k8 = kp[c]; float kf[8] = {bflo(k8.x), bfhi(k8.x), bflo(k8.y), bfhi(k8.y), bflo(k8.z), bfhi(k8.z), bflo(k8.w), bfhi(k8.w)};
#pragma unroll
                for (int h = 0; h < 8; ++h) { const v4f qa = *(const LAS v4f*)(qf + h * 64 + c * 8), qb = *(const LAS v4f*)(qf + h * 64 + c * 8 + 4);
                    dot[h] += (kf[0] * qa.x + kf[1] * qa.y) + (kf[2] * qa.z + kf[3] * qa.w) + (kf[4] * qb.x + kf[5] * qb.y) + (kf[6] * qb.z + kf[7] * qb.w); }
            }
            float sc_ = 0.f;
#pragma unroll
            for (int h = 0; h < 8; ++h) sc_ += w[h] * fmaxf(dot[h], 0.f);
            keys[s] = (s < n) ? f2key(sc_) : 0u;
        }
        asm volatile("s_waitcnt lgkmcnt(0)" ::: "memory");
        const int nch = (n + 63) >> 6;
        unsigned thr = 0u;
        for (int bit = 31; bit >= 0; --bit) {
            const unsigned cand = thr | (1u << bit); int cnt = 0;
            for (int c = 0; c < nch; ++c) cnt += __popcll(__ballot(keys[c * 64 + lane] >= cand));
            if (cnt >= TOPK) thr = cand;
        }
        int cgt = 0;
        for (int c = 0; c < nch; ++c) cgt += __popcll(__ballot(keys[c * 64 + lane] > thr));
        const int need = TOPK - cgt; int pos = 0, ties = 0;
        for (int c = 0; c < nch; ++c) {
            const unsigned k = keys[c * 64 + lane]; const bool gt = k > thr, eq = k == thr;
            const unsigned long long meq = __ballot(eq);
            const bool sel = gt || (eq && (ties + mbcnt64(meq) < need));
            const unsigned long long msel = __ballot(sel);
            if (sel) selrow[pos + mbcnt64(msel)] = (unsigned short)(c * 64 + lane);
            pos += __popcll(msel); ties += __popcll(meq);
        }
    }
}

template <bool SINK, class KeyFn>
__device__ __forceinline__ void attend_wave(const bf16* Q, const bf16* K, const bf16* V, bf16* O, int row, int g, int nslots, const KeyFn& keyfn, const float* sinkv,
                                            LAS float* qf  , LAS float* pf  , LAS int* kidx  , int lane) {
    const int b = row >> 12;
    { const v2u q4 = *((const v2u*)(Q + (size_t)row * 512 + g * 256) + lane);
        LAS float* d = qf + 4 * lane; d[0] = bflo(q4.x); d[1] = bfhi(q4.x); d[2] = bflo(q4.y); d[3] = bfhi(q4.y); }
    asm volatile("s_waitcnt lgkmcnt(0)" ::: "memory");
#pragma unroll 1
    for (int j = 0; j < 4; ++j) {
        const int slot = 64 * j + lane; int key = slot < nslots ? keyfn(slot) : -1; kidx[slot] = key;
        const bool valid = key >= 0; const int kc = valid ? key : 0;
        const v4u* kp = (const v4u*)(K + ((size_t)b * SEQ + kc) * 128 + g * 64);
        float dot[4] = {0.f, 0.f, 0.f, 0.f};
        if (64 * j < nslots) {
#pragma unroll 2
            for (int c = 0; c < 8; ++c) {
                const v4u k8 = kp[c]; float kf[8] = {bflo(k8.x), bfhi(k8.x), bflo(k8.y), bfhi(k8.y), bflo(k8.z), bfhi(k8.z), bflo(k8.w), bfhi(k8.w)};
#pragma unroll
                for (int h = 0; h < 4; ++h) { const v4f qa = *(const LAS v4f*)(qf + h * 64 + c * 8), qb = *(const LAS v4f*)(qf + h * 64 + c * 8 + 4);
                    dot[h] += (kf[0] * qa.x + kf[1] * qa.y) + (kf[2] * qa.z + kf[3] * qa.w) + (kf[4] * qb.x + kf[5] * qb.y) + (kf[6] * qb.z + kf[7] * qb.w); }
            }
        }
        *(LAS v4f*)(pf + slot * 4) = valid ? (v4f){dot[0], dot[1], dot[2], dot[3]} : (v4f){-INFINITY, -INFINITY, -INFINITY, -INFINITY};
    }
    asm volatile("s_waitcnt lgkmcnt(0)" ::: "memory");
    float lg[4][4];
#pragma unroll
    for (int j = 0; j < 4; ++j) { const v4f t4 = *(const LAS v4f*)(pf + (64 * j + lane) * 4); lg[j][0] = t4.x; lg[j][1] = t4.y; lg[j][2] = t4.z; lg[j][3] = t4.w; }
    float inv[4];
#pragma unroll
    for (int h = 0; h < 4; ++h) {
        float mx = fmaxf(fmaxf(lg[0][h], lg[1][h]), fmaxf(lg[2][h], lg[3][h])); mx = wave_max(mx);
        float sk = 0.f; if (SINK) { sk = sinkv[g * 4 + h] * LOG2E; mx = fmaxf(mx, sk); }
        float s = 0.f;
#pragma unroll
        for (int j = 0; j < 4; ++j) { const float e = fexp2(lg[j][h] - mx); lg[j][h] = e; s += e; }
        s = wave_sum(s); if (SINK) s += fexp2(sk - mx);
        inv[h] = 1.0f / s;
    }
#pragma unroll
    for (int j = 0; j < 4; ++j) *(LAS v4f*)(pf + (64 * j + lane) * 4) = (v4f){lg[j][0], lg[j][1], lg[j][2], lg[j][3]};
    asm volatile("s_waitcnt lgkmcnt(0)" ::: "memory");
    float o[4] = {0.f, 0.f, 0.f, 0.f};
    const bf16* Vb = V + (size_t)b * SEQ * 128 + g * 64 + lane;
#pragma unroll 1
    for (int s0 = 0; s0 < nslots; s0 += 8) {
        float vv[8]; v4f pp[8];
#pragma unroll
        for (int i = 0; i < 8; ++i) { const int slot = s0 + i; const int key = slot < nslots ? kidx[slot] : -1; pp[i] = *(const LAS v4f*)(pf + (slot & 255) * 4);
            vv[i] = key >= 0 ? bf2f(Vb[(size_t)key * 128]) : 0.f; if (key < 0) pp[i] = (v4f){0.f, 0.f, 0.f, 0.f}; }
#pragma unroll
        for (int i = 0; i < 8; ++i) { o[0] += pp[i].x * vv[i]; o[1] += pp[i].y * vv[i]; o[2] += pp[i].z * vv[i]; o[3] += pp[i].w * vv[i]; }
    }
    bf16* op = O + (size_t)row * 512 + g * 256 + lane;
#pragma unroll
    for (int h = 0; h < 4; ++h) op[h * 64] = (bf16)f2bf(o[h] * inv[h]);
}
struct SelKey { const unsigned short* selrow; __device__ __forceinline__ int operator()(int slot) const { return (int)selrow[slot]; } };
struct WinKey { int t; __device__ __forceinline__ int operator()(int slot) const { return t - (WIN - 1) + slot; } };

template <bool DO_DSA, bool DO_SWA>
__device__ __forceinline__ void phase_attn_simple(const Params& p, LAS unsigned char* lds, int G, int wv) {
    const int wave = wv, lane = lane_id();
    unsigned char* ws = p.ws;
    LAS float* qf = (LAS float*)(lds + wave * 16384); LAS float* pf = qf + 256; LAS int* kidx = (LAS int*)(pf + 1024);
    const int gw = blockIdx.x * NWAVES + wave, NGW = G * NWAVES;
    const unsigned short* SEL = (const unsigned short*)(ws + WS_SEL);
    for (int item = gw; item < TOK * 2; item += NGW) {
        const int row = item >> 1, g = item & 1, t = row & 4095;
        if (DO_DSA) { SelKey kf{SEL + (size_t)row * TOPK}; const int ns = (t + 1 < TOPK) ? t + 1 : TOPK;
            attend_wave<false>((const bf16*)(ws + WS_AQ), (const bf16*)(ws + WS_AK), (const bf16*)(ws + WS_AV), (bf16*)(ws + WS_OA), row, g, ns, kf, nullptr, qf, pf, kidx, lane); }
        if (DO_SWA) { WinKey kf{t};
            attend_wave<true>((const bf16*)(ws + WS_BQ), (const bf16*)(ws + WS_BK), (const bf16*)(ws + WS_BV), (bf16*)(ws + WS_OB), row, g, WIN, kf, p.sinks, qf, pf, kidx, lane); }
    }
}

__device__ __forceinline__ void phase_final(const Params& p, int G, int wv) {
    const int wave = wv, lane = lane_id();
    const float* SS3 = (const float*)(p.ws + WS_SS3);
    const int gw = blockIdx.x * NWAVES + wave, NGW = G * NWAVES;
    v4f g[4];
#pragma unroll
    for (int j = 0; j < 4; ++j) g[j] = *((const v4f*)p.final_w + lane + 64 * j);
    for (int m = gw; m < TOK; m += NGW) {
        float rs = frsq(SS3[m] * (1.0f / DM) + RMS_EPS);
#ifdef PROBE_TS
        { const unsigned long long* TS = (const unsigned long long*)(p.ws + WS_RSTD1 + 384 * 1024); rs *= 1.0f + (float)(TS[PROBE_TS + 1] - TS[PROBE_TS]) * 1.0e-5f; }
#endif
        v4f* xr = (v4f*)(p.out + (size_t)m * DM) + lane;
#pragma unroll
        for (int j = 0; j < 4; ++j) { v4f v = xr[64 * j]; xr[64 * j] = v * g[j] * rs; }
    }
}

typedef short bf16x8_t __attribute__((ext_vector_type(8)));
typedef float f32x16_t __attribute__((ext_vector_type(16)));
typedef float f32x4_t __attribute__((ext_vector_type(4)));
typedef float f32x2_t __attribute__((ext_vector_type(2)));
__device__ __forceinline__ unsigned f16key(float f) { const int q = (int)__builtin_rintf(f * 4096.0f) + 32768; return (unsigned)(q < 256 ? 256 : (q > 65535 ? 65535 : q)); }
__device__ __forceinline__ float relu1(float x) { return __builtin_amdgcn_fmed3f(x, 0.f, 3.0e38f); }
constexpr int TK_H1 = LDS_RING, TK_WAVE = LDS_RING + 8192, TK_WAVE_BYTES = 3072, TK_CAND = 512;
static_assert(TK_WAVE + 8 * TK_WAVE_BYTES <= LDS_BYTES, "top-k LDS map");

__device__ __forceinline__ void phase_topk_fast(const Params& p, LAS unsigned char* lds, int G, int wv) {
    const int wave = wv, lane = lane_id(), tid = wave * 64 + lane;
    const int r = lane & 31, h = lane >> 5, mt = wave & 3, par = wave >> 2;
    unsigned char* ws = p.ws;
    const bf16* IQ = (const bf16*)(ws + WS_IQ); const bf16* IK = (const bf16*)(ws + WS_IK); const float* IW = (const float*)(ws + WS_IW);
    unsigned short* SEL = (unsigned short*)(ws + WS_SEL);
    LAS unsigned short* kb = (LAS unsigned short*)lds;
    LAS unsigned* H1 = (LAS unsigned*)(lds + TK_H1);
    LAS unsigned* cl = (LAS unsigned*)(lds + TK_WAVE + wave * TK_WAVE_BYTES); LAS unsigned short* ol = (LAS unsigned short*)(lds + TK_WAVE + wave * TK_WAVE_BYTES + 4 * TK_CAND);
    const int qrow = 4 * mt + 2 * ((r >> 2) & 1) + (r >> 4), qhead = 4 * ((r >> 3) & 1) + (r & 3);
    { LAS v4u* hz = (LAS v4u*)H1; hz[tid] = (v4u){0u, 0u, 0u, 0u}; }
    for (int k = 0;; ++k) {
        int b, tile;
        if (G == 256) { if (k >= 8) break; const int c = blockIdx.x, i = c >> 3, grp = k >> 1; b = c & 7; tile = (k & 1) ? (64 * grp + 63 - i) : (64 * grp + i); }
        else { const int u = blockIdx.x + k * G; if (u >= TOK / 16) break; b = u >> 8; tile = u & 255; }
        const int t0 = tile * 16, R0 = b * SEQ + t0;
        if (t0 + 16 <= TOPK) {
            for (int i = tid; i < 16 * TOPK; i += NTHREADS) { const int ql = i >> 8, s = i & 255; if (s <= t0 + ql) SEL[(size_t)(R0 + ql) * TOPK + s] = (unsigned short)s; }
            continue;
        }
        bf16x8_t aq[4];
#pragma unroll
        for (int s = 0; s < 4; ++s) aq[s] = *(const bf16x8_t*)(IQ + (size_t)(R0 + qrow) * 512 + qhead * 64 + 16 * s + 8 * h);
        f32x2_t wq[2][4];
#pragma unroll
        for (int qq = 0; qq < 2; ++qq) { const f32x4_t w0 = *(const f32x4_t*)(IW + (size_t)(R0 + 4 * mt + 2 * h + qq) * 8), w1 = *(const f32x4_t*)(IW + (size_t)(R0 + 4 * mt + 2 * h + qq) * 8 + 4);
            wq[qq][0] = (f32x2_t){w0[0], w0[1]}; wq[qq][1] = (f32x2_t){w0[2], w0[3]}; wq[qq][2] = (f32x2_t){w1[0], w1[1]}; wq[qq][3] = (f32x2_t){w1[2], w1[3]}; }
        const int ntile = (t0 + 16 + 31) >> 5, ntp = (ntile + 7) & ~7, nch = (t0 + 16 + 511) >> 9;
        const char* kbase = (const char*)IK + (size_t)b * SEQ * 128;
        const unsigned voff = (unsigned)(lane * 16);
        const int tq0 = t0 + 4 * mt + 2 * h;
        const int ql0 = 4 * mt + 2 * h;
        LAS unsigned short* row0 = kb + ql0 * 4096; LAS unsigned* h0 = H1 + ql0 * 128;
        __syncthreads();
#define TK_LOAD(dst, kt_) do { const int ktc_ = (kt_) < 127 ? (kt_) : 127; const char* tp_ = kbase + (size_t)ktc_ * 4096; _Pragma("unroll") for (int s_ = 0; s_ < 4; ++s_) dst[s_] = *(const bf16x8_t*)(tp_ + voff + 1024 * s_); } while (0)
#define TK_MMA(acc_, src) do { acc_ = (f32x16_t){0.f, 0.f, 0.f, 0.f, 0.f, 0.f, 0.f, 0.f, 0.f, 0.f, 0.f, 0.f, 0.f, 0.f, 0.f, 0.f}; \
            _Pragma("unroll") for (int s_ = 0; s_ < 4; ++s_) acc_ = __builtin_amdgcn_mfma_f32_32x32x16_bf16(aq[s_], src[s_], acc_, 0, 0, 0); } while (0)
#define TK_POST(acc_, kt_) do { f32x2_t s0_ = {0.f, 0.f}, s1_ = {0.f, 0.f}; \
            _Pragma("unroll") for (int hd_ = 0; hd_ < 4; ++hd_) { s0_ += (f32x2_t){relu1(acc_[2 * hd_]), relu1(acc_[2 * hd_ + 1])} * wq[0][hd_]; s1_ += (f32x2_t){relu1(acc_[8 + 2 * hd_]), relu1(acc_[9 + 2 * hd_])} * wq[1][hd_]; } \
            const int e_ = 32 * (kt_) + r; const unsigned k0_ = (e_ <= tq0) ? f16key(s0_.x + s0_.y) : 0u, k1_ = (e_ <= tq0 + 1) ? f16key(s1_.x + s1_.y) : 0u; \
            row0[e_] = (unsigned short)k0_; row0[4096 + e_] = (unsigned short)k1_; \
            if (k0_) __hip_atomic_fetch_add(h0 + (k0_ >> 9), 1u << ((k0_ >> 4) & 16u), __ATOMIC_RELAXED, __HIP_MEMORY_SCOPE_WORKGROUP); \
            if (k1_) __hip_atomic_fetch_add(h0 + 128 + (k1_ >> 9), 1u << ((k1_ >> 4) & 16u), __ATOMIC_RELAXED, __HIP_MEMORY_SCOPE_WORKGROUP); } while (0)
#ifndef TK_REP_SCORE
#define TK_REP_SCORE 1
#endif
#ifndef TK_REP_SEL
#define TK_REP_SEL 1
#endif
#pragma unroll 1
        for (int rp_ = 0; rp_ < TK_REP_SCORE; ++rp_) {
            bf16x8_t B[4][4]; f32x16_t accA, accB;
            const int nmy = ntp >> 1;
#pragma unroll
            for (int u = 0; u < 4; ++u) TK_LOAD(B[u], par + 2 * u);
            TK_MMA(accA, B[0]);
#pragma unroll 1
            for (int i = 0; i < nmy; i += 4) {
                const int kt = par + 2 * i;
                TK_MMA(accB, B[1]); TK_POST(accA, kt);     TK_LOAD(B[0], kt + 8);
                TK_MMA(accA, B[2]); TK_POST(accB, kt + 2); TK_LOAD(B[1], kt + 10);
                TK_MMA(accB, B[3]); TK_POST(accA, kt + 4); TK_LOAD(B[2], kt + 12);
                TK_MMA(accA, B[0]); TK_POST(accB, kt + 6); TK_LOAD(B[3], kt + 14);
            }
        }
#undef TK_LOAD
#undef TK_MMA
#undef TK_POST
        if (32 * ntp < 512 * nch) {
#pragma unroll
            for (int qi = 0; qi < 2; ++qi) { LAS v2u* z = (LAS v2u*)(kb + (2 * wave + qi) * 4096 + 32 * ntp) + lane; *z = (v2u){0u, 0u}; }
        }
        __syncthreads();
#pragma unroll 1
        for (int qi = 0; qi < 2 * TK_REP_SEL; ++qi) {
            const int ql = 2 * wave + (qi & 1);
            const LAS unsigned short* rb = kb + ql * 4096 + lane;
            const v2u hw = *(const LAS v2u*)(H1 + ql * 128 + 2 * lane); const v4u hv = {hw.x & 0xffffu, hw.x >> 16, hw.y & 0xffffu, hw.y >> 16};
            if ((qi >> 1) + 1 == TK_REP_SEL) *(LAS v2u*)(H1 + ql * 128 + 2 * lane) = (v2u){0u, 0u};
            const int hs = (int)(hv.x + hv.y + hv.z + hv.w); int S = hs;
#pragma unroll
            for (int off = 1; off < 64; off <<= 1) { const int v = __shfl_down(S, off); if (lane + off < 64) S += v; }
            int ab = S - hs; const bool cross = ab < TOPK && S >= TOPK;
            int Bl = 4 * lane + 3;
            if (ab + (int)hv.w < TOPK) { ab += (int)hv.w; Bl = 4 * lane + 2; if (ab + (int)hv.z < TOPK) { ab += (int)hv.z; Bl = 4 * lane + 1; if (ab + (int)hv.y < TOPK) { ab += (int)hv.y; Bl = 4 * lane; } } }
            const unsigned long long mc = __ballot(cross);
            const int src = mc ? (__ffsll((long long)mc) - 1) : 0;
            const unsigned Bb = (unsigned)__shfl(Bl, src);
            int pos = 0, m = 0;
#pragma unroll 1
            for (int j = 0; j < nch; ++j) {
                unsigned kk[8];
#pragma unroll
                for (int s = 0; s < 8; ++s) kk[s] = rb[512 * j + 64 * s];
#pragma unroll
                for (int s = 0; s < 8; ++s) {
                    const unsigned hb = kk[s] >> 8; const bool gt = hb > Bb, eq = hb == Bb;
                    const unsigned long long mg = __ballot(gt), me = __ballot(eq);
                    const unsigned e = (unsigned)(512 * j + 64 * s + lane);
                    if (gt) ol[pos + mbcnt64(mg)] = (unsigned short)e;
                    if (eq) { const int ci = m + mbcnt64(me); if (ci < TK_CAND) cl[ci] = ((kk[s] & 0xffu) << 16) | e; }
                    pos += __popcll(mg); m += __popcll(me);
                }
            }
            asm volatile("s_waitcnt lgkmcnt(0)" ::: "memory");
            if (mc != 0ull && m <= TK_CAND && pos < TOPK && pos + m >= TOPK) {
                const int need2 = TOPK - pos;
                unsigned ent[8]; bool val[8];
#pragma unroll
                for (int q = 0; q < 8; ++q) { val[q] = 64 * q + lane < m; ent[q] = val[q] ? cl[64 * q + lane] : 0u; }
                unsigned thr2 = 0u;
#pragma unroll 1
                for (int bit = 7; bit >= 0; --bit) {
                    const unsigned cand = thr2 | (1u << bit); int cnt = 0;
#pragma unroll
                    for (int q = 0; q < 8; ++q) cnt += __popcll(__ballot(val[q] && (ent[q] >> 16) >= cand));
                    if (cnt >= need2) thr2 = cand;
                }
                int cgt2 = 0;
#pragma unroll
                for (int q = 0; q < 8; ++q) cgt2 += __popcll(__ballot(val[q] && (ent[q] >> 16) > thr2));
                const int need3 = need2 - cgt2; int ties = 0;
#pragma unroll
                for (int q = 0; q < 8; ++q) {
                    const unsigned lb = ent[q] >> 16; const bool gt = val[q] && lb > thr2, eq = val[q] && lb == thr2;
                    const unsigned long long meq = __ballot(eq);
                    const bool sel = gt || (eq && (ties + mbcnt64(meq) < need3));
                    const unsigned long long msel = __ballot(sel);
                    if (sel) ol[pos + mbcnt64(msel)] = (unsigned short)(ent[q] & 0xffffu);
                    pos += __popcll(msel); ties += __popcll(meq);
                }
            } else {
                unsigned thr = 0u;
#pragma unroll 1
                for (int bit = 15; bit >= 0; --bit) {
                    const unsigned cand = thr | (1u << bit); int cnt = 0;
#pragma unroll 1
                    for (int i = 0; i < 8 * nch; ++i) cnt += __popcll(__ballot((unsigned)rb[64 * i] >= cand));
                    if (cnt >= TOPK) thr = cand;
                }
                int cgt = 0;
#pragma unroll 1
                for (int i = 0; i < 8 * nch; ++i) cgt += __popcll(__ballot((unsigned)rb[64 * i] > thr));
                const int need = TOPK - cgt; int ties = 0; pos = 0;
#pragma unroll 1
                for (int i = 0; i < 8 * nch; ++i) {
                    const unsigned kx = rb[64 * i]; const bool gt = kx > thr, eq = kx == thr;
                    const unsigned long long meq = __ballot(eq);
                    const bool sel = gt || (eq && (ties + mbcnt64(meq) < need));
                    const unsigned long long msel = __ballot(sel);
                    if (sel) ol[pos + mbcnt64(msel)] = (unsigned short)(64 * i + lane);
                    pos += __popcll(msel); ties += __popcll(meq);
                }
            }
            asm volatile("s_waitcnt lgkmcnt(0)" ::: "memory");
            *((v2u*)(SEL + (size_t)(R0 + ql) * TOPK) + lane) = *(const LAS v2u*)(ol + 4 * lane);
            asm volatile("s_waitcnt lgkmcnt(0)" ::: "memory");
        }
    }
    __syncthreads();
}

typedef short s16x4_t __attribute__((ext_vector_type(4)));
__device__ __forceinline__ s16x4_t tr_read(unsigned addr) { s16x4_t r_; asm volatile("ds_read_b64_tr_b16 %0, %1" : "=v"(r_) : "v"(addr) : "memory"); return r_; }

__device__ __forceinline__ void phase_dsa_fast(const Params& p, LAS unsigned char* lds, int G, int wv) {
    const int wave = wv, lane = lane_id(), tid = wave * 64 + lane;
    const int c16 = lane & 15, kq = lane >> 4;
    unsigned char* ws = p.ws;
    const bf16* AQ = (const bf16*)(ws + WS_AQ); const bf16* AK = (const bf16*)(ws + WS_AK); const bf16* AV = (const bf16*)(ws + WS_AV); bf16* OA = (bf16*)(ws + WS_OA);
    const unsigned short* SEL = (const unsigned short*)(ws + WS_SEL);
    LAS unsigned char* wl = lds + wave * 13312;
    LAS unsigned short* sidx = (LAS unsigned short*)wl; LAS unsigned short* Pl = (LAS unsigned short*)(wl + 512); LAS unsigned char* Vl = wl + 2560;
    const unsigned vl_addr = (unsigned)(size_t)Vl;
    const bool arow = (c16 & 3) == 0; const int ahead = c16 >> 2;
    const int nper = (G >= 8 && (G & 7) == 0) ? (G >> 3) * NWAVES : 0;
    for (int it = 0;; ++it) {
        int row;
        if (nper) { const int wi = (blockIdx.x >> 3) * NWAVES + wave, t = wi + it * nper; if (t >= SEQ) break; row = (blockIdx.x & 7) * SEQ + t; }
        else { row = blockIdx.x * NWAVES + wave + it * G * NWAVES; if (row >= TOK) break; }
        const int b = row >> 12, t = row & 4095; const int cnt = (t + 1 < TOPK) ? t + 1 : TOPK;
        { const v2u sv = *((const v2u*)(SEL + (size_t)row * TOPK) + lane);
            const int s0 = 4 * lane; v2u o;
            o.x = ((s0 < cnt) ? (sv.x & 0xffffu) : 0u) | (((s0 + 1 < cnt) ? (sv.x >> 16) : 0u) << 16); o.y = ((s0 + 2 < cnt) ? (sv.y & 0xffffu) : 0u) | (((s0 + 3 < cnt) ? (sv.y >> 16) : 0u) << 16);
            *(LAS v2u*)(sidx + 4 * lane) = o; }
        asm volatile("s_waitcnt lgkmcnt(0)" ::: "memory");
        const bf16* Kb = AK + (size_t)b * SEQ * 128; const bf16* Vb = AV + (size_t)b * SEQ * 128;
#pragma unroll 1
        for (int g = 0; g < 2; ++g) {
            bf16x8_t aq[2];
#pragma unroll
            for (int c = 0; c < 2; ++c) { aq[c] = (bf16x8_t){0, 0, 0, 0, 0, 0, 0, 0}; if (arow) aq[c] = *(const bf16x8_t*)(AQ + (size_t)row * 512 + (4 * g + ahead) * 64 + 32 * c + 8 * kq); }
            float sc[16];
            const bf16* Kg = Kb + g * 64 + 8 * kq;
#pragma unroll
            for (int q4 = 0; q4 < 4; ++q4) {
                bf16x8_t kf[4][2];
#pragma unroll
                for (int u = 0; u < 4; ++u) { const int key = sidx[16 * (4 * q4 + u) + c16]; const bf16* kp = Kg + (size_t)key * 128; kf[u][0] = *(const bf16x8_t*)kp; kf[u][1] = *(const bf16x8_t*)(kp + 32); }
#pragma unroll
                for (int u = 0; u < 4; ++u) { f32x4_t a = {0.f, 0.f, 0.f, 0.f};
                    a = __builtin_amdgcn_mfma_f32_16x16x32_bf16(aq[0], kf[u][0], a, 0, 0, 0); a = __builtin_amdgcn_mfma_f32_16x16x32_bf16(aq[1], kf[u][1], a, 0, 0, 0);
                    sc[4 * q4 + u] = (16 * (4 * q4 + u) + c16 < cnt) ? a[0] : -INFINITY; }
            }
            float mx = sc[0];
#pragma unroll
            for (int i = 1; i < 16; ++i) mx = fmaxf(mx, sc[i]);
            mx = fmaxf(mx, __shfl_xor(mx, 1)); mx = fmaxf(mx, __shfl_xor(mx, 2)); mx = fmaxf(mx, __shfl_xor(mx, 4)); mx = fmaxf(mx, __shfl_xor(mx, 8));
            float sum = 0.f;
#pragma unroll
            for (int i = 0; i < 16; ++i) { sc[i] = fexp2(sc[i] - mx); sum += sc[i]; }
            sum += __shfl_xor(sum, 1); sum += __shfl_xor(sum, 2); sum += __shfl_xor(sum, 4); sum += __shfl_xor(sum, 8);
            const float inv = 1.0f / sum;
#pragma unroll
            for (int i = 0; i < 16; ++i) Pl[kq * 256 + 16 * i + c16] = (unsigned short)f2bf(sc[i]);
            asm volatile("s_waitcnt lgkmcnt(0)" ::: "memory");
            f32x4_t o[4];
#pragma unroll
            for (int dt = 0; dt < 4; ++dt) o[dt] = (f32x4_t){0.f, 0.f, 0.f, 0.f};
            const bf16* Vg = Vb + g * 64 + 8 * (lane & 7);
#pragma unroll 1
            for (int ch = 0; ch < 4; ++ch) {
                v4u vr[8];
#pragma unroll
                for (int i = 0; i < 8; ++i) { const int key = sidx[64 * ch + 8 * i + (lane >> 3)]; vr[i] = *(const v4u*)(Vg + (size_t)key * 128); }
#pragma unroll
                for (int i = 0; i < 8; ++i) *(LAS v4u*)(Vl + (8 * i + (lane >> 3)) * 160 + 16 * (lane & 7)) = vr[i];
                asm volatile("s_waitcnt lgkmcnt(0)" ::: "memory");
#pragma unroll
                for (int hf = 0; hf < 2; ++hf) {
                    bf16x8_t pa = (bf16x8_t){0, 0, 0, 0, 0, 0, 0, 0};
                    if (arow) { const s16x4_t lo = *(const LAS s16x4_t*)(Pl + ahead * 256 + 64 * ch + 32 * hf + 4 * kq), hi = *(const LAS s16x4_t*)(Pl + ahead * 256 + 64 * ch + 32 * hf + 16 + 4 * kq);
                        pa = (bf16x8_t){lo[0], lo[1], lo[2], lo[3], hi[0], hi[1], hi[2], hi[3]}; }
                    const unsigned va = vl_addr + (unsigned)((32 * hf + 4 * kq + (c16 >> 2)) * 160 + 8 * (c16 & 3));
                    s16x4_t vlo[4], vhi[4];
#pragma unroll
                    for (int dt = 0; dt < 4; ++dt) { vlo[dt] = tr_read(va + 32 * dt); vhi[dt] = tr_read(va + 16 * 160 + 32 * dt); }
                    asm volatile("s_waitcnt lgkmcnt(0)" : "+v"(vlo[0]), "+v"(vlo[1]), "+v"(vlo[2]), "+v"(vlo[3]), "+v"(vhi[0]), "+v"(vhi[1]), "+v"(vhi[2]), "+v"(vhi[3]) :: "memory");
                    __builtin_amdgcn_sched_barrier(0);
#pragma unroll
                    for (int dt = 0; dt < 4; ++dt) { const bf16x8_t vb = (bf16x8_t){vlo[dt][0], vlo[dt][1], vlo[dt][2], vlo[dt][3], vhi[dt][0], vhi[dt][1], vhi[dt][2], vhi[dt][3]};
                        o[dt] = __builtin_amdgcn_mfma_f32_16x16x32_bf16(pa, vb, o[dt], 0, 0, 0); }
                }
                asm volatile("s_waitcnt lgkmcnt(0)" ::: "memory");
            }
            bf16* op = OA + (size_t)row * 512 + (4 * g + kq) * 64 + c16;
#pragma unroll
            for (int dt = 0; dt < 4; ++dt) op[16 * dt] = (bf16)f2bf(o[dt][0] * inv);
        }
    }
}

typedef float f32x2_t __attribute__((ext_vector_type(2))); typedef __bf16 bf16x2v_t __attribute__((ext_vector_type(2)));
__device__ __forceinline__ unsigned cvtpk_s(float lo, float hi) { f32x2_t v = {lo, hi}; bf16x2v_t b = __builtin_convertvector(v, bf16x2v_t); return __builtin_bit_cast(unsigned, b); }
__device__ __forceinline__ int crow16(int reg, int h) { return (reg & 3) + 8 * (reg >> 2) + 4 * h; }

__device__ __forceinline__ void phase_swa_fast(const Params& p, int G, int wv) {
    const int wave = wv, lane = lane_id(), tid = wave * 64 + lane;
    const int r = lane & 31, h = lane >> 5, hh = wave >> 1, qh = wave & 1;
    unsigned char* ws = p.ws;
    const bf16* BQ = (const bf16*)(ws + WS_BQ); const bf16* BK = (const bf16*)(ws + WS_BK); const bf16* BV = (const bf16*)(ws + WS_BV); bf16* OB = (bf16*)(ws + WS_OB);
    for (int k = 0;; ++k) {
        int b, idx;
        if (G >= 8 && (G & 7) == 0) { idx = (blockIdx.x >> 3) + (G >> 3) * k; if (idx >= 64) break; b = blockIdx.x & 7; }
        else { const int u = blockIdx.x + k * G; if (u >= 512) break; b = u >> 6; idx = u & 63; }
        const int qb = idx >> 1, g = idx & 1, head = 4 * g + hh;
        const float sink = p.sinks[head] * LOG2E;
        const bf16* Kb = BK + (size_t)b * SEQ * 128 + g * 64 + 8 * h; const bf16* Vb = BV + (size_t)b * SEQ * 128 + g * 64 + r;
#pragma unroll 1
        for (int qt = 0; qt < 2; ++qt) {
            const int q0 = 128 * qb + 64 * qh + 32 * qt;
            const size_t qrow = (size_t)b * SEQ + q0 + r;
            bf16x8_t qf[4];
#pragma unroll
            for (int s = 0; s < 4; ++s) qf[s] = *(const bf16x8_t*)(BQ + qrow * 512 + head * 64 + 16 * s + 8 * h);
            f32x16_t S[5];
#pragma unroll
            for (int kt = 0; kt < 5; ++kt) {
                const int kb0 = q0 - 128 + 32 * kt; const int krow_ = kb0 + r; const int kc = krow_ < 0 ? 0 : krow_;
                bf16x8_t kf[4];
#pragma unroll
                for (int s = 0; s < 4; ++s) kf[s] = *(const bf16x8_t*)(Kb + (size_t)kc * 128 + 16 * s);
                f32x16_t a = {0.f, 0.f, 0.f, 0.f, 0.f, 0.f, 0.f, 0.f, 0.f, 0.f, 0.f, 0.f, 0.f, 0.f, 0.f, 0.f};
#pragma unroll
                for (int s = 0; s < 4; ++s) a = __builtin_amdgcn_mfma_f32_32x32x16_bf16(kf[s], qf[s], a, 0, 0, 0);
#pragma unroll
                for (int i = 0; i < 16; ++i) { const int key = kb0 + crow16(i, h); const int rel = q0 + r - key; S[kt][i] = (key >= 0 && rel >= 0 && rel < WIN) ? a[i] : -INFINITY; }
            }
            float mx = sink;
#pragma unroll
            for (int kt = 0; kt < 5; ++kt)
#pragma unroll
                for (int i = 0; i < 16; ++i) mx = fmaxf(mx, S[kt][i]);
            mx = fmaxf(mx, __shfl_xor(mx, 32));
            float l = 0.f;
#pragma unroll
            for (int kt = 0; kt < 5; ++kt)
#pragma unroll
                for (int i = 0; i < 16; ++i) { S[kt][i] = fexp2(S[kt][i] - mx); l += S[kt][i]; }
            l += __shfl_xor(l, 32); l += fexp2(sink - mx);
            const float linv = 1.0f / l;
            f32x16_t O0 = {0.f, 0.f, 0.f, 0.f, 0.f, 0.f, 0.f, 0.f, 0.f, 0.f, 0.f, 0.f, 0.f, 0.f, 0.f, 0.f}, O1 = O0;
#pragma unroll
            for (int kt = 0; kt < 5; ++kt) {
                const int kb0 = q0 - 128 + 32 * kt;
#pragma unroll
                for (int s = 0; s < 2; ++s) {
                    v4u pw; pw.x = cvtpk_s(S[kt][8 * s + 0], S[kt][8 * s + 1]); pw.y = cvtpk_s(S[kt][8 * s + 2], S[kt][8 * s + 3]); pw.z = cvtpk_s(S[kt][8 * s + 4], S[kt][8 * s + 5]); pw.w = cvtpk_s(S[kt][8 * s + 6], S[kt][8 * s + 7]);
                    const bf16x8_t pa = __builtin_bit_cast(bf16x8_t, pw);
                    unsigned short v0[8], v1[8];
#pragma unroll
                    for (int j = 0; j < 8; ++j) { int key = kb0 + 16 * s + 8 * (j >> 2) + 4 * h + (j & 3); key = key < 0 ? 0 : key; v0[j] = Vb[(size_t)key * 128]; v1[j] = Vb[(size_t)key * 128 + 32]; }
                    const bf16x8_t vb0 = (bf16x8_t){(short)v0[0], (short)v0[1], (short)v0[2], (short)v0[3], (short)v0[4], (short)v0[5], (short)v0[6], (short)v0[7]};
                    const bf16x8_t vb1 = (bf16x8_t){(short)v1[0], (short)v1[1], (short)v1[2], (short)v1[3], (short)v1[4], (short)v1[5], (short)v1[6], (short)v1[7]};
                    O0 = __builtin_amdgcn_mfma_f32_32x32x16_bf16(pa, vb0, O0, 0, 0, 0); O1 = __builtin_amdgcn_mfma_f32_32x32x16_bf16(pa, vb1, O1, 0, 0, 0);
                }
            }
            bf16* op = OB + ((size_t)b * SEQ + q0) * 512 + head * 64 + r;
#pragma unroll
            for (int i = 0; i < 16; ++i) { const int qq = crow16(i, h); const float li = __shfl(linv, qq); op[(size_t)qq * 512] = (bf16)f2bf(O0[i] * li); op[(size_t)qq * 512 + 32] = (bf16)f2bf(O1[i] * li); }
        }
    }
}

#define XB_TMO      128
#define XB_XCNT(j)  (256  + 64 * (j))
#define XB_XSUB(j)  (1280 + 64 * (j))
#define XB_XGEN(j)  (2304 + 64 * (j))
#define XB_TOP      3328
#define XB_TOPGEN   3392
#define XCD_BAR_WORDS 3456
#define XB_SPIN_CAP (1u << 18)

__device__ __forceinline__ unsigned xb_ld(unsigned* p)              { return __hip_atomic_load(p, __ATOMIC_RELAXED, __HIP_MEMORY_SCOPE_AGENT); }
__device__ __forceinline__ unsigned xb_add(unsigned* p, unsigned v) { return __hip_atomic_fetch_add(p, v, __ATOMIC_RELAXED, __HIP_MEMORY_SCOPE_AGENT); }
__device__ __forceinline__ unsigned xb_xcc_id() { return (unsigned)__builtin_amdgcn_s_getreg((3 << 11) | 20) & 0xFu; }
#define XB_SPIN(cond, bar) do { unsigned _sp = 0; while (cond) { __builtin_amdgcn_s_sleep(1); \
    if ((++_sp & 255u) == 0u) { if (xb_ld(&(bar)[XB_TMO])) break; if (_sp > XB_SPIN_CAP) { atomicAdd(&(bar)[XB_TMO], 1u); break; } } } } while (0)

struct XcdBarrier {
    unsigned* bar; unsigned x;
    volatile LAS unsigned* st;
};

__device__ __forceinline__ XcdBarrier xcd_barrier_post(unsigned* bar, volatile LAS unsigned* st) {
    XcdBarrier b; b.bar = bar; b.x = xb_xcc_id(); b.st = st;
    if (threadIdx.x == 0) (void)xb_add(&bar[XB_XCNT(b.x)], 1u);
    return b;
}
__device__ __forceinline__ void xcd_barrier_complete(unsigned* bar, unsigned x, unsigned& nloc, unsigned& nx) {
    const unsigned G = gridDim.x * gridDim.y * gridDim.z;
    unsigned sum, cnt, mine, sp = 0u;
    for (;;) {
        sum = 0u; cnt = 0u; mine = 0u;
#pragma unroll
        for (unsigned j = 0; j < 16; ++j) { const unsigned c = xb_ld(&bar[XB_XCNT(j)]); sum += c; cnt += (c > 0u) ? 1u : 0u; mine = (j == x) ? c : mine; }
        if (sum == G) break;
        __builtin_amdgcn_s_sleep(1);
        if ((++sp & 255u) == 0u) { if (xb_ld(&bar[XB_TMO])) break; if (sp > XB_SPIN_CAP) { atomicAdd(&bar[XB_TMO], 1u); break; } }
    }
    nloc = mine > 0u ? mine : 1u; nx = cnt > 0u ? cnt : 1u;
}

__device__ __forceinline__ void xcd_barrier(const XcdBarrier& b, int wv) {
    asm volatile("s_waitcnt vmcnt(0)" ::: "memory");
    __syncthreads();
    if (wv == 0 && lane_id() == 0) {
        unsigned* bar = b.bar;
        __builtin_amdgcn_s_waitcnt(0);
        unsigned nloc = b.st[0], nx = b.st[1];
        if (nloc == 0u) { xcd_barrier_complete(bar, b.x, nloc, nx); b.st[0] = nloc; b.st[1] = nx; }
        const unsigned old = xb_add(&bar[XB_XSUB(b.x)], 1u);
        const unsigned gen = old / nloc;
        if (old + 1u == (gen + 1u) * nloc) {
            __builtin_amdgcn_fence(__ATOMIC_RELEASE, "agent");
            asm volatile("s_waitcnt vmcnt(0)" ::: "memory");
            const unsigned og = xb_add(&bar[XB_TOP], 1u);
            const unsigned tg = og / nx;
            if (og + 1u == (tg + 1u) * nx) xb_add(&bar[XB_TOPGEN], 1u);
            else XB_SPIN(xb_ld(&bar[XB_TOPGEN]) == tg, bar);
            __builtin_amdgcn_fence(__ATOMIC_ACQUIRE, "agent");
            xb_add(&bar[XB_XGEN(b.x)], 1u);
            asm volatile("s_waitcnt vmcnt(0)" ::: "memory");
        } else {
            XB_SPIN(xb_ld(&bar[XB_XGEN(b.x)]) == gen, bar);
            __builtin_amdgcn_fence(__ATOMIC_ACQUIRE, "agent");
            asm volatile("s_waitcnt vmcnt(0)" ::: "memory");
        }
    }
    __syncthreads();
}

constexpr int NPHASE = 9;
__global__ void __launch_bounds__(NTHREADS, 2) mk_fwd(Params p) {
    extern __shared__ __attribute__((aligned(16))) unsigned char lds_raw[];
    LAS unsigned char* lds = (LAS unsigned char*)lds_raw;
    const int G = gridDim.x, wv = __builtin_amdgcn_readfirstlane(threadIdx.x >> 6);
    unsigned char* ws = p.ws;
#if MK_ONE_LAUNCH
#define SEAM(k) do { if (rep_ + 1 < REPS(k)) __syncthreads(); else if (lo <= (k) && (k) + 1 < hi) { xcd_barrier(xbar, wv); } } while (0)
#else
#define SEAM(k) do { if (rep_ + 1 < REPS(k)) __syncthreads(); } while (0)
#endif
    const int lo = p.ph_lo, hi = p.ph_hi;
#if MK_ONE_LAUNCH
    if (threadIdx.x == 0) { ((volatile LAS unsigned*)(lds + XB_LDS_OFF))[0] = 0u; ((volatile LAS unsigned*)(lds + XB_LDS_OFF))[1] = 0u; }
    const XcdBarrier xbar = xcd_barrier_post((unsigned*)(ws + WS_BAR), (volatile LAS unsigned*)(lds + XB_LDS_OFF));
#endif
#ifdef PROBE_TS
    unsigned long long* TS = (unsigned long long*)(ws + WS_RSTD1 + 384 * 1024);
#define STAMP(k) do { if (blockIdx.x == 0) TS[k] = __builtin_amdgcn_s_memrealtime(); } while (0)
#else
#define STAMP(k) do { } while (0)
#endif
#if MK_ONE_LAUNCH
    if (p.ph_hi > 1000) cg::this_grid().sync();
#endif
    STAMP(0);
#ifndef PHMASK
#define PHMASK 0x1ffu
#endif
#define IN(k) (((PHMASK >> (k)) & 1u) && lo <= (k) && (k) < hi)
#define REPS(k) (((REP_MASK >> (k)) & 1u) ? 2 : 1)
#define PHASE(k) if (IN(k)) for (int rep_ = 0; rep_ < REPS(k); ++rep_)
    PHASE(0) { phase_prologue(p, lds, G, wv); SEAM(0); STAMP(0 + 1); }
    PHASE(1) {
        pg8::Gemm g{(const bf16*)(ws + WS_XG), (const bf16*)(ws + WS_WIN), TOK, NIN, DM, nullptr, 1 << 30};
        pg8::StaticOrder S; S.init(TOK, NIN, G, (int)blockIdx.x);
        pg8::EpiInProj E{(const float*)(ws + WS_RSTD1), (const float*)(ws + WS_COS), (const float*)(ws + WS_SIN), ws, p.ikw, p.ikb};
        pg8::gemm_phase<pg8::EpiInProj, pg8::StaticOrder, true, true>(lds, g, S, E, wv);
        SEAM(1); STAMP(1 + 1);
    }
#if MK_SIMPLE_TOPK
    PHASE(2) { phase_topk_simple(p, lds, G, wv); SEAM(2); STAMP(2 + 1); }
#else
    PHASE(2) { phase_topk_fast(p, lds, G, wv); SEAM(2); STAMP(2 + 1); }
#endif
#if MK_SIMPLE_DSA
    PHASE(3) { phase_attn_simple<true, true>(p, lds, G, wv); SEAM(3); STAMP(3 + 1); }
#else
#if MK_SIMPLE_SWA
    PHASE(3) { phase_dsa_fast(p, lds, G, wv); __syncthreads(); phase_attn_simple<false, true>(p, lds, G, wv); SEAM(3); STAMP(3 + 1); }
#else
    PHASE(3) { phase_swa_fast(p, G, wv); phase_dsa_fast(p, lds, G, wv); SEAM(3); STAMP(3 + 1); }
#endif
#endif
    PHASE(4) {
        pg8::Gemm g{(const bf16*)(ws + WS_OA), (const bf16*)(ws + WS_WAB), TOK, 2048, 512, (const bf16*)(ws + WS_OB), 4};
        pg8::BranchOrder S{G, (int)blockIdx.x};
        pg8::EpiGate E{(const bf16*)(ws + WS_GA), (const bf16*)(ws + WS_GB), p.out, (bf16*)(ws + WS_MIX)};
        pg8::gemm_phase<pg8::EpiGate, pg8::BranchOrder, true, true>(lds, g, S, E, wv);
        SEAM(4); STAMP(4 + 1);
    }
    PHASE(5) {
        pg8::Gemm g{(const bf16*)(ws + WS_MIX), (const bf16*)(ws + WS_WOUT), TOK, DM, DM, nullptr, 1 << 30};
        pg8::StaticOrder S; S.init(TOK, DM, G, (int)blockIdx.x);
        pg8::EpiResid<true> E{p.x, p.out, (bf16*)(ws + WS_XG), p.mlp_norm_w, (float*)(ws + WS_SS2)};
        pg8::gemm_phase<pg8::EpiResid<true>, pg8::StaticOrder, true, true>(lds, g, S, E, wv);
        SEAM(5); STAMP(5 + 1);
    }
    PHASE(6) {
        pg8::Gemm g{(const bf16*)(ws + WS_XG), (const bf16*)(ws + WS_WUP), TOK, DFF, DM, nullptr, 1 << 30};
        pg8::StaticOrder S; S.init(TOK, DFF, G, (int)blockIdx.x);
        pg8::EpiUp E{(const float*)(ws + WS_SS2), (bf16*)(ws + WS_HID)};
        pg8::gemm_phase<pg8::EpiUp, pg8::StaticOrder, true, true>(lds, g, S, E, wv);
        SEAM(6); STAMP(6 + 1);
    }
    PHASE(7) {
        pg8::Gemm g{(const bf16*)(ws + WS_HID), (const bf16*)(ws + WS_WDN), TOK, DM, DFF, nullptr, 1 << 30};
        pg8::StaticOrder S; S.init(TOK, DM, G, (int)blockIdx.x);
        pg8::EpiResid<false> E{p.out, p.out, nullptr, nullptr, (float*)(ws + WS_SS3)};
        pg8::gemm_phase<pg8::EpiResid<false>, pg8::StaticOrder, true, true>(lds, g, S, E, wv);
        SEAM(7); STAMP(7 + 1);
    }
#ifdef EXTRA_SYNCS
#if MK_ONE_LAUNCH
    for (int es_ = 0; es_ < EXTRA_SYNCS; ++es_) xcd_barrier(xbar, wv);
#endif
#endif
    PHASE(8) { phase_final(p, G, wv); }
#undef PHASE
#undef REPS
#undef IN
#undef SEAM
}

extern "C" void kernel_launch(void* const* d_in, const int* in_sizes, int n_in, void* d_out, int out_size, void* d_ws, size_t ws_size, hipStream_t stream) {
    static int grid = 0;
    if (grid == 0) {
        if (n_in != 13 || in_sizes[0] != TOK * DM || out_size != TOK * DM || ws_size < WS_NEED) {
            fprintf(stderr, "kernel_launch: unexpected shapes (n_in %d, in0 %d, out %d, ws %zu); nothing launched\n", n_in, n_in > 0 ? in_sizes[0] : -1, out_size, ws_size); grid = -1; return; }
        int dev = 0, cus = 0, per_cu = 0;
        (void)hipGetDevice(&dev); (void)hipDeviceGetAttribute(&cus, hipDeviceAttributeMultiprocessorCount, dev);
        if (hipFuncSetAttribute((const void*)mk_fwd, hipFuncAttributeMaxDynamicSharedMemorySize, LDS_BYTES) != hipSuccess) { fprintf(stderr, "kernel_launch: hipFuncSetAttribute failed\n"); grid = -1; return; }
        if (hipOccupancyMaxActiveBlocksPerMultiprocessor(&per_cu, (const void*)mk_fwd, NTHREADS, LDS_BYTES) != hipSuccess || per_cu < 1) { fprintf(stderr, "kernel_launch: occupancy query says %d blocks per CU\n", per_cu); per_cu = 1; }
        (void)hipGetLastError();
        if (per_cu > 1) per_cu = 1;
        grid = cus * per_cu;
    }
    if (grid < 0) return;
    Params p{};
    p.x = (const float*)d_in[0]; p.attn_norm_w = (const float*)d_in[1]; p.w_in = (const float*)d_in[2]; p.ikw = (const float*)d_in[3]; p.ikb = (const float*)d_in[4];
    p.sinks = (const float*)d_in[5]; p.w_a = (const float*)d_in[6]; p.w_b = (const float*)d_in[7]; p.w_out = (const float*)d_in[8]; p.mlp_norm_w = (const float*)d_in[9];
    p.w_up = (const float*)d_in[10]; p.w_down = (const float*)d_in[11]; p.final_w = (const float*)d_in[12];
    p.out = (float*)d_out; p.ws = (unsigned char*)d_ws;
    for (int i = 0; i < 32; ++i) p.inv_freq[i] = 1.0f / powf(10000.0f, (float)(2 * i) / 64.0f);
#if MK_ONE_LAUNCH
    if (hipMemsetAsync((char*)d_ws + WS_BAR, 0, 16384, stream) != hipSuccess) { fprintf(stderr, "kernel_launch: hipMemsetAsync of the barrier words failed\n"); return; }
    p.ph_lo = 0; p.ph_hi = NPHASE;
    void* args[] = {&p};
    hipError_t e = hipLaunchCooperativeKernel((const void*)mk_fwd, dim3(grid), dim3(NTHREADS), args, LDS_BYTES, stream);
    if (e != hipSuccess) fprintf(stderr, "kernel_launch: cooperative launch failed: %s (grid %d)\n", hipGetErrorString(e), grid);
#else
    for (int ph = 0; ph < NPHASE; ++ph) {
        p.ph_lo = ph; p.ph_hi = ph + 1;
        hipLaunchKernelGGL(mk_fwd, dim3(grid), dim3(NTHREADS), LDS_BYTES, stream, p);
    }
#endif
}
```

```cpp
#include <hip/hip_runtime.h>
#include <hip/hip_cooperative_groups.h>
#include <cstdio>
#include <cstdint>
namespace cg = cooperative_groups;

#ifndef MK_ONE_LAUNCH
#define MK_ONE_LAUNCH 1
#endif
#ifndef MK_SIMPLE_TOPK
#define MK_SIMPLE_TOPK 0
#endif
#ifndef MK_SIMPLE_SWA
#define MK_SIMPLE_SWA 0
#endif
#ifndef MK_SIMPLE_DSA
#define MK_SIMPLE_DSA 0
#endif

constexpr int NBATCH = 8, SEQ = 4096, DM = 1024, TOK = NBATCH * SEQ, DFF = 4096, TOPK = 256, WIN = 128;
constexpr int NIN = 4352;
constexpr float RMS_EPS = 1e-6f, LN_EPS = 1e-6f;
constexpr float QSCALE = 0.125f * 1.4426950408889634f;
constexpr float LOG2E = 1.4426950408889634f;
constexpr float W_SCALE = 0.04419417382415922f;
constexpr int C_AQ = 0, C_AK = 512, C_AV = 640, C_IQ = 768, C_IK = 1280, C_IW = 1344, C_BQ = 1352, C_BK = 1864, C_BV = 1992, C_GA = 2120, C_GB = 3144, D_IN = 4168;

constexpr size_t MiB = 1u << 20;
constexpr size_t WS_RSTD1 = 0, WS_SS2 = 128 * 1024, WS_SS3 = 256 * 1024;
constexpr size_t WS_BAR = 512 * 1024;
constexpr int XB_LDS_OFF = 163832;
constexpr size_t WS_COS = 1 * MiB, WS_SIN = 1 * MiB + 512 * 1024;
constexpr size_t WS_WIN = 2 * MiB, WS_WAB = 11 * MiB, WS_WOUT = 13 * MiB, WS_WUP = 15 * MiB, WS_WDN = 23 * MiB;
constexpr size_t WS_XG = 32 * MiB;
constexpr size_t WS_AQ = 96 * MiB, WS_IQ = 128 * MiB, WS_BQ = 160 * MiB, WS_AK = 192 * MiB, WS_AV = 200 * MiB, WS_BK = 208 * MiB, WS_BV = 216 * MiB;
constexpr size_t WS_IK = 224 * MiB, WS_IW = 228 * MiB, WS_SEL = 230 * MiB, WS_GA = 248 * MiB, WS_GB = 312 * MiB, WS_MIX = 376 * MiB, WS_END = 440 * MiB;
#ifndef MK_SEPARATE_O
#define MK_SEPARATE_O 0
#endif
#ifndef REP_MASK
#define REP_MASK 0u
#endif
constexpr size_t WS_OA = MK_SEPARATE_O ? 440 * MiB : WS_AQ, WS_OB = MK_SEPARATE_O ? 472 * MiB : WS_BQ, WS_NEED = MK_SEPARATE_O ? 504 * MiB : WS_END;
constexpr size_t WS_HID = 96 * MiB;
static_assert(WS_WIN + (size_t)NIN * DM * 2 <= WS_WAB && WS_HID + (size_t)TOK * DFF * 2 <= WS_MIX, "ws map");

constexpr int LDS_RING = 131072, LDS_BYTES = 163840;

#define GAS __attribute__((address_space(1)))
#define LAS __attribute__((address_space(3)))
typedef unsigned short bf16;
typedef unsigned v4u __attribute__((ext_vector_type(4)));
typedef unsigned v2u __attribute__((ext_vector_type(2)));
typedef float v4f __attribute__((ext_vector_type(4)));

__device__ __forceinline__ float bf2f(unsigned short u) { return __uint_as_float((unsigned)u << 16); }
__device__ __forceinline__ float bflo(unsigned u) { return __uint_as_float(u << 16); }
__device__ __forceinline__ float bfhi(unsigned u) { return __uint_as_float(u & 0xffff0000u); }
__device__ __forceinline__ unsigned f2bf(float f) { unsigned u = __float_as_uint(f); return (u + 0x7fffu + ((u >> 16) & 1u)) >> 16; }
__device__ __forceinline__ unsigned pk2(float lo, float hi) { unsigned r; asm volatile("v_cvt_pk_bf16_f32 %0, %1, %2" : "=v"(r) : "v"(lo), "v"(hi)); return r; }
__device__ __forceinline__ float fexp2(float x) { return __builtin_amdgcn_exp2f(x); }
__device__ __forceinline__ float frsq(float x) { return __builtin_amdgcn_rsqf(x); }
__device__ __forceinline__ float frcp(float x) { return __builtin_amdgcn_rcpf(x); }
__device__ __forceinline__ float sigmoidf_(float x) { return frcp(1.0f + fexp2(-x * LOG2E)); }
__device__ __forceinline__ float wave_sum(float v) {
#pragma unroll
    for (int o = 1; o < 64; o <<= 1) v += __shfl_xor(v, o);
    return v;
}
__device__ __forceinline__ float wave_max(float v) {
#pragma unroll
    for (int o = 1; o < 64; o <<= 1) v = fmaxf(v, __shfl_xor(v, o));
    return v;
}
__device__ __forceinline__ int lane_id() { unsigned m = ~0u; asm volatile("" : "+s"(m)); return __builtin_amdgcn_mbcnt_hi(m, __builtin_amdgcn_mbcnt_lo(m, 0u)); }
__device__ __forceinline__ int tid_op(int wv) { return wv * 64 + lane_id(); }
__device__ __forceinline__ int mbcnt64(unsigned long long m) { return __builtin_amdgcn_mbcnt_hi((unsigned)(m >> 32), __builtin_amdgcn_mbcnt_lo((unsigned)m, 0u)); }

namespace pg8 {
#define PG8_LAS __attribute__((address_space(3)))
typedef unsigned short bf16_t;
typedef short bf16x8 __attribute__((ext_vector_type(8)));
typedef float f32x4 __attribute__((ext_vector_type(4)));
typedef unsigned u32x4 __attribute__((ext_vector_type(4)));
constexpr int BM = 256, BK = 64, HALF = 128, HTB = HALF * BK * 2  , STAGE_BYTES = 8 * HTB, NXCD = 8, WGM = 8;

__host__ __device__ __forceinline__ int lds_byte(int r, int c) { const int st = (r >> 4) * 2 + (c >> 5), rr = r & 15, cc = c & 31, ob = rr * 64 + cc * 2; return st * 1024 + (ob ^ (((ob >> 9) & 1) << 5)); }
__host__ __device__ __forceinline__ void stage_rc(int b, int& R, int& C) { const int st = b / 1024, sb = b % 1024, swz = sb ^ (((sb >> 9) & 1) << 5); R = (st >> 1) * 16 + swz / 64; C = (st & 1) * 32 + (swz % 64) / 2; }
__host__ __device__ __forceinline__ int perm32(int rho) { const int n = rho >> 4, i = rho & 15; return 8 * (i >> 2) + 4 * n + (i & 3); }

struct Unit { int pm, pn; };
struct Gemm { const bf16_t* A; const bf16_t* Bt; int M, N, K; const bf16_t* A2; int asplit;
    __device__ __forceinline__ const char* abase(const Unit& u) const { return (const char*)(u.pn >= asplit ? A2 : A); } };

struct StaticOrder {
    int nM, nN, nwg, G, c;
    __host__ __device__ void init(int M, int N, int G_, int c_) { nM = M / BM; nN = N / BM; nwg = nM * nN; G = G_; c = c_; }
    __host__ __device__ bool next(int i, Unit& u) const {
        const long L = (long)i * G + c; if (L >= nwg) return false;
        int wgid = (int)L; { const int q = nwg / NXCD, r = nwg % NXCD, xcd = wgid % NXCD, off = wgid / NXCD; wgid = (xcd < r ? xcd * (q + 1) : r * (q + 1) + (xcd - r) * q) + off; }
        const int nig = WGM * nN, gid = wgid / nig, fm = gid * WGM, gsz = (nM - fm) < WGM ? (nM - fm) : WGM;
        u.pm = fm + ((wgid % nig) % gsz); u.pn = (wgid % nig) / gsz; return true;
    }
    __device__ __forceinline__ void a_ready(const Unit&) const {}
    __device__ __forceinline__ void done(const Unit&) const {}
};

__device__ __forceinline__ unsigned cvt_pk_bf16(float lo, float hi) { unsigned r; asm volatile("v_cvt_pk_bf16_f32 %0, %1, %2" : "=v"(r) : "v"(lo), "v"(hi)); return r; }
__device__ __forceinline__ u32x4 pack8(const float (&v)[8]) { u32x4 w; w.x = cvt_pk_bf16(v[0], v[1]); w.y = cvt_pk_bf16(v[2], v[3]); w.z = cvt_pk_bf16(v[4], v[5]); w.w = cvt_pk_bf16(v[6], v[7]); return w; }

struct EpiInProj {
    static constexpr bool PERM = true, AFTER_DRAIN = false;
    const float* rstd1; const float* cs; const float* sn; unsigned char* ws; const float* ikw; const float* ikb;
    __device__ __forceinline__ void operator()(const f32x4 (&acc)[2][2][4][2], const Unit& u, int wr, int wc, int fr_, int fq_) const {
        const int pn = u.pn; int fr = fr_, fq = fq_;
        asm volatile("" : "+v"(fr), "+v"(fq));
#pragma unroll
        for (int ai = 0; ai < 2; ++ai)
#pragma unroll
            for (int m = 0; m < 4; ++m) {
                const int row = u.pm * BM + ai * HALF + wr * 64 + m * 16 + fr;
                const float rs = rstd1[row];
                float x1[8], x2[8];
#pragma unroll
                for (int j = 0; j < 4; ++j) { x1[j] = acc[ai][0][m][0][j] * rs; x1[4 + j] = acc[ai][0][m][1][j] * rs; x2[j] = acc[ai][1][m][0][j] * rs; x2[4 + j] = acc[ai][1][m][1][j] * rs; }
                if (pn >= 9) {
                    bf16_t* G = (bf16_t*)(ws + WS_GA + (size_t)((pn - 9) >> 2) * (WS_GB - WS_GA)) + (size_t)row * 1024 + 256 * ((pn - 9) & 3) + 32 * wc + 8 * fq;
                    float a[8], b[8];
#pragma unroll
                    for (int j = 0; j < 8; ++j) { a[j] = 1.0f / (1.0f + __builtin_amdgcn_exp2f(-x1[j] * 1.4426950408889634f)); b[j] = 1.0f / (1.0f + __builtin_amdgcn_exp2f(-x2[j] * 1.4426950408889634f)); }
                    *(u32x4*)G = pack8(a); *(u32x4*)(G + 128) = pack8(b);
                } else if (pn == 8) {
                    if (wc == 0) {
                        float s = 0.f;
#pragma unroll
                        for (int j = 0; j < 8; ++j) s += x1[j] + x2[j];
                        s += __shfl_xor(s, 16); s += __shfl_xor(s, 32);
                        const float mu = s * (1.0f / 64.0f); float q = 0.f;
#pragma unroll
                        for (int j = 0; j < 8; ++j) { x1[j] -= mu; x2[j] -= mu; q += x1[j] * x1[j] + x2[j] * x2[j]; }
                        q += __shfl_xor(q, 16); q += __shfl_xor(q, 32);
                        const float rstd = __builtin_amdgcn_rsqf(q * (1.0f / 64.0f) + 1e-6f);
                        const int pos = row & 4095; const float* cp = cs + pos * 32 + 8 * fq; const float* sp = sn + pos * 32 + 8 * fq;
                        float o1[8], o2[8];
#pragma unroll
                        for (int j = 0; j < 8; ++j) { const float y1 = x1[j] * rstd * ikw[8 * fq + j] + ikb[8 * fq + j], y2 = x2[j] * rstd * ikw[32 + 8 * fq + j] + ikb[32 + 8 * fq + j];
                            const float c = cp[j], sI = sp[j]; o1[j] = y1 * c - y2 * sI; o2[j] = y2 * c + y1 * sI; }
                        unsigned char* tb = ws + WS_IK + (size_t)(row >> 5) * 4096 + (size_t)(row & 31) * 16;
                        *(u32x4*)(tb + (fq >> 1) * 1024 + (fq & 1) * 512) = pack8(o1); *(u32x4*)(tb + (2 + (fq >> 1)) * 1024 + (fq & 1) * 512) = pack8(o2);
                    } else if (wc == 1 && fq == 0) {
                        float* dst = (float*)(ws + WS_IW) + (size_t)row * 8;
                        *(f32x4*)dst = (f32x4){x1[0], x1[1], x1[2], x1[3]} * 0.04419417382415922f; *(f32x4*)(dst + 4) = (f32x4){x1[4], x1[5], x1[6], x1[7]} * 0.04419417382415922f;
                    }
                } else if (pn >= 6) {
                    bf16_t* Kd = (bf16_t*)(ws + WS_AK + (size_t)(pn - 6) * (WS_BK - WS_AK)); bf16_t* Vd = (bf16_t*)(ws + WS_AV + (size_t)(pn - 6) * (WS_BV - WS_AV));
                    if (wc < 2) {
                        const int pos = row & 4095; const float* cp = cs + pos * 32 + 8 * fq; const float* sp = sn + pos * 32 + 8 * fq;
                        float o1[8], o2[8];
#pragma unroll
                        for (int j = 0; j < 8; ++j) { const float c = cp[j], sI = sp[j]; o1[j] = x1[j] * c - x2[j] * sI; o2[j] = x2[j] * c + x1[j] * sI; }
                        bf16_t* dst = Kd + (size_t)row * 128 + wc * 64 + 8 * fq;
                        *(u32x4*)dst = pack8(o1); *(u32x4*)(dst + 32) = pack8(o2);
                    } else {
                        bf16_t* dst = Vd + (size_t)row * 128 + 32 * (wc - 2) + 8 * fq;
                        *(u32x4*)dst = pack8(x1); *(u32x4*)(dst + 64) = pack8(x2);
                    }
                } else {
                    bf16_t* Q = (bf16_t*)(ws + WS_AQ + (size_t)(pn >> 1) * (WS_IQ - WS_AQ)); const float sc = (pn >= 2 && pn < 4) ? 1.0f : 0.125f * 1.4426950408889634f;
                    const int pos = row & 4095; const float* cp = cs + pos * 32 + 8 * fq; const float* sp = sn + pos * 32 + 8 * fq;
                    float o1[8], o2[8];
#pragma unroll
                    for (int j = 0; j < 8; ++j) { const float c = cp[j], sI = sp[j]; o1[j] = (x1[j] * c - x2[j] * sI) * sc; o2[j] = (x2[j] * c + x1[j] * sI) * sc; }
                    bf16_t* dst = Q + (size_t)row * 512 + (4 * (pn & 1) + wc) * 64 + 8 * fq;
                    *(u32x4*)dst = pack8(o1); *(u32x4*)(dst + 32) = pack8(o2);
                }
                asm volatile("" ::: "memory");
            }
    }
};

struct EpiGate {
    static constexpr bool PERM = true, AFTER_DRAIN = false;
    const bf16_t *GA, *GB; float* P; bf16_t* MIX;
    __device__ __forceinline__ void operator()(const f32x4 (&acc)[2][2][4][2], const Unit& u, int wr, int wc, int fr, int fq) const {
        const bool second = u.pn >= 4; const bf16_t* G = second ? GB : GA;
#pragma unroll
        for (int ai = 0; ai < 2; ++ai)
#pragma unroll
            for (int m = 0; m < 4; ++m) {
                const int row = u.pm * BM + ai * HALF + wr * 64 + m * 16 + fr;
#pragma unroll
                for (int bj = 0; bj < 2; ++bj) {
                    const size_t off = (size_t)row * 1024 + 256 * (u.pn & 3) + 128 * bj + 32 * wc + 8 * fq;
                    const u32x4 gw = *(const u32x4*)(G + off);
                    float v[8];
#pragma unroll
                    for (int j = 0; j < 4; ++j) { v[j] = acc[ai][bj][m][0][j]; v[4 + j] = acc[ai][bj][m][1][j]; }
                    v[0] *= __uint_as_float(gw.x << 16); v[1] *= __uint_as_float(gw.x & 0xffff0000u); v[2] *= __uint_as_float(gw.y << 16); v[3] *= __uint_as_float(gw.y & 0xffff0000u);
                    v[4] *= __uint_as_float(gw.z << 16); v[5] *= __uint_as_float(gw.z & 0xffff0000u); v[6] *= __uint_as_float(gw.w << 16); v[7] *= __uint_as_float(gw.w & 0xffff0000u);
                    if (!second) { *(f32x4*)(P + off) = (f32x4){v[0], v[1], v[2], v[3]}; *(f32x4*)(P + off + 4) = (f32x4){v[4], v[5], v[6], v[7]}; }
                    else { const f32x4 p0 = *(const f32x4*)(P + off), p1 = *(const f32x4*)(P + off + 4);
#pragma unroll
                        for (int j = 0; j < 4; ++j) { v[j] += p0[j]; v[4 + j] += p1[j]; }
                        *(u32x4*)(MIX + off) = pack8(v); }
                }
            }
    }
};

template <bool WITH_XG> struct EpiResid {
    static constexpr bool PERM = false, AFTER_DRAIN = false;
    const float* base; float* out; bf16_t* XG; const float* gw; float* ss;
    __device__ __forceinline__ void operator()(const f32x4 (&acc)[2][2][4][2], const Unit& u, int wr, int wc, int fr, int fq) const {
#pragma unroll
        for (int ai = 0; ai < 2; ++ai)
#pragma unroll
            for (int m = 0; m < 4; ++m) {
                const int row = u.pm * BM + ai * HALF + wr * 64 + m * 16 + fr; float s = 0.f;
#pragma unroll
                for (int bj = 0; bj < 2; ++bj)
#pragma unroll
                    for (int n = 0; n < 2; ++n) {
                        const int col = u.pn * BM + bj * HALF + wc * 32 + n * 16 + 4 * fq; const size_t off = (size_t)row * 1024 + col;
                        const f32x4 v = *(const f32x4*)(base + off) + acc[ai][bj][m][n];
                        *(f32x4*)(out + off) = v; s += (v[0] * v[0] + v[1] * v[1]) + (v[2] * v[2] + v[3] * v[3]);
                        if (WITH_XG) { const f32x4 g = *(const f32x4*)(gw + col); unsigned long long w = (unsigned long long)cvt_pk_bf16(v[0] * g[0], v[1] * g[1]) | ((unsigned long long)cvt_pk_bf16(v[2] * g[2], v[3] * g[3]) << 32);
                            *(unsigned long long*)(XG + off) = w; }
                    }
                s += __shfl_xor(s, 16); s += __shfl_xor(s, 32);
                if (fq == 0) atomicAdd(ss + row, s);
            }
    }
};

struct EpiUp {
    static constexpr bool PERM = true, AFTER_DRAIN = false;
    const float* ss; bf16_t* HID;
    __device__ __forceinline__ void operator()(const f32x4 (&acc)[2][2][4][2], const Unit& u, int wr, int wc, int fr, int fq) const {
#pragma unroll
        for (int ai = 0; ai < 2; ++ai)
#pragma unroll
            for (int m = 0; m < 4; ++m) {
                const int row = u.pm * BM + ai * HALF + wr * 64 + m * 16 + fr;
                const float rs = __builtin_amdgcn_rsqf(ss[row] * (1.0f / 1024.0f) + 1e-6f);
#pragma unroll
                for (int bj = 0; bj < 2; ++bj) {
                    float v[8];
#pragma unroll
                    for (int j = 0; j < 4; ++j) { float a = fmaxf(acc[ai][bj][m][0][j] * rs, 0.f), b = fmaxf(acc[ai][bj][m][1][j] * rs, 0.f); v[j] = a * a; v[4 + j] = b * b; }
                    *(u32x4*)(HID + (size_t)row * 4096 + u.pn * BM + bj * HALF + wc * 32 + 8 * fq) = pack8(v);
                }
            }
    }
};

struct BranchOrder {
    int G, c;
    __device__ __forceinline__ bool next(int i, Unit& u) const {
        const int tile = (i >> 1) * G + c; if (tile >= 128 * 4) return false;
        u.pm = tile >> 2; u.pn = (tile & 3) + 4 * (i & 1); return true;
    }
    __device__ __forceinline__ void a_ready(const Unit&) const {}
    __device__ __forceinline__ void done(const Unit&) const {}
};

template <class Epi, class Sched, bool ALIGN_EPI = false, bool SP2 = false>
__device__ __forceinline__ void gemm_phase(PG8_LAS unsigned char* lds, const Gemm g, const Sched& S, const Epi& E, int wv) {
    const int tid = tid_op(wv), wid = wv, lane = tid & 63, wr = wid >> 2, wc = wid & 3, fr = lane & 15, fq = lane >> 4;
    const int K = g.K, nt = K / BK;
    unsigned voffA[2], voffB[2];
#pragma unroll
    for (int i = 0; i < 2; ++i) { int R, C; stage_rc(tid * 16 + i * 8192, R, C); const int Rb = Epi::PERM ? ((R & ~31) + perm32(R & 31)) : R;
        voffA[i] = (unsigned)(R * K + C) * 2u; voffB[i] = (unsigned)(Rb * K + C) * 2u; }
    const size_t kstep = (size_t)(BK * 2);
    const size_t hstep = (size_t)HALF * K * 2;
    const size_t tstep = 2 * hstep;
    const unsigned ldsw = (unsigned)wid * 1024u;
    const int aoff = lds_byte(wr * 64 + fr, fq * 8), boff = lds_byte(wc * 32 + fr, fq * 8);
#define PG8_SA(b, h) (((b) * 2 + (h)) * HTB)
#define PG8_SB(b, h) ((4 + (b) * 2 + (h)) * HTB)
#define PG8_STAGE(bufoff, gbase, voff) do { _Pragma("unroll") for (int _i = 0; _i < 2; ++_i) \
        __builtin_amdgcn_global_load_lds((const unsigned*)((const char*)(gbase) + (voff)[_i]), (PG8_LAS unsigned*)(lds + (bufoff) + ldsw + _i * 8192), 16, 0, 0); } while (0)
#define PG8_LDA(dst, b, h) do { _Pragma("unroll") for (int m = 0; m < 4; ++m) _Pragma("unroll") for (int k = 0; k < 2; ++k) dst[m][k] = *(const PG8_LAS bf16x8*)(lds + PG8_SA(b, h) + aoff + m * 2048 + k * 1024); } while (0)
#define PG8_LDB(dst, b, h) do { _Pragma("unroll") for (int n = 0; n < 2; ++n) _Pragma("unroll") for (int k = 0; k < 2; ++k) dst[n][k] = *(const PG8_LAS bf16x8*)(lds + PG8_SB(b, h) + boff + n * 2048 + k * 1024); } while (0)
#define PG8_MMA(ai, bj, At, Bt) do { __builtin_amdgcn_s_setprio(1); _Pragma("unroll") for (int m = 0; m < 4; ++m) _Pragma("unroll") for (int n = 0; n < 2; ++n) _Pragma("unroll") for (int k = 0; k < 2; ++k) \
        acc[ai][bj][m][n] = __builtin_amdgcn_mfma_f32_16x16x32_bf16(Bt[n][k], At[m][k], acc[ai][bj][m][n], 0, 0, 0); __builtin_amdgcn_s_setprio(0); } while (0)
#define PG8_WAIT_V(n) asm volatile("s_waitcnt vmcnt(" #n ")" ::: "memory")
#define PG8_WAIT_L(n) asm volatile("s_waitcnt lgkmcnt(" #n ")" ::: "memory")
#define PG8_BAR __builtin_amdgcn_s_barrier()
#define PG8_SCHED __builtin_amdgcn_sched_barrier(0)
    Unit cur, nxt; int ui = 0;
    if (!S.next(0, cur)) return;
    f32x4 acc[2][2][4][2];
#pragma unroll
    for (int a = 0; a < 2; ++a)
#pragma unroll
        for (int b = 0; b < 2; ++b)
#pragma unroll
            for (int m = 0; m < 4; ++m)
#pragma unroll
                for (int n = 0; n < 2; ++n) acc[a][b][m][n] = (f32x4){0.f, 0.f, 0.f, 0.f};
    bf16x8 At[4][2], B0[2][2], B1[2][2];
    const char* cA = g.abase(cur) + (size_t)cur.pm * tstep; const char* cB = (const char*)g.Bt + (size_t)cur.pn * tstep;
    S.a_ready(cur);
    if constexpr (SP2) {
        PG8_STAGE(PG8_SB(0, 0), cB, voffB); PG8_STAGE(PG8_SB(0, 1), cB + hstep, voffB); PG8_STAGE(PG8_SA(0, 0), cA, voffA); PG8_STAGE(PG8_SA(0, 1), cA + hstep, voffA);
        if (wr == 1) PG8_BAR;
        PG8_WAIT_V(2); PG8_BAR;
        PG8_STAGE(PG8_SB(1, 0), cB + kstep, voffB); PG8_STAGE(PG8_SA(1, 0), cA + kstep, voffA); PG8_STAGE(PG8_SB(1, 1), cB + hstep + kstep, voffB);
        PG8_WAIT_V(6); PG8_BAR;
    } else {
        PG8_STAGE(PG8_SB(0, 0), cB, voffB); PG8_STAGE(PG8_SA(0, 0), cA, voffA); PG8_STAGE(PG8_SB(0, 1), cB + hstep, voffB); PG8_STAGE(PG8_SA(0, 1), cA + hstep, voffA);
        if (wr == 1) PG8_BAR;
        PG8_WAIT_V(4); PG8_BAR;
        PG8_STAGE(PG8_SB(1, 0), cB + kstep, voffB); PG8_STAGE(PG8_SA(1, 0), cA + kstep, voffA); PG8_STAGE(PG8_SB(1, 1), cB + hstep + kstep, voffB);
        PG8_WAIT_V(6); PG8_BAR;
    }
    for (;;) {
        const bool has_next = S.next(ui + 1, nxt);
        const char* nA = has_next ? g.abase(nxt) + (size_t)nxt.pm * tstep : cA; const char* nB = has_next ? (const char*)g.Bt + (size_t)nxt.pn * tstep : cB;
        for (int t = 0; t < nt; t += 2) {
            const bool last = (t == nt - 2);
            const char* a1 = cA + (size_t)(t + 1) * kstep;
            const char* a2 = last ? nA : cA + (size_t)(t + 2) * kstep; const char* b2 = last ? nB : cB + (size_t)(t + 2) * kstep;
            const char* a3 = a2 + kstep; const char* b3 = b2 + kstep;
            if (last && has_next) S.a_ready(nxt);
            if constexpr (SP2) {
            PG8_LDB(B0, 0, 0); PG8_LDB(B1, 0, 1); PG8_SCHED; PG8_LDA(At, 0, 0); PG8_STAGE(PG8_SA(1, 1), a1 + hstep, voffA);
            PG8_WAIT_V(8); PG8_WAIT_L(0); PG8_BAR; PG8_MMA(0, 0, At, B0); PG8_MMA(0, 1, At, B1); PG8_BAR; PG8_SCHED;
            PG8_LDA(At, 0, 1); PG8_STAGE(PG8_SB(0, 0), b2, voffB); PG8_STAGE(PG8_SB(0, 1), b2 + hstep, voffB); PG8_STAGE(PG8_SA(0, 0), a2, voffA);
            PG8_WAIT_V(8); PG8_WAIT_L(0); PG8_BAR; PG8_MMA(1, 0, At, B0); PG8_MMA(1, 1, At, B1); PG8_BAR; PG8_SCHED;
            PG8_LDB(B0, 1, 0); PG8_LDB(B1, 1, 1); PG8_SCHED; PG8_LDA(At, 1, 0); PG8_STAGE(PG8_SA(0, 1), a2 + hstep, voffA);
            PG8_WAIT_V(8); PG8_WAIT_L(0); PG8_BAR; PG8_MMA(0, 0, At, B0); PG8_MMA(0, 1, At, B1); PG8_BAR; PG8_SCHED;
            PG8_LDA(At, 1, 1); PG8_STAGE(PG8_SB(1, 0), b3, voffB); PG8_STAGE(PG8_SB(1, 1), b3 + hstep, voffB); PG8_STAGE(PG8_SA(1, 0), a3, voffA);
            PG8_WAIT_V(8); PG8_WAIT_L(0); PG8_BAR; PG8_MMA(1, 0, At, B0); PG8_MMA(1, 1, At, B1); PG8_BAR; PG8_SCHED;
            } else {
            PG8_LDB(B0, 0, 0); PG8_SCHED; PG8_LDA(At, 0, 0); PG8_STAGE(PG8_SA(1, 1), a1 + hstep, voffA);
            PG8_WAIT_L(8); PG8_BAR; PG8_WAIT_L(0); PG8_MMA(0, 0, At, B0); PG8_BAR; PG8_SCHED;
            PG8_LDB(B1, 0, 1); PG8_STAGE(PG8_SB(0, 0), b2, voffB);
            PG8_BAR; PG8_WAIT_L(0); PG8_MMA(0, 1, At, B1); PG8_BAR;
            PG8_LDA(At, 0, 1); PG8_STAGE(PG8_SA(0, 0), a2, voffA);
            PG8_BAR; PG8_WAIT_L(0); PG8_MMA(1, 0, At, B0); PG8_BAR; PG8_SCHED;
            PG8_STAGE(PG8_SB(0, 1), b2 + hstep, voffB);
            PG8_WAIT_V(6); PG8_BAR; PG8_MMA(1, 1, At, B1); PG8_BAR;
            PG8_LDB(B0, 1, 0); PG8_SCHED; PG8_LDA(At, 1, 0); PG8_STAGE(PG8_SA(0, 1), a2 + hstep, voffA);
            PG8_WAIT_L(8); PG8_BAR; PG8_WAIT_L(0); PG8_MMA(0, 0, At, B0); PG8_BAR; PG8_SCHED;
            PG8_LDB(B1, 1, 1); PG8_STAGE(PG8_SB(1, 0), b3, voffB);
            PG8_BAR; PG8_WAIT_L(0); PG8_MMA(0, 1, At, B1); PG8_BAR;
            PG8_LDA(At, 1, 1); PG8_STAGE(PG8_SA(1, 0), a3, voffA);
            PG8_BAR; PG8_WAIT_L(0); PG8_MMA(1, 0, At, B0); PG8_BAR; PG8_SCHED;
            PG8_STAGE(PG8_SB(1, 1), b3 + hstep, voffB);
            PG8_WAIT_V(6); PG8_BAR; PG8_MMA(1, 1, At, B1); PG8_BAR;
            }
        }
        if constexpr (ALIGN_EPI) { if (wr == 0) PG8_BAR; }
        if constexpr (!Epi::AFTER_DRAIN) { E(acc, cur, wr, wc, fr, fq); S.done(cur); }
        if (!has_next) break;
#pragma unroll
        for (int a = 0; a < 2; ++a)
#pragma unroll
            for (int b = 0; b < 2; ++b)
#pragma unroll
                for (int m = 0; m < 4; ++m)
#pragma unroll
                    for (int n = 0; n < 2; ++n) acc[a][b][m][n] = (f32x4){0.f, 0.f, 0.f, 0.f};
        cur = nxt; cA = nA; cB = nB; ++ui;
        if constexpr (ALIGN_EPI) { if (wr == 1) PG8_BAR; }
    }
    PG8_WAIT_V(0);
    if constexpr (!ALIGN_EPI) { if (wr == 0) PG8_BAR; }
    PG8_BAR;
    if constexpr (Epi::AFTER_DRAIN) { E.fused(acc, cur, wr, wc, fr, fq, lds, wid, lane); S.done(cur); }
#undef PG8_SA
#undef PG8_SB
#undef PG8_STAGE
#undef PG8_LDA
#undef PG8_LDB
#undef PG8_MMA
#undef PG8_WAIT_V
#undef PG8_WAIT_L
#undef PG8_BAR
#undef PG8_SCHED
}
}
struct Params {
    const float *x, *attn_norm_w, *w_in, *ikw, *ikb, *sinks, *w_a, *w_b, *w_out, *mlp_norm_w, *w_up, *w_down, *final_w;
    float* out; unsigned char* ws;
    float inv_freq[32];
    int ph_lo, ph_hi;
};
constexpr int NWAVES = 8, NTHREADS = 512;

__device__ __forceinline__ int win_src_group(int grp, int& cnt) {
    const int tile = grp >> 3, g = grp & 7; cnt = 32;
    if (tile < 6) { const int base = tile < 2 ? C_AQ : (tile < 4 ? C_IQ : C_BQ); const int head = 4 * (tile & 1) + (g & 3); return base + head * 64 + 32 * (g >> 2); }
    if (tile < 8) { const int kb = tile == 6 ? C_AK : C_BK, vb = tile == 6 ? C_AV : C_BV; const int hf = g >> 2, q = g & 3;
        if (q < 2) return kb + q * 64 + 32 * hf; return vb + 64 * hf + 32 * (q - 2); }
    if (tile == 8) { if (g == 0) return C_IK; if (g == 4) return C_IK + 32; if (g == 1) { cnt = 8; return C_IW; } cnt = 0; return 0; }
    return C_GA + (grp - 72) * 32;
}
__device__ __forceinline__ void p0_transpose_item(const float* W, int ldw, int c0, int cnt, int K, bf16* WT, int n0, int k0, LAS float* scr, int lane) {
#pragma unroll 8
    for (int i = 0; i < 32; ++i) { const int kk = 2 * i + (lane >> 5), n = lane & 31; scr[kk * 33 + n] = (n < cnt) ? W[(size_t)(k0 + kk) * ldw + c0 + n] : 0.f; }
    asm volatile("s_waitcnt lgkmcnt(0)" ::: "memory");
    const int c = lane & 7;
#pragma unroll
    for (int j = 0; j < 4; ++j) { const int n = (lane >> 3) + 8 * j; const LAS float* s = scr + (8 * c) * 33 + n;
        v4u o; o.x = pk2(s[0 * 33], s[1 * 33]); o.y = pk2(s[2 * 33], s[3 * 33]); o.z = pk2(s[4 * 33], s[5 * 33]); o.w = pk2(s[6 * 33], s[7 * 33]);
        *(v4u*)(WT + (size_t)(n0 + n) * K + k0 + 8 * c) = o; }
    asm volatile("s_waitcnt lgkmcnt(0)" ::: "memory");
}
__device__ __forceinline__ void sincos_d(float angf, float& sn, float& cs) {
    const double a = (double)angf; const double kq = __builtin_rint(a * 0.63661977236758134308);
    const double y = (a - kq * 1.57079632679489655800) - kq * 6.123233995736766e-17; const double y2 = y * y;
    double s = y * (1.0 + y2 * (-1.0 / 6 + y2 * (1.0 / 120 + y2 * (-1.0 / 5040 + y2 * (1.0 / 362880 + y2 * (-1.0 / 39916800 + y2 * (1.0 / 6227020800.0)))))));
    double c = 1.0 + y2 * (-0.5 + y2 * (1.0 / 24 + y2 * (-1.0 / 720 + y2 * (1.0 / 40320 + y2 * (-1.0 / 3628800 + y2 * (1.0 / 479001600.0 + y2 * (-1.0 / 87178291200.0)))))));
    const int q = ((int)kq) & 3;
    const double ss = (q == 0) ? s : (q == 1) ? c : (q == 2) ? -s : -c; const double cc = (q == 0) ? c : (q == 1) ? -s : (q == 2) ? -c : s;
    sn = (float)ss; cs = (float)cc;
}
__device__ __forceinline__ void phase_prologue(const Params& p, LAS unsigned char* lds, int G, int wv) {
    const int wave = wv, lane = lane_id();
    unsigned char* ws = p.ws;
    LAS float* scr = (LAS float*)(lds + wave * 16384);
    const int gw = blockIdx.x * NWAVES + wave, NGW = G * NWAVES;
    constexpr int I_IN = (DM / 64) * (NIN / 32), I_A = (512 / 64) * (DM / 32), I_O = (DM / 64) * (DM / 32), I_U = (DM / 64) * (DFF / 32), I_D = (DFF / 64) * (DM / 32);
    constexpr int NITEMS = I_IN + 2 * I_A + I_O + I_U + I_D;
    for (int it = gw; it < NITEMS; it += NGW) {
        int r = it;
        if (r < I_IN) { const int grp = r % (NIN / 32), kb = r / (NIN / 32); int cnt; const int c0 = win_src_group(grp, cnt);
            p0_transpose_item(p.w_in, D_IN, c0, cnt, DM, (bf16*)(ws + WS_WIN), grp * 32, kb * 64, scr, lane); continue; } r -= I_IN;
        if (r < I_A) { const int nb = r % 32, kb = r / 32; p0_transpose_item(p.w_a, DM, nb * 32, 32, 512, (bf16*)(ws + WS_WAB), nb * 32, kb * 64, scr, lane); continue; } r -= I_A;
        if (r < I_A) { const int nb = r % 32, kb = r / 32; p0_transpose_item(p.w_b, DM, nb * 32, 32, 512, (bf16*)(ws + WS_WAB), 1024 + nb * 32, kb * 64, scr, lane); continue; } r -= I_A;
        if (r < I_O) { const int nb = r % 32, kb = r / 32; p0_transpose_item(p.w_out, DM, nb * 32, 32, DM, (bf16*)(ws + WS_WOUT), nb * 32, kb * 64, scr, lane); continue; } r -= I_O;
        if (r < I_U) { const int nb = r % 128, kb = r / 128; p0_transpose_item(p.w_up, DFF, nb * 32, 32, DM, (bf16*)(ws + WS_WUP), nb * 32, kb * 64, scr, lane); continue; } r -= I_U;
        { const int nb = r % 32, kb = r / 32; p0_transpose_item(p.w_down, DM, nb * 32, 32, DFF, (bf16*)(ws + WS_WDN), nb * 32, kb * 64, scr, lane); }
    }
    float* COS = (float*)(ws + WS_COS); float* SIN = (float*)(ws + WS_SIN);
    for (int i = gw * 64 + lane; i < SEQ * 32; i += NGW * 64) { const int pos = i >> 5, d = i & 31; const float ang = (float)pos * p.inv_freq[d]; float s, c; sincos_d(ang, s, c); COS[i] = c; SIN[i] = s; }
    float* RSTD1 = (float*)(ws + WS_RSTD1); float* SS2 = (float*)(ws + WS_SS2); float* SS3 = (float*)(ws + WS_SS3); bf16* XG = (bf16*)(ws + WS_XG);
    v4f g[4];
#pragma unroll
    for (int j = 0; j < 4; ++j) g[j] = *((const v4f*)p.attn_norm_w + lane + 64 * j);
    for (int m = gw; m < TOK; m += NGW) {
        const v4f* xr = (const v4f*)(p.x + (size_t)m * DM) + lane; v4f v[4]; float s = 0.f;
#pragma unroll
        for (int j = 0; j < 4; ++j) { v[j] = xr[64 * j]; s += (v[j].x * v[j].x + v[j].y * v[j].y) + (v[j].z * v[j].z + v[j].w * v[j].w); }
        s = wave_sum(s);
        unsigned long long* o8 = (unsigned long long*)(XG + (size_t)m * DM) + lane;
#pragma unroll
        for (int j = 0; j < 4; ++j) o8[64 * j] = (unsigned long long)pk2(v[j].x * g[j].x, v[j].y * g[j].y) | ((unsigned long long)pk2(v[j].z * g[j].z, v[j].w * g[j].w) << 32);
        if (lane == 0) { RSTD1[m] = frsq(s * (1.0f / DM) + RMS_EPS); SS2[m] = 0.f; SS3[m] = 0.f; }
    }
}

__device__ __forceinline__ unsigned f2key(float f) { const unsigned u = __float_as_uint(f); return (u & 0x80000000u) ? ~u : (u | 0x80000000u); }
__device__ __forceinline__ void phase_topk_simple(const Params& p, LAS unsigned char* lds, int G, int wv) {
    const int wave = wv, lane = lane_id();
    unsigned char* ws = p.ws;
    const bf16* IQ = (const bf16*)(ws + WS_IQ); const bf16* IK = (const bf16*)(ws + WS_IK); const float* IW = (const float*)(ws + WS_IW);
    unsigned short* SEL = (unsigned short*)(ws + WS_SEL);
    LAS unsigned* keys = (LAS unsigned*)(lds + wave * 16384);
    LAS float* qf = (LAS float*)(lds + LDS_RING + wave * 2048);
    const int gw = blockIdx.x * NWAVES + wave, NGW = G * NWAVES;
    for (int row = gw; row < TOK; row += NGW) {
        const int b = row >> 12, t = row & 4095, n = t + 1;
        unsigned short* selrow = SEL + (size_t)row * TOPK;
        if (n <= TOPK) { for (int i = lane; i < n; i += 64) selrow[i] = (unsigned short)i; continue; }
        { const v4u q8 = *((const v4u*)(IQ + (size_t)row * 512) + lane);
            LAS float* d = qf + 8 * lane;
            d[0] = bflo(q8.x); d[1] = bfhi(q8.x); d[2] = bflo(q8.y); d[3] = bfhi(q8.y); d[4] = bflo(q8.z); d[5] = bfhi(q8.z); d[6] = bflo(q8.w); d[7] = bfhi(q8.w); }
        float w[8];
#pragma unroll
        for (int h = 0; h < 8; ++h) w[h] = IW[(size_t)row * 8 + h];
        asm volatile("s_waitcnt lgkmcnt(0)" ::: "memory");
        for (int s0 = 0; s0 < n; s0 += 64) {
            const int s = s0 + lane; const int sc = s < n ? s : t;
            const v4u* kp = (const v4u*)(IK + ((size_t)b * SEQ + sc) * 64);
            float dot[8];
#pragma unroll
            for (int h = 0; h < 8; ++h) dot[h] = 0.f;
#pragma unroll
            for (int c = 0; c < 8; ++c) {
                const v4u k8 = kp[c]; float kf[8] = {bflo(k8.x), bfhi(k8.x), bflo(k8.y), bfhi(k8.y), bflo(k8.z), bfhi(k8.z), bflo(k8.w), bfhi(k8.w)};
#pragma unroll
                for (int h = 0; h < 8; ++h) { const v4f qa = *(const LAS v4f*)(qf + h * 64 + c * 8), qb = *(const LAS v4f*)(qf + h * 64 + c * 8 + 4);
                    dot[h] += (kf[0] * qa.x + kf[1] * qa.y) + (kf[2] * qa.z + kf[3] * qa.w) + (kf[4] * qb.x + kf[5] * qb.y) + (kf[6] * qb.z + kf[7] * qb.w); }
            }
            float sc_ = 0.f;
#pragma unroll
            for (int h = 0; h < 8; ++h) sc_ += w[h] * fmaxf(dot[h], 0.f);
            keys[s] = (s < n) ? f2key(sc_) : 0u;
        }
        asm volatile("s_waitcnt lgkmcnt(0)" ::: "memory");
        const int nch = (n + 63) >> 6;
        unsigned thr = 0u;
        for (int bit = 31; bit >= 0; --bit) {
            const unsigned cand = thr | (1u << bit); int cnt = 0;
            for (int c = 0; c < nch; ++c) cnt += __popcll(__ballot(keys[c * 64 + lane] >= cand));
            if (cnt >= TOPK) thr = cand;
        }
        int cgt = 0;
        for (int c = 0; c < nch; ++c) cgt += __popcll(__ballot(keys[c * 64 + lane] > thr));
        const int need = TOPK - cgt; int pos = 0, ties = 0;
        for (int c = 0; c < nch; ++c) {
            const unsigned k = keys[c * 64 + lane]; const bool gt = k > thr, eq = k == thr;
            const unsigned long long meq = __ballot(eq);
            const bool sel = gt || (eq && (ties + mbcnt64(meq) < need));
            const unsigned long long msel = __ballot(sel);
            if (sel) selrow[pos + mbcnt64(msel)] = (unsigned short)(c * 64 + lane);
            pos += __popcll(msel); ties += __popcll(meq);
        }
    }
}

template <bool SINK, class KeyFn>
__device__ __forceinline__ void attend_wave(const bf16* Q, const bf16* K, const bf16* V, bf16* O, int row, int g, int nslots, const KeyFn& keyfn, const float* sinkv,
                                            LAS float* qf  , LAS float* pf  , LAS int* kidx  , int lane) {
    const int b = row >> 12;
    { const v2u q4 = *((const v2u*)(Q + (size_t)row * 512 + g * 256) + lane);
        LAS float* d = qf + 4 * lane; d[0] = bflo(q4.x); d[1] = bfhi(q4.x); d[2] = bflo(q4.y); d[3] = bfhi(q4.y); }
    asm volatile("s_waitcnt lgkmcnt(0)" ::: "memory");
#pragma unroll 1
    for (int j = 0; j < 4; ++j) {
        const int slot = 64 * j + lane; int key = slot < nslots ? keyfn(slot) : -1; kidx[slot] = key;
        const bool valid = key >= 0; const int kc = valid ? key : 0;
        const v4u* kp = (const v4u*)(K + ((size_t)b * SEQ + kc) * 128 + g * 64);
        float dot[4] = {0.f, 0.f, 0.f, 0.f};
        if (64 * j < nslots) {
#pragma unroll 2
            for (int c = 0; c < 8; ++c) {
                const v4u k8 = kp[c]; float kf[8] = {bflo(k8.x), bfhi(k8.x), bflo(k8.y), bfhi(k8.y), bflo(k8.z), bfhi(k8.z), bflo(k8.w), bfhi(k8.w)};
#pragma unroll
                for (int h = 0; h < 4; ++h) { const v4f qa = *(const LAS v4f*)(qf + h * 64 + c * 8), qb = *(const LAS v4f*)(qf + h * 64 + c * 8 + 4);
                    dot[h] += (kf[0] * qa.x + kf[1] * qa.y) + (kf[2] * qa.z + kf[3] * qa.w) + (kf[4] * qb.x + kf[5] * qb.y) + (kf[6] * qb.z + kf[7] * qb.w); }
            }
        }
        *(LAS v4f*)(pf + slot * 4) = valid ? (v4f){dot[0], dot[1], dot[2], dot[3]} : (v4f){-INFINITY, -INFINITY, -INFINITY, -INFINITY};
    }
    asm volatile("s_waitcnt lgkmcnt(0)" ::: "memory");
    float lg[4][4];
#pragma unroll
    for (int j = 0; j < 4; ++j) { const v4f t4 = *(const LAS v4f*)(pf + (64 * j + lane) * 4); lg[j][0] = t4.x; lg[j][1] = t4.y; lg[j][2] = t4.z; lg[j][3] = t4.w; }
    float inv[4];
#pragma unroll
    for (int h = 0; h < 4; ++h) {
        float mx = fmaxf(fmaxf(lg[0][h], lg[1][h]), fmaxf(lg[2][h], lg[3][h])); mx = wave_max(mx);
        float sk = 0.f; if (SINK) { sk = sinkv[g * 4 + h] * LOG2E; mx = fmaxf(mx, sk); }
        float s = 0.f;
#pragma unroll
        for (int j = 0; j < 4; ++j) { const float e = fexp2(lg[j][h] - mx); lg[j][h] = e; s += e; }
        s = wave_sum(s); if (SINK) s += fexp2(sk - mx);
        inv[h] = 1.0f / s;
    }
#pragma unroll
    for (int j = 0; j < 4; ++j) *(LAS v4f*)(pf + (64 * j + lane) * 4) = (v4f){lg[j][0], lg[j][1], lg[j][2], lg[j][3]};
    asm volatile("s_waitcnt lgkmcnt(0)" ::: "memory");
    float o[4] = {0.f, 0.f, 0.f, 0.f};
    const bf16* Vb = V + (size_t)b * SEQ * 128 + g * 64 + lane;
#pragma unroll 1
    for (int s0 = 0; s0 < nslots; s0 += 8) {
        float vv[8]; v4f pp[8];
#pragma unroll
        for (int i = 0; i < 8; ++i) { const int slot = s0 + i; const int key = slot < nslots ? kidx[slot] : -1; pp[i] = *(const LAS v4f*)(pf + (slot & 255) * 4);
            vv[i] = key >= 0 ? bf2f(Vb[(size_t)key * 128]) : 0.f; if (key < 0) pp[i] = (v4f){0.f, 0.f, 0.f, 0.f}; }
#pragma unroll
        for (int i = 0; i < 8; ++i) { o[0] += pp[i].x * vv[i]; o[1] += pp[i].y * vv[i]; o[2] += pp[i].z * vv[i]; o[3] += pp[i].w * vv[i]; }
    }
    bf16* op = O + (size_t)row * 512 + g * 256 + lane;
#pragma unroll
    for (int h = 0; h < 4; ++h) op[h * 64] = (bf16)f2bf(o[h] * inv[h]);
}
struct SelKey { const unsigned short* selrow; __device__ __forceinline__ int operator()(int slot) const { return (int)selrow[slot]; } };
struct WinKey { int t; __device__ __forceinline__ int operator()(int slot) const { return t - (WIN - 1) + slot; } };

template <bool DO_DSA, bool DO_SWA>
__device__ __forceinline__ void phase_attn_simple(const Params& p, LAS unsigned char* lds, int G, int wv) {
    const int wave = wv, lane = lane_id();
    unsigned char* ws = p.ws;
    LAS float* qf = (LAS float*)(lds + wave * 16384); LAS float* pf = qf + 256; LAS int* kidx = (LAS int*)(pf + 1024);
    const int gw = blockIdx.x * NWAVES + wave, NGW = G * NWAVES;
    const unsigned short* SEL = (const unsigned short*)(ws + WS_SEL);
    for (int item = gw; item < TOK * 2; item += NGW) {
        const int row = item >> 1, g = item & 1, t = row & 4095;
        if (DO_DSA) { SelKey kf{SEL + (size_t)row * TOPK}; const int ns = (t + 1 < TOPK) ? t + 1 : TOPK;
            attend_wave<false>((const bf16*)(ws + WS_AQ), (const bf16*)(ws + WS_AK), (const bf16*)(ws + WS_AV), (bf16*)(ws + WS_OA), row, g, ns, kf, nullptr, qf, pf, kidx, lane); }
        if (DO_SWA) { WinKey kf{t};
            attend_wave<true>((const bf16*)(ws + WS_BQ), (const bf16*)(ws + WS_BK), (const bf16*)(ws + WS_BV), (bf16*)(ws + WS_OB), row, g, WIN, kf, p.sinks, qf, pf, kidx, lane); }
    }
}

__device__ __forceinline__ void phase_final(const Params& p, int G, int wv) {
    const int wave = wv, lane = lane_id();
    const float* SS3 = (const float*)(p.ws + WS_SS3);
    const int gw = blockIdx.x * NWAVES + wave, NGW = G * NWAVES;
    v4f g[4];
#pragma unroll
    for (int j = 0; j < 4; ++j) g[j] = *((const v4f*)p.final_w + lane + 64 * j);
    for (int m = gw; m < TOK; m += NGW) {
        float rs = frsq(SS3[m] * (1.0f / DM) + RMS_EPS);
#ifdef PROBE_TS
        { const unsigned long long* TS = (const unsigned long long*)(p.ws + WS_RSTD1 + 384 * 1024); rs *= 1.0f + (float)(TS[PROBE_TS + 1] - TS[PROBE_TS]) * 1.0e-5f; }
#endif
        v4f* xr = (v4f*)(p.out + (size_t)m * DM) + lane;
#pragma unroll
        for (int j = 0; j < 4; ++j) { v4f v = xr[64 * j]; xr[64 * j] = v * g[j] * rs; }
    }
}

typedef short bf16x8_t __attribute__((ext_vector_type(8)));
typedef float f32x16_t __attribute__((ext_vector_type(16)));
typedef float f32x4_t __attribute__((ext_vector_type(4)));
typedef float f32x2_t __attribute__((ext_vector_type(2)));
__device__ __forceinline__ unsigned f16key(float f) { const int q = (int)__builtin_rintf(f * 4096.0f) + 32768; return (unsigned)(q < 256 ? 256 : (q > 65535 ? 65535 : q)); }
__device__ __forceinline__ float relu1(float x) { return __builtin_amdgcn_fmed3f(x, 0.f, 3.0e38f); }
constexpr int TK_H1 = LDS_RING, TK_WAVE = LDS_RING + 8192, TK_WAVE_BYTES = 3072, TK_CAND = 512;
static_assert(TK_WAVE + 8 * TK_WAVE_BYTES <= LDS_BYTES, "top-k LDS map");

__device__ __forceinline__ void phase_topk_fast(const Params& p, LAS unsigned char* lds, int G, int wv) {
    const int wave = wv, lane = lane_id(), tid = wave * 64 + lane;
    const int r = lane & 31, h = lane >> 5, mt = wave & 3, par = wave >> 2;
    unsigned char* ws = p.ws;
    const bf16* IQ = (const bf16*)(ws + WS_IQ); const bf16* IK = (const bf16*)(ws + WS_IK); const float* IW = (const float*)(ws + WS_IW);
    unsigned short* SEL = (unsigned short*)(ws + WS_SEL);
    LAS unsigned short* kb = (LAS unsigned short*)lds;
    LAS unsigned* H1 = (LAS unsigned*)(lds + TK_H1);
    LAS unsigned* cl = (LAS unsigned*)(lds + TK_WAVE + wave * TK_WAVE_BYTES); LAS unsigned short* ol = (LAS unsigned short*)(lds + TK_WAVE + wave * TK_WAVE_BYTES + 4 * TK_CAND);
    const int qrow = 4 * mt + 2 * ((r >> 2) & 1) + (r >> 4), qhead = 4 * ((r >> 3) & 1) + (r & 3);
    { LAS v4u* hz = (LAS v4u*)H1; hz[tid] = (v4u){0u, 0u, 0u, 0u}; }
    for (int k = 0;; ++k) {
        int b, tile;
        if (G == 256) { if (k >= 8) break; const int c = blockIdx.x, i = c >> 3, grp = k >> 1; b = c & 7; tile = (k & 1) ? (64 * grp + 63 - i) : (64 * grp + i); }
        else { const int u = blockIdx.x + k * G; if (u >= TOK / 16) break; b = u >> 8; tile = u & 255; }
        const int t0 = tile * 16, R0 = b * SEQ + t0;
        if (t0 + 16 <= TOPK) {
            for (int i = tid; i < 16 * TOPK; i += NTHREADS) { const int ql = i >> 8, s = i & 255; if (s <= t0 + ql) SEL[(size_t)(R0 + ql) * TOPK + s] = (unsigned short)s; }
            continue;
        }
        bf16x8_t aq[4];
#pragma unroll
        for (int s = 0; s < 4; ++s) aq[s] = *(const bf16x8_t*)(IQ + (size_t)(R0 + qrow) * 512 + qhead * 64 + 16 * s + 8 * h);
        f32x2_t wq[2][4];
#pragma unroll
        for (int qq = 0; qq < 2; ++qq) { const f32x4_t w0 = *(const f32x4_t*)(IW + (size_t)(R0 + 4 * mt + 2 * h + qq) * 8), w1 = *(const f32x4_t*)(IW + (size_t)(R0 + 4 * mt + 2 * h + qq) * 8 + 4);
            wq[qq][0] = (f32x2_t){w0[0], w0[1]}; wq[qq][1] = (f32x2_t){w0[2], w0[3]}; wq[qq][2] = (f32x2_t){w1[0], w1[1]}; wq[qq][3] = (f32x2_t){w1[2], w1[3]}; }
        const int ntile = (t0 + 16 + 31) >> 5, ntp = (ntile + 7) & ~7, nch = (t0 + 16 + 511) >> 9;
        const char* kbase = (const char*)IK + (size_t)b * SEQ * 128;
        const unsigned voff = (unsigned)(lane * 16);
        const int tq0 = t0 + 4 * mt + 2 * h;
        const int ql0 = 4 * mt + 2 * h;
        LAS unsigned short* row0 = kb + ql0 * 4096; LAS unsigned* h0 = H1 + ql0 * 128;
        __syncthreads();
#define TK_LOAD(dst, kt_) do { const int ktc_ = (kt_) < 127 ? (kt_) : 127; const char* tp_ = kbase + (size_t)ktc_ * 4096; _Pragma("unroll") for (int s_ = 0; s_ < 4; ++s_) dst[s_] = *(const bf16x8_t*)(tp_ + voff + 1024 * s_); } while (0)
#define TK_MMA(acc_, src) do { acc_ = (f32x16_t){0.f, 0.f, 0.f, 0.f, 0.f, 0.f, 0.f, 0.f, 0.f, 0.f, 0.f, 0.f, 0.f, 0.f, 0.f, 0.f}; \
            _Pragma("unroll") for (int s_ = 0; s_ < 4; ++s_) acc_ = __builtin_amdgcn_mfma_f32_32x32x16_bf16(aq[s_], src[s_], acc_, 0, 0, 0); } while (0)
#define TK_POST(acc_, kt_) do { f32x2_t s0_ = {0.f, 0.f}, s1_ = {0.f, 0.f}; \
            _Pragma("unroll") for (int hd_ = 0; hd_ < 4; ++hd_) { s0_ += (f32x2_t){relu1(acc_[2 * hd_]), relu1(acc_[2 * hd_ + 1])} * wq[0][hd_]; s1_ += (f32x2_t){relu1(acc_[8 + 2 * hd_]), relu1(acc_[9 + 2 * hd_])} * wq[1][hd_]; } \
            const int e_ = 32 * (kt_) + r; const unsigned k0_ = (e_ <= tq0) ? f16key(s0_.x + s0_.y) : 0u, k1_ = (e_ <= tq0 + 1) ? f16key(s1_.x + s1_.y) : 0u; \
            row0[e_] = (unsigned short)k0_; row0[4096 + e_] = (unsigned short)k1_; \
            if (k0_) __hip_atomic_fetch_add(h0 + (k0_ >> 9), 1u << ((k0_ >> 4) & 16u), __ATOMIC_RELAXED, __HIP_MEMORY_SCOPE_WORKGROUP); \
            if (k1_) __hip_atomic_fetch_add(h0 + 128 + (k1_ >> 9), 1u << ((k1_ >> 4) & 16u), __ATOMIC_RELAXED, __HIP_MEMORY_SCOPE_WORKGROUP); } while (0)
#ifndef TK_REP_SCORE
#define TK_REP_SCORE 1
#endif
#ifndef TK_REP_SEL
#define TK_REP_SEL 1
#endif
#pragma unroll 1
        for (int rp_ = 0; rp_ < TK_REP_SCORE; ++rp_) {
            bf16x8_t B[4][4]; f32x16_t accA, accB;
            const int nmy = ntp >> 1;
#pragma unroll
            for (int u = 0; u < 4; ++u) TK_LOAD(B[u], par + 2 * u);
            TK_MMA(accA, B[0]);
#pragma unroll 1
            for (int i = 0; i < nmy; i += 4) {
                const int kt = par + 2 * i;
                TK_MMA(accB, B[1]); TK_POST(accA, kt);     TK_LOAD(B[0], kt + 8);
                TK_MMA(accA, B[2]); TK_POST(accB, kt + 2); TK_LOAD(B[1], kt + 10);
                TK_MMA(accB, B[3]); TK_POST(accA, kt + 4); TK_LOAD(B[2], kt + 12);
                TK_MMA(accA, B[0]); TK_POST(accB, kt + 6); TK_LOAD(B[3], kt + 14);
            }
        }
#undef TK_LOAD
#undef TK_MMA
#undef TK_POST
        if (32 * ntp < 512 * nch) {
#pragma unroll
            for (int qi = 0; qi < 2; ++qi) { LAS v2u* z = (LAS v2u*)(kb + (2 * wave + qi) * 4096 + 32 * ntp) + lane; *z = (v2u){0u, 0u}; }
        }
        __syncthreads();
#pragma unroll 1
        for (int qi = 0; qi < 2 * TK_REP_SEL; ++qi) {
            const int ql = 2 * wave + (qi & 1);
            const LAS unsigned short* rb = kb + ql * 4096 + lane;
            const v2u hw = *(const LAS v2u*)(H1 + ql * 128 + 2 * lane); const v4u hv = {hw.x & 0xffffu, hw.x >> 16, hw.y & 0xffffu, hw.y >> 16};
            if ((qi >> 1) + 1 == TK_REP_SEL) *(LAS v2u*)(H1 + ql * 128 + 2 * lane) = (v2u){0u, 0u};
            const int hs = (int)(hv.x + hv.y + hv.z + hv.w); int S = hs;
#pragma unroll
            for (int off = 1; off < 64; off <<= 1) { const int v = __shfl_down(S, off); if (lane + off < 64) S += v; }
            int ab = S - hs; const bool cross = ab < TOPK && S >= TOPK;
            int Bl = 4 * lane + 3;
            if (ab + (int)hv.w < TOPK) { ab += (int)hv.w; Bl = 4 * lane + 2; if (ab + (int)hv.z < TOPK) { ab += (int)hv.z; Bl = 4 * lane + 1; if (ab + (int)hv.y < TOPK) { ab += (int)hv.y; Bl = 4 * lane; } } }
            const unsigned long long mc = __ballot(cross);
            const int src = mc ? (__ffsll((long long)mc) - 1) : 0;
            const unsigned Bb = (unsigned)__shfl(Bl, src);
            int pos = 0, m = 0;
#pragma unroll 1
            for (int j = 0; j < nch; ++j) {
                unsigned kk[8];
#pragma unroll
                for (int s = 0; s < 8; ++s) kk[s] = rb[512 * j + 64 * s];
#pragma unroll
                for (int s = 0; s < 8; ++s) {
                    const unsigned hb = kk[s] >> 8; const bool gt = hb > Bb, eq = hb == Bb;
                    const unsigned long long mg = __ballot(gt), me = __ballot(eq);
                    const unsigned e = (unsigned)(512 * j + 64 * s + lane);
                    if (gt) ol[pos + mbcnt64(mg)] = (unsigned short)e;
                    if (eq) { const int ci = m + mbcnt64(me); if (ci < TK_CAND) cl[ci] = ((kk[s] & 0xffu) << 16) | e; }
                    pos += __popcll(mg); m += __popcll(me);
                }
            }
            asm volatile("s_waitcnt lgkmcnt(0)" ::: "memory");
            if (mc != 0ull && m <= TK_CAND && pos < TOPK && pos + m >= TOPK) {
                const int need2 = TOPK - pos;
                unsigned ent[8]; bool val[8];
#pragma unroll
                for (int q = 0; q < 8; ++q) { val[q] = 64 * q + lane < m; ent[q] = val[q] ? cl[64 * q + lane] : 0u; }
                unsigned thr2 = 0u;
#pragma unroll 1
                for (int bit = 7; bit >= 0; --bit) {
                    const unsigned cand = thr2 | (1u << bit); int cnt = 0;
#pragma unroll
                    for (int q = 0; q < 8; ++q) cnt += __popcll(__ballot(val[q] && (ent[q] >> 16) >= cand));
                    if (cnt >= need2) thr2 = cand;
                }
                int cgt2 = 0;
#pragma unroll
                for (int q = 0; q < 8; ++q) cgt2 += __popcll(__ballot(val[q] && (ent[q] >> 16) > thr2));
                const int need3 = need2 - cgt2; int ties = 0;
#pragma unroll
                for (int q = 0; q < 8; ++q) {
                    const unsigned lb = ent[q] >> 16; const bool gt = val[q] && lb > thr2, eq = val[q] && lb == thr2;
                    const unsigned long long meq = __ballot(eq);
                    const bool sel = gt || (eq && (ties + mbcnt64(meq) < need3));
                    const unsigned long long msel = __ballot(sel);
                    if (sel) ol[pos + mbcnt64(msel)] = (unsigned short)(ent[q] & 0xffffu);
                    pos += __popcll(msel); ties += __popcll(meq);
                }
            } else {
                unsigned thr = 0u;
#pragma unroll 1
                for (int bit = 15; bit >= 0; --bit) {
                    const unsigned cand = thr | (1u << bit); int cnt = 0;
#pragma unroll 1
                    for (int i = 0; i < 8 * nch; ++i) cnt += __popcll(__ballot((unsigned)rb[64 * i] >= cand));
                    if (cnt >= TOPK) thr = cand;
                }
                int cgt = 0;
#pragma unroll 1
                for (int i = 0; i < 8 * nch; ++i) cgt += __popcll(__ballot((unsigned)rb[64 * i] > thr));
                const int need = TOPK - cgt; int ties = 0; pos = 0;
#pragma unroll 1
                for (int i = 0; i < 8 * nch; ++i) {
                    const unsigned kx = rb[64 * i]; const bool gt = kx > thr, eq = kx == thr;
                    const unsigned long long meq = __ballot(eq);
                    const bool sel = gt || (eq && (ties + mbcnt64(meq) < need));
                    const unsigned long long msel = __ballot(sel);
                    if (sel) ol[pos + mbcnt64(msel)] = (unsigned short)(64 * i + lane);
                    pos += __popcll(msel); ties += __popcll(meq);
                }
            }
            asm volatile("s_waitcnt lgkmcnt(0)" ::: "memory");
            *((v2u*)(SEL + (size_t)(R0 + ql) * TOPK) + lane) = *(const LAS v2u*)(ol + 4 * lane);
            asm volatile("s_waitcnt lgkmcnt(0)" ::: "memory");
        }
    }
    __syncthreads();
}

typedef short s16x4_t __attribute__((ext_vector_type(4)));
__device__ __forceinline__ s16x4_t tr_read(unsigned addr) { s16x4_t r_; asm volatile("ds_read_b64_tr_b16 %0, %1" : "=v"(r_) : "v"(addr) : "memory"); return r_; }
__device__ __forceinline__ void dma16(const void* src, LAS unsigned char* dst) { __builtin_amdgcn_global_load_lds((const unsigned*)src, (LAS unsigned*)dst, 16, 0, 0); }
constexpr int DSA_WAVE_BYTES = 19968, DSA_PL = 16384, DSA_SIDX = 18432, DSA_QS = 19456;
static_assert(8 * DSA_WAVE_BYTES <= XB_LDS_OFF, "DSA LDS map");

__device__ __forceinline__ void phase_dsa_fast(const Params& p, LAS unsigned char* lds, int G, int wv) {
    const int wave = wv, lane = lane_id();
    const int c16 = lane & 15, kq = lane >> 4;
    unsigned char* ws = p.ws;
    const unsigned char* AQ = ws + WS_AQ; bf16* OA = (bf16*)(ws + WS_OA);
    const unsigned char* SEL = ws + WS_SEL;
    LAS unsigned char* wl = lds + wave * DSA_WAVE_BYTES;
    LAS unsigned short* Pl = (LAS unsigned short*)(wl + DSA_PL); LAS unsigned short* sidx = (LAS unsigned short*)(wl + DSA_SIDX); LAS unsigned char* Qs = wl + DSA_QS;
    const unsigned ring_addr = (unsigned)(size_t)wl;
    const bool arow = (c16 & 3) == 0; const int ahead = c16 >> 2;
    if (!(G >= 8 && (G & 7) == 0)) return;
    const int nper = (G >> 3) * NWAVES, wi = (blockIdx.x >> 3) * NWAVES + wave, b = blockIdx.x & 7;
    const int nrows = (SEQ - wi + nper - 1) / nper, nsteps = 32 * nrows;
    const unsigned char* KVb = ws + WS_AK + (size_t)b * SEQ * 256;
    const int sw16 = ((lane & 7) ^ (lane >> 3)) * 16, r8 = lane >> 3;
#define DSA_ISSUE(n_) do { const int n__ = (n_); if (n__ < nsteps) { const int item_ = n__ >> 4, sub_ = n__ & 15, c_ = sub_ & 7, it_ = item_ >> 1; \
        const int t_ = wi + it_ * nper; const int cnt_ = (t_ + 1 < TOPK) ? t_ + 1 : TOPK; \
        const unsigned char* base_ = KVb + ((sub_ >> 3) ? (WS_AV - WS_AK) : 0) + (item_ & 1) * 128 + sw16; \
        const LAS unsigned short* sx_ = sidx + (it_ & 1) * 256 + 32 * c_ + r8; LAS unsigned char* dst_ = wl + (n__ & 3) * 4096; \
        _Pragma("unroll") for (int i_ = 0; i_ < 4; ++i_) { const int slot_ = 32 * c_ + 8 * i_ + r8; const unsigned key_ = slot_ < cnt_ ? (unsigned)sx_[8 * i_] : 0u; dma16(base_ + (size_t)key_ * 256, dst_ + i_ * 1024); } } } while (0)
#define DSA_WAIT(n_) do { if ((n_) + 3 < nsteps) asm volatile("s_waitcnt vmcnt(12)" ::: "memory"); else asm volatile("s_waitcnt vmcnt(0)" ::: "memory"); } while (0)
    if (nrows > 0) {
        if (lane < 32) { dma16(SEL + (size_t)(b * SEQ + wi) * 512 + lane * 16, (LAS unsigned char*)sidx); dma16(AQ + (size_t)(b * SEQ + wi) * 1024 + lane * 16, Qs); }
        asm volatile("s_waitcnt vmcnt(0)" ::: "memory");
        DSA_ISSUE(0); DSA_ISSUE(1); DSA_ISSUE(2);
    }
#pragma unroll 1
    for (int item = 0; item < 2 * nrows; ++item) {
        const int it = item >> 1, g = item & 1, t = wi + it * nper, row = b * SEQ + t;
        const int cnt = (t + 1 < TOPK) ? t + 1 : TOPK; const int n0 = 16 * item;
        float sc[16]; bf16x8_t aq[2];
#pragma unroll
        for (int c = 0; c < 8; ++c) {
            DSA_ISSUE(n0 + c + 3); DSA_WAIT(n0 + c);
            if (c == 0) {
#pragma unroll
                for (int c2 = 0; c2 < 2; ++c2) { aq[c2] = (bf16x8_t){0, 0, 0, 0, 0, 0, 0, 0}; if (arow) aq[c2] = *(const LAS bf16x8_t*)(Qs + ahead * 128 + 64 * c2 + 16 * kq); }
            }
            const LAS unsigned char* rb = wl + ((n0 + c) & 3) * 4096;
#pragma unroll
            for (int kt = 0; kt < 2; ++kt) {
                const int rr = 16 * kt + c16; const LAS unsigned char* rp = rb + rr * 128;
                const bf16x8_t k0 = *(const LAS bf16x8_t*)(rp + ((kq ^ (rr & 7)) << 4)), k1 = *(const LAS bf16x8_t*)(rp + (((4 + kq) ^ (rr & 7)) << 4));
                f32x4_t a = {0.f, 0.f, 0.f, 0.f};
                a = __builtin_amdgcn_mfma_f32_16x16x32_bf16(aq[0], k0, a, 0, 0, 0); a = __builtin_amdgcn_mfma_f32_16x16x32_bf16(aq[1], k1, a, 0, 0, 0);
                sc[2 * c + kt] = (32 * c + rr < cnt) ? a[0] : -INFINITY;
            }
        }
        float mx = sc[0];
#pragma unroll
        for (int i = 1; i < 16; ++i) mx = fmaxf(mx, sc[i]);
        mx = fmaxf(mx, __shfl_xor(mx, 1)); mx = fmaxf(mx, __shfl_xor(mx, 2)); mx = fmaxf(mx, __shfl_xor(mx, 4)); mx = fmaxf(mx, __shfl_xor(mx, 8));
        float sum = 0.f;
#pragma unroll
        for (int i = 0; i < 16; ++i) { sc[i] = fexp2(sc[i] - mx); sum += sc[i]; }
        sum += __shfl_xor(sum, 1); sum += __shfl_xor(sum, 2); sum += __shfl_xor(sum, 4); sum += __shfl_xor(sum, 8);
        const float inv = 1.0f / sum;
#pragma unroll
        for (int i = 0; i < 16; ++i) Pl[kq * 256 + 16 * i + c16] = (unsigned short)f2bf(sc[i]);
        f32x4_t o[4];
#pragma unroll
        for (int dt = 0; dt < 4; ++dt) o[dt] = (f32x4_t){0.f, 0.f, 0.f, 0.f};
#pragma unroll
        for (int c = 0; c < 8; ++c) {
            DSA_ISSUE(n0 + 8 + c + 3); DSA_WAIT(n0 + 8 + c);
            if (c == 0 && item + 1 < 2 * nrows) {
                if (lane < 32) { const int t2 = wi + ((item + 1) >> 1) * nper; dma16(AQ + (size_t)(b * SEQ + t2) * 1024 + ((item + 1) & 1) * 512 + lane * 16, Qs);
                    if (g == 1) dma16(SEL + (size_t)(b * SEQ + t2) * 512 + lane * 16, (LAS unsigned char*)(sidx + ((it + 1) & 1) * 256)); }
            }
            const unsigned rba = ring_addr + (unsigned)(((n0 + 8 + c) & 3) * 4096);
            bf16x8_t pa = (bf16x8_t){0, 0, 0, 0, 0, 0, 0, 0};
            if (arow) { const s16x4_t lo = *(const LAS s16x4_t*)(Pl + ahead * 256 + 32 * c + 4 * kq), hi = *(const LAS s16x4_t*)(Pl + ahead * 256 + 32 * c + 16 + 4 * kq);
                pa = (bf16x8_t){lo[0], lo[1], lo[2], lo[3], hi[0], hi[1], hi[2], hi[3]}; }
            const int r1 = 4 * kq + (c16 >> 2), pp = c16 & 3;
            s16x4_t vlo[4], vhi[4];
#pragma unroll
            for (int dt = 0; dt < 4; ++dt) { const unsigned off = (unsigned)(r1 * 128 + (((2 * dt + (pp >> 1)) ^ (r1 & 7)) << 4) + 8 * (pp & 1)); vlo[dt] = tr_read(rba + off); vhi[dt] = tr_read(rba + off + 16 * 128); }
            asm volatile("s_waitcnt lgkmcnt(0)" : "+v"(vlo[0]), "+v"(vlo[1]), "+v"(vlo[2]), "+v"(vlo[3]), "+v"(vhi[0]), "+v"(vhi[1]), "+v"(vhi[2]), "+v"(vhi[3]) :: "memory");
            __builtin_amdgcn_sched_barrier(0);
#pragma unroll
            for (int dt = 0; dt < 4; ++dt) { const bf16x8_t vb = (bf16x8_t){vlo[dt][0], vlo[dt][1], vlo[dt][2], vlo[dt][3], vhi[dt][0], vhi[dt][1], vhi[dt][2], vhi[dt][3]};
                o[dt] = __builtin_amdgcn_mfma_f32_16x16x32_bf16(pa, vb, o[dt], 0, 0, 0); }
        }
        bf16* op = OA + (size_t)row * 512 + (4 * g + kq) * 64 + c16;
#pragma unroll
        for (int dt = 0; dt < 4; ++dt) op[16 * dt] = (bf16)f2bf(o[dt][0] * inv);
    }
    asm volatile("s_waitcnt vmcnt(0)" ::: "memory");
#undef DSA_ISSUE
#undef DSA_WAIT
}

typedef float f32x2_t __attribute__((ext_vector_type(2))); typedef __bf16 bf16x2v_t __attribute__((ext_vector_type(2)));
__device__ __forceinline__ unsigned cvtpk_s(float lo, float hi) { f32x2_t v = {lo, hi}; bf16x2v_t b = __builtin_convertvector(v, bf16x2v_t); return __builtin_bit_cast(unsigned, b); }
__device__ __forceinline__ int crow16(int reg, int h) { return (reg & 3) + 8 * (reg >> 2) + 4 * h; }

__device__ __forceinline__ void phase_swa_fast(const Params& p, int G, int wv) {
    const int wave = wv, lane = lane_id(), tid = wave * 64 + lane;
    const int r = lane & 31, h = lane >> 5, hh = wave >> 1, qh = wave & 1;
    unsigned char* ws = p.ws;
    const bf16* BQ = (const bf16*)(ws + WS_BQ); const bf16* BK = (const bf16*)(ws + WS_BK); const bf16* BV = (const bf16*)(ws + WS_BV); bf16* OB = (bf16*)(ws + WS_OB);
    for (int k = 0;; ++k) {
        int b, idx;
        if (G >= 8 && (G & 7) == 0) { idx = (blockIdx.x >> 3) + (G >> 3) * k; if (idx >= 64) break; b = blockIdx.x & 7; }
        else { const int u = blockIdx.x + k * G; if (u >= 512) break; b = u >> 6; idx = u & 63; }
        const int qb = idx >> 1, g = idx & 1, head = 4 * g + hh;
        const float sink = p.sinks[head] * LOG2E;
        const bf16* Kb = BK + (size_t)b * SEQ * 128 + g * 64 + 8 * h; const bf16* Vb = BV + (size_t)b * SEQ * 128 + g * 64 + r;
#pragma unroll 1
        for (int qt = 0; qt < 2; ++qt) {
            const int q0 = 128 * qb + 64 * qh + 32 * qt;
            const size_t qrow = (size_t)b * SEQ + q0 + r;
            bf16x8_t qf[4];
#pragma unroll
            for (int s = 0; s < 4; ++s) qf[s] = *(const bf16x8_t*)(BQ + qrow * 512 + head * 64 + 16 * s + 8 * h);
            f32x16_t S[5];
#pragma unroll
            for (int kt = 0; kt < 5; ++kt) {
                const int kb0 = q0 - 128 + 32 * kt; const int krow_ = kb0 + r; const int kc = krow_ < 0 ? 0 : krow_;
                bf16x8_t kf[4];
#pragma unroll
                for (int s = 0; s < 4; ++s) kf[s] = *(const bf16x8_t*)(Kb + (size_t)kc * 128 + 16 * s);
                f32x16_t a = {0.f, 0.f, 0.f, 0.f, 0.f, 0.f, 0.f, 0.f, 0.f, 0.f, 0.f, 0.f, 0.f, 0.f, 0.f, 0.f};
#pragma unroll
                for (int s = 0; s < 4; ++s) a = __builtin_amdgcn_mfma_f32_32x32x16_bf16(kf[s], qf[s], a, 0, 0, 0);
#pragma unroll
                for (int i = 0; i < 16; ++i) { const int key = kb0 + crow16(i, h); const int rel = q0 + r - key; S[kt][i] = (key >= 0 && rel >= 0 && rel < WIN) ? a[i] : -INFINITY; }
            }
            float mx = sink;
#pragma unroll
            for (int kt = 0; kt < 5; ++kt)
#pragma unroll
                for (int i = 0; i < 16; ++i) mx = fmaxf(mx, S[kt][i]);
            mx = fmaxf(mx, __shfl_xor(mx, 32));
            float l = 0.f;
#pragma unroll
            for (int kt = 0; kt < 5; ++kt)
#pragma unroll
                for (int i = 0; i < 16; ++i) { S[kt][i] = fexp2(S[kt][i] - mx); l += S[kt][i]; }
            l += __shfl_xor(l, 32); l += fexp2(sink - mx);
            const float linv = 1.0f / l;
            f32x16_t O0 = {0.f, 0.f, 0.f, 0.f, 0.f, 0.f, 0.f, 0.f, 0.f, 0.f, 0.f, 0.f, 0.f, 0.f, 0.f, 0.f}, O1 = O0;
#pragma unroll
            for (int kt = 0; kt < 5; ++kt) {
                const int kb0 = q0 - 128 + 32 * kt;
#pragma unroll
                for (int s = 0; s < 2; ++s) {
                    v4u pw; pw.x = cvtpk_s(S[kt][8 * s + 0], S[kt][8 * s + 1]); pw.y = cvtpk_s(S[kt][8 * s + 2], S[kt][8 * s + 3]); pw.z = cvtpk_s(S[kt][8 * s + 4], S[kt][8 * s + 5]); pw.w = cvtpk_s(S[kt][8 * s + 6], S[kt][8 * s + 7]);
                    const bf16x8_t pa = __builtin_bit_cast(bf16x8_t, pw);
                    unsigned short v0[8], v1[8];
#pragma unroll
                    for (int j = 0; j < 8; ++j) { int key = kb0 + 16 * s + 8 * (j >> 2) + 4 * h + (j & 3); key = key < 0 ? 0 : key; v0[j] = Vb[(size_t)key * 128]; v1[j] = Vb[(size_t)key * 128 + 32]; }
                    const bf16x8_t vb0 = (bf16x8_t){(short)v0[0], (short)v0[1], (short)v0[2], (short)v0[3], (short)v0[4], (short)v0[5], (short)v0[6], (short)v0[7]};
                    const bf16x8_t vb1 = (bf16x8_t){(short)v1[0], (short)v1[1], (short)v1[2], (short)v1[3], (short)v1[4], (short)v1[5], (short)v1[6], (short)v1[7]};
                    O0 = __builtin_amdgcn_mfma_f32_32x32x16_bf16(pa, vb0, O0, 0, 0, 0); O1 = __builtin_amdgcn_mfma_f32_32x32x16_bf16(pa, vb1, O1, 0, 0, 0);
                }
            }
            bf16* op = OB + ((size_t)b * SEQ + q0) * 512 + head * 64 + r;
#pragma unroll
            for (int i = 0; i < 16; ++i) { const int qq = crow16(i, h); const float li = __shfl(linv, qq); op[(size_t)qq * 512] = (bf16)f2bf(O0[i] * li); op[(size_t)qq * 512 + 32] = (bf16)f2bf(O1[i] * li); }
        }
    }
}

#define XB_TMO      128
#define XB_XCNT(j)  (256  + 64 * (j))
#define XB_XSUB(j)  (1280 + 64 * (j))
#define XB_XGEN(j)  (2304 + 64 * (j))
#define XB_TOP      3328
#define XB_TOPGEN   3392
#define XCD_BAR_WORDS 3456
#define XB_SPIN_CAP (1u << 18)

__device__ __forceinline__ unsigned xb_ld(unsigned* p)              { return __hip_atomic_load(p, __ATOMIC_RELAXED, __HIP_MEMORY_SCOPE_AGENT); }
__device__ __forceinline__ unsigned xb_add(unsigned* p, unsigned v) { return __hip_atomic_fetch_add(p, v, __ATOMIC_RELAXED, __HIP_MEMORY_SCOPE_AGENT); }
__device__ __forceinline__ unsigned xb_xcc_id() { return (unsigned)__builtin_amdgcn_s_getreg((3 << 11) | 20) & 0xFu; }
#define XB_SPIN(cond, bar) do { unsigned _sp = 0; while (cond) { __builtin_amdgcn_s_sleep(1); \
    if ((++_sp & 255u) == 0u) { if (xb_ld(&(bar)[XB_TMO])) break; if (_sp > XB_SPIN_CAP) { atomicAdd(&(bar)[XB_TMO], 1u); break; } } } } while (0)

struct XcdBarrier {
    unsigned* bar; unsigned x;
    volatile LAS unsigned* st;
};

__device__ __forceinline__ XcdBarrier xcd_barrier_post(unsigned* bar, volatile LAS unsigned* st) {
    XcdBarrier b; b.bar = bar; b.x = xb_xcc_id(); b.st = st;
    if (threadIdx.x == 0) (void)xb_add(&bar[XB_XCNT(b.x)], 1u);
    return b;
}
__device__ __forceinline__ void xcd_barrier_complete(unsigned* bar, unsigned x, unsigned& nloc, unsigned& nx) {
    const unsigned G = gridDim.x * gridDim.y * gridDim.z;
    unsigned sum, cnt, mine, sp = 0u;
    for (;;) {
        sum = 0u; cnt = 0u; mine = 0u;
#pragma unroll
        for (unsigned j = 0; j < 16; ++j) { const unsigned c = xb_ld(&bar[XB_XCNT(j)]); sum += c; cnt += (c > 0u) ? 1u : 0u; mine = (j == x) ? c : mine; }
        if (sum == G) break;
        __builtin_amdgcn_s_sleep(1);
        if ((++sp & 255u) == 0u) { if (xb_ld(&bar[XB_TMO])) break; if (sp > XB_SPIN_CAP) { atomicAdd(&bar[XB_TMO], 1u); break; } }
    }
    nloc = mine > 0u ? mine : 1u; nx = cnt > 0u ? cnt : 1u;
}

__device__ __forceinline__ void xcd_barrier(const XcdBarrier& b, int wv) {
    asm volatile("s_waitcnt vmcnt(0)" ::: "memory");
    __syncthreads();
    if (wv == 0 && lane_id() == 0) {
        unsigned* bar = b.bar;
        __builtin_amdgcn_s_waitcnt(0);
        unsigned nloc = b.st[0], nx = b.st[1];
        if (nloc == 0u) { xcd_barrier_complete(bar, b.x, nloc, nx); b.st[0] = nloc; b.st[1] = nx; }
        const unsigned old = xb_add(&bar[XB_XSUB(b.x)], 1u);
        const unsigned gen = old / nloc;
        if (old + 1u == (gen + 1u) * nloc) {
            __builtin_amdgcn_fence(__ATOMIC_RELEASE, "agent");
            asm volatile("s_waitcnt vmcnt(0)" ::: "memory");
            const unsigned og = xb_add(&bar[XB_TOP], 1u);
            const unsigned tg = og / nx;
            if (og + 1u == (tg + 1u) * nx) xb_add(&bar[XB_TOPGEN], 1u);
            else XB_SPIN(xb_ld(&bar[XB_TOPGEN]) == tg, bar);
            __builtin_amdgcn_fence(__ATOMIC_ACQUIRE, "agent");
            xb_add(&bar[XB_XGEN(b.x)], 1u);
            asm volatile("s_waitcnt vmcnt(0)" ::: "memory");
        } else {
            XB_SPIN(xb_ld(&bar[XB_XGEN(b.x)]) == gen, bar);
            __builtin_amdgcn_fence(__ATOMIC_ACQUIRE, "agent");
            asm volatile("s_waitcnt vmcnt(0)" ::: "memory");
        }
    }
    __syncthreads();
}

constexpr int NPHASE = 9;
__global__ void __launch_bounds__(NTHREADS, 2) mk_fwd(Params p) {
    extern __shared__ __attribute__((aligned(16))) unsigned char lds_raw[];
    LAS unsigned char* lds = (LAS unsigned char*)lds_raw;
    const int G = gridDim.x, wv = __builtin_amdgcn_readfirstlane(threadIdx.x >> 6);
    unsigned char* ws = p.ws;
#if MK_ONE_LAUNCH
#define SEAM(k) do { if (rep_ + 1 < REPS(k)) __syncthreads(); else if (lo <= (k) && (k) + 1 < hi) { xcd_barrier(xbar, wv); } } while (0)
#else
#define SEAM(k) do { if (rep_ + 1 < REPS(k)) __syncthreads(); } while (0)
#endif
    const int lo = p.ph_lo, hi = p.ph_hi;
#if MK_ONE_LAUNCH
    if (threadIdx.x == 0) { ((volatile LAS unsigned*)(lds + XB_LDS_OFF))[0] = 0u; ((volatile LAS unsigned*)(lds + XB_LDS_OFF))[1] = 0u; }
    const XcdBarrier xbar = xcd_barrier_post((unsigned*)(ws + WS_BAR), (volatile LAS unsigned*)(lds + XB_LDS_OFF));
#endif
#ifdef PROBE_TS
    unsigned long long* TS = (unsigned long long*)(ws + WS_RSTD1 + 384 * 1024);
#define STAMP(k) do { if (blockIdx.x == 0) TS[k] = __builtin_amdgcn_s_memrealtime(); } while (0)
#else
#define STAMP(k) do { } while (0)
#endif
#if MK_ONE_LAUNCH
    if (p.ph_hi > 1000) cg::this_grid().sync();
#endif
    STAMP(0);
#ifndef PHMASK
#define PHMASK 0x1ffu
#endif
#define IN(k) (((PHMASK >> (k)) & 1u) && lo <= (k) && (k) < hi)
#define REPS(k) (((REP_MASK >> (k)) & 1u) ? 2 : 1)
#define PHASE(k) if (IN(k)) for (int rep_ = 0; rep_ < REPS(k); ++rep_)
    PHASE(0) { phase_prologue(p, lds, G, wv); SEAM(0); STAMP(0 + 1); }
    PHASE(1) {
        pg8::Gemm g{(const bf16*)(ws + WS_XG), (const bf16*)(ws + WS_WIN), TOK, NIN, DM, nullptr, 1 << 30};
        pg8::StaticOrder S; S.init(TOK, NIN, G, (int)blockIdx.x);
        pg8::EpiInProj E{(const float*)(ws + WS_RSTD1), (const float*)(ws + WS_COS), (const float*)(ws + WS_SIN), ws, p.ikw, p.ikb};
        pg8::gemm_phase<pg8::EpiInProj, pg8::StaticOrder, true, true>(lds, g, S, E, wv);
        SEAM(1); STAMP(1 + 1);
    }
#if MK_SIMPLE_TOPK
    PHASE(2) { phase_topk_simple(p, lds, G, wv); SEAM(2); STAMP(2 + 1); }
#else
    PHASE(2) { phase_topk_fast(p, lds, G, wv); SEAM(2); STAMP(2 + 1); }
#endif
#if MK_SIMPLE_DSA
    PHASE(3) { phase_attn_simple<true, true>(p, lds, G, wv); SEAM(3); STAMP(3 + 1); }
#else
#if MK_SIMPLE_SWA
    PHASE(3) { phase_dsa_fast(p, lds, G, wv); __syncthreads(); phase_attn_simple<false, true>(p, lds, G, wv); SEAM(3); STAMP(3 + 1); }
#else
#ifndef REP_SWA
#define REP_SWA 1
#endif
#ifndef REP_DSA
#define REP_DSA 1
#endif
    PHASE(3) { for (int q_ = 0; q_ < REP_SWA; ++q_) phase_swa_fast(p, G, wv); for (int q_ = 0; q_ < REP_DSA; ++q_) phase_dsa_fast(p, lds, G, wv); SEAM(3); STAMP(3 + 1); }
#endif
#endif
    PHASE(4) {
        pg8::Gemm g{(const bf16*)(ws + WS_OA), (const bf16*)(ws + WS_WAB), TOK, 2048, 512, (const bf16*)(ws + WS_OB), 4};
        pg8::BranchOrder S{G, (int)blockIdx.x};
        pg8::EpiGate E{(const bf16*)(ws + WS_GA), (const bf16*)(ws + WS_GB), p.out, (bf16*)(ws + WS_MIX)};
        pg8::gemm_phase<pg8::EpiGate, pg8::BranchOrder, true, true>(lds, g, S, E, wv);
        SEAM(4); STAMP(4 + 1);
    }
    PHASE(5) {
        pg8::Gemm g{(const bf16*)(ws + WS_MIX), (const bf16*)(ws + WS_WOUT), TOK, DM, DM, nullptr, 1 << 30};
        pg8::StaticOrder S; S.init(TOK, DM, G, (int)blockIdx.x);
        pg8::EpiResid<true> E{p.x, p.out, (bf16*)(ws + WS_XG), p.mlp_norm_w, (float*)(ws + WS_SS2)};
        pg8::gemm_phase<pg8::EpiResid<true>, pg8::StaticOrder, true, true>(lds, g, S, E, wv);
        SEAM(5); STAMP(5 + 1);
    }
    PHASE(6) {
        pg8::Gemm g{(const bf16*)(ws + WS_XG), (const bf16*)(ws + WS_WUP), TOK, DFF, DM, nullptr, 1 << 30};
        pg8::StaticOrder S; S.init(TOK, DFF, G, (int)blockIdx.x);
        pg8::EpiUp E{(const float*)(ws + WS_SS2), (bf16*)(ws + WS_HID)};
        pg8::gemm_phase<pg8::EpiUp, pg8::StaticOrder, true, true>(lds, g, S, E, wv);
        SEAM(6); STAMP(6 + 1);
    }
    PHASE(7) {
        pg8::Gemm g{(const bf16*)(ws + WS_HID), (const bf16*)(ws + WS_WDN), TOK, DM, DFF, nullptr, 1 << 30};
        pg8::StaticOrder S; S.init(TOK, DM, G, (int)blockIdx.x);
        pg8::EpiResid<false> E{p.out, p.out, nullptr, nullptr, (float*)(ws + WS_SS3)};
        pg8::gemm_phase<pg8::EpiResid<false>, pg8::StaticOrder, true, true>(lds, g, S, E, wv);
        SEAM(7); STAMP(7 + 1);
    }
#ifdef EXTRA_SYNCS
#if MK_ONE_LAUNCH
    for (int es_ = 0; es_ < EXTRA_SYNCS; ++es_) xcd_barrier(xbar, wv);
#endif
#endif
    PHASE(8) { phase_final(p, G, wv); }
#undef PHASE
#undef REPS
#undef IN
#undef SEAM
}

extern "C" void kernel_launch(void* const* d_in, const int* in_sizes, int n_in, void* d_out, int out_size, void* d_ws, size_t ws_size, hipStream_t stream) {
    static int grid = 0;
    if (grid == 0) {
        if (n_in != 13 || in_sizes[0] != TOK * DM || out_size != TOK * DM || ws_size < WS_NEED) {
            fprintf(stderr, "kernel_launch: unexpected shapes (n_in %d, in0 %d, out %d, ws %zu); nothing launched\n", n_in, n_in > 0 ? in_sizes[0] : -1, out_size, ws_size); grid = -1; return; }
        int dev = 0, cus = 0, per_cu = 0;
        (void)hipGetDevice(&dev); (void)hipDeviceGetAttribute(&cus, hipDeviceAttributeMultiprocessorCount, dev);
        if (hipFuncSetAttribute((const void*)mk_fwd, hipFuncAttributeMaxDynamicSharedMemorySize, LDS_BYTES) != hipSuccess) { fprintf(stderr, "kernel_launch: hipFuncSetAttribute failed\n"); grid = -1; return; }
        if (hipOccupancyMaxActiveBlocksPerMultiprocessor(&per_cu, (const void*)mk_fwd, NTHREADS, LDS_BYTES) != hipSuccess || per_cu < 1) { fprintf(stderr, "kernel_launch: occupancy query says %d blocks per CU\n", per_cu); per_cu = 1; }
        (void)hipGetLastError();
        if (per_cu > 1) per_cu = 1;
        grid = cus * per_cu;
    }
    if (grid < 0) return;
    Params p{};
    p.x = (const float*)d_in[0]; p.attn_norm_w = (const float*)d_in[1]; p.w_in = (const float*)d_in[2]; p.ikw = (const float*)d_in[3]; p.ikb = (const float*)d_in[4];
    p.sinks = (const float*)d_in[5]; p.w_a = (const float*)d_in[6]; p.w_b = (const float*)d_in[7]; p.w_out = (const float*)d_in[8]; p.mlp_norm_w = (const float*)d_in[9];
    p.w_up = (const float*)d_in[10]; p.w_down = (const float*)d_in[11]; p.final_w = (const float*)d_in[12];
    p.out = (float*)d_out; p.ws = (unsigned char*)d_ws;
    for (int i = 0; i < 32; ++i) p.inv_freq[i] = 1.0f / powf(10000.0f, (float)(2 * i) / 64.0f);
#if MK_ONE_LAUNCH
    if (hipMemsetAsync((char*)d_ws + WS_BAR, 0, 16384, stream) != hipSuccess) { fprintf(stderr, "kernel_launch: hipMemsetAsync of the barrier words failed\n"); return; }
    p.ph_lo = 0; p.ph_hi = NPHASE;
    void* args[] = {&p};
    hipError_t e = hipLaunchCooperativeKernel((const void*)mk_fwd, dim3(grid), dim3(NTHREADS), args, LDS_BYTES, stream);
    if (e != hipSuccess) fprintf(stderr, "kernel_launch: cooperative launch failed: %s (grid %d)\n", hipGetErrorString(e), grid);
#else
    for (int ph = 0; ph < NPHASE; ++ph) {
        p.ph_lo = ph; p.ph_hi = ph + 1;
        hipLaunchKernelGGL(mk_fwd, dim3(grid), dim3(NTHREADS), LDS_BYTES, stream, p);
    }
#endif
}
```

```cpp
#include <hip/hip_runtime.h>
#include <hip/hip_cooperative_groups.h>
#include <cstdio>
#include <cstdint>
namespace cg = cooperative_groups;

#ifndef MK_ONE_LAUNCH
#define MK_ONE_LAUNCH 1
#endif
#ifndef MK_SIMPLE_TOPK
#define MK_SIMPLE_TOPK 0
#endif
#ifndef MK_SIMPLE_SWA
#define MK_SIMPLE_SWA 0
#endif
#ifndef MK_SIMPLE_DSA
#define MK_SIMPLE_DSA 0
#endif

constexpr int NBATCH = 8, SEQ = 4096, DM = 1024, TOK = NBATCH * SEQ, DFF = 4096, TOPK = 256, WIN = 128;
constexpr int NIN = 4352;
constexpr float RMS_EPS = 1e-6f, LN_EPS = 1e-6f;
constexpr float QSCALE = 0.125f * 1.4426950408889634f;
constexpr float LOG2E = 1.4426950408889634f;
constexpr float W_SCALE = 0.04419417382415922f;
constexpr int C_AQ = 0, C_AK = 512, C_AV = 640, C_IQ = 768, C_IK = 1280, C_IW = 1344, C_BQ = 1352, C_BK = 1864, C_BV = 1992, C_GA = 2120, C_GB = 3144, D_IN = 4168;

constexpr size_t MiB = 1u << 20;
constexpr size_t WS_RSTD1 = 0, WS_SS2 = 128 * 1024, WS_SS3 = 256 * 1024;
constexpr size_t WS_BAR = 512 * 1024;
constexpr int XB_LDS_OFF = 163832;
constexpr size_t WS_COS = 1 * MiB, WS_SIN = 1 * MiB + 512 * 1024;
constexpr size_t WS_WIN = 2 * MiB, WS_WAB = 11 * MiB, WS_WOUT = 13 * MiB, WS_WUP = 15 * MiB, WS_WDN = 23 * MiB;
constexpr size_t WS_XG = 32 * MiB;
constexpr size_t WS_AQ = 96 * MiB, WS_IQ = 128 * MiB, WS_BQ = 160 * MiB, WS_AK = 192 * MiB, WS_AV = 200 * MiB, WS_BK = 208 * MiB, WS_BV = 216 * MiB;
constexpr size_t WS_IK = 224 * MiB, WS_IW = 228 * MiB, WS_SEL = 230 * MiB, WS_GA = 248 * MiB, WS_GB = 312 * MiB, WS_MIX = 376 * MiB, WS_END = 440 * MiB;
#ifndef MK_SEPARATE_O
#define MK_SEPARATE_O 0
#endif
#ifndef REP_MASK
#define REP_MASK 0u
#endif
constexpr size_t WS_OA = MK_SEPARATE_O ? 440 * MiB : WS_AQ, WS_OB = MK_SEPARATE_O ? 472 * MiB : WS_BQ, WS_NEED = MK_SEPARATE_O ? 504 * MiB : WS_END;
constexpr size_t WS_HID = 96 * MiB;
static_assert(WS_WIN + (size_t)NIN * DM * 2 <= WS_WAB && WS_HID + (size_t)TOK * DFF * 2 <= WS_MIX, "ws map");

constexpr int LDS_RING = 131072, LDS_BYTES = 163840;

#define GAS __attribute__((address_space(1)))
#define LAS __attribute__((address_space(3)))
typedef unsigned short bf16;
typedef unsigned v4u __attribute__((ext_vector_type(4)));
typedef unsigned v2u __attribute__((ext_vector_type(2)));
typedef float v4f __attribute__((ext_vector_type(4)));

__device__ __forceinline__ float bf2f(unsigned short u) { return __uint_as_float((unsigned)u << 16); }
__device__ __forceinline__ float bflo(unsigned u) { return __uint_as_float(u << 16); }
__device__ __forceinline__ float bfhi(unsigned u) { return __uint_as_float(u & 0xffff0000u); }
__device__ __forceinline__ unsigned f2bf(float f) { unsigned u = __float_as_uint(f); return (u + 0x7fffu + ((u >> 16) & 1u)) >> 16; }
__device__ __forceinline__ unsigned pk2(float lo, float hi) { unsigned r; asm volatile("v_cvt_pk_bf16_f32 %0, %1, %2" : "=v"(r) : "v"(lo), "v"(hi)); return r; }
__device__ __forceinline__ float fexp2(float x) { return __builtin_amdgcn_exp2f(x); }
__device__ __forceinline__ float frsq(float x) { return __builtin_amdgcn_rsqf(x); }
__device__ __forceinline__ float frcp(float x) { return __builtin_amdgcn_rcpf(x); }
__device__ __forceinline__ float sigmoidf_(float x) { return frcp(1.0f + fexp2(-x * LOG2E)); }
__device__ __forceinline__ float wave_sum(float v) {
#pragma unroll
    for (int o = 1; o < 64; o <<= 1) v += __shfl_xor(v, o);
    return v;
}
__device__ __forceinline__ float wave_max(float v) {
#pragma unroll
    for (int o = 1; o < 64; o <<= 1) v = fmaxf(v, __shfl_xor(v, o));
    return v;
}
__device__ __forceinline__ int lane_id() { unsigned m = ~0u; asm volatile("" : "+s"(m)); return __builtin_amdgcn_mbcnt_hi(m, __builtin_amdgcn_mbcnt_lo(m, 0u)); }
__device__ __forceinline__ int tid_op(int wv) { return wv * 64 + lane_id(); }
__device__ __forceinline__ int mbcnt64(unsigned long long m) { return __builtin_amdgcn_mbcnt_hi((unsigned)(m >> 32), __builtin_amdgcn_mbcnt_lo((unsigned)m, 0u)); }

namespace pg8 {
#define PG8_LAS __attribute__((address_space(3)))
typedef unsigned short bf16_t;
typedef short bf16x8 __attribute__((ext_vector_type(8)));
typedef float f32x4 __attribute__((ext_vector_type(4)));
typedef unsigned u32x4 __attribute__((ext_vector_type(4)));
constexpr int BM = 256, BK = 64, HALF = 128, HTB = HALF * BK * 2  , STAGE_BYTES = 8 * HTB, NXCD = 8, WGM = 8;

__host__ __device__ __forceinline__ int lds_byte(int r, int c) { const int st = (r >> 4) * 2 + (c >> 5), rr = r & 15, cc = c & 31, ob = rr * 64 + cc * 2; return st * 1024 + (ob ^ (((ob >> 9) & 1) << 5)); }
__host__ __device__ __forceinline__ void stage_rc(int b, int& R, int& C) { const int st = b / 1024, sb = b % 1024, swz = sb ^ (((sb >> 9) & 1) << 5); R = (st >> 1) * 16 + swz / 64; C = (st & 1) * 32 + (swz % 64) / 2; }
__host__ __device__ __forceinline__ int perm32(int rho) { const int n = rho >> 4, i = rho & 15; return 8 * (i >> 2) + 4 * n + (i & 3); }

struct Unit { int pm, pn; };
struct Gemm { const bf16_t* A; const bf16_t* Bt; int M, N, K; const bf16_t* A2; int asplit;
    __device__ __forceinline__ const char* abase(const Unit& u) const { return (const char*)(u.pn >= asplit ? A2 : A); } };

struct StaticOrder {
    int nM, nN, nwg, G, c;
    __host__ __device__ void init(int M, int N, int G_, int c_) { nM = M / BM; nN = N / BM; nwg = nM * nN; G = G_; c = c_; }
    __host__ __device__ bool next(int i, Unit& u) const {
        const long L = (long)i * G + c; if (L >= nwg) return false;
        int wgid = (int)L; { const int q = nwg / NXCD, r = nwg % NXCD, xcd = wgid % NXCD, off = wgid / NXCD; wgid = (xcd < r ? xcd * (q + 1) : r * (q + 1) + (xcd - r) * q) + off; }
        const int nig = WGM * nN, gid = wgid / nig, fm = gid * WGM, gsz = (nM - fm) < WGM ? (nM - fm) : WGM;
        u.pm = fm + ((wgid % nig) % gsz); u.pn = (wgid % nig) / gsz; return true;
    }
    __device__ __forceinline__ void a_ready(const Unit&) const {}
    __device__ __forceinline__ void done(const Unit&) const {}
};

__device__ __forceinline__ unsigned cvt_pk_bf16(float lo, float hi) { unsigned r; asm volatile("v_cvt_pk_bf16_f32 %0, %1, %2" : "=v"(r) : "v"(lo), "v"(hi)); return r; }
__device__ __forceinline__ u32x4 pack8(const float (&v)[8]) { u32x4 w; w.x = cvt_pk_bf16(v[0], v[1]); w.y = cvt_pk_bf16(v[2], v[3]); w.z = cvt_pk_bf16(v[4], v[5]); w.w = cvt_pk_bf16(v[6], v[7]); return w; }

struct EpiInProj {
    static constexpr bool PERM = true, AFTER_DRAIN = false;
    const float* rstd1; const float* cs; const float* sn; unsigned char* ws; const float* ikw; const float* ikb;
    __device__ __forceinline__ void operator()(const f32x4 (&acc)[2][2][4][2], const Unit& u, int wr, int wc, int fr_, int fq_) const {
        const int pn = u.pn; int fr = fr_, fq = fq_;
        asm volatile("" : "+v"(fr), "+v"(fq));
#pragma unroll
        for (int ai = 0; ai < 2; ++ai)
#pragma unroll
            for (int m = 0; m < 4; ++m) {
                const int row = u.pm * BM + ai * HALF + wr * 64 + m * 16 + fr;
                const float rs = rstd1[row];
                float x1[8], x2[8];
#pragma unroll
                for (int j = 0; j < 4; ++j) { x1[j] = acc[ai][0][m][0][j] * rs; x1[4 + j] = acc[ai][0][m][1][j] * rs; x2[j] = acc[ai][1][m][0][j] * rs; x2[4 + j] = acc[ai][1][m][1][j] * rs; }
                if (pn >= 9) {
                    bf16_t* G = (bf16_t*)(ws + WS_GA + (size_t)((pn - 9) >> 2) * (WS_GB - WS_GA)) + (size_t)row * 1024 + 256 * ((pn - 9) & 3) + 32 * wc + 8 * fq;
                    float a[8], b[8];
#pragma unroll
                    for (int j = 0; j < 8; ++j) { a[j] = 1.0f / (1.0f + __builtin_amdgcn_exp2f(-x1[j] * 1.4426950408889634f)); b[j] = 1.0f / (1.0f + __builtin_amdgcn_exp2f(-x2[j] * 1.4426950408889634f)); }
                    *(u32x4*)G = pack8(a); *(u32x4*)(G + 128) = pack8(b);
                } else if (pn == 8) {
                    if (wc == 0) {
                        float s = 0.f;
#pragma unroll
                        for (int j = 0; j < 8; ++j) s += x1[j] + x2[j];
                        s += __shfl_xor(s, 16); s += __shfl_xor(s, 32);
                        const float mu = s * (1.0f / 64.0f); float q = 0.f;
#pragma unroll
                        for (int j = 0; j < 8; ++j) { x1[j] -= mu; x2[j] -= mu; q += x1[j] * x1[j] + x2[j] * x2[j]; }
                        q += __shfl_xor(q, 16); q += __shfl_xor(q, 32);
                        const float rstd = __builtin_amdgcn_rsqf(q * (1.0f / 64.0f) + 1e-6f);
                        const int pos = row & 4095; const float* cp = cs + pos * 32 + 8 * fq; const float* sp = sn + pos * 32 + 8 * fq;
                        float o1[8], o2[8];
#pragma unroll
                        for (int j = 0; j < 8; ++j) { const float y1 = x1[j] * rstd * ikw[8 * fq + j] + ikb[8 * fq + j], y2 = x2[j] * rstd * ikw[32 + 8 * fq + j] + ikb[32 + 8 * fq + j];
                            const float c = cp[j], sI = sp[j]; o1[j] = y1 * c - y2 * sI; o2[j] = y2 * c + y1 * sI; }
                        unsigned char* tb = ws + WS_IK + (size_t)(row >> 5) * 4096 + (size_t)(row & 31) * 16;
                        *(u32x4*)(tb + (fq >> 1) * 1024 + (fq & 1) * 512) = pack8(o1); *(u32x4*)(tb + (2 + (fq >> 1)) * 1024 + (fq & 1) * 512) = pack8(o2);
                    } else if (wc == 1 && fq == 0) {
                        float* dst = (float*)(ws + WS_IW) + (size_t)row * 8;
                        *(f32x4*)dst = (f32x4){x1[0], x1[1], x1[2], x1[3]} * 0.04419417382415922f; *(f32x4*)(dst + 4) = (f32x4){x1[4], x1[5], x1[6], x1[7]} * 0.04419417382415922f;
                    }
                } else if (pn >= 6) {
                    bf16_t* Kd = (bf16_t*)(ws + WS_AK + (size_t)(pn - 6) * (WS_BK - WS_AK)); bf16_t* Vd = (bf16_t*)(ws + WS_AV + (size_t)(pn - 6) * (WS_BV - WS_AV));
                    if (wc < 2) {
                        const int pos = row & 4095; const float* cp = cs + pos * 32 + 8 * fq; const float* sp = sn + pos * 32 + 8 * fq;
                        float o1[8], o2[8];
#pragma unroll
                        for (int j = 0; j < 8; ++j) { const float c = cp[j], sI = sp[j]; o1[j] = x1[j] * c - x2[j] * sI; o2[j] = x2[j] * c + x1[j] * sI; }
                        bf16_t* dst = Kd + (size_t)row * 128 + wc * 64 + 8 * fq;
                        *(u32x4*)dst = pack8(o1); *(u32x4*)(dst + 32) = pack8(o2);
                    } else {
                        bf16_t* dst = Vd + (size_t)row * 128 + 32 * (wc - 2) + 8 * fq;
                        *(u32x4*)dst = pack8(x1); *(u32x4*)(dst + 64) = pack8(x2);
                    }
                } else {
                    bf16_t* Q = (bf16_t*)(ws + WS_AQ + (size_t)(pn >> 1) * (WS_IQ - WS_AQ)); const float sc = (pn >= 2 && pn < 4) ? 1.0f : 0.125f * 1.4426950408889634f;
                    const int pos = row & 4095; const float* cp = cs + pos * 32 + 8 * fq; const float* sp = sn + pos * 32 + 8 * fq;
                    float o1[8], o2[8];
#pragma unroll
                    for (int j = 0; j < 8; ++j) { const float c = cp[j], sI = sp[j]; o1[j] = (x1[j] * c - x2[j] * sI) * sc; o2[j] = (x2[j] * c + x1[j] * sI) * sc; }
                    bf16_t* dst = Q + (size_t)row * 512 + (4 * (pn & 1) + wc) * 64 + 8 * fq;
                    *(u32x4*)dst = pack8(o1); *(u32x4*)(dst + 32) = pack8(o2);
                }
                asm volatile("" ::: "memory");
            }
    }
};

struct EpiGate {
    static constexpr bool PERM = true, AFTER_DRAIN = false;
    const bf16_t *GA, *GB; float* P; bf16_t* MIX;
    __device__ __forceinline__ void operator()(const f32x4 (&acc)[2][2][4][2], const Unit& u, int wr, int wc, int fr, int fq) const {
        const bool second = u.pn >= 4; const bf16_t* G = second ? GB : GA;
#pragma unroll
        for (int ai = 0; ai < 2; ++ai)
#pragma unroll
            for (int m = 0; m < 4; ++m) {
                const int row = u.pm * BM + ai * HALF + wr * 64 + m * 16 + fr;
#pragma unroll
                for (int bj = 0; bj < 2; ++bj) {
                    const size_t off = (size_t)row * 1024 + 256 * (u.pn & 3) + 128 * bj + 32 * wc + 8 * fq;
                    const u32x4 gw = *(const u32x4*)(G + off);
                    float v[8];
#pragma unroll
                    for (int j = 0; j < 4; ++j) { v[j] = acc[ai][bj][m][0][j]; v[4 + j] = acc[ai][bj][m][1][j]; }
                    v[0] *= __uint_as_float(gw.x << 16); v[1] *= __uint_as_float(gw.x & 0xffff0000u); v[2] *= __uint_as_float(gw.y << 16); v[3] *= __uint_as_float(gw.y & 0xffff0000u);
                    v[4] *= __uint_as_float(gw.z << 16); v[5] *= __uint_as_float(gw.z & 0xffff0000u); v[6] *= __uint_as_float(gw.w << 16); v[7] *= __uint_as_float(gw.w & 0xffff0000u);
                    if (!second) { *(f32x4*)(P + off) = (f32x4){v[0], v[1], v[2], v[3]}; *(f32x4*)(P + off + 4) = (f32x4){v[4], v[5], v[6], v[7]}; }
                    else { const f32x4 p0 = *(const f32x4*)(P + off), p1 = *(const f32x4*)(P + off + 4);
#pragma unroll
                        for (int j = 0; j < 4; ++j) { v[j] += p0[j]; v[4 + j] += p1[j]; }
                        *(u32x4*)(MIX + off) = pack8(v); }
                }
            }
    }
};

template <bool WITH_XG> struct EpiResid {
    static constexpr bool PERM = false, AFTER_DRAIN = false;
    const float* base; float* out; bf16_t* XG; const float* gw; float* ss;
    __device__ __forceinline__ void operator()(const f32x4 (&acc)[2][2][4][2], const Unit& u, int wr, int wc, int fr, int fq) const {
#pragma unroll
        for (int ai = 0; ai < 2; ++ai)
#pragma unroll
            for (int m = 0; m < 4; ++m) {
                const int row = u.pm * BM + ai * HALF + wr * 64 + m * 16 + fr; float s = 0.f;
#pragma unroll
                for (int bj = 0; bj < 2; ++bj)
#pragma unroll
                    for (int n = 0; n < 2; ++n) {
                        const int col = u.pn * BM + bj * HALF + wc * 32 + n * 16 + 4 * fq; const size_t off = (size_t)row * 1024 + col;
                        const f32x4 v = *(const f32x4*)(base + off) + acc[ai][bj][m][n];
                        *(f32x4*)(out + off) = v; s += (v[0] * v[0] + v[1] * v[1]) + (v[2] * v[2] + v[3] * v[3]);
                        if (WITH_XG) { const f32x4 g = *(const f32x4*)(gw + col); unsigned long long w = (unsigned long long)cvt_pk_bf16(v[0] * g[0], v[1] * g[1]) | ((unsigned long long)cvt_pk_bf16(v[2] * g[2], v[3] * g[3]) << 32);
                            *(unsigned long long*)(XG + off) = w; }
                    }
                s += __shfl_xor(s, 16); s += __shfl_xor(s, 32);
                if (fq == 0) atomicAdd(ss + row, s);
            }
    }
};

struct EpiUp {
    static constexpr bool PERM = true, AFTER_DRAIN = false;
    const float* ss; bf16_t* HID;
    __device__ __forceinline__ void operator()(const f32x4 (&acc)[2][2][4][2], const Unit& u, int wr, int wc, int fr, int fq) const {
#pragma unroll
        for (int ai = 0; ai < 2; ++ai)
#pragma unroll
            for (int m = 0; m < 4; ++m) {
                const int row = u.pm * BM + ai * HALF + wr * 64 + m * 16 + fr;
                const float rs = __builtin_amdgcn_rsqf(ss[row] * (1.0f / 1024.0f) + 1e-6f);
#pragma unroll
                for (int bj = 0; bj < 2; ++bj) {
                    float v[8];
#pragma unroll
                    for (int j = 0; j < 4; ++j) { float a = fmaxf(acc[ai][bj][m][0][j] * rs, 0.f), b = fmaxf(acc[ai][bj][m][1][j] * rs, 0.f); v[j] = a * a; v[4 + j] = b * b; }
                    *(u32x4*)(HID + (size_t)row * 4096 + u.pn * BM + bj * HALF + wc * 32 + 8 * fq) = pack8(v);
                }
            }
    }
};

struct BranchOrder {
    int G, c;
    __device__ __forceinline__ bool next(int i, Unit& u) const {
        const int tile = (i >> 1) * G + c; if (tile >= 128 * 4) return false;
        u.pm = tile >> 2; u.pn = (tile & 3) + 4 * (i & 1); return true;
    }
    __device__ __forceinline__ void a_ready(const Unit&) const {}
    __device__ __forceinline__ void done(const Unit&) const {}
};

template <class Epi, class Sched, bool ALIGN_EPI = false, bool SP2 = false>
__device__ __forceinline__ void gemm_phase(PG8_LAS unsigned char* lds, const Gemm g, const Sched& S, const Epi& E, int wv) {
    const int tid = tid_op(wv), wid = wv, lane = tid & 63, wr = wid >> 2, wc = wid & 3, fr = lane & 15, fq = lane >> 4;
    const int K = g.K, nt = K / BK;
    unsigned voffA[2], voffB[2];
#pragma unroll
    for (int i = 0; i < 2; ++i) { int R, C; stage_rc(tid * 16 + i * 8192, R, C); const int Rb = Epi::PERM ? ((R & ~31) + perm32(R & 31)) : R;
        voffA[i] = (unsigned)(R * K + C) * 2u; voffB[i] = (unsigned)(Rb * K + C) * 2u; }
    const size_t kstep = (size_t)(BK * 2);
    const size_t hstep = (size_t)HALF * K * 2;
    const size_t tstep = 2 * hstep;
    const unsigned ldsw = (unsigned)wid * 1024u;
    const int aoff = lds_byte(wr * 64 + fr, fq * 8), boff = lds_byte(wc * 32 + fr, fq * 8);
#define PG8_SA(b, h) (((b) * 2 + (h)) * HTB)
#define PG8_SB(b, h) ((4 + (b) * 2 + (h)) * HTB)
#define PG8_STAGE(bufoff, gbase, voff) do { _Pragma("unroll") for (int _i = 0; _i < 2; ++_i) \
        __builtin_amdgcn_global_load_lds((const unsigned*)((const char*)(gbase) + (voff)[_i]), (PG8_LAS unsigned*)(lds + (bufoff) + ldsw + _i * 8192), 16, 0, 0); } while (0)
#define PG8_LDA(dst, b, h) do { _Pragma("unroll") for (int m = 0; m < 4; ++m) _Pragma("unroll") for (int k = 0; k < 2; ++k) dst[m][k] = *(const PG8_LAS bf16x8*)(lds + PG8_SA(b, h) + aoff + m * 2048 + k * 1024); } while (0)
#define PG8_LDB(dst, b, h) do { _Pragma("unroll") for (int n = 0; n < 2; ++n) _Pragma("unroll") for (int k = 0; k < 2; ++k) dst[n][k] = *(const PG8_LAS bf16x8*)(lds + PG8_SB(b, h) + boff + n * 2048 + k * 1024); } while (0)
#define PG8_MMA(ai, bj, At, Bt) do { __builtin_amdgcn_s_setprio(1); _Pragma("unroll") for (int m = 0; m < 4; ++m) _Pragma("unroll") for (int n = 0; n < 2; ++n) _Pragma("unroll") for (int k = 0; k < 2; ++k) \
        acc[ai][bj][m][n] = __builtin_amdgcn_mfma_f32_16x16x32_bf16(Bt[n][k], At[m][k], acc[ai][bj][m][n], 0, 0, 0); __builtin_amdgcn_s_setprio(0); } while (0)
#define PG8_WAIT_V(n) asm volatile("s_waitcnt vmcnt(" #n ")" ::: "memory")
#define PG8_WAIT_L(n) asm volatile("s_waitcnt lgkmcnt(" #n ")" ::: "memory")
#define PG8_BAR __builtin_amdgcn_s_barrier()
#define PG8_SCHED __builtin_amdgcn_sched_barrier(0)
    Unit cur, nxt; int ui = 0;
    if (!S.next(0, cur)) return;
    f32x4 acc[2][2][4][2];
#pragma unroll
    for (int a = 0; a < 2; ++a)
#pragma unroll
        for (int b = 0; b < 2; ++b)
#pragma unroll
            for (int m = 0; m < 4; ++m)
#pragma unroll
                for (int n = 0; n < 2; ++n) acc[a][b][m][n] = (f32x4){0.f, 0.f, 0.f, 0.f};
    bf16x8 At[4][2], B0[2][2], B1[2][2];
    const char* cA = g.abase(cur) + (size_t)cur.pm * tstep; const char* cB = (const char*)g.Bt + (size_t)cur.pn * tstep;
    S.a_ready(cur);
    if constexpr (SP2) {
        PG8_STAGE(PG8_SB(0, 0), cB, voffB); PG8_STAGE(PG8_SB(0, 1), cB + hstep, voffB); PG8_STAGE(PG8_SA(0, 0), cA, voffA); PG8_STAGE(PG8_SA(0, 1), cA + hstep, voffA);
        if (wr == 1) PG8_BAR;
        PG8_WAIT_V(2); PG8_BAR;
        PG8_STAGE(PG8_SB(1, 0), cB + kstep, voffB); PG8_STAGE(PG8_SA(1, 0), cA + kstep, voffA); PG8_STAGE(PG8_SB(1, 1), cB + hstep + kstep, voffB);
        PG8_WAIT_V(6); PG8_BAR;
    } else {
        PG8_STAGE(PG8_SB(0, 0), cB, voffB); PG8_STAGE(PG8_SA(0, 0), cA, voffA); PG8_STAGE(PG8_SB(0, 1), cB + hstep, voffB); PG8_STAGE(PG8_SA(0, 1), cA + hstep, voffA);
        if (wr == 1) PG8_BAR;
        PG8_WAIT_V(4); PG8_BAR;
        PG8_STAGE(PG8_SB(1, 0), cB + kstep, voffB); PG8_STAGE(PG8_SA(1, 0), cA + kstep, voffA); PG8_STAGE(PG8_SB(1, 1), cB + hstep + kstep, voffB);
        PG8_WAIT_V(6); PG8_BAR;
    }
    for (;;) {
        const bool has_next = S.next(ui + 1, nxt);
        const char* nA = has_next ? g.abase(nxt) + (size_t)nxt.pm * tstep : cA; const char* nB = has_next ? (const char*)g.Bt + (size_t)nxt.pn * tstep : cB;
        for (int t = 0; t < nt; t += 2) {
            const bool last = (t == nt - 2);
            const char* a1 = cA + (size_t)(t + 1) * kstep;
            const char* a2 = last ? nA : cA + (size_t)(t + 2) * kstep; const char* b2 = last ? nB : cB + (size_t)(t + 2) * kstep;
            const char* a3 = a2 + kstep; const char* b3 = b2 + kstep;
            if (last && has_next) S.a_ready(nxt);
            if constexpr (SP2) {
            PG8_LDB(B0, 0, 0); PG8_LDB(B1, 0, 1); PG8_SCHED; PG8_LDA(At, 0, 0); PG8_STAGE(PG8_SA(1, 1), a1 + hstep, voffA);
            PG8_WAIT_V(8); PG8_WAIT_L(0); PG8_BAR; PG8_MMA(0, 0, At, B0); PG8_MMA(0, 1, At, B1); PG8_BAR; PG8_SCHED;
            PG8_LDA(At, 0, 1); PG8_STAGE(PG8_SB(0, 0), b2, voffB); PG8_STAGE(PG8_SB(0, 1), b2 + hstep, voffB); PG8_STAGE(PG8_SA(0, 0), a2, voffA);
            PG8_WAIT_V(8); PG8_WAIT_L(0); PG8_BAR; PG8_MMA(1, 0, At, B0); PG8_MMA(1, 1, At, B1); PG8_BAR; PG8_SCHED;
            PG8_LDB(B0, 1, 0); PG8_LDB(B1, 1, 1); PG8_SCHED; PG8_LDA(At, 1, 0); PG8_STAGE(PG8_SA(0, 1), a2 + hstep, voffA);
            PG8_WAIT_V(8); PG8_WAIT_L(0); PG8_BAR; PG8_MMA(0, 0, At, B0); PG8_MMA(0, 1, At, B1); PG8_BAR; PG8_SCHED;
            PG8_LDA(At, 1, 1); PG8_STAGE(PG8_SB(1, 0), b3, voffB); PG8_STAGE(PG8_SB(1, 1), b3 + hstep, voffB); PG8_STAGE(PG8_SA(1, 0), a3, voffA);
            PG8_WAIT_V(8); PG8_WAIT_L(0); PG8_BAR; PG8_MMA(1, 0, At, B0); PG8_MMA(1, 1, At, B1); PG8_BAR; PG8_SCHED;
            } else {
            PG8_LDB(B0, 0, 0); PG8_SCHED; PG8_LDA(At, 0, 0); PG8_STAGE(PG8_SA(1, 1), a1 + hstep, voffA);
            PG8_WAIT_L(8); PG8_BAR; PG8_WAIT_L(0); PG8_MMA(0, 0, At, B0); PG8_BAR; PG8_SCHED;
            PG8_LDB(B1, 0, 1); PG8_STAGE(PG8_SB(0, 0), b2, voffB);
            PG8_BAR; PG8_WAIT_L(0); PG8_MMA(0, 1, At, B1); PG8_BAR;
            PG8_LDA(At, 0, 1); PG8_STAGE(PG8_SA(0, 0), a2, voffA);
            PG8_BAR; PG8_WAIT_L(0); PG8_MMA(1, 0, At, B0); PG8_BAR; PG8_SCHED;
            PG8_STAGE(PG8_SB(0, 1), b2 + hstep, voffB);
            PG8_WAIT_V(6); PG8_BAR; PG8_MMA(1, 1, At, B1); PG8_BAR;
            PG8_LDB(B0, 1, 0); PG8_SCHED; PG8_LDA(At, 1, 0); PG8_STAGE(PG8_SA(0, 1), a2 + hstep, voffA);
            PG8_WAIT_L(8); PG8_BAR; PG8_WAIT_L(0); PG8_MMA(0, 0, At, B0); PG8_BAR; PG8_SCHED;
            PG8_LDB(B1, 1, 1); PG8_STAGE(PG8_SB(1, 0), b3, voffB);
            PG8_BAR; PG8_WAIT_L(0); PG8_MMA(0, 1, At, B1); PG8_BAR;
            PG8_LDA(At, 1, 1); PG8_STAGE(PG8_SA(1, 0), a3, voffA);
            PG8_BAR; PG8_WAIT_L(0); PG8_MMA(1, 0, At, B0); PG8_BAR; PG8_SCHED;
            PG8_STAGE(PG8_SB(1, 1), b3 + hstep, voffB);
            PG8_WAIT_V(6); PG8_BAR; PG8_MMA(1, 1, At, B1); PG8_BAR;
            }
        }
        if constexpr (ALIGN_EPI) { if (wr == 0) PG8_BAR; }
        if constexpr (!Epi::AFTER_DRAIN) { E(acc, cur, wr, wc, fr, fq); S.done(cur); }
        if (!has_next) break;
#pragma unroll
        for (int a = 0; a < 2; ++a)
#pragma unroll
            for (int b = 0; b < 2; ++b)
#pragma unroll
                for (int m = 0; m < 4; ++m)
#pragma unroll
                    for (int n = 0; n < 2; ++n) acc[a][b][m][n] = (f32x4){0.f, 0.f, 0.f, 0.f};
        cur = nxt; cA = nA; cB = nB; ++ui;
        if constexpr (ALIGN_EPI) { if (wr == 1) PG8_BAR; }
    }
    PG8_WAIT_V(0);
    if constexpr (!ALIGN_EPI) { if (wr == 0) PG8_BAR; }
    PG8_BAR;
    if constexpr (Epi::AFTER_DRAIN) { E.fused(acc, cur, wr, wc, fr, fq, lds, wid, lane); S.done(cur); }
#undef PG8_SA
#undef PG8_SB
#undef PG8_STAGE
#undef PG8_LDA
#undef PG8_LDB
#undef PG8_MMA
#undef PG8_WAIT_V
#undef PG8_WAIT_L
#undef PG8_BAR
#undef PG8_SCHED
}
}
struct Params {
    const float *x, *attn_norm_w, *w_in, *ikw, *ikb, *sinks, *w_a, *w_b, *w_out, *mlp_norm_w, *w_up, *w_down, *final_w;
    float* out; unsigned char* ws;
    float inv_freq[32];
    int ph_lo, ph_hi;
};
constexpr int NWAVES = 8, NTHREADS = 512;

__device__ __forceinline__ int win_src_group(int grp, int& cnt) {
    const int tile = grp >> 3, g = grp & 7; cnt = 32;
    if (tile < 6) { const int base = tile < 2 ? C_AQ : (tile < 4 ? C_IQ : C_BQ); const int head = 4 * (tile & 1) + (g & 3); return base + head * 64 + 32 * (g >> 2); }
    if (tile < 8) { const int kb = tile == 6 ? C_AK : C_BK, vb = tile == 6 ? C_AV : C_BV; const int hf = g >> 2, q = g & 3;
        if (q < 2) return kb + q * 64 + 32 * hf; return vb + 64 * hf + 32 * (q - 2); }
    if (tile == 8) { if (g == 0) return C_IK; if (g == 4) return C_IK + 32; if (g == 1) { cnt = 8; return C_IW; } cnt = 0; return 0; }
    return C_GA + (grp - 72) * 32;
}
__device__ __forceinline__ void p0_transpose_item(const float* W, int ldw, int c0, int cnt, int K, bf16* WT, int n0, int k0, LAS float* scr, int lane) {
#pragma unroll 8
    for (int i = 0; i < 32; ++i) { const int kk = 2 * i + (lane >> 5), n = lane & 31; scr[kk * 33 + n] = (n < cnt) ? W[(size_t)(k0 + kk) * ldw + c0 + n] : 0.f; }
    asm volatile("s_waitcnt lgkmcnt(0)" ::: "memory");
    const int c = lane & 7;
#pragma unroll
    for (int j = 0; j < 4; ++j) { const int n = (lane >> 3) + 8 * j; const LAS float* s = scr + (8 * c) * 33 + n;
        v4u o; o.x = pk2(s[0 * 33], s[1 * 33]); o.y = pk2(s[2 * 33], s[3 * 33]); o.z = pk2(s[4 * 33], s[5 * 33]); o.w = pk2(s[6 * 33], s[7 * 33]);
        *(v4u*)(WT + (size_t)(n0 + n) * K + k0 + 8 * c) = o; }
    asm volatile("s_waitcnt lgkmcnt(0)" ::: "memory");
}
__device__ __forceinline__ void sincos_d(float angf, float& sn, float& cs) {
    const double a = (double)angf; const double kq = __builtin_rint(a * 0.63661977236758134308);
    const double y = (a - kq * 1.57079632679489655800) - kq * 6.123233995736766e-17; const double y2 = y * y;
    double s = y * (1.0 + y2 * (-1.0 / 6 + y2 * (1.0 / 120 + y2 * (-1.0 / 5040 + y2 * (1.0 / 362880 + y2 * (-1.0 / 39916800 + y2 * (1.0 / 6227020800.0)))))));
    double c = 1.0 + y2 * (-0.5 + y2 * (1.0 / 24 + y2 * (-1.0 / 720 + y2 * (1.0 / 40320 + y2 * (-1.0 / 3628800 + y2 * (1.0 / 479001600.0 + y2 * (-1.0 / 87178291200.0)))))));
    const int q = ((int)kq) & 3;
    const double ss = (q == 0) ? s : (q == 1) ? c : (q == 2) ? -s : -c; const double cc = (q == 0) ? c : (q == 1) ? -s : (q == 2) ? -c : s;
    sn = (float)ss; cs = (float)cc;
}
__device__ __forceinline__ void phase_prologue(const Params& p, LAS unsigned char* lds, int G, int wv) {
    const int wave = wv, lane = lane_id();
    unsigned char* ws = p.ws;
    LAS float* scr = (LAS float*)(lds + wave * 16384);
    const int gw = blockIdx.x * NWAVES + wave, NGW = G * NWAVES;
    constexpr int I_IN = (DM / 64) * (NIN / 32), I_A = (512 / 64) * (DM / 32), I_O = (DM / 64) * (DM / 32), I_U = (DM / 64) * (DFF / 32), I_D = (DFF / 64) * (DM / 32);
    constexpr int NITEMS = I_IN + 2 * I_A + I_O + I_U + I_D;
    for (int it = gw; it < NITEMS; it += NGW) {
        int r = it;
        if (r < I_IN) { const int grp = r % (NIN / 32), kb = r / (NIN / 32); int cnt; const int c0 = win_src_group(grp, cnt);
            p0_transpose_item(p.w_in, D_IN, c0, cnt, DM, (bf16*)(ws + WS_WIN), grp * 32, kb * 64, scr, lane); continue; } r -= I_IN;
        if (r < I_A) { const int nb = r % 32, kb = r / 32; p0_transpose_item(p.w_a, DM, nb * 32, 32, 512, (bf16*)(ws + WS_WAB), nb * 32, kb * 64, scr, lane); continue; } r -= I_A;
        if (r < I_A) { const int nb = r % 32, kb = r / 32; p0_transpose_item(p.w_b, DM, nb * 32, 32, 512, (bf16*)(ws + WS_WAB), 1024 + nb * 32, kb * 64, scr, lane); continue; } r -= I_A;
        if (r < I_O) { const int nb = r % 32, kb = r / 32; p0_transpose_item(p.w_out, DM, nb * 32, 32, DM, (bf16*)(ws + WS_WOUT), nb * 32, kb * 64, scr, lane); continue; } r -= I_O;
        if (r < I_U) { const int nb = r % 128, kb = r / 128; p0_transpose_item(p.w_up, DFF, nb * 32, 32, DM, (bf16*)(ws + WS_WUP), nb * 32, kb * 64, scr, lane); continue; } r -= I_U;
        { const int nb = r % 32, kb = r / 32; p0_transpose_item(p.w_down, DM, nb * 32, 32, DFF, (bf16*)(ws + WS_WDN), nb * 32, kb * 64, scr, lane); }
    }
    float* COS = (float*)(ws + WS_COS); float* SIN = (float*)(ws + WS_SIN);
    for (int i = gw * 64 + lane; i < SEQ * 32; i += NGW * 64) { const int pos = i >> 5, d = i & 31; const float ang = (float)pos * p.inv_freq[d]; float s, c; sincos_d(ang, s, c); COS[i] = c; SIN[i] = s; }
    float* RSTD1 = (float*)(ws + WS_RSTD1); float* SS2 = (float*)(ws + WS_SS2); float* SS3 = (float*)(ws + WS_SS3); bf16* XG = (bf16*)(ws + WS_XG);
    v4f g[4];
#pragma unroll
    for (int j = 0; j < 4; ++j) g[j] = *((const v4f*)p.attn_norm_w + lane + 64 * j);
    for (int m = gw; m < TOK; m += NGW) {
        const v4f* xr = (const v4f*)(p.x + (size_t)m * DM) + lane; v4f v[4]; float s = 0.f;
#pragma unroll
        for (int j = 0; j < 4; ++j) { v[j] = xr[64 * j]; s += (v[j].x * v[j].x + v[j].y * v[j].y) + (v[j].z * v[j].z + v[j].w * v[j].w); }
        s = wave_sum(s);
        unsigned long long* o8 = (unsigned long long*)(XG + (size_t)m * DM) + lane;
#pragma unroll
        for (int j = 0; j < 4; ++j) o8[64 * j] = (unsigned long long)pk2(v[j].x * g[j].x, v[j].y * g[j].y) | ((unsigned long long)pk2(v[j].z * g[j].z, v[j].w * g[j].w) << 32);
        if (lane == 0) { RSTD1[m] = frsq(s * (1.0f / DM) + RMS_EPS); SS2[m] = 0.f; SS3[m] = 0.f; }
    }
}

__device__ __forceinline__ unsigned f2key(float f) { const unsigned u = __float_as_uint(f); return (u & 0x80000000u) ? ~u : (u | 0x80000000u); }
__device__ __forceinline__ void phase_topk_simple(const Params& p, LAS unsigned char* lds, int G, int wv) {
    const int wave = wv, lane = lane_id();
    unsigned char* ws = p.ws;
    const bf16* IQ = (const bf16*)(ws + WS_IQ); const bf16* IK = (const bf16*)(ws + WS_IK); const float* IW = (const float*)(ws + WS_IW);
    unsigned short* SEL = (unsigned short*)(ws + WS_SEL);
    LAS unsigned* keys = (LAS unsigned*)(lds + wave * 16384);
    LAS float* qf = (LAS float*)(lds + LDS_RING + wave * 2048);
    const int gw = blockIdx.x * NWAVES + wave, NGW = G * NWAVES;
    for (int row = gw; row < TOK; row += NGW) {
        const int b = row >> 12, t = row & 4095, n = t + 1;
        unsigned short* selrow = SEL + (size_t)row * TOPK;
        if (n <= TOPK) { for (int i = lane; i < n; i += 64) selrow[i] = (unsigned short)i; continue; }
        { const v4u q8 = *((const v4u*)(IQ + (size_t)row * 512) + lane);
            LAS float* d = qf + 8 * lane;
            d[0] = bflo(q8.x); d[1] = bfhi(q8.x); d[2] = bflo(q8.y); d[3] = bfhi(q8.y); d[4] = bflo(q8.z); d[5] = bfhi(q8.z); d[6] = bflo(q8.w); d[7] = bfhi(q8.w); }
        float w[8];
#pragma unroll
        for (int h = 0; h < 8; ++h) w[h] = IW[(size_t)row * 8 + h];
        asm volatile("s_waitcnt lgkmcnt(0)" ::: "memory");
        for (int s0 = 0; s0 < n; s0 += 64) {
            const int s = s0 + lane; const int sc = s < n ? s : t;
            const v4u* kp = (const v4u*)(IK + ((size_t)b * SEQ + sc) * 64);
            float dot[8];
#pragma unroll
            for (int h = 0; h < 8; ++h) dot[h] = 0.f;
#pragma unroll
            for (int c = 0; c < 8; ++c) {
                const v4u k8 = kp[c]; float kf[8] = {bflo(k8.x), bfhi(k8.x), bflo(k8.y), bfhi(k8.y), bflo(k8.z), bfhi(k8.z), bflo(k8.w), bfhi(k8.w)};
#pragma unroll
                for (int h = 0; h < 8; ++h) { const v4f qa = *(const LAS v4f*)(qf + h * 64 + c * 8), qb = *(const LAS v4f*)(qf + h * 64 + c * 8 + 4);
                    dot[h] += (kf[0] * qa.x + kf[1] * qa.y) + (kf[2] * qa.z + kf[3] * qa.w) + (kf[4] * qb.x + kf[5] * qb.y) + (kf[6] * qb.z + kf[7] * qb.w); }
            }
            float sc_ = 0.f;
#pragma unroll
            for (int h = 0; h < 8; ++h) sc_ += w[h] * fmaxf(dot[h], 0.f);
            keys[s] = (s < n) ? f2key(sc_) : 0u;
        }
        asm volatile("s_waitcnt lgkmcnt(0)" ::: "memory");
        const int nch = (n + 63) >> 6;
        unsigned thr = 0u;
        for (int bit = 31; bit >= 0; --bit) {
            const unsigned cand = thr | (1u << bit); int cnt = 0;
            for (int c = 0; c < nch; ++c) cnt += __popcll(__ballot(keys[c * 64 + lane] >= cand));
            if (cnt >= TOPK) thr = cand;
        }
        int cgt = 0;
        for (int c = 0; c < nch; ++c) cgt += __popcll(__ballot(keys[c * 64 + lane] > thr));
        const int need = TOPK - cgt; int pos = 0, ties = 0;
        for (int c = 0; c < nch; ++c) {
            const unsigned k = keys[c * 64 + lane]; const bool gt = k > thr, eq = k == thr;
            const unsigned long long meq = __ballot(eq);
            const bool sel = gt || (eq && (ties + mbcnt64(meq) < need));
            const unsigned long long msel = __ballot(sel);
            if (sel) selrow[pos + mbcnt64(msel)] = (unsigned short)(c * 64 + lane);
            pos += __popcll(msel); ties += __popcll(meq);
        }
    }
}

template <bool SINK, class KeyFn>
__device__ __forceinline__ void attend_wave(const bf16* Q, const bf16* K, const bf16* V, bf16* O, int row, int g, int nslots, const KeyFn& keyfn, const float* sinkv,
                                            LAS float* qf  , LAS float* pf  , LAS int* kidx  , int lane) {
    const int b = row >> 12;
    { const v2u q4 = *((const v2u*)(Q + (size_t)row * 512 + g * 256) + lane);
        LAS float* d = qf + 4 * lane; d[0] = bflo(q4.x); d[1] = bfhi(q4.x); d[2] = bflo(q4.y); d[3] = bfhi(q4.y); }
    asm volatile("s_waitcnt lgkmcnt(0)" ::: "memory");
#pragma unroll 1
    for (int j = 0; j < 4; ++j) {
        const int slot = 64 * j + lane; int key = slot < nslots ? keyfn(slot) : -1; kidx[slot] = key;
        const bool valid = key >= 0; const int kc = valid ? key : 0;
        const v4u* kp = (const v4u*)(K + ((size_t)b * SEQ + kc) * 128 + g * 64);
        float dot[4] = {0.f, 0.f, 0.f, 0.f};
        if (64 * j < nslots) {
#pragma unroll 2
            for (int c = 0; c < 8; ++c) {
                const v4u k8 = kp[c]; float kf[8] = {bflo(k8.x), bfhi(k8.x), bflo(k8.y), bfhi(k8.y), bflo(k8.z), bfhi(k8.z), bflo(k8.w), bfhi(k8.w)};
#pragma unroll
                for (int h = 0; h < 4; ++h) { const v4f qa = *(const LAS v4f*)(qf + h * 64 + c * 8), qb = *(const LAS v4f*)(qf + h * 64 + c * 8 + 4);
                    dot[h] += (kf[0] * qa.x + kf[1] * qa.y) + (kf[2] * qa.z + kf[3] * qa.w) + (kf[4] * qb.x + kf[5] * qb.y) + (kf[6] * qb.z + kf[7] * qb.w); }
            }
        }
        *(LAS v4f*)(pf + slot * 4) = valid ? (v4f){dot[0], dot[1], dot[2], dot[3]} : (v4f){-INFINITY, -INFINITY, -INFINITY, -INFINITY};
    }
    asm volatile("s_waitcnt lgkmcnt(0)" ::: "memory");
    float lg[4][4];
#pragma unroll
    for (int j = 0; j < 4; ++j) { const v4f t4 = *(const LAS v4f*)(pf + (64 * j + lane) * 4); lg[j][0] = t4.x; lg[j][1] = t4.y; lg[j][2] = t4.z; lg[j][3] = t4.w; }
    float inv[4];
#pragma unroll
    for (int h = 0; h < 4; ++h) {
        float mx = fmaxf(fmaxf(lg[0][h], lg[1][h]), fmaxf(lg[2][h], lg[3][h])); mx = wave_max(mx);
        float sk = 0.f; if (SINK) { sk = sinkv[g * 4 + h] * LOG2E; mx = fmaxf(mx, sk); }
        float s = 0.f;
#pragma unroll
        for (int j = 0; j < 4; ++j) { const float e = fexp2(lg[j][h] - mx); lg[j][h] = e; s += e; }
        s = wave_sum(s); if (SINK) s += fexp2(sk - mx);
        inv[h] = 1.0f / s;
    }
#pragma unroll
    for (int j = 0; j < 4; ++j) *(LAS v4f*)(pf + (64 * j + lane) * 4) = (v4f){lg[j][0], lg[j][1], lg[j][2], lg[j][3]};
    asm volatile("s_waitcnt lgkmcnt(0)" ::: "memory");
    float o[4] = {0.f, 0.f, 0.f, 0.f};
    const bf16* Vb = V + (size_t)b * SEQ * 128 + g * 64 + lane;
#pragma unroll 1
    for (int s0 = 0; s0 < nslots; s0 += 8) {
        float vv[8]; v4f pp[8];
#pragma unroll
        for (int i = 0; i < 8; ++i) { const int slot = s0 + i; const int key = slot < nslots ? kidx[slot] : -1; pp[i] = *(const LAS v4f*)(pf + (slot & 255) * 4);
            vv[i] = key >= 0 ? bf2f(Vb[(size_t)key * 128]) : 0.f; if (key < 0) pp[i] = (v4f){0.f, 0.f, 0.f, 0.f}; }
#pragma unroll
        for (int i = 0; i < 8; ++i) { o[0] += pp[i].x * vv[i]; o[1] += pp[i].y * vv[i]; o[2] += pp[i].z * vv[i]; o[3] += pp[i].w * vv[i]; }
    }
    bf16* op = O + (size_t)row * 512 + g * 256 + lane;
#pragma unroll
    for (int h = 0; h < 4; ++h) op[h * 64] = (bf16)f2bf(o[h] * inv[h]);
}
struct SelKey { const unsigned short* selrow; __device__ __forceinline__ int operator()(int slot) const { return (int)selrow[slot]; } };
struct WinKey { int t; __device__ __forceinline__ int operator()(int slot) const { return t - (WIN - 1) + slot; } };

template <bool DO_DSA, bool DO_SWA>
__device__ __forceinline__ void phase_attn_simple(const Params& p, LAS unsigned char* lds, int G, int wv) {
    const int wave = wv, lane = lane_id();
    unsigned char* ws = p.ws;
    LAS float* qf = (LAS float*)(lds + wave * 16384); LAS float* pf = qf + 256; LAS int* kidx = (LAS int*)(pf + 1024);
    const int gw = blockIdx.x * NWAVES + wave, NGW = G * NWAVES;
    const unsigned short* SEL = (const unsigned short*)(ws + WS_SEL);
    for (int item = gw; item < TOK * 2; item += NGW) {
        const int row = item >> 1, g = item & 1, t = row & 4095;
        if (DO_DSA) { SelKey kf{SEL + (size_t)row * TOPK}; const int ns = (t + 1 < TOPK) ? t + 1 : TOPK;
            attend_wave<false>((const bf16*)(ws + WS_AQ), (const bf16*)(ws + WS_AK), (const bf16*)(ws + WS_AV), (bf16*)(ws + WS_OA), row, g, ns, kf, nullptr, qf, pf, kidx, lane); }
        if (DO_SWA) { WinKey kf{t};
            attend_wave<true>((const bf16*)(ws + WS_BQ), (const bf16*)(ws + WS_BK), (const bf16*)(ws + WS_BV), (bf16*)(ws + WS_OB), row, g, WIN, kf, p.sinks, qf, pf, kidx, lane); }
    }
}

__device__ __forceinline__ void phase_final(const Params& p, int G, int wv) {
    const int wave = wv, lane = lane_id();
    const float* SS3 = (const float*)(p.ws + WS_SS3);
    const int gw = blockIdx.x * NWAVES + wave, NGW = G * NWAVES;
    v4f g[4];
#pragma unroll
    for (int j = 0; j < 4; ++j) g[j] = *((const v4f*)p.final_w + lane + 64 * j);
    for (int m = gw; m < TOK; m += NGW) {
        float rs = frsq(SS3[m] * (1.0f / DM) + RMS_EPS);
#ifdef PROBE_TS
        { const unsigned long long* TS = (const unsigned long long*)(p.ws + WS_RSTD1 + 384 * 1024); rs *= 1.0f + (float)(TS[PROBE_TS + 1] - TS[PROBE_TS]) * 1.0e-5f; }
#endif
        v4f* xr = (v4f*)(p.out + (size_t)m * DM) + lane;
#pragma unroll
        for (int j = 0; j < 4; ++j) { v4f v = xr[64 * j]; xr[64 * j] = v * g[j] * rs; }
    }
}

typedef short bf16x8_t __attribute__((ext_vector_type(8)));
typedef float f32x16_t __attribute__((ext_vector_type(16)));
typedef float f32x4_t __attribute__((ext_vector_type(4)));
typedef float f32x2_t __attribute__((ext_vector_type(2)));
__device__ __forceinline__ unsigned f16key(float f) { const int q = (int)__builtin_rintf(f * 4096.0f) + 32768; return (unsigned)(q < 256 ? 256 : (q > 65535 ? 65535 : q)); }
__device__ __forceinline__ float relu1(float x) { return __builtin_amdgcn_fmed3f(x, 0.f, 3.0e38f); }
constexpr int TK_H1 = LDS_RING, TK_WAVE = LDS_RING + 8192, TK_WAVE_BYTES = 3072, TK_CAND = 512;
static_assert(TK_WAVE + 8 * TK_WAVE_BYTES <= LDS_BYTES, "top-k LDS map");

__device__ __forceinline__ void phase_topk_fast(const Params& p, LAS unsigned char* lds, int G, int wv) {
    const int wave = wv, lane = lane_id(), tid = wave * 64 + lane;
    const int r = lane & 31, h = lane >> 5, mt = wave & 3, par = wave >> 2;
    unsigned char* ws = p.ws;
    const bf16* IQ = (const bf16*)(ws + WS_IQ); const bf16* IK = (const bf16*)(ws + WS_IK); const float* IW = (const float*)(ws + WS_IW);
    unsigned short* SEL = (unsigned short*)(ws + WS_SEL);
    LAS unsigned short* kb = (LAS unsigned short*)lds;
    LAS unsigned* H1 = (LAS unsigned*)(lds + TK_H1);
    LAS unsigned* cl = (LAS unsigned*)(lds + TK_WAVE + wave * TK_WAVE_BYTES); LAS unsigned short* ol = (LAS unsigned short*)(lds + TK_WAVE + wave * TK_WAVE_BYTES + 4 * TK_CAND);
    const int qrow = 4 * mt + 2 * ((r >> 2) & 1) + (r >> 4), qhead = 4 * ((r >> 3) & 1) + (r & 3);
    { LAS v4u* hz = (LAS v4u*)H1; hz[tid] = (v4u){0u, 0u, 0u, 0u}; }
    for (int k = 0;; ++k) {
        int b, tile;
        if (G == 256) { if (k >= 8) break; const int c = blockIdx.x, i = c >> 3, grp = k >> 1; b = c & 7; tile = (k & 1) ? (64 * grp + 63 - i) : (64 * grp + i); }
        else { const int u = blockIdx.x + k * G; if (u >= TOK / 16) break; b = u >> 8; tile = u & 255; }
        const int t0 = tile * 16, R0 = b * SEQ + t0;
        if (t0 + 16 <= TOPK) {
            for (int i = tid; i < 16 * TOPK; i += NTHREADS) { const int ql = i >> 8, s = i & 255; if (s <= t0 + ql) SEL[(size_t)(R0 + ql) * TOPK + s] = (unsigned short)s; }
            continue;
        }
        bf16x8_t aq[4];
#pragma unroll
        for (int s = 0; s < 4; ++s) aq[s] = *(const bf16x8_t*)(IQ + (size_t)(R0 + qrow) * 512 + qhead * 64 + 16 * s + 8 * h);
        f32x2_t wq[2][4];
#pragma unroll
        for (int qq = 0; qq < 2; ++qq) { const f32x4_t w0 = *(const f32x4_t*)(IW + (size_t)(R0 + 4 * mt + 2 * h + qq) * 8), w1 = *(const f32x4_t*)(IW + (size_t)(R0 + 4 * mt + 2 * h + qq) * 8 + 4);
            const float n2 = (w0[0] * w0[0] + w0[1] * w0[1]) + (w0[2] * w0[2] + w0[3] * w0[3]) + (w1[0] * w1[0] + w1[1] * w1[1]) + (w1[2] * w1[2] + w1[3] * w1[3]);
            const float sn = __builtin_amdgcn_rsqf(fmaxf(n2, 1e-30f)) * 0.2141f;
            wq[qq][0] = (f32x2_t){w0[0], w0[1]} * sn; wq[qq][1] = (f32x2_t){w0[2], w0[3]} * sn; wq[qq][2] = (f32x2_t){w1[0], w1[1]} * sn; wq[qq][3] = (f32x2_t){w1[2], w1[3]} * sn; }
        const int ntile = (t0 + 16 + 31) >> 5, ntp = (ntile + 7) & ~7, nch = (t0 + 16 + 511) >> 9;
        const char* kbase = (const char*)IK + (size_t)b * SEQ * 128;
        const unsigned voff = (unsigned)(lane * 16);
        const int tq0 = t0 + 4 * mt + 2 * h;
        const int ql0 = 4 * mt + 2 * h;
        LAS unsigned short* row0 = kb + ql0 * 4096; LAS unsigned* h0 = H1 + ql0 * 128;
        __syncthreads();
#define TK_LOAD(dst, kt_) do { const int ktc_ = (kt_) < 127 ? (kt_) : 127; const char* tp_ = kbase + (size_t)ktc_ * 4096; _Pragma("unroll") for (int s_ = 0; s_ < 4; ++s_) dst[s_] = *(const bf16x8_t*)(tp_ + voff + 1024 * s_); } while (0)
#define TK_MMA(acc_, src) do { acc_ = (f32x16_t){0.f, 0.f, 0.f, 0.f, 0.f, 0.f, 0.f, 0.f, 0.f, 0.f, 0.f, 0.f, 0.f, 0.f, 0.f, 0.f}; \
            _Pragma("unroll") for (int s_ = 0; s_ < 4; ++s_) acc_ = __builtin_amdgcn_mfma_f32_32x32x16_bf16(aq[s_], src[s_], acc_, 0, 0, 0); } while (0)
#define TK_POST(acc_, kt_) do { f32x2_t s0_ = {0.f, 0.f}, s1_ = {0.f, 0.f}; \
            _Pragma("unroll") for (int hd_ = 0; hd_ < 4; ++hd_) { s0_ += (f32x2_t){relu1(acc_[2 * hd_]), relu1(acc_[2 * hd_ + 1])} * wq[0][hd_]; s1_ += (f32x2_t){relu1(acc_[8 + 2 * hd_]), relu1(acc_[9 + 2 * hd_])} * wq[1][hd_]; } \
            const int e_ = 32 * (kt_) + r; const unsigned k0_ = (e_ <= tq0) ? f16key(s0_.x + s0_.y) : 0u, k1_ = (e_ <= tq0 + 1) ? f16key(s1_.x + s1_.y) : 0u; \
            row0[e_] = (unsigned short)k0_; row0[4096 + e_] = (unsigned short)k1_; \
            if (k0_) __hip_atomic_fetch_add(h0 + (k0_ >> 9), 1u << ((k0_ >> 4) & 16u), __ATOMIC_RELAXED, __HIP_MEMORY_SCOPE_WORKGROUP); \
            if (k1_) __hip_atomic_fetch_add(h0 + 128 + (k1_ >> 9), 1u << ((k1_ >> 4) & 16u), __ATOMIC_RELAXED, __HIP_MEMORY_SCOPE_WORKGROUP); } while (0)
#ifndef TK_REP_SCORE
#define TK_REP_SCORE 1
#endif
#ifndef TK_REP_SEL
#define TK_REP_SEL 1
#endif
#pragma unroll 1
        for (int rp_ = 0; rp_ < TK_REP_SCORE; ++rp_) {
            bf16x8_t B[4][4]; f32x16_t accA, accB;
            const int nmy = ntp >> 1;
#pragma unroll
            for (int u = 0; u < 4; ++u) TK_LOAD(B[u], par + 2 * u);
            TK_MMA(accA, B[0]);
#pragma unroll 1
            for (int i = 0; i < nmy; i += 4) {
                const int kt = par + 2 * i;
                TK_MMA(accB, B[1]); TK_POST(accA, kt);     TK_LOAD(B[0], kt + 8);
                TK_MMA(accA, B[2]); TK_POST(accB, kt + 2); TK_LOAD(B[1], kt + 10);
                TK_MMA(accB, B[3]); TK_POST(accA, kt + 4); TK_LOAD(B[2], kt + 12);
                TK_MMA(accA, B[0]); TK_POST(accB, kt + 6); TK_LOAD(B[3], kt + 14);
            }
        }
#undef TK_LOAD
#undef TK_MMA
#undef TK_POST
        if (32 * ntp < 512 * nch) {
#pragma unroll
            for (int qi = 0; qi < 2; ++qi) { LAS v2u* z = (LAS v2u*)(kb + (2 * wave + qi) * 4096 + 32 * ntp) + lane; *z = (v2u){0u, 0u}; }
        }
        __syncthreads();
#pragma unroll 1
        for (int qi = 0; qi < 2 * TK_REP_SEL; ++qi) {
            const int ql = 2 * wave + (qi & 1);
            const LAS unsigned short* rb = kb + ql * 4096 + lane;
            const v2u hw = *(const LAS v2u*)(H1 + ql * 128 + 2 * lane); const v4u hv = {hw.x & 0xffffu, hw.x >> 16, hw.y & 0xffffu, hw.y >> 16};
            if ((qi >> 1) + 1 == TK_REP_SEL) *(LAS v2u*)(H1 + ql * 128 + 2 * lane) = (v2u){0u, 0u};
            const int hs = (int)(hv.x + hv.y + hv.z + hv.w); int S = hs;
#pragma unroll
            for (int off = 1; off < 64; off <<= 1) { const int v = __shfl_down(S, off); if (lane + off < 64) S += v; }
            int ab = S - hs; const bool cross = ab < TOPK && S >= TOPK;
            int Bl = 4 * lane + 3;
            if (ab + (int)hv.w < TOPK) { ab += (int)hv.w; Bl = 4 * lane + 2; if (ab + (int)hv.z < TOPK) { ab += (int)hv.z; Bl = 4 * lane + 1; if (ab + (int)hv.y < TOPK) { ab += (int)hv.y; Bl = 4 * lane; } } }
            const unsigned long long mc = __ballot(cross);
            const int src = mc ? (__ffsll((long long)mc) - 1) : 0;
            const unsigned Bb = (unsigned)__shfl(Bl, src);
            const unsigned kmin = Bb << 8; int m = 0;
#pragma unroll 1
            for (int j = 0; j < nch; ++j) {
                unsigned kk[8];
#pragma unroll
                for (int s = 0; s < 8; ++s) kk[s] = rb[512 * j + 64 * s];
#pragma unroll
                for (int s = 0; s < 8; ++s) {
                    const bool in = kk[s] >= kmin;
                    const unsigned long long mi = __ballot(in);
                    if (in) { const int ci = m + mbcnt64(mi); if (ci < TK_CAND) cl[ci] = (kk[s] << 16) | (unsigned)(512 * j + 64 * s + lane); }
                    m += __popcll(mi);
                }
            }
            asm volatile("s_waitcnt lgkmcnt(0)" ::: "memory");
            int pos = 0;
            if (mc != 0ull && m <= TK_CAND && m >= TOPK) {
                unsigned ent[8]; bool val[8];
#pragma unroll
                for (int q = 0; q < 8; ++q) { val[q] = 64 * q + lane < m; ent[q] = val[q] ? cl[64 * q + lane] : 0u; }
                int nab = 0;
#pragma unroll
                for (int q = 0; q < 8; ++q) nab += __popcll(__ballot(val[q] && (ent[q] >> 24) > Bb));
                const int need2 = TOPK - nab;
                unsigned thr2 = 0u;
#pragma unroll 1
                for (int bit = 7; bit >= 0; --bit) {
                    const unsigned cand = thr2 | (1u << bit); int cnt = 0;
#pragma unroll
                    for (int q = 0; q < 8; ++q) cnt += __popcll(__ballot(val[q] && (ent[q] >> 24) == Bb && ((ent[q] >> 16) & 0xffu) >= cand));
                    if (cnt >= need2) thr2 = cand;
                }
                const unsigned kthr = (Bb << 8) | thr2;
                int cgt2 = 0;
#pragma unroll
                for (int q = 0; q < 8; ++q) cgt2 += __popcll(__ballot(val[q] && (ent[q] >> 16) > kthr));
                const int need3 = TOPK - cgt2; int ties = 0;
#pragma unroll
                for (int q = 0; q < 8; ++q) {
                    const unsigned kx = ent[q] >> 16; const bool gt = val[q] && kx > kthr, eq = val[q] && kx == kthr;
                    const unsigned long long meq = __ballot(eq);
                    const bool sel = gt || (eq && (ties + mbcnt64(meq) < need3));
                    const unsigned long long msel = __ballot(sel);
                    if (sel) ol[pos + mbcnt64(msel)] = (unsigned short)(ent[q] & 0xffffu);
                    pos += __popcll(msel); ties += __popcll(meq);
                }
            } else {
                unsigned thr = 0u;
#pragma unroll 1
                for (int bit = 15; bit >= 0; --bit) {
                    const unsigned cand = thr | (1u << bit); int cnt = 0;
#pragma unroll 1
                    for (int i = 0; i < 8 * nch; ++i) cnt += __popcll(__ballot((unsigned)rb[64 * i] >= cand));
                    if (cnt >= TOPK) thr = cand;
                }
                int cgt = 0;
#pragma unroll 1
                for (int i = 0; i < 8 * nch; ++i) cgt += __popcll(__ballot((unsigned)rb[64 * i] > thr));
                const int need = TOPK - cgt; int ties = 0; pos = 0;
#pragma unroll 1
                for (int i = 0; i < 8 * nch; ++i) {
                    const unsigned kx = rb[64 * i]; const bool gt = kx > thr, eq = kx == thr;
                    const unsigned long long meq = __ballot(eq);
                    const bool sel = gt || (eq && (ties + mbcnt64(meq) < need));
                    const unsigned long long msel = __ballot(sel);
                    if (sel) ol[pos + mbcnt64(msel)] = (unsigned short)(64 * i + lane);
                    pos += __popcll(msel); ties += __popcll(meq);
                }
            }
            asm volatile("s_waitcnt lgkmcnt(0)" ::: "memory");
            *((v2u*)(SEL + (size_t)(R0 + ql) * TOPK) + lane) = *(const LAS v2u*)(ol + 4 * lane);
            asm volatile("s_waitcnt lgkmcnt(0)" ::: "memory");
        }
    }
    __syncthreads();
}

typedef short s16x4_t __attribute__((ext_vector_type(4)));
__device__ __forceinline__ s16x4_t tr_read(unsigned addr) { s16x4_t r_; asm volatile("ds_read_b64_tr_b16 %0, %1" : "=v"(r_) : "v"(addr) : "memory"); return r_; }
__device__ __forceinline__ void dma16(const void* src, LAS unsigned char* dst) { __builtin_amdgcn_global_load_lds((const unsigned*)src, (LAS unsigned*)dst, 16, 0, 0); }
constexpr int DSA_WAVE_BYTES = 19968, DSA_PL = 16384, DSA_SIDX = 18432, DSA_QS = 19456;
static_assert(8 * DSA_WAVE_BYTES <= XB_LDS_OFF, "DSA LDS map");

__device__ __forceinline__ void phase_dsa_fast(const Params& p, LAS unsigned char* lds, int G, int wv) {
    const int wave = wv, lane = lane_id();
    const int c16 = lane & 15, kq = lane >> 4;
    unsigned char* ws = p.ws;
    const unsigned char* AQ = ws + WS_AQ; bf16* OA = (bf16*)(ws + WS_OA);
    const unsigned char* SEL = ws + WS_SEL;
    LAS unsigned char* wl = lds + wave * DSA_WAVE_BYTES;
    LAS unsigned short* Pl = (LAS unsigned short*)(wl + DSA_PL); LAS unsigned short* sidx = (LAS unsigned short*)(wl + DSA_SIDX); LAS unsigned char* Qs = wl + DSA_QS;
    const unsigned ring_addr = (unsigned)(size_t)wl;
    const bool arow = (c16 & 3) == 0; const int ahead = c16 >> 2;
    if (!(G >= 8 && (G & 7) == 0)) return;
    const int nper = (G >> 3) * NWAVES, wi = (blockIdx.x >> 3) * NWAVES + wave, b = blockIdx.x & 7;
    const int nrows = (SEQ - wi + nper - 1) / nper, nsteps = 32 * nrows;
    const unsigned char* KVb = ws + WS_AK + (size_t)b * SEQ * 256;
    const int sw16 = ((lane & 7) ^ (lane >> 3)) * 16, r8 = lane >> 3;
#define DSA_ISSUE(n_) do { const int n__ = (n_); if (n__ < nsteps) { const int item_ = n__ >> 4, sub_ = n__ & 15, c_ = sub_ & 7, it_ = item_ >> 1; \
        const int t_ = wi + it_ * nper; const int cnt_ = (t_ + 1 < TOPK) ? t_ + 1 : TOPK; \
        const unsigned char* base_ = KVb + ((sub_ >> 3) ? (WS_AV - WS_AK) : 0) + (item_ & 1) * 128 + sw16; \
        const LAS unsigned short* sx_ = sidx + (it_ & 1) * 256 + 32 * c_ + r8; LAS unsigned char* dst_ = wl + (n__ & 3) * 4096; \
        _Pragma("unroll") for (int i_ = 0; i_ < 4; ++i_) { const int slot_ = 32 * c_ + 8 * i_ + r8; const unsigned key_ = slot_ < cnt_ ? (unsigned)sx_[8 * i_] : 0u; dma16(base_ + (size_t)key_ * 256, dst_ + i_ * 1024); } } } while (0)
#define DSA_WAIT(n_) do { if ((n_) + 3 < nsteps) asm volatile("s_waitcnt vmcnt(12)" ::: "memory"); else asm volatile("s_waitcnt vmcnt(0)" ::: "memory"); } while (0)
    if (nrows > 0) {
        if (lane < 32) { dma16(SEL + (size_t)(b * SEQ + wi) * 512 + lane * 16, (LAS unsigned char*)sidx); dma16(AQ + (size_t)(b * SEQ + wi) * 1024 + lane * 16, Qs); }
        asm volatile("s_waitcnt vmcnt(0)" ::: "memory");
        DSA_ISSUE(0); DSA_ISSUE(1); DSA_ISSUE(2);
    }
#pragma unroll 1
    for (int item = 0; item < 2 * nrows; ++item) {
        const int it = item >> 1, g = item & 1, t = wi + it * nper, row = b * SEQ + t;
        const int cnt = (t + 1 < TOPK) ? t + 1 : TOPK; const int n0 = 16 * item;
        float sc[16]; bf16x8_t aq[2];
#pragma unroll
        for (int c = 0; c < 8; ++c) {
            DSA_ISSUE(n0 + c + 3); DSA_WAIT(n0 + c);
            if (c == 0) {
#pragma unroll
                for (int c2 = 0; c2 < 2; ++c2) { aq[c2] = (bf16x8_t){0, 0, 0, 0, 0, 0, 0, 0}; if (arow) aq[c2] = *(const LAS bf16x8_t*)(Qs + ahead * 128 + 64 * c2 + 16 * kq); }
            }
            const LAS unsigned char* rb = wl + ((n0 + c) & 3) * 4096;
#pragma unroll
            for (int kt = 0; kt < 2; ++kt) {
                const int rr = 16 * kt + c16; const LAS unsigned char* rp = rb + rr * 128;
                const bf16x8_t k0 = *(const LAS bf16x8_t*)(rp + ((kq ^ (rr & 7)) << 4)), k1 = *(const LAS bf16x8_t*)(rp + (((4 + kq) ^ (rr & 7)) << 4));
                f32x4_t a = {0.f, 0.f, 0.f, 0.f};
                a = __builtin_amdgcn_mfma_f32_16x16x32_bf16(aq[0], k0, a, 0, 0, 0); a = __builtin_amdgcn_mfma_f32_16x16x32_bf16(aq[1], k1, a, 0, 0, 0);
                sc[2 * c + kt] = (32 * c + rr < cnt) ? a[0] : -INFINITY;
            }
        }
        float mx = sc[0];
#pragma unroll
        for (int i = 1; i < 16; ++i) mx = fmaxf(mx, sc[i]);
        mx = fmaxf(mx, __shfl_xor(mx, 1)); mx = fmaxf(mx, __shfl_xor(mx, 2)); mx = fmaxf(mx, __shfl_xor(mx, 4)); mx = fmaxf(mx, __shfl_xor(mx, 8));
        float sum = 0.f;
#pragma unroll
        for (int i = 0; i < 16; ++i) { sc[i] = fexp2(sc[i] - mx); sum += sc[i]; }
        sum += __shfl_xor(sum, 1); sum += __shfl_xor(sum, 2); sum += __shfl_xor(sum, 4); sum += __shfl_xor(sum, 8);
        const float inv = 1.0f / sum;
#pragma unroll
        for (int i = 0; i < 16; ++i) Pl[kq * 256 + 16 * i + c16] = (unsigned short)f2bf(sc[i]);
        f32x4_t o[4];
#pragma unroll
        for (int dt = 0; dt < 4; ++dt) o[dt] = (f32x4_t){0.f, 0.f, 0.f, 0.f};
#pragma unroll
        for (int c = 0; c < 8; ++c) {
            DSA_ISSUE(n0 + 8 + c + 3); DSA_WAIT(n0 + 8 + c);
            if (c == 0 && item + 1 < 2 * nrows) {
                if (lane < 32) { const int t2 = wi + ((item + 1) >> 1) * nper; dma16(AQ + (size_t)(b * SEQ + t2) * 1024 + ((item + 1) & 1) * 512 + lane * 16, Qs);
                    if (g == 1) dma16(SEL + (size_t)(b * SEQ + t2) * 512 + lane * 16, (LAS unsigned char*)(sidx + ((it + 1) & 1) * 256)); }
            }
            const unsigned rba = ring_addr + (unsigned)(((n0 + 8 + c) & 3) * 4096);
            bf16x8_t pa = (bf16x8_t){0, 0, 0, 0, 0, 0, 0, 0};
            if (arow) { const s16x4_t lo = *(const LAS s16x4_t*)(Pl + ahead * 256 + 32 * c + 4 * kq), hi = *(const LAS s16x4_t*)(Pl + ahead * 256 + 32 * c + 16 + 4 * kq);
                pa = (bf16x8_t){lo[0], lo[1], lo[2], lo[3], hi[0], hi[1], hi[2], hi[3]}; }
            const int r1 = 4 * kq + (c16 >> 2), pp = c16 & 3;
            s16x4_t vlo[4], vhi[4];
#pragma unroll
            for (int dt = 0; dt < 4; ++dt) { const unsigned off = (unsigned)(r1 * 128 + (((2 * dt + (pp >> 1)) ^ (r1 & 7)) << 4) + 8 * (pp & 1)); vlo[dt] = tr_read(rba + off); vhi[dt] = tr_read(rba + off + 16 * 128); }
            asm volatile("s_waitcnt lgkmcnt(0)" : "+v"(vlo[0]), "+v"(vlo[1]), "+v"(vlo[2]), "+v"(vlo[3]), "+v"(vhi[0]), "+v"(vhi[1]), "+v"(vhi[2]), "+v"(vhi[3]) :: "memory");
            __builtin_amdgcn_sched_barrier(0);
#pragma unroll
            for (int dt = 0; dt < 4; ++dt) { const bf16x8_t vb = (bf16x8_t){vlo[dt][0], vlo[dt][1], vlo[dt][2], vlo[dt][3], vhi[dt][0], vhi[dt][1], vhi[dt][2], vhi[dt][3]};
                o[dt] = __builtin_amdgcn_mfma_f32_16x16x32_bf16(pa, vb, o[dt], 0, 0, 0); }
        }
        bf16* op = OA + (size_t)row * 512 + (4 * g + kq) * 64 + c16;
#pragma unroll
        for (int dt = 0; dt < 4; ++dt) op[16 * dt] = (bf16)f2bf(o[dt][0] * inv);
    }
    asm volatile("s_waitcnt vmcnt(0)" ::: "memory");
#undef DSA_ISSUE
#undef DSA_WAIT
}

typedef float f32x2_t __attribute__((ext_vector_type(2))); typedef __bf16 bf16x2v_t __attribute__((ext_vector_type(2)));
__device__ __forceinline__ unsigned cvtpk_s(float lo, float hi) { f32x2_t v = {lo, hi}; bf16x2v_t b = __builtin_convertvector(v, bf16x2v_t); return __builtin_bit_cast(unsigned, b); }
__device__ __forceinline__ int crow16(int reg, int h) { return (reg & 3) + 8 * (reg >> 2) + 4 * h; }

__device__ __forceinline__ void phase_swa_fast(const Params& p, int G, int wv) {
    const int wave = wv, lane = lane_id(), tid = wave * 64 + lane;
    const int r = lane & 31, h = lane >> 5, hh = wave >> 1, qh = wave & 1;
    unsigned char* ws = p.ws;
    const bf16* BQ = (const bf16*)(ws + WS_BQ); const bf16* BK = (const bf16*)(ws + WS_BK); const bf16* BV = (const bf16*)(ws + WS_BV); bf16* OB = (bf16*)(ws + WS_OB);
    for (int k = 0;; ++k) {
        int b, idx;
        if (G >= 8 && (G & 7) == 0) { idx = (blockIdx.x >> 3) + (G >> 3) * k; if (idx >= 64) break; b = blockIdx.x & 7; }
        else { const int u = blockIdx.x + k * G; if (u >= 512) break; b = u >> 6; idx = u & 63; }
        const int qb = idx >> 1, g = idx & 1, head = 4 * g + hh;
        const float sink = p.sinks[head] * LOG2E;
        const bf16* Kb = BK + (size_t)b * SEQ * 128 + g * 64 + 8 * h; const bf16* Vb = BV + (size_t)b * SEQ * 128 + g * 64 + r;
#pragma unroll 1
        for (int qt = 0; qt < 2; ++qt) {
            const int q0 = 128 * qb + 64 * qh + 32 * qt;
            const size_t qrow = (size_t)b * SEQ + q0 + r;
            bf16x8_t qf[4];
#pragma unroll
            for (int s = 0; s < 4; ++s) qf[s] = *(const bf16x8_t*)(BQ + qrow * 512 + head * 64 + 16 * s + 8 * h);
            f32x16_t S[5];
#pragma unroll
            for (int kt = 0; kt < 5; ++kt) {
                const int kb0 = q0 - 128 + 32 * kt; const int krow_ = kb0 + r; const int kc = krow_ < 0 ? 0 : krow_;
                bf16x8_t kf[4];
#pragma unroll
                for (int s = 0; s < 4; ++s) kf[s] = *(const bf16x8_t*)(Kb + (size_t)kc * 128 + 16 * s);
                f32x16_t a = {0.f, 0.f, 0.f, 0.f, 0.f, 0.f, 0.f, 0.f, 0.f, 0.f, 0.f, 0.f, 0.f, 0.f, 0.f, 0.f};
#pragma unroll
                for (int s = 0; s < 4; ++s) a = __builtin_amdgcn_mfma_f32_32x32x16_bf16(kf[s], qf[s], a, 0, 0, 0);
#pragma unroll
                for (int i = 0; i < 16; ++i) { const int key = kb0 + crow16(i, h); const int rel = q0 + r - key; S[kt][i] = (key >= 0 && rel >= 0 && rel < WIN) ? a[i] : -INFINITY; }
            }
            float mx = sink;
#pragma unroll
            for (int kt = 0; kt < 5; ++kt)
#pragma unroll
                for (int i = 0; i < 16; ++i) mx = fmaxf(mx, S[kt][i]);
            mx = fmaxf(mx, __shfl_xor(mx, 32));
            float l = 0.f;
#pragma unroll
            for (int kt = 0; kt < 5; ++kt)
#pragma unroll
                for (int i = 0; i < 16; ++i) { S[kt][i] = fexp2(S[kt][i] - mx); l += S[kt][i]; }
            l += __shfl_xor(l, 32); l += fexp2(sink - mx);
            const float linv = 1.0f / l;
            f32x16_t O0 = {0.f, 0.f, 0.f, 0.f, 0.f, 0.f, 0.f, 0.f, 0.f, 0.f, 0.f, 0.f, 0.f, 0.f, 0.f, 0.f}, O1 = O0;
#pragma unroll
            for (int kt = 0; kt < 5; ++kt) {
                const int kb0 = q0 - 128 + 32 * kt;
#pragma unroll
                for (int s = 0; s < 2; ++s) {
                    v4u pw; pw.x = cvtpk_s(S[kt][8 * s + 0], S[kt][8 * s + 1]); pw.y = cvtpk_s(S[kt][8 * s + 2], S[kt][8 * s + 3]); pw.z = cvtpk_s(S[kt][8 * s + 4], S[kt][8 * s + 5]); pw.w = cvtpk_s(S[kt][8 * s + 6], S[kt][8 * s + 7]);
                    const bf16x8_t pa = __builtin_bit_cast(bf16x8_t, pw);
                    unsigned short v0[8], v1[8];
#pragma unroll
                    for (int j = 0; j < 8; ++j) { int key = kb0 + 16 * s + 8 * (j >> 2) + 4 * h + (j & 3); key = key < 0 ? 0 : key; v0[j] = Vb[(size_t)key * 128]; v1[j] = Vb[(size_t)key * 128 + 32]; }
                    const bf16x8_t vb0 = (bf16x8_t){(short)v0[0], (short)v0[1], (short)v0[2], (short)v0[3], (short)v0[4], (short)v0[5], (short)v0[6], (short)v0[7]};
                    const bf16x8_t vb1 = (bf16x8_t){(short)v1[0], (short)v1[1], (short)v1[2], (short)v1[3], (short)v1[4], (short)v1[5], (short)v1[6], (short)v1[7]};
                    O0 = __builtin_amdgcn_mfma_f32_32x32x16_bf16(pa, vb0, O0, 0, 0, 0); O1 = __builtin_amdgcn_mfma_f32_32x32x16_bf16(pa, vb1, O1, 0, 0, 0);
                }
            }
            bf16* op = OB + ((size_t)b * SEQ + q0) * 512 + head * 64 + r;
#pragma unroll
            for (int i = 0; i < 16; ++i) { const int qq = crow16(i, h); const float li = __shfl(linv, qq); op[(size_t)qq * 512] = (bf16)f2bf(O0[i] * li); op[(size_t)qq * 512 + 32] = (bf16)f2bf(O1[i] * li); }
        }
    }
}

#define XB_TMO      128
#define XB_XCNT(j)  (256  + 64 * (j))
#define XB_XSUB(j)  (1280 + 64 * (j))
#define XB_XGEN(j)  (2304 + 64 * (j))
#define XB_TOP      3328
#define XB_TOPGEN   3392
#define XCD_BAR_WORDS 3456
#define XB_SPIN_CAP (1u << 18)

__device__ __forceinline__ unsigned xb_ld(unsigned* p)              { return __hip_atomic_load(p, __ATOMIC_RELAXED, __HIP_MEMORY_SCOPE_AGENT); }
__device__ __forceinline__ unsigned xb_add(unsigned* p, unsigned v) { return __hip_atomic_fetch_add(p, v, __ATOMIC_RELAXED, __HIP_MEMORY_SCOPE_AGENT); }
__device__ __forceinline__ unsigned xb_xcc_id() { return (unsigned)__builtin_amdgcn_s_getreg((3 << 11) | 20) & 0xFu; }
#define XB_SPIN(cond, bar) do { unsigned _sp = 0; while (cond) { __builtin_amdgcn_s_sleep(1); \
    if ((++_sp & 255u) == 0u) { if (xb_ld(&(bar)[XB_TMO])) break; if (_sp > XB_SPIN_CAP) { atomicAdd(&(bar)[XB_TMO], 1u); break; } } } } while (0)

struct XcdBarrier {
    unsigned* bar; unsigned x;
    volatile LAS unsigned* st;
};

__device__ __forceinline__ XcdBarrier xcd_barrier_post(unsigned* bar, volatile LAS unsigned* st) {
    XcdBarrier b; b.bar = bar; b.x = xb_xcc_id(); b.st = st;
    if (threadIdx.x == 0) (void)xb_add(&bar[XB_XCNT(b.x)], 1u);
    return b;
}
__device__ __forceinline__ void xcd_barrier_complete(unsigned* bar, unsigned x, unsigned& nloc, unsigned& nx) {
    const unsigned G = gridDim.x * gridDim.y * gridDim.z;
    unsigned sum, cnt, mine, sp = 0u;
    for (;;) {
        sum = 0u; cnt = 0u; mine = 0u;
#pragma unroll
        for (unsigned j = 0; j < 16; ++j) { const unsigned c = xb_ld(&bar[XB_XCNT(j)]); sum += c; cnt += (c > 0u) ? 1u : 0u; mine = (j == x) ? c : mine; }
        if (sum == G) break;
        __builtin_amdgcn_s_sleep(1);
        if ((++sp & 255u) == 0u) { if (xb_ld(&bar[XB_TMO])) break; if (sp > XB_SPIN_CAP) { atomicAdd(&bar[XB_TMO], 1u); break; } }
    }
    nloc = mine > 0u ? mine : 1u; nx = cnt > 0u ? cnt : 1u;
}

__device__ __forceinline__ void xcd_barrier(const XcdBarrier& b, int wv) {
    asm volatile("s_waitcnt vmcnt(0)" ::: "memory");
    __syncthreads();
    if (wv == 0 && lane_id() == 0) {
        unsigned* bar = b.bar;
        __builtin_amdgcn_s_waitcnt(0);
        unsigned nloc = b.st[0], nx = b.st[1];
        if (nloc == 0u) { xcd_barrier_complete(bar, b.x, nloc, nx); b.st[0] = nloc; b.st[1] = nx; }
        const unsigned old = xb_add(&bar[XB_XSUB(b.x)], 1u);
        const unsigned gen = old / nloc;
        if (old + 1u == (gen + 1u) * nloc) {
            __builtin_amdgcn_fence(__ATOMIC_RELEASE, "agent");
            asm volatile("s_waitcnt vmcnt(0)" ::: "memory");
            const unsigned og = xb_add(&bar[XB_TOP], 1u);
            const unsigned tg = og / nx;
            if (og + 1u == (tg + 1u) * nx) xb_add(&bar[XB_TOPGEN], 1u);
            else XB_SPIN(xb_ld(&bar[XB_TOPGEN]) == tg, bar);
            __builtin_amdgcn_fence(__ATOMIC_ACQUIRE, "agent");
            xb_add(&bar[XB_XGEN(b.x)], 1u);
            asm volatile("s_waitcnt vmcnt(0)" ::: "memory");
        } else {
            XB_SPIN(xb_ld(&bar[XB_XGEN(b.x)]) == gen, bar);
            __builtin_amdgcn_fence(__ATOMIC_ACQUIRE, "agent");
            asm volatile("s_waitcnt vmcnt(0)" ::: "memory");
        }
    }
    __syncthreads();
}

constexpr int NPHASE = 9;
__global__ void __launch_bounds__(NTHREADS, 2) mk_fwd(Params p) {
    extern __shared__ __attribute__((aligned(16))) unsigned char lds_raw[];
    LAS unsigned char* lds = (LAS unsigned char*)lds_raw;
    const int G = gridDim.x, wv = __builtin_amdgcn_readfirstlane(threadIdx.x >> 6);
    unsigned char* ws = p.ws;
#if MK_ONE_LAUNCH
#define SEAM(k) do { if (rep_ + 1 < REPS(k)) __syncthreads(); else if (lo <= (k) && (k) + 1 < hi) { xcd_barrier(xbar, wv); } } while (0)
#else
#define SEAM(k) do { if (rep_ + 1 < REPS(k)) __syncthreads(); } while (0)
#endif
    const int lo = p.ph_lo, hi = p.ph_hi;
#if MK_ONE_LAUNCH
    if (threadIdx.x == 0) { ((volatile LAS unsigned*)(lds + XB_LDS_OFF))[0] = 0u; ((volatile LAS unsigned*)(lds + XB_LDS_OFF))[1] = 0u; }
    const XcdBarrier xbar = xcd_barrier_post((unsigned*)(ws + WS_BAR), (volatile LAS unsigned*)(lds + XB_LDS_OFF));
#endif
#ifdef PROBE_TS
    unsigned long long* TS = (unsigned long long*)(ws + WS_RSTD1 + 384 * 1024);
#define STAMP(k) do { if (blockIdx.x == 0) TS[k] = __builtin_amdgcn_s_memrealtime(); } while (0)
#else
#define STAMP(k) do { } while (0)
#endif
#if MK_ONE_LAUNCH
    if (p.ph_hi > 1000) cg::this_grid().sync();
#endif
    STAMP(0);
#ifndef PHMASK
#define PHMASK 0x1ffu
#endif
#define IN(k) (((PHMASK >> (k)) & 1u) && lo <= (k) && (k) < hi)
#define REPS(k) (((REP_MASK >> (k)) & 1u) ? 2 : 1)
#define PHASE(k) if (IN(k)) for (int rep_ = 0; rep_ < REPS(k); ++rep_)
    PHASE(0) { phase_prologue(p, lds, G, wv); SEAM(0); STAMP(0 + 1); }
    PHASE(1) {
        pg8::Gemm g{(const bf16*)(ws + WS_XG), (const bf16*)(ws + WS_WIN), TOK, NIN, DM, nullptr, 1 << 30};
        pg8::StaticOrder S; S.init(TOK, NIN, G, (int)blockIdx.x);
        pg8::EpiInProj E{(const float*)(ws + WS_RSTD1), (const float*)(ws + WS_COS), (const float*)(ws + WS_SIN), ws, p.ikw, p.ikb};
        pg8::gemm_phase<pg8::EpiInProj, pg8::StaticOrder, true, true>(lds, g, S, E, wv);
        SEAM(1); STAMP(1 + 1);
    }
#if MK_SIMPLE_TOPK
    PHASE(2) { phase_topk_simple(p, lds, G, wv); SEAM(2); STAMP(2 + 1); }
#else
    PHASE(2) { phase_topk_fast(p, lds, G, wv); SEAM(2); STAMP(2 + 1); }
#endif
#if MK_SIMPLE_DSA
    PHASE(3) { phase_attn_simple<true, true>(p, lds, G, wv); SEAM(3); STAMP(3 + 1); }
#else
#if MK_SIMPLE_SWA
    PHASE(3) { phase_dsa_fast(p, lds, G, wv); __syncthreads(); phase_attn_simple<false, true>(p, lds, G, wv); SEAM(3); STAMP(3 + 1); }
#else
#ifndef REP_SWA
#define REP_SWA 1
#endif
#ifndef REP_DSA
#define REP_DSA 1
#endif
    PHASE(3) { for (int q_ = 0; q_ < REP_SWA; ++q_) phase_swa_fast(p, G, wv); for (int q_ = 0; q_ < REP_DSA; ++q_) phase_dsa_fast(p, lds, G, wv); SEAM(3); STAMP(3 + 1); }
#endif
#endif
    PHASE(4) {
        pg8::Gemm g{(const bf16*)(ws + WS_OA), (const bf16*)(ws + WS_WAB), TOK, 2048, 512, (const bf16*)(ws + WS_OB), 4};
        pg8::BranchOrder S{G, (int)blockIdx.x};
        pg8::EpiGate E{(const bf16*)(ws + WS_GA), (const bf16*)(ws + WS_GB), p.out, (bf16*)(ws + WS_MIX)};
        pg8::gemm_phase<pg8::EpiGate, pg8::BranchOrder, true, true>(lds, g, S, E, wv);
        SEAM(4); STAMP(4 + 1);
    }
    PHASE(5) {
        pg8::Gemm g{(const bf16*)(ws + WS_MIX), (const bf16*)(ws + WS_WOUT), TOK, DM, DM, nullptr, 1 << 30};
        pg8::StaticOrder S; S.init(TOK, DM, G, (int)blockIdx.x);
        pg8::EpiResid<true> E{p.x, p.out, (bf16*)(ws + WS_XG), p.mlp_norm_w, (float*)(ws + WS_SS2)};
        pg8::gemm_phase<pg8::EpiResid<true>, pg8::StaticOrder, true, true>(lds, g, S, E, wv);
        SEAM(5); STAMP(5 + 1);
    }
    PHASE(6) {
        pg8::Gemm g{(const bf16*)(ws + WS_XG), (const bf16*)(ws + WS_WUP), TOK, DFF, DM, nullptr, 1 << 30};
        pg8::StaticOrder S; S.init(TOK, DFF, G, (int)blockIdx.x);
        pg8::EpiUp E{(const float*)(ws + WS_SS2), (bf16*)(ws + WS_HID)};
        pg8::gemm_phase<pg8::EpiUp, pg8::StaticOrder, true, true>(lds, g, S, E, wv);
        SEAM(6); STAMP(6 + 1);
    }
    PHASE(7) {
        pg8::Gemm g{(const bf16*)(ws + WS_HID), (const bf16*)(ws + WS_WDN), TOK, DM, DFF, nullptr, 1 << 30};
        pg8::StaticOrder S; S.init(TOK, DM, G, (int)blockIdx.x);
        pg8::EpiResid<false> E{p.out, p.out, nullptr, nullptr, (float*)(ws + WS_SS3)};
        pg8::gemm_phase<pg8::EpiResid<false>, pg8::StaticOrder, true, true>(lds, g, S, E, wv);
        SEAM(7); STAMP(7 + 1);
    }
#ifdef EXTRA_SYNCS
#if MK_ONE_LAUNCH
    for (int es_ = 0; es_ < EXTRA_SYNCS; ++es_) xcd_barrier(xbar, wv);
#endif
#endif
    PHASE(8) { phase_final(p, G, wv); }
#undef PHASE
#undef REPS
#undef IN
#undef SEAM
}

extern "C" void kernel_launch(void* const* d_in, const int* in_sizes, int n_in, void* d_out, int out_size, void* d_ws, size_t ws_size, hipStream_t stream) {
    static int grid = 0;
    if (grid == 0) {
        if (n_in != 13 || in_sizes[0] != TOK * DM || out_size != TOK * DM || ws_size < WS_NEED) {
            fprintf(stderr, "kernel_launch: unexpected shapes (n_in %d, in0 %d, out %d, ws %zu); nothing launched\n", n_in, n_in > 0 ? in_sizes[0] : -1, out_size, ws_size); grid = -1; return; }
        int dev = 0, cus = 0, per_cu = 0;
        (void)hipGetDevice(&dev); (void)hipDeviceGetAttribute(&cus, hipDeviceAttributeMultiprocessorCount, dev);
        if (hipFuncSetAttribute((const void*)mk_fwd, hipFuncAttributeMaxDynamicSharedMemorySize, LDS_BYTES) != hipSuccess) { fprintf(stderr, "kernel_launch: hipFuncSetAttribute failed\n"); grid = -1; return; }
        if (hipOccupancyMaxActiveBlocksPerMultiprocessor(&per_cu, (const void*)mk_fwd, NTHREADS, LDS_BYTES) != hipSuccess || per_cu < 1) { fprintf(stderr, "kernel_launch: occupancy query says %d blocks per CU\n", per_cu); per_cu = 1; }
        (void)hipGetLastError();
        if (per_cu > 1) per_cu = 1;
        grid = cus * per_cu;
    }
    if (grid < 0) return;
    Params p{};
    p.x = (const float*)d_in[0]; p.attn_norm_w = (const float*)d_in[1]; p.w_in = (const float*)d_in[2]; p.ikw = (const float*)d_in[3]; p.ikb = (const float*)d_in[4];
    p.sinks = (const float*)d_in[5]; p.w_a = (const float*)d_in[6]; p.w_b = (const float*)d_in[7]; p.w_out = (const float*)d_in[8]; p.mlp_norm_w = (const float*)d_in[9];
    p.w_up = (const float*)d_in[10]; p.w_down = (const float*)d_in[11]; p.final_w = (const float*)d_in[12];
    p.out = (float*)d_out; p.ws = (unsigned char*)d_ws;
    for (int i = 0; i < 32; ++i) p.inv_freq[i] = 1.0f / powf(10000.0f, (float)(2 * i) / 64.0f);
#if MK_ONE_LAUNCH
    if (hipMemsetAsync((char*)d_ws + WS_BAR, 0, 16384, stream) != hipSuccess) { fprintf(stderr, "kernel_launch: hipMemsetAsync of the barrier words failed\n"); return; }
    p.ph_lo = 0; p.ph_hi = NPHASE;
    void* args[] = {&p};
    hipError_t e = hipLaunchCooperativeKernel((const void*)mk_fwd, dim3(grid), dim3(NTHREADS), args, LDS_BYTES, stream);
    if (e != hipSuccess) fprintf(stderr, "kernel_launch: cooperative launch failed: %s (grid %d)\n", hipGetErrorString(e), grid);
#else
    for (int ph = 0; ph < NPHASE; ++ph) {
        p.ph_lo = ph; p.ph_hi = ph + 1;
        hipLaunchKernelGGL(mk_fwd, dim3(grid), dim3(NTHREADS), LDS_BYTES, stream, p);
    }
#endif
}
```

```cpp
#include <hip/hip_runtime.h>
#include <hip/hip_cooperative_groups.h>
#include <cstdio>
#include <cstdint>
namespace cg = cooperative_groups;

#ifndef MK_ONE_LAUNCH
#define MK_ONE_LAUNCH 1
#endif
#ifndef MK_SIMPLE_TOPK
#define MK_SIMPLE_TOPK 0
#endif
#ifndef MK_SIMPLE_SWA
#define MK_SIMPLE_SWA 0
#endif
#ifndef MK_SIMPLE_DSA
#define MK_SIMPLE_DSA 0
#endif

constexpr int NBATCH = 8, SEQ = 4096, DM = 1024, TOK = NBATCH * SEQ, DFF = 4096, TOPK = 256, WIN = 128;
constexpr int NIN = 4352;
constexpr float RMS_EPS = 1e-6f, LN_EPS = 1e-6f;
constexpr float QSCALE = 0.125f * 1.4426950408889634f;
constexpr float LOG2E = 1.4426950408889634f;
constexpr float W_SCALE = 0.04419417382415922f;
constexpr int C_AQ = 0, C_AK = 512, C_AV = 640, C_IQ = 768, C_IK = 1280, C_IW = 1344, C_BQ = 1352, C_BK = 1864, C_BV = 1992, C_GA = 2120, C_GB = 3144, D_IN = 4168;

constexpr size_t MiB = 1u << 20;
constexpr size_t WS_RSTD1 = 0, WS_SS2 = 128 * 1024, WS_SS3 = 256 * 1024;
constexpr size_t WS_BAR = 512 * 1024;
constexpr int XB_LDS_OFF = 163832;
constexpr size_t WS_COS = 1 * MiB, WS_SIN = 1 * MiB + 512 * 1024;
constexpr size_t WS_WIN = 2 * MiB, WS_WAB = 11 * MiB, WS_WOUT = 13 * MiB, WS_WUP = 15 * MiB, WS_WDN = 23 * MiB;
constexpr size_t WS_XG = 32 * MiB;
constexpr size_t WS_AQ = 96 * MiB, WS_IQ = 128 * MiB, WS_BQ = 160 * MiB, WS_AK = 192 * MiB, WS_AV = 200 * MiB, WS_BK = 208 * MiB, WS_BV = 216 * MiB;
constexpr size_t WS_IK = 224 * MiB, WS_IW = 228 * MiB, WS_SEL = 230 * MiB, WS_GA = 248 * MiB, WS_GB = 312 * MiB, WS_MIX = 376 * MiB, WS_END = 440 * MiB;
#ifndef MK_SEPARATE_O
#define MK_SEPARATE_O 0
#endif
#ifndef REP_MASK
#define REP_MASK 0u
#endif
constexpr size_t WS_OA = MK_SEPARATE_O ? 440 * MiB : WS_AQ, WS_OB = MK_SEPARATE_O ? 472 * MiB : WS_BQ, WS_NEED = MK_SEPARATE_O ? 504 * MiB : WS_END;
constexpr size_t WS_HID = 96 * MiB;
static_assert(WS_WIN + (size_t)NIN * DM * 2 <= WS_WAB && WS_HID + (size_t)TOK * DFF * 2 <= WS_MIX, "ws map");

constexpr int LDS_RING = 131072, LDS_BYTES = 163840;

#define GAS __attribute__((address_space(1)))
#define LAS __attribute__((address_space(3)))
typedef unsigned short bf16;
typedef unsigned v4u __attribute__((ext_vector_type(4)));
typedef unsigned v2u __attribute__((ext_vector_type(2)));
typedef float v4f __attribute__((ext_vector_type(4)));

__device__ __forceinline__ float bf2f(unsigned short u) { return __uint_as_float((unsigned)u << 16); }
__device__ __forceinline__ float bflo(unsigned u) { return __uint_as_float(u << 16); }
__device__ __forceinline__ float bfhi(unsigned u) { return __uint_as_float(u & 0xffff0000u); }
__device__ __forceinline__ unsigned f2bf(float f) { unsigned u = __float_as_uint(f); return (u + 0x7fffu + ((u >> 16) & 1u)) >> 16; }
__device__ __forceinline__ unsigned pk2(float lo, float hi) { unsigned r; asm volatile("v_cvt_pk_bf16_f32 %0, %1, %2" : "=v"(r) : "v"(lo), "v"(hi)); return r; }
__device__ __forceinline__ float fexp2(float x) { return __builtin_amdgcn_exp2f(x); }
__device__ __forceinline__ float frsq(float x) { return __builtin_amdgcn_rsqf(x); }
__device__ __forceinline__ float frcp(float x) { return __builtin_amdgcn_rcpf(x); }
__device__ __forceinline__ float sigmoidf_(float x) { return frcp(1.0f + fexp2(-x * LOG2E)); }
__device__ __forceinline__ float wave_sum(float v) {
#pragma unroll
    for (int o = 1; o < 64; o <<= 1) v += __shfl_xor(v, o);
    return v;
}
__device__ __forceinline__ float wave_max(float v) {
#pragma unroll
    for (int o = 1; o < 64; o <<= 1) v = fmaxf(v, __shfl_xor(v, o));
    return v;
}
__device__ __forceinline__ int lane_id() { unsigned m = ~0u; asm volatile("" : "+s"(m)); return __builtin_amdgcn_mbcnt_hi(m, __builtin_amdgcn_mbcnt_lo(m, 0u)); }
__device__ __forceinline__ int tid_op(int wv) { return wv * 64 + lane_id(); }
__device__ __forceinline__ int mbcnt64(unsigned long long m) { return __builtin_amdgcn_mbcnt_hi((unsigned)(m >> 32), __builtin_amdgcn_mbcnt_lo((unsigned)m, 0u)); }

namespace pg8 {
#define PG8_LAS __attribute__((address_space(3)))
typedef unsigned short bf16_t;
typedef short bf16x8 __attribute__((ext_vector_type(8)));
typedef float f32x4 __attribute__((ext_vector_type(4)));
typedef unsigned u32x4 __attribute__((ext_vector_type(4)));
constexpr int BM = 256, BK = 64, HALF = 128, HTB = HALF * BK * 2  , STAGE_BYTES = 8 * HTB, NXCD = 8, WGM = 8;

__host__ __device__ __forceinline__ int lds_byte(int r, int c) { const int st = (r >> 4) * 2 + (c >> 5), rr = r & 15, cc = c & 31, ob = rr * 64 + cc * 2; return st * 1024 + (ob ^ (((ob >> 9) & 1) << 5)); }
__host__ __device__ __forceinline__ void stage_rc(int b, int& R, int& C) { const int st = b / 1024, sb = b % 1024, swz = sb ^ (((sb >> 9) & 1) << 5); R = (st >> 1) * 16 + swz / 64; C = (st & 1) * 32 + (swz % 64) / 2; }
__host__ __device__ __forceinline__ int perm32(int rho) { const int n = rho >> 4, i = rho & 15; return 8 * (i >> 2) + 4 * n + (i & 3); }

struct Unit { int pm, pn; };
struct Gemm { const bf16_t* A; const bf16_t* Bt; int M, N, K; const bf16_t* A2; int asplit;
    __device__ __forceinline__ const char* abase(const Unit& u) const { return (const char*)(u.pn >= asplit ? A2 : A); } };

struct StaticOrder {
    int nM, nN, nwg, G, c;
    __host__ __device__ void init(int M, int N, int G_, int c_) { nM = M / BM; nN = N / BM; nwg = nM * nN; G = G_; c = c_; }
    __host__ __device__ bool next(int i, Unit& u) const {
        const long L = (long)i * G + c; if (L >= nwg) return false;
        int wgid = (int)L; { const int q = nwg / NXCD, r = nwg % NXCD, xcd = wgid % NXCD, off = wgid / NXCD; wgid = (xcd < r ? xcd * (q + 1) : r * (q + 1) + (xcd - r) * q) + off; }
        const int nig = WGM * nN, gid = wgid / nig, fm = gid * WGM, gsz = (nM - fm) < WGM ? (nM - fm) : WGM;
        u.pm = fm + ((wgid % nig) % gsz); u.pn = (wgid % nig) / gsz; return true;
    }
    __device__ __forceinline__ void a_ready(const Unit&) const {}
    __device__ __forceinline__ void done(const Unit&) const {}
};

__device__ __forceinline__ unsigned cvt_pk_bf16(float lo, float hi) { unsigned r; asm volatile("v_cvt_pk_bf16_f32 %0, %1, %2" : "=v"(r) : "v"(lo), "v"(hi)); return r; }
__device__ __forceinline__ u32x4 pack8(const float (&v)[8]) { u32x4 w; w.x = cvt_pk_bf16(v[0], v[1]); w.y = cvt_pk_bf16(v[2], v[3]); w.z = cvt_pk_bf16(v[4], v[5]); w.w = cvt_pk_bf16(v[6], v[7]); return w; }

struct EpiInProj {
    static constexpr bool PERM = true, AFTER_DRAIN = false;
    const float* rstd1; const float* cs; const float* sn; unsigned char* ws; const float* ikw; const float* ikb;
    __device__ __forceinline__ void operator()(const f32x4 (&acc)[2][2][4][2], const Unit& u, int wr, int wc, int fr_, int fq_) const {
        const int pn = u.pn; int fr = fr_, fq = fq_;
        asm volatile("" : "+v"(fr), "+v"(fq));
#pragma unroll
        for (int ai = 0; ai < 2; ++ai)
#pragma unroll
            for (int m = 0; m < 4; ++m) {
                const int row = u.pm * BM + ai * HALF + wr * 64 + m * 16 + fr;
                const float rs = rstd1[row];
                float x1[8], x2[8];
#pragma unroll
                for (int j = 0; j < 4; ++j) { x1[j] = acc[ai][0][m][0][j] * rs; x1[4 + j] = acc[ai][0][m][1][j] * rs; x2[j] = acc[ai][1][m][0][j] * rs; x2[4 + j] = acc[ai][1][m][1][j] * rs; }
                if (pn >= 9) {
                    bf16_t* G = (bf16_t*)(ws + WS_GA + (size_t)((pn - 9) >> 2) * (WS_GB - WS_GA)) + (size_t)row * 1024 + 256 * ((pn - 9) & 3) + 32 * wc + 8 * fq;
                    float a[8], b[8];
#pragma unroll
                    for (int j = 0; j < 8; ++j) { a[j] = 1.0f / (1.0f + __builtin_amdgcn_exp2f(-x1[j] * 1.4426950408889634f)); b[j] = 1.0f / (1.0f + __builtin_amdgcn_exp2f(-x2[j] * 1.4426950408889634f)); }
                    *(u32x4*)G = pack8(a); *(u32x4*)(G + 128) = pack8(b);
                } else if (pn == 8) {
                    if (wc == 0) {
                        float s = 0.f;
#pragma unroll
                        for (int j = 0; j < 8; ++j) s += x1[j] + x2[j];
                        s += __shfl_xor(s, 16); s += __shfl_xor(s, 32);
                        const float mu = s * (1.0f / 64.0f); float q = 0.f;
#pragma unroll
                        for (int j = 0; j < 8; ++j) { x1[j] -= mu; x2[j] -= mu; q += x1[j] * x1[j] + x2[j] * x2[j]; }
                        q += __shfl_xor(q, 16); q += __shfl_xor(q, 32);
                        const float rstd = __builtin_amdgcn_rsqf(q * (1.0f / 64.0f) + 1e-6f);
                        const int pos = row & 4095; const float* cp = cs + pos * 32 + 8 * fq; const float* sp = sn + pos * 32 + 8 * fq;
                        float o1[8], o2[8];
#pragma unroll
                        for (int j = 0; j < 8; ++j) { const float y1 = x1[j] * rstd * ikw[8 * fq + j] + ikb[8 * fq + j], y2 = x2[j] * rstd * ikw[32 + 8 * fq + j] + ikb[32 + 8 * fq + j];
                            const float c = cp[j], sI = sp[j]; o1[j] = y1 * c - y2 * sI; o2[j] = y2 * c + y1 * sI; }
                        unsigned char* tb = ws + WS_IK + (size_t)(row >> 5) * 4096 + (size_t)(row & 31) * 16;
                        *(u32x4*)(tb + (fq >> 1) * 1024 + (fq & 1) * 512) = pack8(o1); *(u32x4*)(tb + (2 + (fq >> 1)) * 1024 + (fq & 1) * 512) = pack8(o2);
                    } else if (wc == 1 && fq == 0) {
                        float* dst = (float*)(ws + WS_IW) + (size_t)row * 8;
                        *(f32x4*)dst = (f32x4){x1[0], x1[1], x1[2], x1[3]} * 0.04419417382415922f; *(f32x4*)(dst + 4) = (f32x4){x1[4], x1[5], x1[6], x1[7]} * 0.04419417382415922f;
                    }
                } else if (pn >= 6) {
                    bf16_t* Kd = (bf16_t*)(ws + WS_AK + (size_t)(pn - 6) * (WS_BK - WS_AK)); bf16_t* Vd = (bf16_t*)(ws + WS_AV + (size_t)(pn - 6) * (WS_BV - WS_AV));
                    if (wc < 2) {
                        const int pos = row & 4095; const float* cp = cs + pos * 32 + 8 * fq; const float* sp = sn + pos * 32 + 8 * fq;
                        float o1[8], o2[8];
#pragma unroll
                        for (int j = 0; j < 8; ++j) { const float c = cp[j], sI = sp[j]; o1[j] = x1[j] * c - x2[j] * sI; o2[j] = x2[j] * c + x1[j] * sI; }
                        bf16_t* dst = Kd + (size_t)row * 128 + wc * 64 + 8 * fq;
                        *(u32x4*)dst = pack8(o1); *(u32x4*)(dst + 32) = pack8(o2);
                    } else {
                        bf16_t* dst = Vd + (size_t)row * 128 + 32 * (wc - 2) + 8 * fq;
                        *(u32x4*)dst = pack8(x1); *(u32x4*)(dst + 64) = pack8(x2);
                    }
                } else {
                    bf16_t* Q = (bf16_t*)(ws + WS_AQ + (size_t)(pn >> 1) * (WS_IQ - WS_AQ)); const float sc = (pn >= 2 && pn < 4) ? 1.0f : 0.125f * 1.4426950408889634f;
                    const int pos = row & 4095; const float* cp = cs + pos * 32 + 8 * fq; const float* sp = sn + pos * 32 + 8 * fq;
                    float o1[8], o2[8];
#pragma unroll
                    for (int j = 0; j < 8; ++j) { const float c = cp[j], sI = sp[j]; o1[j] = (x1[j] * c - x2[j] * sI) * sc; o2[j] = (x2[j] * c + x1[j] * sI) * sc; }
                    bf16_t* dst = Q + (size_t)row * 512 + (4 * (pn & 1) + wc) * 64 + 8 * fq;
                    *(u32x4*)dst = pack8(o1); *(u32x4*)(dst + 32) = pack8(o2);
                }
                asm volatile("" ::: "memory");
            }
    }
};

struct EpiGate {
    static constexpr bool PERM = true, AFTER_DRAIN = false;
    const bf16_t *GA, *GB; float* P; bf16_t* MIX;
    __device__ __forceinline__ void operator()(const f32x4 (&acc)[2][2][4][2], const Unit& u, int wr, int wc, int fr, int fq) const {
        const bool second = u.pn >= 4; const bf16_t* G = second ? GB : GA;
#pragma unroll
        for (int ai = 0; ai < 2; ++ai)
#pragma unroll
            for (int m = 0; m < 4; ++m) {
                const int row = u.pm * BM + ai * HALF + wr * 64 + m * 16 + fr;
#pragma unroll
                for (int bj = 0; bj < 2; ++bj) {
                    const size_t off = (size_t)row * 1024 + 256 * (u.pn & 3) + 128 * bj + 32 * wc + 8 * fq;
                    const u32x4 gw = *(const u32x4*)(G + off);
                    float v[8];
#pragma unroll
                    for (int j = 0; j < 4; ++j) { v[j] = acc[ai][bj][m][0][j]; v[4 + j] = acc[ai][bj][m][1][j]; }
                    v[0] *= __uint_as_float(gw.x << 16); v[1] *= __uint_as_float(gw.x & 0xffff0000u); v[2] *= __uint_as_float(gw.y << 16); v[3] *= __uint_as_float(gw.y & 0xffff0000u);
                    v[4] *= __uint_as_float(gw.z << 16); v[5] *= __uint_as_float(gw.z & 0xffff0000u); v[6] *= __uint_as_float(gw.w << 16); v[7] *= __uint_as_float(gw.w & 0xffff0000u);
                    if (!second) { *(u32x4*)(MIX + off) = pack8(v); }
                    else { const u32x4 pw = *(const u32x4*)(MIX + off);
                        v[0] += __uint_as_float(pw.x << 16); v[1] += __uint_as_float(pw.x & 0xffff0000u); v[2] += __uint_as_float(pw.y << 16); v[3] += __uint_as_float(pw.y & 0xffff0000u);
                        v[4] += __uint_as_float(pw.z << 16); v[5] += __uint_as_float(pw.z & 0xffff0000u); v[6] += __uint_as_float(pw.w << 16); v[7] += __uint_as_float(pw.w & 0xffff0000u);
                        *(u32x4*)(MIX + off) = pack8(v); }
                }
            }
    }
};

template <bool WITH_XG> struct EpiResid {
    static constexpr bool PERM = false, AFTER_DRAIN = false;
    const float* base; float* out; bf16_t* XG; const float* gw; float* ss;
    __device__ __forceinline__ void operator()(const f32x4 (&acc)[2][2][4][2], const Unit& u, int wr, int wc, int fr, int fq) const {
#pragma unroll
        for (int ai = 0; ai < 2; ++ai)
#pragma unroll
            for (int m = 0; m < 4; ++m) {
                const int row = u.pm * BM + ai * HALF + wr * 64 + m * 16 + fr; float s = 0.f;
#pragma unroll
                for (int bj = 0; bj < 2; ++bj)
#pragma unroll
                    for (int n = 0; n < 2; ++n) {
                        const int col = u.pn * BM + bj * HALF + wc * 32 + n * 16 + 4 * fq; const size_t off = (size_t)row * 1024 + col;
                        const f32x4 v = *(const f32x4*)(base + off) + acc[ai][bj][m][n];
                        *(f32x4*)(out + off) = v; s += (v[0] * v[0] + v[1] * v[1]) + (v[2] * v[2] + v[3] * v[3]);
                        if (WITH_XG) { const f32x4 g = *(const f32x4*)(gw + col); unsigned long long w = (unsigned long long)cvt_pk_bf16(v[0] * g[0], v[1] * g[1]) | ((unsigned long long)cvt_pk_bf16(v[2] * g[2], v[3] * g[3]) << 32);
                            *(unsigned long long*)(XG + off) = w; }
                    }
                s += __shfl_xor(s, 16); s += __shfl_xor(s, 32);
                if (fq == 0) atomicAdd(ss + row, s);
            }
    }
};

struct EpiUp {
    static constexpr bool PERM = true, AFTER_DRAIN = false;
    const float* ss; bf16_t* HID;
    __device__ __forceinline__ void operator()(const f32x4 (&acc)[2][2][4][2], const Unit& u, int wr, int wc, int fr, int fq) const {
#pragma unroll
        for (int ai = 0; ai < 2; ++ai)
#pragma unroll
            for (int m = 0; m < 4; ++m) {
                const int row = u.pm * BM + ai * HALF + wr * 64 + m * 16 + fr;
                const float rs = __builtin_amdgcn_rsqf(ss[row] * (1.0f / 1024.0f) + 1e-6f);
#pragma unroll
                for (int bj = 0; bj < 2; ++bj) {
                    float v[8];
#pragma unroll
                    for (int j = 0; j < 4; ++j) { float a = fmaxf(acc[ai][bj][m][0][j] * rs, 0.f), b = fmaxf(acc[ai][bj][m][1][j] * rs, 0.f); v[j] = a * a; v[4 + j] = b * b; }
                    *(u32x4*)(HID + (size_t)row * 4096 + u.pn * BM + bj * HALF + wc * 32 + 8 * fq) = pack8(v);
                }
            }
    }
};

struct BranchOrder {
    int G, c;
    __device__ __forceinline__ bool next(int i, Unit& u) const {
        const int tile = (i >> 1) * G + c; if (tile >= 128 * 4) return false;
        u.pm = tile >> 2; u.pn = (tile & 3) + 4 * (i & 1); return true;
    }
    __device__ __forceinline__ void a_ready(const Unit&) const {}
    __device__ __forceinline__ void done(const Unit&) const {}
};

template <class Epi, class Sched, bool ALIGN_EPI = false, bool SP2 = false>
__device__ __forceinline__ void gemm_phase(PG8_LAS unsigned char* lds, const Gemm g, const Sched& S, const Epi& E, int wv) {
    const int tid = tid_op(wv), wid = wv, lane = tid & 63, wr = wid >> 2, wc = wid & 3, fr = lane & 15, fq = lane >> 4;
    const int K = g.K, nt = K / BK;
    unsigned voffA[2], voffB[2];
#pragma unroll
    for (int i = 0; i < 2; ++i) { int R, C; stage_rc(tid * 16 + i * 8192, R, C); const int Rb = Epi::PERM ? ((R & ~31) + perm32(R & 31)) : R;
        voffA[i] = (unsigned)(R * K + C) * 2u; voffB[i] = (unsigned)(Rb * K + C) * 2u; }
    const size_t kstep = (size_t)(BK * 2);
    const size_t hstep = (size_t)HALF * K * 2;
    const size_t tstep = 2 * hstep;
    const unsigned ldsw = (unsigned)wid * 1024u;
    const int aoff = lds_byte(wr * 64 + fr, fq * 8), boff = lds_byte(wc * 32 + fr, fq * 8);
#define PG8_SA(b, h) (((b) * 2 + (h)) * HTB)
#define PG8_SB(b, h) ((4 + (b) * 2 + (h)) * HTB)
#define PG8_STAGE(bufoff, gbase, voff) do { _Pragma("unroll") for (int _i = 0; _i < 2; ++_i) \
        __builtin_amdgcn_global_load_lds((const unsigned*)((const char*)(gbase) + (voff)[_i]), (PG8_LAS unsigned*)(lds + (bufoff) + ldsw + _i * 8192), 16, 0, 0); } while (0)
#define PG8_LDA(dst, b, h) do { _Pragma("unroll") for (int m = 0; m < 4; ++m) _Pragma("unroll") for (int k = 0; k < 2; ++k) dst[m][k] = *(const PG8_LAS bf16x8*)(lds + PG8_SA(b, h) + aoff + m * 2048 + k * 1024); } while (0)
#define PG8_LDB(dst, b, h) do { _Pragma("unroll") for (int n = 0; n < 2; ++n) _Pragma("unroll") for (int k = 0; k < 2; ++k) dst[n][k] = *(const PG8_LAS bf16x8*)(lds + PG8_SB(b, h) + boff + n * 2048 + k * 1024); } while (0)
#define PG8_MMA(ai, bj, At, Bt) do { __builtin_amdgcn_s_setprio(1); _Pragma("unroll") for (int m = 0; m < 4; ++m) _Pragma("unroll") for (int n = 0; n < 2; ++n) _Pragma("unroll") for (int k = 0; k < 2; ++k) \
        acc[ai][bj][m][n] = __builtin_amdgcn_mfma_f32_16x16x32_bf16(Bt[n][k], At[m][k], acc[ai][bj][m][n], 0, 0, 0); __builtin_amdgcn_s_setprio(0); } while (0)
#define PG8_WAIT_V(n) asm volatile("s_waitcnt vmcnt(" #n ")" ::: "memory")
#define PG8_WAIT_L(n) asm volatile("s_waitcnt lgkmcnt(" #n ")" ::: "memory")
#define PG8_BAR __builtin_amdgcn_s_barrier()
#define PG8_SCHED __builtin_amdgcn_sched_barrier(0)
    Unit cur, nxt; int ui = 0;
    if (!S.next(0, cur)) return;
    f32x4 acc[2][2][4][2];
#pragma unroll
    for (int a = 0; a < 2; ++a)
#pragma unroll
        for (int b = 0; b < 2; ++b)
#pragma unroll
            for (int m = 0; m < 4; ++m)
#pragma unroll
                for (int n = 0; n < 2; ++n) acc[a][b][m][n] = (f32x4){0.f, 0.f, 0.f, 0.f};
    bf16x8 At[4][2], B0[2][2], B1[2][2];
    const char* cA = g.abase(cur) + (size_t)cur.pm * tstep; const char* cB = (const char*)g.Bt + (size_t)cur.pn * tstep;
    S.a_ready(cur);
    if constexpr (SP2) {
        PG8_STAGE(PG8_SB(0, 0), cB, voffB); PG8_STAGE(PG8_SB(0, 1), cB + hstep, voffB); PG8_STAGE(PG8_SA(0, 0), cA, voffA); PG8_STAGE(PG8_SA(0, 1), cA + hstep, voffA);
        if (wr == 1) PG8_BAR;
        PG8_WAIT_V(2); PG8_BAR;
        PG8_STAGE(PG8_SB(1, 0), cB + kstep, voffB); PG8_STAGE(PG8_SA(1, 0), cA + kstep, voffA); PG8_STAGE(PG8_SB(1, 1), cB + hstep + kstep, voffB);
        PG8_WAIT_V(6); PG8_BAR;
    } else {
        PG8_STAGE(PG8_SB(0, 0), cB, voffB); PG8_STAGE(PG8_SA(0, 0), cA, voffA); PG8_STAGE(PG8_SB(0, 1), cB + hstep, voffB); PG8_STAGE(PG8_SA(0, 1), cA + hstep, voffA);
        if (wr == 1) PG8_BAR;
        PG8_WAIT_V(4); PG8_BAR;
        PG8_STAGE(PG8_SB(1, 0), cB + kstep, voffB); PG8_STAGE(PG8_SA(1, 0), cA + kstep, voffA); PG8_STAGE(PG8_SB(1, 1), cB + hstep + kstep, voffB);
        PG8_WAIT_V(6); PG8_BAR;
    }
    for (;;) {
        const bool has_next = S.next(ui + 1, nxt);
        const char* nA = has_next ? g.abase(nxt) + (size_t)nxt.pm * tstep : cA; const char* nB = has_next ? (const char*)g.Bt + (size_t)nxt.pn * tstep : cB;
        for (int t = 0; t < nt; t += 2) {
            const bool last = (t == nt - 2);
            const char* a1 = cA + (size_t)(t + 1) * kstep;
            const char* a2 = last ? nA : cA + (size_t)(t + 2) * kstep; const char* b2 = last ? nB : cB + (size_t)(t + 2) * kstep;
            const char* a3 = a2 + kstep; const char* b3 = b2 + kstep;
            if (last && has_next) S.a_ready(nxt);
            if constexpr (SP2) {
            PG8_LDB(B0, 0, 0); PG8_LDB(B1, 0, 1); PG8_SCHED; PG8_LDA(At, 0, 0); PG8_STAGE(PG8_SA(1, 1), a1 + hstep, voffA);
            PG8_WAIT_V(8); PG8_WAIT_L(0); PG8_BAR; PG8_MMA(0, 0, At, B0); PG8_MMA(0, 1, At, B1); PG8_BAR; PG8_SCHED;
            PG8_LDA(At, 0, 1); PG8_STAGE(PG8_SB(0, 0), b2, voffB); PG8_STAGE(PG8_SB(0, 1), b2 + hstep, voffB); PG8_STAGE(PG8_SA(0, 0), a2, voffA);
            PG8_WAIT_V(8); PG8_WAIT_L(0); PG8_BAR; PG8_MMA(1, 0, At, B0); PG8_MMA(1, 1, At, B1); PG8_BAR; PG8_SCHED;
            PG8_LDB(B0, 1, 0); PG8_LDB(B1, 1, 1); PG8_SCHED; PG8_LDA(At, 1, 0); PG8_STAGE(PG8_SA(0, 1), a2 + hstep, voffA);
            PG8_WAIT_V(8); PG8_WAIT_L(0); PG8_BAR; PG8_MMA(0, 0, At, B0); PG8_MMA(0, 1, At, B1); PG8_BAR; PG8_SCHED;
            PG8_LDA(At, 1, 1); PG8_STAGE(PG8_SB(1, 0), b3, voffB); PG8_STAGE(PG8_SB(1, 1), b3 + hstep, voffB); PG8_STAGE(PG8_SA(1, 0), a3, voffA);
            PG8_WAIT_V(8); PG8_WAIT_L(0); PG8_BAR; PG8_MMA(1, 0, At, B0); PG8_MMA(1, 1, At, B1); PG8_BAR; PG8_SCHED;
            } else {
            PG8_LDB(B0, 0, 0); PG8_SCHED; PG8_LDA(At, 0, 0); PG8_STAGE(PG8_SA(1, 1), a1 + hstep, voffA);
            PG8_WAIT_L(8); PG8_BAR; PG8_WAIT_L(0); PG8_MMA(0, 0, At, B0); PG8_BAR; PG8_SCHED;
            PG8_LDB(B1, 0, 1); PG8_STAGE(PG8_SB(0, 0), b2, voffB);
            PG8_BAR; PG8_WAIT_L(0); PG8_MMA(0, 1, At, B1); PG8_BAR;
            PG8_LDA(At, 0, 1); PG8_STAGE(PG8_SA(0, 0), a2, voffA);
            PG8_BAR; PG8_WAIT_L(0); PG8_MMA(1, 0, At, B0); PG8_BAR; PG8_SCHED;
            PG8_STAGE(PG8_SB(0, 1), b2 + hstep, voffB);
            PG8_WAIT_V(6); PG8_BAR; PG8_MMA(1, 1, At, B1); PG8_BAR;
            PG8_LDB(B0, 1, 0); PG8_SCHED; PG8_LDA(At, 1, 0); PG8_STAGE(PG8_SA(0, 1), a2 + hstep, voffA);
            PG8_WAIT_L(8); PG8_BAR; PG8_WAIT_L(0); PG8_MMA(0, 0, At, B0); PG8_BAR; PG8_SCHED;
            PG8_LDB(B1, 1, 1); PG8_STAGE(PG8_SB(1, 0), b3, voffB);
            PG8_BAR; PG8_WAIT_L(0); PG8_MMA(0, 1, At, B1); PG8_BAR;
            PG8_LDA(At, 1, 1); PG8_STAGE(PG8_SA(1, 0), a3, voffA);
            PG8_BAR; PG8_WAIT_L(0); PG8_MMA(1, 0, At, B0); PG8_BAR; PG8_SCHED;
            PG8_STAGE(PG8_SB(1, 1), b3 + hstep, voffB);
            PG8_WAIT_V(6); PG8_BAR; PG8_MMA(1, 1, At, B1); PG8_BAR;
            }
        }
        if constexpr (ALIGN_EPI) { if (wr == 0) PG8_BAR; }
        if constexpr (!Epi::AFTER_DRAIN) { E(acc, cur, wr, wc, fr, fq); S.done(cur); }
        if (!has_next) break;
#pragma unroll
        for (int a = 0; a < 2; ++a)
#pragma unroll
            for (int b = 0; b < 2; ++b)
#pragma unroll
                for (int m = 0; m < 4; ++m)
#pragma unroll
                    for (int n = 0; n < 2; ++n) acc[a][b][m][n] = (f32x4){0.f, 0.f, 0.f, 0.f};
        cur = nxt; cA = nA; cB = nB; ++ui;
        if constexpr (ALIGN_EPI) { if (wr == 1) PG8_BAR; }
    }
    PG8_WAIT_V(0);
    if constexpr (!ALIGN_EPI) { if (wr == 0) PG8_BAR; }
    PG8_BAR;
    if constexpr (Epi::AFTER_DRAIN) { E.fused(acc, cur, wr, wc, fr, fq, lds, wid, lane); S.done(cur); }
#undef PG8_SA
#undef PG8_SB
#undef PG8_STAGE
#undef PG8_LDA
#undef PG8_LDB
#undef PG8_MMA
#undef PG8_WAIT_V
#undef PG8_WAIT_L
#undef PG8_BAR
#undef PG8_SCHED
}
}
struct Params {
    const float *x, *attn_norm_w, *w_in, *ikw, *ikb, *sinks, *w_a, *w_b, *w_out, *mlp_norm_w, *w_up, *w_down, *final_w;
    float* out; unsigned char* ws;
    float inv_freq[32];
    int ph_lo, ph_hi;
};
constexpr int NWAVES = 8, NTHREADS = 512;

__device__ __forceinline__ int win_src_group(int grp, int& cnt) {
    const int tile = grp >> 3, g = grp & 7; cnt = 32;
    if (tile < 6) { const int base = tile < 2 ? C_AQ : (tile < 4 ? C_IQ : C_BQ); const int head = 4 * (tile & 1) + (g & 3); return base + head * 64 + 32 * (g >> 2); }
    if (tile < 8) { const int kb = tile == 6 ? C_AK : C_BK, vb = tile == 6 ? C_AV : C_BV; const int hf = g >> 2, q = g & 3;
        if (q < 2) return kb + q * 64 + 32 * hf; return vb + 64 * hf + 32 * (q - 2); }
    if (tile == 8) { if (g == 0) return C_IK; if (g == 4) return C_IK + 32; if (g == 1) { cnt = 8; return C_IW; } cnt = 0; return 0; }
    return C_GA + (grp - 72) * 32;
}
__device__ __forceinline__ void p0_transpose_item(const float* W, int ldw, int c0, int cnt, int K, bf16* WT, int n0, int k0, LAS float* scr, int lane) {
#pragma unroll 8
    for (int i = 0; i < 32; ++i) { const int kk = 2 * i + (lane >> 5), n = lane & 31; scr[kk * 33 + n] = (n < cnt) ? W[(size_t)(k0 + kk) * ldw + c0 + n] : 0.f; }
    asm volatile("s_waitcnt lgkmcnt(0)" ::: "memory");
    const int c = lane & 7;
#pragma unroll
    for (int j = 0; j < 4; ++j) { const int n = (lane >> 3) + 8 * j; const LAS float* s = scr + (8 * c) * 33 + n;
        v4u o; o.x = pk2(s[0 * 33], s[1 * 33]); o.y = pk2(s[2 * 33], s[3 * 33]); o.z = pk2(s[4 * 33], s[5 * 33]); o.w = pk2(s[6 * 33], s[7 * 33]);
        *(v4u*)(WT + (size_t)(n0 + n) * K + k0 + 8 * c) = o; }
    asm volatile("s_waitcnt lgkmcnt(0)" ::: "memory");
}
__device__ __forceinline__ void sincos_d(float angf, float& sn, float& cs) {
    const double a = (double)angf; const double kq = __builtin_rint(a * 0.63661977236758134308);
    const double y = (a - kq * 1.57079632679489655800) - kq * 6.123233995736766e-17; const double y2 = y * y;
    double s = y * (1.0 + y2 * (-1.0 / 6 + y2 * (1.0 / 120 + y2 * (-1.0 / 5040 + y2 * (1.0 / 362880 + y2 * (-1.0 / 39916800 + y2 * (1.0 / 6227020800.0)))))));
    double c = 1.0 + y2 * (-0.5 + y2 * (1.0 / 24 + y2 * (-1.0 / 720 + y2 * (1.0 / 40320 + y2 * (-1.0 / 3628800 + y2 * (1.0 / 479001600.0 + y2 * (-1.0 / 87178291200.0)))))));
    const int q = ((int)kq) & 3;
    const double ss = (q == 0) ? s : (q == 1) ? c : (q == 2) ? -s : -c; const double cc = (q == 0) ? c : (q == 1) ? -s : (q == 2) ? -c : s;
    sn = (float)ss; cs = (float)cc;
}
__device__ __forceinline__ void phase_prologue(const Params& p, LAS unsigned char* lds, int G, int wv) {
    const int wave = wv, lane = lane_id();
    unsigned char* ws = p.ws;
    LAS float* scr = (LAS float*)(lds + wave * 16384);
    const int gw = blockIdx.x * NWAVES + wave, NGW = G * NWAVES;
    constexpr int I_IN = (DM / 64) * (NIN / 32), I_A = (512 / 64) * (DM / 32), I_O = (DM / 64) * (DM / 32), I_U = (DM / 64) * (DFF / 32), I_D = (DFF / 64) * (DM / 32);
    constexpr int NITEMS = I_IN + 2 * I_A + I_O + I_U + I_D;
    for (int it = gw; it < NITEMS; it += NGW) {
        int r = it;
        if (r < I_IN) { const int grp = r % (NIN / 32), kb = r / (NIN / 32); int cnt; const int c0 = win_src_group(grp, cnt);
            p0_transpose_item(p.w_in, D_IN, c0, cnt, DM, (bf16*)(ws + WS_WIN), grp * 32, kb * 64, scr, lane); continue; } r -= I_IN;
        if (r < I_A) { const int nb = r % 32, kb = r / 32; p0_transpose_item(p.w_a, DM, nb * 32, 32, 512, (bf16*)(ws + WS_WAB), nb * 32, kb * 64, scr, lane); continue; } r -= I_A;
        if (r < I_A) { const int nb = r % 32, kb = r / 32; p0_transpose_item(p.w_b, DM, nb * 32, 32, 512, (bf16*)(ws + WS_WAB), 1024 + nb * 32, kb * 64, scr, lane); continue; } r -= I_A;
        if (r < I_O) { const int nb = r % 32, kb = r / 32; p0_transpose_item(p.w_out, DM, nb * 32, 32, DM, (bf16*)(ws + WS_WOUT), nb * 32, kb * 64, scr, lane); continue; } r -= I_O;
        if (r < I_U) { const int nb = r % 128, kb = r / 128; p0_transpose_item(p.w_up, DFF, nb * 32, 32, DM, (bf16*)(ws + WS_WUP), nb * 32, kb * 64, scr, lane); continue; } r -= I_U;
        { const int nb = r % 32, kb = r / 32; p0_transpose_item(p.w_down, DM, nb * 32, 32, DFF, (bf16*)(ws + WS_WDN), nb * 32, kb * 64, scr, lane); }
    }
    float* COS = (float*)(ws + WS_COS); float* SIN = (float*)(ws + WS_SIN);
    for (int i = gw * 64 + lane; i < SEQ * 32; i += NGW * 64) { const int pos = i >> 5, d = i & 31; const float ang = (float)pos * p.inv_freq[d]; float s, c; sincos_d(ang, s, c); COS[i] = c; SIN[i] = s; }
    float* RSTD1 = (float*)(ws + WS_RSTD1); float* SS2 = (float*)(ws + WS_SS2); float* SS3 = (float*)(ws + WS_SS3); bf16* XG = (bf16*)(ws + WS_XG);
    v4f g[4];
#pragma unroll
    for (int j = 0; j < 4; ++j) g[j] = *((const v4f*)p.attn_norm_w + lane + 64 * j);
    for (int m = gw; m < TOK; m += NGW) {
        const v4f* xr = (const v4f*)(p.x + (size_t)m * DM) + lane; v4f v[4]; float s = 0.f;
#pragma unroll
        for (int j = 0; j < 4; ++j) { v[j] = xr[64 * j]; s += (v[j].x * v[j].x + v[j].y * v[j].y) + (v[j].z * v[j].z + v[j].w * v[j].w); }
        s = wave_sum(s);
        unsigned long long* o8 = (unsigned long long*)(XG + (size_t)m * DM) + lane;
#pragma unroll
        for (int j = 0; j < 4; ++j) o8[64 * j] = (unsigned long long)pk2(v[j].x * g[j].x, v[j].y * g[j].y) | ((unsigned long long)pk2(v[j].z * g[j].z, v[j].w * g[j].w) << 32);
        if (lane == 0) { RSTD1[m] = frsq(s * (1.0f / DM) + RMS_EPS); SS2[m] = 0.f; SS3[m] = 0.f; }
    }
}

__device__ __forceinline__ unsigned f2key(float f) { const unsigned u = __float_as_uint(f); return (u & 0x80000000u) ? ~u : (u | 0x80000000u); }
__device__ __forceinline__ void phase_topk_simple(const Params& p, LAS unsigned char* lds, int G, int wv) {
    const int wave = wv, lane = lane_id();
    unsigned char* ws = p.ws;
    const bf16* IQ = (const bf16*)(ws + WS_IQ); const bf16* IK = (const bf16*)(ws + WS_IK); const float* IW = (const float*)(ws + WS_IW);
    unsigned short* SEL = (unsigned short*)(ws + WS_SEL);
    LAS unsigned* keys = (LAS unsigned*)(lds + wave * 16384);
    LAS float* qf = (LAS float*)(lds + LDS_RING + wave * 2048);
    const int gw = blockIdx.x * NWAVES + wave, NGW = G * NWAVES;
    for (int row = gw; row < TOK; row += NGW) {
        const int b = row >> 12, t = row & 4095, n = t + 1;
        unsigned short* selrow = SEL + (size_t)row * TOPK;
        if (n <= TOPK) { for (int i = lane; i < n; i += 64) selrow[i] = (unsigned short)i; continue; }
        { const v4u q8 = *((const v4u*)(IQ + (size_t)row * 512) + lane);
            LAS float* d = qf + 8 * lane;
            d[0] = bflo(q8.x); d[1] = bfhi(q8.x); d[2] = bflo(q8.y); d[3] = bfhi(q8.y); d[4] = bflo(q8.z); d[5] = bfhi(q8.z); d[6] = bflo(q8.w); d[7] = bfhi(q8.w); }
        float w[8];
#pragma unroll
        for (int h = 0; h < 8; ++h) w[h] = IW[(size_t)row * 8 + h];
        asm volatile("s_waitcnt lgkmcnt(0)" ::: "memory");
        for (int s0 = 0; s0 < n; s0 += 64) {
            const int s = s0 + lane; const int sc = s < n ? s : t;
            const v4u* kp = (const v4u*)(IK + ((size_t)b * SEQ + sc) * 64);
            float dot[8];
#pragma unroll
            for (int h = 0; h < 8; ++h) dot[h] = 0.f;
#pragma unroll
            for (int c = 0; c < 8; ++c) {
                const v4u k8 = kp[c]; float kf[8] = {bflo(k8.x), bfhi(k8.x), bflo(k8.y), bfhi(k8.y), bflo(k8.z), bfhi(k8.z), bflo(k8.w), bfhi(k8.w)};
#pragma unroll
                for (int h = 0; h < 8; ++h) { const v4f qa = *(const LAS v4f*)(qf + h * 64 + c * 8), qb = *(const LAS v4f*)(qf + h * 64 + c * 8 + 4);
                    dot[h] += (kf[0] * qa.x + kf[1] * qa.y) + (kf[2] * qa.z + kf[3] * qa.w) + (kf[4] * qb.x + kf[5] * qb.y) + (kf[6] * qb.z + kf[7] * qb.w); }
            }
            float sc_ = 0.f;
#pragma unroll
            for (int h = 0; h < 8; ++h) sc_ += w[h] * fmaxf(dot[h], 0.f);
            keys[s] = (s < n) ? f2key(sc_) : 0u;
        }
        asm volatile("s_waitcnt lgkmcnt(0)" ::: "memory");
        const int nch = (n + 63) >> 6;
        unsigned thr = 0u;
        for (int bit = 31; bit >= 0; --bit) {
            const unsigned cand = thr | (1u << bit); int cnt = 0;
            for (int c = 0; c < nch; ++c) cnt += __popcll(__ballot(keys[c * 64 + lane] >= cand));
            if (cnt >= TOPK) thr = cand;
        }
        int cgt = 0;
        for (int c = 0; c < nch; ++c) cgt += __popcll(__ballot(keys[c * 64 + lane] > thr));
        const int need = TOPK - cgt; int pos = 0, ties = 0;
        for (int c = 0; c < nch; ++c) {
            const unsigned k = keys[c * 64 + lane]; const bool gt = k > thr, eq = k == thr;
            const unsigned long long meq = __ballot(eq);
            const bool sel = gt || (eq && (ties + mbcnt64(meq) < need));
            const unsigned long long msel = __ballot(sel);
            if (sel) selrow[pos + mbcnt64(msel)] = (unsigned short)(c * 64 + lane);
            pos += __popcll(msel); ties += __popcll(meq);
        }
    }
}

template <bool SINK, class KeyFn>
__device__ __forceinline__ void attend_wave(const bf16* Q, const bf16* K, const bf16* V, bf16* O, int row, int g, int nslots, const KeyFn& keyfn, const float* sinkv,
                                            LAS float* qf  , LAS float* pf  , LAS int* kidx  , int lane) {
    const int b = row >> 12;
    { const v2u q4 = *((const v2u*)(Q + (size_t)row * 512 + g * 256) + lane);
        LAS float* d = qf + 4 * lane; d[0] = bflo(q4.x); d[1] = bfhi(q4.x); d[2] = bflo(q4.y); d[3] = bfhi(q4.y); }
    asm volatile("s_waitcnt lgkmcnt(0)" ::: "memory");
#pragma unroll 1
    for (int j = 0; j < 4; ++j) {
        const int slot = 64 * j + lane; int key = slot < nslots ? keyfn(slot) : -1; kidx[slot] = key;
        const bool valid = key >= 0; const int kc = valid ? key : 0;
        const v4u* kp = (const v4u*)(K + ((size_t)b * SEQ + kc) * 128 + g * 64);
        float dot[4] = {0.f, 0.f, 0.f, 0.f};
        if (64 * j < nslots) {
#pragma unroll 2
            for (int c = 0; c < 8; ++c) {
                const v4u k8 = kp[c]; float kf[8] = {bflo(k8.x), bfhi(k8.x), bflo(k8.y), bfhi(k8.y), bflo(k8.z), bfhi(k8.z), bflo(k8.w), bfhi(k8.w)};
#pragma unroll
                for (int h = 0; h < 4; ++h) { const v4f qa = *(const LAS v4f*)(qf + h * 64 + c * 8), qb = *(const LAS v4f*)(qf + h * 64 + c * 8 + 4);
                    dot[h] += (kf[0] * qa.x + kf[1] * qa.y) + (kf[2] * qa.z + kf[3] * qa.w) + (kf[4] * qb.x + kf[5] * qb.y) + (kf[6] * qb.z + kf[7] * qb.w); }
            }
        }
        *(LAS v4f*)(pf + slot * 4) = valid ? (v4f){dot[0], dot[1], dot[2], dot[3]} : (v4f){-INFINITY, -INFINITY, -INFINITY, -INFINITY};
    }
    asm volatile("s_waitcnt lgkmcnt(0)" ::: "memory");
    float lg[4][4];
#pragma unroll
    for (int j = 0; j < 4; ++j) { const v4f t4 = *(const LAS v4f*)(pf + (64 * j + lane) * 4); lg[j][0] = t4.x; lg[j][1] = t4.y; lg[j][2] = t4.z; lg[j][3] = t4.w; }
    float inv[4];
#pragma unroll
    for (int h = 0; h < 4; ++h) {
        float mx = fmaxf(fmaxf(lg[0][h], lg[1][h]), fmaxf(lg[2][h], lg[3][h])); mx = wave_max(mx);
        float sk = 0.f; if (SINK) { sk = sinkv[g * 4 + h] * LOG2E; mx = fmaxf(mx, sk); }
        float s = 0.f;
#pragma unroll
        for (int j = 0; j < 4; ++j) { const float e = fexp2(lg[j][h] - mx); lg[j][h] = e; s += e; }
        s = wave_sum(s); if (SINK) s += fexp2(sk - mx);
        inv[h] = 1.0f / s;
    }
#pragma unroll
    for (int j = 0; j < 4; ++j) *(LAS v4f*)(pf + (64 * j + lane) * 4) = (v4f){lg[j][0], lg[j][1], lg[j][2], lg[j][3]};
    asm volatile("s_waitcnt lgkmcnt(0)" ::: "memory");
    float o[4] = {0.f, 0.f, 0.f, 0.f};
    const bf16* Vb = V + (size_t)b * SEQ * 128 + g * 64 + lane;
#pragma unroll 1
    for (int s0 = 0; s0 < nslots; s0 += 8) {
        float vv[8]; v4f pp[8];
#pragma unroll
        for (int i = 0; i < 8; ++i) { const int slot = s0 + i; const int key = slot < nslots ? kidx[slot] : -1; pp[i] = *(const LAS v4f*)(pf + (slot & 255) * 4);
            vv[i] = key >= 0 ? bf2f(Vb[(size_t)key * 128]) : 0.f; if (key < 0) pp[i] = (v4f){0.f, 0.f, 0.f, 0.f}; }
#pragma unroll
        for (int i = 0; i < 8; ++i) { o[0] += pp[i].x * vv[i]; o[1] += pp[i].y * vv[i]; o[2] += pp[i].z * vv[i]; o[3] += pp[i].w * vv[i]; }
    }
    bf16* op = O + (size_t)row * 512 + g * 256 + lane;
#pragma unroll
    for (int h = 0; h < 4; ++h) op[h * 64] = (bf16)f2bf(o[h] * inv[h]);
}
struct SelKey { const unsigned short* selrow; __device__ __forceinline__ int operator()(int slot) const { return (int)selrow[slot]; } };
struct WinKey { int t; __device__ __forceinline__ int operator()(int slot) const { return t - (WIN - 1) + slot; } };

template <bool DO_DSA, bool DO_SWA>
__device__ __forceinline__ void phase_attn_simple(const Params& p, LAS unsigned char* lds, int G, int wv) {
    const int wave = wv, lane = lane_id();
    unsigned char* ws = p.ws;
    LAS float* qf = (LAS float*)(lds + wave * 16384); LAS float* pf = qf + 256; LAS int* kidx = (LAS int*)(pf + 1024);
    const int gw = blockIdx.x * NWAVES + wave, NGW = G * NWAVES;
    const unsigned short* SEL = (const unsigned short*)(ws + WS_SEL);
    for (int item = gw; item < TOK * 2; item += NGW) {
        const int row = item >> 1, g = item & 1, t = row & 4095;
        if (DO_DSA) { SelKey kf{SEL + (size_t)row * TOPK}; const int ns = (t + 1 < TOPK) ? t + 1 : TOPK;
            attend_wave<false>((const bf16*)(ws + WS_AQ), (const bf16*)(ws + WS_AK), (const bf16*)(ws + WS_AV), (bf16*)(ws + WS_OA), row, g, ns, kf, nullptr, qf, pf, kidx, lane); }
        if (DO_SWA) { WinKey kf{t};
            attend_wave<true>((const bf16*)(ws + WS_BQ), (const bf16*)(ws + WS_BK), (const bf16*)(ws + WS_BV), (bf16*)(ws + WS_OB), row, g, WIN, kf, p.sinks, qf, pf, kidx, lane); }
    }
}

__device__ __forceinline__ void phase_final(const Params& p, int G, int wv) {
    const int wave = wv, lane = lane_id();
    const float* SS3 = (const float*)(p.ws + WS_SS3);
    const int gw = blockIdx.x * NWAVES + wave, NGW = G * NWAVES;
    v4f g[4];
#pragma unroll
    for (int j = 0; j < 4; ++j) g[j] = *((const v4f*)p.final_w + lane + 64 * j);
    for (int m = gw; m < TOK; m += NGW) {
        float rs = frsq(SS3[m] * (1.0f / DM) + RMS_EPS);
#ifdef PROBE_TS
        { const unsigned long long* TS = (const unsigned long long*)(p.ws + WS_RSTD1 + 384 * 1024); rs *= 1.0f + (float)(TS[PROBE_TS + 1] - TS[PROBE_TS]) * 1.0e-5f; }
#endif
        v4f* xr = (v4f*)(p.out + (size_t)m * DM) + lane;
#pragma unroll
        for (int j = 0; j < 4; ++j) { v4f v = xr[64 * j]; xr[64 * j] = v * g[j] * rs; }
    }
}

typedef short bf16x8_t __attribute__((ext_vector_type(8)));
typedef float f32x16_t __attribute__((ext_vector_type(16)));
typedef float f32x4_t __attribute__((ext_vector_type(4)));
typedef float f32x2_t __attribute__((ext_vector_type(2)));
__device__ __forceinline__ unsigned f16key(float f) { const int q = (int)__builtin_rintf(f * 4096.0f) + 32768; return (unsigned)(q < 256 ? 256 : (q > 65535 ? 65535 : q)); }
__device__ __forceinline__ float relu1(float x) { return __builtin_amdgcn_fmed3f(x, 0.f, 3.0e38f); }
constexpr int TK_H1 = LDS_RING, TK_WAVE = LDS_RING + 8192, TK_WAVE_BYTES = 3072, TK_CAND = 512;
static_assert(TK_WAVE + 8 * TK_WAVE_BYTES <= LDS_BYTES, "top-k LDS map");

__device__ __forceinline__ void phase_topk_fast(const Params& p, LAS unsigned char* lds, int G, int wv) {
    const int wave = wv, lane = lane_id(), tid = wave * 64 + lane;
    const int r = lane & 31, h = lane >> 5, mt = wave & 3, par = wave >> 2;
    unsigned char* ws = p.ws;
    const bf16* IQ = (const bf16*)(ws + WS_IQ); const bf16* IK = (const bf16*)(ws + WS_IK); const float* IW = (const float*)(ws + WS_IW);
    unsigned short* SEL = (unsigned short*)(ws + WS_SEL);
    LAS unsigned short* kb = (LAS unsigned short*)lds;
    LAS unsigned* H1 = (LAS unsigned*)(lds + TK_H1);
    LAS unsigned* cl = (LAS unsigned*)(lds + TK_WAVE + wave * TK_WAVE_BYTES); LAS unsigned short* ol = (LAS unsigned short*)(lds + TK_WAVE + wave * TK_WAVE_BYTES + 4 * TK_CAND);
    const int qrow = 4 * mt + 2 * ((r >> 2) & 1) + (r >> 4), qhead = 4 * ((r >> 3) & 1) + (r & 3);
    { LAS v4u* hz = (LAS v4u*)H1; hz[tid] = (v4u){0u, 0u, 0u, 0u}; }
    for (int k = 0;; ++k) {
        int b, tile;
        if (G == 256) { if (k >= 8) break; const int c = blockIdx.x, i = c >> 3, grp = k >> 1; b = c & 7; tile = (k & 1) ? (64 * grp + 63 - i) : (64 * grp + i); }
        else { const int u = blockIdx.x + k * G; if (u >= TOK / 16) break; b = u >> 8; tile = u & 255; }
        const int t0 = tile * 16, R0 = b * SEQ + t0;
        if (t0 + 16 <= TOPK) {
            for (int i = tid; i < 16 * TOPK; i += NTHREADS) { const int ql = i >> 8, s = i & 255; if (s <= t0 + ql) SEL[(size_t)(R0 + ql) * TOPK + s] = (unsigned short)s; }
            continue;
        }
        bf16x8_t aq[4];
#pragma unroll
        for (int s = 0; s < 4; ++s) aq[s] = *(const bf16x8_t*)(IQ + (size_t)(R0 + qrow) * 512 + qhead * 64 + 16 * s + 8 * h);
        f32x2_t wq[2][4];
#pragma unroll
        for (int qq = 0; qq < 2; ++qq) { const f32x4_t w0 = *(const f32x4_t*)(IW + (size_t)(R0 + 4 * mt + 2 * h + qq) * 8), w1 = *(const f32x4_t*)(IW + (size_t)(R0 + 4 * mt + 2 * h + qq) * 8 + 4);
            const float n2 = (w0[0] * w0[0] + w0[1] * w0[1]) + (w0[2] * w0[2] + w0[3] * w0[3]) + (w1[0] * w1[0] + w1[1] * w1[1]) + (w1[2] * w1[2] + w1[3] * w1[3]);
            const float sn = __builtin_amdgcn_rsqf(fmaxf(n2, 1e-30f)) * 0.2141f;
            wq[qq][0] = (f32x2_t){w0[0], w0[1]} * sn; wq[qq][1] = (f32x2_t){w0[2], w0[3]} * sn; wq[qq][2] = (f32x2_t){w1[0], w1[1]} * sn; wq[qq][3] = (f32x2_t){w1[2], w1[3]} * sn; }
        const int ntile = (t0 + 16 + 31) >> 5, ntp = (ntile + 7) & ~7, nch = (t0 + 16 + 511) >> 9;
        const char* kbase = (const char*)IK + (size_t)b * SEQ * 128;
        const unsigned voff = (unsigned)(lane * 16);
        const int tq0 = t0 + 4 * mt + 2 * h;
        const int ql0 = 4 * mt + 2 * h;
        LAS unsigned short* row0 = kb + ql0 * 4096; LAS unsigned* h0 = H1 + ql0 * 128;
        __syncthreads();
#define TK_LOAD(dst, kt_) do { const int ktc_ = (kt_) < 127 ? (kt_) : 127; const char* tp_ = kbase + (size_t)ktc_ * 4096; _Pragma("unroll") for (int s_ = 0; s_ < 4; ++s_) dst[s_] = *(const bf16x8_t*)(tp_ + voff + 1024 * s_); } while (0)
#define TK_MMA(acc_, src) do { acc_ = (f32x16_t){0.f, 0.f, 0.f, 0.f, 0.f, 0.f, 0.f, 0.f, 0.f, 0.f, 0.f, 0.f, 0.f, 0.f, 0.f, 0.f}; \
            _Pragma("unroll") for (int s_ = 0; s_ < 4; ++s_) acc_ = __builtin_amdgcn_mfma_f32_32x32x16_bf16(aq[s_], src[s_], acc_, 0, 0, 0); } while (0)
#define TK_POST(acc_, kt_) do { f32x2_t s0_ = {0.f, 0.f}, s1_ = {0.f, 0.f}; \
            _Pragma("unroll") for (int hd_ = 0; hd_ < 4; ++hd_) { s0_ += (f32x2_t){relu1(acc_[2 * hd_]), relu1(acc_[2 * hd_ + 1])} * wq[0][hd_]; s1_ += (f32x2_t){relu1(acc_[8 + 2 * hd_]), relu1(acc_[9 + 2 * hd_])} * wq[1][hd_]; } \
            const int e_ = 32 * (kt_) + r; const unsigned k0_ = (e_ <= tq0) ? f16key(s0_.x + s0_.y) : 0u, k1_ = (e_ <= tq0 + 1) ? f16key(s1_.x + s1_.y) : 0u; \
            row0[e_] = (unsigned short)k0_; row0[4096 + e_] = (unsigned short)k1_; \
            if (k0_) __hip_atomic_fetch_add(h0 + (k0_ >> 9), 1u << ((k0_ >> 4) & 16u), __ATOMIC_RELAXED, __HIP_MEMORY_SCOPE_WORKGROUP); \
            if (k1_) __hip_atomic_fetch_add(h0 + 128 + (k1_ >> 9), 1u << ((k1_ >> 4) & 16u), __ATOMIC_RELAXED, __HIP_MEMORY_SCOPE_WORKGROUP); } while (0)
#ifndef TK_REP_SCORE
#define TK_REP_SCORE 1
#endif
#ifndef TK_REP_SEL
#define TK_REP_SEL 1
#endif
#pragma unroll 1
        for (int rp_ = 0; rp_ < TK_REP_SCORE; ++rp_) {
            bf16x8_t B[4][4]; f32x16_t accA, accB;
            const int nmy = ntp >> 1;
#pragma unroll
            for (int u = 0; u < 4; ++u) TK_LOAD(B[u], par + 2 * u);
            TK_MMA(accA, B[0]);
#pragma unroll 1
            for (int i = 0; i < nmy; i += 4) {
                const int kt = par + 2 * i;
                TK_MMA(accB, B[1]); TK_POST(accA, kt);     TK_LOAD(B[0], kt + 8);
                TK_MMA(accA, B[2]); TK_POST(accB, kt + 2); TK_LOAD(B[1], kt + 10);
                TK_MMA(accB, B[3]); TK_POST(accA, kt + 4); TK_LOAD(B[2], kt + 12);
                TK_MMA(accA, B[0]); TK_POST(accB, kt + 6); TK_LOAD(B[3], kt + 14);
            }
        }
#undef TK_LOAD
#undef TK_MMA
#undef TK_POST
        if (32 * ntp < 512 * nch) {
#pragma unroll
            for (int qi = 0; qi < 2; ++qi) { LAS v2u* z = (LAS v2u*)(kb + (2 * wave + qi) * 4096 + 32 * ntp) + lane; *z = (v2u){0u, 0u}; }
        }
        __syncthreads();
#pragma unroll 1
        for (int qi = 0; qi < 2 * TK_REP_SEL; ++qi) {
            const int ql = 2 * wave + (qi & 1);
            const LAS unsigned short* rb = kb + ql * 4096 + lane;
            const v2u hw = *(const LAS v2u*)(H1 + ql * 128 + 2 * lane); const v4u hv = {hw.x & 0xffffu, hw.x >> 16, hw.y & 0xffffu, hw.y >> 16};
            if ((qi >> 1) + 1 == TK_REP_SEL) *(LAS v2u*)(H1 + ql * 128 + 2 * lane) = (v2u){0u, 0u};
            const int hs = (int)(hv.x + hv.y + hv.z + hv.w); int S = hs;
#pragma unroll
            for (int off = 1; off < 64; off <<= 1) { const int v = __shfl_down(S, off); if (lane + off < 64) S += v; }
            int ab = S - hs; const bool cross = ab < TOPK && S >= TOPK;
            int Bl = 4 * lane + 3;
            if (ab + (int)hv.w < TOPK) { ab += (int)hv.w; Bl = 4 * lane + 2; if (ab + (int)hv.z < TOPK) { ab += (int)hv.z; Bl = 4 * lane + 1; if (ab + (int)hv.y < TOPK) { ab += (int)hv.y; Bl = 4 * lane; } } }
            const unsigned long long mc = __ballot(cross);
            const int src = mc ? (__ffsll((long long)mc) - 1) : 0;
            const unsigned Bb = (unsigned)__shfl(Bl, src);
            const unsigned kmin = Bb << 8; int m = 0;
#pragma unroll 1
            for (int j = 0; j < nch; ++j) {
                unsigned kk[8];
#pragma unroll
                for (int s = 0; s < 8; ++s) kk[s] = rb[512 * j + 64 * s];
#pragma unroll
                for (int s = 0; s < 8; ++s) {
                    const bool in = kk[s] >= kmin;
                    const unsigned long long mi = __ballot(in);
                    if (in) { const int ci = m + mbcnt64(mi); if (ci < TK_CAND) cl[ci] = (kk[s] << 16) | (unsigned)(512 * j + 64 * s + lane); }
                    m += __popcll(mi);
                }
            }
            asm volatile("s_waitcnt lgkmcnt(0)" ::: "memory");
            int pos = 0;
            if (mc != 0ull && m <= TK_CAND && m >= TOPK) {
                unsigned ent[8]; bool val[8];
#pragma unroll
                for (int q = 0; q < 8; ++q) { val[q] = 64 * q + lane < m; ent[q] = val[q] ? cl[64 * q + lane] : 0u; }
                int nab = 0;
#pragma unroll
                for (int q = 0; q < 8; ++q) nab += __popcll(__ballot(val[q] && (ent[q] >> 24) > Bb));
                const int need2 = TOPK - nab;
                unsigned thr2 = 0u;
#pragma unroll 1
                for (int bit = 7; bit >= 0; --bit) {
                    const unsigned cand = thr2 | (1u << bit); int cnt = 0;
#pragma unroll
                    for (int q = 0; q < 8; ++q) cnt += __popcll(__ballot(val[q] && (ent[q] >> 24) == Bb && ((ent[q] >> 16) & 0xffu) >= cand));
                    if (cnt >= need2) thr2 = cand;
                }
                const unsigned kthr = (Bb << 8) | thr2;
                int cgt2 = 0;
#pragma unroll
                for (int q = 0; q < 8; ++q) cgt2 += __popcll(__ballot(val[q] && (ent[q] >> 16) > kthr));
                const int need3 = TOPK - cgt2; int ties = 0;
#pragma unroll
                for (int q = 0; q < 8; ++q) {
                    const unsigned kx = ent[q] >> 16; const bool gt = val[q] && kx > kthr, eq = val[q] && kx == kthr;
                    const unsigned long long meq = __ballot(eq);
                    const bool sel = gt || (eq && (ties + mbcnt64(meq) < need3));
                    const unsigned long long msel = __ballot(sel);
                    if (sel) ol[pos + mbcnt64(msel)] = (unsigned short)(ent[q] & 0xffffu);
                    pos += __popcll(msel); ties += __popcll(meq);
                }
            } else {
                unsigned thr = 0u;
#pragma unroll 1
                for (int bit = 15; bit >= 0; --bit) {
                    const unsigned cand = thr | (1u << bit); int cnt = 0;
#pragma unroll 1
                    for (int i = 0; i < 8 * nch; ++i) cnt += __popcll(__ballot((unsigned)rb[64 * i] >= cand));
                    if (cnt >= TOPK) thr = cand;
                }
                int cgt = 0;
#pragma unroll 1
                for (int i = 0; i < 8 * nch; ++i) cgt += __popcll(__ballot((unsigned)rb[64 * i] > thr));
                const int need = TOPK - cgt; int ties = 0; pos = 0;
#pragma unroll 1
                for (int i = 0; i < 8 * nch; ++i) {
                    const unsigned kx = rb[64 * i]; const bool gt = kx > thr, eq = kx == thr;
                    const unsigned long long meq = __ballot(eq);
                    const bool sel = gt || (eq && (ties + mbcnt64(meq) < need));
                    const unsigned long long msel = __ballot(sel);
                    if (sel) ol[pos + mbcnt64(msel)] = (unsigned short)(64 * i + lane);
                    pos += __popcll(msel); ties += __popcll(meq);
                }
            }
            asm volatile("s_waitcnt lgkmcnt(0)" ::: "memory");
            *((v2u*)(SEL + (size_t)(R0 + ql) * TOPK) + lane) = *(const LAS v2u*)(ol + 4 * lane);
            asm volatile("s_waitcnt lgkmcnt(0)" ::: "memory");
        }
    }
    __syncthreads();
}

typedef short s16x4_t __attribute__((ext_vector_type(4)));
__device__ __forceinline__ s16x4_t tr_read(unsigned addr) { s16x4_t r_; asm volatile("ds_read_b64_tr_b16 %0, %1" : "=v"(r_) : "v"(addr) : "memory"); return r_; }
__device__ __forceinline__ void dma16(const void* src, LAS unsigned char* dst) { __builtin_amdgcn_global_load_lds((const unsigned*)src, (LAS unsigned*)dst, 16, 0, 0); }
constexpr int DSA_WAVE_BYTES = 19968, DSA_PL = 16384, DSA_SIDX = 18432, DSA_QS = 19456;
static_assert(8 * DSA_WAVE_BYTES <= XB_LDS_OFF, "DSA LDS map");

__device__ __forceinline__ void phase_dsa_fast(const Params& p, LAS unsigned char* lds, int G, int wv) {
    const int wave = wv, lane = lane_id();
    const int c16 = lane & 15, kq = lane >> 4;
    unsigned char* ws = p.ws;
    const unsigned char* AQ = ws + WS_AQ; bf16* OA = (bf16*)(ws + WS_OA);
    const unsigned char* SEL = ws + WS_SEL;
    LAS unsigned char* wl = lds + wave * DSA_WAVE_BYTES;
    LAS unsigned short* Pl = (LAS unsigned short*)(wl + DSA_PL); LAS unsigned short* sidx = (LAS unsigned short*)(wl + DSA_SIDX); LAS unsigned char* Qs = wl + DSA_QS;
    const unsigned ring_addr = (unsigned)(size_t)wl;
    const bool arow = (c16 & 3) == 0; const int ahead = c16 >> 2;
    if (!(G >= 8 && (G & 7) == 0)) return;
    const int nper = (G >> 3) * NWAVES, wi = (blockIdx.x >> 3) * NWAVES + wave, b = blockIdx.x & 7;
    const int nrows = (SEQ - wi + nper - 1) / nper, nsteps = 32 * nrows;
    const unsigned char* KVb = ws + WS_AK + (size_t)b * SEQ * 256;
    const int sw16 = ((lane & 7) ^ (lane >> 3)) * 16, r8 = lane >> 3;
#define DSA_ISSUE(n_) do { const int n__ = (n_); if (n__ < nsteps) { const int item_ = n__ >> 4, sub_ = n__ & 15, c_ = sub_ & 7, it_ = item_ >> 1; \
        const int t_ = wi + it_ * nper; const int cnt_ = (t_ + 1 < TOPK) ? t_ + 1 : TOPK; \
        const unsigned char* base_ = KVb + ((sub_ >> 3) ? (WS_AV - WS_AK) : 0) + (item_ & 1) * 128 + sw16; \
        const LAS unsigned short* sx_ = sidx + (it_ & 1) * 256 + 32 * c_ + r8; LAS unsigned char* dst_ = wl + (n__ & 3) * 4096; \
        _Pragma("unroll") for (int i_ = 0; i_ < 4; ++i_) { const int slot_ = 32 * c_ + 8 * i_ + r8; const unsigned key_ = slot_ < cnt_ ? (unsigned)sx_[8 * i_] : 0u; dma16(base_ + (size_t)key_ * 256, dst_ + i_ * 1024); } } } while (0)
#define DSA_WAIT(n_) do { if ((n_) + 3 < nsteps) asm volatile("s_waitcnt vmcnt(12)" ::: "memory"); else asm volatile("s_waitcnt vmcnt(0)" ::: "memory"); } while (0)
    if (nrows > 0) {
        if (lane < 32) { dma16(SEL + (size_t)(b * SEQ + wi) * 512 + lane * 16, (LAS unsigned char*)sidx); dma16(AQ + (size_t)(b * SEQ + wi) * 1024 + lane * 16, Qs); }
        asm volatile("s_waitcnt vmcnt(0)" ::: "memory");
        DSA_ISSUE(0); DSA_ISSUE(1); DSA_ISSUE(2);
    }
#pragma unroll 1
    for (int item = 0; item < 2 * nrows; ++item) {
        const int it = item >> 1, g = item & 1, t = wi + it * nper, row = b * SEQ + t;
        const int cnt = (t + 1 < TOPK) ? t + 1 : TOPK; const int n0 = 16 * item;
        float sc[16]; bf16x8_t aq[2];
#pragma unroll
        for (int c = 0; c < 8; ++c) {
            DSA_ISSUE(n0 + c + 3); DSA_WAIT(n0 + c);
            if (c == 0) {
#pragma unroll
                for (int c2 = 0; c2 < 2; ++c2) { aq[c2] = (bf16x8_t){0, 0, 0, 0, 0, 0, 0, 0}; if (arow) aq[c2] = *(const LAS bf16x8_t*)(Qs + ahead * 128 + 64 * c2 + 16 * kq); }
            }
            const LAS unsigned char* rb = wl + ((n0 + c) & 3) * 4096;
#pragma unroll
            for (int kt = 0; kt < 2; ++kt) {
                const int rr = 16 * kt + c16; const LAS unsigned char* rp = rb + rr * 128;
                const bf16x8_t k0 = *(const LAS bf16x8_t*)(rp + ((kq ^ (rr & 7)) << 4)), k1 = *(const LAS bf16x8_t*)(rp + (((4 + kq) ^ (rr & 7)) << 4));
                f32x4_t a = {0.f, 0.f, 0.f, 0.f};
                a = __builtin_amdgcn_mfma_f32_16x16x32_bf16(aq[0], k0, a, 0, 0, 0); a = __builtin_amdgcn_mfma_f32_16x16x32_bf16(aq[1], k1, a, 0, 0, 0);
                sc[2 * c + kt] = (32 * c + rr < cnt) ? a[0] : -INFINITY;
            }
        }
        float mx = sc[0];
#pragma unroll
        for (int i = 1; i < 16; ++i) mx = fmaxf(mx, sc[i]);
        mx = fmaxf(mx, __shfl_xor(mx, 1)); mx = fmaxf(mx, __shfl_xor(mx, 2)); mx = fmaxf(mx, __shfl_xor(mx, 4)); mx = fmaxf(mx, __shfl_xor(mx, 8));
        float sum = 0.f;
#pragma unroll
        for (int i = 0; i < 16; ++i) { sc[i] = fexp2(sc[i] - mx); sum += sc[i]; }
        sum += __shfl_xor(sum, 1); sum += __shfl_xor(sum, 2); sum += __shfl_xor(sum, 4); sum += __shfl_xor(sum, 8);
        const float inv = 1.0f / sum;
#pragma unroll
        for (int i = 0; i < 16; ++i) Pl[kq * 256 + 16 * i + c16] = (unsigned short)f2bf(sc[i]);
        f32x4_t o[4];
#pragma unroll
        for (int dt = 0; dt < 4; ++dt) o[dt] = (f32x4_t){0.f, 0.f, 0.f, 0.f};
#pragma unroll
        for (int c = 0; c < 8; ++c) {
            DSA_ISSUE(n0 + 8 + c + 3); DSA_WAIT(n0 + 8 + c);
            if (c == 0 && item + 1 < 2 * nrows) {
                if (lane < 32) { const int t2 = wi + ((item + 1) >> 1) * nper; dma16(AQ + (size_t)(b * SEQ + t2) * 1024 + ((item + 1) & 1) * 512 + lane * 16, Qs);
                    if (g == 1) dma16(SEL + (size_t)(b * SEQ + t2) * 512 + lane * 16, (LAS unsigned char*)(sidx + ((it + 1) & 1) * 256)); }
            }
            const unsigned rba = ring_addr + (unsigned)(((n0 + 8 + c) & 3) * 4096);
            bf16x8_t pa = (bf16x8_t){0, 0, 0, 0, 0, 0, 0, 0};
            if (arow) { const s16x4_t lo = *(const LAS s16x4_t*)(Pl + ahead * 256 + 32 * c + 4 * kq), hi = *(const LAS s16x4_t*)(Pl + ahead * 256 + 32 * c + 16 + 4 * kq);
                pa = (bf16x8_t){lo[0], lo[1], lo[2], lo[3], hi[0], hi[1], hi[2], hi[3]}; }
            const int r1 = 4 * kq + (c16 >> 2), pp = c16 & 3;
            s16x4_t vlo[4], vhi[4];
#pragma unroll
            for (int dt = 0; dt < 4; ++dt) { const unsigned off = (unsigned)(r1 * 128 + (((2 * dt + (pp >> 1)) ^ (r1 & 7)) << 4) + 8 * (pp & 1)); vlo[dt] = tr_read(rba + off); vhi[dt] = tr_read(rba + off + 16 * 128); }
            asm volatile("s_waitcnt lgkmcnt(0)" : "+v"(vlo[0]), "+v"(vlo[1]), "+v"(vlo[2]), "+v"(vlo[3]), "+v"(vhi[0]), "+v"(vhi[1]), "+v"(vhi[2]), "+v"(vhi[3]) :: "memory");
            __builtin_amdgcn_sched_barrier(0);
#pragma unroll
            for (int dt = 0; dt < 4; ++dt) { const bf16x8_t vb = (bf16x8_t){vlo[dt][0], vlo[dt][1], vlo[dt][2], vlo[dt][3], vhi[dt][0], vhi[dt][1], vhi[dt][2], vhi[dt][3]};
                o[dt] = __builtin_amdgcn_mfma_f32_16x16x32_bf16(pa, vb, o[dt], 0, 0, 0); }
        }
        bf16* op = OA + (size_t)row * 512 + (4 * g + kq) * 64 + c16;
#pragma unroll
        for (int dt = 0; dt < 4; ++dt) op[16 * dt] = (bf16)f2bf(o[dt][0] * inv);
    }
    asm volatile("s_waitcnt vmcnt(0)" ::: "memory");
#undef DSA_ISSUE
#undef DSA_WAIT
}

typedef float f32x2_t __attribute__((ext_vector_type(2))); typedef __bf16 bf16x2v_t __attribute__((ext_vector_type(2)));
__device__ __forceinline__ unsigned cvtpk_s(float lo, float hi) { f32x2_t v = {lo, hi}; bf16x2v_t b = __builtin_convertvector(v, bf16x2v_t); return __builtin_bit_cast(unsigned, b); }
__device__ __forceinline__ int crow16(int reg, int h) { return (reg & 3) + 8 * (reg >> 2) + 4 * h; }

__device__ __forceinline__ void phase_swa_fast(const Params& p, int G, int wv) {
    const int wave = wv, lane = lane_id(), tid = wave * 64 + lane;
    const int r = lane & 31, h = lane >> 5, hh = wave >> 1, qh = wave & 1;
    unsigned char* ws = p.ws;
    const bf16* BQ = (const bf16*)(ws + WS_BQ); const bf16* BK = (const bf16*)(ws + WS_BK); const bf16* BV = (const bf16*)(ws + WS_BV); bf16* OB = (bf16*)(ws + WS_OB);
    for (int k = 0;; ++k) {
        int b, idx;
        if (G >= 8 && (G & 7) == 0) { idx = (blockIdx.x >> 3) + (G >> 3) * k; if (idx >= 64) break; b = blockIdx.x & 7; }
        else { const int u = blockIdx.x + k * G; if (u >= 512) break; b = u >> 6; idx = u & 63; }
        const int qb = idx >> 1, g = idx & 1, head = 4 * g + hh;
        const float sink = p.sinks[head] * LOG2E;
        const bf16* Kb = BK + (size_t)b * SEQ * 128 + g * 64 + 8 * h; const bf16* Vb = BV + (size_t)b * SEQ * 128 + g * 64 + r;
#pragma unroll 1
        for (int qt = 0; qt < 2; ++qt) {
            const int q0 = 128 * qb + 64 * qh + 32 * qt;
            const size_t qrow = (size_t)b * SEQ + q0 + r;
            bf16x8_t qf[4];
#pragma unroll
            for (int s = 0; s < 4; ++s) qf[s] = *(const bf16x8_t*)(BQ + qrow * 512 + head * 64 + 16 * s + 8 * h);
            f32x16_t S[5];
#pragma unroll
            for (int kt = 0; kt < 5; ++kt) {
                const int kb0 = q0 - 128 + 32 * kt; const int krow_ = kb0 + r; const int kc = krow_ < 0 ? 0 : krow_;
                bf16x8_t kf[4];
#pragma unroll
                for (int s = 0; s < 4; ++s) kf[s] = *(const bf16x8_t*)(Kb + (size_t)kc * 128 + 16 * s);
                f32x16_t a = {0.f, 0.f, 0.f, 0.f, 0.f, 0.f, 0.f, 0.f, 0.f, 0.f, 0.f, 0.f, 0.f, 0.f, 0.f, 0.f};
#pragma unroll
                for (int s = 0; s < 4; ++s) a = __builtin_amdgcn_mfma_f32_32x32x16_bf16(kf[s], qf[s], a, 0, 0, 0);
#pragma unroll
                for (int i = 0; i < 16; ++i) { const int key = kb0 + crow16(i, h); const int rel = q0 + r - key; S[kt][i] = (key >= 0 && rel >= 0 && rel < WIN) ? a[i] : -INFINITY; }
            }
            float mx = sink;
#pragma unroll
            for (int kt = 0; kt < 5; ++kt)
#pragma unroll
                for (int i = 0; i < 16; ++i) mx = fmaxf(mx, S[kt][i]);
            mx = fmaxf(mx, __shfl_xor(mx, 32));
            float l = 0.f;
#pragma unroll
            for (int kt = 0; kt < 5; ++kt)
#pragma unroll
                for (int i = 0; i < 16; ++i) { S[kt][i] = fexp2(S[kt][i] - mx); l += S[kt][i]; }
            l += __shfl_xor(l, 32); l += fexp2(sink - mx);
            const float linv = 1.0f / l;
            f32x16_t O0 = {0.f, 0.f, 0.f, 0.f, 0.f, 0.f, 0.f, 0.f, 0.f, 0.f, 0.f, 0.f, 0.f, 0.f, 0.f, 0.f}, O1 = O0;
#pragma unroll
            for (int kt = 0; kt < 5; ++kt) {
                const int kb0 = q0 - 128 + 32 * kt;
#pragma unroll
                for (int s = 0; s < 2; ++s) {
                    v4u pw; pw.x = cvtpk_s(S[kt][8 * s + 0], S[kt][8 * s + 1]); pw.y = cvtpk_s(S[kt][8 * s + 2], S[kt][8 * s + 3]); pw.z = cvtpk_s(S[kt][8 * s + 4], S[kt][8 * s + 5]); pw.w = cvtpk_s(S[kt][8 * s + 6], S[kt][8 * s + 7]);
                    const bf16x8_t pa = __builtin_bit_cast(bf16x8_t, pw);
                    unsigned short v0[8], v1[8];
#pragma unroll
                    for (int j = 0; j < 8; ++j) { int key = kb0 + 16 * s + 8 * (j >> 2) + 4 * h + (j & 3); key = key < 0 ? 0 : key; v0[j] = Vb[(size_t)key * 128]; v1[j] = Vb[(size_t)key * 128 + 32]; }
                    const bf16x8_t vb0 = (bf16x8_t){(short)v0[0], (short)v0[1], (short)v0[2], (short)v0[3], (short)v0[4], (short)v0[5], (short)v0[6], (short)v0[7]};
                    const bf16x8_t vb1 = (bf16x8_t){(short)v1[0], (short)v1[1], (short)v1[2], (short)v1[3], (short)v1[4], (short)v1[5], (short)v1[6], (short)v1[7]};
                    O0 = __builtin_amdgcn_mfma_f32_32x32x16_bf16(pa, vb0, O0, 0, 0, 0); O1 = __builtin_amdgcn_mfma_f32_32x32x16_bf16(pa, vb1, O1, 0, 0, 0);
                }
            }
            bf16* op = OB + ((size_t)b * SEQ + q0) * 512 + head * 64 + r;
#pragma unroll
            for (int i = 0; i < 16; ++i) { const int qq = crow16(i, h); const float li = __shfl(linv, qq); op[(size_t)qq * 512] = (bf16)f2bf(O0[i] * li); op[(size_t)qq * 512 + 32] = (bf16)f2bf(O1[i] * li); }
        }
    }
}

#define XB_TMO      128
#define XB_XCNT(j)  (256  + 64 * (j))
#define XB_XSUB(j)  (1280 + 64 * (j))
#define XB_XGEN(j)  (2304 + 64 * (j))
#define XB_TOP      3328
#define XB_TOPGEN   3392
#define XCD_BAR_WORDS 3456
#define XB_SPIN_CAP (1u << 18)

__device__ __forceinline__ unsigned xb_ld(unsigned* p)              { return __hip_atomic_load(p, __ATOMIC_RELAXED, __HIP_MEMORY_SCOPE_AGENT); }
__device__ __forceinline__ unsigned xb_add(unsigned* p, unsigned v) { return __hip_atomic_fetch_add(p, v, __ATOMIC_RELAXED, __HIP_MEMORY_SCOPE_AGENT); }
__device__ __forceinline__ unsigned xb_xcc_id() { return (unsigned)__builtin_amdgcn_s_getreg((3 << 11) | 20) & 0xFu; }
#define XB_SPIN(cond, bar) do { unsigned _sp = 0; while (cond) { __builtin_amdgcn_s_sleep(1); \
    if ((++_sp & 255u) == 0u) { if (xb_ld(&(bar)[XB_TMO])) break; if (_sp > XB_SPIN_CAP) { atomicAdd(&(bar)[XB_TMO], 1u); break; } } } } while (0)

struct XcdBarrier {
    unsigned* bar; unsigned x;
    volatile LAS unsigned* st;
};

__device__ __forceinline__ XcdBarrier xcd_barrier_post(unsigned* bar, volatile LAS unsigned* st) {
    XcdBarrier b; b.bar = bar; b.x = xb_xcc_id(); b.st = st;
    if (threadIdx.x == 0) (void)xb_add(&bar[XB_XCNT(b.x)], 1u);
    return b;
}
__device__ __forceinline__ void xcd_barrier_complete(unsigned* bar, unsigned x, unsigned& nloc, unsigned& nx) {
    const unsigned G = gridDim.x * gridDim.y * gridDim.z;
    unsigned sum, cnt, mine, sp = 0u;
    for (;;) {
        sum = 0u; cnt = 0u; mine = 0u;
#pragma unroll
        for (unsigned j = 0; j < 16; ++j) { const unsigned c = xb_ld(&bar[XB_XCNT(j)]); sum += c; cnt += (c > 0u) ? 1u : 0u; mine = (j == x) ? c : mine; }
        if (sum == G) break;
        __builtin_amdgcn_s_sleep(1);
        if ((++sp & 255u) == 0u) { if (xb_ld(&bar[XB_TMO])) break; if (sp > XB_SPIN_CAP) { atomicAdd(&bar[XB_TMO], 1u); break; } }
    }
    nloc = mine > 0u ? mine : 1u; nx = cnt > 0u ? cnt : 1u;
}

__device__ __forceinline__ void xcd_barrier(const XcdBarrier& b, int wv) {
    asm volatile("s_waitcnt vmcnt(0)" ::: "memory");
    __syncthreads();
    if (wv == 0 && lane_id() == 0) {
        unsigned* bar = b.bar;
        __builtin_amdgcn_s_waitcnt(0);
        unsigned nloc = b.st[0], nx = b.st[1];
        if (nloc == 0u) { xcd_barrier_complete(bar, b.x, nloc, nx); b.st[0] = nloc; b.st[1] = nx; }
        const unsigned old = xb_add(&bar[XB_XSUB(b.x)], 1u);
        const unsigned gen = old / nloc;
        if (old + 1u == (gen + 1u) * nloc) {
            __builtin_amdgcn_fence(__ATOMIC_RELEASE, "agent");
            asm volatile("s_waitcnt vmcnt(0)" ::: "memory");
            const unsigned og = xb_add(&bar[XB_TOP], 1u);
            const unsigned tg = og / nx;
            if (og + 1u == (tg + 1u) * nx) xb_add(&bar[XB_TOPGEN], 1u);
            else XB_SPIN(xb_ld(&bar[XB_TOPGEN]) == tg, bar);
            __builtin_amdgcn_fence(__ATOMIC_ACQUIRE, "agent");
            xb_add(&bar[XB_XGEN(b.x)], 1u);
            asm volatile("s_waitcnt vmcnt(0)" ::: "memory");
        } else {
            XB_SPIN(xb_ld(&bar[XB_XGEN(b.x)]) == gen, bar);
            __builtin_amdgcn_fence(__ATOMIC_ACQUIRE, "agent");
            asm volatile("s_waitcnt vmcnt(0)" ::: "memory");
        }
    }
    __syncthreads();
}

constexpr int NPHASE = 9;
__global__ void __launch_bounds__(NTHREADS, 2) mk_fwd(Params p) {
    extern __shared__ __attribute__((aligned(16))) unsigned char lds_raw[];
    LAS unsigned char* lds = (LAS unsigned char*)lds_raw;
    const int G = gridDim.x, wv = __builtin_amdgcn_readfirstlane(threadIdx.x >> 6);
    unsigned char* ws = p.ws;
#if MK_ONE_LAUNCH
#define SEAM(k) do { if (rep_ + 1 < REPS(k)) __syncthreads(); else if (lo <= (k) && (k) + 1 < hi) { xcd_barrier(xbar, wv); } } while (0)
#else
#define SEAM(k) do { if (rep_ + 1 < REPS(k)) __syncthreads(); } while (0)
#endif
    const int lo = p.ph_lo, hi = p.ph_hi;
#if MK_ONE_LAUNCH
    if (threadIdx.x == 0) { ((volatile LAS unsigned*)(lds + XB_LDS_OFF))[0] = 0u; ((volatile LAS unsigned*)(lds + XB_LDS_OFF))[1] = 0u; }
    const XcdBarrier xbar = xcd_barrier_post((unsigned*)(ws + WS_BAR), (volatile LAS unsigned*)(lds + XB_LDS_OFF));
#endif
#ifdef PROBE_TS
    unsigned long long* TS = (unsigned long long*)(ws + WS_RSTD1 + 384 * 1024);
#define STAMP(k) do { if (blockIdx.x == 0) TS[k] = __builtin_amdgcn_s_memrealtime(); } while (0)
#else
#define STAMP(k) do { } while (0)
#endif
#if MK_ONE_LAUNCH
    if (p.ph_hi > 1000) cg::this_grid().sync();
#endif
    STAMP(0);
#ifndef PHMASK
#define PHMASK 0x1ffu
#endif
#define IN(k) (((PHMASK >> (k)) & 1u) && lo <= (k) && (k) < hi)
#define REPS(k) (((REP_MASK >> (k)) & 1u) ? 2 : 1)
#define PHASE(k) if (IN(k)) for (int rep_ = 0; rep_ < REPS(k); ++rep_)
    PHASE(0) { phase_prologue(p, lds, G, wv); SEAM(0); STAMP(0 + 1); }
    PHASE(1) {
        pg8::Gemm g{(const bf16*)(ws + WS_XG), (const bf16*)(ws + WS_WIN), TOK, NIN, DM, nullptr, 1 << 30};
        pg8::StaticOrder S; S.init(TOK, NIN, G, (int)blockIdx.x);
        pg8::EpiInProj E{(const float*)(ws + WS_RSTD1), (const float*)(ws + WS_COS), (const float*)(ws + WS_SIN), ws, p.ikw, p.ikb};
        pg8::gemm_phase<pg8::EpiInProj, pg8::StaticOrder, true, true>(lds, g, S, E, wv);
        SEAM(1); STAMP(1 + 1);
    }
#if MK_SIMPLE_TOPK
    PHASE(2) { phase_topk_simple(p, lds, G, wv); SEAM(2); STAMP(2 + 1); }
#else
    PHASE(2) { phase_topk_fast(p, lds, G, wv); SEAM(2); STAMP(2 + 1); }
#endif
#if MK_SIMPLE_DSA
    PHASE(3) { phase_attn_simple<true, true>(p, lds, G, wv); SEAM(3); STAMP(3 + 1); }
#else
#if MK_SIMPLE_SWA
    PHASE(3) { phase_dsa_fast(p, lds, G, wv); __syncthreads(); phase_attn_simple<false, true>(p, lds, G, wv); SEAM(3); STAMP(3 + 1); }
#else
#ifndef REP_SWA
#define REP_SWA 1
#endif
#ifndef REP_DSA
#define REP_DSA 1
#endif
    PHASE(3) { for (int q_ = 0; q_ < REP_SWA; ++q_) phase_swa_fast(p, G, wv); for (int q_ = 0; q_ < REP_DSA; ++q_) phase_dsa_fast(p, lds, G, wv); SEAM(3); STAMP(3 + 1); }
#endif
#endif
    PHASE(4) {
        pg8::Gemm g{(const bf16*)(ws + WS_OA), (const bf16*)(ws + WS_WAB), TOK, 2048, 512, (const bf16*)(ws + WS_OB), 4};
        pg8::BranchOrder S{G, (int)blockIdx.x};
        pg8::EpiGate E{(const bf16*)(ws + WS_GA), (const bf16*)(ws + WS_GB), p.out, (bf16*)(ws + WS_MIX)};
        pg8::gemm_phase<pg8::EpiGate, pg8::BranchOrder, true, true>(lds, g, S, E, wv);
        SEAM(4); STAMP(4 + 1);
    }
    PHASE(5) {
        pg8::Gemm g{(const bf16*)(ws + WS_MIX), (const bf16*)(ws + WS_WOUT), TOK, DM, DM, nullptr, 1 << 30};
        pg8::StaticOrder S; S.init(TOK, DM, G, (int)blockIdx.x);
        pg8::EpiResid<true> E{p.x, p.out, (bf16*)(ws + WS_XG), p.mlp_norm_w, (float*)(ws + WS_SS2)};
        pg8::gemm_phase<pg8::EpiResid<true>, pg8::StaticOrder, true, true>(lds, g, S, E, wv);
        SEAM(5); STAMP(5 + 1);
    }
    PHASE(6) {
        pg8::Gemm g{(const bf16*)(ws + WS_XG), (const bf16*)(ws + WS_WUP), TOK, DFF, DM, nullptr, 1 << 30};
        pg8::StaticOrder S; S.init(TOK, DFF, G, (int)blockIdx.x);
        pg8::EpiUp E{(const float*)(ws + WS_SS2), (bf16*)(ws + WS_HID)};
        pg8::gemm_phase<pg8::EpiUp, pg8::StaticOrder, true, true>(lds, g, S, E, wv);
        SEAM(6); STAMP(6 + 1);
    }
    PHASE(7) {
        pg8::Gemm g{(const bf16*)(ws + WS_HID), (const bf16*)(ws + WS_WDN), TOK, DM, DFF, nullptr, 1 << 30};
        pg8::StaticOrder S; S.init(TOK, DM, G, (int)blockIdx.x);
        pg8::EpiResid<false> E{p.out, p.out, nullptr, nullptr, (float*)(ws + WS_SS3)};
        pg8::gemm_phase<pg8::EpiResid<false>, pg8::StaticOrder, true, true>(lds, g, S, E, wv);
        SEAM(7); STAMP(7 + 1);
    }
#ifdef EXTRA_SYNCS
#if MK_ONE_LAUNCH
    for (int es_ = 0; es_ < EXTRA_SYNCS; ++es_) xcd_barrier(xbar, wv);
#endif
#endif
    PHASE(8) { phase_final(p, G, wv); }
#undef PHASE
#undef REPS
#undef IN
#undef SEAM
}

extern "C" void kernel_launch(void* const* d_in, const int* in_sizes, int n_in, void* d_out, int out_size, void* d_ws, size_t ws_size, hipStream_t stream) {
    static int grid = 0;
    if (grid == 0) {
        if (n_in != 13 || in_sizes[0] != TOK * DM || out_size != TOK * DM || ws_size < WS_NEED) {
            fprintf(stderr, "kernel_launch: unexpected shapes (n_in %d, in0 %d, out %d, ws %zu); nothing launched\n", n_in, n_in > 0 ? in_sizes[0] : -1, out_size, ws_size); grid = -1; return; }
        int dev = 0, cus = 0, per_cu = 0;
        (void)hipGetDevice(&dev); (void)hipDeviceGetAttribute(&cus, hipDeviceAttributeMultiprocessorCount, dev);
        if (hipFuncSetAttribute((const void*)mk_fwd, hipFuncAttributeMaxDynamicSharedMemorySize, LDS_BYTES) != hipSuccess) { fprintf(stderr, "kernel_launch: hipFuncSetAttribute failed\n"); grid = -1; return; }
        if (hipOccupancyMaxActiveBlocksPerMultiprocessor(&per_cu, (const void*)mk_fwd, NTHREADS, LDS_BYTES) != hipSuccess || per_cu < 1) { fprintf(stderr, "kernel_launch: occupancy query says %d blocks per CU\n", per_cu); per_cu = 1; }
        (void)hipGetLastError();
        if (per_cu > 1) per_cu = 1;
        grid = cus * per_cu;
    }
    if (grid < 0) return;
    Params p{};
    p.x = (const float*)d_in[0]; p.attn_norm_w = (const float*)d_in[1]; p.w_in = (const float*)d_in[2]; p.ikw = (const float*)d_in[3]; p.ikb = (const float*)d_in[4];
    p.sinks = (const float*)d_in[5]; p.w_a = (const float*)d_in[6]; p.w_b = (const float*)d_in[7]; p.w_out = (const float*)d_in[8]; p.mlp_norm_w = (const float*)d_in[9];
    p.w_up = (const float*)d_in[10]; p.w_down = (const float*)d_in[11]; p.final_w = (const float*)d_in[12];
    p.out = (float*)d_out; p.ws = (unsigned char*)d_ws;
    for (int i = 0; i < 32; ++i) p.inv_freq[i] = 1.0f / powf(10000.0f, (float)(2 * i) / 64.0f);
#if MK_ONE_LAUNCH
    if (hipMemsetAsync((char*)d_ws + WS_BAR, 0, 16384, stream) != hipSuccess) { fprintf(stderr, "kernel_launch: hipMemsetAsync of the barrier words failed\n"); return; }
    p.ph_lo = 0; p.ph_hi = NPHASE;
    void* args[] = {&p};
    hipError_t e = hipLaunchCooperativeKernel((const void*)mk_fwd, dim3(grid), dim3(NTHREADS), args, LDS_BYTES, stream);
    if (e != hipSuccess) fprintf(stderr, "kernel_launch: cooperative launch failed: %s (grid %d)\n", hipGetErrorString(e), grid);
#else
    for (int ph = 0; ph < NPHASE; ++ph) {
        p.ph_lo = ph; p.ph_hi = ph + 1;
        hipLaunchKernelGGL(mk_fwd, dim3(grid), dim3(NTHREADS), LDS_BYTES, stream, p);
    }
#endif
}
```

```cpp
#include <hip/hip_runtime.h>
#include <hip/hip_cooperative_groups.h>
#include <cstdio>
#include <cstdint>
namespace cg = cooperative_groups;

#ifndef MK_ONE_LAUNCH
#define MK_ONE_LAUNCH 1
#endif
#ifndef MK_SIMPLE_TOPK
#define MK_SIMPLE_TOPK 0
#endif
#ifndef MK_SIMPLE_SWA
#define MK_SIMPLE_SWA 0
#endif
#ifndef MK_SIMPLE_DSA
#define MK_SIMPLE_DSA 0
#endif

constexpr int NBATCH = 8, SEQ = 4096, DM = 1024, TOK = NBATCH * SEQ, DFF = 4096, TOPK = 256, WIN = 128;
constexpr int NIN = 4352;
constexpr float RMS_EPS = 1e-6f, LN_EPS = 1e-6f;
constexpr float QSCALE = 0.125f * 1.4426950408889634f;
constexpr float LOG2E = 1.4426950408889634f;
constexpr float W_SCALE = 0.04419417382415922f;
constexpr int C_AQ = 0, C_AK = 512, C_AV = 640, C_IQ = 768, C_IK = 1280, C_IW = 1344, C_BQ = 1352, C_BK = 1864, C_BV = 1992, C_GA = 2120, C_GB = 3144, D_IN = 4168;

constexpr size_t MiB = 1u << 20;
constexpr size_t WS_RSTD1 = 0, WS_SS2 = 128 * 1024, WS_SS3 = 256 * 1024;
constexpr size_t WS_BAR = 512 * 1024;
constexpr int XB_LDS_OFF = 163832;
constexpr size_t WS_COS = 1 * MiB, WS_SIN = 1 * MiB + 512 * 1024;
constexpr size_t WS_WIN = 2 * MiB, WS_WAB = 11 * MiB, WS_WOUT = 13 * MiB, WS_WUP = 15 * MiB, WS_WDN = 23 * MiB;
constexpr size_t WS_XG = 32 * MiB;
constexpr size_t WS_AQ = 96 * MiB, WS_IQ = 128 * MiB, WS_BQ = 160 * MiB, WS_AK = 192 * MiB, WS_AV = 200 * MiB, WS_BK = 208 * MiB, WS_BV = 216 * MiB;
constexpr size_t WS_IK = 224 * MiB, WS_IW = 228 * MiB, WS_SEL = 230 * MiB, WS_GA = 248 * MiB, WS_GB = 312 * MiB, WS_MIX = 376 * MiB, WS_END = 440 * MiB;
#ifndef MK_SEPARATE_O
#define MK_SEPARATE_O 0
#endif
#ifndef REP_MASK
#define REP_MASK 0u
#endif
constexpr size_t WS_OA = MK_SEPARATE_O ? 440 * MiB : WS_AQ, WS_OB = MK_SEPARATE_O ? 472 * MiB : WS_BQ, WS_NEED = MK_SEPARATE_O ? 504 * MiB : WS_END;
constexpr size_t WS_PROBE_SS = 640 * 1024, WS_PROBE_OUT = 376 * MiB;
constexpr size_t WS_HID = 96 * MiB;
static_assert(WS_WIN + (size_t)NIN * DM * 2 <= WS_WAB && WS_HID + (size_t)TOK * DFF * 2 <= WS_MIX, "ws map");

constexpr int LDS_RING = 131072, LDS_BYTES = 163840;

#define GAS __attribute__((address_space(1)))
#define LAS __attribute__((address_space(3)))
typedef unsigned short bf16;
typedef unsigned v4u __attribute__((ext_vector_type(4)));
typedef unsigned v2u __attribute__((ext_vector_type(2)));
typedef float v4f __attribute__((ext_vector_type(4)));

__device__ __forceinline__ float bf2f(unsigned short u) { return __uint_as_float((unsigned)u << 16); }
__device__ __forceinline__ float bflo(unsigned u) { return __uint_as_float(u << 16); }
__device__ __forceinline__ float bfhi(unsigned u) { return __uint_as_float(u & 0xffff0000u); }
__device__ __forceinline__ unsigned f2bf(float f) { unsigned u = __float_as_uint(f); return (u + 0x7fffu + ((u >> 16) & 1u)) >> 16; }
__device__ __forceinline__ unsigned pk2(float lo, float hi) { unsigned r; asm volatile("v_cvt_pk_bf16_f32 %0, %1, %2" : "=v"(r) : "v"(lo), "v"(hi)); return r; }
__device__ __forceinline__ float fexp2(float x) { return __builtin_amdgcn_exp2f(x); }
__device__ __forceinline__ float frsq(float x) { return __builtin_amdgcn_rsqf(x); }
__device__ __forceinline__ float frcp(float x) { return __builtin_amdgcn_rcpf(x); }
__device__ __forceinline__ float sigmoidf_(float x) { return frcp(1.0f + fexp2(-x * LOG2E)); }
__device__ __forceinline__ float wave_sum(float v) {
#pragma unroll
    for (int o = 1; o < 64; o <<= 1) v += __shfl_xor(v, o);
    return v;
}
__device__ __forceinline__ float wave_max(float v) {
#pragma unroll
    for (int o = 1; o < 64; o <<= 1) v = fmaxf(v, __shfl_xor(v, o));
    return v;
}
__device__ __forceinline__ int lane_id() { unsigned m = ~0u; asm volatile("" : "+s"(m)); return __builtin_amdgcn_mbcnt_hi(m, __builtin_amdgcn_mbcnt_lo(m, 0u)); }
__device__ __forceinline__ int tid_op(int wv) { return wv * 64 + lane_id(); }
__device__ __forceinline__ int mbcnt64(unsigned long long m) { return __builtin_amdgcn_mbcnt_hi((unsigned)(m >> 32), __builtin_amdgcn_mbcnt_lo((unsigned)m, 0u)); }

namespace pg8 {
#define PG8_LAS __attribute__((address_space(3)))
typedef unsigned short bf16_t;
typedef short bf16x8 __attribute__((ext_vector_type(8)));
typedef float f32x4 __attribute__((ext_vector_type(4)));
typedef unsigned u32x4 __attribute__((ext_vector_type(4)));
constexpr int BM = 256, BK = 64, HALF = 128, HTB = HALF * BK * 2  , STAGE_BYTES = 8 * HTB, NXCD = 8, WGM = 8;

__host__ __device__ __forceinline__ int lds_byte(int r, int c) { const int st = (r >> 4) * 2 + (c >> 5), rr = r & 15, cc = c & 31, ob = rr * 64 + cc * 2; return st * 1024 + (ob ^ (((ob >> 9) & 1) << 5)); }
__host__ __device__ __forceinline__ void stage_rc(int b, int& R, int& C) { const int st = b / 1024, sb = b % 1024, swz = sb ^ (((sb >> 9) & 1) << 5); R = (st >> 1) * 16 + swz / 64; C = (st & 1) * 32 + (swz % 64) / 2; }
__host__ __device__ __forceinline__ int perm32(int rho) { const int n = rho >> 4, i = rho & 15; return 8 * (i >> 2) + 4 * n + (i & 3); }

struct Unit { int pm, pn; };
struct Gemm { const bf16_t* A; const bf16_t* Bt; int M, N, K; const bf16_t* A2; int asplit;
    __device__ __forceinline__ const char* abase(const Unit& u) const { return (const char*)(u.pn >= asplit ? A2 : A); } };

struct StaticOrder {
    int nM, nN, nwg, G, c;
    __host__ __device__ void init(int M, int N, int G_, int c_) { nM = M / BM; nN = N / BM; nwg = nM * nN; G = G_; c = c_; }
    __host__ __device__ bool next(int i, Unit& u) const {
        const long L = (long)i * G + c; if (L >= nwg) return false;
        int wgid = (int)L; { const int q = nwg / NXCD, r = nwg % NXCD, xcd = wgid % NXCD, off = wgid / NXCD; wgid = (xcd < r ? xcd * (q + 1) : r * (q + 1) + (xcd - r) * q) + off; }
        const int nig = WGM * nN, gid = wgid / nig, fm = gid * WGM, gsz = (nM - fm) < WGM ? (nM - fm) : WGM;
        u.pm = fm + ((wgid % nig) % gsz); u.pn = (wgid % nig) / gsz; return true;
    }
    __device__ __forceinline__ void a_ready(const Unit&) const {}
    __device__ __forceinline__ void done(const Unit&) const {}
};

__device__ __forceinline__ unsigned cvt_pk_bf16(float lo, float hi) { unsigned r; asm volatile("v_cvt_pk_bf16_f32 %0, %1, %2" : "=v"(r) : "v"(lo), "v"(hi)); return r; }
__device__ __forceinline__ u32x4 pack8(const float (&v)[8]) { u32x4 w; w.x = cvt_pk_bf16(v[0], v[1]); w.y = cvt_pk_bf16(v[2], v[3]); w.z = cvt_pk_bf16(v[4], v[5]); w.w = cvt_pk_bf16(v[6], v[7]); return w; }

struct EpiInProj {
    static constexpr bool PERM = true, AFTER_DRAIN = false;
    const float* rstd1; const float* cs; const float* sn; unsigned char* ws; const float* ikw; const float* ikb;
    __device__ __forceinline__ void operator()(const f32x4 (&acc)[2][2][4][2], const Unit& u, int wr, int wc, int fr_, int fq_) const {
        const int pn = u.pn; int fr = fr_, fq = fq_;
        asm volatile("" : "+v"(fr), "+v"(fq));
#pragma unroll
        for (int ai = 0; ai < 2; ++ai)
#pragma unroll
            for (int m = 0; m < 4; ++m) {
                const int row = u.pm * BM + ai * HALF + wr * 64 + m * 16 + fr;
                const float rs = rstd1[row];
                float x1[8], x2[8];
#pragma unroll
                for (int j = 0; j < 4; ++j) { x1[j] = acc[ai][0][m][0][j] * rs; x1[4 + j] = acc[ai][0][m][1][j] * rs; x2[j] = acc[ai][1][m][0][j] * rs; x2[4 + j] = acc[ai][1][m][1][j] * rs; }
                if (pn >= 9) {
                    bf16_t* G = (bf16_t*)(ws + WS_GA + (size_t)((pn - 9) >> 2) * (WS_GB - WS_GA)) + (size_t)row * 1024 + 256 * ((pn - 9) & 3) + 32 * wc + 8 * fq;
                    float a[8], b[8];
#pragma unroll
                    for (int j = 0; j < 8; ++j) { a[j] = 1.0f / (1.0f + __builtin_amdgcn_exp2f(-x1[j] * 1.4426950408889634f)); b[j] = 1.0f / (1.0f + __builtin_amdgcn_exp2f(-x2[j] * 1.4426950408889634f)); }
                    *(u32x4*)G = pack8(a); *(u32x4*)(G + 128) = pack8(b);
                } else if (pn == 8) {
                    if (wc == 0) {
                        float s = 0.f;
#pragma unroll
                        for (int j = 0; j < 8; ++j) s += x1[j] + x2[j];
                        s += __shfl_xor(s, 16); s += __shfl_xor(s, 32);
                        const float mu = s * (1.0f / 64.0f); float q = 0.f;
#pragma unroll
                        for (int j = 0; j < 8; ++j) { x1[j] -= mu; x2[j] -= mu; q += x1[j] * x1[j] + x2[j] * x2[j]; }
                        q += __shfl_xor(q, 16); q += __shfl_xor(q, 32);
                        const float rstd = __builtin_amdgcn_rsqf(q * (1.0f / 64.0f) + 1e-6f);
                        const int pos = row & 4095; const float* cp = cs + pos * 32 + 8 * fq; const float* sp = sn + pos * 32 + 8 * fq;
                        float o1[8], o2[8];
#pragma unroll
                        for (int j = 0; j < 8; ++j) { const float y1 = x1[j] * rstd * ikw[8 * fq + j] + ikb[8 * fq + j], y2 = x2[j] * rstd * ikw[32 + 8 * fq + j] + ikb[32 + 8 * fq + j];
                            const float c = cp[j], sI = sp[j]; o1[j] = y1 * c - y2 * sI; o2[j] = y2 * c + y1 * sI; }
                        unsigned char* tb = ws + WS_IK + (size_t)(row >> 5) * 4096 + (size_t)(row & 31) * 16;
                        *(u32x4*)(tb + (fq >> 1) * 1024 + (fq & 1) * 512) = pack8(o1); *(u32x4*)(tb + (2 + (fq >> 1)) * 1024 + (fq & 1) * 512) = pack8(o2);
                    } else if (wc == 1 && fq == 0) {
                        float* dst = (float*)(ws + WS_IW) + (size_t)row * 8;
                        *(f32x4*)dst = (f32x4){x1[0], x1[1], x1[2], x1[3]} * 0.04419417382415922f; *(f32x4*)(dst + 4) = (f32x4){x1[4], x1[5], x1[6], x1[7]} * 0.04419417382415922f;
                    }
                } else if (pn >= 6) {
                    bf16_t* Kd = (bf16_t*)(ws + WS_AK + (size_t)(pn - 6) * (WS_BK - WS_AK)); bf16_t* Vd = (bf16_t*)(ws + WS_AV + (size_t)(pn - 6) * (WS_BV - WS_AV));
                    if (wc < 2) {
                        const int pos = row & 4095; const float* cp = cs + pos * 32 + 8 * fq; const float* sp = sn + pos * 32 + 8 * fq;
                        float o1[8], o2[8];
#pragma unroll
                        for (int j = 0; j < 8; ++j) { const float c = cp[j], sI = sp[j]; o1[j] = x1[j] * c - x2[j] * sI; o2[j] = x2[j] * c + x1[j] * sI; }
                        bf16_t* dst = Kd + (size_t)row * 128 + wc * 64 + 8 * fq;
                        *(u32x4*)dst = pack8(o1); *(u32x4*)(dst + 32) = pack8(o2);
                    } else {
                        bf16_t* dst = Vd + (size_t)row * 128 + 32 * (wc - 2) + 8 * fq;
                        *(u32x4*)dst = pack8(x1); *(u32x4*)(dst + 64) = pack8(x2);
                    }
                } else {
                    bf16_t* Q = (bf16_t*)(ws + WS_AQ + (size_t)(pn >> 1) * (WS_IQ - WS_AQ)); const float sc = (pn >= 2 && pn < 4) ? 1.0f : 0.125f * 1.4426950408889634f;
                    const int pos = row & 4095; const float* cp = cs + pos * 32 + 8 * fq; const float* sp = sn + pos * 32 + 8 * fq;
                    float o1[8], o2[8];
#pragma unroll
                    for (int j = 0; j < 8; ++j) { const float c = cp[j], sI = sp[j]; o1[j] = (x1[j] * c - x2[j] * sI) * sc; o2[j] = (x2[j] * c + x1[j] * sI) * sc; }
                    bf16_t* dst = Q + (size_t)row * 512 + (4 * (pn & 1) + wc) * 64 + 8 * fq;
                    *(u32x4*)dst = pack8(o1); *(u32x4*)(dst + 32) = pack8(o2);
                }
                asm volatile("" ::: "memory");
            }
    }
};

struct EpiGate {
    static constexpr bool PERM = true, AFTER_DRAIN = false;
    const bf16_t *GA, *GB; float* P; bf16_t* MIX;
    __device__ __forceinline__ void operator()(const f32x4 (&acc)[2][2][4][2], const Unit& u, int wr, int wc, int fr, int fq) const {
        const bool second = u.pn >= 4; const bf16_t* G = second ? GB : GA;
#pragma unroll
        for (int ai = 0; ai < 2; ++ai)
#pragma unroll
            for (int m = 0; m < 4; ++m) {
                const int row = u.pm * BM + ai * HALF + wr * 64 + m * 16 + fr;
#pragma unroll
                for (int bj = 0; bj < 2; ++bj) {
                    const size_t off = (size_t)row * 1024 + 256 * (u.pn & 3) + 128 * bj + 32 * wc + 8 * fq;
                    const u32x4 gw = *(const u32x4*)(G + off);
                    float v[8];
#pragma unroll
                    for (int j = 0; j < 4; ++j) { v[j] = acc[ai][bj][m][0][j]; v[4 + j] = acc[ai][bj][m][1][j]; }
                    v[0] *= __uint_as_float(gw.x << 16); v[1] *= __uint_as_float(gw.x & 0xffff0000u); v[2] *= __uint_as_float(gw.y << 16); v[3] *= __uint_as_float(gw.y & 0xffff0000u);
                    v[4] *= __uint_as_float(gw.z << 16); v[5] *= __uint_as_float(gw.z & 0xffff0000u); v[6] *= __uint_as_float(gw.w << 16); v[7] *= __uint_as_float(gw.w & 0xffff0000u);
                    if (!second) { *(u32x4*)(MIX + off) = pack8(v); }
                    else { const u32x4 pw = *(const u32x4*)(MIX + off);
                        v[0] += __uint_as_float(pw.x << 16); v[1] += __uint_as_float(pw.x & 0xffff0000u); v[2] += __uint_as_float(pw.y << 16); v[3] += __uint_as_float(pw.y & 0xffff0000u);
                        v[4] += __uint_as_float(pw.z << 16); v[5] += __uint_as_float(pw.z & 0xffff0000u); v[6] += __uint_as_float(pw.w << 16); v[7] += __uint_as_float(pw.w & 0xffff0000u);
                        *(u32x4*)(MIX + off) = pack8(v); }
                }
            }
    }
};

template <bool WITH_XG> struct EpiResid {
    static constexpr bool PERM = false, AFTER_DRAIN = false;
    const float* base; float* out; bf16_t* XG; const float* gw; float* ss;
    __device__ __forceinline__ void operator()(const f32x4 (&acc)[2][2][4][2], const Unit& u, int wr, int wc, int fr, int fq) const {
#pragma unroll
        for (int ai = 0; ai < 2; ++ai)
#pragma unroll
            for (int m = 0; m < 4; ++m) {
                const int row = u.pm * BM + ai * HALF + wr * 64 + m * 16 + fr; float s = 0.f;
#pragma unroll
                for (int bj = 0; bj < 2; ++bj)
#pragma unroll
                    for (int n = 0; n < 2; ++n) {
                        const int col = u.pn * BM + bj * HALF + wc * 32 + n * 16 + 4 * fq; const size_t off = (size_t)row * 1024 + col;
                        const f32x4 v = *(const f32x4*)(base + off) + acc[ai][bj][m][n];
                        *(f32x4*)(out + off) = v; s += (v[0] * v[0] + v[1] * v[1]) + (v[2] * v[2] + v[3] * v[3]);
                        if (WITH_XG) { const f32x4 g = *(const f32x4*)(gw + col); unsigned long long w = (unsigned long long)cvt_pk_bf16(v[0] * g[0], v[1] * g[1]) | ((unsigned long long)cvt_pk_bf16(v[2] * g[2], v[3] * g[3]) << 32);
                            *(unsigned long long*)(XG + off) = w; }
                    }
                s += __shfl_xor(s, 16); s += __shfl_xor(s, 32);
                if (fq == 0) atomicAdd(ss + row, s);
            }
    }
};

struct EpiUp {
    static constexpr bool PERM = true, AFTER_DRAIN = false;
    const float* ss; bf16_t* HID;
    __device__ __forceinline__ void operator()(const f32x4 (&acc)[2][2][4][2], const Unit& u, int wr, int wc, int fr, int fq) const {
#pragma unroll
        for (int ai = 0; ai < 2; ++ai)
#pragma unroll
            for (int m = 0; m < 4; ++m) {
                const int row = u.pm * BM + ai * HALF + wr * 64 + m * 16 + fr;
                const float rs = __builtin_amdgcn_rsqf(ss[row] * (1.0f / 1024.0f) + 1e-6f);
#pragma unroll
                for (int bj = 0; bj < 2; ++bj) {
                    float v[8];
#pragma unroll
                    for (int j = 0; j < 4; ++j) { float a = fmaxf(acc[ai][bj][m][0][j] * rs, 0.f), b = fmaxf(acc[ai][bj][m][1][j] * rs, 0.f); v[j] = a * a; v[4 + j] = b * b; }
                    *(u32x4*)(HID + (size_t)row * 4096 + u.pn * BM + bj * HALF + wc * 32 + 8 * fq) = pack8(v);
                }
            }
    }
};

struct BranchOrder {
    int G, c;
    __device__ __forceinline__ bool next(int i, Unit& u) const {
        const int tile = (i >> 1) * G + c; if (tile >= 128 * 4) return false;
        u.pm = tile >> 2; u.pn = (tile & 3) + 4 * (i & 1); return true;
    }
    __device__ __forceinline__ void a_ready(const Unit&) const {}
    __device__ __forceinline__ void done(const Unit&) const {}
};


struct EpiDummy {
    static constexpr bool PERM = true, AFTER_DRAIN = false;
    bf16_t* D; int ldc;
    __device__ __forceinline__ void operator()(const f32x4 (&acc)[2][2][4][2], const Unit& u, int wr, int wc, int fr, int fq) const {
#pragma unroll
        for (int ai = 0; ai < 2; ++ai)
#pragma unroll
            for (int m = 0; m < 4; ++m) {
                const int row = (u.pm * BM + ai * HALF + wr * 64 + m * 16 + fr) & 8191;
#pragma unroll
                for (int bj = 0; bj < 2; ++bj) { float v[8];
#pragma unroll
                    for (int j = 0; j < 4; ++j) { v[j] = acc[ai][bj][m][0][j]; v[4 + j] = acc[ai][bj][m][1][j]; }
                    *(u32x4*)(D + (size_t)row * ldc + u.pn * BM + bj * HALF + wc * 32 + 8 * fq) = pack8(v); }
            }
    }
};
template <class Epi, class Sched, bool ALIGN_EPI = false, bool SP2 = false>
__device__ __forceinline__ void gemm_phase(PG8_LAS unsigned char* lds, const Gemm g, const Sched& S, const Epi& E, int wv) {
    const int tid = tid_op(wv), wid = wv, lane = tid & 63, wr = wid >> 2, wc = wid & 3, fr = lane & 15, fq = lane >> 4;
    const int K = g.K, nt = K / BK;
    unsigned voffA[2], voffB[2];
#pragma unroll
    for (int i = 0; i < 2; ++i) { int R, C; stage_rc(tid * 16 + i * 8192, R, C); const int Rb = Epi::PERM ? ((R & ~31) + perm32(R & 31)) : R;
        voffA[i] = (unsigned)(R * K + C) * 2u; voffB[i] = (unsigned)(Rb * K + C) * 2u; }
    const size_t kstep = (size_t)(BK * 2);
    const size_t hstep = (size_t)HALF * K * 2;
    const size_t tstep = 2 * hstep;
    const unsigned ldsw = (unsigned)wid * 1024u;
    const int aoff = lds_byte(wr * 64 + fr, fq * 8), boff = lds_byte(wc * 32 + fr, fq * 8);
#define PG8_SA(b, h) (((b) * 2 + (h)) * HTB)
#define PG8_SB(b, h) ((4 + (b) * 2 + (h)) * HTB)
#define PG8_STAGE(bufoff, gbase, voff) do { _Pragma("unroll") for (int _i = 0; _i < 2; ++_i) \
        __builtin_amdgcn_global_load_lds((const unsigned*)((const char*)(gbase) + (voff)[_i]), (PG8_LAS unsigned*)(lds + (bufoff) + ldsw + _i * 8192), 16, 0, 0); } while (0)
#define PG8_LDA(dst, b, h) do { _Pragma("unroll") for (int m = 0; m < 4; ++m) _Pragma("unroll") for (int k = 0; k < 2; ++k) dst[m][k] = *(const PG8_LAS bf16x8*)(lds + PG8_SA(b, h) + aoff + m * 2048 + k * 1024); } while (0)
#define PG8_LDB(dst, b, h) do { _Pragma("unroll") for (int n = 0; n < 2; ++n) _Pragma("unroll") for (int k = 0; k < 2; ++k) dst[n][k] = *(const PG8_LAS bf16x8*)(lds + PG8_SB(b, h) + boff + n * 2048 + k * 1024); } while (0)
#define PG8_MMA(ai, bj, At, Bt) do { __builtin_amdgcn_s_setprio(1); _Pragma("unroll") for (int m = 0; m < 4; ++m) _Pragma("unroll") for (int n = 0; n < 2; ++n) _Pragma("unroll") for (int k = 0; k < 2; ++k) \
        acc[ai][bj][m][n] = __builtin_amdgcn_mfma_f32_16x16x32_bf16(Bt[n][k], At[m][k], acc[ai][bj][m][n], 0, 0, 0); __builtin_amdgcn_s_setprio(0); } while (0)
#define PG8_WAIT_V(n) asm volatile("s_waitcnt vmcnt(" #n ")" ::: "memory")
#define PG8_WAIT_L(n) asm volatile("s_waitcnt lgkmcnt(" #n ")" ::: "memory")
#define PG8_BAR __builtin_amdgcn_s_barrier()
#define PG8_SCHED __builtin_amdgcn_sched_barrier(0)
    Unit cur, nxt; int ui = 0;
    if (!S.next(0, cur)) return;
    f32x4 acc[2][2][4][2];
#pragma unroll
    for (int a = 0; a < 2; ++a)
#pragma unroll
        for (int b = 0; b < 2; ++b)
#pragma unroll
            for (int m = 0; m < 4; ++m)
#pragma unroll
                for (int n = 0; n < 2; ++n) acc[a][b][m][n] = (f32x4){0.f, 0.f, 0.f, 0.f};
    bf16x8 At[4][2], B0[2][2], B1[2][2];
    const char* cA = g.abase(cur) + (size_t)cur.pm * tstep; const char* cB = (const char*)g.Bt + (size_t)cur.pn * tstep;
    S.a_ready(cur);
    if constexpr (SP2) {
        PG8_STAGE(PG8_SB(0, 0), cB, voffB); PG8_STAGE(PG8_SB(0, 1), cB + hstep, voffB); PG8_STAGE(PG8_SA(0, 0), cA, voffA); PG8_STAGE(PG8_SA(0, 1), cA + hstep, voffA);
        if (wr == 1) PG8_BAR;
        PG8_WAIT_V(2); PG8_BAR;
        PG8_STAGE(PG8_SB(1, 0), cB + kstep, voffB); PG8_STAGE(PG8_SA(1, 0), cA + kstep, voffA); PG8_STAGE(PG8_SB(1, 1), cB + hstep + kstep, voffB);
        PG8_WAIT_V(6); PG8_BAR;
    } else {
        PG8_STAGE(PG8_SB(0, 0), cB, voffB); PG8_STAGE(PG8_SA(0, 0), cA, voffA); PG8_STAGE(PG8_SB(0, 1), cB + hstep, voffB); PG8_STAGE(PG8_SA(0, 1), cA + hstep, voffA);
        if (wr == 1) PG8_BAR;
        PG8_WAIT_V(4); PG8_BAR;
        PG8_STAGE(PG8_SB(1, 0), cB + kstep, voffB); PG8_STAGE(PG8_SA(1, 0), cA + kstep, voffA); PG8_STAGE(PG8_SB(1, 1), cB + hstep + kstep, voffB);
        PG8_WAIT_V(6); PG8_BAR;
    }
    for (;;) {
        const bool has_next = S.next(ui + 1, nxt);
        const char* nA = has_next ? g.abase(nxt) + (size_t)nxt.pm * tstep : cA; const char* nB = has_next ? (const char*)g.Bt + (size_t)nxt.pn * tstep : cB;
        for (int t = 0; t < nt; t += 2) {
            const bool last = (t == nt - 2);
            const char* a1 = cA + (size_t)(t + 1) * kstep;
            const char* a2 = last ? nA : cA + (size_t)(t + 2) * kstep; const char* b2 = last ? nB : cB + (size_t)(t + 2) * kstep;
            const char* a3 = a2 + kstep; const char* b3 = b2 + kstep;
            if (last && has_next) S.a_ready(nxt);
            if constexpr (SP2) {
            PG8_LDB(B0, 0, 0); PG8_LDB(B1, 0, 1); PG8_SCHED; PG8_LDA(At, 0, 0); PG8_STAGE(PG8_SA(1, 1), a1 + hstep, voffA);
            PG8_WAIT_V(8); PG8_WAIT_L(0); PG8_BAR; PG8_MMA(0, 0, At, B0); PG8_MMA(0, 1, At, B1); PG8_BAR; PG8_SCHED;
            PG8_LDA(At, 0, 1); PG8_STAGE(PG8_SB(0, 0), b2, voffB); PG8_STAGE(PG8_SB(0, 1), b2 + hstep, voffB); PG8_STAGE(PG8_SA(0, 0), a2, voffA);
            PG8_WAIT_V(8); PG8_WAIT_L(0); PG8_BAR; PG8_MMA(1, 0, At, B0); PG8_MMA(1, 1, At, B1); PG8_BAR; PG8_SCHED;
            PG8_LDB(B0, 1, 0); PG8_LDB(B1, 1, 1); PG8_SCHED; PG8_LDA(At, 1, 0); PG8_STAGE(PG8_SA(0, 1), a2 + hstep, voffA);
            PG8_WAIT_V(8); PG8_WAIT_L(0); PG8_BAR; PG8_MMA(0, 0, At, B0); PG8_MMA(0, 1, At, B1); PG8_BAR; PG8_SCHED;
            PG8_LDA(At, 1, 1); PG8_STAGE(PG8_SB(1, 0), b3, voffB); PG8_STAGE(PG8_SB(1, 1), b3 + hstep, voffB); PG8_STAGE(PG8_SA(1, 0), a3, voffA);
            PG8_WAIT_V(8); PG8_WAIT_L(0); PG8_BAR; PG8_MMA(1, 0, At, B0); PG8_MMA(1, 1, At, B1); PG8_BAR; PG8_SCHED;
            } else {
            PG8_LDB(B0, 0, 0); PG8_SCHED; PG8_LDA(At, 0, 0); PG8_STAGE(PG8_SA(1, 1), a1 + hstep, voffA);
            PG8_WAIT_L(8); PG8_BAR; PG8_WAIT_L(0); PG8_MMA(0, 0, At, B0); PG8_BAR; PG8_SCHED;
            PG8_LDB(B1, 0, 1); PG8_STAGE(PG8_SB(0, 0), b2, voffB);
            PG8_BAR; PG8_WAIT_L(0); PG8_MMA(0, 1, At, B1); PG8_BAR;
            PG8_LDA(At, 0, 1); PG8_STAGE(PG8_SA(0, 0), a2, voffA);
            PG8_BAR; PG8_WAIT_L(0); PG8_MMA(1, 0, At, B0); PG8_BAR; PG8_SCHED;
            PG8_STAGE(PG8_SB(0, 1), b2 + hstep, voffB);
            PG8_WAIT_V(6); PG8_BAR; PG8_MMA(1, 1, At, B1); PG8_BAR;
            PG8_LDB(B0, 1, 0); PG8_SCHED; PG8_LDA(At, 1, 0); PG8_STAGE(PG8_SA(0, 1), a2 + hstep, voffA);
            PG8_WAIT_L(8); PG8_BAR; PG8_WAIT_L(0); PG8_MMA(0, 0, At, B0); PG8_BAR; PG8_SCHED;
            PG8_LDB(B1, 1, 1); PG8_STAGE(PG8_SB(1, 0), b3, voffB);
            PG8_BAR; PG8_WAIT_L(0); PG8_MMA(0, 1, At, B1); PG8_BAR;
            PG8_LDA(At, 1, 1); PG8_STAGE(PG8_SA(1, 0), a3, voffA);
            PG8_BAR; PG8_WAIT_L(0); PG8_MMA(1, 0, At, B0); PG8_BAR; PG8_SCHED;
            PG8_STAGE(PG8_SB(1, 1), b3 + hstep, voffB);
            PG8_WAIT_V(6); PG8_BAR; PG8_MMA(1, 1, At, B1); PG8_BAR;
            }
        }
        if constexpr (ALIGN_EPI) { if (wr == 0) PG8_BAR; }
        if constexpr (!Epi::AFTER_DRAIN) { E(acc, cur, wr, wc, fr, fq); S.done(cur); }
        if (!has_next) break;
#pragma unroll
        for (int a = 0; a < 2; ++a)
#pragma unroll
            for (int b = 0; b < 2; ++b)
#pragma unroll
                for (int m = 0; m < 4; ++m)
#pragma unroll
                    for (int n = 0; n < 2; ++n) acc[a][b][m][n] = (f32x4){0.f, 0.f, 0.f, 0.f};
        cur = nxt; cA = nA; cB = nB; ++ui;
        if constexpr (ALIGN_EPI) { if (wr == 1) PG8_BAR; }
    }
    PG8_WAIT_V(0);
    if constexpr (!ALIGN_EPI) { if (wr == 0) PG8_BAR; }
    PG8_BAR;
    if constexpr (Epi::AFTER_DRAIN) { E.fused(acc, cur, wr, wc, fr, fq, lds, wid, lane); S.done(cur); }
#undef PG8_SA
#undef PG8_SB
#undef PG8_STAGE
#undef PG8_LDA
#undef PG8_LDB
#undef PG8_MMA
#undef PG8_WAIT_V
#undef PG8_WAIT_L
#undef PG8_BAR
#undef PG8_SCHED
}
}
struct Params {
    const float *x, *attn_norm_w, *w_in, *ikw, *ikb, *sinks, *w_a, *w_b, *w_out, *mlp_norm_w, *w_up, *w_down, *final_w;
    float* out; unsigned char* ws;
    float inv_freq[32];
    int ph_lo, ph_hi;
};
constexpr int NWAVES = 8, NTHREADS = 512;

__device__ __forceinline__ int win_src_group(int grp, int& cnt) {
    const int tile = grp >> 3, g = grp & 7; cnt = 32;
    if (tile < 6) { const int base = tile < 2 ? C_AQ : (tile < 4 ? C_IQ : C_BQ); const int head = 4 * (tile & 1) + (g & 3); return base + head * 64 + 32 * (g >> 2); }
    if (tile < 8) { const int kb = tile == 6 ? C_AK : C_BK, vb = tile == 6 ? C_AV : C_BV; const int hf = g >> 2, q = g & 3;
        if (q < 2) return kb + q * 64 + 32 * hf; return vb + 64 * hf + 32 * (q - 2); }
    if (tile == 8) { if (g == 0) return C_IK; if (g == 4) return C_IK + 32; if (g == 1) { cnt = 8; return C_IW; } cnt = 0; return 0; }
    return C_GA + (grp - 72) * 32;
}
__device__ __forceinline__ void p0_transpose_item(const float* W, int ldw, int c0, int cnt, int K, bf16* WT, int n0, int k0, LAS float* scr, int lane) {
#pragma unroll 8
    for (int i = 0; i < 32; ++i) { const int kk = 2 * i + (lane >> 5), n = lane & 31; scr[kk * 33 + n] = (n < cnt) ? W[(size_t)(k0 + kk) * ldw + c0 + n] : 0.f; }
    asm volatile("s_waitcnt lgkmcnt(0)" ::: "memory");
    const int c = lane & 7;
#pragma unroll
    for (int j = 0; j < 4; ++j) { const int n = (lane >> 3) + 8 * j; const LAS float* s = scr + (8 * c) * 33 + n;
        v4u o; o.x = pk2(s[0 * 33], s[1 * 33]); o.y = pk2(s[2 * 33], s[3 * 33]); o.z = pk2(s[4 * 33], s[5 * 33]); o.w = pk2(s[6 * 33], s[7 * 33]);
        *(v4u*)(WT + (size_t)(n0 + n) * K + k0 + 8 * c) = o; }
    asm volatile("s_waitcnt lgkmcnt(0)" ::: "memory");
}
__device__ __forceinline__ void sincos_d(float angf, float& sn, float& cs) {
    const double a = (double)angf; const double kq = __builtin_rint(a * 0.63661977236758134308);
    const double y = (a - kq * 1.57079632679489655800) - kq * 6.123233995736766e-17; const double y2 = y * y;
    double s = y * (1.0 + y2 * (-1.0 / 6 + y2 * (1.0 / 120 + y2 * (-1.0 / 5040 + y2 * (1.0 / 362880 + y2 * (-1.0 / 39916800 + y2 * (1.0 / 6227020800.0)))))));
    double c = 1.0 + y2 * (-0.5 + y2 * (1.0 / 24 + y2 * (-1.0 / 720 + y2 * (1.0 / 40320 + y2 * (-1.0 / 3628800 + y2 * (1.0 / 479001600.0 + y2 * (-1.0 / 87178291200.0)))))));
    const int q = ((int)kq) & 3;
    const double ss = (q == 0) ? s : (q == 1) ? c : (q == 2) ? -s : -c; const double cc = (q == 0) ? c : (q == 1) ? -s : (q == 2) ? -c : s;
    sn = (float)ss; cs = (float)cc;
}
__device__ __forceinline__ void phase_prologue(const Params& p, LAS unsigned char* lds, int G, int wv) {
    const int wave = wv, lane = lane_id();
    unsigned char* ws = p.ws;
    LAS float* scr = (LAS float*)(lds + wave * 16384);
    const int gw = blockIdx.x * NWAVES + wave, NGW = G * NWAVES;
    constexpr int I_IN = (DM / 64) * (NIN / 32), I_A = (512 / 64) * (DM / 32), I_O = (DM / 64) * (DM / 32), I_U = (DM / 64) * (DFF / 32), I_D = (DFF / 64) * (DM / 32);
    constexpr int NITEMS = I_IN + 2 * I_A + I_O + I_U + I_D;
    for (int it = gw; it < NITEMS; it += NGW) {
        int r = it;
        if (r < I_IN) { const int grp = r % (NIN / 32), kb = r / (NIN / 32); int cnt; const int c0 = win_src_group(grp, cnt);
            p0_transpose_item(p.w_in, D_IN, c0, cnt, DM, (bf16*)(ws + WS_WIN), grp * 32, kb * 64, scr, lane); continue; } r -= I_IN;
        if (r < I_A) { const int nb = r % 32, kb = r / 32; p0_transpose_item(p.w_a, DM, nb * 32, 32, 512, (bf16*)(ws + WS_WAB), nb * 32, kb * 64, scr, lane); continue; } r -= I_A;
        if (r < I_A) { const int nb = r % 32, kb = r / 32; p0_transpose_item(p.w_b, DM, nb * 32, 32, 512, (bf16*)(ws + WS_WAB), 1024 + nb * 32, kb * 64, scr, lane); continue; } r -= I_A;
        if (r < I_O) { const int nb = r % 32, kb = r / 32; p0_transpose_item(p.w_out, DM, nb * 32, 32, DM, (bf16*)(ws + WS_WOUT), nb * 32, kb * 64, scr, lane); continue; } r -= I_O;
        if (r < I_U) { const int nb = r % 128, kb = r / 128; p0_transpose_item(p.w_up, DFF, nb * 32, 32, DM, (bf16*)(ws + WS_WUP), nb * 32, kb * 64, scr, lane); continue; } r -= I_U;
        { const int nb = r % 32, kb = r / 32; p0_transpose_item(p.w_down, DM, nb * 32, 32, DFF, (bf16*)(ws + WS_WDN), nb * 32, kb * 64, scr, lane); }
    }
    float* COS = (float*)(ws + WS_COS); float* SIN = (float*)(ws + WS_SIN);
    for (int i = gw * 64 + lane; i < SEQ * 32; i += NGW * 64) { const int pos = i >> 5, d = i & 31; const float ang = (float)pos * p.inv_freq[d]; float s, c; sincos_d(ang, s, c); COS[i] = c; SIN[i] = s; }
    float* RSTD1 = (float*)(ws + WS_RSTD1); float* SS2 = (float*)(ws + WS_SS2); float* SS3 = (float*)(ws + WS_SS3); bf16* XG = (bf16*)(ws + WS_XG);
    v4f g[4];
#pragma unroll
    for (int j = 0; j < 4; ++j) g[j] = *((const v4f*)p.attn_norm_w + lane + 64 * j);
    int m = gw;
    for (; m + 3 * NGW < TOK; m += 4 * NGW) {
        v4f v[4][4]; float s[4];
#pragma unroll
        for (int q = 0; q < 4; ++q) { const v4f* xr = (const v4f*)(p.x + (size_t)(m + q * NGW) * DM) + lane;
#pragma unroll
            for (int j = 0; j < 4; ++j) v[q][j] = xr[64 * j]; }
#pragma unroll
        for (int q = 0; q < 4; ++q) { s[q] = 0.f;
#pragma unroll
            for (int j = 0; j < 4; ++j) s[q] += (v[q][j].x * v[q][j].x + v[q][j].y * v[q][j].y) + (v[q][j].z * v[q][j].z + v[q][j].w * v[q][j].w);
            s[q] = wave_sum(s[q]);
            unsigned long long* o8 = (unsigned long long*)(XG + (size_t)(m + q * NGW) * DM) + lane;
#pragma unroll
            for (int j = 0; j < 4; ++j) o8[64 * j] = (unsigned long long)pk2(v[q][j].x * g[j].x, v[q][j].y * g[j].y) | ((unsigned long long)pk2(v[q][j].z * g[j].z, v[q][j].w * g[j].w) << 32);
            if (lane == 0) { RSTD1[m + q * NGW] = frsq(s[q] * (1.0f / DM) + RMS_EPS); SS2[m + q * NGW] = 0.f; SS3[m + q * NGW] = 0.f; } }
    }
    for (; m < TOK; m += NGW) {
        const v4f* xr = (const v4f*)(p.x + (size_t)m * DM) + lane; v4f v[4]; float s = 0.f;
#pragma unroll
        for (int j = 0; j < 4; ++j) { v[j] = xr[64 * j]; s += (v[j].x * v[j].x + v[j].y * v[j].y) + (v[j].z * v[j].z + v[j].w * v[j].w); }
        s = wave_sum(s);
        unsigned long long* o8 = (unsigned long long*)(XG + (size_t)m * DM) + lane;
#pragma unroll
        for (int j = 0; j < 4; ++j) o8[64 * j] = (unsigned long long)pk2(v[j].x * g[j].x, v[j].y * g[j].y) | ((unsigned long long)pk2(v[j].z * g[j].z, v[j].w * g[j].w) << 32);
        if (lane == 0) { RSTD1[m] = frsq(s * (1.0f / DM) + RMS_EPS); SS2[m] = 0.f; SS3[m] = 0.f; }
    }
}

__device__ __forceinline__ unsigned f2key(float f) { const unsigned u = __float_as_uint(f); return (u & 0x80000000u) ? ~u : (u | 0x80000000u); }
__device__ __forceinline__ void phase_topk_simple(const Params& p, LAS unsigned char* lds, int G, int wv) {
    const int wave = wv, lane = lane_id();
    unsigned char* ws = p.ws;
    const bf16* IQ = (const bf16*)(ws + WS_IQ); const bf16* IK = (const bf16*)(ws + WS_IK); const float* IW = (const float*)(ws + WS_IW);
    unsigned short* SEL = (unsigned short*)(ws + WS_SEL);
    LAS unsigned* keys = (LAS unsigned*)(lds + wave * 16384);
    LAS float* qf = (LAS float*)(lds + LDS_RING + wave * 2048);
    const int gw = blockIdx.x * NWAVES + wave, NGW = G * NWAVES;
    for (int row = gw; row < TOK; row += NGW) {
        const int b = row >> 12, t = row & 4095, n = t + 1;
        unsigned short* selrow = SEL + (size_t)row * TOPK;
        if (n <= TOPK) { for (int i = lane; i < n; i += 64) selrow[i] = (unsigned short)i; continue; }
        { const v4u q8 = *((const v4u*)(IQ + (size_t)row * 512) + lane);
            LAS float* d = qf + 8 * lane;
            d[0] = bflo(q8.x); d[1] = bfhi(q8.x); d[2] = bflo(q8.y); d[3] = bfhi(q8.y); d[4] = bflo(q8.z); d[5] = bfhi(q8.z); d[6] = bflo(q8.w); d[7] = bfhi(q8.w); }
        float w[8];
#pragma unroll
        for (int h = 0; h < 8; ++h) w[h] = IW[(size_t)row * 8 + h];
        asm volatile("s_waitcnt lgkmcnt(0)" ::: "memory");
        for (int s0 = 0; s0 < n; s0 += 64) {
            const int s = s0 + lane; const int sc = s < n ? s : t;
            const v4u* kp = (const v4u*)(IK + ((size_t)b * SEQ + sc) * 64);
            float dot[8];
#pragma unroll
            for (int h = 0; h < 8; ++h) dot[h] = 0.f;
#pragma unroll
            for (int c = 0; c < 8; ++c) {
                const v4u k8 = kp[c]; float kf[8] = {bflo(k8.x), bfhi(k8.x), bflo(k8.y), bfhi(k8.y), bflo(k8.z), bfhi(k8.z), bflo(k8.w), bfhi(k8.w)};
#pragma unroll
                for (int h = 0; h < 8; ++h) { const v4f qa = *(const LAS v4f*)(qf + h * 64 + c * 8), qb = *(const LAS v4f*)(qf + h * 64 + c * 8 + 4);
                    dot[h] += (kf[0] * qa.x + kf[1] * qa.y) + (kf[2] * qa.z + kf[3] * qa.w) + (kf[4] * qb.x + kf[5] * qb.y) + (kf[6] * qb.z + kf[7] * qb.w); }
            }
            float sc_ = 0.f;
#pragma unroll
            for (int h = 0; h < 8; ++h) sc_ += w[h] * fmaxf(dot[h], 0.f);
            keys[s] = (s < n) ? f2key(sc_) : 0u;
        }
        asm volatile("s_waitcnt lgkmcnt(0)" ::: "memory");
        const int nch = (n + 63) >> 6;
        unsigned thr = 0u;
        for (int bit = 31; bit >= 0; --bit) {
            const unsigned cand = thr | (1u << bit); int cnt = 0;
            for (int c = 0; c < nch; ++c) cnt += __popcll(__ballot(keys[c * 64 + lane] >= cand));
            if (cnt >= TOPK) thr = cand;
        }
        int cgt = 0;
        for (int c = 0; c < nch; ++c) cgt += __popcll(__ballot(keys[c * 64 + lane] > thr));
        const int need = TOPK - cgt; int pos = 0, ties = 0;
        for (int c = 0; c < nch; ++c) {
            const unsigned k = keys[c * 64 + lane]; const bool gt = k > thr, eq = k == thr;
            const unsigned long long meq = __ballot(eq);
            const bool sel = gt || (eq && (ties + mbcnt64(meq) < need));
            const unsigned long long msel = __ballot(sel);
            if (sel) selrow[pos + mbcnt64(msel)] = (unsigned short)(c * 64 + lane);
            pos += __popcll(msel); ties += __popcll(meq);
        }
    }
}

template <bool SINK, class KeyFn>
__device__ __forceinline__ void attend_wave(const bf16* Q, const bf16* K, const bf16* V, bf16* O, int row, int g, int nslots, const KeyFn& keyfn, const float* sinkv,
                                            LAS float* qf  , LAS float* pf  , LAS int* kidx  , int lane) {
    const int b = row >> 12;
    { const v2u q4 = *((const v2u*)(Q + (size_t)row * 512 + g * 256) + lane);
        LAS float* d = qf + 4 * lane; d[0] = bflo(q4.x); d[1] = bfhi(q4.x); d[2] = bflo(q4.y); d[3] = bfhi(q4.y); }
    asm volatile("s_waitcnt lgkmcnt(0)" ::: "memory");
#pragma unroll 1
    for (int j = 0; j < 4; ++j) {
        const int slot = 64 * j + lane; int key = slot < nslots ? keyfn(slot) : -1; kidx[slot] = key;
        const bool valid = key >= 0; const int kc = valid ? key : 0;
        const v4u* kp = (const v4u*)(K + ((size_t)b * SEQ + kc) * 128 + g * 64);
        float dot[4] = {0.f, 0.f, 0.f, 0.f};
        if (64 * j < nslots) {
#pragma unroll 2
            for (int c = 0; c < 8; ++c) {
                const v4u k8 = kp[c]; float kf[8] = {bflo(k8.x), bfhi(k8.x), bflo(k8.y), bfhi(k8.y), bflo(k8.z), bfhi(k8.z), bflo(k8.w), bfhi(k8.w)};
#pragma unroll
                for (int h = 0; h < 4; ++h) { const v4f qa = *(const LAS v4f*)(qf + h * 64 + c * 8), qb = *(const LAS v4f*)(qf + h * 64 + c * 8 + 4);
                    dot[h] += (kf[0] * qa.x + kf[1] * qa.y) + (kf[2] * qa.z + kf[3] * qa.w) + (kf[4] * qb.x + kf[5] * qb.y) + (kf[6] * qb.z + kf[7] * qb.w); }
            }
        }
        *(LAS v4f*)(pf + slot * 4) = valid ? (v4f){dot[0], dot[1], dot[2], dot[3]} : (v4f){-INFINITY, -INFINITY, -INFINITY, -INFINITY};
    }
    asm volatile("s_waitcnt lgkmcnt(0)" ::: "memory");
    float lg[4][4];
#pragma unroll
    for (int j = 0; j < 4; ++j) { const v4f t4 = *(const LAS v4f*)(pf + (64 * j + lane) * 4); lg[j][0] = t4.x; lg[j][1] = t4.y; lg[j][2] = t4.z; lg[j][3] = t4.w; }
    float inv[4];
#pragma unroll
    for (int h = 0; h < 4; ++h) {
        float mx = fmaxf(fmaxf(lg[0][h], lg[1][h]), fmaxf(lg[2][h], lg[3][h])); mx = wave_max(mx);
        float sk = 0.f; if (SINK) { sk = sinkv[g * 4 + h] * LOG2E; mx = fmaxf(mx, sk); }
        float s = 0.f;
#pragma unroll
        for (int j = 0; j < 4; ++j) { const float e = fexp2(lg[j][h] - mx); lg[j][h] = e; s += e; }
        s = wave_sum(s); if (SINK) s += fexp2(sk - mx);
        inv[h] = 1.0f / s;
    }
#pragma unroll
    for (int j = 0; j < 4; ++j) *(LAS v4f*)(pf + (64 * j + lane) * 4) = (v4f){lg[j][0], lg[j][1], lg[j][2], lg[j][3]};
    asm volatile("s_waitcnt lgkmcnt(0)" ::: "memory");
    float o[4] = {0.f, 0.f, 0.f, 0.f};
    const bf16* Vb = V + (size_t)b * SEQ * 128 + g * 64 + lane;
#pragma unroll 1
    for (int s0 = 0; s0 < nslots; s0 += 8) {
        float vv[8]; v4f pp[8];
#pragma unroll
        for (int i = 0; i < 8; ++i) { const int slot = s0 + i; const int key = slot < nslots ? kidx[slot] : -1; pp[i] = *(const LAS v4f*)(pf + (slot & 255) * 4);
            vv[i] = key >= 0 ? bf2f(Vb[(size_t)key * 128]) : 0.f; if (key < 0) pp[i] = (v4f){0.f, 0.f, 0.f, 0.f}; }
#pragma unroll
        for (int i = 0; i < 8; ++i) { o[0] += pp[i].x * vv[i]; o[1] += pp[i].y * vv[i]; o[2] += pp[i].z * vv[i]; o[3] += pp[i].w * vv[i]; }
    }
    bf16* op = O + (size_t)row * 512 + g * 256 + lane;
#pragma unroll
    for (int h = 0; h < 4; ++h) op[h * 64] = (bf16)f2bf(o[h] * inv[h]);
}
struct SelKey { const unsigned short* selrow; __device__ __forceinline__ int operator()(int slot) const { return (int)selrow[slot]; } };
struct WinKey { int t; __device__ __forceinline__ int operator()(int slot) const { return t - (WIN - 1) + slot; } };

template <bool DO_DSA, bool DO_SWA>
__device__ __forceinline__ void phase_attn_simple(const Params& p, LAS unsigned char* lds, int G, int wv) {
    const int wave = wv, lane = lane_id();
    unsigned char* ws = p.ws;
    LAS float* qf = (LAS float*)(lds + wave * 16384); LAS float* pf = qf + 256; LAS int* kidx = (LAS int*)(pf + 1024);
    const int gw = blockIdx.x * NWAVES + wave, NGW = G * NWAVES;
    const unsigned short* SEL = (const unsigned short*)(ws + WS_SEL);
    for (int item = gw; item < TOK * 2; item += NGW) {
        const int row = item >> 1, g = item & 1, t = row & 4095;
        if (DO_DSA) { SelKey kf{SEL + (size_t)row * TOPK}; const int ns = (t + 1 < TOPK) ? t + 1 : TOPK;
            attend_wave<false>((const bf16*)(ws + WS_AQ), (const bf16*)(ws + WS_AK), (const bf16*)(ws + WS_AV), (bf16*)(ws + WS_OA), row, g, ns, kf, nullptr, qf, pf, kidx, lane); }
        if (DO_SWA) { WinKey kf{t};
            attend_wave<true>((const bf16*)(ws + WS_BQ), (const bf16*)(ws + WS_BK), (const bf16*)(ws + WS_BV), (bf16*)(ws + WS_OB), row, g, WIN, kf, p.sinks, qf, pf, kidx, lane); }
    }
}

__device__ __forceinline__ void phase_final(const Params& p, int G, int wv, float* dst) {
    const int wave = wv, lane = lane_id();
    const float* SS3 = (const float*)(p.ws + WS_SS3);
    const int gw = blockIdx.x * NWAVES + wave, NGW = G * NWAVES;
    v4f g[4];
#pragma unroll
    for (int j = 0; j < 4; ++j) g[j] = *((const v4f*)p.final_w + lane + 64 * j);
    for (int m = gw; m < TOK; m += NGW) {
        float rs = frsq(SS3[m] * (1.0f / DM) + RMS_EPS);
#ifdef PROBE_TS
        { const unsigned long long* TS = (const unsigned long long*)(p.ws + WS_RSTD1 + 384 * 1024); rs *= 1.0f + (float)(TS[PROBE_TS + 1] - TS[PROBE_TS]) * 1.0e-5f; }
#endif
        const v4f* xr = (const v4f*)(p.out + (size_t)m * DM) + lane; v4f* xo = (v4f*)(dst + (size_t)m * DM) + lane;
#pragma unroll
        for (int j = 0; j < 4; ++j) { v4f v = xr[64 * j]; xo[64 * j] = v * g[j] * rs; }
    }
}

typedef short bf16x8_t __attribute__((ext_vector_type(8)));
typedef float f32x16_t __attribute__((ext_vector_type(16)));
typedef float f32x4_t __attribute__((ext_vector_type(4)));
typedef float f32x2_t __attribute__((ext_vector_type(2)));
__device__ __forceinline__ unsigned f16key(float f) { const int q = (int)__builtin_rintf(f * 4096.0f) + 32768; return (unsigned)(q < 256 ? 256 : (q > 65535 ? 65535 : q)); }
__device__ __forceinline__ float relu1(float x) { return __builtin_amdgcn_fmed3f(x, 0.f, 3.0e38f); }
constexpr int TK_H1 = LDS_RING, TK_WAVE = LDS_RING + 8192, TK_WAVE_BYTES = 3072, TK_CAND = 512;
static_assert(TK_WAVE + 8 * TK_WAVE_BYTES <= LDS_BYTES, "top-k LDS map");

__device__ __forceinline__ void phase_topk_fast(const Params& p, LAS unsigned char* lds, int G, int wv) {
    const int wave = wv, lane = lane_id(), tid = wave * 64 + lane;
    const int r = lane & 31, h = lane >> 5, mt = wave & 3, par = wave >> 2;
    unsigned char* ws = p.ws;
    const bf16* IQ = (const bf16*)(ws + WS_IQ); const bf16* IK = (const bf16*)(ws + WS_IK); const float* IW = (const float*)(ws + WS_IW);
    unsigned short* SEL = (unsigned short*)(ws + WS_SEL);
    LAS unsigned short* kb = (LAS unsigned short*)lds;
    LAS unsigned* H1 = (LAS unsigned*)(lds + TK_H1);
    LAS unsigned* cl = (LAS unsigned*)(lds + TK_WAVE + wave * TK_WAVE_BYTES); LAS unsigned short* ol = (LAS unsigned short*)(lds + TK_WAVE + wave * TK_WAVE_BYTES + 4 * TK_CAND);
    const int qrow = 4 * mt + 2 * ((r >> 2) & 1) + (r >> 4), qhead = 4 * ((r >> 3) & 1) + (r & 3);
    { LAS v4u* hz = (LAS v4u*)H1; hz[tid] = (v4u){0u, 0u, 0u, 0u}; }
    for (int k = 0;; ++k) {
        int b, tile;
        if (G == 256) { if (k >= 8) break; const int c = blockIdx.x, i = c >> 3, grp = k >> 1; b = c & 7; tile = (k & 1) ? (64 * grp + 63 - i) : (64 * grp + i); }
        else { const int u = blockIdx.x + k * G; if (u >= TOK / 16) break; b = u >> 8; tile = u & 255; }
        const int t0 = tile * 16, R0 = b * SEQ + t0;
        if (t0 + 16 <= TOPK) {
            for (int i = tid; i < 16 * TOPK; i += NTHREADS) { const int ql = i >> 8, s = i & 255; if (s <= t0 + ql) SEL[(size_t)(R0 + ql) * TOPK + s] = (unsigned short)s; }
            continue;
        }
        bf16x8_t aq[4];
#pragma unroll
        for (int s = 0; s < 4; ++s) aq[s] = *(const bf16x8_t*)(IQ + (size_t)(R0 + qrow) * 512 + qhead * 64 + 16 * s + 8 * h);
        f32x2_t wq[2][4];
#pragma unroll
        for (int qq = 0; qq < 2; ++qq) { const f32x4_t w0 = *(const f32x4_t*)(IW + (size_t)(R0 + 4 * mt + 2 * h + qq) * 8), w1 = *(const f32x4_t*)(IW + (size_t)(R0 + 4 * mt + 2 * h + qq) * 8 + 4);
            const float n2 = (w0[0] * w0[0] + w0[1] * w0[1]) + (w0[2] * w0[2] + w0[3] * w0[3]) + (w1[0] * w1[0] + w1[1] * w1[1]) + (w1[2] * w1[2] + w1[3] * w1[3]);
            const float sn = __builtin_amdgcn_rsqf(fmaxf(n2, 1e-30f)) * 0.2141f;
            wq[qq][0] = (f32x2_t){w0[0], w0[1]} * sn; wq[qq][1] = (f32x2_t){w0[2], w0[3]} * sn; wq[qq][2] = (f32x2_t){w1[0], w1[1]} * sn; wq[qq][3] = (f32x2_t){w1[2], w1[3]} * sn; }
        const int ntile = (t0 + 16 + 31) >> 5, ntp = (ntile + 7) & ~7, nch = (t0 + 16 + 511) >> 9;
        const char* kbase = (const char*)IK + (size_t)b * SEQ * 128;
        const unsigned voff = (unsigned)(lane * 16);
        const int tq0 = t0 + 4 * mt + 2 * h;
        const int ql0 = 4 * mt + 2 * h;
        LAS unsigned short* row0 = kb + ql0 * 4096; LAS unsigned* h0 = H1 + ql0 * 128;
        __syncthreads();
#define TK_LOAD(dst, kt_) do { const int ktc_ = (kt_) < 127 ? (kt_) : 127; const char* tp_ = kbase + (size_t)ktc_ * 4096; _Pragma("unroll") for (int s_ = 0; s_ < 4; ++s_) dst[s_] = *(const bf16x8_t*)(tp_ + voff + 1024 * s_); } while (0)
#define TK_MMA(acc_, src) do { acc_ = (f32x16_t){0.f, 0.f, 0.f, 0.f, 0.f, 0.f, 0.f, 0.f, 0.f, 0.f, 0.f, 0.f, 0.f, 0.f, 0.f, 0.f}; \
            _Pragma("unroll") for (int s_ = 0; s_ < 4; ++s_) acc_ = __builtin_amdgcn_mfma_f32_32x32x16_bf16(aq[s_], src[s_], acc_, 0, 0, 0); } while (0)
#define TK_POST(acc_, kt_) do { f32x2_t s0_ = {0.f, 0.f}, s1_ = {0.f, 0.f}; \
            _Pragma("unroll") for (int hd_ = 0; hd_ < 4; ++hd_) { s0_ += (f32x2_t){relu1(acc_[2 * hd_]), relu1(acc_[2 * hd_ + 1])} * wq[0][hd_]; s1_ += (f32x2_t){relu1(acc_[8 + 2 * hd_]), relu1(acc_[9 + 2 * hd_])} * wq[1][hd_]; } \
            const int e_ = 32 * (kt_) + r; const unsigned k0_ = (e_ <= tq0) ? f16key(s0_.x + s0_.y) : 0u, k1_ = (e_ <= tq0 + 1) ? f16key(s1_.x + s1_.y) : 0u; \
            row0[e_] = (unsigned short)k0_; row0[4096 + e_] = (unsigned short)k1_; \
            if (k0_) __hip_atomic_fetch_add(h0 + (k0_ >> 9), 1u << ((k0_ >> 4) & 16u), __ATOMIC_RELAXED, __HIP_MEMORY_SCOPE_WORKGROUP); \
            if (k1_) __hip_atomic_fetch_add(h0 + 128 + (k1_ >> 9), 1u << ((k1_ >> 4) & 16u), __ATOMIC_RELAXED, __HIP_MEMORY_SCOPE_WORKGROUP); } while (0)
#ifndef TK_REP_SCORE
#define TK_REP_SCORE 1
#endif
#ifndef TK_REP_SEL
#define TK_REP_SEL 1
#endif
#pragma unroll 1
        for (int rp_ = 0; rp_ < TK_REP_SCORE; ++rp_) {
            if (rp_ > 0) { __syncthreads(); LAS v4u* hz = (LAS v4u*)H1; hz[tid] = (v4u){0u, 0u, 0u, 0u}; __syncthreads(); }
            bf16x8_t B[4][4]; f32x16_t accA, accB;
            const int nmy = ntp >> 1;
#pragma unroll
            for (int u = 0; u < 4; ++u) TK_LOAD(B[u], par + 2 * u);
            TK_MMA(accA, B[0]);
#pragma unroll 1
            for (int i = 0; i < nmy; i += 4) {
                const int kt = par + 2 * i;
                TK_MMA(accB, B[1]); TK_POST(accA, kt);     TK_LOAD(B[0], kt + 8);
                TK_MMA(accA, B[2]); TK_POST(accB, kt + 2); TK_LOAD(B[1], kt + 10);
                TK_MMA(accB, B[3]); TK_POST(accA, kt + 4); TK_LOAD(B[2], kt + 12);
                TK_MMA(accA, B[0]); TK_POST(accB, kt + 6); TK_LOAD(B[3], kt + 14);
            }
        }
#undef TK_LOAD
#undef TK_MMA
#undef TK_POST
        if (32 * ntp < 512 * nch) {
#pragma unroll
            for (int qi = 0; qi < 2; ++qi) { LAS v2u* z = (LAS v2u*)(kb + (2 * wave + qi) * 4096 + 32 * ntp) + lane; *z = (v2u){0u, 0u}; }
        }
        __syncthreads();
#pragma unroll 1
        for (int qi = 0; qi < 2 * TK_REP_SEL; ++qi) {
            const int ql = 2 * wave + (qi & 1);
            const LAS unsigned short* rb = kb + ql * 4096 + lane;
            const v2u hw = *(const LAS v2u*)(H1 + ql * 128 + 2 * lane); const v4u hv = {hw.x & 0xffffu, hw.x >> 16, hw.y & 0xffffu, hw.y >> 16};
            if ((qi >> 1) + 1 == TK_REP_SEL) *(LAS v2u*)(H1 + ql * 128 + 2 * lane) = (v2u){0u, 0u};
            const int hs = (int)(hv.x + hv.y + hv.z + hv.w); int S = hs;
#pragma unroll
            for (int off = 1; off < 64; off <<= 1) { const int v = __shfl_down(S, off); if (lane + off < 64) S += v; }
            int ab = S - hs; const bool cross = ab < TOPK && S >= TOPK;
            int Bl = 4 * lane + 3;
            if (ab + (int)hv.w < TOPK) { ab += (int)hv.w; Bl = 4 * lane + 2; if (ab + (int)hv.z < TOPK) { ab += (int)hv.z; Bl = 4 * lane + 1; if (ab + (int)hv.y < TOPK) { ab += (int)hv.y; Bl = 4 * lane; } } }
            const unsigned long long mc = __ballot(cross);
            const int src = mc ? (__ffsll((long long)mc) - 1) : 0;
            const unsigned Bb = (unsigned)__shfl(Bl, src);
            const unsigned kmin = Bb << 8; int m = 0;
#pragma unroll 1
            for (int j = 0; j < nch; ++j) {
                unsigned kk[8];
#pragma unroll
                for (int s = 0; s < 8; ++s) kk[s] = rb[512 * j + 64 * s];
#pragma unroll
                for (int s = 0; s < 8; ++s) {
                    const bool in = kk[s] >= kmin;
                    const unsigned long long mi = __ballot(in);
                    if (in) { const int ci = m + mbcnt64(mi); if (ci < TK_CAND) cl[ci] = (kk[s] << 16) | (unsigned)(512 * j + 64 * s + lane); }
                    m += __popcll(mi);
                }
            }
            asm volatile("s_waitcnt lgkmcnt(0)" ::: "memory");
            int pos = 0;
            if (mc != 0ull && m <= TK_CAND && m >= TOPK) {
                unsigned ent[8]; bool val[8];
#pragma unroll
                for (int q = 0; q < 8; ++q) { val[q] = 64 * q + lane < m; ent[q] = val[q] ? cl[64 * q + lane] : 0u; }
                int nab = 0;
#pragma unroll
                for (int q = 0; q < 8; ++q) nab += __popcll(__ballot(val[q] && (ent[q] >> 24) > Bb));
                const int need2 = TOPK - nab;
                unsigned thr2 = 0u;
#pragma unroll 1
                for (int bit = 7; bit >= 0; --bit) {
                    const unsigned cand = thr2 | (1u << bit); int cnt = 0;
#pragma unroll
                    for (int q = 0; q < 8; ++q) cnt += __popcll(__ballot(val[q] && (ent[q] >> 24) == Bb && ((ent[q] >> 16) & 0xffu) >= cand));
                    if (cnt >= need2) thr2 = cand;
                }
                const unsigned kthr = (Bb << 8) | thr2;
                int cgt2 = 0;
#pragma unroll
                for (int q = 0; q < 8; ++q) cgt2 += __popcll(__ballot(val[q] && (ent[q] >> 16) > kthr));
                const int need3 = TOPK - cgt2; int ties = 0;
#pragma unroll
                for (int q = 0; q < 8; ++q) {
                    const unsigned kx = ent[q] >> 16; const bool gt = val[q] && kx > kthr, eq = val[q] && kx == kthr;
                    const unsigned long long meq = __ballot(eq);
                    const bool sel = gt || (eq && (ties + mbcnt64(meq) < need3));
                    const unsigned long long msel = __ballot(sel);
                    if (sel) ol[pos + mbcnt64(msel)] = (unsigned short)(ent[q] & 0xffffu);
                    pos += __popcll(msel); ties += __popcll(meq);
                }
            } else {
                unsigned thr = 0u;
#pragma unroll 1
                for (int bit = 15; bit >= 0; --bit) {
                    const unsigned cand = thr | (1u << bit); int cnt = 0;
#pragma unroll 1
                    for (int i = 0; i < 8 * nch; ++i) cnt += __popcll(__ballot((unsigned)rb[64 * i] >= cand));
                    if (cnt >= TOPK) thr = cand;
                }
                int cgt = 0;
#pragma unroll 1
                for (int i = 0; i < 8 * nch; ++i) cgt += __popcll(__ballot((unsigned)rb[64 * i] > thr));
                const int need = TOPK - cgt; int ties = 0; pos = 0;
#pragma unroll 1
                for (int i = 0; i < 8 * nch; ++i) {
                    const unsigned kx = rb[64 * i]; const bool gt = kx > thr, eq = kx == thr;
                    const unsigned long long meq = __ballot(eq);
                    const bool sel = gt || (eq && (ties + mbcnt64(meq) < need));
                    const unsigned long long msel = __ballot(sel);
                    if (sel) ol[pos + mbcnt64(msel)] = (unsigned short)(64 * i + lane);
                    pos += __popcll(msel); ties += __popcll(meq);
                }
            }
            asm volatile("s_waitcnt lgkmcnt(0)" ::: "memory");
            *((v2u*)(SEL + (size_t)(R0 + ql) * TOPK) + lane) = *(const LAS v2u*)(ol + 4 * lane);
            asm volatile("s_waitcnt lgkmcnt(0)" ::: "memory");
        }
    }
    __syncthreads();
}

typedef short s16x4_t __attribute__((ext_vector_type(4)));
__device__ __forceinline__ s16x4_t tr_read(unsigned addr) { s16x4_t r_; asm volatile("ds_read_b64_tr_b16 %0, %1" : "=v"(r_) : "v"(addr) : "memory"); return r_; }
__device__ __forceinline__ void dma16(const void* src, LAS unsigned char* dst) { __builtin_amdgcn_global_load_lds((const unsigned*)src, (LAS unsigned*)dst, 16, 0, 0); }
constexpr int DSA_WAVE_BYTES = 19968, DSA_PL = 16384, DSA_SIDX = 18432, DSA_QS = 19456;
static_assert(8 * DSA_WAVE_BYTES <= XB_LDS_OFF, "DSA LDS map");

__device__ __forceinline__ void phase_dsa_fast(const Params& p, LAS unsigned char* lds, int G, int wv) {
    const int wave = wv, lane = lane_id();
    const int c16 = lane & 15, kq = lane >> 4;
    unsigned char* ws = p.ws;
    const unsigned char* AQ = ws + WS_AQ; bf16* OA = (bf16*)(ws + WS_OA);
    const unsigned char* SEL = ws + WS_SEL;
    LAS unsigned char* wl = lds + wave * DSA_WAVE_BYTES;
    LAS unsigned short* Pl = (LAS unsigned short*)(wl + DSA_PL); LAS unsigned short* sidx = (LAS unsigned short*)(wl + DSA_SIDX); LAS unsigned char* Qs = wl + DSA_QS;
    const unsigned ring_addr = (unsigned)(size_t)wl;
    const bool arow = (c16 & 3) == 0; const int ahead = c16 >> 2;
    if (!(G >= 8 && (G & 7) == 0)) return;
    const int nper = (G >> 3) * NWAVES, wi = (blockIdx.x >> 3) * NWAVES + wave, b = blockIdx.x & 7;
    const int nrows = (SEQ - wi + nper - 1) / nper, nsteps = 32 * nrows;
    const unsigned char* KVb = ws + WS_AK + (size_t)b * SEQ * 256;
    const int sw16 = ((lane & 7) ^ (lane >> 3)) * 16, r8 = lane >> 3;
#define DSA_ISSUE(n_) do { const int n__ = (n_); if (n__ < nsteps) { const int item_ = n__ >> 4, sub_ = n__ & 15, c_ = sub_ & 7, it_ = item_ >> 1; \
        const unsigned char* base_ = KVb + ((sub_ >> 3) ? (WS_AV - WS_AK) : 0) + (item_ & 1) * 128 + sw16; \
        const LAS unsigned short* sx_ = sidx + (it_ & 1) * 256 + 32 * c_ + r8; LAS unsigned char* dst_ = wl + (n__ & 3) * 4096; \
        _Pragma("unroll") for (int i_ = 0; i_ < 4; ++i_) { const unsigned key_ = (unsigned)sx_[8 * i_]; dma16(base_ + (size_t)key_ * 256, dst_ + i_ * 1024); } } } while (0)
#define DSA_WAIT(n_) do { if ((n_) + 3 < nsteps) asm volatile("s_waitcnt vmcnt(12)" ::: "memory"); else asm volatile("s_waitcnt vmcnt(0)" ::: "memory"); } while (0)
    if (nrows > 0) {
        if (lane < 32) { dma16(SEL + (size_t)(b * SEQ + wi) * 512 + lane * 16, (LAS unsigned char*)sidx); dma16(AQ + (size_t)(b * SEQ + wi) * 1024 + lane * 16, Qs); }
        asm volatile("s_waitcnt vmcnt(0)" ::: "memory");
        if (wi + 1 < TOPK) {
            const int cnt0 = wi + 1; LAS unsigned short* sp = sidx + 4 * lane;
#pragma unroll
            for (int q = 0; q < 4; ++q) if (4 * lane + q >= cnt0) sp[q] = 0;
            asm volatile("s_waitcnt lgkmcnt(0)" ::: "memory");
        }
        DSA_ISSUE(0); DSA_ISSUE(1); DSA_ISSUE(2);
    }
#pragma unroll 1
    for (int item = 0; item < 2 * nrows; ++item) {
        const int it = item >> 1, g = item & 1, t = wi + it * nper, row = b * SEQ + t;
        const int cnt = (t + 1 < TOPK) ? t + 1 : TOPK; const int n0 = 16 * item;
        float sc[16]; bf16x8_t aq[2];
#pragma unroll
        for (int c = 0; c < 8; ++c) {
            DSA_ISSUE(n0 + c + 3); DSA_WAIT(n0 + c);
            if (c == 0) {
#pragma unroll
                for (int c2 = 0; c2 < 2; ++c2) { aq[c2] = (bf16x8_t){0, 0, 0, 0, 0, 0, 0, 0}; if (arow) aq[c2] = *(const LAS bf16x8_t*)(Qs + ahead * 128 + 64 * c2 + 16 * kq); }
            }
            const LAS unsigned char* rb = wl + ((n0 + c) & 3) * 4096;
#pragma unroll
            for (int kt = 0; kt < 2; ++kt) {
                const int rr = 16 * kt + c16; const LAS unsigned char* rp = rb + rr * 128;
                const bf16x8_t k0 = *(const LAS bf16x8_t*)(rp + ((kq ^ (rr & 7)) << 4)), k1 = *(const LAS bf16x8_t*)(rp + (((4 + kq) ^ (rr & 7)) << 4));
                f32x4_t a = {0.f, 0.f, 0.f, 0.f};
                a = __builtin_amdgcn_mfma_f32_16x16x32_bf16(aq[0], k0, a, 0, 0, 0); a = __builtin_amdgcn_mfma_f32_16x16x32_bf16(aq[1], k1, a, 0, 0, 0);
                sc[2 * c + kt] = (32 * c + rr < cnt) ? a[0] : -INFINITY;
            }
        }
        float mx = sc[0];
#pragma unroll
        for (int i = 1; i < 16; ++i) mx = fmaxf(mx, sc[i]);
        mx = fmaxf(mx, __shfl_xor(mx, 1)); mx = fmaxf(mx, __shfl_xor(mx, 2)); mx = fmaxf(mx, __shfl_xor(mx, 4)); mx = fmaxf(mx, __shfl_xor(mx, 8));
        float sum = 0.f;
#pragma unroll
        for (int i = 0; i < 16; ++i) { sc[i] = fexp2(sc[i] - mx); sum += sc[i]; }
        sum += __shfl_xor(sum, 1); sum += __shfl_xor(sum, 2); sum += __shfl_xor(sum, 4); sum += __shfl_xor(sum, 8);
        const float inv = 1.0f / sum;
#pragma unroll
        for (int i = 0; i < 16; ++i) Pl[kq * 256 + 16 * i + c16] = (unsigned short)f2bf(sc[i]);
        f32x4_t o[4];
#pragma unroll
        for (int dt = 0; dt < 4; ++dt) o[dt] = (f32x4_t){0.f, 0.f, 0.f, 0.f};
#pragma unroll
        for (int c = 0; c < 8; ++c) {
            DSA_ISSUE(n0 + 8 + c + 3); DSA_WAIT(n0 + 8 + c);
            if (c == 0 && item + 1 < 2 * nrows) {
                if (lane < 32) { const int t2 = wi + ((item + 1) >> 1) * nper; dma16(AQ + (size_t)(b * SEQ + t2) * 1024 + ((item + 1) & 1) * 512 + lane * 16, Qs);
                    if (g == 1) dma16(SEL + (size_t)(b * SEQ + t2) * 512 + lane * 16, (LAS unsigned char*)(sidx + ((it + 1) & 1) * 256)); }
            }
            const unsigned rba = ring_addr + (unsigned)(((n0 + 8 + c) & 3) * 4096);
            bf16x8_t pa = (bf16x8_t){0, 0, 0, 0, 0, 0, 0, 0};
            if (arow) { const s16x4_t lo = *(const LAS s16x4_t*)(Pl + ahead * 256 + 32 * c + 4 * kq), hi = *(const LAS s16x4_t*)(Pl + ahead * 256 + 32 * c + 16 + 4 * kq);
                pa = (bf16x8_t){lo[0], lo[1], lo[2], lo[3], hi[0], hi[1], hi[2], hi[3]}; }
            const int r1 = 4 * kq + (c16 >> 2), pp = c16 & 3;
            s16x4_t vlo[4], vhi[4];
#pragma unroll
            for (int dt = 0; dt < 4; ++dt) { const unsigned off = (unsigned)(r1 * 128 + (((2 * dt + (pp >> 1)) ^ (r1 & 7)) << 4) + 8 * (pp & 1)); vlo[dt] = tr_read(rba + off); vhi[dt] = tr_read(rba + off + 16 * 128); }
            asm volatile("s_waitcnt lgkmcnt(0)" : "+v"(vlo[0]), "+v"(vlo[1]), "+v"(vlo[2]), "+v"(vlo[3]), "+v"(vhi[0]), "+v"(vhi[1]), "+v"(vhi[2]), "+v"(vhi[3]) :: "memory");
            __builtin_amdgcn_sched_barrier(0);
#pragma unroll
            for (int dt = 0; dt < 4; ++dt) { const bf16x8_t vb = (bf16x8_t){vlo[dt][0], vlo[dt][1], vlo[dt][2], vlo[dt][3], vhi[dt][0], vhi[dt][1], vhi[dt][2], vhi[dt][3]};
                o[dt] = __builtin_amdgcn_mfma_f32_16x16x32_bf16(pa, vb, o[dt], 0, 0, 0); }
        }
        bf16* op = OA + (size_t)row * 512 + (4 * g + kq) * 64 + c16;
#pragma unroll
        for (int dt = 0; dt < 4; ++dt) op[16 * dt] = (bf16)f2bf(o[dt][0] * inv);
    }
    asm volatile("s_waitcnt vmcnt(0)" ::: "memory");
#undef DSA_ISSUE
#undef DSA_WAIT
}

typedef float f32x2_t __attribute__((ext_vector_type(2))); typedef __bf16 bf16x2v_t __attribute__((ext_vector_type(2)));
__device__ __forceinline__ unsigned cvtpk_s(float lo, float hi) { f32x2_t v = {lo, hi}; bf16x2v_t b = __builtin_convertvector(v, bf16x2v_t); return __builtin_bit_cast(unsigned, b); }
__device__ __forceinline__ int crow16(int reg, int h) { return (reg & 3) + 8 * (reg >> 2) + 4 * h; }

__device__ __forceinline__ void phase_swa_fast(const Params& p, int G, int wv) {
    const int wave = wv, lane = lane_id(), tid = wave * 64 + lane;
    const int r = lane & 31, h = lane >> 5, hh = wave >> 1, qh = wave & 1;
    unsigned char* ws = p.ws;
    const bf16* BQ = (const bf16*)(ws + WS_BQ); const bf16* BK = (const bf16*)(ws + WS_BK); const bf16* BV = (const bf16*)(ws + WS_BV); bf16* OB = (bf16*)(ws + WS_OB);
    for (int k = 0;; ++k) {
        int b, idx;
        if (G >= 8 && (G & 7) == 0) { idx = (blockIdx.x >> 3) + (G >> 3) * k; if (idx >= 64) break; b = blockIdx.x & 7; }
        else { const int u = blockIdx.x + k * G; if (u >= 512) break; b = u >> 6; idx = u & 63; }
        const int qb = idx >> 1, g = idx & 1, head = 4 * g + hh;
        const float sink = p.sinks[head] * LOG2E;
        const bf16* Kb = BK + (size_t)b * SEQ * 128 + g * 64 + 8 * h; const bf16* Vb = BV + (size_t)b * SEQ * 128 + g * 64 + r;
#pragma unroll 1
        for (int qt = 0; qt < 2; ++qt) {
            const int q0 = 128 * qb + 64 * qh + 32 * qt;
            const size_t qrow = (size_t)b * SEQ + q0 + r;
            bf16x8_t qf[4];
#pragma unroll
            for (int s = 0; s < 4; ++s) qf[s] = *(const bf16x8_t*)(BQ + qrow * 512 + head * 64 + 16 * s + 8 * h);
            f32x16_t S[5];
#pragma unroll
            for (int kt = 0; kt < 5; ++kt) {
                const int kb0 = q0 - 128 + 32 * kt; const int krow_ = kb0 + r; const int kc = krow_ < 0 ? 0 : krow_;
                bf16x8_t kf[4];
#pragma unroll
                for (int s = 0; s < 4; ++s) kf[s] = *(const bf16x8_t*)(Kb + (size_t)kc * 128 + 16 * s);
                f32x16_t a = {0.f, 0.f, 0.f, 0.f, 0.f, 0.f, 0.f, 0.f, 0.f, 0.f, 0.f, 0.f, 0.f, 0.f, 0.f, 0.f};
#pragma unroll
                for (int s = 0; s < 4; ++s) a = __builtin_amdgcn_mfma_f32_32x32x16_bf16(kf[s], qf[s], a, 0, 0, 0);
#pragma unroll
                for (int i = 0; i < 16; ++i) { const int key = kb0 + crow16(i, h); const int rel = q0 + r - key; S[kt][i] = (key >= 0 && rel >= 0 && rel < WIN) ? a[i] : -INFINITY; }
            }
            float mx = sink;
#pragma unroll
            for (int kt = 0; kt < 5; ++kt)
#pragma unroll
                for (int i = 0; i < 16; ++i) mx = fmaxf(mx, S[kt][i]);
            mx = fmaxf(mx, __shfl_xor(mx, 32));
            float l = 0.f;
#pragma unroll
            for (int kt = 0; kt < 5; ++kt)
#pragma unroll
                for (int i = 0; i < 16; ++i) { S[kt][i] = fexp2(S[kt][i] - mx); l += S[kt][i]; }
            l += __shfl_xor(l, 32); l += fexp2(sink - mx);
            const float linv = 1.0f / l;
            f32x16_t O0 = {0.f, 0.f, 0.f, 0.f, 0.f, 0.f, 0.f, 0.f, 0.f, 0.f, 0.f, 0.f, 0.f, 0.f, 0.f, 0.f}, O1 = O0;
#pragma unroll
            for (int kt = 0; kt < 5; ++kt) {
                const int kb0 = q0 - 128 + 32 * kt;
#pragma unroll
                for (int s = 0; s < 2; ++s) {
                    v4u pw; pw.x = cvtpk_s(S[kt][8 * s + 0], S[kt][8 * s + 1]); pw.y = cvtpk_s(S[kt][8 * s + 2], S[kt][8 * s + 3]); pw.z = cvtpk_s(S[kt][8 * s + 4], S[kt][8 * s + 5]); pw.w = cvtpk_s(S[kt][8 * s + 6], S[kt][8 * s + 7]);
                    const bf16x8_t pa = __builtin_bit_cast(bf16x8_t, pw);
                    unsigned short v0[8], v1[8];
#pragma unroll
                    for (int j = 0; j < 8; ++j) { int key = kb0 + 16 * s + 8 * (j >> 2) + 4 * h + (j & 3); key = key < 0 ? 0 : key; v0[j] = Vb[(size_t)key * 128]; v1[j] = Vb[(size_t)key * 128 + 32]; }
                    const bf16x8_t vb0 = (bf16x8_t){(short)v0[0], (short)v0[1], (short)v0[2], (short)v0[3], (short)v0[4], (short)v0[5], (short)v0[6], (short)v0[7]};
                    const bf16x8_t vb1 = (bf16x8_t){(short)v1[0], (short)v1[1], (short)v1[2], (short)v1[3], (short)v1[4], (short)v1[5], (short)v1[6], (short)v1[7]};
                    O0 = __builtin_amdgcn_mfma_f32_32x32x16_bf16(pa, vb0, O0, 0, 0, 0); O1 = __builtin_amdgcn_mfma_f32_32x32x16_bf16(pa, vb1, O1, 0, 0, 0);
                }
            }
            bf16* op = OB + ((size_t)b * SEQ + q0) * 512 + head * 64 + r;
#pragma unroll
            for (int i = 0; i < 16; ++i) { const int qq = crow16(i, h); const float li = __shfl(linv, qq); op[(size_t)qq * 512] = (bf16)f2bf(O0[i] * li); op[(size_t)qq * 512 + 32] = (bf16)f2bf(O1[i] * li); }
        }
    }
}

#define XB_TMO      128
#define XB_XCNT(j)  (256  + 64 * (j))
#define XB_XSUB(j)  (1280 + 64 * (j))
#define XB_XGEN(j)  (2304 + 64 * (j))
#define XB_TOP      3328
#define XB_TOPGEN   3392
#define XCD_BAR_WORDS 3456
#define XB_SPIN_CAP (1u << 18)

__device__ __forceinline__ unsigned xb_ld(unsigned* p)              { return __hip_atomic_load(p, __ATOMIC_RELAXED, __HIP_MEMORY_SCOPE_AGENT); }
__device__ __forceinline__ unsigned xb_add(unsigned* p, unsigned v) { return __hip_atomic_fetch_add(p, v, __ATOMIC_RELAXED, __HIP_MEMORY_SCOPE_AGENT); }
__device__ __forceinline__ unsigned xb_xcc_id() { return (unsigned)__builtin_amdgcn_s_getreg((3 << 11) | 20) & 0xFu; }
#define XB_SPIN(cond, bar) do { unsigned _sp = 0; while (cond) { __builtin_amdgcn_s_sleep(1); \
    if ((++_sp & 255u) == 0u) { if (xb_ld(&(bar)[XB_TMO])) break; if (_sp > XB_SPIN_CAP) { atomicAdd(&(bar)[XB_TMO], 1u); break; } } } } while (0)

struct XcdBarrier {
    unsigned* bar; unsigned x;
    volatile LAS unsigned* st;
};

__device__ __forceinline__ XcdBarrier xcd_barrier_post(unsigned* bar, volatile LAS unsigned* st) {
    XcdBarrier b; b.bar = bar; b.x = xb_xcc_id(); b.st = st;
    if (threadIdx.x == 0) (void)xb_add(&bar[XB_XCNT(b.x)], 1u);
    return b;
}
__device__ __forceinline__ void xcd_barrier_complete(unsigned* bar, unsigned x, unsigned& nloc, unsigned& nx) {
    const unsigned G = gridDim.x * gridDim.y * gridDim.z;
    unsigned sum, cnt, mine, sp = 0u;
    for (;;) {
        sum = 0u; cnt = 0u; mine = 0u;
#pragma unroll
        for (unsigned j = 0; j < 16; ++j) { const unsigned c = xb_ld(&bar[XB_XCNT(j)]); sum += c; cnt += (c > 0u) ? 1u : 0u; mine = (j == x) ? c : mine; }
        if (sum == G) break;
        __builtin_amdgcn_s_sleep(1);
        if ((++sp & 255u) == 0u) { if (xb_ld(&bar[XB_TMO])) break; if (sp > XB_SPIN_CAP) { atomicAdd(&bar[XB_TMO], 1u); break; } }
    }
    nloc = mine > 0u ? mine : 1u; nx = cnt > 0u ? cnt : 1u;
}

__device__ __forceinline__ void xcd_barrier(const XcdBarrier& b, int wv) {
    asm volatile("s_waitcnt vmcnt(0)" ::: "memory");
    __syncthreads();
    if (wv == 0 && lane_id() == 0) {
        unsigned* bar = b.bar;
        __builtin_amdgcn_s_waitcnt(0);
        unsigned nloc = b.st[0], nx = b.st[1];
        if (nloc == 0u) { xcd_barrier_complete(bar, b.x, nloc, nx); b.st[0] = nloc; b.st[1] = nx; }
        const unsigned old = xb_add(&bar[XB_XSUB(b.x)], 1u);
        const unsigned gen = old / nloc;
        if (old + 1u == (gen + 1u) * nloc) {
            __builtin_amdgcn_fence(__ATOMIC_RELEASE, "agent");
            asm volatile("s_waitcnt vmcnt(0)" ::: "memory");
            const unsigned og = xb_add(&bar[XB_TOP], 1u);
            const unsigned tg = og / nx;
            if (og + 1u == (tg + 1u) * nx) xb_add(&bar[XB_TOPGEN], 1u);
            else XB_SPIN(xb_ld(&bar[XB_TOPGEN]) == tg, bar);
            __builtin_amdgcn_fence(__ATOMIC_ACQUIRE, "agent");
            xb_add(&bar[XB_XGEN(b.x)], 1u);
            asm volatile("s_waitcnt vmcnt(0)" ::: "memory");
        } else {
            XB_SPIN(xb_ld(&bar[XB_XGEN(b.x)]) == gen, bar);
            __builtin_amdgcn_fence(__ATOMIC_ACQUIRE, "agent");
            asm volatile("s_waitcnt vmcnt(0)" ::: "memory");
        }
    }
    __syncthreads();
}

constexpr int NPHASE = 9;
__global__ void __launch_bounds__(NTHREADS, 2) mk_fwd(Params p) {
    extern __shared__ __attribute__((aligned(16))) unsigned char lds_raw[];
    LAS unsigned char* lds = (LAS unsigned char*)lds_raw;
    const int G = gridDim.x, wv = __builtin_amdgcn_readfirstlane(threadIdx.x >> 6);
    unsigned char* ws = p.ws;
#if MK_ONE_LAUNCH
#define SEAM(k) do { if (rep_ + 1 < REPS(k)) __syncthreads(); else if (lo <= (k) && (k) + 1 < hi) { xcd_barrier(xbar, wv); } } while (0)
#else
#define SEAM(k) do { if (rep_ + 1 < REPS(k)) __syncthreads(); } while (0)
#endif
    const int lo = p.ph_lo, hi = p.ph_hi;
#if MK_ONE_LAUNCH
    if (threadIdx.x == 0) { ((volatile LAS unsigned*)(lds + XB_LDS_OFF))[0] = 0u; ((volatile LAS unsigned*)(lds + XB_LDS_OFF))[1] = 0u; }
    const XcdBarrier xbar = xcd_barrier_post((unsigned*)(ws + WS_BAR), (volatile LAS unsigned*)(lds + XB_LDS_OFF));
#endif
#ifdef PROBE_TS
    unsigned long long* TS = (unsigned long long*)(ws + WS_RSTD1 + 384 * 1024);
#define STAMP(k) do { if (blockIdx.x == 0) TS[k] = __builtin_amdgcn_s_memrealtime(); } while (0)
#else
#define STAMP(k) do { } while (0)
#endif
#if MK_ONE_LAUNCH
    if (p.ph_hi > 1000) cg::this_grid().sync();
#endif
    STAMP(0);
#ifndef PHMASK
#define PHMASK 0x1ffu
#endif
#define IN(k) (((PHMASK >> (k)) & 1u) && lo <= (k) && (k) < hi)
#define REPS(k) (((REP_MASK >> (k)) & 1u) ? 2 : 1)
#define PHASE(k) if (IN(k)) for (int rep_ = 0; rep_ < REPS(k); ++rep_)
    PHASE(0) { phase_prologue(p, lds, G, wv); SEAM(0); STAMP(0 + 1); }
    PHASE(1) {
        pg8::Gemm g{(const bf16*)(ws + WS_XG), (const bf16*)(ws + WS_WIN), TOK, NIN, DM, nullptr, 1 << 30};
        pg8::StaticOrder S; S.init(TOK, NIN, G, (int)blockIdx.x);
        pg8::EpiInProj E{(const float*)(ws + WS_RSTD1), (const float*)(ws + WS_COS), (const float*)(ws + WS_SIN), ws, p.ikw, p.ikb};
        pg8::gemm_phase<pg8::EpiInProj, pg8::StaticOrder, true, true>(lds, g, S, E, wv);
#ifdef PROBE_INPROJ2
#if PROBE_INPROJ2 == 1
        __syncthreads(); pg8::gemm_phase<pg8::EpiInProj, pg8::StaticOrder, true, true>(lds, g, S, E, wv);
#else
        __syncthreads(); { pg8::EpiDummy E2{(bf16*)(ws + 440 * MiB), NIN}; pg8::gemm_phase<pg8::EpiDummy, pg8::StaticOrder, true, true>(lds, g, S, E2, wv); }
#endif
#endif
        SEAM(1); STAMP(1 + 1);
    }
#if MK_SIMPLE_TOPK
    PHASE(2) { phase_topk_simple(p, lds, G, wv); SEAM(2); STAMP(2 + 1); }
#else
    PHASE(2) { phase_topk_fast(p, lds, G, wv); SEAM(2); STAMP(2 + 1); }
#endif
#if MK_SIMPLE_DSA
    PHASE(3) { phase_attn_simple<true, true>(p, lds, G, wv); SEAM(3); STAMP(3 + 1); }
#else
#if MK_SIMPLE_SWA
    PHASE(3) { phase_dsa_fast(p, lds, G, wv); __syncthreads(); phase_attn_simple<false, true>(p, lds, G, wv); SEAM(3); STAMP(3 + 1); }
#else
#ifndef REP_SWA
#define REP_SWA 1
#endif
#ifndef REP_DSA
#define REP_DSA 1
#endif
    PHASE(3) { for (int q_ = 0; q_ < REP_SWA; ++q_) phase_swa_fast(p, G, wv); for (int q_ = 0; q_ < REP_DSA; ++q_) phase_dsa_fast(p, lds, G, wv); SEAM(3); STAMP(3 + 1); }
#endif
#endif
    PHASE(4) {
        pg8::Gemm g{(const bf16*)(ws + WS_OA), (const bf16*)(ws + WS_WAB), TOK, 2048, 512, (const bf16*)(ws + WS_OB), 4};
        pg8::BranchOrder S{G, (int)blockIdx.x};
        pg8::EpiGate E{(const bf16*)(ws + WS_GA), (const bf16*)(ws + WS_GB), p.out, (bf16*)(ws + WS_MIX)};
        pg8::gemm_phase<pg8::EpiGate, pg8::BranchOrder, true, true>(lds, g, S, E, wv);
        SEAM(4); STAMP(4 + 1);
    }
    PHASE(5) {
        pg8::Gemm g{(const bf16*)(ws + WS_MIX), (const bf16*)(ws + WS_WOUT), TOK, DM, DM, nullptr, 1 << 30};
        pg8::StaticOrder S; S.init(TOK, DM, G, (int)blockIdx.x);
        pg8::EpiResid<true> E{p.x, p.out, (bf16*)(ws + WS_XG), p.mlp_norm_w, (float*)(ws + (rep_ + 1 < REPS(5) ? WS_PROBE_SS : WS_SS2))};
        pg8::gemm_phase<pg8::EpiResid<true>, pg8::StaticOrder, true, true>(lds, g, S, E, wv);
        SEAM(5); STAMP(5 + 1);
    }
    PHASE(6) {
        pg8::Gemm g{(const bf16*)(ws + WS_XG), (const bf16*)(ws + WS_WUP), TOK, DFF, DM, nullptr, 1 << 30};
        pg8::StaticOrder S; S.init(TOK, DFF, G, (int)blockIdx.x);
        pg8::EpiUp E{(const float*)(ws + WS_SS2), (bf16*)(ws + WS_HID)};
        pg8::gemm_phase<pg8::EpiUp, pg8::StaticOrder, true, true>(lds, g, S, E, wv);
        SEAM(6); STAMP(6 + 1);
    }
    PHASE(7) {
        pg8::Gemm g{(const bf16*)(ws + WS_HID), (const bf16*)(ws + WS_WDN), TOK, DM, DFF, nullptr, 1 << 30};
        pg8::StaticOrder S; S.init(TOK, DM, G, (int)blockIdx.x);
        pg8::EpiResid<false> E{p.out, (rep_ + 1 < REPS(7)) ? (float*)(ws + WS_PROBE_OUT) : p.out, nullptr, nullptr, (float*)(ws + (rep_ + 1 < REPS(7) ? WS_PROBE_SS : WS_SS3))};
        pg8::gemm_phase<pg8::EpiResid<false>, pg8::StaticOrder, true, true>(lds, g, S, E, wv);
        SEAM(7); STAMP(7 + 1);
    }
#ifdef EXTRA_SYNCS
#if MK_ONE_LAUNCH
    for (int es_ = 0; es_ < EXTRA_SYNCS; ++es_) xcd_barrier(xbar, wv);
#endif
#endif
    PHASE(8) { phase_final(p, G, wv, (rep_ + 1 < REPS(8)) ? (float*)(ws + WS_PROBE_OUT) : p.out); }
#undef PHASE
#undef REPS
#undef IN
#undef SEAM
}

extern "C" void kernel_launch(void* const* d_in, const int* in_sizes, int n_in, void* d_out, int out_size, void* d_ws, size_t ws_size, hipStream_t stream) {
    static int grid = 0;
    if (grid == 0) {
        if (n_in != 13 || in_sizes[0] != TOK * DM || out_size != TOK * DM || ws_size < WS_NEED) {
            fprintf(stderr, "kernel_launch: unexpected shapes (n_in %d, in0 %d, out %d, ws %zu); nothing launched\n", n_in, n_in > 0 ? in_sizes[0] : -1, out_size, ws_size); grid = -1; return; }
        int dev = 0, cus = 0, per_cu = 0;
        (void)hipGetDevice(&dev); (void)hipDeviceGetAttribute(&cus, hipDeviceAttributeMultiprocessorCount, dev);
        if (hipFuncSetAttribute((const void*)mk_fwd, hipFuncAttributeMaxDynamicSharedMemorySize, LDS_BYTES) != hipSuccess) { fprintf(stderr, "kernel_launch: hipFuncSetAttribute failed\n"); grid = -1; return; }
        if (hipOccupancyMaxActiveBlocksPerMultiprocessor(&per_cu, (const void*)mk_fwd, NTHREADS, LDS_BYTES) != hipSuccess || per_cu < 1) { fprintf(stderr, "kernel_launch: occupancy query says %d blocks per CU\n", per_cu); per_cu = 1; }
        (void)hipGetLastError();
        if (per_cu > 1) per_cu = 1;
        grid = cus * per_cu;
    }
    if (grid < 0) return;
    Params p{};
    p.x = (const float*)d_in[0]; p.attn_norm_w = (const float*)d_in[1]; p.w_in = (const float*)d_in[2]; p.ikw = (const float*)d_in[3]; p.ikb = (const float*)d_in[4];
    p.sinks = (const float*)d_in[5]; p.w_a = (const float*)d_in[6]; p.w_b = (const float*)d_in[7]; p.w_out = (const float*)d_in[8]; p.mlp_norm_w = (const float*)d_in[9];
    p.w_up = (const float*)d_in[10]; p.w_down = (const float*)d_in[11]; p.final_w = (const float*)d_in[12];
    p.out = (float*)d_out; p.ws = (unsigned char*)d_ws;
    for (int i = 0; i < 32; ++i) p.inv_freq[i] = 1.0f / powf(10000.0f, (float)(2 * i) / 64.0f);
#if MK_ONE_LAUNCH
    if (hipMemsetAsync((char*)d_ws + WS_BAR, 0, 16384, stream) != hipSuccess) { fprintf(stderr, "kernel_launch: hipMemsetAsync of the barrier words failed\n"); return; }
    p.ph_lo = 0; p.ph_hi = NPHASE;
    void* args[] = {&p};
    hipError_t e = hipLaunchCooperativeKernel((const void*)mk_fwd, dim3(grid), dim3(NTHREADS), args, LDS_BYTES, stream);
    if (e != hipSuccess) fprintf(stderr, "kernel_launch: cooperative launch failed: %s (grid %d)\n", hipGetErrorString(e), grid);
#else
    for (int ph = 0; ph < NPHASE; ++ph) {
        p.ph_lo = ph; p.ph_hi = ph + 1;
        hipLaunchKernelGGL(mk_fwd, dim3(grid), dim3(NTHREADS), LDS_BYTES, stream, p);
    }
#endif
}
```

```cpp
#include <hip/hip_runtime.h>
#include <hip/hip_cooperative_groups.h>
#include <cstdio>
#include <cstdint>
namespace cg = cooperative_groups;

#ifndef MK_ONE_LAUNCH
#define MK_ONE_LAUNCH 1
#endif
#ifndef MK_SIMPLE_TOPK
#define MK_SIMPLE_TOPK 0
#endif
#ifndef MK_SIMPLE_SWA
#define MK_SIMPLE_SWA 0
#endif
#ifndef MK_SIMPLE_DSA
#define MK_SIMPLE_DSA 0
#endif

constexpr int NBATCH = 8, SEQ = 4096, DM = 1024, TOK = NBATCH * SEQ, DFF = 4096, TOPK = 256, WIN = 128;
constexpr int NIN = 4352;
constexpr float RMS_EPS = 1e-6f, LN_EPS = 1e-6f;
constexpr float QSCALE = 0.125f * 1.4426950408889634f;
constexpr float LOG2E = 1.4426950408889634f;
constexpr float W_SCALE = 0.04419417382415922f;
constexpr int C_AQ = 0, C_AK = 512, C_AV = 640, C_IQ = 768, C_IK = 1280, C_IW = 1344, C_BQ = 1352, C_BK = 1864, C_BV = 1992, C_GA = 2120, C_GB = 3144, D_IN = 4168;

constexpr size_t MiB = 1u << 20;
constexpr size_t WS_RSTD1 = 0, WS_SS2 = 128 * 1024, WS_SS3 = 256 * 1024;
constexpr size_t WS_BAR = 512 * 1024;
constexpr int XB_LDS_OFF = 163832;
constexpr size_t WS_COS = 1 * MiB, WS_SIN = 1 * MiB + 512 * 1024;
constexpr size_t WS_WIN = 2 * MiB, WS_WAB = 11 * MiB, WS_WOUT = 13 * MiB, WS_WUP = 15 * MiB, WS_WDN = 23 * MiB;
constexpr size_t WS_XG = 32 * MiB;
constexpr size_t WS_AQ = 96 * MiB, WS_IQ = 128 * MiB, WS_BQ = 160 * MiB, WS_AK = 192 * MiB, WS_AV = 200 * MiB, WS_BK = 208 * MiB, WS_BV = 216 * MiB;
constexpr size_t WS_IK = 224 * MiB, WS_IW = 228 * MiB, WS_SEL = 230 * MiB, WS_GA = 248 * MiB, WS_GB = 312 * MiB, WS_MIX = 376 * MiB, WS_END = 440 * MiB;
#ifndef MK_SEPARATE_O
#define MK_SEPARATE_O 0
#endif
#ifndef REP_MASK
#define REP_MASK 0u
#endif
constexpr size_t WS_OAB = 440 * MiB, WS_NEED = 504 * MiB;
constexpr size_t WS_PROBE_SS = 640 * 1024, WS_PROBE_OUT = 376 * MiB;
constexpr size_t WS_HID = 96 * MiB;
static_assert(WS_WIN + (size_t)NIN * DM * 2 <= WS_WAB && WS_HID + (size_t)TOK * DFF * 2 <= WS_MIX, "ws map");

constexpr int LDS_RING = 131072, LDS_BYTES = 163840;

#define GAS __attribute__((address_space(1)))
#define LAS __attribute__((address_space(3)))
typedef unsigned short bf16;
typedef unsigned v4u __attribute__((ext_vector_type(4)));
typedef unsigned v2u __attribute__((ext_vector_type(2)));
typedef float v4f __attribute__((ext_vector_type(4)));

__device__ __forceinline__ float bf2f(unsigned short u) { return __uint_as_float((unsigned)u << 16); }
__device__ __forceinline__ float bflo(unsigned u) { return __uint_as_float(u << 16); }
__device__ __forceinline__ float bfhi(unsigned u) { return __uint_as_float(u & 0xffff0000u); }
__device__ __forceinline__ unsigned f2bf(float f) { unsigned u = __float_as_uint(f); return (u + 0x7fffu + ((u >> 16) & 1u)) >> 16; }
__device__ __forceinline__ unsigned pk2(float lo, float hi) { unsigned r; asm volatile("v_cvt_pk_bf16_f32 %0, %1, %2" : "=v"(r) : "v"(lo), "v"(hi)); return r; }
__device__ __forceinline__ float fexp2(float x) { return __builtin_amdgcn_exp2f(x); }
__device__ __forceinline__ float frsq(float x) { return __builtin_amdgcn_rsqf(x); }
__device__ __forceinline__ float frcp(float x) { return __builtin_amdgcn_rcpf(x); }
__device__ __forceinline__ float sigmoidf_(float x) { return frcp(1.0f + fexp2(-x * LOG2E)); }
__device__ __forceinline__ float wave_sum(float v) {
#pragma unroll
    for (int o = 1; o < 64; o <<= 1) v += __shfl_xor(v, o);
    return v;
}
__device__ __forceinline__ float wave_max(float v) {
#pragma unroll
    for (int o = 1; o < 64; o <<= 1) v = fmaxf(v, __shfl_xor(v, o));
    return v;
}
__device__ __forceinline__ int lane_id() { unsigned m = ~0u; asm volatile("" : "+s"(m)); return __builtin_amdgcn_mbcnt_hi(m, __builtin_amdgcn_mbcnt_lo(m, 0u)); }
__device__ __forceinline__ int tid_op(int wv) { return wv * 64 + lane_id(); }
__device__ __forceinline__ int mbcnt64(unsigned long long m) { return __builtin_amdgcn_mbcnt_hi((unsigned)(m >> 32), __builtin_amdgcn_mbcnt_lo((unsigned)m, 0u)); }

namespace pg8 {
#define PG8_LAS __attribute__((address_space(3)))
typedef unsigned short bf16_t;
typedef short bf16x8 __attribute__((ext_vector_type(8)));
typedef float f32x4 __attribute__((ext_vector_type(4)));
typedef unsigned u32x4 __attribute__((ext_vector_type(4)));
constexpr int BM = 256, BK = 64, HALF = 128, HTB = HALF * BK * 2  , STAGE_BYTES = 8 * HTB, NXCD = 8, WGM = 8;

__host__ __device__ __forceinline__ int lds_byte(int r, int c) { const int st = (r >> 4) * 2 + (c >> 5), rr = r & 15, cc = c & 31, ob = rr * 64 + cc * 2; return st * 1024 + (ob ^ (((ob >> 9) & 1) << 5)); }
__host__ __device__ __forceinline__ void stage_rc(int b, int& R, int& C) { const int st = b / 1024, sb = b % 1024, swz = sb ^ (((sb >> 9) & 1) << 5); R = (st >> 1) * 16 + swz / 64; C = (st & 1) * 32 + (swz % 64) / 2; }
__host__ __device__ __forceinline__ int perm32(int rho) { const int n = rho >> 4, i = rho & 15; return 8 * (i >> 2) + 4 * n + (i & 3); }

struct Unit { int pm, pn; };
struct Gemm { const bf16_t* A; const bf16_t* Bt; int M, N, K; const bf16_t* A2; int asplit;
    __device__ __forceinline__ const char* abase(const Unit& u) const { return (const char*)(u.pn >= asplit ? A2 : A); } };

struct StaticOrder {
    int nM, nN, nwg, G, c;
    __host__ __device__ void init(int M, int N, int G_, int c_) { nM = M / BM; nN = N / BM; nwg = nM * nN; G = G_; c = c_; }
    __host__ __device__ bool next(int i, Unit& u) const {
        const long L = (long)i * G + c; if (L >= nwg) return false;
        int wgid = (int)L; { const int q = nwg / NXCD, r = nwg % NXCD, xcd = wgid % NXCD, off = wgid / NXCD; wgid = (xcd < r ? xcd * (q + 1) : r * (q + 1) + (xcd - r) * q) + off; }
        const int nig = WGM * nN, gid = wgid / nig, fm = gid * WGM, gsz = (nM - fm) < WGM ? (nM - fm) : WGM;
        u.pm = fm + ((wgid % nig) % gsz); u.pn = (wgid % nig) / gsz; return true;
    }
    __device__ __forceinline__ void a_ready(const Unit&) const {}
    __device__ __forceinline__ void done(const Unit&) const {}
};

__device__ __forceinline__ unsigned cvt_pk_bf16(float lo, float hi) { unsigned r; asm volatile("v_cvt_pk_bf16_f32 %0, %1, %2" : "=v"(r) : "v"(lo), "v"(hi)); return r; }
__device__ __forceinline__ u32x4 pack8(const float (&v)[8]) { u32x4 w; w.x = cvt_pk_bf16(v[0], v[1]); w.y = cvt_pk_bf16(v[2], v[3]); w.z = cvt_pk_bf16(v[4], v[5]); w.w = cvt_pk_bf16(v[6], v[7]); return w; }

struct EpiInProj {
    static constexpr bool PERM = true, AFTER_DRAIN = false, MID = false;
    const float* rstd1; const float* cs; const float* sn; unsigned char* ws; const float* ikw; const float* ikb;
    __device__ __forceinline__ void operator()(const f32x4 (&acc)[2][2][4][2], const Unit& u, int wr, int wc, int fr_, int fq_) const {
        const int pn = u.pn; int fr = fr_, fq = fq_;
        asm volatile("" : "+v"(fr), "+v"(fq));
#pragma unroll
        for (int ai = 0; ai < 2; ++ai)
#pragma unroll
            for (int m = 0; m < 4; ++m) {
                const int row = u.pm * BM + ai * HALF + wr * 64 + m * 16 + fr;
                const float rs = rstd1[row];
                float x1[8], x2[8];
#pragma unroll
                for (int j = 0; j < 4; ++j) { x1[j] = acc[ai][0][m][0][j] * rs; x1[4 + j] = acc[ai][0][m][1][j] * rs; x2[j] = acc[ai][1][m][0][j] * rs; x2[4 + j] = acc[ai][1][m][1][j] * rs; }
                if (pn >= 9) {
                    bf16_t* G = (bf16_t*)(ws + WS_GA + (size_t)((pn - 9) >> 2) * (WS_GB - WS_GA)) + (size_t)row * 1024 + 256 * ((pn - 9) & 3) + 32 * wc + 8 * fq;
                    float a[8], b[8];
#pragma unroll
                    for (int j = 0; j < 8; ++j) { a[j] = 1.0f / (1.0f + __builtin_amdgcn_exp2f(-x1[j] * 1.4426950408889634f)); b[j] = 1.0f / (1.0f + __builtin_amdgcn_exp2f(-x2[j] * 1.4426950408889634f)); }
                    *(u32x4*)G = pack8(a); *(u32x4*)(G + 128) = pack8(b);
                } else if (pn == 8) {
                    if (wc == 0) {
                        float s = 0.f;
#pragma unroll
                        for (int j = 0; j < 8; ++j) s += x1[j] + x2[j];
                        s += __shfl_xor(s, 16); s += __shfl_xor(s, 32);
                        const float mu = s * (1.0f / 64.0f); float q = 0.f;
#pragma unroll
                        for (int j = 0; j < 8; ++j) { x1[j] -= mu; x2[j] -= mu; q += x1[j] * x1[j] + x2[j] * x2[j]; }
                        q += __shfl_xor(q, 16); q += __shfl_xor(q, 32);
                        const float rstd = __builtin_amdgcn_rsqf(q * (1.0f / 64.0f) + 1e-6f);
                        const int pos = row & 4095; const float* cp = cs + pos * 32 + 8 * fq; const float* sp = sn + pos * 32 + 8 * fq;
                        float o1[8], o2[8];
#pragma unroll
                        for (int j = 0; j < 8; ++j) { const float y1 = x1[j] * rstd * ikw[8 * fq + j] + ikb[8 * fq + j], y2 = x2[j] * rstd * ikw[32 + 8 * fq + j] + ikb[32 + 8 * fq + j];
                            const float c = cp[j], sI = sp[j]; o1[j] = y1 * c - y2 * sI; o2[j] = y2 * c + y1 * sI; }
                        unsigned char* tb = ws + WS_IK + (size_t)(row >> 5) * 4096 + (size_t)(row & 31) * 16;
                        *(u32x4*)(tb + (fq >> 1) * 1024 + (fq & 1) * 512) = pack8(o1); *(u32x4*)(tb + (2 + (fq >> 1)) * 1024 + (fq & 1) * 512) = pack8(o2);
                    } else if (wc == 1 && fq == 0) {
                        float* dst = (float*)(ws + WS_IW) + (size_t)row * 8;
                        *(f32x4*)dst = (f32x4){x1[0], x1[1], x1[2], x1[3]} * 0.04419417382415922f; *(f32x4*)(dst + 4) = (f32x4){x1[4], x1[5], x1[6], x1[7]} * 0.04419417382415922f;
                    }
                } else if (pn >= 6) {
                    bf16_t* Kd = (bf16_t*)(ws + WS_AK + (size_t)(pn - 6) * (WS_BK - WS_AK)); bf16_t* Vd = (bf16_t*)(ws + WS_AV + (size_t)(pn - 6) * (WS_BV - WS_AV));
                    if (wc < 2) {
                        const int pos = row & 4095; const float* cp = cs + pos * 32 + 8 * fq; const float* sp = sn + pos * 32 + 8 * fq;
                        float o1[8], o2[8];
#pragma unroll
                        for (int j = 0; j < 8; ++j) { const float c = cp[j], sI = sp[j]; o1[j] = x1[j] * c - x2[j] * sI; o2[j] = x2[j] * c + x1[j] * sI; }
                        bf16_t* dst = Kd + (size_t)row * 128 + wc * 64 + 8 * fq;
                        *(u32x4*)dst = pack8(o1); *(u32x4*)(dst + 32) = pack8(o2);
                    } else {
                        bf16_t* dst = Vd + (size_t)row * 128 + 32 * (wc - 2) + 8 * fq;
                        *(u32x4*)dst = pack8(x1); *(u32x4*)(dst + 64) = pack8(x2);
                    }
                } else {
                    bf16_t* Q = (bf16_t*)(ws + WS_AQ + (size_t)(pn >> 1) * (WS_IQ - WS_AQ)); const float sc = (pn >= 2 && pn < 4) ? 1.0f : 0.125f * 1.4426950408889634f;
                    const int pos = row & 4095; const float* cp = cs + pos * 32 + 8 * fq; const float* sp = sn + pos * 32 + 8 * fq;
                    float o1[8], o2[8];
#pragma unroll
                    for (int j = 0; j < 8; ++j) { const float c = cp[j], sI = sp[j]; o1[j] = (x1[j] * c - x2[j] * sI) * sc; o2[j] = (x2[j] * c + x1[j] * sI) * sc; }
                    bf16_t* dst = Q + (size_t)row * 512 + (4 * (pn & 1) + wc) * 64 + 8 * fq;
                    *(u32x4*)dst = pack8(o1); *(u32x4*)(dst + 32) = pack8(o2);
                }
                asm volatile("" ::: "memory");
            }
    }
};

struct EpiGate2 {
    static constexpr bool PERM = true, AFTER_DRAIN = false, MID = true;
    const bf16_t *GA, *GB; bf16_t* MIX;
    __device__ __forceinline__ void mid(f32x4 (&acc)[2][2][4][2], const Unit& u, int wr, int wc, int fr_, int fq_) const {
        int fr = fr_, fq = fq_; asm volatile("" : "+v"(fr), "+v"(fq));
#pragma unroll
        for (int ai = 0; ai < 2; ++ai)
#pragma unroll
            for (int m = 0; m < 4; ++m) {
                const int row = u.pm * BM + ai * HALF + wr * 64 + m * 16 + fr;
#pragma unroll
                for (int bj = 0; bj < 2; ++bj) {
                    const size_t off = (size_t)row * 1024 + u.pn * BM + 128 * bj + 32 * wc + 8 * fq;
                    const u32x4 ga = *(const u32x4*)(GA + off), gb = *(const u32x4*)(GB + off);
                    const unsigned aw[4] = {ga.x, ga.y, ga.z, ga.w}, bw[4] = {gb.x, gb.y, gb.z, gb.w};
#pragma unroll
                    for (int q = 0; q < 4; ++q) { const float r0 = __uint_as_float(aw[q] << 16) * __builtin_amdgcn_rcpf(__uint_as_float(bw[q] << 16)), r1 = __uint_as_float(aw[q] & 0xffff0000u) * __builtin_amdgcn_rcpf(__uint_as_float(bw[q] & 0xffff0000u));
                        acc[ai][bj][m][q >> 1][2 * (q & 1)] *= r0; acc[ai][bj][m][q >> 1][2 * (q & 1) + 1] *= r1; }
                }
                if (m & 1) asm volatile("" ::: "memory");
            }
    }
    __device__ __forceinline__ void operator()(const f32x4 (&acc)[2][2][4][2], const Unit& u, int wr, int wc, int fr_, int fq_) const {
        int fr = fr_, fq = fq_; asm volatile("" : "+v"(fr), "+v"(fq));
#pragma unroll
        for (int ai = 0; ai < 2; ++ai)
#pragma unroll
            for (int m = 0; m < 4; ++m) {
                const int row = u.pm * BM + ai * HALF + wr * 64 + m * 16 + fr;
#pragma unroll
                for (int bj = 0; bj < 2; ++bj) {
                    const size_t off = (size_t)row * 1024 + u.pn * BM + 128 * bj + 32 * wc + 8 * fq;
                    const u32x4 gb = *(const u32x4*)(GB + off); const unsigned bw[4] = {gb.x, gb.y, gb.z, gb.w};
                    float v[8];
#pragma unroll
                    for (int q = 0; q < 4; ++q) { v[2 * q] = acc[ai][bj][m][q >> 1][2 * (q & 1)] * __uint_as_float(bw[q] << 16); v[2 * q + 1] = acc[ai][bj][m][q >> 1][2 * (q & 1) + 1] * __uint_as_float(bw[q] & 0xffff0000u); }
                    *(u32x4*)(MIX + off) = pack8(v);
                }
            }
    }
};

template <bool WITH_XG> struct EpiResid {
    static constexpr bool PERM = false, AFTER_DRAIN = false, MID = false;
    const float* base; float* out; bf16_t* XG; const float* gw; float* ss;
    __device__ __forceinline__ void operator()(const f32x4 (&acc)[2][2][4][2], const Unit& u, int wr, int wc, int fr, int fq) const {
#pragma unroll
        for (int ai = 0; ai < 2; ++ai)
#pragma unroll
            for (int m = 0; m < 4; ++m) {
                const int row = u.pm * BM + ai * HALF + wr * 64 + m * 16 + fr; float s = 0.f;
#pragma unroll
                for (int bj = 0; bj < 2; ++bj)
#pragma unroll
                    for (int n = 0; n < 2; ++n) {
                        const int col = u.pn * BM + bj * HALF + wc * 32 + n * 16 + 4 * fq; const size_t off = (size_t)row * 1024 + col;
                        const f32x4 v = *(const f32x4*)(base + off) + acc[ai][bj][m][n];
                        *(f32x4*)(out + off) = v; s += (v[0] * v[0] + v[1] * v[1]) + (v[2] * v[2] + v[3] * v[3]);
                        if (WITH_XG) { const f32x4 g = *(const f32x4*)(gw + col); unsigned long long w = (unsigned long long)cvt_pk_bf16(v[0] * g[0], v[1] * g[1]) | ((unsigned long long)cvt_pk_bf16(v[2] * g[2], v[3] * g[3]) << 32);
                            *(unsigned long long*)(XG + off) = w; }
                    }
                s += __shfl_xor(s, 16); s += __shfl_xor(s, 32);
                if (fq == 0) atomicAdd(ss + row, s);
            }
    }
};

struct EpiUp {
    static constexpr bool PERM = true, AFTER_DRAIN = false, MID = false;
    const float* ss; bf16_t* HID;
    __device__ __forceinline__ void operator()(const f32x4 (&acc)[2][2][4][2], const Unit& u, int wr, int wc, int fr, int fq) const {
#pragma unroll
        for (int ai = 0; ai < 2; ++ai)
#pragma unroll
            for (int m = 0; m < 4; ++m) {
                const int row = u.pm * BM + ai * HALF + wr * 64 + m * 16 + fr;
                const float rs = __builtin_amdgcn_rsqf(ss[row] * (1.0f / 1024.0f) + 1e-6f);
#pragma unroll
                for (int bj = 0; bj < 2; ++bj) {
                    float v[8];
#pragma unroll
                    for (int j = 0; j < 4; ++j) { float a = fmaxf(acc[ai][bj][m][0][j] * rs, 0.f), b = fmaxf(acc[ai][bj][m][1][j] * rs, 0.f); v[j] = a * a; v[4 + j] = b * b; }
                    *(u32x4*)(HID + (size_t)row * 4096 + u.pn * BM + bj * HALF + wc * 32 + 8 * fq) = pack8(v);
                }
            }
    }
};

struct BranchOrder {
    int G, c;
    __device__ __forceinline__ bool next(int i, Unit& u) const {
        const int tile = (i >> 1) * G + c; if (tile >= 128 * 4) return false;
        u.pm = tile >> 2; u.pn = (tile & 3) + 4 * (i & 1); return true;
    }
    __device__ __forceinline__ void a_ready(const Unit&) const {}
    __device__ __forceinline__ void done(const Unit&) const {}
};


struct EpiDummy {
    static constexpr bool PERM = true, AFTER_DRAIN = false, MID = false;
    bf16_t* D; int ldc;
    __device__ __forceinline__ void operator()(const f32x4 (&acc)[2][2][4][2], const Unit& u, int wr, int wc, int fr, int fq) const {
#pragma unroll
        for (int ai = 0; ai < 2; ++ai)
#pragma unroll
            for (int m = 0; m < 4; ++m) {
                const int row = (u.pm * BM + ai * HALF + wr * 64 + m * 16 + fr) & 8191;
#pragma unroll
                for (int bj = 0; bj < 2; ++bj) { float v[8];
#pragma unroll
                    for (int j = 0; j < 4; ++j) { v[j] = acc[ai][bj][m][0][j]; v[4 + j] = acc[ai][bj][m][1][j]; }
                    *(u32x4*)(D + (size_t)row * ldc + u.pn * BM + bj * HALF + wc * 32 + 8 * fq) = pack8(v); }
            }
    }
};
template <class Epi, class Sched, bool ALIGN_EPI = false, bool SP2 = false>
__device__ __forceinline__ void gemm_phase(PG8_LAS unsigned char* lds, const Gemm g, const Sched& S, const Epi& E, int wv) {
    const int tid = tid_op(wv), wid = wv, lane = tid & 63, wr = wid >> 2, wc = wid & 3, fr = lane & 15, fq = lane >> 4;
    const int K = g.K, nt = K / BK;
    unsigned voffA[2], voffB[2];
#pragma unroll
    for (int i = 0; i < 2; ++i) { int R, C; stage_rc(tid * 16 + i * 8192, R, C); const int Rb = Epi::PERM ? ((R & ~31) + perm32(R & 31)) : R;
        voffA[i] = (unsigned)(R * K + C) * 2u; voffB[i] = (unsigned)(Rb * K + C) * 2u; }
    const size_t kstep = (size_t)(BK * 2);
    const size_t hstep = (size_t)HALF * K * 2;
    const size_t tstep = 2 * hstep;
    const unsigned ldsw = (unsigned)wid * 1024u;
    const int aoff = lds_byte(wr * 64 + fr, fq * 8), boff = lds_byte(wc * 32 + fr, fq * 8);
#define PG8_SA(b, h) (((b) * 2 + (h)) * HTB)
#define PG8_SB(b, h) ((4 + (b) * 2 + (h)) * HTB)
#define PG8_STAGE(bufoff, gbase, voff) do { _Pragma("unroll") for (int _i = 0; _i < 2; ++_i) \
        __builtin_amdgcn_global_load_lds((const unsigned*)((const char*)(gbase) + (voff)[_i]), (PG8_LAS unsigned*)(lds + (bufoff) + ldsw + _i * 8192), 16, 0, 0); } while (0)
#define PG8_LDA(dst, b, h) do { _Pragma("unroll") for (int m = 0; m < 4; ++m) _Pragma("unroll") for (int k = 0; k < 2; ++k) dst[m][k] = *(const PG8_LAS bf16x8*)(lds + PG8_SA(b, h) + aoff + m * 2048 + k * 1024); } while (0)
#define PG8_LDB(dst, b, h) do { _Pragma("unroll") for (int n = 0; n < 2; ++n) _Pragma("unroll") for (int k = 0; k < 2; ++k) dst[n][k] = *(const PG8_LAS bf16x8*)(lds + PG8_SB(b, h) + boff + n * 2048 + k * 1024); } while (0)
#define PG8_MMA(ai, bj, At, Bt) do { __builtin_amdgcn_s_setprio(1); _Pragma("unroll") for (int m = 0; m < 4; ++m) _Pragma("unroll") for (int n = 0; n < 2; ++n) _Pragma("unroll") for (int k = 0; k < 2; ++k) \
        acc[ai][bj][m][n] = __builtin_amdgcn_mfma_f32_16x16x32_bf16(Bt[n][k], At[m][k], acc[ai][bj][m][n], 0, 0, 0); __builtin_amdgcn_s_setprio(0); } while (0)
#define PG8_WAIT_V(n) asm volatile("s_waitcnt vmcnt(" #n ")" ::: "memory")
#define PG8_WAIT_L(n) asm volatile("s_waitcnt lgkmcnt(" #n ")" ::: "memory")
#define PG8_BAR __builtin_amdgcn_s_barrier()
#define PG8_SCHED __builtin_amdgcn_sched_barrier(0)
    Unit cur, nxt; int ui = 0;
    if (!S.next(0, cur)) return;
    f32x4 acc[2][2][4][2];
#pragma unroll
    for (int a = 0; a < 2; ++a)
#pragma unroll
        for (int b = 0; b < 2; ++b)
#pragma unroll
            for (int m = 0; m < 4; ++m)
#pragma unroll
                for (int n = 0; n < 2; ++n) acc[a][b][m][n] = (f32x4){0.f, 0.f, 0.f, 0.f};
    bf16x8 At[4][2], B0[2][2], B1[2][2];
    const char* cA = g.abase(cur) + (size_t)cur.pm * tstep; const char* cB = (const char*)g.Bt + (size_t)cur.pn * tstep;
    S.a_ready(cur);
    if constexpr (SP2) {
        PG8_STAGE(PG8_SB(0, 0), cB, voffB); PG8_STAGE(PG8_SB(0, 1), cB + hstep, voffB); PG8_STAGE(PG8_SA(0, 0), cA, voffA); PG8_STAGE(PG8_SA(0, 1), cA + hstep, voffA);
        if (wr == 1) PG8_BAR;
        PG8_WAIT_V(2); PG8_BAR;
        PG8_STAGE(PG8_SB(1, 0), cB + kstep, voffB); PG8_STAGE(PG8_SA(1, 0), cA + kstep, voffA); PG8_STAGE(PG8_SB(1, 1), cB + hstep + kstep, voffB);
        PG8_WAIT_V(6); PG8_BAR;
    } else {
        PG8_STAGE(PG8_SB(0, 0), cB, voffB); PG8_STAGE(PG8_SA(0, 0), cA, voffA); PG8_STAGE(PG8_SB(0, 1), cB + hstep, voffB); PG8_STAGE(PG8_SA(0, 1), cA + hstep, voffA);
        if (wr == 1) PG8_BAR;
        PG8_WAIT_V(4); PG8_BAR;
        PG8_STAGE(PG8_SB(1, 0), cB + kstep, voffB); PG8_STAGE(PG8_SA(1, 0), cA + kstep, voffA); PG8_STAGE(PG8_SB(1, 1), cB + hstep + kstep, voffB);
        PG8_WAIT_V(6); PG8_BAR;
    }
    for (;;) {
        const bool has_next = S.next(ui + 1, nxt);
        const char* nA = has_next ? g.abase(nxt) + (size_t)nxt.pm * tstep : cA; const char* nB = has_next ? (const char*)g.Bt + (size_t)nxt.pn * tstep : cB;
        for (int t = 0; t < nt; t += 2) {
            if constexpr (Epi::MID) { if (t == (nt >> 1)) E.mid(acc, cur, wr, wc, fr, fq); }
            const bool last = (t == nt - 2);
            const char* a1 = cA + (size_t)(t + 1) * kstep;
            const char* a2 = last ? nA : cA + (size_t)(t + 2) * kstep; const char* b2 = last ? nB : cB + (size_t)(t + 2) * kstep;
            const char* a3 = a2 + kstep; const char* b3 = b2 + kstep;
            if (last && has_next) S.a_ready(nxt);
            if constexpr (SP2) {
            PG8_LDB(B0, 0, 0); PG8_LDB(B1, 0, 1); PG8_SCHED; PG8_LDA(At, 0, 0); PG8_STAGE(PG8_SA(1, 1), a1 + hstep, voffA);
            PG8_WAIT_V(8); PG8_WAIT_L(0); PG8_BAR; PG8_MMA(0, 0, At, B0); PG8_MMA(0, 1, At, B1); PG8_BAR; PG8_SCHED;
            PG8_LDA(At, 0, 1); PG8_STAGE(PG8_SB(0, 0), b2, voffB); PG8_STAGE(PG8_SB(0, 1), b2 + hstep, voffB); PG8_STAGE(PG8_SA(0, 0), a2, voffA);
            PG8_WAIT_V(8); PG8_WAIT_L(0); PG8_BAR; PG8_MMA(1, 0, At, B0); PG8_MMA(1, 1, At, B1); PG8_BAR; PG8_SCHED;
            PG8_LDB(B0, 1, 0); PG8_LDB(B1, 1, 1); PG8_SCHED; PG8_LDA(At, 1, 0); PG8_STAGE(PG8_SA(0, 1), a2 + hstep, voffA);
            PG8_WAIT_V(8); PG8_WAIT_L(0); PG8_BAR; PG8_MMA(0, 0, At, B0); PG8_MMA(0, 1, At, B1); PG8_BAR; PG8_SCHED;
            PG8_LDA(At, 1, 1); PG8_STAGE(PG8_SB(1, 0), b3, voffB); PG8_STAGE(PG8_SB(1, 1), b3 + hstep, voffB); PG8_STAGE(PG8_SA(1, 0), a3, voffA);
            PG8_WAIT_V(8); PG8_WAIT_L(0); PG8_BAR; PG8_MMA(1, 0, At, B0); PG8_MMA(1, 1, At, B1); PG8_BAR; PG8_SCHED;
            } else {
            PG8_LDB(B0, 0, 0); PG8_SCHED; PG8_LDA(At, 0, 0); PG8_STAGE(PG8_SA(1, 1), a1 + hstep, voffA);
            PG8_WAIT_L(8); PG8_BAR; PG8_WAIT_L(0); PG8_MMA(0, 0, At, B0); PG8_BAR; PG8_SCHED;
            PG8_LDB(B1, 0, 1); PG8_STAGE(PG8_SB(0, 0), b2, voffB);
            PG8_BAR; PG8_WAIT_L(0); PG8_MMA(0, 1, At, B1); PG8_BAR;
            PG8_LDA(At, 0, 1); PG8_STAGE(PG8_SA(0, 0), a2, voffA);
            PG8_BAR; PG8_WAIT_L(0); PG8_MMA(1, 0, At, B0); PG8_BAR; PG8_SCHED;
            PG8_STAGE(PG8_SB(0, 1), b2 + hstep, voffB);
            PG8_WAIT_V(6); PG8_BAR; PG8_MMA(1, 1, At, B1); PG8_BAR;
            PG8_LDB(B0, 1, 0); PG8_SCHED; PG8_LDA(At, 1, 0); PG8_STAGE(PG8_SA(0, 1), a2 + hstep, voffA);
            PG8_WAIT_L(8); PG8_BAR; PG8_WAIT_L(0); PG8_MMA(0, 0, At, B0); PG8_BAR; PG8_SCHED;
            PG8_LDB(B1, 1, 1); PG8_STAGE(PG8_SB(1, 0), b3, voffB);
            PG8_BAR; PG8_WAIT_L(0); PG8_MMA(0, 1, At, B1); PG8_BAR;
            PG8_LDA(At, 1, 1); PG8_STAGE(PG8_SA(1, 0), a3, voffA);
            PG8_BAR; PG8_WAIT_L(0); PG8_MMA(1, 0, At, B0); PG8_BAR; PG8_SCHED;
            PG8_STAGE(PG8_SB(1, 1), b3 + hstep, voffB);
            PG8_WAIT_V(6); PG8_BAR; PG8_MMA(1, 1, At, B1); PG8_BAR;
            }
        }
        if constexpr (ALIGN_EPI) { if (wr == 0) PG8_BAR; }
        if constexpr (!Epi::AFTER_DRAIN) { E(acc, cur, wr, wc, fr, fq); S.done(cur); }
        if (!has_next) break;
#pragma unroll
        for (int a = 0; a < 2; ++a)
#pragma unroll
            for (int b = 0; b < 2; ++b)
#pragma unroll
                for (int m = 0; m < 4; ++m)
#pragma unroll
                    for (int n = 0; n < 2; ++n) acc[a][b][m][n] = (f32x4){0.f, 0.f, 0.f, 0.f};
        cur = nxt; cA = nA; cB = nB; ++ui;
        if constexpr (ALIGN_EPI) { if (wr == 1) PG8_BAR; }
    }
    PG8_WAIT_V(0);
    if constexpr (!ALIGN_EPI) { if (wr == 0) PG8_BAR; }
    PG8_BAR;
    if constexpr (Epi::AFTER_DRAIN) { E.fused(acc, cur, wr, wc, fr, fq, lds, wid, lane); S.done(cur); }
#undef PG8_SA
#undef PG8_SB
#undef PG8_STAGE
#undef PG8_LDA
#undef PG8_LDB
#undef PG8_MMA
#undef PG8_WAIT_V
#undef PG8_WAIT_L
#undef PG8_BAR
#undef PG8_SCHED
}
}
struct Params {
    const float *x, *attn_norm_w, *w_in, *ikw, *ikb, *sinks, *w_a, *w_b, *w_out, *mlp_norm_w, *w_up, *w_down, *final_w;
    float* out; unsigned char* ws;
    float inv_freq[32];
    int ph_lo, ph_hi;
};
constexpr int NWAVES = 8, NTHREADS = 512;

__device__ __forceinline__ int win_src_group(int grp, int& cnt) {
    const int tile = grp >> 3, g = grp & 7; cnt = 32;
    if (tile < 6) { const int base = tile < 2 ? C_AQ : (tile < 4 ? C_IQ : C_BQ); const int head = 4 * (tile & 1) + (g & 3); return base + head * 64 + 32 * (g >> 2); }
    if (tile < 8) { const int kb = tile == 6 ? C_AK : C_BK, vb = tile == 6 ? C_AV : C_BV; const int hf = g >> 2, q = g & 3;
        if (q < 2) return kb + q * 64 + 32 * hf; return vb + 64 * hf + 32 * (q - 2); }
    if (tile == 8) { if (g == 0) return C_IK; if (g == 4) return C_IK + 32; if (g == 1) { cnt = 8; return C_IW; } cnt = 0; return 0; }
    return C_GA + (grp - 72) * 32;
}
__device__ __forceinline__ void p0_transpose_item(const float* W, int ldw, int c0, int cnt, int K, bf16* WT, int n0, int k0, LAS float* scr, int lane, int kd = 0) {
#pragma unroll 8
    for (int i = 0; i < 32; ++i) { const int kk = 2 * i + (lane >> 5), n = lane & 31; scr[kk * 33 + n] = (n < cnt) ? W[(size_t)(k0 + kk) * ldw + c0 + n] : 0.f; }
    asm volatile("s_waitcnt lgkmcnt(0)" ::: "memory");
    const int c = lane & 7;
#pragma unroll
    for (int j = 0; j < 4; ++j) { const int n = (lane >> 3) + 8 * j; const LAS float* s = scr + (8 * c) * 33 + n;
        v4u o; o.x = pk2(s[0 * 33], s[1 * 33]); o.y = pk2(s[2 * 33], s[3 * 33]); o.z = pk2(s[4 * 33], s[5 * 33]); o.w = pk2(s[6 * 33], s[7 * 33]);
        *(v4u*)(WT + (size_t)(n0 + n) * K + kd + k0 + 8 * c) = o; }
    asm volatile("s_waitcnt lgkmcnt(0)" ::: "memory");
}
__device__ __forceinline__ void sincos_d(float angf, float& sn, float& cs) {
    const double a = (double)angf; const double kq = __builtin_rint(a * 0.63661977236758134308);
    const double y = (a - kq * 1.57079632679489655800) - kq * 6.123233995736766e-17; const double y2 = y * y;
    double s = y * (1.0 + y2 * (-1.0 / 6 + y2 * (1.0 / 120 + y2 * (-1.0 / 5040 + y2 * (1.0 / 362880 + y2 * (-1.0 / 39916800 + y2 * (1.0 / 6227020800.0)))))));
    double c = 1.0 + y2 * (-0.5 + y2 * (1.0 / 24 + y2 * (-1.0 / 720 + y2 * (1.0 / 40320 + y2 * (-1.0 / 3628800 + y2 * (1.0 / 479001600.0 + y2 * (-1.0 / 87178291200.0)))))));
    const int q = ((int)kq) & 3;
    const double ss = (q == 0) ? s : (q == 1) ? c : (q == 2) ? -s : -c; const double cc = (q == 0) ? c : (q == 1) ? -s : (q == 2) ? -c : s;
    sn = (float)ss; cs = (float)cc;
}
__device__ __forceinline__ void phase_prologue(const Params& p, LAS unsigned char* lds, int G, int wv) {
    const int wave = wv, lane = lane_id();
    unsigned char* ws = p.ws;
    LAS float* scr = (LAS float*)(lds + wave * 16384);
    const int gw = blockIdx.x * NWAVES + wave, NGW = G * NWAVES;
    constexpr int I_IN = (DM / 64) * (NIN / 32), I_A = (512 / 64) * (DM / 32), I_O = (DM / 64) * (DM / 32), I_U = (DM / 64) * (DFF / 32), I_D = (DFF / 64) * (DM / 32);
    constexpr int NITEMS = I_IN + 2 * I_A + I_O + I_U + I_D;
    for (int it = gw; it < NITEMS; it += NGW) {
        int r = it;
        if (r < I_IN) { const int grp = r % (NIN / 32), kb = r / (NIN / 32); int cnt; const int c0 = win_src_group(grp, cnt);
            p0_transpose_item(p.w_in, D_IN, c0, cnt, DM, (bf16*)(ws + WS_WIN), grp * 32, kb * 64, scr, lane); continue; } r -= I_IN;
        if (r < I_A) { const int nb = r % 32, kb = r / 32; p0_transpose_item(p.w_a, DM, nb * 32, 32, 1024, (bf16*)(ws + WS_WAB), nb * 32, kb * 64, scr, lane); continue; } r -= I_A;
        if (r < I_A) { const int nb = r % 32, kb = r / 32; p0_transpose_item(p.w_b, DM, nb * 32, 32, 1024, (bf16*)(ws + WS_WAB), nb * 32, kb * 64, scr, lane, 512); continue; } r -= I_A;
        if (r < I_O) { const int nb = r % 32, kb = r / 32; p0_transpose_item(p.w_out, DM, nb * 32, 32, DM, (bf16*)(ws + WS_WOUT), nb * 32, kb * 64, scr, lane); continue; } r -= I_O;
        if (r < I_U) { const int nb = r % 128, kb = r / 128; p0_transpose_item(p.w_up, DFF, nb * 32, 32, DM, (bf16*)(ws + WS_WUP), nb * 32, kb * 64, scr, lane); continue; } r -= I_U;
        { const int nb = r % 32, kb = r / 32; p0_transpose_item(p.w_down, DM, nb * 32, 32, DFF, (bf16*)(ws + WS_WDN), nb * 32, kb * 64, scr, lane); }
    }
    float* COS = (float*)(ws + WS_COS); float* SIN = (float*)(ws + WS_SIN);
    for (int i = gw * 64 + lane; i < SEQ * 32; i += NGW * 64) { const int pos = i >> 5, d = i & 31; const float ang = (float)pos * p.inv_freq[d]; float s, c; sincos_d(ang, s, c); COS[i] = c; SIN[i] = s; }
    float* RSTD1 = (float*)(ws + WS_RSTD1); float* SS2 = (float*)(ws + WS_SS2); float* SS3 = (float*)(ws + WS_SS3); bf16* XG = (bf16*)(ws + WS_XG);
    v4f g[4];
#pragma unroll
    for (int j = 0; j < 4; ++j) g[j] = *((const v4f*)p.attn_norm_w + lane + 64 * j);
    int m = gw;
    for (; m + 3 * NGW < TOK; m += 4 * NGW) {
        v4f v[4][4]; float s[4];
#pragma unroll
        for (int q = 0; q < 4; ++q) { const v4f* xr = (const v4f*)(p.x + (size_t)(m + q * NGW) * DM) + lane;
#pragma unroll
            for (int j = 0; j < 4; ++j) v[q][j] = xr[64 * j]; }
#pragma unroll
        for (int q = 0; q < 4; ++q) { s[q] = 0.f;
#pragma unroll
            for (int j = 0; j < 4; ++j) s[q] += (v[q][j].x * v[q][j].x + v[q][j].y * v[q][j].y) + (v[q][j].z * v[q][j].z + v[q][j].w * v[q][j].w);
            s[q] = wave_sum(s[q]);
            unsigned long long* o8 = (unsigned long long*)(XG + (size_t)(m + q * NGW) * DM) + lane;
#pragma unroll
            for (int j = 0; j < 4; ++j) o8[64 * j] = (unsigned long long)pk2(v[q][j].x * g[j].x, v[q][j].y * g[j].y) | ((unsigned long long)pk2(v[q][j].z * g[j].z, v[q][j].w * g[j].w) << 32);
            if (lane == 0) { RSTD1[m + q * NGW] = frsq(s[q] * (1.0f / DM) + RMS_EPS); SS2[m + q * NGW] = 0.f; SS3[m + q * NGW] = 0.f; } }
    }
    for (; m < TOK; m += NGW) {
        const v4f* xr = (const v4f*)(p.x + (size_t)m * DM) + lane; v4f v[4]; float s = 0.f;
#pragma unroll
        for (int j = 0; j < 4; ++j) { v[j] = xr[64 * j]; s += (v[j].x * v[j].x + v[j].y * v[j].y) + (v[j].z * v[j].z + v[j].w * v[j].w); }
        s = wave_sum(s);
        unsigned long long* o8 = (unsigned long long*)(XG + (size_t)m * DM) + lane;
#pragma unroll
        for (int j = 0; j < 4; ++j) o8[64 * j] = (unsigned long long)pk2(v[j].x * g[j].x, v[j].y * g[j].y) | ((unsigned long long)pk2(v[j].z * g[j].z, v[j].w * g[j].w) << 32);
        if (lane == 0) { RSTD1[m] = frsq(s * (1.0f / DM) + RMS_EPS); SS2[m] = 0.f; SS3[m] = 0.f; }
    }
}

__device__ __forceinline__ unsigned f2key(float f) { const unsigned u = __float_as_uint(f); return (u & 0x80000000u) ? ~u : (u | 0x80000000u); }
__device__ __forceinline__ void phase_topk_simple(const Params& p, LAS unsigned char* lds, int G, int wv) {
    const int wave = wv, lane = lane_id();
    unsigned char* ws = p.ws;
    const bf16* IQ = (const bf16*)(ws + WS_IQ); const bf16* IK = (const bf16*)(ws + WS_IK); const float* IW = (const float*)(ws + WS_IW);
    unsigned short* SEL = (unsigned short*)(ws + WS_SEL);
    LAS unsigned* keys = (LAS unsigned*)(lds + wave * 16384);
    LAS float* qf = (LAS float*)(lds + LDS_RING + wave * 2048);
    const int gw = blockIdx.x * NWAVES + wave, NGW = G * NWAVES;
    for (int row = gw; row < TOK; row += NGW) {
        const int b = row >> 12, t = row & 4095, n = t + 1;
        unsigned short* selrow = SEL + (size_t)row * TOPK;
        if (n <= TOPK) { for (int i = lane; i < n; i += 64) selrow[i] = (unsigned short)i; continue; }
        { const v4u q8 = *((const v4u*)(IQ + (size_t)row * 512) + lane);
            LAS float* d = qf + 8 * lane;
            d[0] = bflo(q8.x); d[1] = bfhi(q8.x); d[2] = bflo(q8.y); d[3] = bfhi(q8.y); d[4] = bflo(q8.z); d[5] = bfhi(q8.z); d[6] = bflo(q8.w); d[7] = bfhi(q8.w); }
        float w[8];
#pragma unroll
        for (int h = 0; h < 8; ++h) w[h] = IW[(size_t)row * 8 + h];
        asm volatile("s_waitcnt lgkmcnt(0)" ::: "memory");
        for (int s0 = 0; s0 < n; s0 += 64) {
            const int s = s0 + lane; const int sc = s < n ? s : t;
            const v4u* kp = (const v4u*)(IK + ((size_t)b * SEQ + sc) * 64);
            float dot[8];
#pragma unroll
            for (int h = 0; h < 8; ++h) dot[h] = 0.f;
#pragma unroll
            for (int c = 0; c < 8; ++c) {
                const v4u k8 = kp[c]; float kf[8] = {bflo(k8.x), bfhi(k8.x), bflo(k8.y), bfhi(k8.y), bflo(k8.z), bfhi(k8.z), bflo(k8.w), bfhi(k8.w)};
#pragma unroll
                for (int h = 0; h < 8; ++h) { const v4f qa = *(const LAS v4f*)(qf + h * 64 + c * 8), qb = *(const LAS v4f*)(qf + h * 64 + c * 8 + 4);
                    dot[h] += (kf[0] * qa.x + kf[1] * qa.y) + (kf[2] * qa.z + kf[3] * qa.w) + (kf[4] * qb.x + kf[5] * qb.y) + (kf[6] * qb.z + kf[7] * qb.w); }
            }
            float sc_ = 0.f;
#pragma unroll
            for (int h = 0; h < 8; ++h) sc_ += w[h] * fmaxf(dot[h], 0.f);
            keys[s] = (s < n) ? f2key(sc_) : 0u;
        }
        asm volatile("s_waitcnt lgkmcnt(0)" ::: "memory");
        const int nch = (n + 63) >> 6;
        unsigned thr = 0u;
        for (int bit = 31; bit >= 0; --bit) {
            const unsigned cand = thr | (1u << bit); int cnt = 0;
            for (int c = 0; c < nch; ++c) cnt += __popcll(__ballot(keys[c * 64 + lane] >= cand));
            if (cnt >= TOPK) thr = cand;
        }
        int cgt = 0;
        for (int c = 0; c < nch; ++c) cgt += __popcll(__ballot(keys[c * 64 + lane] > thr));
        const int need = TOPK - cgt; int pos = 0, ties = 0;
        for (int c = 0; c < nch; ++c) {
            const unsigned k = keys[c * 64 + lane]; const bool gt = k > thr, eq = k == thr;
            const unsigned long long meq = __ballot(eq);
            const bool sel = gt || (eq && (ties + mbcnt64(meq) < need));
            const unsigned long long msel = __ballot(sel);
            if (sel) selrow[pos + mbcnt64(msel)] = (unsigned short)(c * 64 + lane);
            pos += __popcll(msel); ties += __popcll(meq);
        }
    }
}

template <bool SINK, class KeyFn>
__device__ __forceinline__ void attend_wave(const bf16* Q, const bf16* K, const bf16* V, bf16* O, int row, int g, int nslots, const KeyFn& keyfn, const float* sinkv,
                                            LAS float* qf  , LAS float* pf  , LAS int* kidx  , int lane) {
    const int b = row >> 12;
    { const v2u q4 = *((const v2u*)(Q + (size_t)row * 512 + g * 256) + lane);
        LAS float* d = qf + 4 * lane; d[0] = bflo(q4.x); d[1] = bfhi(q4.x); d[2] = bflo(q4.y); d[3] = bfhi(q4.y); }
    asm volatile("s_waitcnt lgkmcnt(0)" ::: "memory");
#pragma unroll 1
    for (int j = 0; j < 4; ++j) {
        const int slot = 64 * j + lane; int key = slot < nslots ? keyfn(slot) : -1; kidx[slot] = key;
        const bool valid = key >= 0; const int kc = valid ? key : 0;
        const v4u* kp = (const v4u*)(K + ((size_t)b * SEQ + kc) * 128 + g * 64);
        float dot[4] = {0.f, 0.f, 0.f, 0.f};
        if (64 * j < nslots) {
#pragma unroll 2
            for (int c = 0; c < 8; ++c) {
                const v4u k8 = kp[c]; float kf[8] = {bflo(k8.x), bfhi(k8.x), bflo(k8.y), bfhi(k8.y), bflo(k8.z), bfhi(k8.z), bflo(k8.w), bfhi(k8.w)};
#pragma unroll
                for (int h = 0; h < 4; ++h) { const v4f qa = *(const LAS v4f*)(qf + h * 64 + c * 8), qb = *(const LAS v4f*)(qf + h * 64 + c * 8 + 4);
                    dot[h] += (kf[0] * qa.x + kf[1] * qa.y) + (kf[2] * qa.z + kf[3] * qa.w) + (kf[4] * qb.x + kf[5] * qb.y) + (kf[6] * qb.z + kf[7] * qb.w); }
            }
        }
        *(LAS v4f*)(pf + slot * 4) = valid ? (v4f){dot[0], dot[1], dot[2], dot[3]} : (v4f){-INFINITY, -INFINITY, -INFINITY, -INFINITY};
    }
    asm volatile("s_waitcnt lgkmcnt(0)" ::: "memory");
    float lg[4][4];
#pragma unroll
    for (int j = 0; j < 4; ++j) { const v4f t4 = *(const LAS v4f*)(pf + (64 * j + lane) * 4); lg[j][0] = t4.x; lg[j][1] = t4.y; lg[j][2] = t4.z; lg[j][3] = t4.w; }
    float inv[4];
#pragma unroll
    for (int h = 0; h < 4; ++h) {
        float mx = fmaxf(fmaxf(lg[0][h], lg[1][h]), fmaxf(lg[2][h], lg[3][h])); mx = wave_max(mx);
        float sk = 0.f; if (SINK) { sk = sinkv[g * 4 + h] * LOG2E; mx = fmaxf(mx, sk); }
        float s = 0.f;
#pragma unroll
        for (int j = 0; j < 4; ++j) { const float e = fexp2(lg[j][h] - mx); lg[j][h] = e; s += e; }
        s = wave_sum(s); if (SINK) s += fexp2(sk - mx);
        inv[h] = 1.0f / s;
    }
#pragma unroll
    for (int j = 0; j < 4; ++j) *(LAS v4f*)(pf + (64 * j + lane) * 4) = (v4f){lg[j][0], lg[j][1], lg[j][2], lg[j][3]};
    asm volatile("s_waitcnt lgkmcnt(0)" ::: "memory");
    float o[4] = {0.f, 0.f, 0.f, 0.f};
    const bf16* Vb = V + (size_t)b * SEQ * 128 + g * 64 + lane;
#pragma unroll 1
    for (int s0 = 0; s0 < nslots; s0 += 8) {
        float vv[8]; v4f pp[8];
#pragma unroll
        for (int i = 0; i < 8; ++i) { const int slot = s0 + i; const int key = slot < nslots ? kidx[slot] : -1; pp[i] = *(const LAS v4f*)(pf + (slot & 255) * 4);
            vv[i] = key >= 0 ? bf2f(Vb[(size_t)key * 128]) : 0.f; if (key < 0) pp[i] = (v4f){0.f, 0.f, 0.f, 0.f}; }
#pragma unroll
        for (int i = 0; i < 8; ++i) { o[0] += pp[i].x * vv[i]; o[1] += pp[i].y * vv[i]; o[2] += pp[i].z * vv[i]; o[3] += pp[i].w * vv[i]; }
    }
    bf16* op = O + (size_t)row * 512 + g * 256 + lane;
#pragma unroll
    for (int h = 0; h < 4; ++h) op[h * 64] = (bf16)f2bf(o[h] * inv[h]);
}
struct SelKey { const unsigned short* selrow; __device__ __forceinline__ int operator()(int slot) const { return (int)selrow[slot]; } };
struct WinKey { int t; __device__ __forceinline__ int operator()(int slot) const { return t - (WIN - 1) + slot; } };

template <bool DO_DSA, bool DO_SWA>
__device__ __forceinline__ void phase_attn_simple(const Params& p, LAS unsigned char* lds, int G, int wv) {
    const int wave = wv, lane = lane_id();
    unsigned char* ws = p.ws;
    LAS float* qf = (LAS float*)(lds + wave * 16384); LAS float* pf = qf + 256; LAS int* kidx = (LAS int*)(pf + 1024);
    const int gw = blockIdx.x * NWAVES + wave, NGW = G * NWAVES;
    const unsigned short* SEL = (const unsigned short*)(ws + WS_SEL);
    for (int item = gw; item < TOK * 2; item += NGW) {
        const int row = item >> 1, g = item & 1, t = row & 4095;
        if (DO_DSA) { SelKey kf{SEL + (size_t)row * TOPK}; const int ns = (t + 1 < TOPK) ? t + 1 : TOPK;
            attend_wave<false>((const bf16*)(ws + WS_AQ), (const bf16*)(ws + WS_AK), (const bf16*)(ws + WS_AV), (bf16*)(ws + WS_AQ), row, g, ns, kf, nullptr, qf, pf, kidx, lane); }
        if (DO_SWA) { WinKey kf{t};
            attend_wave<true>((const bf16*)(ws + WS_BQ), (const bf16*)(ws + WS_BK), (const bf16*)(ws + WS_BV), (bf16*)(ws + WS_BQ), row, g, WIN, kf, p.sinks, qf, pf, kidx, lane); }
    }
}

__device__ __forceinline__ void phase_final(const Params& p, int G, int wv, float* dst) {
    const int wave = wv, lane = lane_id();
    const float* SS3 = (const float*)(p.ws + WS_SS3);
    const int gw = blockIdx.x * NWAVES + wave, NGW = G * NWAVES;
    v4f g[4];
#pragma unroll
    for (int j = 0; j < 4; ++j) g[j] = *((const v4f*)p.final_w + lane + 64 * j);
    for (int m = gw; m < TOK; m += NGW) {
        float rs = frsq(SS3[m] * (1.0f / DM) + RMS_EPS);
#ifdef PROBE_TS
        { const unsigned long long* TS = (const unsigned long long*)(p.ws + WS_RSTD1 + 384 * 1024); rs *= 1.0f + (float)(TS[PROBE_TS + 1] - TS[PROBE_TS]) * 1.0e-5f; }
#endif
        const v4f* xr = (const v4f*)(p.out + (size_t)m * DM) + lane; v4f* xo = (v4f*)(dst + (size_t)m * DM) + lane;
#pragma unroll
        for (int j = 0; j < 4; ++j) { v4f v = xr[64 * j]; xo[64 * j] = v * g[j] * rs; }
    }
}

typedef short bf16x8_t __attribute__((ext_vector_type(8)));
typedef float f32x16_t __attribute__((ext_vector_type(16)));
typedef float f32x4_t __attribute__((ext_vector_type(4)));
typedef float f32x2_t __attribute__((ext_vector_type(2)));
__device__ __forceinline__ unsigned f16key(float f) { const int q = (int)__builtin_rintf(f * 4096.0f) + 32768; return (unsigned)(q < 256 ? 256 : (q > 65535 ? 65535 : q)); }
__device__ __forceinline__ float relu1(float x) { return __builtin_amdgcn_fmed3f(x, 0.f, 3.0e38f); }
constexpr int TK_H1 = LDS_RING, TK_WAVE = LDS_RING + 8192, TK_WAVE_BYTES = 3072, TK_CAND = 512;
static_assert(TK_WAVE + 8 * TK_WAVE_BYTES <= LDS_BYTES, "top-k LDS map");

__device__ __forceinline__ void phase_topk_fast(const Params& p, LAS unsigned char* lds, int G, int wv) {
    const int wave = wv, lane = lane_id(), tid = wave * 64 + lane;
    const int r = lane & 31, h = lane >> 5, mt = wave & 3, par = wave >> 2;
    unsigned char* ws = p.ws;
    const bf16* IQ = (const bf16*)(ws + WS_IQ); const bf16* IK = (const bf16*)(ws + WS_IK); const float* IW = (const float*)(ws + WS_IW);
    unsigned short* SEL = (unsigned short*)(ws + WS_SEL);
    LAS unsigned short* kb = (LAS unsigned short*)lds;
    LAS unsigned* H1 = (LAS unsigned*)(lds + TK_H1);
    LAS unsigned* cl = (LAS unsigned*)(lds + TK_WAVE + wave * TK_WAVE_BYTES); LAS unsigned short* ol = (LAS unsigned short*)(lds + TK_WAVE + wave * TK_WAVE_BYTES + 4 * TK_CAND);
    const int qrow = 4 * mt + 2 * ((r >> 2) & 1) + (r >> 4), qhead = 4 * ((r >> 3) & 1) + (r & 3);
    { LAS v4u* hz = (LAS v4u*)H1; hz[tid] = (v4u){0u, 0u, 0u, 0u}; }
    for (int k = 0;; ++k) {
        int b, tile;
        if (G == 256) { if (k >= 8) break; const int c = blockIdx.x, i = c >> 3, grp = k >> 1; b = c & 7; tile = (k & 1) ? (64 * grp + 63 - i) : (64 * grp + i); }
        else { const int u = blockIdx.x + k * G; if (u >= TOK / 16) break; b = u >> 8; tile = u & 255; }
        const int t0 = tile * 16, R0 = b * SEQ + t0;
        if (t0 + 16 <= TOPK) {
            for (int i = tid; i < 16 * TOPK; i += NTHREADS) { const int ql = i >> 8, s = i & 255; if (s <= t0 + ql) SEL[(size_t)(R0 + ql) * TOPK + s] = (unsigned short)s; }
            continue;
        }
        bf16x8_t aq[4];
#pragma unroll
        for (int s = 0; s < 4; ++s) aq[s] = *(const bf16x8_t*)(IQ + (size_t)(R0 + qrow) * 512 + qhead * 64 + 16 * s + 8 * h);
        f32x2_t wq[2][4];
#pragma unroll
        for (int qq = 0; qq < 2; ++qq) { const f32x4_t w0 = *(const f32x4_t*)(IW + (size_t)(R0 + 4 * mt + 2 * h + qq) * 8), w1 = *(const f32x4_t*)(IW + (size_t)(R0 + 4 * mt + 2 * h + qq) * 8 + 4);
            const float n2 = (w0[0] * w0[0] + w0[1] * w0[1]) + (w0[2] * w0[2] + w0[3] * w0[3]) + (w1[0] * w1[0] + w1[1] * w1[1]) + (w1[2] * w1[2] + w1[3] * w1[3]);
            const float sn = __builtin_amdgcn_rsqf(fmaxf(n2, 1e-30f)) * 0.2141f;
            wq[qq][0] = (f32x2_t){w0[0], w0[1]} * sn; wq[qq][1] = (f32x2_t){w0[2], w0[3]} * sn; wq[qq][2] = (f32x2_t){w1[0], w1[1]} * sn; wq[qq][3] = (f32x2_t){w1[2], w1[3]} * sn; }
        const int ntile = (t0 + 16 + 31) >> 5, ntp = (ntile + 7) & ~7, nch = (t0 + 16 + 511) >> 9;
        const char* kbase = (const char*)IK + (size_t)b * SEQ * 128;
        const unsigned voff = (unsigned)(lane * 16);
        const int tq0 = t0 + 4 * mt + 2 * h;
        const int ql0 = 4 * mt + 2 * h;
        LAS unsigned short* row0 = kb + ql0 * 4096; LAS unsigned* h0 = H1 + ql0 * 128;
        __syncthreads();
#define TK_LOAD(dst, kt_) do { const int ktc_ = (kt_) < 127 ? (kt_) : 127; const char* tp_ = kbase + (size_t)ktc_ * 4096; _Pragma("unroll") for (int s_ = 0; s_ < 4; ++s_) dst[s_] = *(const bf16x8_t*)(tp_ + voff + 1024 * s_); } while (0)
#define TK_MMA(acc_, src) do { acc_ = (f32x16_t){0.f, 0.f, 0.f, 0.f, 0.f, 0.f, 0.f, 0.f, 0.f, 0.f, 0.f, 0.f, 0.f, 0.f, 0.f, 0.f}; \
            _Pragma("unroll") for (int s_ = 0; s_ < 4; ++s_) acc_ = __builtin_amdgcn_mfma_f32_32x32x16_bf16(aq[s_], src[s_], acc_, 0, 0, 0); } while (0)
#define TK_POST(acc_, kt_) do { f32x2_t s0_ = {0.f, 0.f}, s1_ = {0.f, 0.f}; \
            _Pragma("unroll") for (int hd_ = 0; hd_ < 4; ++hd_) { s0_ += (f32x2_t){relu1(acc_[2 * hd_]), relu1(acc_[2 * hd_ + 1])} * wq[0][hd_]; s1_ += (f32x2_t){relu1(acc_[8 + 2 * hd_]), relu1(acc_[9 + 2 * hd_])} * wq[1][hd_]; } \
            const int e_ = 32 * (kt_) + r; const unsigned k0_ = (e_ <= tq0) ? f16key(s0_.x + s0_.y) : 0u, k1_ = (e_ <= tq0 + 1) ? f16key(s1_.x + s1_.y) : 0u; \
            row0[e_] = (unsigned short)k0_; row0[4096 + e_] = (unsigned short)k1_; \
            if (k0_) __hip_atomic_fetch_add(h0 + (k0_ >> 9), 1u << ((k0_ >> 4) & 16u), __ATOMIC_RELAXED, __HIP_MEMORY_SCOPE_WORKGROUP); \
            if (k1_) __hip_atomic_fetch_add(h0 + 128 + (k1_ >> 9), 1u << ((k1_ >> 4) & 16u), __ATOMIC_RELAXED, __HIP_MEMORY_SCOPE_WORKGROUP); } while (0)
#ifndef TK_REP_SCORE
#define TK_REP_SCORE 1
#endif
#ifndef TK_REP_SEL
#define TK_REP_SEL 1
#endif
#pragma unroll 1
        for (int rp_ = 0; rp_ < TK_REP_SCORE; ++rp_) {
            if (rp_ > 0) { __syncthreads(); LAS v4u* hz = (LAS v4u*)H1; hz[tid] = (v4u){0u, 0u, 0u, 0u}; __syncthreads(); }
            bf16x8_t B[4][4]; f32x16_t accA, accB;
            const int nmy = ntp >> 1;
#pragma unroll
            for (int u = 0; u < 4; ++u) TK_LOAD(B[u], par + 2 * u);
            TK_MMA(accA, B[0]);
#pragma unroll 1
            for (int i = 0; i < nmy; i += 4) {
                const int kt = par + 2 * i;
                TK_MMA(accB, B[1]); TK_POST(accA, kt);     TK_LOAD(B[0], kt + 8);
                TK_MMA(accA, B[2]); TK_POST(accB, kt + 2); TK_LOAD(B[1], kt + 10);
                TK_MMA(accB, B[3]); TK_POST(accA, kt + 4); TK_LOAD(B[2], kt + 12);
                TK_MMA(accA, B[0]); TK_POST(accB, kt + 6); TK_LOAD(B[3], kt + 14);
            }
        }
#undef TK_LOAD
#undef TK_MMA
#undef TK_POST
        if (32 * ntp < 512 * nch) {
#pragma unroll
            for (int qi = 0; qi < 2; ++qi) { LAS v2u* z = (LAS v2u*)(kb + (2 * wave + qi) * 4096 + 32 * ntp) + lane; *z = (v2u){0u, 0u}; }
        }
        __syncthreads();
#pragma unroll 1
        for (int qi = 0; qi < 2 * TK_REP_SEL; ++qi) {
            const int ql = 2 * wave + (qi & 1);
            const LAS unsigned short* rb = kb + ql * 4096 + lane;
            const v2u hw = *(const LAS v2u*)(H1 + ql * 128 + 2 * lane); const v4u hv = {hw.x & 0xffffu, hw.x >> 16, hw.y & 0xffffu, hw.y >> 16};
            if ((qi >> 1) + 1 == TK_REP_SEL) *(LAS v2u*)(H1 + ql * 128 + 2 * lane) = (v2u){0u, 0u};
            const int hs = (int)(hv.x + hv.y + hv.z + hv.w); int S = hs;
#pragma unroll
            for (int off = 1; off < 64; off <<= 1) { const int v = __shfl_down(S, off); if (lane + off < 64) S += v; }
            int ab = S - hs; const bool cross = ab < TOPK && S >= TOPK;
            int Bl = 4 * lane + 3;
            if (ab + (int)hv.w < TOPK) { ab += (int)hv.w; Bl = 4 * lane + 2; if (ab + (int)hv.z < TOPK) { ab += (int)hv.z; Bl = 4 * lane + 1; if (ab + (int)hv.y < TOPK) { ab += (int)hv.y; Bl = 4 * lane; } } }
            const unsigned long long mc = __ballot(cross);
            const int src = mc ? (__ffsll((long long)mc) - 1) : 0;
            const unsigned Bb = (unsigned)__shfl(Bl, src);
            const unsigned kmin = Bb << 8; int m = 0;
#pragma unroll 1
            for (int j = 0; j < nch; ++j) {
                unsigned kk[8];
#pragma unroll
                for (int s = 0; s < 8; ++s) kk[s] = rb[512 * j + 64 * s];
#pragma unroll
                for (int s = 0; s < 8; ++s) {
                    const bool in = kk[s] >= kmin;
                    const unsigned long long mi = __ballot(in);
                    if (in) { const int ci = m + mbcnt64(mi); if (ci < TK_CAND) cl[ci] = (kk[s] << 16) | (unsigned)(512 * j + 64 * s + lane); }
                    m += __popcll(mi);
                }
            }
            asm volatile("s_waitcnt lgkmcnt(0)" ::: "memory");
            int pos = 0;
            if (mc != 0ull && m <= TK_CAND && m >= TOPK) {
                unsigned ent[8]; bool val[8];
#pragma unroll
                for (int q = 0; q < 8; ++q) { val[q] = 64 * q + lane < m; ent[q] = val[q] ? cl[64 * q + lane] : 0u; }
                int nab = 0;
#pragma unroll
                for (int q = 0; q < 8; ++q) nab += __popcll(__ballot(val[q] && (ent[q] >> 24) > Bb));
                const int need2 = TOPK - nab;
                unsigned thr2 = 0u;
#pragma unroll 1
                for (int bit = 7; bit >= 0; --bit) {
                    const unsigned cand = thr2 | (1u << bit); int cnt = 0;
#pragma unroll
                    for (int q = 0; q < 8; ++q) cnt += __popcll(__ballot(val[q] && (ent[q] >> 24) == Bb && ((ent[q] >> 16) & 0xffu) >= cand));
                    if (cnt >= need2) thr2 = cand;
                }
                const unsigned kthr = (Bb << 8) | thr2;
                int cgt2 = 0;
#pragma unroll
                for (int q = 0; q < 8; ++q) cgt2 += __popcll(__ballot(val[q] && (ent[q] >> 16) > kthr));
                const int need3 = TOPK - cgt2; int ties = 0;
#pragma unroll
                for (int q = 0; q < 8; ++q) {
                    const unsigned kx = ent[q] >> 16; const bool gt = val[q] && kx > kthr, eq = val[q] && kx == kthr;
                    const unsigned long long meq = __ballot(eq);
                    const bool sel = gt || (eq && (ties + mbcnt64(meq) < need3));
                    const unsigned long long msel = __ballot(sel);
                    if (sel) ol[pos + mbcnt64(msel)] = (unsigned short)(ent[q] & 0xffffu);
                    pos += __popcll(msel); ties += __popcll(meq);
                }
            } else {
                unsigned thr = 0u;
#pragma unroll 1
                for (int bit = 15; bit >= 0; --bit) {
                    const unsigned cand = thr | (1u << bit); int cnt = 0;
#pragma unroll 1
                    for (int i = 0; i < 8 * nch; ++i) cnt += __popcll(__ballot((unsigned)rb[64 * i] >= cand));
                    if (cnt >= TOPK) thr = cand;
                }
                int cgt = 0;
#pragma unroll 1
                for (int i = 0; i < 8 * nch; ++i) cgt += __popcll(__ballot((unsigned)rb[64 * i] > thr));
                const int need = TOPK - cgt; int ties = 0; pos = 0;
#pragma unroll 1
                for (int i = 0; i < 8 * nch; ++i) {
                    const unsigned kx = rb[64 * i]; const bool gt = kx > thr, eq = kx == thr;
                    const unsigned long long meq = __ballot(eq);
                    const bool sel = gt || (eq && (ties + mbcnt64(meq) < need));
                    const unsigned long long msel = __ballot(sel);
                    if (sel) ol[pos + mbcnt64(msel)] = (unsigned short)(64 * i + lane);
                    pos += __popcll(msel); ties += __popcll(meq);
                }
            }
            asm volatile("s_waitcnt lgkmcnt(0)" ::: "memory");
            *((v2u*)(SEL + (size_t)(R0 + ql) * TOPK) + lane) = *(const LAS v2u*)(ol + 4 * lane);
            asm volatile("s_waitcnt lgkmcnt(0)" ::: "memory");
        }
    }
    __syncthreads();
}

typedef short s16x4_t __attribute__((ext_vector_type(4)));
__device__ __forceinline__ s16x4_t tr_read(unsigned addr) { s16x4_t r_; asm volatile("ds_read_b64_tr_b16 %0, %1" : "=v"(r_) : "v"(addr) : "memory"); return r_; }
__device__ __forceinline__ void dma16(const void* src, LAS unsigned char* dst) { __builtin_amdgcn_global_load_lds((const unsigned*)src, (LAS unsigned*)dst, 16, 0, 0); }
constexpr int DSA_WAVE_BYTES = 19968, DSA_PL = 16384, DSA_SIDX = 18432, DSA_QS = 19456;
static_assert(8 * DSA_WAVE_BYTES <= XB_LDS_OFF, "DSA LDS map");

__device__ __forceinline__ void phase_dsa_fast(const Params& p, LAS unsigned char* lds, int G, int wv) {
    const int wave = wv, lane = lane_id();
    const int c16 = lane & 15, kq = lane >> 4;
    unsigned char* ws = p.ws;
    const unsigned char* AQ = ws + WS_AQ; bf16* OA = (bf16*)(ws + WS_OAB);
    const unsigned char* SEL = ws + WS_SEL;
    LAS unsigned char* wl = lds + wave * DSA_WAVE_BYTES;
    LAS unsigned short* Pl = (LAS unsigned short*)(wl + DSA_PL); LAS unsigned short* sidx = (LAS unsigned short*)(wl + DSA_SIDX); LAS unsigned char* Qs = wl + DSA_QS;
    const unsigned ring_addr = (unsigned)(size_t)wl;
    const bool arow = (c16 & 3) == 0; const int ahead = c16 >> 2;
    if (!(G >= 8 && (G & 7) == 0)) return;
    const int nper = (G >> 3) * NWAVES, wi = (blockIdx.x >> 3) * NWAVES + wave, b = blockIdx.x & 7;
    const int nrows = (SEQ - wi + nper - 1) / nper, nsteps = 32 * nrows;
    const unsigned char* KVb = ws + WS_AK + (size_t)b * SEQ * 256;
    const int sw16 = ((lane & 7) ^ (lane >> 3)) * 16, r8 = lane >> 3;
#define DSA_ISSUE(n_) do { const int n__ = (n_); if (n__ < nsteps) { const int item_ = n__ >> 4, sub_ = n__ & 15, c_ = sub_ & 7, it_ = item_ >> 1; \
        const unsigned char* base_ = KVb + ((sub_ >> 3) ? (WS_AV - WS_AK) : 0) + (item_ & 1) * 128 + sw16; \
        const LAS unsigned short* sx_ = sidx + (it_ & 1) * 256 + 32 * c_ + r8; LAS unsigned char* dst_ = wl + (n__ & 3) * 4096; \
        unsigned key_[4]; _Pragma("unroll") for (int i_ = 0; i_ < 4; ++i_) key_[i_] = (unsigned)sx_[8 * i_];       \
        _Pragma("unroll") for (int i_ = 0; i_ < 4; ++i_) dma16(base_ + (size_t)key_[i_] * 256, dst_ + i_ * 1024); } } while (0)
#define DSA_WAIT(n_) do { if ((n_) + 3 < nsteps) asm volatile("s_waitcnt vmcnt(12)" ::: "memory"); else asm volatile("s_waitcnt vmcnt(0)" ::: "memory"); } while (0)
    if (nrows > 0) {
        if (lane < 32) { dma16(SEL + (size_t)(b * SEQ + wi) * 512 + lane * 16, (LAS unsigned char*)sidx); dma16(AQ + (size_t)(b * SEQ + wi) * 1024 + lane * 16, Qs); }
        asm volatile("s_waitcnt vmcnt(0)" ::: "memory");
        if (wi + 1 < TOPK) {
            const int cnt0 = wi + 1; LAS unsigned short* sp = sidx + 4 * lane;
#pragma unroll
            for (int q = 0; q < 4; ++q) if (4 * lane + q >= cnt0) sp[q] = 0;
            asm volatile("s_waitcnt lgkmcnt(0)" ::: "memory");
        }
        DSA_ISSUE(0); DSA_ISSUE(1); DSA_ISSUE(2);
    }
#pragma unroll 1
    for (int item = 0; item < 2 * nrows; ++item) {
        const int it = item >> 1, g = item & 1, t = wi + it * nper, row = b * SEQ + t;
        const int cnt = (t + 1 < TOPK) ? t + 1 : TOPK; const int n0 = 16 * item;
        float sc[16]; bf16x8_t aq[2];
#pragma unroll
        for (int c = 0; c < 8; ++c) {
            DSA_ISSUE(n0 + c + 3); DSA_WAIT(n0 + c);
            if (c == 0) {
#pragma unroll
                for (int c2 = 0; c2 < 2; ++c2) { aq[c2] = (bf16x8_t){0, 0, 0, 0, 0, 0, 0, 0}; if (arow) aq[c2] = *(const LAS bf16x8_t*)(Qs + ahead * 128 + 64 * c2 + 16 * kq); }
            }
            const LAS unsigned char* rb = wl + ((n0 + c) & 3) * 4096;
            bf16x8_t kf[2][2];
#pragma unroll
            for (int kt = 0; kt < 2; ++kt) { const int rr = 16 * kt + c16; const LAS unsigned char* rp = rb + rr * 128;
                kf[kt][0] = *(const LAS bf16x8_t*)(rp + ((kq ^ (rr & 7)) << 4)); kf[kt][1] = *(const LAS bf16x8_t*)(rp + (((4 + kq) ^ (rr & 7)) << 4)); }
#pragma unroll
            for (int kt = 0; kt < 2; ++kt) {
                f32x4_t a = {0.f, 0.f, 0.f, 0.f};
                a = __builtin_amdgcn_mfma_f32_16x16x32_bf16(aq[0], kf[kt][0], a, 0, 0, 0); a = __builtin_amdgcn_mfma_f32_16x16x32_bf16(aq[1], kf[kt][1], a, 0, 0, 0);
                sc[2 * c + kt] = (32 * c + 16 * kt + c16 < cnt) ? a[0] : -INFINITY;
            }
        }
        float mx = sc[0];
#pragma unroll
        for (int i = 1; i < 16; ++i) mx = fmaxf(mx, sc[i]);
        mx = fmaxf(mx, __shfl_xor(mx, 1)); mx = fmaxf(mx, __shfl_xor(mx, 2)); mx = fmaxf(mx, __shfl_xor(mx, 4)); mx = fmaxf(mx, __shfl_xor(mx, 8));
        float sum = 0.f;
#pragma unroll
        for (int i = 0; i < 16; ++i) { sc[i] = fexp2(sc[i] - mx); sum += sc[i]; }
        sum += __shfl_xor(sum, 1); sum += __shfl_xor(sum, 2); sum += __shfl_xor(sum, 4); sum += __shfl_xor(sum, 8);
        const float inv = 1.0f / sum;
#pragma unroll
        for (int i = 0; i < 16; ++i) Pl[kq * 256 + 16 * i + c16] = (unsigned short)f2bf(sc[i]);
        f32x4_t o[4];
#pragma unroll
        for (int dt = 0; dt < 4; ++dt) o[dt] = (f32x4_t){0.f, 0.f, 0.f, 0.f};
#pragma unroll
        for (int c = 0; c < 8; ++c) {
            DSA_ISSUE(n0 + 8 + c + 3); DSA_WAIT(n0 + 8 + c);
            if (c == 0 && item + 1 < 2 * nrows) {
                if (lane < 32) { const int t2 = wi + ((item + 1) >> 1) * nper; dma16(AQ + (size_t)(b * SEQ + t2) * 1024 + ((item + 1) & 1) * 512 + lane * 16, Qs);
                    if (g == 1) dma16(SEL + (size_t)(b * SEQ + t2) * 512 + lane * 16, (LAS unsigned char*)(sidx + ((it + 1) & 1) * 256)); }
            }
            const unsigned rba = ring_addr + (unsigned)(((n0 + 8 + c) & 3) * 4096);
            bf16x8_t pa = (bf16x8_t){0, 0, 0, 0, 0, 0, 0, 0};
            if (arow) { const s16x4_t lo = *(const LAS s16x4_t*)(Pl + ahead * 256 + 32 * c + 4 * kq), hi = *(const LAS s16x4_t*)(Pl + ahead * 256 + 32 * c + 16 + 4 * kq);
                pa = (bf16x8_t){lo[0], lo[1], lo[2], lo[3], hi[0], hi[1], hi[2], hi[3]}; }
            const int r1 = 4 * kq + (c16 >> 2), pp = c16 & 3;
            s16x4_t vlo[4], vhi[4];
#pragma unroll
            for (int dt = 0; dt < 4; ++dt) { const unsigned off = (unsigned)(r1 * 128 + (((2 * dt + (pp >> 1)) ^ (r1 & 7)) << 4) + 8 * (pp & 1)); vlo[dt] = tr_read(rba + off); vhi[dt] = tr_read(rba + off + 16 * 128); }
            asm volatile("s_waitcnt lgkmcnt(0)" : "+v"(vlo[0]), "+v"(vlo[1]), "+v"(vlo[2]), "+v"(vlo[3]), "+v"(vhi[0]), "+v"(vhi[1]), "+v"(vhi[2]), "+v"(vhi[3]) :: "memory");
            __builtin_amdgcn_sched_barrier(0);
#pragma unroll
            for (int dt = 0; dt < 4; ++dt) { const bf16x8_t vb = (bf16x8_t){vlo[dt][0], vlo[dt][1], vlo[dt][2], vlo[dt][3], vhi[dt][0], vhi[dt][1], vhi[dt][2], vhi[dt][3]};
                o[dt] = __builtin_amdgcn_mfma_f32_16x16x32_bf16(pa, vb, o[dt], 0, 0, 0); }
        }
        bf16* op = OA + (size_t)row * 1024 + (4 * g + kq) * 64 + c16;
#pragma unroll
        for (int dt = 0; dt < 4; ++dt) op[16 * dt] = (bf16)f2bf(o[dt][0] * inv);
    }
    asm volatile("s_waitcnt vmcnt(0)" ::: "memory");
#undef DSA_ISSUE
#undef DSA_WAIT
}

typedef float f32x2_t __attribute__((ext_vector_type(2))); typedef __bf16 bf16x2v_t __attribute__((ext_vector_type(2)));
__device__ __forceinline__ unsigned cvtpk_s(float lo, float hi) { f32x2_t v = {lo, hi}; bf16x2v_t b = __builtin_convertvector(v, bf16x2v_t); return __builtin_bit_cast(unsigned, b); }
__device__ __forceinline__ int crow16(int reg, int h) { return (reg & 3) + 8 * (reg >> 2) + 4 * h; }

__device__ __forceinline__ void phase_swa_fast(const Params& p, int G, int wv) {
    const int wave = wv, lane = lane_id(), tid = wave * 64 + lane;
    const int r = lane & 31, h = lane >> 5, hh = wave >> 1, qh = wave & 1;
    unsigned char* ws = p.ws;
    const bf16* BQ = (const bf16*)(ws + WS_BQ); const bf16* BK = (const bf16*)(ws + WS_BK); const bf16* BV = (const bf16*)(ws + WS_BV); bf16* OB = (bf16*)(ws + WS_OAB) + 512;
    for (int k = 0;; ++k) {
        int b, idx;
        if (G >= 8 && (G & 7) == 0) { idx = (blockIdx.x >> 3) + (G >> 3) * k; if (idx >= 64) break; b = blockIdx.x & 7; }
        else { const int u = blockIdx.x + k * G; if (u >= 512) break; b = u >> 6; idx = u & 63; }
        const int qb = idx >> 1, g = idx & 1, head = 4 * g + hh;
        const float sink = p.sinks[head] * LOG2E;
        const bf16* Kb = BK + (size_t)b * SEQ * 128 + g * 64 + 8 * h; const bf16* Vb = BV + (size_t)b * SEQ * 128 + g * 64 + r;
#pragma unroll 1
        for (int qt = 0; qt < 2; ++qt) {
            const int q0 = 128 * qb + 64 * qh + 32 * qt;
            const size_t qrow = (size_t)b * SEQ + q0 + r;
            bf16x8_t qf[4];
#pragma unroll
            for (int s = 0; s < 4; ++s) qf[s] = *(const bf16x8_t*)(BQ + qrow * 512 + head * 64 + 16 * s + 8 * h);
            f32x16_t S[5];
#pragma unroll
            for (int kt = 0; kt < 5; ++kt) {
                const int kb0 = q0 - 128 + 32 * kt; const int krow_ = kb0 + r; const int kc = krow_ < 0 ? 0 : krow_;
                bf16x8_t kf[4];
#pragma unroll
                for (int s = 0; s < 4; ++s) kf[s] = *(const bf16x8_t*)(Kb + (size_t)kc * 128 + 16 * s);
                f32x16_t a = {0.f, 0.f, 0.f, 0.f, 0.f, 0.f, 0.f, 0.f, 0.f, 0.f, 0.f, 0.f, 0.f, 0.f, 0.f, 0.f};
#pragma unroll
                for (int s = 0; s < 4; ++s) a = __builtin_amdgcn_mfma_f32_32x32x16_bf16(kf[s], qf[s], a, 0, 0, 0);
#pragma unroll
                for (int i = 0; i < 16; ++i) { const int key = kb0 + crow16(i, h); const int rel = q0 + r - key; S[kt][i] = (key >= 0 && rel >= 0 && rel < WIN) ? a[i] : -INFINITY; }
            }
            float mx = sink;
#pragma unroll
            for (int kt = 0; kt < 5; ++kt)
#pragma unroll
                for (int i = 0; i < 16; ++i) mx = fmaxf(mx, S[kt][i]);
            mx = fmaxf(mx, __shfl_xor(mx, 32));
            float l = 0.f;
#pragma unroll
            for (int kt = 0; kt < 5; ++kt)
#pragma unroll
                for (int i = 0; i < 16; ++i) { S[kt][i] = fexp2(S[kt][i] - mx); l += S[kt][i]; }
            l += __shfl_xor(l, 32); l += fexp2(sink - mx);
            const float linv = 1.0f / l;
            f32x16_t O0 = {0.f, 0.f, 0.f, 0.f, 0.f, 0.f, 0.f, 0.f, 0.f, 0.f, 0.f, 0.f, 0.f, 0.f, 0.f, 0.f}, O1 = O0;
#pragma unroll
            for (int kt = 0; kt < 5; ++kt) {
                const int kb0 = q0 - 128 + 32 * kt;
#pragma unroll
                for (int s = 0; s < 2; ++s) {
                    v4u pw; pw.x = cvtpk_s(S[kt][8 * s + 0], S[kt][8 * s + 1]); pw.y = cvtpk_s(S[kt][8 * s + 2], S[kt][8 * s + 3]); pw.z = cvtpk_s(S[kt][8 * s + 4], S[kt][8 * s + 5]); pw.w = cvtpk_s(S[kt][8 * s + 6], S[kt][8 * s + 7]);
                    const bf16x8_t pa = __builtin_bit_cast(bf16x8_t, pw);
                    unsigned short v0[8], v1[8];
#pragma unroll
                    for (int j = 0; j < 8; ++j) { int key = kb0 + 16 * s + 8 * (j >> 2) + 4 * h + (j & 3); key = key < 0 ? 0 : key; v0[j] = Vb[(size_t)key * 128]; v1[j] = Vb[(size_t)key * 128 + 32]; }
                    const bf16x8_t vb0 = (bf16x8_t){(short)v0[0], (short)v0[1], (short)v0[2], (short)v0[3], (short)v0[4], (short)v0[5], (short)v0[6], (short)v0[7]};
                    const bf16x8_t vb1 = (bf16x8_t){(short)v1[0], (short)v1[1], (short)v1[2], (short)v1[3], (short)v1[4], (short)v1[5], (short)v1[6], (short)v1[7]};
                    O0 = __builtin_amdgcn_mfma_f32_32x32x16_bf16(pa, vb0, O0, 0, 0, 0); O1 = __builtin_amdgcn_mfma_f32_32x32x16_bf16(pa, vb1, O1, 0, 0, 0);
                }
            }
            bf16* op = OB + ((size_t)b * SEQ + q0) * 1024 + head * 64 + r;
#pragma unroll
            for (int i = 0; i < 16; ++i) { const int qq = crow16(i, h); const float li = __shfl(linv, qq); op[(size_t)qq * 1024] = (bf16)f2bf(O0[i] * li); op[(size_t)qq * 1024 + 32] = (bf16)f2bf(O1[i] * li); }
        }
    }
}

#define XB_TMO      128
#define XB_XCNT(j)  (256  + 64 * (j))
#define XB_XSUB(j)  (1280 + 64 * (j))
#define XB_XGEN(j)  (2304 + 64 * (j))
#define XB_TOP      3328
#define XB_TOPGEN   3392
#define XCD_BAR_WORDS 3456
#define XB_SPIN_CAP (1u << 18)

__device__ __forceinline__ unsigned xb_ld(unsigned* p)              { return __hip_atomic_load(p, __ATOMIC_RELAXED, __HIP_MEMORY_SCOPE_AGENT); }
__device__ __forceinline__ unsigned xb_add(unsigned* p, unsigned v) { return __hip_atomic_fetch_add(p, v, __ATOMIC_RELAXED, __HIP_MEMORY_SCOPE_AGENT); }
__device__ __forceinline__ unsigned xb_xcc_id() { return (unsigned)__builtin_amdgcn_s_getreg((3 << 11) | 20) & 0xFu; }
#define XB_SPIN(cond, bar) do { unsigned _sp = 0; while (cond) { __builtin_amdgcn_s_sleep(1); \
    if ((++_sp & 255u) == 0u) { if (xb_ld(&(bar)[XB_TMO])) break; if (_sp > XB_SPIN_CAP) { atomicAdd(&(bar)[XB_TMO], 1u); break; } } } } while (0)

struct XcdBarrier {
    unsigned* bar; unsigned x;
    volatile LAS unsigned* st;
};

__device__ __forceinline__ XcdBarrier xcd_barrier_post(unsigned* bar, volatile LAS unsigned* st) {
    XcdBarrier b; b.bar = bar; b.x = xb_xcc_id(); b.st = st;
    if (threadIdx.x == 0) (void)xb_add(&bar[XB_XCNT(b.x)], 1u);
    return b;
}
__device__ __forceinline__ void xcd_barrier_complete(unsigned* bar, unsigned x, unsigned& nloc, unsigned& nx) {
    const unsigned G = gridDim.x * gridDim.y * gridDim.z;
    unsigned sum, cnt, mine, sp = 0u;
    for (;;) {
        sum = 0u; cnt = 0u; mine = 0u;
#pragma unroll
        for (unsigned j = 0; j < 16; ++j) { const unsigned c = xb_ld(&bar[XB_XCNT(j)]); sum += c; cnt += (c > 0u) ? 1u : 0u; mine = (j == x) ? c : mine; }
        if (sum == G) break;
        __builtin_amdgcn_s_sleep(1);
        if ((++sp & 255u) == 0u) { if (xb_ld(&bar[XB_TMO])) break; if (sp > XB_SPIN_CAP) { atomicAdd(&bar[XB_TMO], 1u); break; } }
    }
    nloc = mine > 0u ? mine : 1u; nx = cnt > 0u ? cnt : 1u;
}

__device__ __forceinline__ void xcd_barrier(const XcdBarrier& b, int wv) {
    asm volatile("s_waitcnt vmcnt(0)" ::: "memory");
    __syncthreads();
    if (wv == 0 && lane_id() == 0) {
        unsigned* bar = b.bar;
        __builtin_amdgcn_s_waitcnt(0);
        unsigned nloc = b.st[0], nx = b.st[1];
        if (nloc == 0u) { xcd_barrier_complete(bar, b.x, nloc, nx); b.st[0] = nloc; b.st[1] = nx; }
        const unsigned old = xb_add(&bar[XB_XSUB(b.x)], 1u);
        const unsigned gen = old / nloc;
        if (old + 1u == (gen + 1u) * nloc) {
            __builtin_amdgcn_fence(__ATOMIC_RELEASE, "agent");
            asm volatile("s_waitcnt vmcnt(0)" ::: "memory");
            const unsigned og = xb_add(&bar[XB_TOP], 1u);
            const unsigned tg = og / nx;
            if (og + 1u == (tg + 1u) * nx) xb_add(&bar[XB_TOPGEN], 1u);
            else XB_SPIN(xb_ld(&bar[XB_TOPGEN]) == tg, bar);
            __builtin_amdgcn_fence(__ATOMIC_ACQUIRE, "agent");
            xb_add(&bar[XB_XGEN(b.x)], 1u);
            asm volatile("s_waitcnt vmcnt(0)" ::: "memory");
        } else {
            XB_SPIN(xb_ld(&bar[XB_XGEN(b.x)]) == gen, bar);
            __builtin_amdgcn_fence(__ATOMIC_ACQUIRE, "agent");
            asm volatile("s_waitcnt vmcnt(0)" ::: "memory");
        }
    }
    __syncthreads();
}

constexpr int NPHASE = 9;
__global__ void __launch_bounds__(NTHREADS, 2) mk_fwd(Params p) {
    extern __shared__ __attribute__((aligned(16))) unsigned char lds_raw[];
    LAS unsigned char* lds = (LAS unsigned char*)lds_raw;
    const int G = gridDim.x, wv = __builtin_amdgcn_readfirstlane(threadIdx.x >> 6);
    unsigned char* ws = p.ws;
#if MK_ONE_LAUNCH
#define SEAM(k) do { if (rep_ + 1 < REPS(k)) __syncthreads(); else if (lo <= (k) && (k) + 1 < hi) { xcd_barrier(xbar, wv); } } while (0)
#else
#define SEAM(k) do { if (rep_ + 1 < REPS(k)) __syncthreads(); } while (0)
#endif
    const int lo = p.ph_lo, hi = p.ph_hi;
#if MK_ONE_LAUNCH
    if (threadIdx.x == 0) { ((volatile LAS unsigned*)(lds + XB_LDS_OFF))[0] = 0u; ((volatile LAS unsigned*)(lds + XB_LDS_OFF))[1] = 0u; }
    const XcdBarrier xbar = xcd_barrier_post((unsigned*)(ws + WS_BAR), (volatile LAS unsigned*)(lds + XB_LDS_OFF));
#endif
#ifdef PROBE_TS
    unsigned long long* TS = (unsigned long long*)(ws + WS_RSTD1 + 384 * 1024);
#define STAMP(k) do { if (blockIdx.x == 0) TS[k] = __builtin_amdgcn_s_memrealtime(); } while (0)
#else
#define STAMP(k) do { } while (0)
#endif
#if MK_ONE_LAUNCH
    if (p.ph_hi > 1000) cg::this_grid().sync();
#endif
    STAMP(0);
#ifndef PHMASK
#define PHMASK 0x1ffu
#endif
#define IN(k) (((PHMASK >> (k)) & 1u) && lo <= (k) && (k) < hi)
#define REPS(k) (((REP_MASK >> (k)) & 1u) ? 2 : 1)
#define PHASE(k) if (IN(k)) for (int rep_ = 0; rep_ < REPS(k); ++rep_)
    PHASE(0) { phase_prologue(p, lds, G, wv); SEAM(0); STAMP(0 + 1); }
    PHASE(1) {
        pg8::Gemm g{(const bf16*)(ws + WS_XG), (const bf16*)(ws + WS_WIN), TOK, NIN, DM, nullptr, 1 << 30};
        pg8::StaticOrder S; S.init(TOK, NIN, G, (int)blockIdx.x);
        pg8::EpiInProj E{(const float*)(ws + WS_RSTD1), (const float*)(ws + WS_COS), (const float*)(ws + WS_SIN), ws, p.ikw, p.ikb};
        pg8::gemm_phase<pg8::EpiInProj, pg8::StaticOrder, true, true>(lds, g, S, E, wv);
#ifdef PROBE_INPROJ2
#if PROBE_INPROJ2 == 1
        __syncthreads(); pg8::gemm_phase<pg8::EpiInProj, pg8::StaticOrder, true, true>(lds, g, S, E, wv);
#else
        __syncthreads(); { pg8::EpiDummy E2{(bf16*)(ws + 440 * MiB), NIN}; pg8::gemm_phase<pg8::EpiDummy, pg8::StaticOrder, true, true>(lds, g, S, E2, wv); }
#endif
#endif
        SEAM(1); STAMP(1 + 1);
    }
#if MK_SIMPLE_TOPK
    PHASE(2) { phase_topk_simple(p, lds, G, wv); SEAM(2); STAMP(2 + 1); }
#else
    PHASE(2) { phase_topk_fast(p, lds, G, wv); SEAM(2); STAMP(2 + 1); }
#endif
#if MK_SIMPLE_DSA
    PHASE(3) { phase_attn_simple<true, true>(p, lds, G, wv); SEAM(3); STAMP(3 + 1); }
#else
#if MK_SIMPLE_SWA
    PHASE(3) { phase_dsa_fast(p, lds, G, wv); __syncthreads(); phase_attn_simple<false, true>(p, lds, G, wv); SEAM(3); STAMP(3 + 1); }
#else
#ifndef REP_SWA
#define REP_SWA 1
#endif
#ifndef REP_DSA
#define REP_DSA 1
#endif
    PHASE(3) { for (int q_ = 0; q_ < REP_SWA; ++q_) phase_swa_fast(p, G, wv); for (int q_ = 0; q_ < REP_DSA; ++q_) phase_dsa_fast(p, lds, G, wv); SEAM(3); STAMP(3 + 1); }
#endif
#endif
    PHASE(4) {
        pg8::Gemm g{(const bf16*)(ws + WS_OAB), (const bf16*)(ws + WS_WAB), TOK, DM, DM, nullptr, 1 << 30};
        pg8::StaticOrder S; S.init(TOK, DM, G, (int)blockIdx.x);
        pg8::EpiGate2 E{(const bf16*)(ws + WS_GA), (const bf16*)(ws + WS_GB), (bf16*)(ws + WS_MIX)};
        pg8::gemm_phase<pg8::EpiGate2, pg8::StaticOrder, true, true>(lds, g, S, E, wv);
        SEAM(4); STAMP(4 + 1);
    }
    PHASE(5) {
        pg8::Gemm g{(const bf16*)(ws + WS_MIX), (const bf16*)(ws + WS_WOUT), TOK, DM, DM, nullptr, 1 << 30};
        pg8::StaticOrder S; S.init(TOK, DM, G, (int)blockIdx.x);
        pg8::EpiResid<true> E{p.x, p.out, (bf16*)(ws + WS_XG), p.mlp_norm_w, (float*)(ws + (rep_ + 1 < REPS(5) ? WS_PROBE_SS : WS_SS2))};
        pg8::gemm_phase<pg8::EpiResid<true>, pg8::StaticOrder, true, true>(lds, g, S, E, wv);
        SEAM(5); STAMP(5 + 1);
    }
    PHASE(6) {
        pg8::Gemm g{(const bf16*)(ws + WS_XG), (const bf16*)(ws + WS_WUP), TOK, DFF, DM, nullptr, 1 << 30};
        pg8::StaticOrder S; S.init(TOK, DFF, G, (int)blockIdx.x);
        pg8::EpiUp E{(const float*)(ws + WS_SS2), (bf16*)(ws + WS_HID)};
        pg8::gemm_phase<pg8::EpiUp, pg8::StaticOrder, true, true>(lds, g, S, E, wv);
        SEAM(6); STAMP(6 + 1);
    }
    PHASE(7) {
        pg8::Gemm g{(const bf16*)(ws + WS_HID), (const bf16*)(ws + WS_WDN), TOK, DM, DFF, nullptr, 1 << 30};
        pg8::StaticOrder S; S.init(TOK, DM, G, (int)blockIdx.x);
        pg8::EpiResid<false> E{p.out, (rep_ + 1 < REPS(7)) ? (float*)(ws + WS_PROBE_OUT) : p.out, nullptr, nullptr, (float*)(ws + (rep_ + 1 < REPS(7) ? WS_PROBE_SS : WS_SS3))};
        pg8::gemm_phase<pg8::EpiResid<false>, pg8::StaticOrder, true, true>(lds, g, S, E, wv);
        SEAM(7); STAMP(7 + 1);
    }
#ifdef EXTRA_SYNCS
#if MK_ONE_LAUNCH
    for (int es_ = 0; es_ < EXTRA_SYNCS; ++es_) xcd_barrier(xbar, wv);
#endif
#endif
    PHASE(8) { phase_final(p, G, wv, (rep_ + 1 < REPS(8)) ? (float*)(ws + WS_PROBE_OUT) : p.out); }
#undef PHASE
#undef REPS
#undef IN
#undef SEAM
}

extern "C" void kernel_launch(void* const* d_in, const int* in_sizes, int n_in, void* d_out, int out_size, void* d_ws, size_t ws_size, hipStream_t stream) {
    static int grid = 0;
    if (grid == 0) {
        if (n_in != 13 || in_sizes[0] != TOK * DM || out_size != TOK * DM || ws_size < WS_NEED) {
            fprintf(stderr, "kernel_launch: unexpected shapes (n_in %d, in0 %d, out %d, ws %zu); nothing launched\n", n_in, n_in > 0 ? in_sizes[0] : -1, out_size, ws_size); grid = -1; return; }
        int dev = 0, cus = 0, per_cu = 0;
        (void)hipGetDevice(&dev); (void)hipDeviceGetAttribute(&cus, hipDeviceAttributeMultiprocessorCount, dev);
        if (hipFuncSetAttribute((const void*)mk_fwd, hipFuncAttributeMaxDynamicSharedMemorySize, LDS_BYTES) != hipSuccess) { fprintf(stderr, "kernel_launch: hipFuncSetAttribute failed\n"); grid = -1; return; }
        if (hipOccupancyMaxActiveBlocksPerMultiprocessor(&per_cu, (const void*)mk_fwd, NTHREADS, LDS_BYTES) != hipSuccess || per_cu < 1) { fprintf(stderr, "kernel_launch: occupancy query says %d blocks per CU\n", per_cu); per_cu = 1; }
        (void)hipGetLastError();
        if (per_cu > 1) per_cu = 1;
        grid = cus * per_cu;
    }
    if (grid < 0) return;
    Params p{};
    p.x = (const float*)d_in[0]; p.attn_norm_w = (const float*)d_in[1]; p.w_in = (const float*)d_in[2]; p.ikw = (const float*)d_in[3]; p.ikb = (const float*)d_in[4];
    p.sinks = (const float*)d_in[5]; p.w_a = (const float*)d_in[6]; p.w_b = (const float*)d_in[7]; p.w_out = (const float*)d_in[8]; p.mlp_norm_w = (const float*)d_in[9];
    p.w_up = (const float*)d_in[10]; p.w_down = (const float*)d_in[11]; p.final_w = (const float*)d_in[12];
    p.out = (float*)d_out; p.ws = (unsigned char*)d_ws;
    for (int i = 0; i < 32; ++i) p.inv_freq[i] = 1.0f / powf(10000.0f, (float)(2 * i) / 64.0f);
#if MK_ONE_LAUNCH
    if (hipMemsetAsync((char*)d_ws + WS_BAR, 0, 16384, stream) != hipSuccess) { fprintf(stderr, "kernel_launch: hipMemsetAsync of the barrier words failed\n"); return; }
    p.ph_lo = 0; p.ph_hi = NPHASE;
    void* args[] = {&p};
    hipError_t e = hipLaunchCooperativeKernel((const void*)mk_fwd, dim3(grid), dim3(NTHREADS), args, LDS_BYTES, stream);
    if (e != hipSuccess) fprintf(stderr, "kernel_launch: cooperative launch failed: %s (grid %d)\n", hipGetErrorString(e), grid);
#else
    for (int ph = 0; ph < NPHASE; ++ph) {
        p.ph_lo = ph; p.ph_hi = ph + 1;
        hipLaunchKernelGGL(mk_fwd, dim3(grid), dim3(NTHREADS), LDS_BYTES, stream, p);
    }
#endif
}
```

```cpp
#include <hip/hip_runtime.h>
#include <hip/hip_cooperative_groups.h>
#include <cstdio>
#include <cstdint>
namespace cg = cooperative_groups;

#ifndef MK_ONE_LAUNCH
#define MK_ONE_LAUNCH 1
#endif
#ifndef MK_SIMPLE_TOPK
#define MK_SIMPLE_TOPK 0
#endif
#ifndef MK_SIMPLE_SWA
#define MK_SIMPLE_SWA 0
#endif
#ifndef MK_SIMPLE_DSA
#define MK_SIMPLE_DSA 0
#endif

constexpr int NBATCH = 8, SEQ = 4096, DM = 1024, TOK = NBATCH * SEQ, DFF = 4096, TOPK = 256, WIN = 128;
constexpr int NIN = 4352;
constexpr float RMS_EPS = 1e-6f, LN_EPS = 1e-6f;
constexpr float QSCALE = 0.125f * 1.4426950408889634f;
constexpr float LOG2E = 1.4426950408889634f;
constexpr float W_SCALE = 0.04419417382415922f;
constexpr int C_AQ = 0, C_AK = 512, C_AV = 640, C_IQ = 768, C_IK = 1280, C_IW = 1344, C_BQ = 1352, C_BK = 1864, C_BV = 1992, C_GA = 2120, C_GB = 3144, D_IN = 4168;

constexpr size_t MiB = 1u << 20;
constexpr size_t WS_RSTD1 = 0, WS_SS2 = 128 * 1024, WS_SS3 = 256 * 1024;
constexpr size_t WS_BAR = 512 * 1024;
constexpr int XB_LDS_OFF = 163832;
constexpr size_t WS_COS = 1 * MiB, WS_SIN = 1 * MiB + 512 * 1024;
constexpr size_t WS_WIN = 2 * MiB, WS_WAB = 11 * MiB, WS_WOUT = 13 * MiB, WS_WUP = 15 * MiB, WS_WDN = 23 * MiB;
constexpr size_t WS_XG = 32 * MiB;
constexpr size_t WS_AQ = 96 * MiB, WS_IQ = 128 * MiB, WS_BQ = 160 * MiB, WS_AK = 192 * MiB, WS_AV = 200 * MiB, WS_BK = 208 * MiB, WS_BV = 216 * MiB;
constexpr size_t WS_IK = 224 * MiB, WS_IW = 228 * MiB, WS_SEL = 230 * MiB, WS_GA = 248 * MiB, WS_GB = 312 * MiB, WS_MIX = 376 * MiB, WS_END = 440 * MiB;
#ifndef MK_SEPARATE_O
#define MK_SEPARATE_O 0
#endif
#ifndef REP_MASK
#define REP_MASK 0u
#endif
constexpr size_t WS_OAB = 440 * MiB, WS_NEED = 504 * MiB;
constexpr size_t WS_PROBE_SS = 640 * 1024, WS_PROBE_OUT = 376 * MiB;
constexpr size_t WS_HID = 96 * MiB;
static_assert(WS_WIN + (size_t)NIN * DM * 2 <= WS_WAB && WS_HID + (size_t)TOK * DFF * 2 <= WS_MIX, "ws map");

constexpr int LDS_RING = 131072, LDS_BYTES = 163840;

#define GAS __attribute__((address_space(1)))
#define LAS __attribute__((address_space(3)))
typedef unsigned short bf16;
typedef unsigned v4u __attribute__((ext_vector_type(4)));
typedef unsigned v2u __attribute__((ext_vector_type(2)));
typedef float v4f __attribute__((ext_vector_type(4)));

__device__ __forceinline__ float bf2f(unsigned short u) { return __uint_as_float((unsigned)u << 16); }
__device__ __forceinline__ float bflo(unsigned u) { return __uint_as_float(u << 16); }
__device__ __forceinline__ float bfhi(unsigned u) { return __uint_as_float(u & 0xffff0000u); }
__device__ __forceinline__ unsigned f2bf(float f) { unsigned u = __float_as_uint(f); return (u + 0x7fffu + ((u >> 16) & 1u)) >> 16; }
__device__ __forceinline__ unsigned pk2(float lo, float hi) { unsigned r; asm volatile("v_cvt_pk_bf16_f32 %0, %1, %2" : "=v"(r) : "v"(lo), "v"(hi)); return r; }
__device__ __forceinline__ float fexp2(float x) { return __builtin_amdgcn_exp2f(x); }
__device__ __forceinline__ float frsq(float x) { return __builtin_amdgcn_rsqf(x); }
__device__ __forceinline__ float frcp(float x) { return __builtin_amdgcn_rcpf(x); }
__device__ __forceinline__ float sigmoidf_(float x) { return frcp(1.0f + fexp2(-x * LOG2E)); }
__device__ __forceinline__ float wave_sum(float v) {
#pragma unroll
    for (int o = 1; o < 64; o <<= 1) v += __shfl_xor(v, o);
    return v;
}
__device__ __forceinline__ float wave_max(float v) {
#pragma unroll
    for (int o = 1; o < 64; o <<= 1) v = fmaxf(v, __shfl_xor(v, o));
    return v;
}
__device__ __forceinline__ int lane_id() { unsigned m = ~0u; asm volatile("" : "+s"(m)); return __builtin_amdgcn_mbcnt_hi(m, __builtin_amdgcn_mbcnt_lo(m, 0u)); }
__device__ __forceinline__ int tid_op(int wv) { return wv * 64 + lane_id(); }
__device__ __forceinline__ int mbcnt64(unsigned long long m) { return __builtin_amdgcn_mbcnt_hi((unsigned)(m >> 32), __builtin_amdgcn_mbcnt_lo((unsigned)m, 0u)); }

namespace pg8 {
#define PG8_LAS __attribute__((address_space(3)))
typedef unsigned short bf16_t;
typedef short bf16x8 __attribute__((ext_vector_type(8)));
typedef float f32x4 __attribute__((ext_vector_type(4)));
typedef unsigned u32x4 __attribute__((ext_vector_type(4)));
constexpr int BM = 256, BK = 64, HALF = 128, HTB = HALF * BK * 2  , STAGE_BYTES = 8 * HTB, NXCD = 8, WGM = 8;

__host__ __device__ __forceinline__ int lds_byte(int r, int c) { const int st = (r >> 4) * 2 + (c >> 5), rr = r & 15, cc = c & 31, ob = rr * 64 + cc * 2; return st * 1024 + (ob ^ (((ob >> 9) & 1) << 5)); }
__host__ __device__ __forceinline__ void stage_rc(int b, int& R, int& C) { const int st = b / 1024, sb = b % 1024, swz = sb ^ (((sb >> 9) & 1) << 5); R = (st >> 1) * 16 + swz / 64; C = (st & 1) * 32 + (swz % 64) / 2; }
__host__ __device__ __forceinline__ int perm32(int rho) { const int n = rho >> 4, i = rho & 15; return 8 * (i >> 2) + 4 * n + (i & 3); }

struct Unit { int pm, pn; };
struct Gemm { const bf16_t* A; const bf16_t* Bt; int M, N, K; const bf16_t* A2; int asplit;
    __device__ __forceinline__ const char* abase(const Unit& u) const { return (const char*)(u.pn >= asplit ? A2 : A); } };

struct StaticOrder {
    int nM, nN, nwg, G, c;
    __host__ __device__ void init(int M, int N, int G_, int c_) { nM = M / BM; nN = N / BM; nwg = nM * nN; G = G_; c = c_; }
    __host__ __device__ bool next(int i, Unit& u) const {
        const long L = (long)i * G + c; if (L >= nwg) return false;
        int wgid = (int)L; { const int q = nwg / NXCD, r = nwg % NXCD, xcd = wgid % NXCD, off = wgid / NXCD; wgid = (xcd < r ? xcd * (q + 1) : r * (q + 1) + (xcd - r) * q) + off; }
        const int nig = WGM * nN, gid = wgid / nig, fm = gid * WGM, gsz = (nM - fm) < WGM ? (nM - fm) : WGM;
        u.pm = fm + ((wgid % nig) % gsz); u.pn = (wgid % nig) / gsz; return true;
    }
    __device__ __forceinline__ void a_ready(const Unit&) const {}
    __device__ __forceinline__ void done(const Unit&) const {}
};

__device__ __forceinline__ unsigned cvt_pk_bf16(float lo, float hi) { unsigned r; asm volatile("v_cvt_pk_bf16_f32 %0, %1, %2" : "=v"(r) : "v"(lo), "v"(hi)); return r; }
__device__ __forceinline__ u32x4 pack8(const float (&v)[8]) { u32x4 w; w.x = cvt_pk_bf16(v[0], v[1]); w.y = cvt_pk_bf16(v[2], v[3]); w.z = cvt_pk_bf16(v[4], v[5]); w.w = cvt_pk_bf16(v[6], v[7]); return w; }

template <bool NOSIG> struct EpiInProjT {
    static constexpr bool PERM = true, AFTER_DRAIN = false, MID = false;
    const float* rstd1; const float* cs; const float* sn; unsigned char* ws; const float* ikw; const float* ikb;
    __device__ __forceinline__ void operator()(const f32x4 (&acc)[2][2][4][2], const Unit& u, int wr, int wc, int fr_, int fq_) const {
        const int pn = u.pn; int fr = fr_, fq = fq_;
        asm volatile("" : "+v"(fr), "+v"(fq));
#pragma unroll
        for (int ai = 0; ai < 2; ++ai)
#pragma unroll
            for (int m = 0; m < 4; ++m) {
                const int row = u.pm * BM + ai * HALF + wr * 64 + m * 16 + fr;
                const float rs = rstd1[row];
                float x1[8], x2[8];
#pragma unroll
                for (int j = 0; j < 4; ++j) { x1[j] = acc[ai][0][m][0][j] * rs; x1[4 + j] = acc[ai][0][m][1][j] * rs; x2[j] = acc[ai][1][m][0][j] * rs; x2[4 + j] = acc[ai][1][m][1][j] * rs; }
                if (pn >= 9) {
                    bf16_t* G = (bf16_t*)(ws + WS_GA + (size_t)((pn - 9) >> 2) * (WS_GB - WS_GA)) + (size_t)row * 1024 + 256 * ((pn - 9) & 3) + 32 * wc + 8 * fq;
                    float a[8], b[8];
#pragma unroll
                    for (int j = 0; j < 8; ++j) if (NOSIG) { a[j] = x1[j]; b[j] = x2[j]; } else { a[j] = 1.0f / (1.0f + __builtin_amdgcn_exp2f(-x1[j] * 1.4426950408889634f)); b[j] = 1.0f / (1.0f + __builtin_amdgcn_exp2f(-x2[j] * 1.4426950408889634f)); }
                    *(u32x4*)G = pack8(a); *(u32x4*)(G + 128) = pack8(b);
                } else if (pn == 8) {
                    if (wc == 0) {
                        float s = 0.f;
#pragma unroll
                        for (int j = 0; j < 8; ++j) s += x1[j] + x2[j];
                        s += __shfl_xor(s, 16); s += __shfl_xor(s, 32);
                        const float mu = s * (1.0f / 64.0f); float q = 0.f;
#pragma unroll
                        for (int j = 0; j < 8; ++j) { x1[j] -= mu; x2[j] -= mu; q += x1[j] * x1[j] + x2[j] * x2[j]; }
                        q += __shfl_xor(q, 16); q += __shfl_xor(q, 32);
                        const float rstd = __builtin_amdgcn_rsqf(q * (1.0f / 64.0f) + 1e-6f);
                        const int pos = row & 4095; const float* cp = cs + pos * 32 + 8 * fq; const float* sp = sn + pos * 32 + 8 * fq;
                        float o1[8], o2[8];
#pragma unroll
                        for (int j = 0; j < 8; ++j) { const float y1 = x1[j] * rstd * ikw[8 * fq + j] + ikb[8 * fq + j], y2 = x2[j] * rstd * ikw[32 + 8 * fq + j] + ikb[32 + 8 * fq + j];
                            const float c = cp[j], sI = sp[j]; o1[j] = y1 * c - y2 * sI; o2[j] = y2 * c + y1 * sI; }
                        unsigned char* tb = ws + WS_IK + (size_t)(row >> 5) * 4096 + (size_t)(row & 31) * 16;
                        *(u32x4*)(tb + (fq >> 1) * 1024 + (fq & 1) * 512) = pack8(o1); *(u32x4*)(tb + (2 + (fq >> 1)) * 1024 + (fq & 1) * 512) = pack8(o2);
                    } else if (wc == 1 && fq == 0) {
                        float* dst = (float*)(ws + WS_IW) + (size_t)row * 8;
                        *(f32x4*)dst = (f32x4){x1[0], x1[1], x1[2], x1[3]} * 0.04419417382415922f; *(f32x4*)(dst + 4) = (f32x4){x1[4], x1[5], x1[6], x1[7]} * 0.04419417382415922f;
                    }
                } else if (pn >= 6) {
                    bf16_t* Kd = (bf16_t*)(ws + WS_AK + (size_t)(pn - 6) * (WS_BK - WS_AK)); bf16_t* Vd = (bf16_t*)(ws + WS_AV + (size_t)(pn - 6) * (WS_BV - WS_AV));
                    if (wc < 2) {
                        const int pos = row & 4095; const float* cp = cs + pos * 32 + 8 * fq; const float* sp = sn + pos * 32 + 8 * fq;
                        float o1[8], o2[8];
#pragma unroll
                        for (int j = 0; j < 8; ++j) { const float c = cp[j], sI = sp[j]; o1[j] = x1[j] * c - x2[j] * sI; o2[j] = x2[j] * c + x1[j] * sI; }
                        bf16_t* dst = Kd + (size_t)row * 128 + wc * 64 + 8 * fq;
                        *(u32x4*)dst = pack8(o1); *(u32x4*)(dst + 32) = pack8(o2);
                    } else {
                        bf16_t* dst = Vd + (size_t)row * 128 + 32 * (wc - 2) + 8 * fq;
                        *(u32x4*)dst = pack8(x1); *(u32x4*)(dst + 64) = pack8(x2);
                    }
                } else {
                    bf16_t* Q = (bf16_t*)(ws + WS_AQ + (size_t)(pn >> 1) * (WS_IQ - WS_AQ)); const float sc = (pn >= 2 && pn < 4) ? 1.0f : 0.125f * 1.4426950408889634f;
                    const int pos = row & 4095; const float* cp = cs + pos * 32 + 8 * fq; const float* sp = sn + pos * 32 + 8 * fq;
                    float o1[8], o2[8];
#pragma unroll
                    for (int j = 0; j < 8; ++j) { const float c = cp[j], sI = sp[j]; o1[j] = (x1[j] * c - x2[j] * sI) * sc; o2[j] = (x2[j] * c + x1[j] * sI) * sc; }
                    bf16_t* dst = Q + (size_t)row * 512 + (4 * (pn & 1) + wc) * 64 + 8 * fq;
                    *(u32x4*)dst = pack8(o1); *(u32x4*)(dst + 32) = pack8(o2);
                }
                asm volatile("" ::: "memory");
            }
    }
};
typedef EpiInProjT<false> EpiInProj;

struct EpiGate2 {
    static constexpr bool PERM = true, AFTER_DRAIN = false, MID = true;
    const bf16_t *GA, *GB; bf16_t* MIX;
    __device__ __forceinline__ void mid(f32x4 (&acc)[2][2][4][2], const Unit& u, int wr, int wc, int fr_, int fq_) const {
        int fr = fr_, fq = fq_; asm volatile("" : "+v"(fr), "+v"(fq));
#pragma unroll
        for (int ai = 0; ai < 2; ++ai)
#pragma unroll
            for (int m = 0; m < 4; ++m) {
                const int row = u.pm * BM + ai * HALF + wr * 64 + m * 16 + fr;
#pragma unroll
                for (int bj = 0; bj < 2; ++bj) {
                    const size_t off = (size_t)row * 1024 + u.pn * BM + 128 * bj + 32 * wc + 8 * fq;
                    const u32x4 ga = *(const u32x4*)(GA + off), gb = *(const u32x4*)(GB + off);
                    const unsigned aw[4] = {ga.x, ga.y, ga.z, ga.w}, bw[4] = {gb.x, gb.y, gb.z, gb.w};
#pragma unroll
                    for (int q = 0; q < 4; ++q) { const float r0 = __uint_as_float(aw[q] << 16) * __builtin_amdgcn_rcpf(__uint_as_float(bw[q] << 16)), r1 = __uint_as_float(aw[q] & 0xffff0000u) * __builtin_amdgcn_rcpf(__uint_as_float(bw[q] & 0xffff0000u));
                        acc[ai][bj][m][q >> 1][2 * (q & 1)] *= r0; acc[ai][bj][m][q >> 1][2 * (q & 1) + 1] *= r1; }
                }
                if (m & 1) asm volatile("" ::: "memory");
            }
    }
    __device__ __forceinline__ void operator()(const f32x4 (&acc)[2][2][4][2], const Unit& u, int wr, int wc, int fr_, int fq_) const {
        int fr = fr_, fq = fq_; asm volatile("" : "+v"(fr), "+v"(fq));
#pragma unroll
        for (int ai = 0; ai < 2; ++ai)
#pragma unroll
            for (int m = 0; m < 4; ++m) {
                const int row = u.pm * BM + ai * HALF + wr * 64 + m * 16 + fr;
#pragma unroll
                for (int bj = 0; bj < 2; ++bj) {
                    const size_t off = (size_t)row * 1024 + u.pn * BM + 128 * bj + 32 * wc + 8 * fq;
                    const u32x4 gb = *(const u32x4*)(GB + off); const unsigned bw[4] = {gb.x, gb.y, gb.z, gb.w};
                    float v[8];
#pragma unroll
                    for (int q = 0; q < 4; ++q) { v[2 * q] = acc[ai][bj][m][q >> 1][2 * (q & 1)] * __uint_as_float(bw[q] << 16); v[2 * q + 1] = acc[ai][bj][m][q >> 1][2 * (q & 1) + 1] * __uint_as_float(bw[q] & 0xffff0000u); }
                    *(u32x4*)(MIX + off) = pack8(v);
                }
            }
    }
};

struct EpiOut {
    static constexpr bool PERM = false, AFTER_DRAIN = false, MID = false;
    const float* base; bf16_t* XG; const float* gw; float* ss;
    __device__ __forceinline__ void operator()(const f32x4 (&acc)[2][2][4][2], const Unit& u, int wr, int wc, int fr, int fq) const {
#pragma unroll
        for (int ai = 0; ai < 2; ++ai)
#pragma unroll
            for (int m = 0; m < 4; ++m) {
                const int row = u.pm * BM + ai * HALF + wr * 64 + m * 16 + fr; float s = 0.f;
#pragma unroll
                for (int bj = 0; bj < 2; ++bj)
#pragma unroll
                    for (int n = 0; n < 2; ++n) {
                        const int col = u.pn * BM + bj * HALF + wc * 32 + n * 16 + 4 * fq; const size_t off = (size_t)row * 1024 + col;
                        const f32x4 v = *(const f32x4*)(base + off) + acc[ai][bj][m][n];
                        s += (v[0] * v[0] + v[1] * v[1]) + (v[2] * v[2] + v[3] * v[3]);
                        const f32x4 g = *(const f32x4*)(gw + col); unsigned long long w = (unsigned long long)cvt_pk_bf16(v[0] * g[0], v[1] * g[1]) | ((unsigned long long)cvt_pk_bf16(v[2] * g[2], v[3] * g[3]) << 32);
                        *(unsigned long long*)(XG + off) = w;
                    }
                s += __shfl_xor(s, 16); s += __shfl_xor(s, 32);
                if (fq == 0) atomicAdd(ss + row, s);
            }
    }
};
struct EpiDown {
    static constexpr bool PERM = false, AFTER_DRAIN = false, MID = false;
    const bf16_t* XG; const float* gw; float* out; float* ss;
    __device__ __forceinline__ void operator()(const f32x4 (&acc)[2][2][4][2], const Unit& u, int wr, int wc, int fr, int fq) const {
        f32x4 gi[2][2];
#pragma unroll
        for (int bj = 0; bj < 2; ++bj)
#pragma unroll
            for (int n = 0; n < 2; ++n) { const f32x4 g = *(const f32x4*)(gw + u.pn * BM + bj * HALF + wc * 32 + n * 16 + 4 * fq);
                gi[bj][n] = (f32x4){__builtin_amdgcn_rcpf(g[0]), __builtin_amdgcn_rcpf(g[1]), __builtin_amdgcn_rcpf(g[2]), __builtin_amdgcn_rcpf(g[3])}; }
#pragma unroll
        for (int ai = 0; ai < 2; ++ai)
#pragma unroll
            for (int m = 0; m < 4; ++m) {
                const int row = u.pm * BM + ai * HALF + wr * 64 + m * 16 + fr; float s = 0.f;
#pragma unroll
                for (int bj = 0; bj < 2; ++bj)
#pragma unroll
                    for (int n = 0; n < 2; ++n) {
                        const int col = u.pn * BM + bj * HALF + wc * 32 + n * 16 + 4 * fq; const size_t off = (size_t)row * 1024 + col;
                        const unsigned long long w = *(const unsigned long long*)(XG + off); const unsigned lo = (unsigned)w, hi = (unsigned)(w >> 32);
                        const f32x4 x1 = (f32x4){__uint_as_float(lo << 16), __uint_as_float(lo & 0xffff0000u), __uint_as_float(hi << 16), __uint_as_float(hi & 0xffff0000u)} * gi[bj][n];
                        const f32x4 v = x1 + acc[ai][bj][m][n];
                        *(f32x4*)(out + off) = v; s += (v[0] * v[0] + v[1] * v[1]) + (v[2] * v[2] + v[3] * v[3]);
                    }
                s += __shfl_xor(s, 16); s += __shfl_xor(s, 32);
                if (fq == 0) atomicAdd(ss + row, s);
            }
    }
};

struct EpiUp {
    static constexpr bool PERM = true, AFTER_DRAIN = false, MID = false;
    const float* ss; bf16_t* HID;
    __device__ __forceinline__ void operator()(const f32x4 (&acc)[2][2][4][2], const Unit& u, int wr, int wc, int fr, int fq) const {
#pragma unroll
        for (int ai = 0; ai < 2; ++ai)
#pragma unroll
            for (int m = 0; m < 4; ++m) {
                const int row = u.pm * BM + ai * HALF + wr * 64 + m * 16 + fr;
                const float rs = __builtin_amdgcn_rsqf(ss[row] * (1.0f / 1024.0f) + 1e-6f);
#pragma unroll
                for (int bj = 0; bj < 2; ++bj) {
                    float v[8];
#pragma unroll
                    for (int j = 0; j < 4; ++j) { float a = fmaxf(acc[ai][bj][m][0][j] * rs, 0.f), b = fmaxf(acc[ai][bj][m][1][j] * rs, 0.f); v[j] = a * a; v[4 + j] = b * b; }
                    *(u32x4*)(HID + (size_t)row * 4096 + u.pn * BM + bj * HALF + wc * 32 + 8 * fq) = pack8(v);
                }
            }
    }
};

struct BranchOrder {
    int G, c;
    __device__ __forceinline__ bool next(int i, Unit& u) const {
        const int tile = (i >> 1) * G + c; if (tile >= 128 * 4) return false;
        u.pm = tile >> 2; u.pn = (tile & 3) + 4 * (i & 1); return true;
    }
    __device__ __forceinline__ void a_ready(const Unit&) const {}
    __device__ __forceinline__ void done(const Unit&) const {}
};


struct EpiDummy {
    static constexpr bool PERM = true, AFTER_DRAIN = false, MID = false;
    bf16_t* D; int ldc;
    __device__ __forceinline__ void operator()(const f32x4 (&acc)[2][2][4][2], const Unit& u, int wr, int wc, int fr, int fq) const {
#pragma unroll
        for (int ai = 0; ai < 2; ++ai)
#pragma unroll
            for (int m = 0; m < 4; ++m) {
                const int row = (u.pm * BM + ai * HALF + wr * 64 + m * 16 + fr) & 8191;
#pragma unroll
                for (int bj = 0; bj < 2; ++bj) { float v[8];
#pragma unroll
                    for (int j = 0; j < 4; ++j) { v[j] = acc[ai][bj][m][0][j]; v[4 + j] = acc[ai][bj][m][1][j]; }
                    *(u32x4*)(D + (size_t)row * ldc + u.pn * BM + bj * HALF + wc * 32 + 8 * fq) = pack8(v); }
            }
    }
};
template <class Epi, class Sched, bool ALIGN_EPI = false, bool SP2 = false>
__device__ __forceinline__ void gemm_phase(PG8_LAS unsigned char* lds, const Gemm g, const Sched& S, const Epi& E, int wv) {
    const int tid = tid_op(wv), wid = wv, lane = tid & 63, wr = wid >> 2, wc = wid & 3, fr = lane & 15, fq = lane >> 4;
    const int K = g.K, nt = K / BK;
    unsigned voffA[2], voffB[2];
#pragma unroll
    for (int i = 0; i < 2; ++i) { int R, C; stage_rc(tid * 16 + i * 8192, R, C); const int Rb = Epi::PERM ? ((R & ~31) + perm32(R & 31)) : R;
        voffA[i] = (unsigned)(R * K + C) * 2u; voffB[i] = (unsigned)(Rb * K + C) * 2u; }
    const size_t kstep = (size_t)(BK * 2);
    const size_t hstep = (size_t)HALF * K * 2;
    const size_t tstep = 2 * hstep;
    const unsigned ldsw = (unsigned)wid * 1024u;
    const int aoff = lds_byte(wr * 64 + fr, fq * 8), boff = lds_byte(wc * 32 + fr, fq * 8);
#define PG8_SA(b, h) (((b) * 2 + (h)) * HTB)
#define PG8_SB(b, h) ((4 + (b) * 2 + (h)) * HTB)
#define PG8_STAGE(bufoff, gbase, voff) do { _Pragma("unroll") for (int _i = 0; _i < 2; ++_i) \
        __builtin_amdgcn_global_load_lds((const unsigned*)((const char*)(gbase) + (voff)[_i]), (PG8_LAS unsigned*)(lds + (bufoff) + ldsw + _i * 8192), 16, 0, 0); } while (0)
#define PG8_LDA(dst, b, h) do { _Pragma("unroll") for (int m = 0; m < 4; ++m) _Pragma("unroll") for (int k = 0; k < 2; ++k) dst[m][k] = *(const PG8_LAS bf16x8*)(lds + PG8_SA(b, h) + aoff + m * 2048 + k * 1024); } while (0)
#define PG8_LDB(dst, b, h) do { _Pragma("unroll") for (int n = 0; n < 2; ++n) _Pragma("unroll") for (int k = 0; k < 2; ++k) dst[n][k] = *(const PG8_LAS bf16x8*)(lds + PG8_SB(b, h) + boff + n * 2048 + k * 1024); } while (0)
#define PG8_MMA(ai, bj, At, Bt) do { __builtin_amdgcn_s_setprio(1); _Pragma("unroll") for (int m = 0; m < 4; ++m) _Pragma("unroll") for (int n = 0; n < 2; ++n) _Pragma("unroll") for (int k = 0; k < 2; ++k) \
        acc[ai][bj][m][n] = __builtin_amdgcn_mfma_f32_16x16x32_bf16(Bt[n][k], At[m][k], acc[ai][bj][m][n], 0, 0, 0); __builtin_amdgcn_s_setprio(0); } while (0)
#define PG8_WAIT_V(n) asm volatile("s_waitcnt vmcnt(" #n ")" ::: "memory")
#define PG8_WAIT_L(n) asm volatile("s_waitcnt lgkmcnt(" #n ")" ::: "memory")
#define PG8_BAR __builtin_amdgcn_s_barrier()
#define PG8_SCHED __builtin_amdgcn_sched_barrier(0)
    Unit cur, nxt; int ui = 0;
    if (!S.next(0, cur)) return;
    f32x4 acc[2][2][4][2];
#pragma unroll
    for (int a = 0; a < 2; ++a)
#pragma unroll
        for (int b = 0; b < 2; ++b)
#pragma unroll
            for (int m = 0; m < 4; ++m)
#pragma unroll
                for (int n = 0; n < 2; ++n) acc[a][b][m][n] = (f32x4){0.f, 0.f, 0.f, 0.f};
    bf16x8 At[4][2], B0[2][2], B1[2][2];
    const char* cA = g.abase(cur) + (size_t)cur.pm * tstep; const char* cB = (const char*)g.Bt + (size_t)cur.pn * tstep;
    S.a_ready(cur);
    if constexpr (SP2) {
        PG8_STAGE(PG8_SB(0, 0), cB, voffB); PG8_STAGE(PG8_SB(0, 1), cB + hstep, voffB); PG8_STAGE(PG8_SA(0, 0), cA, voffA); PG8_STAGE(PG8_SA(0, 1), cA + hstep, voffA);
        if (wr == 1) PG8_BAR;
        PG8_WAIT_V(2); PG8_BAR;
        PG8_STAGE(PG8_SB(1, 0), cB + kstep, voffB); PG8_STAGE(PG8_SA(1, 0), cA + kstep, voffA); PG8_STAGE(PG8_SB(1, 1), cB + hstep + kstep, voffB);
        PG8_WAIT_V(6); PG8_BAR;
    } else {
        PG8_STAGE(PG8_SB(0, 0), cB, voffB); PG8_STAGE(PG8_SA(0, 0), cA, voffA); PG8_STAGE(PG8_SB(0, 1), cB + hstep, voffB); PG8_STAGE(PG8_SA(0, 1), cA + hstep, voffA);
        if (wr == 1) PG8_BAR;
        PG8_WAIT_V(4); PG8_BAR;
        PG8_STAGE(PG8_SB(1, 0), cB + kstep, voffB); PG8_STAGE(PG8_SA(1, 0), cA + kstep, voffA); PG8_STAGE(PG8_SB(1, 1), cB + hstep + kstep, voffB);
        PG8_WAIT_V(6); PG8_BAR;
    }
    for (;;) {
        const bool has_next = S.next(ui + 1, nxt);
        const char* nA = has_next ? g.abase(nxt) + (size_t)nxt.pm * tstep : cA; const char* nB = has_next ? (const char*)g.Bt + (size_t)nxt.pn * tstep : cB;
        for (int t = 0; t < nt; t += 2) {
            if constexpr (Epi::MID) { if (t == (nt >> 1)) E.mid(acc, cur, wr, wc, fr, fq); }
            const bool last = (t == nt - 2);
            const char* a1 = cA + (size_t)(t + 1) * kstep;
            const char* a2 = last ? nA : cA + (size_t)(t + 2) * kstep; const char* b2 = last ? nB : cB + (size_t)(t + 2) * kstep;
            const char* a3 = a2 + kstep; const char* b3 = b2 + kstep;
            if (last && has_next) S.a_ready(nxt);
            if constexpr (SP2) {
            PG8_LDB(B0, 0, 0); PG8_LDB(B1, 0, 1); PG8_SCHED; PG8_LDA(At, 0, 0); PG8_STAGE(PG8_SA(1, 1), a1 + hstep, voffA);
            PG8_WAIT_V(8); PG8_WAIT_L(0); PG8_BAR; PG8_MMA(0, 0, At, B0); PG8_MMA(0, 1, At, B1); PG8_BAR; PG8_SCHED;
            PG8_LDA(At, 0, 1); PG8_STAGE(PG8_SB(0, 0), b2, voffB); PG8_STAGE(PG8_SB(0, 1), b2 + hstep, voffB); PG8_STAGE(PG8_SA(0, 0), a2, voffA);
            PG8_WAIT_V(8); PG8_WAIT_L(0); PG8_BAR; PG8_MMA(1, 0, At, B0); PG8_MMA(1, 1, At, B1); PG8_BAR; PG8_SCHED;
            PG8_LDB(B0, 1, 0); PG8_LDB(B1, 1, 1); PG8_SCHED; PG8_LDA(At, 1, 0); PG8_STAGE(PG8_SA(0, 1), a2 + hstep, voffA);
            PG8_WAIT_V(8); PG8_WAIT_L(0); PG8_BAR; PG8_MMA(0, 0, At, B0); PG8_MMA(0, 1, At, B1); PG8_BAR; PG8_SCHED;
            PG8_LDA(At, 1, 1); PG8_STAGE(PG8_SB(1, 0), b3, voffB); PG8_STAGE(PG8_SB(1, 1), b3 + hstep, voffB); PG8_STAGE(PG8_SA(1, 0), a3, voffA);
            PG8_WAIT_V(8); PG8_WAIT_L(0); PG8_BAR; PG8_MMA(1, 0, At, B0); PG8_MMA(1, 1, At, B1); PG8_BAR; PG8_SCHED;
            } else {
            PG8_LDB(B0, 0, 0); PG8_SCHED; PG8_LDA(At, 0, 0); PG8_STAGE(PG8_SA(1, 1), a1 + hstep, voffA);
            PG8_WAIT_L(8); PG8_BAR; PG8_WAIT_L(0); PG8_MMA(0, 0, At, B0); PG8_BAR; PG8_SCHED;
            PG8_LDB(B1, 0, 1); PG8_STAGE(PG8_SB(0, 0), b2, voffB);
            PG8_BAR; PG8_WAIT_L(0); PG8_MMA(0, 1, At, B1); PG8_BAR;
            PG8_LDA(At, 0, 1); PG8_STAGE(PG8_SA(0, 0), a2, voffA);
            PG8_BAR; PG8_WAIT_L(0); PG8_MMA(1, 0, At, B0); PG8_BAR; PG8_SCHED;
            PG8_STAGE(PG8_SB(0, 1), b2 + hstep, voffB);
            PG8_WAIT_V(6); PG8_BAR; PG8_MMA(1, 1, At, B1); PG8_BAR;
            PG8_LDB(B0, 1, 0); PG8_SCHED; PG8_LDA(At, 1, 0); PG8_STAGE(PG8_SA(0, 1), a2 + hstep, voffA);
            PG8_WAIT_L(8); PG8_BAR; PG8_WAIT_L(0); PG8_MMA(0, 0, At, B0); PG8_BAR; PG8_SCHED;
            PG8_LDB(B1, 1, 1); PG8_STAGE(PG8_SB(1, 0), b3, voffB);
            PG8_BAR; PG8_WAIT_L(0); PG8_MMA(0, 1, At, B1); PG8_BAR;
            PG8_LDA(At, 1, 1); PG8_STAGE(PG8_SA(1, 0), a3, voffA);
            PG8_BAR; PG8_WAIT_L(0); PG8_MMA(1, 0, At, B0); PG8_BAR; PG8_SCHED;
            PG8_STAGE(PG8_SB(1, 1), b3 + hstep, voffB);
            PG8_WAIT_V(6); PG8_BAR; PG8_MMA(1, 1, At, B1); PG8_BAR;
            }
        }
        if constexpr (ALIGN_EPI) { if (wr == 0) PG8_BAR; }
        if constexpr (!Epi::AFTER_DRAIN) { E(acc, cur, wr, wc, fr, fq); S.done(cur); }
        if (!has_next) break;
#pragma unroll
        for (int a = 0; a < 2; ++a)
#pragma unroll
            for (int b = 0; b < 2; ++b)
#pragma unroll
                for (int m = 0; m < 4; ++m)
#pragma unroll
                    for (int n = 0; n < 2; ++n) acc[a][b][m][n] = (f32x4){0.f, 0.f, 0.f, 0.f};
        cur = nxt; cA = nA; cB = nB; ++ui;
        if constexpr (ALIGN_EPI) { if (wr == 1) PG8_BAR; }
    }
    PG8_WAIT_V(0);
    if constexpr (!ALIGN_EPI) { if (wr == 0) PG8_BAR; }
    PG8_BAR;
    if constexpr (Epi::AFTER_DRAIN) { E.fused(acc, cur, wr, wc, fr, fq, lds, wid, lane); S.done(cur); }
#undef PG8_SA
#undef PG8_SB
#undef PG8_STAGE
#undef PG8_LDA
#undef PG8_LDB
#undef PG8_MMA
#undef PG8_WAIT_V
#undef PG8_WAIT_L
#undef PG8_BAR
#undef PG8_SCHED
}
}
struct Params {
    const float *x, *attn_norm_w, *w_in, *ikw, *ikb, *sinks, *w_a, *w_b, *w_out, *mlp_norm_w, *w_up, *w_down, *final_w;
    float* out; unsigned char* ws;
    float inv_freq[32];
    int ph_lo, ph_hi;
};
constexpr int NWAVES = 8, NTHREADS = 512;

__device__ __forceinline__ int win_src_group(int grp, int& cnt) {
    const int tile = grp >> 3, g = grp & 7; cnt = 32;
    if (tile < 6) { const int base = tile < 2 ? C_AQ : (tile < 4 ? C_IQ : C_BQ); const int head = 4 * (tile & 1) + (g & 3); return base + head * 64 + 32 * (g >> 2); }
    if (tile < 8) { const int kb = tile == 6 ? C_AK : C_BK, vb = tile == 6 ? C_AV : C_BV; const int hf = g >> 2, q = g & 3;
        if (q < 2) return kb + q * 64 + 32 * hf; return vb + 64 * hf + 32 * (q - 2); }
    if (tile == 8) { if (g == 0) return C_IK; if (g == 4) return C_IK + 32; if (g == 1) { cnt = 8; return C_IW; } cnt = 0; return 0; }
    return C_GA + (grp - 72) * 32;
}
__device__ __forceinline__ void p0_transpose_item(const float* W, int ldw, int c0, int cnt, int K, bf16* WT, int n0, int k0, LAS float* scr, int lane, int kd = 0) {
#pragma unroll 8
    for (int i = 0; i < 32; ++i) { const int kk = 2 * i + (lane >> 5), n = lane & 31; scr[kk * 33 + n] = (n < cnt) ? W[(size_t)(k0 + kk) * ldw + c0 + n] : 0.f; }
    asm volatile("s_waitcnt lgkmcnt(0)" ::: "memory");
    const int c = lane & 7;
#pragma unroll
    for (int j = 0; j < 4; ++j) { const int n = (lane >> 3) + 8 * j; const LAS float* s = scr + (8 * c) * 33 + n;
        v4u o; o.x = pk2(s[0 * 33], s[1 * 33]); o.y = pk2(s[2 * 33], s[3 * 33]); o.z = pk2(s[4 * 33], s[5 * 33]); o.w = pk2(s[6 * 33], s[7 * 33]);
        *(v4u*)(WT + (size_t)(n0 + n) * K + kd + k0 + 8 * c) = o; }
    asm volatile("s_waitcnt lgkmcnt(0)" ::: "memory");
}
__device__ __forceinline__ void sincos_d(float angf, float& sn, float& cs) {
    const double a = (double)angf; const double kq = __builtin_rint(a * 0.63661977236758134308);
    const double y = (a - kq * 1.57079632679489655800) - kq * 6.123233995736766e-17; const double y2 = y * y;
    double s = y * (1.0 + y2 * (-1.0 / 6 + y2 * (1.0 / 120 + y2 * (-1.0 / 5040 + y2 * (1.0 / 362880 + y2 * (-1.0 / 39916800 + y2 * (1.0 / 6227020800.0)))))));
    double c = 1.0 + y2 * (-0.5 + y2 * (1.0 / 24 + y2 * (-1.0 / 720 + y2 * (1.0 / 40320 + y2 * (-1.0 / 3628800 + y2 * (1.0 / 479001600.0 + y2 * (-1.0 / 87178291200.0)))))));
    const int q = ((int)kq) & 3;
    const double ss = (q == 0) ? s : (q == 1) ? c : (q == 2) ? -s : -c; const double cc = (q == 0) ? c : (q == 1) ? -s : (q == 2) ? -c : s;
    sn = (float)ss; cs = (float)cc;
}
__device__ __forceinline__ void phase_prologue(const Params& p, LAS unsigned char* lds, int G, int wv) {
    const int wave = wv, lane = lane_id();
    unsigned char* ws = p.ws;
    LAS float* scr = (LAS float*)(lds + wave * 16384);
    const int gw = blockIdx.x * NWAVES + wave, NGW = G * NWAVES;
    constexpr int I_IN = (DM / 64) * (NIN / 32), I_A = (512 / 64) * (DM / 32), I_O = (DM / 64) * (DM / 32), I_U = (DM / 64) * (DFF / 32), I_D = (DFF / 64) * (DM / 32);
    constexpr int NITEMS = I_IN + 2 * I_A + I_O + I_U + I_D;
    for (int it = gw; it < NITEMS; it += NGW) {
        int r = it;
        if (r < I_IN) { const int grp = r % (NIN / 32), kb = r / (NIN / 32); int cnt; const int c0 = win_src_group(grp, cnt);
            p0_transpose_item(p.w_in, D_IN, c0, cnt, DM, (bf16*)(ws + WS_WIN), grp * 32, kb * 64, scr, lane); continue; } r -= I_IN;
        if (r < I_A) { const int nb = r % 32, kb = r / 32; p0_transpose_item(p.w_a, DM, nb * 32, 32, 1024, (bf16*)(ws + WS_WAB), nb * 32, kb * 64, scr, lane); continue; } r -= I_A;
        if (r < I_A) { const int nb = r % 32, kb = r / 32; p0_transpose_item(p.w_b, DM, nb * 32, 32, 1024, (bf16*)(ws + WS_WAB), nb * 32, kb * 64, scr, lane, 512); continue; } r -= I_A;
        if (r < I_O) { const int nb = r % 32, kb = r / 32; p0_transpose_item(p.w_out, DM, nb * 32, 32, DM, (bf16*)(ws + WS_WOUT), nb * 32, kb * 64, scr, lane); continue; } r -= I_O;
        if (r < I_U) { const int nb = r % 128, kb = r / 128; p0_transpose_item(p.w_up, DFF, nb * 32, 32, DM, (bf16*)(ws + WS_WUP), nb * 32, kb * 64, scr, lane); continue; } r -= I_U;
        { const int nb = r % 32, kb = r / 32; p0_transpose_item(p.w_down, DM, nb * 32, 32, DFF, (bf16*)(ws + WS_WDN), nb * 32, kb * 64, scr, lane); }
    }
    float* COS = (float*)(ws + WS_COS); float* SIN = (float*)(ws + WS_SIN);
    for (int i = gw * 64 + lane; i < SEQ * 32; i += NGW * 64) { const int pos = i >> 5, d = i & 31; const float ang = (float)pos * p.inv_freq[d]; float s, c; sincos_d(ang, s, c); COS[i] = c; SIN[i] = s; }
    float* RSTD1 = (float*)(ws + WS_RSTD1); float* SS2 = (float*)(ws + WS_SS2); float* SS3 = (float*)(ws + WS_SS3); bf16* XG = (bf16*)(ws + WS_XG);
    v4f g[4];
#pragma unroll
    for (int j = 0; j < 4; ++j) g[j] = *((const v4f*)p.attn_norm_w + lane + 64 * j);
    int m = gw;
    for (; m + 3 * NGW < TOK; m += 4 * NGW) {
        v4f v[4][4]; float s[4];
#pragma unroll
        for (int q = 0; q < 4; ++q) { const v4f* xr = (const v4f*)(p.x + (size_t)(m + q * NGW) * DM) + lane;
#pragma unroll
            for (int j = 0; j < 4; ++j) v[q][j] = xr[64 * j]; }
#pragma unroll
        for (int q = 0; q < 4; ++q) { s[q] = 0.f;
#pragma unroll
            for (int j = 0; j < 4; ++j) s[q] += (v[q][j].x * v[q][j].x + v[q][j].y * v[q][j].y) + (v[q][j].z * v[q][j].z + v[q][j].w * v[q][j].w);
            s[q] = wave_sum(s[q]);
            unsigned long long* o8 = (unsigned long long*)(XG + (size_t)(m + q * NGW) * DM) + lane;
#pragma unroll
            for (int j = 0; j < 4; ++j) o8[64 * j] = (unsigned long long)pk2(v[q][j].x * g[j].x, v[q][j].y * g[j].y) | ((unsigned long long)pk2(v[q][j].z * g[j].z, v[q][j].w * g[j].w) << 32);
            if (lane == 0) { RSTD1[m + q * NGW] = frsq(s[q] * (1.0f / DM) + RMS_EPS); SS2[m + q * NGW] = 0.f; SS3[m + q * NGW] = 0.f; } }
    }
    for (; m < TOK; m += NGW) {
        const v4f* xr = (const v4f*)(p.x + (size_t)m * DM) + lane; v4f v[4]; float s = 0.f;
#pragma unroll
        for (int j = 0; j < 4; ++j) { v[j] = xr[64 * j]; s += (v[j].x * v[j].x + v[j].y * v[j].y) + (v[j].z * v[j].z + v[j].w * v[j].w); }
        s = wave_sum(s);
        unsigned long long* o8 = (unsigned long long*)(XG + (size_t)m * DM) + lane;
#pragma unroll
        for (int j = 0; j < 4; ++j) o8[64 * j] = (unsigned long long)pk2(v[j].x * g[j].x, v[j].y * g[j].y) | ((unsigned long long)pk2(v[j].z * g[j].z, v[j].w * g[j].w) << 32);
        if (lane == 0) { RSTD1[m] = frsq(s * (1.0f / DM) + RMS_EPS); SS2[m] = 0.f; SS3[m] = 0.f; }
    }
}

__device__ __forceinline__ unsigned f2key(float f) { const unsigned u = __float_as_uint(f); return (u & 0x80000000u) ? ~u : (u | 0x80000000u); }
__device__ __forceinline__ void phase_topk_simple(const Params& p, LAS unsigned char* lds, int G, int wv) {
    const int wave = wv, lane = lane_id();
    unsigned char* ws = p.ws;
    const bf16* IQ = (const bf16*)(ws + WS_IQ); const bf16* IK = (const bf16*)(ws + WS_IK); const float* IW = (const float*)(ws + WS_IW);
    unsigned short* SEL = (unsigned short*)(ws + WS_SEL);
    LAS unsigned* keys = (LAS unsigned*)(lds + wave * 16384);
    LAS float* qf = (LAS float*)(lds + LDS_RING + wave * 2048);
    const int gw = blockIdx.x * NWAVES + wave, NGW = G * NWAVES;
    for (int row = gw; row < TOK; row += NGW) {
        const int b = row >> 12, t = row & 4095, n = t + 1;
        unsigned short* selrow = SEL + (size_t)row * TOPK;
        if (n <= TOPK) { for (int i = lane; i < n; i += 64) selrow[i] = (unsigned short)i; continue; }
        { const v4u q8 = *((const v4u*)(IQ + (size_t)row * 512) + lane);
            LAS float* d = qf + 8 * lane;
            d[0] = bflo(q8.x); d[1] = bfhi(q8.x); d[2] = bflo(q8.y); d[3] = bfhi(q8.y); d[4] = bflo(q8.z); d[5] = bfhi(q8.z); d[6] = bflo(q8.w); d[7] = bfhi(q8.w); }
        float w[8];
#pragma unroll
        for (int h = 0; h < 8; ++h) w[h] = IW[(size_t)row * 8 + h];
        asm volatile("s_waitcnt lgkmcnt(0)" ::: "memory");
        for (int s0 = 0; s0 < n; s0 += 64) {
            const int s = s0 + lane; const int sc = s < n ? s : t;
            const v4u* kp = (const v4u*)(IK + ((size_t)b * SEQ + sc) * 64);
            float dot[8];
#pragma unroll
            for (int h = 0; h < 8; ++h) dot[h] = 0.f;
#pragma unroll
            for (int c = 0; c < 8; ++c) {
                const v4u k8 = kp[c]; float kf[8] = {bflo(k8.x), bfhi(k8.x), bflo(k8.y), bfhi(k8.y), bflo(k8.z), bfhi(k8.z), bflo(k8.w), bfhi(k8.w)};
#pragma unroll
                for (int h = 0; h < 8; ++h) { const v4f qa = *(const LAS v4f*)(qf + h * 64 + c * 8), qb = *(const LAS v4f*)(qf + h * 64 + c * 8 + 4);
                    dot[h] += (kf[0] * qa.x + kf[1] * qa.y) + (kf[2] * qa.z + kf[3] * qa.w) + (kf[4] * qb.x + kf[5] * qb.y) + (kf[6] * qb.z + kf[7] * qb.w); }
            }
            float sc_ = 0.f;
#pragma unroll
            for (int h = 0; h < 8; ++h) sc_ += w[h] * fmaxf(dot[h], 0.f);
            keys[s] = (s < n) ? f2key(sc_) : 0u;
        }
        asm volatile("s_waitcnt lgkmcnt(0)" ::: "memory");
        const int nch = (n + 63) >> 6;
        unsigned thr = 0u;
        for (int bit = 31; bit >= 0; --bit) {
            const unsigned cand = thr | (1u << bit); int cnt = 0;
            for (int c = 0; c < nch; ++c) cnt += __popcll(__ballot(keys[c * 64 + lane] >= cand));
            if (cnt >= TOPK) thr = cand;
        }
        int cgt = 0;
        for (int c = 0; c < nch; ++c) cgt += __popcll(__ballot(keys[c * 64 + lane] > thr));
        const int need = TOPK - cgt; int pos = 0, ties = 0;
        for (int c = 0; c < nch; ++c) {
            const unsigned k = keys[c * 64 + lane]; const bool gt = k > thr, eq = k == thr;
            const unsigned long long meq = __ballot(eq);
            const bool sel = gt || (eq && (ties + mbcnt64(meq) < need));
            const unsigned long long msel = __ballot(sel);
            if (sel) selrow[pos + mbcnt64(msel)] = (unsigned short)(c * 64 + lane);
            pos += __popcll(msel); ties += __popcll(meq);
        }
    }
}

template <bool SINK, class KeyFn>
__device__ __forceinline__ void attend_wave(const bf16* Q, const bf16* K, const bf16* V, bf16* O, int row, int g, int nslots, const KeyFn& keyfn, const float* sinkv,
                                            LAS float* qf  , LAS float* pf  , LAS int* kidx  , int lane) {
    const int b = row >> 12;
    { const v2u q4 = *((const v2u*)(Q + (size_t)row * 512 + g * 256) + lane);
        LAS float* d = qf + 4 * lane; d[0] = bflo(q4.x); d[1] = bfhi(q4.x); d[2] = bflo(q4.y); d[3] = bfhi(q4.y); }
    asm volatile("s_waitcnt lgkmcnt(0)" ::: "memory");
#pragma unroll 1
    for (int j = 0; j < 4; ++j) {
        const int slot = 64 * j + lane; int key = slot < nslots ? keyfn(slot) : -1; kidx[slot] = key;
        const bool valid = key >= 0; const int kc = valid ? key : 0;
        const v4u* kp = (const v4u*)(K + ((size_t)b * SEQ + kc) * 128 + g * 64);
        float dot[4] = {0.f, 0.f, 0.f, 0.f};
        if (64 * j < nslots) {
#pragma unroll 2
            for (int c = 0; c < 8; ++c) {
                const v4u k8 = kp[c]; float kf[8] = {bflo(k8.x), bfhi(k8.x), bflo(k8.y), bfhi(k8.y), bflo(k8.z), bfhi(k8.z), bflo(k8.w), bfhi(k8.w)};
#pragma unroll
                for (int h = 0; h < 4; ++h) { const v4f qa = *(const LAS v4f*)(qf + h * 64 + c * 8), qb = *(const LAS v4f*)(qf + h * 64 + c * 8 + 4);
                    dot[h] += (kf[0] * qa.x + kf[1] * qa.y) + (kf[2] * qa.z + kf[3] * qa.w) + (kf[4] * qb.x + kf[5] * qb.y) + (kf[6] * qb.z + kf[7] * qb.w); }
            }
        }
        *(LAS v4f*)(pf + slot * 4) = valid ? (v4f){dot[0], dot[1], dot[2], dot[3]} : (v4f){-INFINITY, -INFINITY, -INFINITY, -INFINITY};
    }
    asm volatile("s_waitcnt lgkmcnt(0)" ::: "memory");
    float lg[4][4];
#pragma unroll
    for (int j = 0; j < 4; ++j) { const v4f t4 = *(const LAS v4f*)(pf + (64 * j + lane) * 4); lg[j][0] = t4.x; lg[j][1] = t4.y; lg[j][2] = t4.z; lg[j][3] = t4.w; }
    float inv[4];
#pragma unroll
    for (int h = 0; h < 4; ++h) {
        float mx = fmaxf(fmaxf(lg[0][h], lg[1][h]), fmaxf(lg[2][h], lg[3][h])); mx = wave_max(mx);
        float sk = 0.f; if (SINK) { sk = sinkv[g * 4 + h] * LOG2E; mx = fmaxf(mx, sk); }
        float s = 0.f;
#pragma unroll
        for (int j = 0; j < 4; ++j) { const float e = fexp2(lg[j][h] - mx); lg[j][h] = e; s += e; }
        s = wave_sum(s); if (SINK) s += fexp2(sk - mx);
        inv[h] = 1.0f / s;
    }
#pragma unroll
    for (int j = 0; j < 4; ++j) *(LAS v4f*)(pf + (64 * j + lane) * 4) = (v4f){lg[j][0], lg[j][1], lg[j][2], lg[j][3]};
    asm volatile("s_waitcnt lgkmcnt(0)" ::: "memory");
    float o[4] = {0.f, 0.f, 0.f, 0.f};
    const bf16* Vb = V + (size_t)b * SEQ * 128 + g * 64 + lane;
#pragma unroll 1
    for (int s0 = 0; s0 < nslots; s0 += 8) {
        float vv[8]; v4f pp[8];
#pragma unroll
        for (int i = 0; i < 8; ++i) { const int slot = s0 + i; const int key = slot < nslots ? kidx[slot] : -1; pp[i] = *(const LAS v4f*)(pf + (slot & 255) * 4);
            vv[i] = key >= 0 ? bf2f(Vb[(size_t)key * 128]) : 0.f; if (key < 0) pp[i] = (v4f){0.f, 0.f, 0.f, 0.f}; }
#pragma unroll
        for (int i = 0; i < 8; ++i) { o[0] += pp[i].x * vv[i]; o[1] += pp[i].y * vv[i]; o[2] += pp[i].z * vv[i]; o[3] += pp[i].w * vv[i]; }
    }
    bf16* op = O + (size_t)row * 512 + g * 256 + lane;
#pragma unroll
    for (int h = 0; h < 4; ++h) op[h * 64] = (bf16)f2bf(o[h] * inv[h]);
}
struct SelKey { const unsigned short* selrow; __device__ __forceinline__ int operator()(int slot) const { return (int)selrow[slot]; } };
struct WinKey { int t; __device__ __forceinline__ int operator()(int slot) const { return t - (WIN - 1) + slot; } };

template <bool DO_DSA, bool DO_SWA>
__device__ __forceinline__ void phase_attn_simple(const Params& p, LAS unsigned char* lds, int G, int wv) {
    const int wave = wv, lane = lane_id();
    unsigned char* ws = p.ws;
    LAS float* qf = (LAS float*)(lds + wave * 16384); LAS float* pf = qf + 256; LAS int* kidx = (LAS int*)(pf + 1024);
    const int gw = blockIdx.x * NWAVES + wave, NGW = G * NWAVES;
    const unsigned short* SEL = (const unsigned short*)(ws + WS_SEL);
    for (int item = gw; item < TOK * 2; item += NGW) {
        const int row = item >> 1, g = item & 1, t = row & 4095;
        if (DO_DSA) { SelKey kf{SEL + (size_t)row * TOPK}; const int ns = (t + 1 < TOPK) ? t + 1 : TOPK;
            attend_wave<false>((const bf16*)(ws + WS_AQ), (const bf16*)(ws + WS_AK), (const bf16*)(ws + WS_AV), (bf16*)(ws + WS_AQ), row, g, ns, kf, nullptr, qf, pf, kidx, lane); }
        if (DO_SWA) { WinKey kf{t};
            attend_wave<true>((const bf16*)(ws + WS_BQ), (const bf16*)(ws + WS_BK), (const bf16*)(ws + WS_BV), (bf16*)(ws + WS_BQ), row, g, WIN, kf, p.sinks, qf, pf, kidx, lane); }
    }
}

__device__ __forceinline__ void phase_final(const Params& p, int G, int wv, float* dst) {
    const int wave = wv, lane = lane_id();
    const float* SS3 = (const float*)(p.ws + WS_SS3);
    const int gw = blockIdx.x * NWAVES + wave, NGW = G * NWAVES;
    v4f g[4];
#pragma unroll
    for (int j = 0; j < 4; ++j) g[j] = *((const v4f*)p.final_w + lane + 64 * j);
    for (int m = gw; m < TOK; m += NGW) {
        float rs = frsq(SS3[m] * (1.0f / DM) + RMS_EPS);
#ifdef PROBE_TS
        { const unsigned long long* TS = (const unsigned long long*)(p.ws + WS_RSTD1 + 384 * 1024); rs *= 1.0f + (float)(TS[PROBE_TS + 1] - TS[PROBE_TS]) * 1.0e-5f; }
#endif
        const v4f* xr = (const v4f*)(p.out + (size_t)m * DM) + lane; v4f* xo = (v4f*)(dst + (size_t)m * DM) + lane;
#pragma unroll
        for (int j = 0; j < 4; ++j) { v4f v = xr[64 * j]; xo[64 * j] = v * g[j] * rs; }
    }
}

typedef short bf16x8_t __attribute__((ext_vector_type(8)));
typedef float f32x16_t __attribute__((ext_vector_type(16)));
typedef float f32x4_t __attribute__((ext_vector_type(4)));
typedef float f32x2_t __attribute__((ext_vector_type(2)));
__device__ __forceinline__ unsigned f16key(float f) { const int q = (int)__builtin_rintf(f * 4096.0f) + 32768; return (unsigned)(q < 256 ? 256 : (q > 65535 ? 65535 : q)); }
__device__ __forceinline__ float relu1(float x) { return __builtin_amdgcn_fmed3f(x, 0.f, 3.0e38f); }
constexpr int TK_H1 = LDS_RING, TK_WAVE = LDS_RING + 8192, TK_WAVE_BYTES = 3072, TK_CAND = 512;
static_assert(TK_WAVE + 8 * TK_WAVE_BYTES <= LDS_BYTES, "top-k LDS map");

__device__ __forceinline__ void phase_topk_fast(const Params& p, LAS unsigned char* lds, int G, int wv) {
    const int wave = wv, lane = lane_id(), tid = wave * 64 + lane;
    const int r = lane & 31, h = lane >> 5, mt = wave & 3, par = wave >> 2;
    unsigned char* ws = p.ws;
    const bf16* IQ = (const bf16*)(ws + WS_IQ); const bf16* IK = (const bf16*)(ws + WS_IK); const float* IW = (const float*)(ws + WS_IW);
    unsigned short* SEL = (unsigned short*)(ws + WS_SEL);
    LAS unsigned short* kb = (LAS unsigned short*)lds;
    LAS unsigned* H1 = (LAS unsigned*)(lds + TK_H1);
    LAS unsigned* cl = (LAS unsigned*)(lds + TK_WAVE + wave * TK_WAVE_BYTES); LAS unsigned short* ol = (LAS unsigned short*)(lds + TK_WAVE + wave * TK_WAVE_BYTES + 4 * TK_CAND);
    const int qrow = 4 * mt + 2 * ((r >> 2) & 1) + (r >> 4), qhead = 4 * ((r >> 3) & 1) + (r & 3);
    { LAS v4u* hz = (LAS v4u*)H1; hz[tid] = (v4u){0u, 0u, 0u, 0u}; }
    for (int k = 0;; ++k) {
        int b, tile;
        if (G == 256) { if (k >= 8) break; const int c = blockIdx.x, i = c >> 3, grp = k >> 1; b = c & 7; tile = (k & 1) ? (64 * grp + 63 - i) : (64 * grp + i); }
        else { const int u = blockIdx.x + k * G; if (u >= TOK / 16) break; b = u >> 8; tile = u & 255; }
        const int t0 = tile * 16, R0 = b * SEQ + t0;
        if (t0 + 16 <= TOPK) {
            for (int i = tid; i < 16 * TOPK; i += NTHREADS) { const int ql = i >> 8, s = i & 255; if (s <= t0 + ql) SEL[(size_t)(R0 + ql) * TOPK + s] = (unsigned short)s; }
            continue;
        }
        bf16x8_t aq[4];
#pragma unroll
        for (int s = 0; s < 4; ++s) aq[s] = *(const bf16x8_t*)(IQ + (size_t)(R0 + qrow) * 512 + qhead * 64 + 16 * s + 8 * h);
        f32x2_t wq[2][4];
#pragma unroll
        for (int qq = 0; qq < 2; ++qq) { const f32x4_t w0 = *(const f32x4_t*)(IW + (size_t)(R0 + 4 * mt + 2 * h + qq) * 8), w1 = *(const f32x4_t*)(IW + (size_t)(R0 + 4 * mt + 2 * h + qq) * 8 + 4);
            const float n2 = (w0[0] * w0[0] + w0[1] * w0[1]) + (w0[2] * w0[2] + w0[3] * w0[3]) + (w1[0] * w1[0] + w1[1] * w1[1]) + (w1[2] * w1[2] + w1[3] * w1[3]);
            const float sn = __builtin_amdgcn_rsqf(fmaxf(n2, 1e-30f)) * 0.2141f;
            wq[qq][0] = (f32x2_t){w0[0], w0[1]} * sn; wq[qq][1] = (f32x2_t){w0[2], w0[3]} * sn; wq[qq][2] = (f32x2_t){w1[0], w1[1]} * sn; wq[qq][3] = (f32x2_t){w1[2], w1[3]} * sn; }
        const int ntile = (t0 + 16 + 31) >> 5, ntp = (ntile + 7) & ~7, nch = (t0 + 16 + 511) >> 9;
        const char* kbase = (const char*)IK + (size_t)b * SEQ * 128;
        const unsigned voff = (unsigned)(lane * 16);
        const int tq0 = t0 + 4 * mt + 2 * h;
        const int ql0 = 4 * mt + 2 * h;
        LAS unsigned short* row0 = kb + ql0 * 4096; LAS unsigned* h0 = H1 + ql0 * 128;
        __syncthreads();
#define TK_LOAD(dst, kt_) do { const int ktc_ = (kt_) < 127 ? (kt_) : 127; const char* tp_ = kbase + (size_t)ktc_ * 4096; _Pragma("unroll") for (int s_ = 0; s_ < 4; ++s_) dst[s_] = *(const bf16x8_t*)(tp_ + voff + 1024 * s_); } while (0)
#define TK_MMA(acc_, src) do { acc_ = (f32x16_t){0.f, 0.f, 0.f, 0.f, 0.f, 0.f, 0.f, 0.f, 0.f, 0.f, 0.f, 0.f, 0.f, 0.f, 0.f, 0.f}; \
            _Pragma("unroll") for (int s_ = 0; s_ < 4; ++s_) acc_ = __builtin_amdgcn_mfma_f32_32x32x16_bf16(aq[s_], src[s_], acc_, 0, 0, 0); } while (0)
#define TK_POST(acc_, kt_) do { f32x2_t s0_ = {0.f, 0.f}, s1_ = {0.f, 0.f}; \
            _Pragma("unroll") for (int hd_ = 0; hd_ < 4; ++hd_) { s0_ += (f32x2_t){relu1(acc_[2 * hd_]), relu1(acc_[2 * hd_ + 1])} * wq[0][hd_]; s1_ += (f32x2_t){relu1(acc_[8 + 2 * hd_]), relu1(acc_[9 + 2 * hd_])} * wq[1][hd_]; } \
            const int e_ = 32 * (kt_) + r; const unsigned k0_ = (e_ <= tq0) ? f16key(s0_.x + s0_.y) : 0u, k1_ = (e_ <= tq0 + 1) ? f16key(s1_.x + s1_.y) : 0u; \
            row0[e_] = (unsigned short)k0_; row0[4096 + e_] = (unsigned short)k1_; \
            if (k0_) __hip_atomic_fetch_add(h0 + (k0_ >> 9), 1u << ((k0_ >> 4) & 16u), __ATOMIC_RELAXED, __HIP_MEMORY_SCOPE_WORKGROUP); \
            if (k1_) __hip_atomic_fetch_add(h0 + 128 + (k1_ >> 9), 1u << ((k1_ >> 4) & 16u), __ATOMIC_RELAXED, __HIP_MEMORY_SCOPE_WORKGROUP); } while (0)
#ifndef TK_REP_SCORE
#define TK_REP_SCORE 1
#endif
#ifndef TK_REP_SEL
#define TK_REP_SEL 1
#endif
#pragma unroll 1
        for (int rp_ = 0; rp_ < TK_REP_SCORE; ++rp_) {
            if (rp_ > 0) { __syncthreads(); LAS v4u* hz = (LAS v4u*)H1; hz[tid] = (v4u){0u, 0u, 0u, 0u}; __syncthreads(); }
            bf16x8_t B[4][4]; f32x16_t accA, accB;
            const int nmy = ntp >> 1;
#pragma unroll
            for (int u = 0; u < 4; ++u) TK_LOAD(B[u], par + 2 * u);
            TK_MMA(accA, B[0]);
#pragma unroll 1
            for (int i = 0; i < nmy; i += 4) {
                const int kt = par + 2 * i;
                TK_MMA(accB, B[1]); TK_POST(accA, kt);     TK_LOAD(B[0], kt + 8);
                TK_MMA(accA, B[2]); TK_POST(accB, kt + 2); TK_LOAD(B[1], kt + 10);
                TK_MMA(accB, B[3]); TK_POST(accA, kt + 4); TK_LOAD(B[2], kt + 12);
                TK_MMA(accA, B[0]); TK_POST(accB, kt + 6); TK_LOAD(B[3], kt + 14);
            }
        }
#undef TK_LOAD
#undef TK_MMA
#undef TK_POST
        if (32 * ntp < 512 * nch) {
#pragma unroll
            for (int qi = 0; qi < 2; ++qi) { LAS v2u* z = (LAS v2u*)(kb + (2 * wave + qi) * 4096 + 32 * ntp) + lane; *z = (v2u){0u, 0u}; }
        }
        __syncthreads();
#pragma unroll 1
        for (int qi = 0; qi < 2 * TK_REP_SEL; ++qi) {
            const int ql = 2 * wave + (qi & 1);
            const LAS unsigned short* rb = kb + ql * 4096 + lane;
            const v2u hw = *(const LAS v2u*)(H1 + ql * 128 + 2 * lane); const v4u hv = {hw.x & 0xffffu, hw.x >> 16, hw.y & 0xffffu, hw.y >> 16};
            if ((qi >> 1) + 1 == TK_REP_SEL) *(LAS v2u*)(H1 + ql * 128 + 2 * lane) = (v2u){0u, 0u};
            const int hs = (int)(hv.x + hv.y + hv.z + hv.w); int S = hs;
#pragma unroll
            for (int off = 1; off < 64; off <<= 1) { const int v = __shfl_down(S, off); if (lane + off < 64) S += v; }
            int ab = S - hs; const bool cross = ab < TOPK && S >= TOPK;
            int Bl = 4 * lane + 3;
            if (ab + (int)hv.w < TOPK) { ab += (int)hv.w; Bl = 4 * lane + 2; if (ab + (int)hv.z < TOPK) { ab += (int)hv.z; Bl = 4 * lane + 1; if (ab + (int)hv.y < TOPK) { ab += (int)hv.y; Bl = 4 * lane; } } }
            const unsigned long long mc = __ballot(cross);
            const int src = mc ? (__ffsll((long long)mc) - 1) : 0;
            const unsigned Bb = (unsigned)__shfl(Bl, src);
            const unsigned kmin = Bb << 8; int m = 0;
#pragma unroll 1
            for (int j = 0; j < nch; ++j) {
                unsigned kk[8];
#pragma unroll
                for (int s = 0; s < 8; ++s) kk[s] = rb[512 * j + 64 * s];
#pragma unroll
                for (int s = 0; s < 8; ++s) {
                    const bool in = kk[s] >= kmin;
                    const unsigned long long mi = __ballot(in);
                    if (in) { const int ci = m + mbcnt64(mi); if (ci < TK_CAND) cl[ci] = (kk[s] << 16) | (unsigned)(512 * j + 64 * s + lane); }
                    m += __popcll(mi);
                }
            }
            asm volatile("s_waitcnt lgkmcnt(0)" ::: "memory");
            int pos = 0;
            if (mc != 0ull && m <= TK_CAND && m >= TOPK) {
                unsigned ent[8]; bool val[8];
#pragma unroll
                for (int q = 0; q < 8; ++q) { val[q] = 64 * q + lane < m; ent[q] = val[q] ? cl[64 * q + lane] : 0u; }
                int nab = 0;
#pragma unroll
                for (int q = 0; q < 8; ++q) nab += __popcll(__ballot(val[q] && (ent[q] >> 24) > Bb));
                const int need2 = TOPK - nab;
                unsigned thr2 = 0u;
#pragma unroll 1
                for (int bit = 7; bit >= 0; --bit) {
                    const unsigned cand = thr2 | (1u << bit); int cnt = 0;
#pragma unroll
                    for (int q = 0; q < 8; ++q) cnt += __popcll(__ballot(val[q] && (ent[q] >> 24) == Bb && ((ent[q] >> 16) & 0xffu) >= cand));
                    if (cnt >= need2) thr2 = cand;
                }
                const unsigned kthr = (Bb << 8) | thr2;
                int cgt2 = 0;
#pragma unroll
                for (int q = 0; q < 8; ++q) cgt2 += __popcll(__ballot(val[q] && (ent[q] >> 16) > kthr));
                const int need3 = TOPK - cgt2; int ties = 0;
#pragma unroll
                for (int q = 0; q < 8; ++q) {
                    const unsigned kx = ent[q] >> 16; const bool gt = val[q] && kx > kthr, eq = val[q] && kx == kthr;
                    const unsigned long long meq = __ballot(eq);
                    const bool sel = gt || (eq && (ties + mbcnt64(meq) < need3));
                    const unsigned long long msel = __ballot(sel);
                    if (sel) ol[pos + mbcnt64(msel)] = (unsigned short)(ent[q] & 0xffffu);
                    pos += __popcll(msel); ties += __popcll(meq);
                }
            } else {
                unsigned thr = 0u;
#pragma unroll 1
                for (int bit = 15; bit >= 0; --bit) {
                    const unsigned cand = thr | (1u << bit); int cnt = 0;
#pragma unroll 1
                    for (int i = 0; i < 8 * nch; ++i) cnt += __popcll(__ballot((unsigned)rb[64 * i] >= cand));
                    if (cnt >= TOPK) thr = cand;
                }
                int cgt = 0;
#pragma unroll 1
                for (int i = 0; i < 8 * nch; ++i) cgt += __popcll(__ballot((unsigned)rb[64 * i] > thr));
                const int need = TOPK - cgt; int ties = 0; pos = 0;
#pragma unroll 1
                for (int i = 0; i < 8 * nch; ++i) {
                    const unsigned kx = rb[64 * i]; const bool gt = kx > thr, eq = kx == thr;
                    const unsigned long long meq = __ballot(eq);
                    const bool sel = gt || (eq && (ties + mbcnt64(meq) < need));
                    const unsigned long long msel = __ballot(sel);
                    if (sel) ol[pos + mbcnt64(msel)] = (unsigned short)(64 * i + lane);
                    pos += __popcll(msel); ties += __popcll(meq);
                }
            }
            asm volatile("s_waitcnt lgkmcnt(0)" ::: "memory");
            *((v2u*)(SEL + (size_t)(R0 + ql) * TOPK) + lane) = *(const LAS v2u*)(ol + 4 * lane);
            asm volatile("s_waitcnt lgkmcnt(0)" ::: "memory");
        }
    }
    __syncthreads();
}

typedef short s16x4_t __attribute__((ext_vector_type(4)));
__device__ __forceinline__ s16x4_t tr_read(unsigned addr) { s16x4_t r_; asm volatile("ds_read_b64_tr_b16 %0, %1" : "=v"(r_) : "v"(addr) : "memory"); return r_; }
__device__ __forceinline__ void dma16(const void* src, LAS unsigned char* dst) { __builtin_amdgcn_global_load_lds((const unsigned*)src, (LAS unsigned*)dst, 16, 0, 0); }
constexpr int DSA_WAVE_BYTES = 19968, DSA_PL = 16384, DSA_SIDX = 18432, DSA_QS = 19456;
static_assert(8 * DSA_WAVE_BYTES <= XB_LDS_OFF, "DSA LDS map");

__device__ __forceinline__ void phase_dsa_fast(const Params& p, LAS unsigned char* lds, int G, int wv) {
    const int wave = wv, lane = lane_id();
    const int c16 = lane & 15, kq = lane >> 4;
    unsigned char* ws = p.ws;
    const unsigned char* AQ = ws + WS_AQ; bf16* OA = (bf16*)(ws + WS_OAB);
    const unsigned char* SEL = ws + WS_SEL;
    LAS unsigned char* wl = lds + wave * DSA_WAVE_BYTES;
    LAS unsigned short* Pl = (LAS unsigned short*)(wl + DSA_PL); LAS unsigned short* sidx = (LAS unsigned short*)(wl + DSA_SIDX); LAS unsigned char* Qs = wl + DSA_QS;
    const unsigned ring_addr = (unsigned)(size_t)wl;
    const bool arow = (c16 & 3) == 0; const int ahead = c16 >> 2;
    if (!(G >= 8 && (G & 7) == 0)) return;
    const int nper = (G >> 3) * NWAVES, wi = (blockIdx.x >> 3) * NWAVES + wave, b = blockIdx.x & 7;
    const int nrows = (SEQ - wi + nper - 1) / nper, nsteps = 32 * nrows;
    const unsigned char* KVb = ws + WS_AK + (size_t)b * SEQ * 256;
    const int sw16 = ((lane & 7) ^ (lane >> 3)) * 16, r8 = lane >> 3;
#define DSA_ISSUE(n_) do { const int n__ = (n_); if (n__ < nsteps) { const int item_ = n__ >> 4, sub_ = n__ & 15, c_ = sub_ & 7, it_ = item_ >> 1; \
        const unsigned char* base_ = KVb + ((sub_ >> 3) ? (WS_AV - WS_AK) : 0) + (item_ & 1) * 128 + sw16; \
        const LAS unsigned short* sx_ = sidx + (it_ & 1) * 256 + 32 * c_ + r8; LAS unsigned char* dst_ = wl + (n__ & 3) * 4096; \
        unsigned key_[4]; _Pragma("unroll") for (int i_ = 0; i_ < 4; ++i_) key_[i_] = (unsigned)sx_[8 * i_];       \
        _Pragma("unroll") for (int i_ = 0; i_ < 4; ++i_) dma16(base_ + (size_t)key_[i_] * 256, dst_ + i_ * 1024); } } while (0)
#define DSA_WAIT(n_) do { if ((n_) + 3 < nsteps) asm volatile("s_waitcnt vmcnt(12)" ::: "memory"); else asm volatile("s_waitcnt vmcnt(0)" ::: "memory"); } while (0)
    if (nrows > 0) {
        if (lane < 32) { dma16(SEL + (size_t)(b * SEQ + wi) * 512 + lane * 16, (LAS unsigned char*)sidx); dma16(AQ + (size_t)(b * SEQ + wi) * 1024 + lane * 16, Qs); }
        asm volatile("s_waitcnt vmcnt(0)" ::: "memory");
        if (wi + 1 < TOPK) {
            const int cnt0 = wi + 1; LAS unsigned short* sp = sidx + 4 * lane;
#pragma unroll
            for (int q = 0; q < 4; ++q) if (4 * lane + q >= cnt0) sp[q] = 0;
            asm volatile("s_waitcnt lgkmcnt(0)" ::: "memory");
        }
        DSA_ISSUE(0); DSA_ISSUE(1); DSA_ISSUE(2);
    }
#pragma unroll 1
    for (int item = 0; item < 2 * nrows; ++item) {
        const int it = item >> 1, g = item & 1, t = wi + it * nper, row = b * SEQ + t;
        const int cnt = (t + 1 < TOPK) ? t + 1 : TOPK; const int n0 = 16 * item;
        float sc[16]; bf16x8_t aq[2];
#pragma unroll
        for (int c = 0; c < 8; ++c) {
            DSA_ISSUE(n0 + c + 3); DSA_WAIT(n0 + c);
            if (c == 0) {
#pragma unroll
                for (int c2 = 0; c2 < 2; ++c2) { aq[c2] = (bf16x8_t){0, 0, 0, 0, 0, 0, 0, 0}; if (arow) aq[c2] = *(const LAS bf16x8_t*)(Qs + ahead * 128 + 64 * c2 + 16 * kq); }
            }
            const LAS unsigned char* rb = wl + ((n0 + c) & 3) * 4096;
            bf16x8_t kf[2][2];
#pragma unroll
            for (int kt = 0; kt < 2; ++kt) { const int rr = 16 * kt + c16; const LAS unsigned char* rp = rb + rr * 128;
                kf[kt][0] = *(const LAS bf16x8_t*)(rp + ((kq ^ (rr & 7)) << 4)); kf[kt][1] = *(const LAS bf16x8_t*)(rp + (((4 + kq) ^ (rr & 7)) << 4)); }
#pragma unroll
            for (int kt = 0; kt < 2; ++kt) {
                f32x4_t a = {0.f, 0.f, 0.f, 0.f};
                a = __builtin_amdgcn_mfma_f32_16x16x32_bf16(aq[0], kf[kt][0], a, 0, 0, 0); a = __builtin_amdgcn_mfma_f32_16x16x32_bf16(aq[1], kf[kt][1], a, 0, 0, 0);
                sc[2 * c + kt] = (32 * c + 16 * kt + c16 < cnt) ? a[0] : -INFINITY;
            }
        }
        float mx = sc[0];
#pragma unroll
        for (int i = 1; i < 16; ++i) mx = fmaxf(mx, sc[i]);
        mx = fmaxf(mx, __shfl_xor(mx, 1)); mx = fmaxf(mx, __shfl_xor(mx, 2)); mx = fmaxf(mx, __shfl_xor(mx, 4)); mx = fmaxf(mx, __shfl_xor(mx, 8));
        float sum = 0.f;
#pragma unroll
        for (int i = 0; i < 16; ++i) { sc[i] = fexp2(sc[i] - mx); sum += sc[i]; }
        sum += __shfl_xor(sum, 1); sum += __shfl_xor(sum, 2); sum += __shfl_xor(sum, 4); sum += __shfl_xor(sum, 8);
        const float inv = 1.0f / sum;
#pragma unroll
        for (int i = 0; i < 16; ++i) Pl[kq * 256 + 16 * i + c16] = (unsigned short)f2bf(sc[i]);
        f32x4_t o[4];
#pragma unroll
        for (int dt = 0; dt < 4; ++dt) o[dt] = (f32x4_t){0.f, 0.f, 0.f, 0.f};
#pragma unroll
        for (int c = 0; c < 8; ++c) {
            DSA_ISSUE(n0 + 8 + c + 3); DSA_WAIT(n0 + 8 + c);
            if (c == 0 && item + 1 < 2 * nrows) {
                if (lane < 32) { const int t2 = wi + ((item + 1) >> 1) * nper; dma16(AQ + (size_t)(b * SEQ + t2) * 1024 + ((item + 1) & 1) * 512 + lane * 16, Qs);
                    if (g == 1) dma16(SEL + (size_t)(b * SEQ + t2) * 512 + lane * 16, (LAS unsigned char*)(sidx + ((it + 1) & 1) * 256)); }
            }
            const unsigned rba = ring_addr + (unsigned)(((n0 + 8 + c) & 3) * 4096);
            bf16x8_t pa = (bf16x8_t){0, 0, 0, 0, 0, 0, 0, 0};
            if (arow) { const s16x4_t lo = *(const LAS s16x4_t*)(Pl + ahead * 256 + 32 * c + 4 * kq), hi = *(const LAS s16x4_t*)(Pl + ahead * 256 + 32 * c + 16 + 4 * kq);
                pa = (bf16x8_t){lo[0], lo[1], lo[2], lo[3], hi[0], hi[1], hi[2], hi[3]}; }
            const int r1 = 4 * kq + (c16 >> 2), pp = c16 & 3;
            s16x4_t vlo[4], vhi[4];
#pragma unroll
            for (int dt = 0; dt < 4; ++dt) { const unsigned off = (unsigned)(r1 * 128 + (((2 * dt + (pp >> 1)) ^ (r1 & 7)) << 4) + 8 * (pp & 1)); vlo[dt] = tr_read(rba + off); vhi[dt] = tr_read(rba + off + 16 * 128); }
            asm volatile("s_waitcnt lgkmcnt(0)" : "+v"(vlo[0]), "+v"(vlo[1]), "+v"(vlo[2]), "+v"(vlo[3]), "+v"(vhi[0]), "+v"(vhi[1]), "+v"(vhi[2]), "+v"(vhi[3]) :: "memory");
            __builtin_amdgcn_sched_barrier(0);
#pragma unroll
            for (int dt = 0; dt < 4; ++dt) { const bf16x8_t vb = (bf16x8_t){vlo[dt][0], vlo[dt][1], vlo[dt][2], vlo[dt][3], vhi[dt][0], vhi[dt][1], vhi[dt][2], vhi[dt][3]};
                o[dt] = __builtin_amdgcn_mfma_f32_16x16x32_bf16(pa, vb, o[dt], 0, 0, 0); }
        }
        bf16* op = OA + (size_t)row * 1024 + (4 * g + kq) * 64 + c16;
#pragma unroll
        for (int dt = 0; dt < 4; ++dt) op[16 * dt] = (bf16)f2bf(o[dt][0] * inv);
    }
    asm volatile("s_waitcnt vmcnt(0)" ::: "memory");
#undef DSA_ISSUE
#undef DSA_WAIT
}

typedef float f32x2_t __attribute__((ext_vector_type(2))); typedef __bf16 bf16x2v_t __attribute__((ext_vector_type(2)));
__device__ __forceinline__ unsigned cvtpk_s(float lo, float hi) { f32x2_t v = {lo, hi}; bf16x2v_t b = __builtin_convertvector(v, bf16x2v_t); return __builtin_bit_cast(unsigned, b); }
__device__ __forceinline__ int crow16(int reg, int h) { return (reg & 3) + 8 * (reg >> 2) + 4 * h; }

__device__ __forceinline__ void phase_swa_fast(const Params& p, int G, int wv) {
    const int wave = wv, lane = lane_id(), tid = wave * 64 + lane;
    const int r = lane & 31, h = lane >> 5, hh = wave >> 1, qh = wave & 1;
    unsigned char* ws = p.ws;
    const bf16* BQ = (const bf16*)(ws + WS_BQ); const bf16* BK = (const bf16*)(ws + WS_BK); const bf16* BV = (const bf16*)(ws + WS_BV); bf16* OB = (bf16*)(ws + WS_OAB) + 512;
    for (int k = 0;; ++k) {
        int b, idx;
        if (G >= 8 && (G & 7) == 0) { idx = (blockIdx.x >> 3) + (G >> 3) * k; if (idx >= 64) break; b = blockIdx.x & 7; }
        else { const int u = blockIdx.x + k * G; if (u >= 512) break; b = u >> 6; idx = u & 63; }
        const int qb = idx >> 1, g = idx & 1, head = 4 * g + hh;
        const float sink = p.sinks[head] * LOG2E;
        const bf16* Kb = BK + (size_t)b * SEQ * 128 + g * 64 + 8 * h; const bf16* Vb = BV + (size_t)b * SEQ * 128 + g * 64 + r;
#pragma unroll 1
        for (int qt = 0; qt < 2; ++qt) {
            const int q0 = 128 * qb + 64 * qh + 32 * qt;
            const size_t qrow = (size_t)b * SEQ + q0 + r;
            bf16x8_t qf[4];
#pragma unroll
            for (int s = 0; s < 4; ++s) qf[s] = *(const bf16x8_t*)(BQ + qrow * 512 + head * 64 + 16 * s + 8 * h);
            f32x16_t S[5];
#pragma unroll
            for (int kt = 0; kt < 5; ++kt) {
                const int kb0 = q0 - 128 + 32 * kt; const int krow_ = kb0 + r; const int kc = krow_ < 0 ? 0 : krow_;
                bf16x8_t kf[4];
#pragma unroll
                for (int s = 0; s < 4; ++s) kf[s] = *(const bf16x8_t*)(Kb + (size_t)kc * 128 + 16 * s);
                f32x16_t a = {0.f, 0.f, 0.f, 0.f, 0.f, 0.f, 0.f, 0.f, 0.f, 0.f, 0.f, 0.f, 0.f, 0.f, 0.f, 0.f};
#pragma unroll
                for (int s = 0; s < 4; ++s) a = __builtin_amdgcn_mfma_f32_32x32x16_bf16(kf[s], qf[s], a, 0, 0, 0);
#pragma unroll
                for (int i = 0; i < 16; ++i) { const int key = kb0 + crow16(i, h); const int rel = q0 + r - key; S[kt][i] = (key >= 0 && rel >= 0 && rel < WIN) ? a[i] : -INFINITY; }
            }
            float mx = sink;
#pragma unroll
            for (int kt = 0; kt < 5; ++kt)
#pragma unroll
                for (int i = 0; i < 16; ++i) mx = fmaxf(mx, S[kt][i]);
            mx = fmaxf(mx, __shfl_xor(mx, 32));
            float l = 0.f;
#pragma unroll
            for (int kt = 0; kt < 5; ++kt)
#pragma unroll
                for (int i = 0; i < 16; ++i) { S[kt][i] = fexp2(S[kt][i] - mx); l += S[kt][i]; }
            l += __shfl_xor(l, 32); l += fexp2(sink - mx);
            const float linv = 1.0f / l;
            f32x16_t O0 = {0.f, 0.f, 0.f, 0.f, 0.f, 0.f, 0.f, 0.f, 0.f, 0.f, 0.f, 0.f, 0.f, 0.f, 0.f, 0.f}, O1 = O0;
#pragma unroll
            for (int kt = 0; kt < 5; ++kt) {
                const int kb0 = q0 - 128 + 32 * kt;
#pragma unroll
                for (int s = 0; s < 2; ++s) {
                    v4u pw; pw.x = cvtpk_s(S[kt][8 * s + 0], S[kt][8 * s + 1]); pw.y = cvtpk_s(S[kt][8 * s + 2], S[kt][8 * s + 3]); pw.z = cvtpk_s(S[kt][8 * s + 4], S[kt][8 * s + 5]); pw.w = cvtpk_s(S[kt][8 * s + 6], S[kt][8 * s + 7]);
                    const bf16x8_t pa = __builtin_bit_cast(bf16x8_t, pw);
                    unsigned short v0[8], v1[8];
#pragma unroll
                    for (int j = 0; j < 8; ++j) { int key = kb0 + 16 * s + 8 * (j >> 2) + 4 * h + (j & 3); key = key < 0 ? 0 : key; v0[j] = Vb[(size_t)key * 128]; v1[j] = Vb[(size_t)key * 128 + 32]; }
                    const bf16x8_t vb0 = (bf16x8_t){(short)v0[0], (short)v0[1], (short)v0[2], (short)v0[3], (short)v0[4], (short)v0[5], (short)v0[6], (short)v0[7]};
                    const bf16x8_t vb1 = (bf16x8_t){(short)v1[0], (short)v1[1], (short)v1[2], (short)v1[3], (short)v1[4], (short)v1[5], (short)v1[6], (short)v1[7]};
                    O0 = __builtin_amdgcn_mfma_f32_32x32x16_bf16(pa, vb0, O0, 0, 0, 0); O1 = __builtin_amdgcn_mfma_f32_32x32x16_bf16(pa, vb1, O1, 0, 0, 0);
                }
            }
            bf16* op = OB + ((size_t)b * SEQ + q0) * 1024 + head * 64 + r;
#pragma unroll
            for (int i = 0; i < 16; ++i) { const int qq = crow16(i, h); const float li = __shfl(linv, qq); op[(size_t)qq * 1024] = (bf16)f2bf(O0[i] * li); op[(size_t)qq * 1024 + 32] = (bf16)f2bf(O1[i] * li); }
        }
    }
}

#define XB_TMO      128
#define XB_XCNT(j)  (256  + 64 * (j))
#define XB_XSUB(j)  (1280 + 64 * (j))
#define XB_XGEN(j)  (2304 + 64 * (j))
#define XB_TOP      3328
#define XB_TOPGEN   3392
#define XCD_BAR_WORDS 3456
#define XB_SPIN_CAP (1u << 18)

__device__ __forceinline__ unsigned xb_ld(unsigned* p)              { return __hip_atomic_load(p, __ATOMIC_RELAXED, __HIP_MEMORY_SCOPE_AGENT); }
__device__ __forceinline__ unsigned xb_add(unsigned* p, unsigned v) { return __hip_atomic_fetch_add(p, v, __ATOMIC_RELAXED, __HIP_MEMORY_SCOPE_AGENT); }
__device__ __forceinline__ unsigned xb_xcc_id() { return (unsigned)__builtin_amdgcn_s_getreg((3 << 11) | 20) & 0xFu; }
#define XB_SPIN(cond, bar) do { unsigned _sp = 0; while (cond) { __builtin_amdgcn_s_sleep(1); \
    if ((++_sp & 255u) == 0u) { if (xb_ld(&(bar)[XB_TMO])) break; if (_sp > XB_SPIN_CAP) { atomicAdd(&(bar)[XB_TMO], 1u); break; } } } } while (0)

struct XcdBarrier {
    unsigned* bar; unsigned x;
    volatile LAS unsigned* st;
};

__device__ __forceinline__ XcdBarrier xcd_barrier_post(unsigned* bar, volatile LAS unsigned* st) {
    XcdBarrier b; b.bar = bar; b.x = xb_xcc_id(); b.st = st;
    if (threadIdx.x == 0) (void)xb_add(&bar[XB_XCNT(b.x)], 1u);
    return b;
}
__device__ __forceinline__ void xcd_barrier_complete(unsigned* bar, unsigned x, unsigned& nloc, unsigned& nx) {
    const unsigned G = gridDim.x * gridDim.y * gridDim.z;
    unsigned sum, cnt, mine, sp = 0u;
    for (;;) {
        sum = 0u; cnt = 0u; mine = 0u;
#pragma unroll
        for (unsigned j = 0; j < 16; ++j) { const unsigned c = xb_ld(&bar[XB_XCNT(j)]); sum += c; cnt += (c > 0u) ? 1u : 0u; mine = (j == x) ? c : mine; }
        if (sum == G) break;
        __builtin_amdgcn_s_sleep(1);
        if ((++sp & 255u) == 0u) { if (xb_ld(&bar[XB_TMO])) break; if (sp > XB_SPIN_CAP) { atomicAdd(&bar[XB_TMO], 1u); break; } }
    }
    nloc = mine > 0u ? mine : 1u; nx = cnt > 0u ? cnt : 1u;
}

__device__ __forceinline__ void xcd_barrier(const XcdBarrier& b, int wv) {
    asm volatile("s_waitcnt vmcnt(0)" ::: "memory");
    __syncthreads();
    if (wv == 0 && lane_id() == 0) {
        unsigned* bar = b.bar;
        __builtin_amdgcn_s_waitcnt(0);
        unsigned nloc = b.st[0], nx = b.st[1];
        if (nloc == 0u) { xcd_barrier_complete(bar, b.x, nloc, nx); b.st[0] = nloc; b.st[1] = nx; }
        const unsigned old = xb_add(&bar[XB_XSUB(b.x)], 1u);
        const unsigned gen = old / nloc;
        if (old + 1u == (gen + 1u) * nloc) {
            __builtin_amdgcn_fence(__ATOMIC_RELEASE, "agent");
            asm volatile("s_waitcnt vmcnt(0)" ::: "memory");
            const unsigned og = xb_add(&bar[XB_TOP], 1u);
            const unsigned tg = og / nx;
            if (og + 1u == (tg + 1u) * nx) xb_add(&bar[XB_TOPGEN], 1u);
            else XB_SPIN(xb_ld(&bar[XB_TOPGEN]) == tg, bar);
            __builtin_amdgcn_fence(__ATOMIC_ACQUIRE, "agent");
            xb_add(&bar[XB_XGEN(b.x)], 1u);
            asm volatile("s_waitcnt vmcnt(0)" ::: "memory");
        } else {
            XB_SPIN(xb_ld(&bar[XB_XGEN(b.x)]) == gen, bar);
            __builtin_amdgcn_fence(__ATOMIC_ACQUIRE, "agent");
            asm volatile("s_waitcnt vmcnt(0)" ::: "memory");
        }
    }
    __syncthreads();
}

constexpr int NPHASE = 9;
__global__ void __launch_bounds__(NTHREADS, 2) mk_fwd(Params p) {
    extern __shared__ __attribute__((aligned(16))) unsigned char lds_raw[];
    LAS unsigned char* lds = (LAS unsigned char*)lds_raw;
    const int G = gridDim.x, wv = __builtin_amdgcn_readfirstlane(threadIdx.x >> 6);
    unsigned char* ws = p.ws;
#if MK_ONE_LAUNCH
#define SEAM(k) do { if (rep_ + 1 < REPS(k)) __syncthreads(); else if (lo <= (k) && (k) + 1 < hi) { xcd_barrier(xbar, wv); } } while (0)
#else
#define SEAM(k) do { if (rep_ + 1 < REPS(k)) __syncthreads(); } while (0)
#endif
    const int lo = p.ph_lo, hi = p.ph_hi;
#if MK_ONE_LAUNCH
    if (threadIdx.x == 0) { ((volatile LAS unsigned*)(lds + XB_LDS_OFF))[0] = 0u; ((volatile LAS unsigned*)(lds + XB_LDS_OFF))[1] = 0u; }
    const XcdBarrier xbar = xcd_barrier_post((unsigned*)(ws + WS_BAR), (volatile LAS unsigned*)(lds + XB_LDS_OFF));
#endif
#ifdef PROBE_TS
    unsigned long long* TS = (unsigned long long*)(ws + WS_RSTD1 + 384 * 1024);
#define STAMP(k) do { if (blockIdx.x == 0) TS[k] = __builtin_amdgcn_s_memrealtime(); } while (0)
#else
#define STAMP(k) do { } while (0)
#endif
#if MK_ONE_LAUNCH
    if (p.ph_hi > 1000) cg::this_grid().sync();
#endif
    STAMP(0);
#ifndef PHMASK
#define PHMASK 0x1ffu
#endif
#define IN(k) (((PHMASK >> (k)) & 1u) && lo <= (k) && (k) < hi)
#define REPS(k) (((REP_MASK >> (k)) & 1u) ? 2 : 1)
#define PHASE(k) if (IN(k)) for (int rep_ = 0; rep_ < REPS(k); ++rep_)
    PHASE(0) { phase_prologue(p, lds, G, wv); SEAM(0); STAMP(0 + 1); }
    PHASE(1) {
        pg8::Gemm g{(const bf16*)(ws + WS_XG), (const bf16*)(ws + WS_WIN), TOK, NIN, DM, nullptr, 1 << 30};
        pg8::StaticOrder S; S.init(TOK, NIN, G, (int)blockIdx.x);
        pg8::EpiInProj E{(const float*)(ws + WS_RSTD1), (const float*)(ws + WS_COS), (const float*)(ws + WS_SIN), ws, p.ikw, p.ikb};
#if defined(PROBE_INPROJ2) && PROBE_INPROJ2 == 3
        { pg8::EpiInProjT<true> E3{(const float*)(ws + WS_RSTD1), (const float*)(ws + WS_COS), (const float*)(ws + WS_SIN), ws, p.ikw, p.ikb}; pg8::gemm_phase<pg8::EpiInProjT<true>, pg8::StaticOrder, true, true>(lds, g, S, E3, wv); __syncthreads(); }
#endif
        pg8::gemm_phase<pg8::EpiInProj, pg8::StaticOrder, true, true>(lds, g, S, E, wv);
#ifdef PROBE_INPROJ2
#if PROBE_INPROJ2 == 3
#elif PROBE_INPROJ2 == 1
        __syncthreads(); pg8::gemm_phase<pg8::EpiInProj, pg8::StaticOrder, true, true>(lds, g, S, E, wv);
#else
        __syncthreads(); { pg8::EpiDummy E2{(bf16*)(ws + 440 * MiB), NIN}; pg8::gemm_phase<pg8::EpiDummy, pg8::StaticOrder, true, true>(lds, g, S, E2, wv); }
#endif
#endif
        SEAM(1); STAMP(1 + 1);
    }
#if MK_SIMPLE_TOPK
    PHASE(2) { phase_topk_simple(p, lds, G, wv); SEAM(2); STAMP(2 + 1); }
#else
    PHASE(2) { phase_topk_fast(p, lds, G, wv); SEAM(2); STAMP(2 + 1); }
#endif
#if MK_SIMPLE_DSA
    PHASE(3) { phase_attn_simple<true, true>(p, lds, G, wv); SEAM(3); STAMP(3 + 1); }
#else
#if MK_SIMPLE_SWA
    PHASE(3) { phase_dsa_fast(p, lds, G, wv); __syncthreads(); phase_attn_simple<false, true>(p, lds, G, wv); SEAM(3); STAMP(3 + 1); }
#else
#ifndef REP_SWA
#define REP_SWA 1
#endif
#ifndef REP_DSA
#define REP_DSA 1
#endif
    PHASE(3) { for (int q_ = 0; q_ < REP_SWA; ++q_) phase_swa_fast(p, G, wv); for (int q_ = 0; q_ < REP_DSA; ++q_) phase_dsa_fast(p, lds, G, wv); SEAM(3); STAMP(3 + 1); }
#endif
#endif
    PHASE(4) {
        pg8::Gemm g{(const bf16*)(ws + WS_OAB), (const bf16*)(ws + WS_WAB), TOK, DM, DM, nullptr, 1 << 30};
        pg8::StaticOrder S; S.init(TOK, DM, G, (int)blockIdx.x);
        pg8::EpiGate2 E{(const bf16*)(ws + WS_GA), (const bf16*)(ws + WS_GB), (bf16*)(ws + WS_MIX)};
        pg8::gemm_phase<pg8::EpiGate2, pg8::StaticOrder, true, true>(lds, g, S, E, wv);
        SEAM(4); STAMP(4 + 1);
    }
    PHASE(5) {
        pg8::Gemm g{(const bf16*)(ws + WS_MIX), (const bf16*)(ws + WS_WOUT), TOK, DM, DM, nullptr, 1 << 30};
        pg8::StaticOrder S; S.init(TOK, DM, G, (int)blockIdx.x);
        pg8::EpiOut E{p.x, (bf16*)(ws + WS_XG), p.mlp_norm_w, (float*)(ws + (rep_ + 1 < REPS(5) ? WS_PROBE_SS : WS_SS2))};
        pg8::gemm_phase<pg8::EpiOut, pg8::StaticOrder, true, true>(lds, g, S, E, wv);
        SEAM(5); STAMP(5 + 1);
    }
    PHASE(6) {
        pg8::Gemm g{(const bf16*)(ws + WS_XG), (const bf16*)(ws + WS_WUP), TOK, DFF, DM, nullptr, 1 << 30};
        pg8::StaticOrder S; S.init(TOK, DFF, G, (int)blockIdx.x);
        pg8::EpiUp E{(const float*)(ws + WS_SS2), (bf16*)(ws + WS_HID)};
        pg8::gemm_phase<pg8::EpiUp, pg8::StaticOrder, true, true>(lds, g, S, E, wv);
        SEAM(6); STAMP(6 + 1);
    }
    PHASE(7) {
        pg8::Gemm g{(const bf16*)(ws + WS_HID), (const bf16*)(ws + WS_WDN), TOK, DM, DFF, nullptr, 1 << 30};
        pg8::StaticOrder S; S.init(TOK, DM, G, (int)blockIdx.x);
        pg8::EpiDown E{(const bf16*)(ws + WS_XG), p.mlp_norm_w, (rep_ + 1 < REPS(7)) ? (float*)(ws + WS_PROBE_OUT) : p.out, (float*)(ws + (rep_ + 1 < REPS(7) ? WS_PROBE_SS : WS_SS3))};
        pg8::gemm_phase<pg8::EpiDown, pg8::StaticOrder, true, true>(lds, g, S, E, wv);
        SEAM(7); STAMP(7 + 1);
    }
#ifdef EXTRA_SYNCS
#if MK_ONE_LAUNCH
    for (int es_ = 0; es_ < EXTRA_SYNCS; ++es_) xcd_barrier(xbar, wv);
#endif
#endif
    PHASE(8) { phase_final(p, G, wv, (rep_ + 1 < REPS(8)) ? (float*)(ws + WS_PROBE_OUT) : p.out); }
#undef PHASE
#undef REPS
#undef IN
#undef SEAM
}

extern "C" void kernel_launch(void* const* d_in, const int* in_sizes, int n_in, void* d_out, int out_size, void* d_ws, size_t ws_size, hipStream_t stream) {
    static int grid = 0;
    if (grid == 0) {
        if (n_in != 13 || in_sizes[0] != TOK * DM || out_size != TOK * DM || ws_size < WS_NEED) {
            fprintf(stderr, "kernel_launch: unexpected shapes (n_in %d, in0 %d, out %d, ws %zu); nothing launched\n", n_in, n_in > 0 ? in_sizes[0] : -1, out_size, ws_size); grid = -1; return; }
        int dev = 0, cus = 0, per_cu = 0;
        (void)hipGetDevice(&dev); (void)hipDeviceGetAttribute(&cus, hipDeviceAttributeMultiprocessorCount, dev);
        if (hipFuncSetAttribute((const void*)mk_fwd, hipFuncAttributeMaxDynamicSharedMemorySize, LDS_BYTES) != hipSuccess) { fprintf(stderr, "kernel_launch: hipFuncSetAttribute failed\n"); grid = -1; return; }
        if (hipOccupancyMaxActiveBlocksPerMultiprocessor(&per_cu, (const void*)mk_fwd, NTHREADS, LDS_BYTES) != hipSuccess || per_cu < 1) { fprintf(stderr, "kernel_launch: occupancy query says %d blocks per CU\n", per_cu); per_cu = 1; }
        (void)hipGetLastError();
        if (per_cu > 1) per_cu = 1;
        grid = cus * per_cu;
    }
    if (grid < 0) return;
    Params p{};
    p.x = (const float*)d_in[0]; p.attn_norm_w = (const float*)d_in[1]; p.w_in = (const float*)d_in[2]; p.ikw = (const float*)d_in[3]; p.ikb = (const float*)d_in[4];
    p.sinks = (const float*)d_in[5]; p.w_a = (const float*)d_in[6]; p.w_b = (const float*)d_in[7]; p.w_out = (const float*)d_in[8]; p.mlp_norm_w = (const float*)d_in[9];
    p.w_up = (const float*)d_in[10]; p.w_down = (const float*)d_in[11]; p.final_w = (const float*)d_in[12];
    p.out = (float*)d_out; p.ws = (unsigned char*)d_ws;
    for (int i = 0; i < 32; ++i) p.inv_freq[i] = 1.0f / powf(10000.0f, (float)(2 * i) / 64.0f);
#if MK_ONE_LAUNCH
    if (hipMemsetAsync((char*)d_ws + WS_BAR, 0, 16384, stream) != hipSuccess) { fprintf(stderr, "kernel_launch: hipMemsetAsync of the barrier words failed\n"); return; }
    p.ph_lo = 0; p.ph_hi = NPHASE;
    void* args[] = {&p};
    hipError_t e = hipLaunchCooperativeKernel((const void*)mk_fwd, dim3(grid), dim3(NTHREADS), args, LDS_BYTES, stream);
    if (e != hipSuccess) fprintf(stderr, "kernel_launch: cooperative launch failed: %s (grid %d)\n", hipGetErrorString(e), grid);
#else
    for (int ph = 0; ph < NPHASE; ++ph) {
        p.ph_lo = ph; p.ph_hi = ph + 1;
        hipLaunchKernelGGL(mk_fwd, dim3(grid), dim3(NTHREADS), LDS_BYTES, stream, p);
    }
#endif
}
```
